# Optimizing an MI355X kernel written in HIP

```python
import math
import jax, jax.numpy as jnp
from jax import lax
import numpy as np

D_MODEL = 1024
BATCH = 16
SEQ = 2048
DEPTH = 1

CHUNK = 64
N_META = 16
D_FF = ((8 * D_MODEL // 3) + 127) // 128 * 128
RMS_EPS = 1e-6
SSM_WIDTH = D_MODEL // 2
SSM_GROUP = 16
SSM_GROUPS = SSM_WIDTH // SSM_GROUP
SSM_STATE = 64
HEAD_DIM = 64
ATT_WIDTH = D_MODEL // 2
N_HEADS = ATT_WIDTH // HEAD_DIM
KV_DIM = HEAD_DIM
IDX_HEADS = 8
IDX_DIM = 64
TOPK_MAX = 256
Q_BLOCK = 128
REL_BUCKETS = 32
REL_MAX_DIST = 128
N_BRANCH = 2
IN_SPLITS = (SSM_WIDTH, IDX_HEADS * IDX_DIM, IDX_DIM, IDX_HEADS, ATT_WIDTH, KV_DIM, KV_DIM, N_BRANCH * D_MODEL)
IN_WIDTH = sum(IN_SPLITS)

kernel_name = "hybrid_s5_dsa_gated_encoder_layer"


def split_columns(t, sizes):
    out, start = [], 0
    for s in sizes:
        out.append(t[..., start:start + s])
        start += s
    return out


def rms_norm(x, g):
    xf = x.astype(jnp.float32)
    y = xf * lax.rsqrt(jnp.mean(xf * xf, axis=-1, keepdims=True) + RMS_EPS)
    return (y * g.astype(jnp.float32)).astype(x.dtype)


def swiglu(x, w_gate, w_up, w_down):
    return (jax.nn.silu(x @ w_gate) * (x @ w_up)) @ w_down


def chunk_ids(pos):
    return jnp.where(pos < N_META, 0, 1 + (pos - N_META) // CHUNK)


def rel_bucket(rel):
    half = REL_BUCKETS // 2
    max_exact = half // 2
    base = jnp.where(rel > 0, half, 0)
    n = jnp.abs(rel)
    nf = jnp.maximum(n, 1).astype(jnp.float32)
    large = max_exact + (jnp.log(nf / max_exact) / math.log(REL_MAX_DIST / max_exact)
                         * (half - max_exact)).astype(jnp.int32)
    large = jnp.minimum(large, half - 1)
    return base + jnp.where(n < max_exact, n, large)


def s5_mixer(u, lambda_re, lambda_im, log_dt, b_re, b_im, c_re, c_im, d_skip, w_glu):
    f32 = jnp.float32
    bsz, L, _ = u.shape
    uf = u.astype(f32).reshape(bsz, L, SSM_GROUPS, SSM_GROUP)
    lr = lambda_re.astype(f32)
    li = lambda_im.astype(f32)
    dt = jnp.exp(log_dt.astype(f32))[:, None]
    mag = jnp.exp(lr * dt)
    a_re = mag * jnp.cos(li * dt)
    a_im = mag * jnp.sin(li * dt)
    den = lr * lr + li * li
    num_re = a_re - 1.0
    num_im = a_im
    coef_re = (num_re * lr + num_im * li) / den
    coef_im = (num_im * lr - num_re * li) / den
    br = b_re.astype(f32)
    bi = b_im.astype(f32)
    bbar_re = coef_re[..., None] * br - coef_im[..., None] * bi
    bbar_im = coef_re[..., None] * bi + coef_im[..., None] * br
    bu_re = jnp.einsum('blgm,gpm->blgp', uf, bbar_re)
    bu_im = jnp.einsum('blgm,gpm->blgp', uf, bbar_im)
    a_re_t = jnp.broadcast_to(a_re[None, None], (1, L, SSM_GROUPS, SSM_STATE))
    a_im_t = jnp.broadcast_to(a_im[None, None], (1, L, SSM_GROUPS, SSM_STATE))

    def combine(e1, e2):
        a1r, a1i, b1r, b1i = e1
        a2r, a2i, b2r, b2i = e2
        return (a2r * a1r - a2i * a1i,
                a2r * a1i + a2i * a1r,
                a2r * b1r - a2i * b1i + b2r,
                a2r * b1i + a2i * b1r + b2i)

    _, _, x_re, x_im = lax.associative_scan(combine, (a_re_t, a_im_t, bu_re, bu_im), axis=1)
    y = (jnp.einsum('blgp,gmp->blgm', x_re, c_re.astype(f32))
         - jnp.einsum('blgp,gmp->blgm', x_im, c_im.astype(f32))
         + d_skip.astype(f32) * uf)
    y = jax.nn.gelu(y.reshape(bsz, L, SSM_WIDTH)).astype(u.dtype)
    return y * jax.nn.sigmoid(y @ w_glu)


def dsa_mixer(q_idx, k_idx, w_idx, q, k, v, rel_bias, top_k):
    f32 = jnp.float32
    bsz, L, _ = q.shape
    Lp = -(-L // Q_BLOCK) * Q_BLOCK
    nblk = Lp // Q_BLOCK
    pad = lambda t: jnp.pad(t, ((0, 0), (0, Lp - L), (0, 0)))
    q_idx = pad(q_idx).reshape(bsz, Lp, IDX_HEADS, IDX_DIM)
    w_idx = pad(w_idx)
    q = pad(q).reshape(bsz, Lp, N_HEADS, HEAD_DIM)
    kidx_f = pad(k_idx).astype(f32)
    k = pad(k)
    v = pad(v)
    pos = jnp.arange(Lp, dtype=jnp.int32)
    cid = chunk_ids(pos)
    rb = rel_bias.astype(f32)

    def to_blocks(t):
        return jnp.moveaxis(t.reshape(bsz, nblk, Q_BLOCK, *t.shape[2:]), 1, 0)

    def block(args):
        qi, wi, qb, qpos = args
        s = jax.nn.relu(jnp.einsum('bqhd,bsd->bqhs', qi.astype(f32), kidx_f) * IDX_DIM ** -0.5)
        score = jnp.einsum('bqhs,bqh->bqs', s, wi.astype(f32)) * IDX_HEADS ** -0.5
        qcid = chunk_ids(qpos)
        adm = cid[None, :] <= qcid[:, None]
        score = jnp.where(adm[None], score, -1e30)
        _, sel = lax.top_k(score, top_k)
        valid = cid[sel] <= qcid[None, :, None]
        k_sel = jax.vmap(lambda kb, ib: kb[ib])(k, sel)
        v_sel = jax.vmap(lambda vb, ib: vb[ib])(v, sel)
        logits = jnp.einsum('bqhd,bqkd->bqhk', qb.astype(f32), k_sel.astype(f32)) * HEAD_DIM ** -0.5
        bias = rb[rel_bucket(sel - qpos[None, :, None])]
        logits = logits + jnp.moveaxis(bias, -1, 2)
        logits = jnp.where(valid[:, :, None, :], logits, -1e30)
        p = jax.nn.softmax(logits, axis=-1)
        return jnp.einsum('bqhk,bqkd->bqhd', p.astype(v.dtype), v_sel)

    outs = lax.map(block, (to_blocks(q_idx), to_blocks(w_idx), to_blocks(q), pos.reshape(nblk, Q_BLOCK)))
    out = jnp.moveaxis(outs, 0, 1).reshape(bsz, Lp, ATT_WIDTH)
    return out[:, :L]


def setup_inputs(seed: int = 0) -> dict:
    key = jax.random.key(seed)
    keys = jax.random.split(key, 32)
    f32 = jnp.float32

    def normal(i, shape, scale):
        return jax.random.normal(keys[i], shape, f32) * scale

    def gain(i):
        return 1.0 + 0.02 * jax.random.normal(keys[i], (DEPTH, D_MODEL), f32)

    G, P, M = SSM_GROUPS, SSM_STATE, SSM_GROUP
    n = jnp.arange(P, dtype=f32)
    return {
        "x": normal(0, (BATCH, SEQ, D_MODEL), 1.0),
        "meta_tokens": normal(1, (N_META, D_MODEL), 1.0),
        "ff1_norm_pre": gain(2),
        "ff1_norm_post": gain(3),
        "mix_norm_pre": gain(4),
        "mix_norm_post": gain(5),
        "ff2_norm_pre": gain(6),
        "ff2_norm_post": gain(7),
        "ff1_w_gate": normal(8, (DEPTH, D_MODEL, D_FF), D_MODEL ** -0.5),
        "ff1_w_up": normal(9, (DEPTH, D_MODEL, D_FF), D_MODEL ** -0.5),
        "ff1_w_down": normal(10, (DEPTH, D_FF, D_MODEL), D_FF ** -0.5),
        "ff2_w_gate": normal(11, (DEPTH, D_MODEL, D_FF), D_MODEL ** -0.5),
        "ff2_w_up": normal(12, (DEPTH, D_MODEL, D_FF), D_MODEL ** -0.5),
        "ff2_w_down": normal(13, (DEPTH, D_FF, D_MODEL), D_FF ** -0.5),
        "w_in": normal(14, (DEPTH, D_MODEL, IN_WIDTH), D_MODEL ** -0.5),
        "ssm_lambda_re": -0.5 + normal(15, (DEPTH, G, P), 0.01),
        "ssm_lambda_im": math.pi * n + normal(16, (DEPTH, G, P), 0.01),
        "ssm_log_dt": jax.random.uniform(keys[17], (DEPTH, G), f32, math.log(1e-3), math.log(1e-1)),
        "ssm_b_re": normal(18, (DEPTH, G, P, M), (2 * M) ** -0.5),
        "ssm_b_im": normal(19, (DEPTH, G, P, M), (2 * M) ** -0.5),
        "ssm_c_re": normal(20, (DEPTH, G, M, P), P ** -0.5),
        "ssm_c_im": normal(21, (DEPTH, G, M, P), P ** -0.5),
        "ssm_d": normal(22, (DEPTH, G, M), 1.0),
        "ssm_w_glu": normal(23, (DEPTH, SSM_WIDTH, SSM_WIDTH), SSM_WIDTH ** -0.5),
        "w_branch_a": normal(24, (DEPTH, SSM_WIDTH, D_MODEL), SSM_WIDTH ** -0.5),
        "rel_bias": normal(25, (REL_BUCKETS, N_HEADS), 0.2),
        "w_branch_b": normal(26, (DEPTH, ATT_WIDTH, D_MODEL), ATT_WIDTH ** -0.5),
        "w_out": normal(27, (DEPTH, D_MODEL, D_MODEL), D_MODEL ** -0.5),
    }


def reference(x, meta_tokens, ff1_norm_pre, ff1_norm_post, mix_norm_pre, mix_norm_post,
              ff2_norm_pre, ff2_norm_post, ff1_w_gate, ff1_w_up, ff1_w_down,
              ff2_w_gate, ff2_w_up, ff2_w_down, w_in, ssm_lambda_re, ssm_lambda_im, ssm_log_dt,
              ssm_b_re, ssm_b_im, ssm_c_re, ssm_c_im, ssm_d, ssm_w_glu, w_branch_a, rel_bias,
              w_branch_b, w_out):
    bsz = x.shape[0]
    meta = jnp.broadcast_to(meta_tokens[None].astype(x.dtype), (bsz, N_META, D_MODEL))
    h = jnp.concatenate([meta, x], axis=1)
    L = h.shape[1]
    top_k = min(TOPK_MAX, SEQ // 4)
    for l in range(DEPTH):
        hn = rms_norm(h, ff1_norm_pre[l])
        h = h + 0.5 * rms_norm(swiglu(hn, ff1_w_gate[l], ff1_w_up[l], ff1_w_down[l]), ff1_norm_post[l])
        hn = rms_norm(h, mix_norm_pre[l])
        proj = hn @ w_in[l]
        u_a, q_idx, k_idx, w_idx, q, k, v, gates = split_columns(proj, IN_SPLITS)
        y_a = s5_mixer(u_a, ssm_lambda_re[l], ssm_lambda_im[l], ssm_log_dt[l], ssm_b_re[l],
                       ssm_b_im[l], ssm_c_re[l], ssm_c_im[l], ssm_d[l], ssm_w_glu[l])
        y_b = dsa_mixer(q_idx, k_idx, w_idx, q, k, v, rel_bias, top_k)
        g = jax.nn.sigmoid(gates).reshape(bsz, L, N_BRANCH, D_MODEL)
        merged = g[:, :, 0] * (y_a @ w_branch_a[l]) + g[:, :, 1] * (y_b @ w_branch_b[l])
        h = h + rms_norm(merged @ w_out[l], mix_norm_post[l])
        hn = rms_norm(h, ff2_norm_pre[l])
        h = h + 0.5 * rms_norm(swiglu(hn, ff2_w_gate[l], ff2_w_up[l], ff2_w_down[l]), ff2_norm_post[l])
    return h[:, N_META:]
```

```cpp
#include <hip/hip_runtime.h>
#include <cstdio>
#include <cstdint>
namespace pg8 {
#define PG8_LAS __attribute__((address_space(3)))
typedef unsigned short bf16_t;
typedef short bf16x8 __attribute__((ext_vector_type(8)));
typedef float f32x4 __attribute__((ext_vector_type(4)));
typedef unsigned u32x4 __attribute__((ext_vector_type(4)));
constexpr int BM = 256, BK = 64, HALF = 128, HTB = HALF * BK * 2  , STAGE_BYTES = 8 * HTB, NXCD = 8, WGM = 8;

__host__ __device__ __forceinline__ int lds_byte(int r, int c) { const int st = (r >> 4) * 2 + (c >> 5), rr = r & 15, cc = c & 31, ob = rr * 64 + cc * 2; return st * 1024 + (ob ^ (((ob >> 9) & 1) << 5)); }
__host__ __device__ __forceinline__ void stage_rc(int b, int& R, int& C) { const int st = b / 1024, sb = b % 1024, swz = sb ^ (((sb >> 9) & 1) << 5); R = (st >> 1) * 16 + swz / 64; C = (st & 1) * 32 + (swz % 64) / 2; }
__host__ __device__ __forceinline__ int perm32(int rho) { const int n = rho >> 4, i = rho & 15; return 8 * (i >> 2) + 4 * n + (i & 3); }

struct Unit { int pm, pn; };
struct Gemm { const bf16_t* A; const bf16_t* Bt; int M, N, K; };

struct StaticOrder {
    int nM, nN, nwg, G, c;
    __host__ __device__ void init(int M, int N, int G_, int c_) { nM = M / BM; nN = N / BM; nwg = nM * nN; G = G_; c = c_; }
    __host__ __device__ bool next(int i, Unit& u) const {
        const long L = (long)i * G + c; if (L >= nwg) return false;
        int wgid = (int)L; { const int q = nwg / NXCD, r = nwg % NXCD, xcd = wgid % NXCD, off = wgid / NXCD; wgid = (xcd < r ? xcd * (q + 1) : r * (q + 1) + (xcd - r) * q) + off; }
        const int nig = WGM * nN, gid = wgid / nig, fm = gid * WGM, gsz = (nM - fm) < WGM ? (nM - fm) : WGM;
        u.pm = fm + ((wgid % nig) % gsz); u.pn = (wgid % nig) / gsz; return true;
    }
    __device__ __forceinline__ void a_ready(const Unit&) const {}
    __device__ __forceinline__ void done(const Unit&) const {}
};
__device__ __forceinline__ unsigned cvt_pk_bf16(float lo, float hi) { unsigned r; asm volatile("v_cvt_pk_bf16_f32 %0, %1, %2" : "=v"(r) : "v"(lo), "v"(hi)); return r; }
__device__ __forceinline__ float fsigmoid(float x) { return __builtin_amdgcn_rcpf(1.0f + __expf(-x)); }
__device__ __forceinline__ float bf_lo(unsigned w) { return __uint_as_float(w << 16); }
__device__ __forceinline__ float bf_hi(unsigned w) { return __uint_as_float(w & 0xffff0000u); }
__device__ __forceinline__ u32x4 pack8(const f32x4 v0, const f32x4 v1) { u32x4 w; w.x = cvt_pk_bf16(v0[0], v0[1]); w.y = cvt_pk_bf16(v0[2], v0[3]); w.z = cvt_pk_bf16(v1[0], v1[1]); w.w = cvt_pk_bf16(v1[2], v1[3]); return w; }
__device__ __forceinline__ void unpack8(const u32x4 w, f32x4& v0, f32x4& v1) { v0 = (f32x4){bf_lo(w.x), bf_hi(w.x), bf_lo(w.y), bf_hi(w.y)}; v1 = (f32x4){bf_lo(w.z), bf_hi(w.z), bf_lo(w.w), bf_hi(w.w)}; }

struct EpiSwiglu {
    static constexpr bool PERM = true, AFTER_DRAIN = false;
    bf16_t* O; int ldc;
    __device__ __forceinline__ void operator()(const f32x4 (&acc)[2][2][4][2], const Unit& u, int wr, int wc, int fr, int fq) const {
        const int row0 = u.pm * BM + wr * 64 + fr, col0 = u.pn * HALF + wc * 32 + 8 * fq;
#pragma unroll
        for (int ai = 0; ai < 2; ++ai)
#pragma unroll
            for (int m = 0; m < 4; ++m) { bf16_t* rowp = O + (size_t)(row0 + ai * HALF + m * 16) * ldc + col0;
                f32x4 v0, v1;
#pragma unroll
                for (int j = 0; j < 4; ++j) { const float g0 = acc[ai][0][m][0][j], g1 = acc[ai][0][m][1][j];
                    v0[j] = g0 * fsigmoid(g0) * acc[ai][1][m][0][j]; v1[j] = g1 * fsigmoid(g1) * acc[ai][1][m][1][j]; }
                *(u32x4*)rowp = pack8(v0, v1); }
    }
};
struct EpiPlain {
    static constexpr bool PERM = true, AFTER_DRAIN = false;
    bf16_t* O; int ldc;
    __device__ __forceinline__ void operator()(const f32x4 (&acc)[2][2][4][2], const Unit& u, int wr, int wc, int fr, int fq) const {
        const int row0 = u.pm * BM + wr * 64 + fr, col0 = u.pn * BM + wc * 32 + 8 * fq;
#pragma unroll
        for (int ai = 0; ai < 2; ++ai)
#pragma unroll
            for (int m = 0; m < 4; ++m) { bf16_t* rowp = O + (size_t)(row0 + ai * HALF + m * 16) * ldc + col0;
#pragma unroll
                for (int bj = 0; bj < 2; ++bj) *(u32x4*)(rowp + bj * HALF) = pack8(acc[ai][bj][m][0], acc[ai][bj][m][1]); }
    }
};
struct EpiProj {
    static constexpr bool PERM = true, AFTER_DRAIN = false;
    bf16_t *PA, *PG, *PK;
    __device__ __forceinline__ void operator()(const f32x4 (&acc)[2][2][4][2], const Unit& u, int wr, int wc, int fr, int fq) const {
        bf16_t* base; int ldc, colt;
        if (u.pn < 6) { base = PA; ldc = 1536; colt = 256 * u.pn; } else if (u.pn < 14) { base = PG; ldc = 2048; colt = 256 * (u.pn - 6); } else { base = PK; ldc = 256; colt = 0; }
        const int row0 = u.pm * BM + wr * 64 + fr, col0 = colt + wc * 32 + 8 * fq;
#pragma unroll
        for (int ai = 0; ai < 2; ++ai)
#pragma unroll
            for (int m = 0; m < 4; ++m) { bf16_t* rowp = base + (size_t)(row0 + ai * HALF + m * 16) * ldc + col0;
#pragma unroll
                for (int bj = 0; bj < 2; ++bj) *(u32x4*)(rowp + bj * HALF) = pack8(acc[ai][bj][m][0], acc[ai][bj][m][1]); }
    }
};
struct EpiGlu {
    static constexpr bool PERM = true, AFTER_DRAIN = false;
    const bf16_t* Y; bf16_t* O;
    __device__ __forceinline__ void operator()(const f32x4 (&acc)[2][2][4][2], const Unit& u, int wr, int wc, int fr, int fq) const {
        const int row0 = u.pm * BM + wr * 64 + fr, col0 = u.pn * BM + wc * 32 + 8 * fq;
#pragma unroll
        for (int ai = 0; ai < 2; ++ai)
#pragma unroll
            for (int m = 0; m < 4; ++m) { const size_t off = (size_t)(row0 + ai * HALF + m * 16) * 512 + col0;
#pragma unroll
                for (int bj = 0; bj < 2; ++bj) { f32x4 y0, y1; unpack8(*(const u32x4*)(Y + off + bj * HALF), y0, y1); f32x4 v0, v1;
#pragma unroll
                    for (int j = 0; j < 4; ++j) { v0[j] = y0[j] * fsigmoid(acc[ai][bj][m][0][j]); v1[j] = y1[j] * fsigmoid(acc[ai][bj][m][1][j]); }
                    *(u32x4*)(O + off + bj * HALF) = pack8(v0, v1); } }
    }
};
template <bool SECOND> struct EpiMerge {
    static constexpr bool PERM = true, AFTER_DRAIN = false;
    const bf16_t* G; int goff; const bf16_t* T; bf16_t* O;
    __device__ __forceinline__ void operator()(const f32x4 (&acc)[2][2][4][2], const Unit& u, int wr, int wc, int fr, int fq) const {
        const int row0 = u.pm * BM + wr * 64 + fr, col0 = u.pn * BM + wc * 32 + 8 * fq;
#pragma unroll
        for (int ai = 0; ai < 2; ++ai)
#pragma unroll
            for (int m = 0; m < 4; ++m) { const size_t row = (size_t)(row0 + ai * HALF + m * 16);
#pragma unroll
                for (int bj = 0; bj < 2; ++bj) { const int col = col0 + bj * HALF; f32x4 g0, g1; unpack8(*(const u32x4*)(G + row * 2048 + goff + col), g0, g1);
                    f32x4 t0 = (f32x4){0.f, 0.f, 0.f, 0.f}, t1 = t0; if (SECOND) unpack8(*(const u32x4*)(T + row * 1024 + col), t0, t1);
                    f32x4 v0, v1;
#pragma unroll
                    for (int j = 0; j < 4; ++j) { v0[j] = t0[j] + fsigmoid(g0[j]) * acc[ai][bj][m][0][j]; v1[j] = t1[j] + fsigmoid(g1[j]) * acc[ai][bj][m][1][j]; }
                    *(u32x4*)(O + row * 1024 + col) = pack8(v0, v1); } }
    }
};
template <class Epi, class Sched, bool ALIGN_EPI = false, bool SP2 = false>
__device__ __forceinline__ void gemm_phase(PG8_LAS unsigned char* lds, const Gemm g, const Sched& S, const Epi& E) {
    const int tid = threadIdx.x, wid = __builtin_amdgcn_readfirstlane(tid >> 6), lane = tid & 63, wr = wid >> 2, wc = wid & 3, fr = lane & 15, fq = lane >> 4;
    const int K = g.K, nt = K / BK;
    unsigned voffA[2], voffB[2];
#pragma unroll
    for (int i = 0; i < 2; ++i) { int R, C; stage_rc(tid * 16 + i * 8192, R, C); const int Rb = Epi::PERM ? ((R & ~31) + perm32(R & 31)) : R;
        voffA[i] = (unsigned)(R * K + C) * 2u; voffB[i] = (unsigned)(Rb * K + C) * 2u; }
    const size_t kstep = (size_t)(BK * 2);
    const size_t hstep = (size_t)HALF * K * 2;
    const size_t tstep = 2 * hstep;
    const unsigned ldsw = (unsigned)wid * 1024u;
    const int aoff = lds_byte(wr * 64 + fr, fq * 8), boff = lds_byte(wc * 32 + fr, fq * 8);
#define PG8_SA(b, h) (((b) * 2 + (h)) * HTB)
#define PG8_SB(b, h) ((4 + (b) * 2 + (h)) * HTB)
#define PG8_STAGE(bufoff, gbase, voff) do { _Pragma("unroll") for (int _i = 0; _i < 2; ++_i) \
        __builtin_amdgcn_global_load_lds((const unsigned*)((const char*)(gbase) + (voff)[_i]), (PG8_LAS unsigned*)(lds + (bufoff) + ldsw + _i * 8192), 16, 0, 0); } while (0)
#define PG8_LDA(dst, b, h) do { _Pragma("unroll") for (int m = 0; m < 4; ++m) _Pragma("unroll") for (int k = 0; k < 2; ++k) dst[m][k] = *(const PG8_LAS bf16x8*)(lds + PG8_SA(b, h) + aoff + m * 2048 + k * 1024); } while (0)
#define PG8_LDB(dst, b, h) do { _Pragma("unroll") for (int n = 0; n < 2; ++n) _Pragma("unroll") for (int k = 0; k < 2; ++k) dst[n][k] = *(const PG8_LAS bf16x8*)(lds + PG8_SB(b, h) + boff + n * 2048 + k * 1024); } while (0)
#define PG8_MMA(ai, bj, At, Bt) do { __builtin_amdgcn_s_setprio(1); _Pragma("unroll") for (int m = 0; m < 4; ++m) _Pragma("unroll") for (int n = 0; n < 2; ++n) _Pragma("unroll") for (int k = 0; k < 2; ++k) \
        acc[ai][bj][m][n] = __builtin_amdgcn_mfma_f32_16x16x32_bf16(Bt[n][k], At[m][k], acc[ai][bj][m][n], 0, 0, 0); __builtin_amdgcn_s_setprio(0); } while (0)
#define PG8_WAIT_V(n) asm volatile("s_waitcnt vmcnt(" #n ")" ::: "memory")
#define PG8_WAIT_L(n) asm volatile("s_waitcnt lgkmcnt(" #n ")" ::: "memory")
#define PG8_BAR __builtin_amdgcn_s_barrier()
#define PG8_SCHED __builtin_amdgcn_sched_barrier(0)
    Unit cur, nxt; int ui = 0;
    if (!S.next(0, cur)) return;
    f32x4 acc[2][2][4][2];
#pragma unroll
    for (int a = 0; a < 2; ++a)
#pragma unroll
        for (int b = 0; b < 2; ++b)
#pragma unroll
            for (int m = 0; m < 4; ++m)
#pragma unroll
                for (int n = 0; n < 2; ++n) acc[a][b][m][n] = (f32x4){0.f, 0.f, 0.f, 0.f};
    bf16x8 At[4][2], B0[2][2], B1[2][2];
    const char* cA = (const char*)g.A + (size_t)cur.pm * tstep; const char* cB = (const char*)g.Bt + (size_t)cur.pn * tstep;
    S.a_ready(cur);
    if constexpr (SP2) {
        PG8_STAGE(PG8_SB(0, 0), cB, voffB); PG8_STAGE(PG8_SB(0, 1), cB + hstep, voffB); PG8_STAGE(PG8_SA(0, 0), cA, voffA); PG8_STAGE(PG8_SA(0, 1), cA + hstep, voffA);
        if (wr == 1) PG8_BAR;
        PG8_WAIT_V(2); PG8_BAR;
        PG8_STAGE(PG8_SB(1, 0), cB + kstep, voffB); PG8_STAGE(PG8_SA(1, 0), cA + kstep, voffA); PG8_STAGE(PG8_SB(1, 1), cB + hstep + kstep, voffB);
        PG8_WAIT_V(6); PG8_BAR;
    } else {
        PG8_STAGE(PG8_SB(0, 0), cB, voffB); PG8_STAGE(PG8_SA(0, 0), cA, voffA); PG8_STAGE(PG8_SB(0, 1), cB + hstep, voffB); PG8_STAGE(PG8_SA(0, 1), cA + hstep, voffA);
        if (wr == 1) PG8_BAR;
        PG8_WAIT_V(4); PG8_BAR;
        PG8_STAGE(PG8_SB(1, 0), cB + kstep, voffB); PG8_STAGE(PG8_SA(1, 0), cA + kstep, voffA); PG8_STAGE(PG8_SB(1, 1), cB + hstep + kstep, voffB);
        PG8_WAIT_V(6); PG8_BAR;
    }
    for (;;) {
        const bool has_next = S.next(ui + 1, nxt);
        const char* nA = has_next ? (const char*)g.A + (size_t)nxt.pm * tstep : cA; const char* nB = has_next ? (const char*)g.Bt + (size_t)nxt.pn * tstep : cB;
        for (int t = 0; t < nt; t += 2) {
            const bool last = (t == nt - 2);
            const char* a1 = cA + (size_t)(t + 1) * kstep;
            const char* a2 = last ? nA : cA + (size_t)(t + 2) * kstep; const char* b2 = last ? nB : cB + (size_t)(t + 2) * kstep;
            const char* a3 = a2 + kstep; const char* b3 = b2 + kstep;
            if (last && has_next) S.a_ready(nxt);
            if constexpr (SP2) {
            PG8_LDB(B0, 0, 0); PG8_LDB(B1, 0, 1); PG8_SCHED; PG8_LDA(At, 0, 0); PG8_STAGE(PG8_SA(1, 1), a1 + hstep, voffA);
            PG8_WAIT_V(8); PG8_WAIT_L(0); PG8_BAR; PG8_MMA(0, 0, At, B0); PG8_MMA(0, 1, At, B1); PG8_BAR; PG8_SCHED;
            PG8_LDA(At, 0, 1); PG8_STAGE(PG8_SB(0, 0), b2, voffB); PG8_STAGE(PG8_SB(0, 1), b2 + hstep, voffB); PG8_STAGE(PG8_SA(0, 0), a2, voffA);
            PG8_WAIT_V(8); PG8_WAIT_L(0); PG8_BAR; PG8_MMA(1, 0, At, B0); PG8_MMA(1, 1, At, B1); PG8_BAR; PG8_SCHED;
            PG8_LDB(B0, 1, 0); PG8_LDB(B1, 1, 1); PG8_SCHED; PG8_LDA(At, 1, 0); PG8_STAGE(PG8_SA(0, 1), a2 + hstep, voffA);
            PG8_WAIT_V(8); PG8_WAIT_L(0); PG8_BAR; PG8_MMA(0, 0, At, B0); PG8_MMA(0, 1, At, B1); PG8_BAR; PG8_SCHED;
            PG8_LDA(At, 1, 1); PG8_STAGE(PG8_SB(1, 0), b3, voffB); PG8_STAGE(PG8_SB(1, 1), b3 + hstep, voffB); PG8_STAGE(PG8_SA(1, 0), a3, voffA);
            PG8_WAIT_V(8); PG8_WAIT_L(0); PG8_BAR; PG8_MMA(1, 0, At, B0); PG8_MMA(1, 1, At, B1); PG8_BAR; PG8_SCHED;
            } else {
            PG8_LDB(B0, 0, 0); PG8_SCHED; PG8_LDA(At, 0, 0); PG8_STAGE(PG8_SA(1, 1), a1 + hstep, voffA);
            PG8_WAIT_L(8); PG8_BAR; PG8_WAIT_L(0); PG8_MMA(0, 0, At, B0); PG8_BAR; PG8_SCHED;
            PG8_LDB(B1, 0, 1); PG8_STAGE(PG8_SB(0, 0), b2, voffB);
            PG8_BAR; PG8_WAIT_L(0); PG8_MMA(0, 1, At, B1); PG8_BAR;
            PG8_LDA(At, 0, 1); PG8_STAGE(PG8_SA(0, 0), a2, voffA);
            PG8_BAR; PG8_WAIT_L(0); PG8_MMA(1, 0, At, B0); PG8_BAR; PG8_SCHED;
            PG8_STAGE(PG8_SB(0, 1), b2 + hstep, voffB);
            PG8_WAIT_V(6); PG8_BAR; PG8_MMA(1, 1, At, B1); PG8_BAR;
            PG8_LDB(B0, 1, 0); PG8_SCHED; PG8_LDA(At, 1, 0); PG8_STAGE(PG8_SA(0, 1), a2 + hstep, voffA);
            PG8_WAIT_L(8); PG8_BAR; PG8_WAIT_L(0); PG8_MMA(0, 0, At, B0); PG8_BAR; PG8_SCHED;
            PG8_LDB(B1, 1, 1); PG8_STAGE(PG8_SB(1, 0), b3, voffB);
            PG8_BAR; PG8_WAIT_L(0); PG8_MMA(0, 1, At, B1); PG8_BAR;
            PG8_LDA(At, 1, 1); PG8_STAGE(PG8_SA(1, 0), a3, voffA);
            PG8_BAR; PG8_WAIT_L(0); PG8_MMA(1, 0, At, B0); PG8_BAR; PG8_SCHED;
            PG8_STAGE(PG8_SB(1, 1), b3 + hstep, voffB);
            PG8_WAIT_V(6); PG8_BAR; PG8_MMA(1, 1, At, B1); PG8_BAR;
            }
        }
        if constexpr (ALIGN_EPI) { if (wr == 0) PG8_BAR; }
        if constexpr (!Epi::AFTER_DRAIN) { E(acc, cur, wr, wc, fr, fq); S.done(cur); }
        if (!has_next) break;
#pragma unroll
        for (int a = 0; a < 2; ++a)
#pragma unroll
            for (int b = 0; b < 2; ++b)
#pragma unroll
                for (int m = 0; m < 4; ++m)
#pragma unroll
                    for (int n = 0; n < 2; ++n) acc[a][b][m][n] = (f32x4){0.f, 0.f, 0.f, 0.f};
        cur = nxt; cA = nA; cB = nB; ++ui;
        if constexpr (ALIGN_EPI) { if (wr == 1) PG8_BAR; }
    }
    PG8_WAIT_V(0);
    if constexpr (!ALIGN_EPI) { if (wr == 0) PG8_BAR; }
    PG8_BAR;
    if constexpr (Epi::AFTER_DRAIN) { E.fused(acc, cur, wr, wc, fr, fq, lds, wid, lane); S.done(cur); }
#undef PG8_SA
#undef PG8_SB
#undef PG8_STAGE
#undef PG8_LDA
#undef PG8_LDB
#undef PG8_MMA
#undef PG8_WAIT_V
#undef PG8_WAIT_L
#undef PG8_BAR
#undef PG8_SCHED
}
}
#ifndef PG8_SP2
#define PG8_SP2 true
#endif
#ifndef PG8_ALIGN
#define PG8_ALIGN true
#endif
#ifndef MK_PER_PHASE
#define MK_PER_PHASE 0
#endif
constexpr int NWAVES = 8;
constexpr int NPH = 14;

constexpr int NB = 16, SEQ = 2048, D = 1024, NMETA = 16, DFF = 2816;
constexpr int R = NB * SEQ;
constexpr int NG = 32, NP = 64, NM = 16;
constexpr float RMS_EPS = 1e-6f;

constexpr size_t MiB = 1u << 20;
constexpr size_t WS_CTL = 0, CTL_ZERO_BYTES = 1 * MiB;
constexpr size_t WS_WT1 = 2 * MiB, WS_WT2 = 13 * MiB, WS_WT3 = 19 * MiB, WS_WT4 = 27 * MiB, WS_WT5 = 38 * MiB;
constexpr size_t WS_WGLU = 44 * MiB, WS_WA = 45 * MiB, WS_WB = 46 * MiB, WS_WOUT = 47 * MiB;
constexpr size_t WS_KS = 50 * MiB, WS_KO = 58 * MiB, WS_KI = 66 * MiB;
constexpr size_t WS_META = 67 * MiB;
constexpr size_t MO_AM1 = 0, MO_ACTM = 32768, MO_FM = 131072, MO_AM2 = 262144, MO_PMU = 294912, MO_PMK = 311296;
constexpr size_t WS_HN = 68 * MiB;
constexpr size_t WS_F = 132 * MiB;
constexpr size_t WS_BIG = 196 * MiB;
constexpr size_t WS_PA = WS_BIG, WS_PG = WS_BIG + 96 * MiB, WS_PK = WS_BIG + 224 * MiB, WS_END = WS_BIG + 240 * MiB;
constexpr int CW_BAR = 4096;

constexpr int LDS_BYTES = 155648;
constexpr int MISC_OFF = 151552;

#define GAS __attribute__((address_space(1)))
#define LAS __attribute__((address_space(3)))
typedef unsigned short bf16;
typedef unsigned v4u __attribute__((ext_vector_type(4)));
typedef unsigned v2u __attribute__((ext_vector_type(2)));
typedef float f32x4 __attribute__((ext_vector_type(4)));
typedef short bf16x8 __attribute__((ext_vector_type(8)));
#define LDS_WAIT() asm volatile("s_waitcnt lgkmcnt(0)" ::: "memory")
#define VM_WAIT() asm volatile("s_waitcnt vmcnt(0)" ::: "memory")
__device__ __forceinline__ unsigned f2bf(float f) { unsigned u = __builtin_bit_cast(unsigned, f); return (u + 0x7fffu + ((u >> 16) & 1u)) >> 16; }
__device__ __forceinline__ unsigned pk2(float lo, float hi) { return f2bf(lo) | (f2bf(hi) << 16); }
__device__ __forceinline__ float bflo(unsigned w) { return __uint_as_float(w << 16); }
__device__ __forceinline__ float bfhi(unsigned w) { return __uint_as_float(w & 0xffff0000u); }
__device__ __forceinline__ float bf2f(bf16 v) { return __uint_as_float(((unsigned)v) << 16); }
__device__ __forceinline__ float fsig(float x) { return __builtin_amdgcn_rcpf(1.0f + __expf(-x)); }

#define XB_TMO      128
#define XB_XCNT(j)  (256  + 64 * (j))
#define XB_XSUB(j)  (1280 + 64 * (j))
#define XB_XGEN(j)  (2304 + 64 * (j))
#define XB_TOP      3328
#define XB_TOPGEN   3392
#define XCD_BAR_WORDS 3456
#define XB_SPIN_CAP (1u << 18)
__device__ __forceinline__ unsigned xb_ld(unsigned* p)              { return __hip_atomic_load(p, __ATOMIC_RELAXED, __HIP_MEMORY_SCOPE_AGENT); }
__device__ __forceinline__ unsigned xb_add(unsigned* p, unsigned v) { return __hip_atomic_fetch_add(p, v, __ATOMIC_RELAXED, __HIP_MEMORY_SCOPE_AGENT); }
__device__ __forceinline__ unsigned xb_xcc_id() { return (unsigned)__builtin_amdgcn_s_getreg((3 << 11) | 20) & 0xFu; }
#define XB_SPIN(cond, bar) do { unsigned _sp = 0; while (cond) { __builtin_amdgcn_s_sleep(1); \
    if ((++_sp & 255u) == 0u) { if (xb_ld(&(bar)[XB_TMO])) break; if (_sp > XB_SPIN_CAP) { atomicAdd(&(bar)[XB_TMO], 1u); break; } } } } while (0)
struct XcdBarrier { unsigned* bar; unsigned x; volatile LAS unsigned* st; };
__device__ __forceinline__ XcdBarrier xcd_barrier_post(unsigned* bar, volatile LAS unsigned* st) {
    XcdBarrier b; b.bar = bar; b.x = xb_xcc_id(); b.st = st;
    if (threadIdx.x == 0) (void)xb_add(&bar[XB_XCNT(b.x)], 1u);
    return b;
}
__device__ __forceinline__ void xcd_barrier_complete(unsigned* bar, unsigned x, unsigned& nloc, unsigned& nx) {
    const unsigned G = gridDim.x * gridDim.y * gridDim.z;
    unsigned sum, cnt, mine, sp = 0u;
    for (;;) {
        sum = 0u; cnt = 0u; mine = 0u;
#pragma unroll
        for (unsigned j = 0; j < 16; ++j) { const unsigned c = xb_ld(&bar[XB_XCNT(j)]); sum += c; cnt += (c > 0u) ? 1u : 0u; mine = (j == x) ? c : mine; }
        if (sum == G) break;
        __builtin_amdgcn_s_sleep(1);
        if ((++sp & 255u) == 0u) { if (xb_ld(&bar[XB_TMO])) break; if (sp > XB_SPIN_CAP) { atomicAdd(&bar[XB_TMO], 1u); break; } }
    }
    nloc = mine > 0u ? mine : 1u; nx = cnt > 0u ? cnt : 1u;
}
__device__ __forceinline__ void xcd_barrier(const XcdBarrier& b) {
    asm volatile("s_waitcnt vmcnt(0)" ::: "memory");
    __syncthreads();
    if (threadIdx.x == 0) {
        unsigned* bar = b.bar;
        __builtin_amdgcn_s_waitcnt(0);
        unsigned nloc = b.st[0], nx = b.st[1];
        if (nloc == 0u) { xcd_barrier_complete(bar, b.x, nloc, nx); b.st[0] = nloc; b.st[1] = nx; }
        const unsigned old = xb_add(&bar[XB_XSUB(b.x)], 1u);
        const unsigned gen = old / nloc;
        if (old + 1u == (gen + 1u) * nloc) {
            __builtin_amdgcn_fence(__ATOMIC_RELEASE, "agent");
            asm volatile("s_waitcnt vmcnt(0)" ::: "memory");
            const unsigned og = xb_add(&bar[XB_TOP], 1u);
            const unsigned tg = og / nx;
            if (og + 1u == (tg + 1u) * nx) xb_add(&bar[XB_TOPGEN], 1u);
            else XB_SPIN(xb_ld(&bar[XB_TOPGEN]) == tg, bar);
            __builtin_amdgcn_fence(__ATOMIC_ACQUIRE, "agent");
            xb_add(&bar[XB_XGEN(b.x)], 1u);
            asm volatile("s_waitcnt vmcnt(0)" ::: "memory");
        } else {
            XB_SPIN(xb_ld(&bar[XB_XGEN(b.x)]) == gen, bar);
            __builtin_amdgcn_fence(__ATOMIC_ACQUIRE, "agent");
            asm volatile("s_waitcnt vmcnt(0)" ::: "memory");
        }
    }
    __syncthreads();
}

__device__ __forceinline__ float wave_sum(float v) {
#pragma unroll
    for (int o = 1; o < 64; o <<= 1) v += __shfl_xor(v, o);
    return v;
}
__device__ __forceinline__ f32x4 mfma16(bf16x8 a, bf16x8 b, f32x4 c) { return __builtin_amdgcn_mfma_f32_16x16x32_bf16(a, b, c, 0, 0, 0); }

__device__ __forceinline__ void transpose_item(const float* W, int Nsrc, int K, bf16* WT, int k0, int drow0, int srccol, LAS float* scr, int lane) {
#pragma unroll 8
    for (int i = 0; i < 32; ++i) { const int kk = 2 * i + (lane >> 5); scr[kk * 33 + (lane & 31)] = (srccol >= 0) ? W[(size_t)(k0 + kk) * Nsrc + srccol] : 0.f; }
    LDS_WAIT(); asm volatile("" ::: "memory");
    const int c = lane & 7;
#pragma unroll
    for (int j = 0; j < 4; ++j) { const int n = (lane >> 3) + 8 * j; const LAS float* s = scr + (8 * c) * 33 + n;
        v4u o; o.x = pk2(s[0 * 33], s[1 * 33]); o.y = pk2(s[2 * 33], s[3 * 33]); o.z = pk2(s[4 * 33], s[5 * 33]); o.w = pk2(s[6 * 33], s[7 * 33]);
        *(v4u*)(WT + (size_t)(drow0 + n) * K + k0 + 8 * c) = o; }
    LDS_WAIT(); asm volatile("" ::: "memory");
}
__device__ __forceinline__ int win_srccol(int d) {
    if (d < 1024) return d;
    if (d < 1536) return 1096 + (d - 1024);
    if (d < 3584) return 1736 + (d - 1536);
    if (d < 3648) return 1024 + (d - 3584);
    if (d < 3712) return 1608 + (d - 3648);
    if (d < 3776) return 1672 + (d - 3712);
    if (d < 3784) return 1088 + (d - 3776);
    return -1;
}
__device__ __forceinline__ void norm_row_to_bf16(const float* xrow, const float* g, bf16* orow, int lane) {
    f32x4 v[4]; float ss = 0.f;
#pragma unroll
    for (int j = 0; j < 4; ++j) { v[j] = ((const f32x4*)xrow)[lane + 64 * j]; ss += (v[j].x * v[j].x + v[j].y * v[j].y) + (v[j].z * v[j].z + v[j].w * v[j].w); }
    const float rs = rsqrtf(wave_sum(ss) * (1.f / D) + RMS_EPS);
#pragma unroll
    for (int j = 0; j < 4; ++j) { const f32x4 gv = ((const f32x4*)g)[lane + 64 * j]; v2u o; o.x = pk2(v[j].x * rs * gv.x, v[j].y * rs * gv.y); o.y = pk2(v[j].z * rs * gv.z, v[j].w * rs * gv.w);
        ((v2u*)orow)[lane + 64 * j] = o; }
}
__device__ __forceinline__ void row_update(const bf16* frow, const float* base, float* outrow, bf16* hnrow, const float* gpost, const float* gnext, float scale, int lane) {
    f32x4 f[4], h[4]; float ss = 0.f;
#pragma unroll
    for (int j = 0; j < 4; ++j) { const v2u w = ((const v2u*)frow)[lane + 64 * j]; f[j] = (f32x4){bflo(w.x), bfhi(w.x), bflo(w.y), bfhi(w.y)};
        ss += (f[j].x * f[j].x + f[j].y * f[j].y) + (f[j].z * f[j].z + f[j].w * f[j].w); }
    const float rs = rsqrtf(wave_sum(ss) * (1.f / D) + RMS_EPS) * scale; float s2 = 0.f;
#pragma unroll
    for (int j = 0; j < 4; ++j) { const f32x4 gv = ((const f32x4*)gpost)[lane + 64 * j]; const f32x4 bv = ((const f32x4*)base)[lane + 64 * j];
        h[j] = bv + f[j] * rs * gv; s2 += (h[j].x * h[j].x + h[j].y * h[j].y) + (h[j].z * h[j].z + h[j].w * h[j].w); }
    if (outrow) {
#pragma unroll
        for (int j = 0; j < 4; ++j) ((f32x4*)outrow)[lane + 64 * j] = h[j]; }
    if (hnrow) { const float r2 = rsqrtf(wave_sum(s2) * (1.f / D) + RMS_EPS);
#pragma unroll
        for (int j = 0; j < 4; ++j) { const f32x4 gv = ((const f32x4*)gnext)[lane + 64 * j]; v2u o; o.x = pk2(h[j].x * r2 * gv.x, h[j].y * r2 * gv.y); o.y = pk2(h[j].z * r2 * gv.z, h[j].w * r2 * gv.w);
            ((v2u*)hnrow)[lane + 64 * j] = o; } }
}
__device__ __forceinline__ f32x4 meta_tile(const bf16* A, const bf16* B, int K, int lane) {
    const int fr = lane & 15, kq = lane >> 4; const bf16* ap = A + (size_t)fr * K + 8 * kq; const bf16* bp = B + (size_t)fr * K + 8 * kq;
    f32x4 acc = (f32x4){0.f, 0.f, 0.f, 0.f};
#pragma unroll 4
    for (int k = 0; k < K; k += 32) { const bf16x8 a = *(const bf16x8*)(ap + k); const bf16x8 b = *(const bf16x8*)(bp + k); acc = mfma16(a, b, acc); }
    return acc;
}

struct Args { const float* in[28]; float* out; unsigned char* ws; int ph_lo, ph_hi; };

__device__ __forceinline__ void s5_table_item(const Args& a, int item, LAS float* sc, int tid) {
    const float* lam_re = a.in[15]; const float* lam_im = a.in[16]; const float* log_dt = a.in[17];
    const float* b_re = a.in[18]; const float* b_im = a.in[19]; const float* c_re = a.in[20]; const float* c_im = a.in[21]; const float* dsk = a.in[22];
    const int type = item / 2048, g = (item % 2048) / 64, idx = item % 64;
    LAS float* ap_re = sc; LAS float* ap_im = sc + 64; LAS float* w_re = sc + 128; LAS float* w_im = sc + 192;
    __syncthreads();
    if (tid < 64) { const int p = tid; const float lr = lam_re[g * 64 + p], li = lam_im[g * 64 + p], dt = expf(log_dt[g]);
        const float ang = li * dt, mag = expf(lr * dt); float s1, c1; sincosf(ang, &s1, &c1);
        const float a_re = mag * c1, a_im = mag * s1, den = lr * lr + li * li, nr = a_re - 1.0f, ni = a_im;
        const float cf_re = (nr * lr + ni * li) / den, cf_im = (ni * lr - nr * li) / den;
        const int n = (type == 0) ? idx : (type == 1 ? 63 - idx : idx + 1);
        float sn, cn; sincosf((float)n * ang, &sn, &cn); const float mn = expf((float)n * lr * dt);
        const float pr = mn * cn, pi = mn * sn;
        ap_re[p] = pr; ap_im[p] = pi; w_re[p] = pr * cf_re - pi * cf_im; w_im[p] = pr * cf_im + pi * cf_re; }
    __syncthreads();
    if (type == 0) {
        if (tid < 256) { const int m = tid >> 4, mp = tid & 15; float s = 0.f;
            for (int p = 0; p < 64; ++p) { const float br = b_re[(g * 64 + p) * 16 + mp], bi = b_im[(g * 64 + p) * 16 + mp];
                const float zr = w_re[p] * br - w_im[p] * bi, zi = w_re[p] * bi + w_im[p] * br;
                s += c_re[(g * 16 + m) * 64 + p] * zr - c_im[(g * 16 + m) * 64 + p] * zi; }
            if (idx == 0 && m == mp) s += dsk[g * 16 + m];
            ((bf16*)(a.ws + WS_KI))[((g * 64 + idx) * 16 + m) * 16 + mp] = (bf16)f2bf(s); }
    } else if (type == 1) {
#pragma unroll
        for (int k = 0; k < 4; ++k) { const int e = tid + 512 * k, n = e >> 4, mp = e & 15, p = n & 63;
            const float br = b_re[(g * 64 + p) * 16 + mp], bi = b_im[(g * 64 + p) * 16 + mp];
            const float zr = w_re[p] * br - w_im[p] * bi, zi = w_re[p] * bi + w_im[p] * br;
            ((bf16*)(a.ws + WS_KS))[((size_t)(g * 64 + idx) * 128 + n) * 16 + mp] = (bf16)f2bf(n < 64 ? zr : zi); }
    } else {
#pragma unroll
        for (int k = 0; k < 4; ++k) { const int e = tid + 512 * k, m = e >> 7, kk = e & 127, p = kk & 63;
            const float cr = c_re[(g * 16 + m) * 64 + p], ci = c_im[(g * 16 + m) * 64 + p];
            const float wr_ = cr * ap_re[p] - ci * ap_im[p], wi_ = cr * ap_im[p] + ci * ap_re[p];
            ((bf16*)(a.ws + WS_KO))[((size_t)(g * 64 + idx) * 16 + m) * 128 + kk] = (bf16)f2bf(kk < 64 ? wr_ : -wi_); }
    }
}

constexpr int S5_U = 0, S5_USTR = 2064, S5_KI = 66048, S5_SLOC = 98816, S5_XINB = 115200, S5_XSTR = 272, S5_MISC = 123904;
__device__ __forceinline__ float gelu_tanh(float x) { const float z = 0.7978845608028654f * (x + 0.044715f * x * x * x); return x * fsig(2.0f * z); }
__device__ __forceinline__ void s5_unit(const Args& a, LAS unsigned char* L, int b, int g, int tid) {
    const int lane = tid & 63, w = __builtin_amdgcn_readfirstlane(tid >> 6), fr = lane & 15, kq = lane >> 4;
    const bf16* PA = (const bf16*)(a.ws + WS_PA); const bf16* PMU = (const bf16*)(a.ws + WS_META + MO_PMU);
    const bf16* KS = (const bf16*)(a.ws + WS_KS); const bf16* KO = (const bf16*)(a.ws + WS_KO); const bf16* KI = (const bf16*)(a.ws + WS_KI);
    bf16* YA = (bf16*)(a.ws + WS_F);
    LAS float* SLOC = (LAS float*)(L + S5_SLOC); LAS float* MS = (LAS float*)(L + S5_MISC);
    __syncthreads();
#pragma unroll
    for (int k = 0; k < 8; ++k) { const int idx = tid + 512 * k, t = idx >> 1, hf = idx & 1;
        const v4u v = *(const v4u*)(PA + (size_t)(b * 2048 + t) * 1536 + 16 * g + 8 * hf);
        *(LAS v4u*)(L + S5_U + (t >> 6) * S5_USTR + (t & 63) * 32 + 16 * hf) = v; }
#pragma unroll
    for (int k = 0; k < 4; ++k) { const int idx = tid + 512 * k; *(LAS v4u*)(L + S5_KI + idx * 16) = *(const v4u*)(KI + (size_t)g * 16384 + idx * 8); }
    if (w == 0) { const int p = lane; const float lr = a.in[15][g * 64 + p], li = a.in[16][g * 64 + p], dt = expf(a.in[17][g]);
        const float ang = li * dt, mag = expf(lr * dt); float s1, c1; sincosf(ang, &s1, &c1);
        const float a_re = mag * c1, a_im = mag * s1, den = lr * lr + li * li, nr = a_re - 1.0f, ni = a_im;
        const float cf_re = (nr * lr + ni * li) / den, cf_im = (ni * lr - nr * li) / den;
        float bb_re[16], bb_im[16];
#pragma unroll
        for (int m = 0; m < 16; ++m) { const float br = a.in[18][(g * 64 + p) * 16 + m], bi = a.in[19][(g * 64 + p) * 16 + m]; bb_re[m] = cf_re * br - cf_im * bi; bb_im[m] = cf_re * bi + cf_im * br; }
        float xr = 0.f, xi = 0.f;
        for (int i = 0; i < 16; ++i) { float ur = 0.f, ui = 0.f;
#pragma unroll
            for (int m = 0; m < 16; ++m) { const float u = bf2f(PMU[i * 512 + 16 * g + m]); ur += bb_re[m] * u; ui += bb_im[m] * u; }
            const float nr2 = a_re * xr - a_im * xi + ur, ni2 = a_re * xi + a_im * xr + ui; xr = nr2; xi = ni2; }
        float s64, c64; sincosf(64.0f * ang, &s64, &c64); const float m64 = expf(64.0f * lr * dt);
        MS[p] = xr; MS[64 + p] = xi; MS[128 + p] = m64 * c64; MS[192 + p] = m64 * s64; }
    __syncthreads();
    { f32x4 acc0 = (f32x4){0.f, 0.f, 0.f, 0.f}, acc1 = acc0;
#pragma unroll 4
      for (int ks = 0; ks < 32; ++ks) { const int i = 2 * ks + (kq >> 1);
          const bf16x8 bfr = *(const bf16x8*)(KS + ((size_t)(g * 64 + i) * 128 + 16 * w + fr) * 16 + 8 * (kq & 1));
          const bf16x8 a0 = *(const LAS bf16x8*)(L + S5_U + fr * S5_USTR + (32 * ks + 8 * kq) * 2);
          const bf16x8 a1 = *(const LAS bf16x8*)(L + S5_U + (16 + fr) * S5_USTR + (32 * ks + 8 * kq) * 2);
          acc0 = mfma16(a0, bfr, acc0); acc1 = mfma16(a1, bfr, acc1); }
#pragma unroll
      for (int r = 0; r < 4; ++r) { SLOC[(4 * kq + r) * 128 + 16 * w + fr] = acc0[r]; SLOC[(16 + 4 * kq + r) * 128 + 16 * w + fr] = acc1[r]; } }
    __syncthreads();
    if (w == 0) { const int p = lane; float xr = MS[p], xi = MS[64 + p]; const float ar = MS[128 + p], ai = MS[192 + p];
        for (int c = 0; c < 32; ++c) { *(LAS bf16*)(L + S5_XINB + c * S5_XSTR + p * 2) = (bf16)f2bf(xr); *(LAS bf16*)(L + S5_XINB + c * S5_XSTR + (64 + p) * 2) = (bf16)f2bf(xi);
            const float sr = SLOC[c * 128 + p], si = SLOC[c * 128 + 64 + p]; const float nr2 = ar * xr - ai * xi + sr, ni2 = ar * xi + ai * xr + si; xr = nr2; xi = ni2; } }
    __syncthreads();
    for (int jj = 0; jj < 8; ++jj) { const int j = w + 8 * jj;
        f32x4 acc0 = (f32x4){0.f, 0.f, 0.f, 0.f}, acc1 = acc0;
#pragma unroll
        for (int ks = 0; ks < 4; ++ks) { const bf16x8 bfr = *(const bf16x8*)(KO + ((size_t)(g * 64 + j) * 16 + fr) * 128 + 32 * ks + 8 * kq);
            const bf16x8 a0 = *(const LAS bf16x8*)(L + S5_XINB + fr * S5_XSTR + (32 * ks + 8 * kq) * 2);
            const bf16x8 a1 = *(const LAS bf16x8*)(L + S5_XINB + (16 + fr) * S5_XSTR + (32 * ks + 8 * kq) * 2);
            acc0 = mfma16(a0, bfr, acc0); acc1 = mfma16(a1, bfr, acc1); }
        const int nks = (j >> 1) + 1;
        for (int ks = 0; ks < nks; ++ks) { const int i = 2 * ks + (kq >> 1), tau = j - i;
            bf16x8 bfr = (bf16x8){0, 0, 0, 0, 0, 0, 0, 0};
            if (tau >= 0) bfr = *(const LAS bf16x8*)(L + S5_KI + ((tau * 16 + fr) * 16 + 8 * (kq & 1)) * 2);
            const bf16x8 a0 = *(const LAS bf16x8*)(L + S5_U + fr * S5_USTR + (32 * ks + 8 * kq) * 2);
            const bf16x8 a1 = *(const LAS bf16x8*)(L + S5_U + (16 + fr) * S5_USTR + (32 * ks + 8 * kq) * 2);
            acc0 = mfma16(a0, bfr, acc0); acc1 = mfma16(a1, bfr, acc1); }
#pragma unroll
        for (int r = 0; r < 4; ++r) { const int c0 = 4 * kq + r, c1 = 16 + 4 * kq + r;
            YA[(size_t)(b * 2048 + 64 * c0 + j) * 512 + 16 * g + fr] = (bf16)f2bf(gelu_tanh(acc0[r]));
            YA[(size_t)(b * 2048 + 64 * c1 + j) * 512 + 16 * g + fr] = (bf16)f2bf(gelu_tanh(acc1[r])); } }
}

constexpr int DS_S = 0, DS_SSTR = 2128, DS_KL = 0, DS_VT = 9216, DS_PL = 18432, DS_TSTR = 144, DS_HIST = 136192, DS_MASK = 144384, DS_RB = 148736, DS_TB = 149760;
__device__ __forceinline__ unsigned okey(float f) { const unsigned u = __float_as_uint(f); return (u & 0x80000000u) ? ~u : (u | 0x80000000u); }
__device__ __forceinline__ void dsa_tables(const Args& a, LAS unsigned char* L, int tid) {
    if (tid < 256) { ((LAS float*)(L + DS_RB))[tid] = a.in[25][tid];
        const int n = tid; const int lo = n < 8 ? n : (n < 12 ? 8 : n < 16 ? 9 : n < 23 ? 10 : n < 32 ? 11 : n < 46 ? 12 : n < 64 ? 13 : n < 91 ? 14 : 15);
        ((LAS int*)(L + DS_TB))[tid] = lo; }
}
__device__ __forceinline__ void dsa_unit(const Args& a, LAS unsigned char* L, int b, int jq, int tid) {
    const int lane = tid & 63, w = __builtin_amdgcn_readfirstlane(tid >> 6), fr = lane & 15, kq = lane >> 4;
    const bf16* PA = (const bf16*)(a.ws + WS_PA); const bf16* PK = (const bf16*)(a.ws + WS_PK); const bf16* PMK = (const bf16*)(a.ws + WS_META + MO_PMK);
    bf16* YB = (bf16*)(a.ws + WS_HN) + (size_t)R * 512;
    const int c = 1 + (jq >> 2), nt64 = c + 1, qrow0 = b * 2048 + 16 * jq;
    LAS float* S = (LAS float*)(L + DS_S); LAS unsigned long long* MASK = (LAS unsigned long long*)(L + DS_MASK);
    const LAS float* RB = (const LAS float*)(L + DS_RB); const LAS int* TB = (const LAS int*)(L + DS_TB);
    __syncthreads();
    { bf16x8 qa[8][2]; float wv[8][4];
#pragma unroll
      for (int mt = 0; mt < 8; ++mt) { const int q = 2 * mt + (fr >> 3), h = fr & 7;
#pragma unroll
          for (int ks = 0; ks < 2; ++ks) qa[mt][ks] = *(const bf16x8*)(PA + (size_t)(qrow0 + q) * 1536 + 512 + h * 64 + 32 * ks + 8 * kq);
          const v2u wraw = *(const v2u*)(PK + (size_t)(qrow0 + 2 * mt + (kq >> 1)) * 256 + 192 + 4 * (kq & 1));
          wv[mt][0] = bflo(wraw.x) * 0.04419417382f; wv[mt][1] = bfhi(wraw.x) * 0.04419417382f; wv[mt][2] = bflo(wraw.y) * 0.04419417382f; wv[mt][3] = bfhi(wraw.y) * 0.04419417382f; }
      for (int kt = w; kt < 4 * nt64; kt += 8) { const int s0 = 16 * kt;
          if (kt >= 1 && kt <= 3) {
#pragma unroll
              for (int mt = 0; mt < 8; ++mt) if (!(kq & 1)) S[(2 * mt + (kq >> 1)) * DS_SSTR + s0 + fr] = -3.0e38f;
              continue; }
          const bf16* krow = (kt == 0) ? PMK + fr * 256 : PK + (size_t)(b * 2048 + s0 - 64 + fr) * 256;
          const bf16x8 kb0 = *(const bf16x8*)(krow + 8 * kq), kb1 = *(const bf16x8*)(krow + 32 + 8 * kq);
#pragma unroll
          for (int mt = 0; mt < 8; ++mt) { f32x4 acc = (f32x4){0.f, 0.f, 0.f, 0.f}; acc = mfma16(qa[mt][0], kb0, acc); acc = mfma16(qa[mt][1], kb1, acc);
              float v = fmaxf(acc[0], 0.f) * wv[mt][0] + fmaxf(acc[1], 0.f) * wv[mt][1] + fmaxf(acc[2], 0.f) * wv[mt][2] + fmaxf(acc[3], 0.f) * wv[mt][3];
              v += __shfl_xor(v, 16);
              if (!(kq & 1)) S[(2 * mt + (kq >> 1)) * DS_SSTR + s0 + fr] = v; } } }
    __syncthreads();
    { LAS unsigned* H = (LAS unsigned*)(L + DS_HIST) + w * 256;
      for (int qq = 0; qq < 2; ++qq) { const int q = 2 * w + qq; const LAS float* Sq = S + q * DS_SSTR; unsigned tkey = 0u;
          if (c >= 4) { unsigned prefix = 0u; int kth = 256;
              for (int pass = 0; pass < 4; ++pass) { const int shift = 24 - 8 * pass;
                  H[lane] = 0u; H[lane + 64] = 0u; H[lane + 128] = 0u; H[lane + 192] = 0u; LDS_WAIT();
                  for (int e = 0; e < nt64; ++e) { const unsigned key = okey(Sq[64 * e + lane]); const bool in = (pass == 0) || ((key >> (shift + 8)) == prefix);
                      if (in) (void)__hip_atomic_fetch_add(&H[(key >> shift) & 255u], 1u, __ATOMIC_RELAXED, __HIP_MEMORY_SCOPE_WORKGROUP); }
                  LDS_WAIT();
                  const unsigned h0 = H[4 * lane], h1 = H[4 * lane + 1], h2 = H[4 * lane + 2], h3 = H[4 * lane + 3]; const int t = (int)(h0 + h1 + h2 + h3);
                  int sfx = t;
#pragma unroll
                  for (int off = 1; off < 64; off <<= 1) { const int v = __shfl_down(sfx, off); if (lane + off < 64) sfx += v; }
                  const int above = sfx - t; const bool has = (above < kth) && (above + t >= kth);
                  const unsigned long long bm = __ballot(has); const int src = bm ? (__ffsll((long long)bm) - 1) : 0;
                  int cum = above, B; if (cum + (int)h3 >= kth) B = 3; else { cum += (int)h3; if (cum + (int)h2 >= kth) B = 2; else { cum += (int)h2; if (cum + (int)h1 >= kth) B = 1; else { cum += (int)h1; B = 0; } } }
                  const int bin = __shfl(4 * lane + B, src); kth = __shfl(kth - cum, src);
                  prefix = (prefix << 8) | (unsigned)bin; LDS_WAIT(); }
              tkey = prefix; }
          for (int e = 0; e < nt64; ++e) { const int s = 64 * e + lane; const unsigned key = okey(Sq[s]); const bool sel = ((s < 16) || (s >= 64)) && (key >= tkey);
              const unsigned long long m = __ballot(sel); if (lane == 0) MASK[q * 34 + e] = m; } } }
    __syncthreads();
    { bf16x8 qa2[2]; { const int q = 2 * w + (fr >> 3), h = fr & 7;
#pragma unroll
        for (int ks = 0; ks < 2; ++ks) qa2[ks] = *(const bf16x8*)(PA + (size_t)(qrow0 + q) * 1536 + 1024 + h * 64 + 32 * ks + 8 * kq); }
      const int qc = 2 * w + (kq >> 1), hb = 4 * (kq & 1), qpos = 16 + 16 * jq + qc;
      float mrun[4], lrun[4]; f32x4 O[4];
#pragma unroll
      for (int r = 0; r < 4; ++r) { mrun[r] = -1.0e30f; lrun[r] = 0.f; O[r] = (f32x4){0.f, 0.f, 0.f, 0.f}; }
      LAS unsigned char* PLw = L + DS_PL + w * 16 * DS_TSTR;
      for (int T = 0; T < nt64; ++T) {
          { const int key = tid >> 3, piece = tid & 7, s = 64 * T + key; const bool valid = (s < 16) || (s >= 64);
            const bf16* krow = (s < 16) ? PMK + s * 256 : PK + (size_t)(b * 2048 + s - 64) * 256;
            v4u kv = (v4u){0u, 0u, 0u, 0u}, vv = kv; if (valid) { kv = *(const v4u*)(krow + 64 + 8 * piece); vv = *(const v4u*)(krow + 128 + 8 * piece); }
            *(LAS v4u*)(L + DS_KL + key * DS_TSTR + 16 * piece) = kv;
            LAS unsigned char* vt = L + DS_VT + (8 * piece) * DS_TSTR + 2 * key;
            *(LAS bf16*)(vt + 0 * DS_TSTR) = (bf16)(vv.x & 0xffffu); *(LAS bf16*)(vt + 1 * DS_TSTR) = (bf16)(vv.x >> 16);
            *(LAS bf16*)(vt + 2 * DS_TSTR) = (bf16)(vv.y & 0xffffu); *(LAS bf16*)(vt + 3 * DS_TSTR) = (bf16)(vv.y >> 16);
            *(LAS bf16*)(vt + 4 * DS_TSTR) = (bf16)(vv.z & 0xffffu); *(LAS bf16*)(vt + 5 * DS_TSTR) = (bf16)(vv.z >> 16);
            *(LAS bf16*)(vt + 6 * DS_TSTR) = (bf16)(vv.w & 0xffffu); *(LAS bf16*)(vt + 7 * DS_TSTR) = (bf16)(vv.w >> 16); }
          __syncthreads();
          const unsigned long long mword = MASK[qc * 34 + T];
          f32x4 lg[4]; float mx[4] = {-1.0e30f, -1.0e30f, -1.0e30f, -1.0e30f};
#pragma unroll
          for (int sub = 0; sub < 4; ++sub) { const bf16x8 kb0 = *(const LAS bf16x8*)(L + DS_KL + (16 * sub + fr) * DS_TSTR + 16 * kq), kb1 = *(const LAS bf16x8*)(L + DS_KL + (16 * sub + fr) * DS_TSTR + 64 + 16 * kq);
              f32x4 acc = (f32x4){0.f, 0.f, 0.f, 0.f}; acc = mfma16(qa2[0], kb0, acc); acc = mfma16(qa2[1], kb1, acc);
              const int s = 64 * T + 16 * sub + fr, pos_s = (s < 16) ? s : s - 48, rel = pos_s - qpos; int n = rel < 0 ? -rel : rel; n = n > 255 ? 255 : n;
              const int bk = TB[n] + (rel > 0 ? 16 : 0);
#pragma unroll
              for (int r = 0; r < 4; ++r) { lg[sub][r] = acc[r] * 0.125f + RB[bk * 8 + hb + r]; mx[r] = fmaxf(mx[r], lg[sub][r]); } }
#pragma unroll
          for (int r = 0; r < 4; ++r) { float v = mx[r]; v = fmaxf(v, __shfl_xor(v, 1)); v = fmaxf(v, __shfl_xor(v, 2)); v = fmaxf(v, __shfl_xor(v, 4)); v = fmaxf(v, __shfl_xor(v, 8));
              const float mn = fmaxf(mrun[r], v), sc = __expf(mrun[r] - mn); mrun[r] = mn; lrun[r] *= sc;
#pragma unroll
              for (int dt = 0; dt < 4; ++dt) O[dt][r] *= sc; }
#pragma unroll
          for (int sub = 0; sub < 4; ++sub) { const bool bit = (mword >> (16 * sub + fr)) & 1ull;
#pragma unroll
              for (int r = 0; r < 4; ++r) { const float p = bit ? __expf(lg[sub][r] - mrun[r]) : 0.f; lrun[r] += p;
                  *(LAS bf16*)(PLw + (4 * kq + r) * DS_TSTR + (16 * sub + fr) * 2) = (bf16)f2bf(p); } }
          LDS_WAIT();
#pragma unroll
          for (int ks2 = 0; ks2 < 2; ++ks2) { const bf16x8 pa = *(const LAS bf16x8*)(PLw + fr * DS_TSTR + (32 * ks2 + 8 * kq) * 2);
#pragma unroll
              for (int dt = 0; dt < 4; ++dt) { const bf16x8 vb = *(const LAS bf16x8*)(L + DS_VT + (16 * dt + fr) * DS_TSTR + (32 * ks2 + 8 * kq) * 2); O[dt] = mfma16(pa, vb, O[dt]); } }
          __syncthreads();
      }
#pragma unroll
      for (int r = 0; r < 4; ++r) { float v = lrun[r]; v += __shfl_xor(v, 1); v += __shfl_xor(v, 2); v += __shfl_xor(v, 4); v += __shfl_xor(v, 8); const float inv = 1.0f / v;
#pragma unroll
          for (int dt = 0; dt < 4; ++dt) YB[(size_t)(qrow0 + qc) * 512 + (hb + r) * 64 + 16 * dt + fr] = (bf16)f2bf(O[dt][r] * inv); } }
}

__global__ void __launch_bounds__(NWAVES * 64, 2) mk_fwd(Args args) {
    extern __shared__ __attribute__((aligned(16))) unsigned char lds[];
    LAS unsigned char* L = (LAS unsigned char*)lds;
    volatile LAS unsigned* MISC = (volatile LAS unsigned*)(L + MISC_OFF);
    const int tid = threadIdx.x, lane = tid & 63, wave = __builtin_amdgcn_readfirstlane(tid >> 6);
    const int G = gridDim.x, bx = blockIdx.x;
    const int gw = bx * NWAVES + wave, NGW = G * NWAVES;
    unsigned char* ws = args.ws;
    if (tid < 32) MISC[tid] = 0u;
    __syncthreads();
    XcdBarrier bar; bar.bar = (unsigned*)(ws + WS_CTL) + CW_BAR; bar.x = 0; bar.st = nullptr;
    if (!MK_PER_PHASE) bar = xcd_barrier_post((unsigned*)(ws + WS_CTL) + CW_BAR, MISC + 8);
    const int lo = args.ph_lo, hi = args.ph_hi;
#define IN(k) (lo <= (k) && (k) < hi)
#define SEAM(k) do { if (IN(k) && IN((k) + 1)) xcd_barrier(bar); } while (0)
    bf16* WT1 = (bf16*)(ws + WS_WT1); bf16* WT2 = (bf16*)(ws + WS_WT2); bf16* WT3 = (bf16*)(ws + WS_WT3); bf16* WT4 = (bf16*)(ws + WS_WT4); bf16* WT5 = (bf16*)(ws + WS_WT5);
    bf16* WGLU = (bf16*)(ws + WS_WGLU); bf16* WA = (bf16*)(ws + WS_WA); bf16* WB = (bf16*)(ws + WS_WB); bf16* WOUT = (bf16*)(ws + WS_WOUT);
    bf16* HN = (bf16*)(ws + WS_HN); bf16* FB = (bf16*)(ws + WS_F); bf16* ACT = (bf16*)(ws + WS_BIG);
    bf16* PA = (bf16*)(ws + WS_PA); bf16* PG = (bf16*)(ws + WS_PG); bf16* PK = (bf16*)(ws + WS_PK);
    bf16* AM1 = (bf16*)(ws + WS_META + MO_AM1); bf16* ACTM = (bf16*)(ws + WS_META + MO_ACTM); bf16* FM = (bf16*)(ws + WS_META + MO_FM); bf16* AM2 = (bf16*)(ws + WS_META + MO_AM2);
    bf16* PMU = (bf16*)(ws + WS_META + MO_PMU); bf16* PMK = (bf16*)(ws + WS_META + MO_PMK);
    bf16* YA = FB; bf16* YG = HN; bf16* YB = HN + (size_t)R * 512; bf16* MERGED = PA;
    const float* x = args.in[0]; float* out = args.out;

    if (IN(0)) {
        for (int item = bx; item < 3 * 2048; item += G) s5_table_item(args, item, (LAS float*)(L + 140000), tid);
        __syncthreads();
        LAS float* scr = (LAS float*)(L + wave * 16384);
        for (int it = gw; it < 11520; it += NGW) {
            int r = it;
            if (r < 6 * 1408) { const int mat = r / 1408; r -= mat * 1408;
                if (mat == 2 || mat == 5) { const int kb = r / 32, nb = r % 32; transpose_item(args.in[mat == 2 ? 10 : 13], D, DFF, mat == 2 ? WT2 : WT5, 64 * kb, 32 * nb, 32 * nb + (lane & 31), scr, lane); }
                else { const int kb = r / 88, nb = r % 88, d0 = 32 * nb, up = (mat == 1 || mat == 4) ? 128 : 0;
                    transpose_item(args.in[mat == 0 ? 8 : mat == 1 ? 9 : mat == 3 ? 11 : 12], DFF, D, mat < 3 ? WT1 : WT4, 64 * kb, 256 * (d0 >> 7) + (d0 & 127) + up, d0 + (lane & 31), scr, lane); }
                continue; }
            r -= 6 * 1408;
            if (r < 1920) { const int kb = r / 120, nb = r % 120; transpose_item(args.in[14], 3784, D, WT3, 64 * kb, 32 * nb, win_srccol(32 * nb + (lane & 31)), scr, lane); continue; }
            r -= 1920;
            if (r < 128) { const int kb = r / 16, nb = r % 16; transpose_item(args.in[23], 512, 512, WGLU, 64 * kb, 32 * nb, 32 * nb + (lane & 31), scr, lane); continue; }
            r -= 128;
            if (r < 256) { const int kb = r / 32, nb = r % 32; transpose_item(args.in[24], D, 512, WA, 64 * kb, 32 * nb, 32 * nb + (lane & 31), scr, lane); continue; }
            r -= 256;
            if (r < 256) { const int kb = r / 32, nb = r % 32; transpose_item(args.in[26], D, 512, WB, 64 * kb, 32 * nb, 32 * nb + (lane & 31), scr, lane); continue; }
            r -= 256;
            { const int kb = r / 32, nb = r % 32; transpose_item(args.in[27], D, D, WOUT, 64 * kb, 32 * nb, 32 * nb + (lane & 31), scr, lane); }
        }
        for (int m = gw; m < R; m += NGW) norm_row_to_bf16(x + (size_t)m * D, args.in[2], HN + (size_t)m * D, lane);
        if (gw < NMETA) norm_row_to_bf16(args.in[1] + (size_t)gw * D, args.in[2], AM1 + (size_t)gw * D, lane);
    }
    SEAM(0);
    if (IN(1)) {
        if (gw < 176) { const int j0 = 16 * gw, grow = 256 * (j0 >> 7) + (j0 & 127); const f32x4 g4 = meta_tile(AM1, WT1 + (size_t)grow * D, D, lane), u4 = meta_tile(AM1, WT1 + (size_t)(grow + 128) * D, D, lane);
#pragma unroll
            for (int r = 0; r < 4; ++r) ACTM[(4 * (lane >> 4) + r) * DFF + j0 + (lane & 15)] = (bf16)f2bf(g4[r] * fsig(g4[r]) * u4[r]); }
        pg8::Gemm g{HN, WT1, R, 2 * DFF, D}; pg8::StaticOrder S; S.init(R, 2 * DFF, G, bx); pg8::EpiSwiglu E{ACT, DFF};
        pg8::gemm_phase<pg8::EpiSwiglu, pg8::StaticOrder, PG8_ALIGN, PG8_SP2>(L, g, S, E);
    }
    SEAM(1);
    if (IN(2)) {
        if (gw < 64) { const int n0 = 16 * gw; const f32x4 f4 = meta_tile(ACTM, WT2 + (size_t)n0 * DFF, DFF, lane);
#pragma unroll
            for (int r = 0; r < 4; ++r) FM[(4 * (lane >> 4) + r) * D + n0 + (lane & 15)] = (bf16)f2bf(f4[r]); }
        pg8::Gemm g{ACT, WT2, R, D, DFF}; pg8::StaticOrder S; S.init(R, D, G, bx); pg8::EpiPlain E{FB, D};
        pg8::gemm_phase<pg8::EpiPlain, pg8::StaticOrder, PG8_ALIGN, PG8_SP2>(L, g, S, E);
    }
    SEAM(2);
    if (IN(3)) {
        if (gw < NMETA) row_update(FM + (size_t)gw * D, args.in[1] + (size_t)gw * D, nullptr, AM2 + (size_t)gw * D, args.in[3], args.in[4], 0.5f, lane);
        for (int m = gw; m < R; m += NGW) row_update(FB + (size_t)m * D, x + (size_t)m * D, out + (size_t)m * D, HN + (size_t)m * D, args.in[3], args.in[4], 0.5f, lane);
    }
    SEAM(3);
    if (IN(4)) {
        if (gw < 44) { const int n0 = gw < 32 ? 16 * gw : 3584 + 16 * (gw - 32); const f32x4 p4 = meta_tile(AM2, WT3 + (size_t)n0 * D, D, lane);
#pragma unroll
            for (int r = 0; r < 4; ++r) { const int row = 4 * (lane >> 4) + r; if (gw < 32) PMU[row * 512 + n0 + (lane & 15)] = (bf16)f2bf(p4[r]); else PMK[row * 256 + (n0 - 3584) + (lane & 15)] = (bf16)f2bf(p4[r]); } }
        pg8::Gemm g{HN, WT3, R, 3840, D}; pg8::StaticOrder S; S.init(R, 3840, G, bx); pg8::EpiProj E{PA, PG, PK};
        pg8::gemm_phase<pg8::EpiProj, pg8::StaticOrder, PG8_ALIGN, PG8_SP2>(L, g, S, E);
    }
    SEAM(4);
    if (IN(5)) {
        for (int u = bx; u < NB * NG; u += G) s5_unit(args, L, u >> 5, u & 31, tid);
        __syncthreads();
        dsa_tables(args, L, tid);
        for (int i = 0; i < 8; ++i) { const int u = bx * 8 + i; if (u >= 2048) break; const int u2 = u >> 1, b = u2 >> 6, xq = u2 & 63; dsa_unit(args, L, b, (u & 1) ? 127 - xq : xq, tid); }
        __syncthreads();
    }
    SEAM(5);
    if (IN(6)) { pg8::Gemm g{YA, WGLU, R, 512, 512}; pg8::StaticOrder S; S.init(R, 512, G, bx); pg8::EpiGlu E{YA, YG};
        pg8::gemm_phase<pg8::EpiGlu, pg8::StaticOrder, PG8_ALIGN, PG8_SP2>(L, g, S, E); }
    SEAM(6);
    if (IN(7)) { pg8::Gemm g{YG, WA, R, D, 512}; pg8::StaticOrder S; S.init(R, D, G, bx); pg8::EpiMerge<false> E{PG, 0, nullptr, FB};
        pg8::gemm_phase<pg8::EpiMerge<false>, pg8::StaticOrder, PG8_ALIGN, PG8_SP2>(L, g, S, E); }
    SEAM(7);
    if (IN(8)) { pg8::Gemm g{YB, WB, R, D, 512}; pg8::StaticOrder S; S.init(R, D, G, bx); pg8::EpiMerge<true> E{PG, 1024, FB, MERGED};
        pg8::gemm_phase<pg8::EpiMerge<true>, pg8::StaticOrder, PG8_ALIGN, PG8_SP2>(L, g, S, E); }
    SEAM(8);
    if (IN(9)) { pg8::Gemm g{MERGED, WOUT, R, D, D}; pg8::StaticOrder S; S.init(R, D, G, bx); pg8::EpiPlain E{FB, D};
        pg8::gemm_phase<pg8::EpiPlain, pg8::StaticOrder, PG8_ALIGN, PG8_SP2>(L, g, S, E); }
    SEAM(9);
    if (IN(10)) { for (int m = gw; m < R; m += NGW) row_update(FB + (size_t)m * D, out + (size_t)m * D, out + (size_t)m * D, HN + (size_t)m * D, args.in[5], args.in[6], 1.0f, lane); }
    SEAM(10);
    if (IN(11)) { pg8::Gemm g{HN, WT4, R, 2 * DFF, D}; pg8::StaticOrder S; S.init(R, 2 * DFF, G, bx); pg8::EpiSwiglu E{ACT, DFF};
        pg8::gemm_phase<pg8::EpiSwiglu, pg8::StaticOrder, PG8_ALIGN, PG8_SP2>(L, g, S, E); }
    SEAM(11);
    if (IN(12)) { pg8::Gemm g{ACT, WT5, R, D, DFF}; pg8::StaticOrder S; S.init(R, D, G, bx); pg8::EpiPlain E{FB, D};
        pg8::gemm_phase<pg8::EpiPlain, pg8::StaticOrder, PG8_ALIGN, PG8_SP2>(L, g, S, E); }
    SEAM(12);
    if (IN(13)) { for (int m = gw; m < R; m += NGW) row_update(FB + (size_t)m * D, out + (size_t)m * D, out + (size_t)m * D, nullptr, args.in[7], args.in[7], 0.5f, lane); }
#undef IN
#undef SEAM
}

extern "C" void kernel_launch(void* const* d_in, const int* in_sizes, int n_in, void* d_out, int out_size, void* d_ws, size_t ws_size, hipStream_t stream) {
    static int grid = 0;
    if (grid == 0) {
        if (n_in != 28 || out_size != R * D || ws_size < WS_END) { fprintf(stderr, "kernel_launch: unexpected shapes (n_in %d, out %d, ws %zu); nothing launched\n", n_in, out_size, ws_size); grid = -1; return; }
        int dev = 0, cus = 0, per_cu = 0;
        if (hipGetDevice(&dev) != hipSuccess || hipDeviceGetAttribute(&cus, hipDeviceAttributeMultiprocessorCount, dev) != hipSuccess) { grid = -1; return; }
        if (hipFuncSetAttribute((const void*)mk_fwd, hipFuncAttributeMaxDynamicSharedMemorySize, LDS_BYTES) != hipSuccess) { fprintf(stderr, "kernel_launch: hipFuncSetAttribute failed\n"); grid = -1; return; }
        if (hipOccupancyMaxActiveBlocksPerMultiprocessor(&per_cu, (const void*)mk_fwd, NWAVES * 64, LDS_BYTES) != hipSuccess || per_cu < 1) fprintf(stderr, "kernel_launch: note: occupancy query reports %d\n", per_cu);
        (void)hipGetLastError();
        grid = cus;
    }
    if (grid < 0) return;
    if (hipMemsetAsync((char*)d_ws + WS_CTL, 0, CTL_ZERO_BYTES, stream) != hipSuccess) return;
    Args a{};
    for (int i = 0; i < 28; ++i) a.in[i] = (const float*)d_in[i];
    a.out = (float*)d_out; a.ws = (unsigned char*)d_ws;
#if MK_PER_PHASE
    for (int ph = 0; ph < NPH; ++ph) { a.ph_lo = ph; a.ph_hi = ph + 1; hipLaunchKernelGGL(mk_fwd, dim3(grid), dim3(NWAVES * 64), LDS_BYTES, stream, a); }
#else
    a.ph_lo = 0; a.ph_hi = NPH;
    hipLaunchKernelGGL(mk_fwd, dim3(grid), dim3(NWAVES * 64), LDS_BYTES, stream, a);
#endif
}
```

```cpp
#include <hip/hip_runtime.h>
#include <cstdio>
#include <cstdint>
namespace pg8 {
#define PG8_LAS __attribute__((address_space(3)))
typedef unsigned short bf16_t;
typedef short bf16x8 __attribute__((ext_vector_type(8)));
typedef float f32x4 __attribute__((ext_vector_type(4)));
typedef unsigned u32x4 __attribute__((ext_vector_type(4)));
constexpr int BM = 256, BK = 64, HALF = 128, HTB = HALF * BK * 2  , STAGE_BYTES = 8 * HTB, NXCD = 8, WGM = 8;

__host__ __device__ __forceinline__ int lds_byte(int r, int c) { const int st = (r >> 4) * 2 + (c >> 5), rr = r & 15, cc = c & 31, ob = rr * 64 + cc * 2; return st * 1024 + (ob ^ (((ob >> 9) & 1) << 5)); }
__host__ __device__ __forceinline__ void stage_rc(int b, int& R, int& C) { const int st = b / 1024, sb = b % 1024, swz = sb ^ (((sb >> 9) & 1) << 5); R = (st >> 1) * 16 + swz / 64; C = (st & 1) * 32 + (swz % 64) / 2; }
__host__ __device__ __forceinline__ int perm32(int rho) { const int n = rho >> 4, i = rho & 15; return 8 * (i >> 2) + 4 * n + (i & 3); }

struct Unit { int pm, pn; };
struct Gemm { const bf16_t* A; const bf16_t* Bt; int M, N, K; };

struct StaticOrder {
    int nM, nN, nwg, G, c;
    __host__ __device__ void init(int M, int N, int G_, int c_) { nM = M / BM; nN = N / BM; nwg = nM * nN; G = G_; c = c_; }
    __host__ __device__ bool next(int i, Unit& u) const {
        const long L = (long)i * G + c; if (L >= nwg) return false;
        int wgid = (int)L; { const int q = nwg / NXCD, r = nwg % NXCD, xcd = wgid % NXCD, off = wgid / NXCD; wgid = (xcd < r ? xcd * (q + 1) : r * (q + 1) + (xcd - r) * q) + off; }
        const int nig = WGM * nN, gid = wgid / nig, fm = gid * WGM, gsz = (nM - fm) < WGM ? (nM - fm) : WGM;
        u.pm = fm + ((wgid % nig) % gsz); u.pn = (wgid % nig) / gsz; return true;
    }
    __device__ __forceinline__ void a_ready(const Unit&) const {}
    __device__ __forceinline__ void done(const Unit&) const {}
};
__device__ __forceinline__ unsigned cvt_pk_bf16(float lo, float hi) { unsigned r; asm volatile("v_cvt_pk_bf16_f32 %0, %1, %2" : "=v"(r) : "v"(lo), "v"(hi)); return r; }
__device__ __forceinline__ float fsigmoid(float x) { return __builtin_amdgcn_rcpf(1.0f + __expf(-x)); }
__device__ __forceinline__ float bf_lo(unsigned w) { return __uint_as_float(w << 16); }
__device__ __forceinline__ float bf_hi(unsigned w) { return __uint_as_float(w & 0xffff0000u); }
__device__ __forceinline__ u32x4 pack8(const f32x4 v0, const f32x4 v1) { u32x4 w; w.x = cvt_pk_bf16(v0[0], v0[1]); w.y = cvt_pk_bf16(v0[2], v0[3]); w.z = cvt_pk_bf16(v1[0], v1[1]); w.w = cvt_pk_bf16(v1[2], v1[3]); return w; }
__device__ __forceinline__ void unpack8(const u32x4 w, f32x4& v0, f32x4& v1) { v0 = (f32x4){bf_lo(w.x), bf_hi(w.x), bf_lo(w.y), bf_hi(w.y)}; v1 = (f32x4){bf_lo(w.z), bf_hi(w.z), bf_lo(w.w), bf_hi(w.w)}; }

struct EpiSwiglu {
    static constexpr bool PERM = true, AFTER_DRAIN = false;
    bf16_t* O; int ldc;
    __device__ __forceinline__ void operator()(const f32x4 (&acc)[2][2][4][2], const Unit& u, int wr, int wc, int fr, int fq) const {
        const int row0 = u.pm * BM + wr * 64 + fr, col0 = u.pn * HALF + wc * 32 + 8 * fq;
#pragma unroll
        for (int ai = 0; ai < 2; ++ai)
#pragma unroll
            for (int m = 0; m < 4; ++m) { bf16_t* rowp = O + (size_t)(row0 + ai * HALF + m * 16) * ldc + col0;
                f32x4 v0, v1;
#pragma unroll
                for (int j = 0; j < 4; ++j) { const float g0 = acc[ai][0][m][0][j], g1 = acc[ai][0][m][1][j];
                    v0[j] = g0 * fsigmoid(g0) * acc[ai][1][m][0][j]; v1[j] = g1 * fsigmoid(g1) * acc[ai][1][m][1][j]; }
                *(u32x4*)rowp = pack8(v0, v1); }
    }
};
struct EpiPlain {
    static constexpr bool PERM = true, AFTER_DRAIN = false;
    bf16_t* O; int ldc;
    __device__ __forceinline__ void operator()(const f32x4 (&acc)[2][2][4][2], const Unit& u, int wr, int wc, int fr, int fq) const {
        const int row0 = u.pm * BM + wr * 64 + fr, col0 = u.pn * BM + wc * 32 + 8 * fq;
#pragma unroll
        for (int ai = 0; ai < 2; ++ai)
#pragma unroll
            for (int m = 0; m < 4; ++m) { bf16_t* rowp = O + (size_t)(row0 + ai * HALF + m * 16) * ldc + col0;
#pragma unroll
                for (int bj = 0; bj < 2; ++bj) *(u32x4*)(rowp + bj * HALF) = pack8(acc[ai][bj][m][0], acc[ai][bj][m][1]); }
    }
};
struct EpiProj {
    static constexpr bool PERM = true, AFTER_DRAIN = false;
    bf16_t *PA, *PG, *PK;
    __device__ __forceinline__ void operator()(const f32x4 (&acc)[2][2][4][2], const Unit& u, int wr, int wc, int fr, int fq) const {
        bf16_t* base; int ldc, colt;
        if (u.pn < 6) { base = PA; ldc = 1536; colt = 256 * u.pn; } else if (u.pn < 14) { base = PG; ldc = 2048; colt = 256 * (u.pn - 6); } else { base = PK; ldc = 256; colt = 0; }
        const int row0 = u.pm * BM + wr * 64 + fr, col0 = colt + wc * 32 + 8 * fq;
#pragma unroll
        for (int ai = 0; ai < 2; ++ai)
#pragma unroll
            for (int m = 0; m < 4; ++m) { bf16_t* rowp = base + (size_t)(row0 + ai * HALF + m * 16) * ldc + col0;
#pragma unroll
                for (int bj = 0; bj < 2; ++bj) *(u32x4*)(rowp + bj * HALF) = pack8(acc[ai][bj][m][0], acc[ai][bj][m][1]); }
    }
};
struct EpiGlu {
    static constexpr bool PERM = true, AFTER_DRAIN = false;
    const bf16_t* Y; bf16_t* O;
    __device__ __forceinline__ void operator()(const f32x4 (&acc)[2][2][4][2], const Unit& u, int wr, int wc, int fr, int fq) const {
        const int row0 = u.pm * BM + wr * 64 + fr, col0 = u.pn * BM + wc * 32 + 8 * fq;
#pragma unroll
        for (int ai = 0; ai < 2; ++ai)
#pragma unroll
            for (int m = 0; m < 4; ++m) { const size_t off = (size_t)(row0 + ai * HALF + m * 16) * 512 + col0;
#pragma unroll
                for (int bj = 0; bj < 2; ++bj) { f32x4 y0, y1; unpack8(*(const u32x4*)(Y + off + bj * HALF), y0, y1); f32x4 v0, v1;
#pragma unroll
                    for (int j = 0; j < 4; ++j) { v0[j] = y0[j] * fsigmoid(acc[ai][bj][m][0][j]); v1[j] = y1[j] * fsigmoid(acc[ai][bj][m][1][j]); }
                    *(u32x4*)(O + off + bj * HALF) = pack8(v0, v1); } }
    }
};
template <bool SECOND> struct EpiMerge {
    static constexpr bool PERM = true, AFTER_DRAIN = false;
    const bf16_t* G; int goff; const bf16_t* T; bf16_t* O;
    __device__ __forceinline__ void operator()(const f32x4 (&acc)[2][2][4][2], const Unit& u, int wr, int wc, int fr, int fq) const {
        const int row0 = u.pm * BM + wr * 64 + fr, col0 = u.pn * BM + wc * 32 + 8 * fq;
#pragma unroll
        for (int ai = 0; ai < 2; ++ai)
#pragma unroll
            for (int m = 0; m < 4; ++m) { const size_t row = (size_t)(row0 + ai * HALF + m * 16);
#pragma unroll
                for (int bj = 0; bj < 2; ++bj) { const int col = col0 + bj * HALF; f32x4 g0, g1; unpack8(*(const u32x4*)(G + row * 2048 + goff + col), g0, g1);
                    f32x4 t0 = (f32x4){0.f, 0.f, 0.f, 0.f}, t1 = t0; if (SECOND) unpack8(*(const u32x4*)(T + row * 1024 + col), t0, t1);
                    f32x4 v0, v1;
#pragma unroll
                    for (int j = 0; j < 4; ++j) { v0[j] = t0[j] + fsigmoid(g0[j]) * acc[ai][bj][m][0][j]; v1[j] = t1[j] + fsigmoid(g1[j]) * acc[ai][bj][m][1][j]; }
                    *(u32x4*)(O + row * 1024 + col) = pack8(v0, v1); } }
    }
};
template <class Epi, class Sched, bool ALIGN_EPI = false, bool SP2 = false>
__device__ __forceinline__ void gemm_phase(PG8_LAS unsigned char* lds, const Gemm g, const Sched& S, const Epi& E) {
    const int tid = threadIdx.x, wid = __builtin_amdgcn_readfirstlane(tid >> 6), lane = tid & 63, wr = wid >> 2, wc = wid & 3, fr = lane & 15, fq = lane >> 4;
    const int K = g.K, nt = K / BK;
    unsigned voffA[2], voffB[2];
#pragma unroll
    for (int i = 0; i < 2; ++i) { int R, C; stage_rc(tid * 16 + i * 8192, R, C); const int Rb = Epi::PERM ? ((R & ~31) + perm32(R & 31)) : R;
        voffA[i] = (unsigned)(R * K + C) * 2u; voffB[i] = (unsigned)(Rb * K + C) * 2u; }
    const size_t kstep = (size_t)(BK * 2);
    const size_t hstep = (size_t)HALF * K * 2;
    const size_t tstep = 2 * hstep;
    const unsigned ldsw = (unsigned)wid * 1024u;
    const int aoff = lds_byte(wr * 64 + fr, fq * 8), boff = lds_byte(wc * 32 + fr, fq * 8);
#define PG8_SA(b, h) (((b) * 2 + (h)) * HTB)
#define PG8_SB(b, h) ((4 + (b) * 2 + (h)) * HTB)
#define PG8_STAGE(bufoff, gbase, voff) do { _Pragma("unroll") for (int _i = 0; _i < 2; ++_i) \
        __builtin_amdgcn_global_load_lds((const unsigned*)((const char*)(gbase) + (voff)[_i]), (PG8_LAS unsigned*)(lds + (bufoff) + ldsw + _i * 8192), 16, 0, 0); } while (0)
#define PG8_LDA(dst, b, h) do { _Pragma("unroll") for (int m = 0; m < 4; ++m) _Pragma("unroll") for (int k = 0; k < 2; ++k) dst[m][k] = *(const PG8_LAS bf16x8*)(lds + PG8_SA(b, h) + aoff + m * 2048 + k * 1024); } while (0)
#define PG8_LDB(dst, b, h) do { _Pragma("unroll") for (int n = 0; n < 2; ++n) _Pragma("unroll") for (int k = 0; k < 2; ++k) dst[n][k] = *(const PG8_LAS bf16x8*)(lds + PG8_SB(b, h) + boff + n * 2048 + k * 1024); } while (0)
#define PG8_MMA(ai, bj, At, Bt) do { __builtin_amdgcn_s_setprio(1); _Pragma("unroll") for (int m = 0; m < 4; ++m) _Pragma("unroll") for (int n = 0; n < 2; ++n) _Pragma("unroll") for (int k = 0; k < 2; ++k) \
        acc[ai][bj][m][n] = __builtin_amdgcn_mfma_f32_16x16x32_bf16(Bt[n][k], At[m][k], acc[ai][bj][m][n], 0, 0, 0); __builtin_amdgcn_s_setprio(0); } while (0)
#define PG8_WAIT_V(n) asm volatile("s_waitcnt vmcnt(" #n ")" ::: "memory")
#define PG8_WAIT_L(n) asm volatile("s_waitcnt lgkmcnt(" #n ")" ::: "memory")
#define PG8_BAR __builtin_amdgcn_s_barrier()
#define PG8_SCHED __builtin_amdgcn_sched_barrier(0)
    Unit cur, nxt; int ui = 0;
    if (!S.next(0, cur)) return;
    f32x4 acc[2][2][4][2];
#pragma unroll
    for (int a = 0; a < 2; ++a)
#pragma unroll
        for (int b = 0; b < 2; ++b)
#pragma unroll
            for (int m = 0; m < 4; ++m)
#pragma unroll
                for (int n = 0; n < 2; ++n) acc[a][b][m][n] = (f32x4){0.f, 0.f, 0.f, 0.f};
    bf16x8 At[4][2], B0[2][2], B1[2][2];
    const char* cA = (const char*)g.A + (size_t)cur.pm * tstep; const char* cB = (const char*)g.Bt + (size_t)cur.pn * tstep;
    S.a_ready(cur);
    if constexpr (SP2) {
        PG8_STAGE(PG8_SB(0, 0), cB, voffB); PG8_STAGE(PG8_SB(0, 1), cB + hstep, voffB); PG8_STAGE(PG8_SA(0, 0), cA, voffA); PG8_STAGE(PG8_SA(0, 1), cA + hstep, voffA);
        if (wr == 1) PG8_BAR;
        PG8_WAIT_V(2); PG8_BAR;
        PG8_STAGE(PG8_SB(1, 0), cB + kstep, voffB); PG8_STAGE(PG8_SA(1, 0), cA + kstep, voffA); PG8_STAGE(PG8_SB(1, 1), cB + hstep + kstep, voffB);
        PG8_WAIT_V(6); PG8_BAR;
    } else {
        PG8_STAGE(PG8_SB(0, 0), cB, voffB); PG8_STAGE(PG8_SA(0, 0), cA, voffA); PG8_STAGE(PG8_SB(0, 1), cB + hstep, voffB); PG8_STAGE(PG8_SA(0, 1), cA + hstep, voffA);
        if (wr == 1) PG8_BAR;
        PG8_WAIT_V(4); PG8_BAR;
        PG8_STAGE(PG8_SB(1, 0), cB + kstep, voffB); PG8_STAGE(PG8_SA(1, 0), cA + kstep, voffA); PG8_STAGE(PG8_SB(1, 1), cB + hstep + kstep, voffB);
        PG8_WAIT_V(6); PG8_BAR;
    }
    for (;;) {
        const bool has_next = S.next(ui + 1, nxt);
        const char* nA = has_next ? (const char*)g.A + (size_t)nxt.pm * tstep : cA; const char* nB = has_next ? (const char*)g.Bt + (size_t)nxt.pn * tstep : cB;
        for (int t = 0; t < nt; t += 2) {
            const bool last = (t == nt - 2);
            const char* a1 = cA + (size_t)(t + 1) * kstep;
            const char* a2 = last ? nA : cA + (size_t)(t + 2) * kstep; const char* b2 = last ? nB : cB + (size_t)(t + 2) * kstep;
            const char* a3 = a2 + kstep; const char* b3 = b2 + kstep;
            if (last && has_next) S.a_ready(nxt);
            if constexpr (SP2) {
            PG8_LDB(B0, 0, 0); PG8_LDB(B1, 0, 1); PG8_SCHED; PG8_LDA(At, 0, 0); PG8_STAGE(PG8_SA(1, 1), a1 + hstep, voffA);
            PG8_WAIT_V(8); PG8_WAIT_L(0); PG8_BAR; PG8_MMA(0, 0, At, B0); PG8_MMA(0, 1, At, B1); PG8_BAR; PG8_SCHED;
            PG8_LDA(At, 0, 1); PG8_STAGE(PG8_SB(0, 0), b2, voffB); PG8_STAGE(PG8_SB(0, 1), b2 + hstep, voffB); PG8_STAGE(PG8_SA(0, 0), a2, voffA);
            PG8_WAIT_V(8); PG8_WAIT_L(0); PG8_BAR; PG8_MMA(1, 0, At, B0); PG8_MMA(1, 1, At, B1); PG8_BAR; PG8_SCHED;
            PG8_LDB(B0, 1, 0); PG8_LDB(B1, 1, 1); PG8_SCHED; PG8_LDA(At, 1, 0); PG8_STAGE(PG8_SA(0, 1), a2 + hstep, voffA);
            PG8_WAIT_V(8); PG8_WAIT_L(0); PG8_BAR; PG8_MMA(0, 0, At, B0); PG8_MMA(0, 1, At, B1); PG8_BAR; PG8_SCHED;
            PG8_LDA(At, 1, 1); PG8_STAGE(PG8_SB(1, 0), b3, voffB); PG8_STAGE(PG8_SB(1, 1), b3 + hstep, voffB); PG8_STAGE(PG8_SA(1, 0), a3, voffA);
            PG8_WAIT_V(8); PG8_WAIT_L(0); PG8_BAR; PG8_MMA(1, 0, At, B0); PG8_MMA(1, 1, At, B1); PG8_BAR; PG8_SCHED;
            } else {
            PG8_LDB(B0, 0, 0); PG8_SCHED; PG8_LDA(At, 0, 0); PG8_STAGE(PG8_SA(1, 1), a1 + hstep, voffA);
            PG8_WAIT_L(8); PG8_BAR; PG8_WAIT_L(0); PG8_MMA(0, 0, At, B0); PG8_BAR; PG8_SCHED;
            PG8_LDB(B1, 0, 1); PG8_STAGE(PG8_SB(0, 0), b2, voffB);
            PG8_BAR; PG8_WAIT_L(0); PG8_MMA(0, 1, At, B1); PG8_BAR;
            PG8_LDA(At, 0, 1); PG8_STAGE(PG8_SA(0, 0), a2, voffA);
            PG8_BAR; PG8_WAIT_L(0); PG8_MMA(1, 0, At, B0); PG8_BAR; PG8_SCHED;
            PG8_STAGE(PG8_SB(0, 1), b2 + hstep, voffB);
            PG8_WAIT_V(6); PG8_BAR; PG8_MMA(1, 1, At, B1); PG8_BAR;
            PG8_LDB(B0, 1, 0); PG8_SCHED; PG8_LDA(At, 1, 0); PG8_STAGE(PG8_SA(0, 1), a2 + hstep, voffA);
            PG8_WAIT_L(8); PG8_BAR; PG8_WAIT_L(0); PG8_MMA(0, 0, At, B0); PG8_BAR; PG8_SCHED;
            PG8_LDB(B1, 1, 1); PG8_STAGE(PG8_SB(1, 0), b3, voffB);
            PG8_BAR; PG8_WAIT_L(0); PG8_MMA(0, 1, At, B1); PG8_BAR;
            PG8_LDA(At, 1, 1); PG8_STAGE(PG8_SA(1, 0), a3, voffA);
            PG8_BAR; PG8_WAIT_L(0); PG8_MMA(1, 0, At, B0); PG8_BAR; PG8_SCHED;
            PG8_STAGE(PG8_SB(1, 1), b3 + hstep, voffB);
            PG8_WAIT_V(6); PG8_BAR; PG8_MMA(1, 1, At, B1); PG8_BAR;
            }
        }
        if constexpr (ALIGN_EPI) { if (wr == 0) PG8_BAR; }
        if constexpr (!Epi::AFTER_DRAIN) { E(acc, cur, wr, wc, fr, fq); S.done(cur); }
        if (!has_next) break;
#pragma unroll
        for (int a = 0; a < 2; ++a)
#pragma unroll
            for (int b = 0; b < 2; ++b)
#pragma unroll
                for (int m = 0; m < 4; ++m)
#pragma unroll
                    for (int n = 0; n < 2; ++n) acc[a][b][m][n] = (f32x4){0.f, 0.f, 0.f, 0.f};
        cur = nxt; cA = nA; cB = nB; ++ui;
        if constexpr (ALIGN_EPI) { if (wr == 1) PG8_BAR; }
    }
    PG8_WAIT_V(0);
    if constexpr (!ALIGN_EPI) { if (wr == 0) PG8_BAR; }
    PG8_BAR;
    if constexpr (Epi::AFTER_DRAIN) { E.fused(acc, cur, wr, wc, fr, fq, lds, wid, lane); S.done(cur); }
#undef PG8_SA
#undef PG8_SB
#undef PG8_STAGE
#undef PG8_LDA
#undef PG8_LDB
#undef PG8_MMA
#undef PG8_WAIT_V
#undef PG8_WAIT_L
#undef PG8_BAR
#undef PG8_SCHED
}
}
#ifndef PG8_SP2
#define PG8_SP2 true
#endif
#ifndef PG8_ALIGN
#define PG8_ALIGN true
#endif
#ifndef MK_PER_PHASE
#define MK_PER_PHASE 0
#endif
#ifndef REP_S5
#define REP_S5 1
#endif
#ifndef REP_DSA
#define REP_DSA 1
#endif
#ifndef REP_G1
#define REP_G1 1
#endif
constexpr int NWAVES = 8;
constexpr int NPH = 14;

constexpr int NB = 16, SEQ = 2048, D = 1024, NMETA = 16, DFF = 2816;
constexpr int R = NB * SEQ;
constexpr int NG = 32, NP = 64, NM = 16;
constexpr float RMS_EPS = 1e-6f;

constexpr size_t MiB = 1u << 20;
constexpr size_t WS_CTL = 0, CTL_ZERO_BYTES = 1 * MiB;
constexpr size_t WS_WT1 = 2 * MiB, WS_WT2 = 13 * MiB, WS_WT3 = 19 * MiB, WS_WT4 = 27 * MiB, WS_WT5 = 38 * MiB;
constexpr size_t WS_WGLU = 44 * MiB, WS_WA = 45 * MiB, WS_WB = 46 * MiB, WS_WOUT = 47 * MiB;
constexpr size_t WS_KS = 50 * MiB, WS_KO = 58 * MiB, WS_KI = 66 * MiB;
constexpr size_t WS_META = 67 * MiB;
constexpr size_t MO_AM1 = 0, MO_ACTM = 32768, MO_FM = 131072, MO_AM2 = 262144, MO_PMU = 294912, MO_PMK = 311296;
constexpr size_t WS_HN = 68 * MiB;
constexpr size_t WS_F = 132 * MiB;
constexpr size_t WS_BIG = 196 * MiB;
constexpr size_t WS_PA = WS_BIG, WS_PG = WS_BIG + 96 * MiB, WS_PK = WS_BIG + 224 * MiB, WS_END = WS_BIG + 240 * MiB;
constexpr int CW_BAR = 4096;

constexpr int LDS_BYTES = 155648;
constexpr int MISC_OFF = 154624;

#define GAS __attribute__((address_space(1)))
#define LAS __attribute__((address_space(3)))
typedef unsigned short bf16;
typedef unsigned v4u __attribute__((ext_vector_type(4)));
typedef unsigned v2u __attribute__((ext_vector_type(2)));
typedef float f32x4 __attribute__((ext_vector_type(4)));
typedef short bf16x8 __attribute__((ext_vector_type(8)));
#define LDS_WAIT() asm volatile("s_waitcnt lgkmcnt(0)" ::: "memory")
#define VM_WAIT() asm volatile("s_waitcnt vmcnt(0)" ::: "memory")
__device__ __forceinline__ unsigned f2bf(float f) { unsigned u = __builtin_bit_cast(unsigned, f); return (u + 0x7fffu + ((u >> 16) & 1u)) >> 16; }
__device__ __forceinline__ unsigned pk2(float lo, float hi) { return f2bf(lo) | (f2bf(hi) << 16); }
__device__ __forceinline__ float bflo(unsigned w) { return __uint_as_float(w << 16); }
__device__ __forceinline__ float bfhi(unsigned w) { return __uint_as_float(w & 0xffff0000u); }
__device__ __forceinline__ float bf2f(bf16 v) { return __uint_as_float(((unsigned)v) << 16); }
__device__ __forceinline__ float fsig(float x) { return __builtin_amdgcn_rcpf(1.0f + __expf(-x)); }

#define XB_TMO      128
#define XB_XCNT(j)  (256  + 64 * (j))
#define XB_XSUB(j)  (1280 + 64 * (j))
#define XB_XGEN(j)  (2304 + 64 * (j))
#define XB_TOP      3328
#define XB_TOPGEN   3392
#define XCD_BAR_WORDS 3456
#define XB_SPIN_CAP (1u << 18)
__device__ __forceinline__ unsigned xb_ld(unsigned* p)              { return __hip_atomic_load(p, __ATOMIC_RELAXED, __HIP_MEMORY_SCOPE_AGENT); }
__device__ __forceinline__ unsigned xb_add(unsigned* p, unsigned v) { return __hip_atomic_fetch_add(p, v, __ATOMIC_RELAXED, __HIP_MEMORY_SCOPE_AGENT); }
__device__ __forceinline__ unsigned xb_xcc_id() { return (unsigned)__builtin_amdgcn_s_getreg((3 << 11) | 20) & 0xFu; }
#define XB_SPIN(cond, bar) do { unsigned _sp = 0; while (cond) { __builtin_amdgcn_s_sleep(1); \
    if ((++_sp & 255u) == 0u) { if (xb_ld(&(bar)[XB_TMO])) break; if (_sp > XB_SPIN_CAP) { atomicAdd(&(bar)[XB_TMO], 1u); break; } } } } while (0)
struct XcdBarrier { unsigned* bar; unsigned x; volatile LAS unsigned* st; };
__device__ __forceinline__ XcdBarrier xcd_barrier_post(unsigned* bar, volatile LAS unsigned* st) {
    XcdBarrier b; b.bar = bar; b.x = xb_xcc_id(); b.st = st;
    if (threadIdx.x == 0) (void)xb_add(&bar[XB_XCNT(b.x)], 1u);
    return b;
}
__device__ __forceinline__ void xcd_barrier_complete(unsigned* bar, unsigned x, unsigned& nloc, unsigned& nx) {
    const unsigned G = gridDim.x * gridDim.y * gridDim.z;
    unsigned sum, cnt, mine, sp = 0u;
    for (;;) {
        sum = 0u; cnt = 0u; mine = 0u;
#pragma unroll
        for (unsigned j = 0; j < 16; ++j) { const unsigned c = xb_ld(&bar[XB_XCNT(j)]); sum += c; cnt += (c > 0u) ? 1u : 0u; mine = (j == x) ? c : mine; }
        if (sum == G) break;
        __builtin_amdgcn_s_sleep(1);
        if ((++sp & 255u) == 0u) { if (xb_ld(&bar[XB_TMO])) break; if (sp > XB_SPIN_CAP) { atomicAdd(&bar[XB_TMO], 1u); break; } }
    }
    nloc = mine > 0u ? mine : 1u; nx = cnt > 0u ? cnt : 1u;
}
__device__ __forceinline__ void xcd_barrier(const XcdBarrier& b) {
    asm volatile("s_waitcnt vmcnt(0)" ::: "memory");
    __syncthreads();
    if (threadIdx.x == 0) {
        unsigned* bar = b.bar;
        __builtin_amdgcn_s_waitcnt(0);
        unsigned nloc = b.st[0], nx = b.st[1];
        if (nloc == 0u) { xcd_barrier_complete(bar, b.x, nloc, nx); b.st[0] = nloc; b.st[1] = nx; }
        const unsigned old = xb_add(&bar[XB_XSUB(b.x)], 1u);
        const unsigned gen = old / nloc;
        if (old + 1u == (gen + 1u) * nloc) {
            __builtin_amdgcn_fence(__ATOMIC_RELEASE, "agent");
            asm volatile("s_waitcnt vmcnt(0)" ::: "memory");
            const unsigned og = xb_add(&bar[XB_TOP], 1u);
            const unsigned tg = og / nx;
            if (og + 1u == (tg + 1u) * nx) xb_add(&bar[XB_TOPGEN], 1u);
            else XB_SPIN(xb_ld(&bar[XB_TOPGEN]) == tg, bar);
            __builtin_amdgcn_fence(__ATOMIC_ACQUIRE, "agent");
            xb_add(&bar[XB_XGEN(b.x)], 1u);
            asm volatile("s_waitcnt vmcnt(0)" ::: "memory");
        } else {
            XB_SPIN(xb_ld(&bar[XB_XGEN(b.x)]) == gen, bar);
            __builtin_amdgcn_fence(__ATOMIC_ACQUIRE, "agent");
            asm volatile("s_waitcnt vmcnt(0)" ::: "memory");
        }
    }
    __syncthreads();
}

__device__ __forceinline__ float wave_sum(float v) {
#pragma unroll
    for (int o = 1; o < 64; o <<= 1) v += __shfl_xor(v, o);
    return v;
}
__device__ __forceinline__ f32x4 mfma16(bf16x8 a, bf16x8 b, f32x4 c) { return __builtin_amdgcn_mfma_f32_16x16x32_bf16(a, b, c, 0, 0, 0); }

__device__ __forceinline__ void transpose_item(const float* W, int Nsrc, int K, bf16* WT, int k0, int drow0, int srccol, LAS float* scr, int lane) {
#pragma unroll 8
    for (int i = 0; i < 32; ++i) { const int kk = 2 * i + (lane >> 5); scr[kk * 33 + (lane & 31)] = (srccol >= 0) ? W[(size_t)(k0 + kk) * Nsrc + srccol] : 0.f; }
    LDS_WAIT(); asm volatile("" ::: "memory");
    const int c = lane & 7;
#pragma unroll
    for (int j = 0; j < 4; ++j) { const int n = (lane >> 3) + 8 * j; const LAS float* s = scr + (8 * c) * 33 + n;
        v4u o; o.x = pk2(s[0 * 33], s[1 * 33]); o.y = pk2(s[2 * 33], s[3 * 33]); o.z = pk2(s[4 * 33], s[5 * 33]); o.w = pk2(s[6 * 33], s[7 * 33]);
        *(v4u*)(WT + (size_t)(drow0 + n) * K + k0 + 8 * c) = o; }
    LDS_WAIT(); asm volatile("" ::: "memory");
}
__device__ __forceinline__ int win_srccol(int d) {
    if (d < 1024) return d;
    if (d < 1536) return 1096 + (d - 1024);
    if (d < 3584) return 1736 + (d - 1536);
    if (d < 3648) return 1024 + (d - 3584);
    if (d < 3712) return 1608 + (d - 3648);
    if (d < 3776) return 1672 + (d - 3712);
    if (d < 3784) return 1088 + (d - 3776);
    return -1;
}
__device__ __forceinline__ void norm_row_to_bf16(const float* xrow, const float* g, bf16* orow, int lane) {
    f32x4 v[4]; float ss = 0.f;
#pragma unroll
    for (int j = 0; j < 4; ++j) { v[j] = ((const f32x4*)xrow)[lane + 64 * j]; ss += (v[j].x * v[j].x + v[j].y * v[j].y) + (v[j].z * v[j].z + v[j].w * v[j].w); }
    const float rs = rsqrtf(wave_sum(ss) * (1.f / D) + RMS_EPS);
#pragma unroll
    for (int j = 0; j < 4; ++j) { const f32x4 gv = ((const f32x4*)g)[lane + 64 * j]; v2u o; o.x = pk2(v[j].x * rs * gv.x, v[j].y * rs * gv.y); o.y = pk2(v[j].z * rs * gv.z, v[j].w * rs * gv.w);
        ((v2u*)orow)[lane + 64 * j] = o; }
}
__device__ __forceinline__ void row_update(const bf16* frow, const float* base, float* outrow, bf16* hnrow, const float* gpost, const float* gnext, float scale, int lane) {
    f32x4 f[4], h[4]; float ss = 0.f;
#pragma unroll
    for (int j = 0; j < 4; ++j) { const v2u w = ((const v2u*)frow)[lane + 64 * j]; f[j] = (f32x4){bflo(w.x), bfhi(w.x), bflo(w.y), bfhi(w.y)};
        ss += (f[j].x * f[j].x + f[j].y * f[j].y) + (f[j].z * f[j].z + f[j].w * f[j].w); }
    const float rs = rsqrtf(wave_sum(ss) * (1.f / D) + RMS_EPS) * scale; float s2 = 0.f;
#pragma unroll
    for (int j = 0; j < 4; ++j) { const f32x4 gv = ((const f32x4*)gpost)[lane + 64 * j]; const f32x4 bv = ((const f32x4*)base)[lane + 64 * j];
        h[j] = bv + f[j] * rs * gv; s2 += (h[j].x * h[j].x + h[j].y * h[j].y) + (h[j].z * h[j].z + h[j].w * h[j].w); }
    if (outrow) {
#pragma unroll
        for (int j = 0; j < 4; ++j) ((f32x4*)outrow)[lane + 64 * j] = h[j]; }
    if (hnrow) { const float r2 = rsqrtf(wave_sum(s2) * (1.f / D) + RMS_EPS);
#pragma unroll
        for (int j = 0; j < 4; ++j) { const f32x4 gv = ((const f32x4*)gnext)[lane + 64 * j]; v2u o; o.x = pk2(h[j].x * r2 * gv.x, h[j].y * r2 * gv.y); o.y = pk2(h[j].z * r2 * gv.z, h[j].w * r2 * gv.w);
            ((v2u*)hnrow)[lane + 64 * j] = o; } }
}
__device__ __forceinline__ f32x4 meta_tile(const bf16* A, const bf16* B, int K, int lane) {
    const int fr = lane & 15, kq = lane >> 4; const bf16* ap = A + (size_t)fr * K + 8 * kq; const bf16* bp = B + (size_t)fr * K + 8 * kq;
    f32x4 acc = (f32x4){0.f, 0.f, 0.f, 0.f};
#pragma unroll 4
    for (int k = 0; k < K; k += 32) { const bf16x8 a = *(const bf16x8*)(ap + k); const bf16x8 b = *(const bf16x8*)(bp + k); acc = mfma16(a, b, acc); }
    return acc;
}

struct Args { const float* in[28]; float* out; unsigned char* ws; int ph_lo, ph_hi; };

__device__ __forceinline__ void s5_table_item(const Args& a, int item, LAS float* sc, int tid) {
    const float* lam_re = a.in[15]; const float* lam_im = a.in[16]; const float* log_dt = a.in[17];
    const float* b_re = a.in[18]; const float* b_im = a.in[19]; const float* c_re = a.in[20]; const float* c_im = a.in[21]; const float* dsk = a.in[22];
    const int type = item / 2048, g = (item % 2048) / 64, idx = item % 64;
    LAS float* ap_re = sc; LAS float* ap_im = sc + 64; LAS float* w_re = sc + 128; LAS float* w_im = sc + 192;
    __syncthreads();
    if (tid < 64) { const int p = tid; const float lr = lam_re[g * 64 + p], li = lam_im[g * 64 + p], dt = expf(log_dt[g]);
        const float ang = li * dt, mag = expf(lr * dt); float s1, c1; sincosf(ang, &s1, &c1);
        const float a_re = mag * c1, a_im = mag * s1, den = lr * lr + li * li, nr = a_re - 1.0f, ni = a_im;
        const float cf_re = (nr * lr + ni * li) / den, cf_im = (ni * lr - nr * li) / den;
        const int n = (type == 0) ? idx : (type == 1 ? 63 - idx : idx + 1);
        float sn, cn; sincosf((float)n * ang, &sn, &cn); const float mn = expf((float)n * lr * dt);
        const float pr = mn * cn, pi = mn * sn;
        ap_re[p] = pr; ap_im[p] = pi; w_re[p] = pr * cf_re - pi * cf_im; w_im[p] = pr * cf_im + pi * cf_re; }
    __syncthreads();
    if (type == 0) {
        if (tid < 256) { const int m = tid >> 4, mp = tid & 15; float s = 0.f;
            for (int p = 0; p < 64; ++p) { const float br = b_re[(g * 64 + p) * 16 + mp], bi = b_im[(g * 64 + p) * 16 + mp];
                const float zr = w_re[p] * br - w_im[p] * bi, zi = w_re[p] * bi + w_im[p] * br;
                s += c_re[(g * 16 + m) * 64 + p] * zr - c_im[(g * 16 + m) * 64 + p] * zi; }
            if (idx == 0 && m == mp) s += dsk[g * 16 + m];
            ((bf16*)(a.ws + WS_KI))[((g * 64 + idx) * 16 + m) * 16 + mp] = (bf16)f2bf(s); }
    } else if (type == 1) {
#pragma unroll
        for (int k = 0; k < 4; ++k) { const int e = tid + 512 * k, n = e >> 4, mp = e & 15, p = n & 63;
            const float br = b_re[(g * 64 + p) * 16 + mp], bi = b_im[(g * 64 + p) * 16 + mp];
            const float zr = w_re[p] * br - w_im[p] * bi, zi = w_re[p] * bi + w_im[p] * br;
            ((bf16*)(a.ws + WS_KS))[((size_t)(g * 64 + idx) * 128 + n) * 16 + mp] = (bf16)f2bf(n < 64 ? zr : zi); }
    } else {
#pragma unroll
        for (int k = 0; k < 4; ++k) { const int e = tid + 512 * k, m = e >> 7, kk = e & 127, p = kk & 63;
            const float cr = c_re[(g * 16 + m) * 64 + p], ci = c_im[(g * 16 + m) * 64 + p];
            const float wr_ = cr * ap_re[p] - ci * ap_im[p], wi_ = cr * ap_im[p] + ci * ap_re[p];
            ((bf16*)(a.ws + WS_KO))[((size_t)(g * 64 + idx) * 16 + m) * 128 + kk] = (bf16)f2bf(kk < 64 ? wr_ : -wi_); }
    }
}

constexpr int S5_U = 0, S5_USTR = 2064, S5_KI = 66048, S5_SLOC = 98816, S5_XINB = 115200, S5_XSTR = 272, S5_MISC = 123904;
__device__ __forceinline__ float gelu_tanh(float x) { const float z = 0.7978845608028654f * (x + 0.044715f * x * x * x); return x * fsig(2.0f * z); }
__device__ __forceinline__ void s5_unit(const Args& a, LAS unsigned char* L, int b, int g, int tid) {
    const int lane = tid & 63, w = __builtin_amdgcn_readfirstlane(tid >> 6), fr = lane & 15, kq = lane >> 4;
    const bf16* PA = (const bf16*)(a.ws + WS_PA); const bf16* PMU = (const bf16*)(a.ws + WS_META + MO_PMU);
    const bf16* KS = (const bf16*)(a.ws + WS_KS); const bf16* KO = (const bf16*)(a.ws + WS_KO); const bf16* KI = (const bf16*)(a.ws + WS_KI);
    bf16* YA = (bf16*)(a.ws + WS_F);
    LAS float* SLOC = (LAS float*)(L + S5_SLOC); LAS float* MS = (LAS float*)(L + S5_MISC);
    __syncthreads();
#pragma unroll
    for (int k = 0; k < 8; ++k) { const int idx = tid + 512 * k, t = idx >> 1, hf = idx & 1;
        const v4u v = *(const v4u*)(PA + (size_t)(b * 2048 + t) * 1536 + 16 * g + 8 * hf);
        *(LAS v4u*)(L + S5_U + (t >> 6) * S5_USTR + (t & 63) * 32 + 16 * hf) = v; }
#pragma unroll
    for (int k = 0; k < 4; ++k) { const int idx = tid + 512 * k; *(LAS v4u*)(L + S5_KI + idx * 16) = *(const v4u*)(KI + (size_t)g * 16384 + idx * 8); }
    if (w == 0) { const int p = lane; const float lr = a.in[15][g * 64 + p], li = a.in[16][g * 64 + p], dt = expf(a.in[17][g]);
        const float ang = li * dt, mag = expf(lr * dt); float s1, c1; sincosf(ang, &s1, &c1);
        const float a_re = mag * c1, a_im = mag * s1, den = lr * lr + li * li, nr = a_re - 1.0f, ni = a_im;
        const float cf_re = (nr * lr + ni * li) / den, cf_im = (ni * lr - nr * li) / den;
        float bb_re[16], bb_im[16];
#pragma unroll
        for (int m = 0; m < 16; ++m) { const float br = a.in[18][(g * 64 + p) * 16 + m], bi = a.in[19][(g * 64 + p) * 16 + m]; bb_re[m] = cf_re * br - cf_im * bi; bb_im[m] = cf_re * bi + cf_im * br; }
        float xr = 0.f, xi = 0.f;
        for (int i = 0; i < 16; ++i) { float ur = 0.f, ui = 0.f;
#pragma unroll
            for (int m = 0; m < 16; ++m) { const float u = bf2f(PMU[i * 512 + 16 * g + m]); ur += bb_re[m] * u; ui += bb_im[m] * u; }
            const float nr2 = a_re * xr - a_im * xi + ur, ni2 = a_re * xi + a_im * xr + ui; xr = nr2; xi = ni2; }
        float s64, c64; sincosf(64.0f * ang, &s64, &c64); const float m64 = expf(64.0f * lr * dt);
        MS[p] = xr; MS[64 + p] = xi; MS[128 + p] = m64 * c64; MS[192 + p] = m64 * s64; }
    __syncthreads();
    { f32x4 acc0 = (f32x4){0.f, 0.f, 0.f, 0.f}, acc1 = acc0;
#pragma unroll 4
      for (int ks = 0; ks < 32; ++ks) { const int i = 2 * ks + (kq >> 1);
          const bf16x8 bfr = *(const bf16x8*)(KS + ((size_t)(g * 64 + i) * 128 + 16 * w + fr) * 16 + 8 * (kq & 1));
          const bf16x8 a0 = *(const LAS bf16x8*)(L + S5_U + fr * S5_USTR + (32 * ks + 8 * kq) * 2);
          const bf16x8 a1 = *(const LAS bf16x8*)(L + S5_U + (16 + fr) * S5_USTR + (32 * ks + 8 * kq) * 2);
          acc0 = mfma16(a0, bfr, acc0); acc1 = mfma16(a1, bfr, acc1); }
#pragma unroll
      for (int r = 0; r < 4; ++r) { SLOC[(4 * kq + r) * 128 + 16 * w + fr] = acc0[r]; SLOC[(16 + 4 * kq + r) * 128 + 16 * w + fr] = acc1[r]; } }
    __syncthreads();
    if (w == 0) { const int p = lane; float xr = MS[p], xi = MS[64 + p]; const float ar = MS[128 + p], ai = MS[192 + p];
        for (int c = 0; c < 32; ++c) { *(LAS bf16*)(L + S5_XINB + c * S5_XSTR + p * 2) = (bf16)f2bf(xr); *(LAS bf16*)(L + S5_XINB + c * S5_XSTR + (64 + p) * 2) = (bf16)f2bf(xi);
            const float sr = SLOC[c * 128 + p], si = SLOC[c * 128 + 64 + p]; const float nr2 = ar * xr - ai * xi + sr, ni2 = ar * xi + ai * xr + si; xr = nr2; xi = ni2; } }
    __syncthreads();
    for (int jj = 0; jj < 8; ++jj) { const int j = w + 8 * jj;
        f32x4 acc0 = (f32x4){0.f, 0.f, 0.f, 0.f}, acc1 = acc0;
#pragma unroll
        for (int ks = 0; ks < 4; ++ks) { const bf16x8 bfr = *(const bf16x8*)(KO + ((size_t)(g * 64 + j) * 16 + fr) * 128 + 32 * ks + 8 * kq);
            const bf16x8 a0 = *(const LAS bf16x8*)(L + S5_XINB + fr * S5_XSTR + (32 * ks + 8 * kq) * 2);
            const bf16x8 a1 = *(const LAS bf16x8*)(L + S5_XINB + (16 + fr) * S5_XSTR + (32 * ks + 8 * kq) * 2);
            acc0 = mfma16(a0, bfr, acc0); acc1 = mfma16(a1, bfr, acc1); }
        const int nks = (j >> 1) + 1;
        for (int ks = 0; ks < nks; ++ks) { const int i = 2 * ks + (kq >> 1), tau = j - i;
            bf16x8 bfr = (bf16x8){0, 0, 0, 0, 0, 0, 0, 0};
            if (tau >= 0) bfr = *(const LAS bf16x8*)(L + S5_KI + ((tau * 16 + fr) * 16 + 8 * (kq & 1)) * 2);
            const bf16x8 a0 = *(const LAS bf16x8*)(L + S5_U + fr * S5_USTR + (32 * ks + 8 * kq) * 2);
            const bf16x8 a1 = *(const LAS bf16x8*)(L + S5_U + (16 + fr) * S5_USTR + (32 * ks + 8 * kq) * 2);
            acc0 = mfma16(a0, bfr, acc0); acc1 = mfma16(a1, bfr, acc1); }
#pragma unroll
        for (int r = 0; r < 4; ++r) { const int c0 = 4 * kq + r, c1 = 16 + 4 * kq + r;
            YA[(size_t)(b * 2048 + 64 * c0 + j) * 512 + 16 * g + fr] = (bf16)f2bf(gelu_tanh(acc0[r]));
            YA[(size_t)(b * 2048 + 64 * c1 + j) * 512 + 16 * g + fr] = (bf16)f2bf(gelu_tanh(acc1[r])); } }
}

constexpr int DS_SSTR = 2120, DS_TSTR = 144, DS_BUF = 18432  , DS_BT = 36864  , DS_HIST = 135680, DS_MASK = 143872, DS_RB = 152576, DS_TB = 153600;
typedef short s16x4 __attribute__((ext_vector_type(4)));
__device__ __forceinline__ s16x4 tr_read(unsigned addr) { s16x4 r; asm volatile("ds_read_b64_tr_b16 %0, %1" : "=&v"(r) : "v"(addr) : "memory"); return r; }
__device__ __forceinline__ unsigned f16key(float f) { const _Float16 hf = (_Float16)f; const unsigned h = (unsigned)__builtin_bit_cast(unsigned short, hf); return (h & 0x8000u) ? (~h & 0xffffu) : (h | 0x8000u); }
__device__ __forceinline__ unsigned cvtpk(float lo, float hi) { unsigned r; asm volatile("v_cvt_pk_bf16_f32 %0, %1, %2" : "=v"(r) : "v"(lo), "v"(hi)); return r; }
__device__ __forceinline__ void dsa_tables(const Args& a, LAS unsigned char* L, int tid) {
    if (tid < 256) { ((LAS float*)(L + DS_RB))[tid] = a.in[25][tid] * 1.44269504f;
        const int n = tid; const int lo = n < 8 ? n : (n < 12 ? 8 : n < 16 ? 9 : n < 23 ? 10 : n < 32 ? 11 : n < 46 ? 12 : n < 64 ? 13 : n < 91 ? 14 : 15);
        ((LAS int*)(L + DS_TB))[tid] = lo; }
}
__device__ __forceinline__ void dsa_unit(const Args& a, LAS unsigned char* L, int b, int uq, int tid) {
    const int lane = tid & 63, w = __builtin_amdgcn_readfirstlane(tid >> 6), fr = lane & 15, kq = lane >> 4;
    const bf16* PA = (const bf16*)(a.ws + WS_PA); const bf16* PK = (const bf16*)(a.ws + WS_PK); const bf16* PMK = (const bf16*)(a.ws + WS_META + MO_PMK);
    bf16* YB = (bf16*)(a.ws + WS_HN) + (size_t)R * 512;
    const int c = 1 + (uq >> 1), nt64 = c + 1, qrow0 = b * 2048 + 32 * uq;
    LAS unsigned short* S16 = (LAS unsigned short*)L; LAS unsigned long long* MASK = (LAS unsigned long long*)(L + DS_MASK);
    const LAS float* RB = (const LAS float*)(L + DS_RB); const LAS int* TB = (const LAS int*)(L + DS_TB);
    __syncthreads();
    { const int qh = w >> 2; bf16x8 qa[4][2][2]; float wv[4][2][4];
#pragma unroll
      for (int p = 0; p < 4; ++p) {
#pragma unroll
          for (int hf = 0; hf < 2; ++hf)
#pragma unroll
              for (int ks = 0; ks < 2; ++ks) qa[p][hf][ks] = *(const bf16x8*)(PA + (size_t)(qrow0 + 16 * qh + 4 * p + (fr >> 2)) * 1536 + 512 + (4 * hf + (fr & 3)) * 64 + 32 * ks + 8 * kq);
          const v4u wraw = *(const v4u*)(PK + (size_t)(qrow0 + 16 * qh + 4 * p + kq) * 256 + 192);
          wv[p][0][0] = bflo(wraw.x) * 0.04419417382f; wv[p][0][1] = bfhi(wraw.x) * 0.04419417382f; wv[p][0][2] = bflo(wraw.y) * 0.04419417382f; wv[p][0][3] = bfhi(wraw.y) * 0.04419417382f;
          wv[p][1][0] = bflo(wraw.z) * 0.04419417382f; wv[p][1][1] = bfhi(wraw.z) * 0.04419417382f; wv[p][1][2] = bflo(wraw.w) * 0.04419417382f; wv[p][1][3] = bfhi(wraw.w) * 0.04419417382f; }
      const int nkt = 4 * nt64;
      if ((w & 3) != 0) {
#pragma unroll
          for (int p = 0; p < 4; ++p) S16[(16 * qh + 4 * p + kq) * DS_SSTR + 16 * (w & 3) + fr] = (unsigned short)0; }
      int kt = (w & 3) == 0 ? 0 : (w & 3) + 4;
      bf16x8 kb0, kb1, kc0, kc1;
      { const bf16* krow = (kt == 0) ? PMK + fr * 256 : PK + (size_t)(b * 2048 + 16 * kt - 64 + fr) * 256; kb0 = *(const bf16x8*)(krow + 8 * kq); kb1 = *(const bf16x8*)(krow + 32 + 8 * kq); }
      { const int k1 = (kt == 0) ? 4 : kt + 4; kc0 = kb0; kc1 = kb1;
        if (k1 < nkt) { const bf16* krow = PK + (size_t)(b * 2048 + 16 * k1 - 64 + fr) * 256; kc0 = *(const bf16x8*)(krow + 8 * kq); kc1 = *(const bf16x8*)(krow + 32 + 8 * kq); } }
      while (kt < nkt) {
          const int ktn = (kt == 0) ? 4 : kt + 4, ktnn = ktn + 4; bf16x8 nb0 = kc0, nb1 = kc1;
          if (ktnn < nkt) { const bf16* krow = PK + (size_t)(b * 2048 + 16 * ktnn - 64 + fr) * 256; nb0 = *(const bf16x8*)(krow + 8 * kq); nb1 = *(const bf16x8*)(krow + 32 + 8 * kq); }
#pragma unroll
          for (int p = 0; p < 4; ++p) { f32x4 aA = (f32x4){0.f, 0.f, 0.f, 0.f}, aB = aA;
              aA = mfma16(qa[p][0][0], kb0, aA); aB = mfma16(qa[p][1][0], kb0, aB); aA = mfma16(qa[p][0][1], kb1, aA); aB = mfma16(qa[p][1][1], kb1, aB);
              const float v = (fmaxf(aA[0], 0.f) * wv[p][0][0] + fmaxf(aA[1], 0.f) * wv[p][0][1]) + (fmaxf(aA[2], 0.f) * wv[p][0][2] + fmaxf(aA[3], 0.f) * wv[p][0][3])
                            + (fmaxf(aB[0], 0.f) * wv[p][1][0] + fmaxf(aB[1], 0.f) * wv[p][1][1]) + (fmaxf(aB[2], 0.f) * wv[p][1][2] + fmaxf(aB[3], 0.f) * wv[p][1][3]);
              S16[(16 * qh + 4 * p + kq) * DS_SSTR + 16 * kt + fr] = (unsigned short)f16key(v); }
          kb0 = kc0; kb1 = kc1; kc0 = nb0; kc1 = nb1; kt = ktn; } }
    __syncthreads();
    bf16x8 qb[2][2]; unsigned mkoff[2];
#pragma unroll
    for (int cg = 0; cg < 2; ++cg) { const int q = 4 * w + 2 * cg + (fr >> 3), h = fr & 7; mkoff[cg] = q * 34;
#pragma unroll
        for (int ks = 0; ks < 2; ++ks) qb[cg][ks] = *(const bf16x8*)(PA + (size_t)(qrow0 + q) * 1536 + 1024 + h * 64 + 32 * ks + 8 * kq); }
    const int skey = tid >> 3, spiece = tid & 7;
    v4u kv0 = (v4u){0u, 0u, 0u, 0u}, vv0 = kv0, kv, vv;
    if (skey < 16) { const bf16* krow = PMK + skey * 256; kv0 = *(const v4u*)(krow + 64 + 8 * spiece); vv0 = *(const v4u*)(krow + 128 + 8 * spiece); }
    { const bf16* krow = PK + (size_t)(b * 2048 + skey) * 256; kv = *(const v4u*)(krow + 64 + 8 * spiece); vv = *(const v4u*)(krow + 128 + 8 * spiece); }
    { LAS unsigned* H = (LAS unsigned*)(L + DS_HIST) + w * 256;
      for (int qq = 0; qq < 4; ++qq) { const int q = 4 * w + qq; const LAS unsigned short* Sq = S16 + q * DS_SSTR; unsigned tkey = 0u;
          unsigned kr[33];
#pragma unroll
          for (int e = 0; e < 33; ++e) kr[e] = (e < nt64) ? (unsigned)Sq[64 * e + lane] : 0u;
          if (c >= 4) { unsigned prefix = 0u; int kth = 256;
#pragma unroll
              for (int pass = 0; pass < 2; ++pass) {
                  H[lane] = 0u; H[lane + 64] = 0u; H[lane + 128] = 0u; H[lane + 192] = 0u; LDS_WAIT();
#pragma unroll
                  for (int e = 0; e < 33; ++e) if (e < nt64) { const unsigned key = kr[e]; const bool in = (pass == 0) || ((key >> 8) == prefix);
                      if (in) (void)__hip_atomic_fetch_add(&H[pass == 0 ? (key >> 8) : (key & 255u)], 1u, __ATOMIC_RELAXED, __HIP_MEMORY_SCOPE_WORKGROUP); }
                  LDS_WAIT();
                  const unsigned h0 = H[4 * lane], h1 = H[4 * lane + 1], h2 = H[4 * lane + 2], h3 = H[4 * lane + 3]; const int t = (int)(h0 + h1 + h2 + h3);
                  int sfx = t;
#pragma unroll
                  for (int off = 1; off < 64; off <<= 1) { const int v = __shfl_down(sfx, off); if (lane + off < 64) sfx += v; }
                  const int above = sfx - t; const bool has = (above < kth) && (above + t >= kth);
                  const unsigned long long bm = __ballot(has); const int src = bm ? (__ffsll((long long)bm) - 1) : 0;
                  int cum = above, B; if (cum + (int)h3 >= kth) B = 3; else { cum += (int)h3; if (cum + (int)h2 >= kth) B = 2; else { cum += (int)h2; if (cum + (int)h1 >= kth) B = 1; else { cum += (int)h1; B = 0; } } }
                  const int bin = __shfl(4 * lane + B, src); kth = __shfl(kth - cum, src);
                  prefix = (prefix << 8) | (unsigned)bin; LDS_WAIT(); }
              tkey = prefix; }
          unsigned mlo = 0u, mhi = 0u;
#pragma unroll
          for (int e = 0; e < 33; ++e) if (e < nt64) { const int s = 64 * e + lane; const bool sel = ((s < 16) || (s >= 64)) && (kr[e] >= tkey);
              const unsigned long long m = __ballot(sel); mlo = (lane == e) ? (unsigned)m : mlo; mhi = (lane == e) ? (unsigned)(m >> 32) : mhi; }
          if (lane < nt64) MASK[q * 34 + lane] = ((unsigned long long)mhi << 32) | mlo; } }
    __syncthreads();
    {
      const int hh = fr & 7; const float bfar = RB[15 * 8 + hh];
      float mrun[2] = {-1.0e30f, -1.0e30f}, lrun[2] = {0.f, 0.f}; f32x4 O[2][4];
#pragma unroll
      for (int cg = 0; cg < 2; ++cg)
#pragma unroll
          for (int dt = 0; dt < 4; ++dt) O[cg][dt] = (f32x4){0.f, 0.f, 0.f, 0.f};
      const LAS float* BT = (const LAS float*)(L + DS_BT);
#pragma unroll
      for (int k = 0; k < 4; ++k) { const int e = tid + 512 * k, relc = (e >> 3) - 128, n = relc < 0 ? -relc : relc; ((LAS float*)(L + DS_BT))[e] = RB[(TB[n] + (relc > 0 ? 16 : 0)) * 8 + (e & 7)]; }
      const unsigned ldsV = (unsigned)(size_t)(L) + 9216u + (unsigned)((4 * kq + ((lane & 15) >> 2)) * DS_TSTR + 8 * (lane & 3));
      *(LAS v4u*)(L + skey * DS_TSTR + 16 * spiece) = kv0; *(LAS v4u*)(L + 9216 + skey * DS_TSTR + 16 * spiece) = vv0;
      __syncthreads();
      for (int T = 0; T < nt64; ++T) { const int buf = T & 1;
          v4u kn = kv, vn = vv;
          if (T + 2 < nt64) { const bf16* krow = PK + (size_t)(b * 2048 + 64 * (T + 1) + skey) * 256; kn = *(const v4u*)(krow + 64 + 8 * spiece); vn = *(const v4u*)(krow + 128 + 8 * spiece); }
          const bool nearT = (64 * T > 32 * uq - 90);
          f32x4 lg[2][4];
          { bf16x8 ka[4][2];
#pragma unroll
            for (int sub = 0; sub < 4; ++sub)
#pragma unroll
                for (int ks = 0; ks < 2; ++ks) ka[sub][ks] = *(const LAS bf16x8*)(L + buf * DS_BUF + fr * DS_TSTR + 16 * kq + sub * 16 * DS_TSTR + ks * 64);
#pragma unroll
            for (int cg = 0; cg < 2; ++cg)
#pragma unroll
                for (int sub = 0; sub < 4; ++sub) { f32x4 acc = (f32x4){0.f, 0.f, 0.f, 0.f}; acc = mfma16(ka[sub][0], qb[cg][0], acc); acc = mfma16(ka[sub][1], qb[cg][1], acc); lg[cg][sub] = acc; } }
          s16x4 vt[2][4][2];
#pragma unroll
          for (int cg = 0; cg < 2; ++cg) {
              float mxl = -1.0e30f;
              if (nearT) { const int relb = ((T == 0) ? 0 : 64 * T - 48) + 4 * kq - (16 + 32 * uq + 4 * w + 2 * cg + (fr >> 3));
#pragma unroll
                  for (int sub = 0; sub < 4; ++sub)
#pragma unroll
                      for (int r = 0; r < 4; ++r) { int idx = relb + 16 * sub + r; idx = idx < -128 ? -128 : idx; idx = idx > 127 ? 127 : idx;
                          const float v = lg[cg][sub][r] * 0.18033688f + BT[(idx + 128) * 8 + hh]; lg[cg][sub][r] = v; mxl = fmaxf(mxl, v); }
              } else {
#pragma unroll
                  for (int sub = 0; sub < 4; ++sub)
#pragma unroll
                      for (int r = 0; r < 4; ++r) { const float v = lg[cg][sub][r] * 0.18033688f + bfar; lg[cg][sub][r] = v; mxl = fmaxf(mxl, v); } }
              if (__ballot(mxl > mrun[cg] + 8.0f) != 0ull) { float mx = mxl; mx = fmaxf(mx, __shfl_xor(mx, 16)); mx = fmaxf(mx, __shfl_xor(mx, 32));
                  const float mn = fmaxf(mrun[cg], mx), sc = __builtin_amdgcn_exp2f(mrun[cg] - mn); mrun[cg] = mn; lrun[cg] *= sc;
#pragma unroll
                  for (int dt = 0; dt < 4; ++dt) O[cg][dt] = O[cg][dt] * sc; }
              const unsigned long long mword = MASK[mkoff[cg] + T] >> (4 * kq); const unsigned mlo = (unsigned)mword, mhi = (unsigned)(mword >> 32); const float mcur = mrun[cg]; float ls = 0.f;
#pragma unroll
              for (int sub = 0; sub < 4; ++sub)
#pragma unroll
                  for (int r = 0; r < 4; ++r) { const int keep = __builtin_amdgcn_sbfe((int)(sub < 2 ? mlo : mhi), 16 * (sub & 1) + r, 1);
                      const float p = __uint_as_float(__float_as_uint(__builtin_amdgcn_exp2f(lg[cg][sub][r] - mcur)) & (unsigned)keep); ls += p; lg[cg][sub][r] = p; }
              lrun[cg] += ls; }
          { const unsigned vaddr = ldsV + (unsigned)(buf * DS_BUF);
            asm volatile("ds_read_b64_tr_b16 %0, %16 offset:0\n\t"
                "ds_read_b64_tr_b16 %1, %16 offset:2304\n\t"
                "ds_read_b64_tr_b16 %2, %16 offset:32\n\t"
                "ds_read_b64_tr_b16 %3, %16 offset:2336\n\t"
                "ds_read_b64_tr_b16 %4, %16 offset:64\n\t"
                "ds_read_b64_tr_b16 %5, %16 offset:2368\n\t"
                "ds_read_b64_tr_b16 %6, %16 offset:96\n\t"
                "ds_read_b64_tr_b16 %7, %16 offset:2400\n\t"
                "ds_read_b64_tr_b16 %8, %16 offset:4608\n\t"
                "ds_read_b64_tr_b16 %9, %16 offset:6912\n\t"
                "ds_read_b64_tr_b16 %10, %16 offset:4640\n\t"
                "ds_read_b64_tr_b16 %11, %16 offset:6944\n\t"
                "ds_read_b64_tr_b16 %12, %16 offset:4672\n\t"
                "ds_read_b64_tr_b16 %13, %16 offset:6976\n\t"
                "ds_read_b64_tr_b16 %14, %16 offset:4704\n\t"
                "ds_read_b64_tr_b16 %15, %16 offset:7008\n\t"
                "s_waitcnt lgkmcnt(0)"
                : "=&v"(vt[0][0][0]), "=&v"(vt[0][0][1]), "=&v"(vt[0][1][0]), "=&v"(vt[0][1][1]), "=&v"(vt[0][2][0]), "=&v"(vt[0][2][1]), "=&v"(vt[0][3][0]), "=&v"(vt[0][3][1]), "=&v"(vt[1][0][0]), "=&v"(vt[1][0][1]), "=&v"(vt[1][1][0]), "=&v"(vt[1][1][1]), "=&v"(vt[1][2][0]), "=&v"(vt[1][2][1]), "=&v"(vt[1][3][0]), "=&v"(vt[1][3][1])
                : "v"(vaddr) : "memory"); }
#pragma unroll
          for (int ks2 = 0; ks2 < 2; ++ks2) { bf16x8 pb[2];
#pragma unroll
              for (int cg = 0; cg < 2; ++cg) { v4u pw; pw.x = cvtpk(lg[cg][2 * ks2][0], lg[cg][2 * ks2][1]); pw.y = cvtpk(lg[cg][2 * ks2][2], lg[cg][2 * ks2][3]);
                  pw.z = cvtpk(lg[cg][2 * ks2 + 1][0], lg[cg][2 * ks2 + 1][1]); pw.w = cvtpk(lg[cg][2 * ks2 + 1][2], lg[cg][2 * ks2 + 1][3]); pb[cg] = __builtin_bit_cast(bf16x8, pw); }
#pragma unroll
              for (int dt = 0; dt < 4; ++dt) { const bf16x8 va = __builtin_shufflevector(vt[ks2][dt][0], vt[ks2][dt][1], 0, 1, 2, 3, 4, 5, 6, 7);
#pragma unroll
                  for (int cg = 0; cg < 2; ++cg) O[cg][dt] = mfma16(va, pb[cg], O[cg][dt]); } }
          if (T + 1 < nt64) { *(LAS v4u*)(L + (buf ^ 1) * DS_BUF + skey * DS_TSTR + 16 * spiece) = kv; *(LAS v4u*)(L + (buf ^ 1) * DS_BUF + 9216 + skey * DS_TSTR + 16 * spiece) = vv; }
          kv = kn; vv = vn;
          __syncthreads();
      }
#pragma unroll
      for (int cg = 0; cg < 2; ++cg) { float v = lrun[cg]; v += __shfl_xor(v, 16); v += __shfl_xor(v, 32); const float inv = 1.0f / v;
          const int q = 4 * w + 2 * cg + (fr >> 3);
#pragma unroll
          for (int dt = 0; dt < 4; ++dt) { v2u o; o.x = cvtpk(O[cg][dt][0] * inv, O[cg][dt][1] * inv); o.y = cvtpk(O[cg][dt][2] * inv, O[cg][dt][3] * inv);
              *(v2u*)(YB + (size_t)(qrow0 + q) * 512 + hh * 64 + 16 * dt + 4 * kq) = o; } } }
}

__global__ void __launch_bounds__(NWAVES * 64, 2) mk_fwd(Args args) {
    extern __shared__ __attribute__((aligned(16))) unsigned char lds[];
    LAS unsigned char* L = (LAS unsigned char*)lds;
    volatile LAS unsigned* MISC = (volatile LAS unsigned*)(L + MISC_OFF);
    const int tid = threadIdx.x, lane = tid & 63, wave = __builtin_amdgcn_readfirstlane(tid >> 6);
    const int G = gridDim.x, bx = blockIdx.x;
    const int gw = bx * NWAVES + wave, NGW = G * NWAVES;
    unsigned char* ws = args.ws;
    if (tid < 32) MISC[tid] = 0u;
    __syncthreads();
    XcdBarrier bar; bar.bar = (unsigned*)(ws + WS_CTL) + CW_BAR; bar.x = 0; bar.st = nullptr;
    if (!MK_PER_PHASE) bar = xcd_barrier_post((unsigned*)(ws + WS_CTL) + CW_BAR, MISC + 8);
    const int lo = args.ph_lo, hi = args.ph_hi;
#define IN(k) (lo <= (k) && (k) < hi)
#define SEAM(k) do { if (IN(k) && IN((k) + 1)) xcd_barrier(bar); } while (0)
    bf16* WT1 = (bf16*)(ws + WS_WT1); bf16* WT2 = (bf16*)(ws + WS_WT2); bf16* WT3 = (bf16*)(ws + WS_WT3); bf16* WT4 = (bf16*)(ws + WS_WT4); bf16* WT5 = (bf16*)(ws + WS_WT5);
    bf16* WGLU = (bf16*)(ws + WS_WGLU); bf16* WA = (bf16*)(ws + WS_WA); bf16* WB = (bf16*)(ws + WS_WB); bf16* WOUT = (bf16*)(ws + WS_WOUT);
    bf16* HN = (bf16*)(ws + WS_HN); bf16* FB = (bf16*)(ws + WS_F); bf16* ACT = (bf16*)(ws + WS_BIG);
    bf16* PA = (bf16*)(ws + WS_PA); bf16* PG = (bf16*)(ws + WS_PG); bf16* PK = (bf16*)(ws + WS_PK);
    bf16* AM1 = (bf16*)(ws + WS_META + MO_AM1); bf16* ACTM = (bf16*)(ws + WS_META + MO_ACTM); bf16* FM = (bf16*)(ws + WS_META + MO_FM); bf16* AM2 = (bf16*)(ws + WS_META + MO_AM2);
    bf16* PMU = (bf16*)(ws + WS_META + MO_PMU); bf16* PMK = (bf16*)(ws + WS_META + MO_PMK);
    bf16* YA = FB; bf16* YG = HN; bf16* YB = HN + (size_t)R * 512; bf16* MERGED = PA;
    const float* x = args.in[0]; float* out = args.out;

    if (IN(0)) {
        for (int item = bx; item < 3 * 2048; item += G) s5_table_item(args, item, (LAS float*)(L + 140000), tid);
        __syncthreads();
        LAS float* scr = (LAS float*)(L + wave * 16384);
        for (int it = gw; it < 11520; it += NGW) {
            int r = it;
            if (r < 6 * 1408) { const int mat = r / 1408; r -= mat * 1408;
                if (mat == 2 || mat == 5) { const int kb = r / 32, nb = r % 32; transpose_item(args.in[mat == 2 ? 10 : 13], D, DFF, mat == 2 ? WT2 : WT5, 64 * kb, 32 * nb, 32 * nb + (lane & 31), scr, lane); }
                else { const int kb = r / 88, nb = r % 88, d0 = 32 * nb, up = (mat == 1 || mat == 4) ? 128 : 0;
                    transpose_item(args.in[mat == 0 ? 8 : mat == 1 ? 9 : mat == 3 ? 11 : 12], DFF, D, mat < 3 ? WT1 : WT4, 64 * kb, 256 * (d0 >> 7) + (d0 & 127) + up, d0 + (lane & 31), scr, lane); }
                continue; }
            r -= 6 * 1408;
            if (r < 1920) { const int kb = r / 120, nb = r % 120; transpose_item(args.in[14], 3784, D, WT3, 64 * kb, 32 * nb, win_srccol(32 * nb + (lane & 31)), scr, lane); continue; }
            r -= 1920;
            if (r < 128) { const int kb = r / 16, nb = r % 16; transpose_item(args.in[23], 512, 512, WGLU, 64 * kb, 32 * nb, 32 * nb + (lane & 31), scr, lane); continue; }
            r -= 128;
            if (r < 256) { const int kb = r / 32, nb = r % 32; transpose_item(args.in[24], D, 512, WA, 64 * kb, 32 * nb, 32 * nb + (lane & 31), scr, lane); continue; }
            r -= 256;
            if (r < 256) { const int kb = r / 32, nb = r % 32; transpose_item(args.in[26], D, 512, WB, 64 * kb, 32 * nb, 32 * nb + (lane & 31), scr, lane); continue; }
            r -= 256;
            { const int kb = r / 32, nb = r % 32; transpose_item(args.in[27], D, D, WOUT, 64 * kb, 32 * nb, 32 * nb + (lane & 31), scr, lane); }
        }
        for (int m = gw; m < R; m += NGW) norm_row_to_bf16(x + (size_t)m * D, args.in[2], HN + (size_t)m * D, lane);
        if (gw < NMETA) norm_row_to_bf16(args.in[1] + (size_t)gw * D, args.in[2], AM1 + (size_t)gw * D, lane);
    }
    SEAM(0);
    if (IN(1)) {
        if (gw < 176) { const int j0 = 16 * gw, grow = 256 * (j0 >> 7) + (j0 & 127); const f32x4 g4 = meta_tile(AM1, WT1 + (size_t)grow * D, D, lane), u4 = meta_tile(AM1, WT1 + (size_t)(grow + 128) * D, D, lane);
#pragma unroll
            for (int r = 0; r < 4; ++r) ACTM[(4 * (lane >> 4) + r) * DFF + j0 + (lane & 15)] = (bf16)f2bf(g4[r] * fsig(g4[r]) * u4[r]); }
        pg8::Gemm g{HN, WT1, R, 2 * DFF, D}; pg8::StaticOrder S; S.init(R, 2 * DFF, G, bx); pg8::EpiSwiglu E{ACT, DFF};
        pg8::gemm_phase<pg8::EpiSwiglu, pg8::StaticOrder, PG8_ALIGN, PG8_SP2>(L, g, S, E);
        if (REP_G1 > 1) pg8::gemm_phase<pg8::EpiSwiglu, pg8::StaticOrder, PG8_ALIGN, PG8_SP2>(L, g, S, E);
    }
    SEAM(1);
    if (IN(2)) {
        if (gw < 64) { const int n0 = 16 * gw; const f32x4 f4 = meta_tile(ACTM, WT2 + (size_t)n0 * DFF, DFF, lane);
#pragma unroll
            for (int r = 0; r < 4; ++r) FM[(4 * (lane >> 4) + r) * D + n0 + (lane & 15)] = (bf16)f2bf(f4[r]); }
        pg8::Gemm g{ACT, WT2, R, D, DFF}; pg8::StaticOrder S; S.init(R, D, G, bx); pg8::EpiPlain E{FB, D};
        pg8::gemm_phase<pg8::EpiPlain, pg8::StaticOrder, PG8_ALIGN, PG8_SP2>(L, g, S, E);
    }
    SEAM(2);
    if (IN(3)) {
        if (gw < NMETA) row_update(FM + (size_t)gw * D, args.in[1] + (size_t)gw * D, nullptr, AM2 + (size_t)gw * D, args.in[3], args.in[4], 0.5f, lane);
        for (int m = gw; m < R; m += NGW) row_update(FB + (size_t)m * D, x + (size_t)m * D, out + (size_t)m * D, HN + (size_t)m * D, args.in[3], args.in[4], 0.5f, lane);
    }
    SEAM(3);
    if (IN(4)) {
        if (gw < 44) { const int n0 = gw < 32 ? 16 * gw : 3584 + 16 * (gw - 32); const f32x4 p4 = meta_tile(AM2, WT3 + (size_t)n0 * D, D, lane);
#pragma unroll
            for (int r = 0; r < 4; ++r) { const int row = 4 * (lane >> 4) + r; if (gw < 32) PMU[row * 512 + n0 + (lane & 15)] = (bf16)f2bf(p4[r]); else PMK[row * 256 + (n0 - 3584) + (lane & 15)] = (bf16)f2bf(p4[r]); } }
        pg8::Gemm g{HN, WT3, R, 3840, D}; pg8::StaticOrder S; S.init(R, 3840, G, bx); pg8::EpiProj E{PA, PG, PK};
        pg8::gemm_phase<pg8::EpiProj, pg8::StaticOrder, PG8_ALIGN, PG8_SP2>(L, g, S, E);
    }
    SEAM(4);
    if (IN(5)) {
        for (int rep = 0; rep < REP_S5; ++rep) for (int i = 0; i < 2; ++i) s5_unit(args, L, 2 * (bx & 7) + i, bx >> 3, tid);
        __syncthreads();
        dsa_tables(args, L, tid);
        for (int i = 0; i < 4 * REP_DSA; ++i) { const int up = 4 * (bx >> 3) + (i & 3), u2 = up >> 1, b = 2 * (bx & 7) + (u2 >> 5), xq = u2 & 31; dsa_unit(args, L, b, (up & 1) ? 63 - xq : xq, tid); }
        __syncthreads();
    }
    SEAM(5);
    if (IN(6)) { pg8::Gemm g{YA, WGLU, R, 512, 512}; pg8::StaticOrder S; S.init(R, 512, G, bx); pg8::EpiGlu E{YA, YG};
        pg8::gemm_phase<pg8::EpiGlu, pg8::StaticOrder, PG8_ALIGN, PG8_SP2>(L, g, S, E); }
    SEAM(6);
    if (IN(7)) { pg8::Gemm g{YG, WA, R, D, 512}; pg8::StaticOrder S; S.init(R, D, G, bx); pg8::EpiMerge<false> E{PG, 0, nullptr, FB};
        pg8::gemm_phase<pg8::EpiMerge<false>, pg8::StaticOrder, PG8_ALIGN, PG8_SP2>(L, g, S, E); }
    SEAM(7);
    if (IN(8)) { pg8::Gemm g{YB, WB, R, D, 512}; pg8::StaticOrder S; S.init(R, D, G, bx); pg8::EpiMerge<true> E{PG, 1024, FB, MERGED};
        pg8::gemm_phase<pg8::EpiMerge<true>, pg8::StaticOrder, PG8_ALIGN, PG8_SP2>(L, g, S, E); }
    SEAM(8);
    if (IN(9)) { pg8::Gemm g{MERGED, WOUT, R, D, D}; pg8::StaticOrder S; S.init(R, D, G, bx); pg8::EpiPlain E{FB, D};
        pg8::gemm_phase<pg8::EpiPlain, pg8::StaticOrder, PG8_ALIGN, PG8_SP2>(L, g, S, E); }
    SEAM(9);
    if (IN(10)) { for (int m = gw; m < R; m += NGW) row_update(FB + (size_t)m * D, out + (size_t)m * D, out + (size_t)m * D, HN + (size_t)m * D, args.in[5], args.in[6], 1.0f, lane); }
    SEAM(10);
    if (IN(11)) { pg8::Gemm g{HN, WT4, R, 2 * DFF, D}; pg8::StaticOrder S; S.init(R, 2 * DFF, G, bx); pg8::EpiSwiglu E{ACT, DFF};
        pg8::gemm_phase<pg8::EpiSwiglu, pg8::StaticOrder, PG8_ALIGN, PG8_SP2>(L, g, S, E); }
    SEAM(11);
    if (IN(12)) { pg8::Gemm g{ACT, WT5, R, D, DFF}; pg8::StaticOrder S; S.init(R, D, G, bx); pg8::EpiPlain E{FB, D};
        pg8::gemm_phase<pg8::EpiPlain, pg8::StaticOrder, PG8_ALIGN, PG8_SP2>(L, g, S, E); }
    SEAM(12);
    if (IN(13)) { for (int m = gw; m < R; m += NGW) row_update(FB + (size_t)m * D, out + (size_t)m * D, out + (size_t)m * D, nullptr, args.in[7], args.in[7], 0.5f, lane); }
#undef IN
#undef SEAM
}

extern "C" void kernel_launch(void* const* d_in, const int* in_sizes, int n_in, void* d_out, int out_size, void* d_ws, size_t ws_size, hipStream_t stream) {
    static int grid = 0;
    if (grid == 0) {
        if (n_in != 28 || out_size != R * D || ws_size < WS_END) { fprintf(stderr, "kernel_launch: unexpected shapes (n_in %d, out %d, ws %zu); nothing launched\n", n_in, out_size, ws_size); grid = -1; return; }
        int dev = 0, cus = 0, per_cu = 0;
        if (hipGetDevice(&dev) != hipSuccess || hipDeviceGetAttribute(&cus, hipDeviceAttributeMultiprocessorCount, dev) != hipSuccess) { grid = -1; return; }
        if (hipFuncSetAttribute((const void*)mk_fwd, hipFuncAttributeMaxDynamicSharedMemorySize, LDS_BYTES) != hipSuccess) { fprintf(stderr, "kernel_launch: hipFuncSetAttribute failed\n"); grid = -1; return; }
        if (hipOccupancyMaxActiveBlocksPerMultiprocessor(&per_cu, (const void*)mk_fwd, NWAVES * 64, LDS_BYTES) != hipSuccess || per_cu < 1) fprintf(stderr, "kernel_launch: note: occupancy query reports %d\n", per_cu);
        (void)hipGetLastError();
        grid = cus;
    }
    if (grid < 0) return;
    if (hipMemsetAsync((char*)d_ws + WS_CTL, 0, CTL_ZERO_BYTES, stream) != hipSuccess) return;
    Args a{};
    for (int i = 0; i < 28; ++i) a.in[i] = (const float*)d_in[i];
    a.out = (float*)d_out; a.ws = (unsigned char*)d_ws;
#if MK_PER_PHASE
    for (int ph = 0; ph < NPH; ++ph) { a.ph_lo = ph; a.ph_hi = ph + 1; hipLaunchKernelGGL(mk_fwd, dim3(grid), dim3(NWAVES * 64), LDS_BYTES, stream, a); }
#else
    a.ph_lo = 0; a.ph_hi = NPH;
    hipLaunchKernelGGL(mk_fwd, dim3(grid), dim3(NWAVES * 64), LDS_BYTES, stream, a);
#endif
}
```

```cpp
#include <hip/hip_runtime.h>
#include <cstdio>
#include <cstdint>
namespace pg8 {
#define PG8_LAS __attribute__((address_space(3)))
typedef unsigned short bf16_t;
typedef short bf16x8 __attribute__((ext_vector_type(8)));
typedef float f32x4 __attribute__((ext_vector_type(4)));
typedef unsigned u32x4 __attribute__((ext_vector_type(4)));
constexpr int BM = 256, BK = 64, HALF = 128, HTB = HALF * BK * 2  , STAGE_BYTES = 8 * HTB, NXCD = 8, WGM = 8;

__host__ __device__ __forceinline__ int lds_byte(int r, int c) { const int st = (r >> 4) * 2 + (c >> 5), rr = r & 15, cc = c & 31, ob = rr * 64 + cc * 2; return st * 1024 + (ob ^ (((ob >> 9) & 1) << 5)); }
__host__ __device__ __forceinline__ void stage_rc(int b, int& R, int& C) { const int st = b / 1024, sb = b % 1024, swz = sb ^ (((sb >> 9) & 1) << 5); R = (st >> 1) * 16 + swz / 64; C = (st & 1) * 32 + (swz % 64) / 2; }
__host__ __device__ __forceinline__ int perm32(int rho) { const int n = rho >> 4, i = rho & 15; return 8 * (i >> 2) + 4 * n + (i & 3); }

struct Unit { int pm, pn; };
struct Gemm { const bf16_t* A; const bf16_t* Bt; int M, N, K; };

struct StaticOrder {
    int nM, nN, nwg, G, c;
    __host__ __device__ void init(int M, int N, int G_, int c_) { nM = M / BM; nN = N / BM; nwg = nM * nN; G = G_; c = c_; }
    __host__ __device__ bool next(int i, Unit& u) const {
        const long L = (long)i * G + c; if (L >= nwg) return false;
        int wgid = (int)L; { const int q = nwg / NXCD, r = nwg % NXCD, xcd = wgid % NXCD, off = wgid / NXCD; wgid = (xcd < r ? xcd * (q + 1) : r * (q + 1) + (xcd - r) * q) + off; }
        const int nig = WGM * nN, gid = wgid / nig, fm = gid * WGM, gsz = (nM - fm) < WGM ? (nM - fm) : WGM;
        u.pm = fm + ((wgid % nig) % gsz); u.pn = (wgid % nig) / gsz; return true;
    }
    __device__ __forceinline__ void a_ready(const Unit&) const {}
    __device__ __forceinline__ void done(const Unit&) const {}
};
__device__ __forceinline__ unsigned cvt_pk_bf16(float lo, float hi) { unsigned r; asm volatile("v_cvt_pk_bf16_f32 %0, %1, %2" : "=v"(r) : "v"(lo), "v"(hi)); return r; }
__device__ __forceinline__ float fsigmoid(float x) { return __builtin_amdgcn_rcpf(1.0f + __expf(-x)); }
__device__ __forceinline__ float bf_lo(unsigned w) { return __uint_as_float(w << 16); }
__device__ __forceinline__ float bf_hi(unsigned w) { return __uint_as_float(w & 0xffff0000u); }
__device__ __forceinline__ u32x4 pack8(const f32x4 v0, const f32x4 v1) { u32x4 w; w.x = cvt_pk_bf16(v0[0], v0[1]); w.y = cvt_pk_bf16(v0[2], v0[3]); w.z = cvt_pk_bf16(v1[0], v1[1]); w.w = cvt_pk_bf16(v1[2], v1[3]); return w; }
__device__ __forceinline__ void unpack8(const u32x4 w, f32x4& v0, f32x4& v1) { v0 = (f32x4){bf_lo(w.x), bf_hi(w.x), bf_lo(w.y), bf_hi(w.y)}; v1 = (f32x4){bf_lo(w.z), bf_hi(w.z), bf_lo(w.w), bf_hi(w.w)}; }

struct EpiSwiglu {
    static constexpr bool PERM = true, AFTER_DRAIN = false;
    bf16_t* O; int ldc;
    __device__ __forceinline__ void operator()(const f32x4 (&acc)[2][2][4][2], const Unit& u, int wr, int wc, int fr, int fq) const {
        const int row0 = u.pm * BM + wr * 64 + fr, col0 = u.pn * HALF + wc * 32 + 8 * fq;
#pragma unroll
        for (int ai = 0; ai < 2; ++ai)
#pragma unroll
            for (int m = 0; m < 4; ++m) { bf16_t* rowp = O + (size_t)(row0 + ai * HALF + m * 16) * ldc + col0;
                f32x4 v0, v1;
#pragma unroll
                for (int j = 0; j < 4; ++j) { const float g0 = acc[ai][0][m][0][j], g1 = acc[ai][0][m][1][j];
                    v0[j] = g0 * fsigmoid(g0) * acc[ai][1][m][0][j]; v1[j] = g1 * fsigmoid(g1) * acc[ai][1][m][1][j]; }
                *(u32x4*)rowp = pack8(v0, v1); }
    }
};
struct EpiPlain {
    static constexpr bool PERM = true, AFTER_DRAIN = false;
    bf16_t* O; int ldc;
    __device__ __forceinline__ void operator()(const f32x4 (&acc)[2][2][4][2], const Unit& u, int wr, int wc, int fr, int fq) const {
        const int row0 = u.pm * BM + wr * 64 + fr, col0 = u.pn * BM + wc * 32 + 8 * fq;
#pragma unroll
        for (int ai = 0; ai < 2; ++ai)
#pragma unroll
            for (int m = 0; m < 4; ++m) { bf16_t* rowp = O + (size_t)(row0 + ai * HALF + m * 16) * ldc + col0;
#pragma unroll
                for (int bj = 0; bj < 2; ++bj) *(u32x4*)(rowp + bj * HALF) = pack8(acc[ai][bj][m][0], acc[ai][bj][m][1]); }
    }
};

__device__ __forceinline__ unsigned pk4_fp8(float a, float b, float c, float d) { int w = 0; w = __builtin_amdgcn_cvt_pk_fp8_f32(fminf(fmaxf(a, -448.f), 448.f), fminf(fmaxf(b, -448.f), 448.f), w, false);
    w = __builtin_amdgcn_cvt_pk_fp8_f32(fminf(fmaxf(c, -448.f), 448.f), fminf(fmaxf(d, -448.f), 448.f), w, true); return (unsigned)w; }
struct EpiSwiglu8 {
    static constexpr bool PERM = true, AFTER_DRAIN = false;
    unsigned char* O; int ldc; float ascale, oscale;
    __device__ __forceinline__ void operator()(const f32x4 (&acc)[2][2][4][2], const Unit& u, int wr, int wc, int fr, int fq) const {
        const int row0 = u.pm * BM + wr * 64 + fr, col0 = u.pn * HALF + wc * 32 + 8 * fq;
#pragma unroll
        for (int ai = 0; ai < 2; ++ai)
#pragma unroll
            for (int m = 0; m < 4; ++m) { unsigned char* rowp = O + (size_t)(row0 + ai * HALF + m * 16) * ldc + col0;
                f32x4 v0, v1;
#pragma unroll
                for (int j = 0; j < 4; ++j) { const float g0 = acc[ai][0][m][0][j] * ascale, g1 = acc[ai][0][m][1][j] * ascale;
                    v0[j] = g0 * fsigmoid(g0) * (acc[ai][1][m][0][j] * ascale) * oscale; v1[j] = g1 * fsigmoid(g1) * (acc[ai][1][m][1][j] * ascale) * oscale; }
                typedef unsigned u32x2 __attribute__((ext_vector_type(2))); u32x2 w; w.x = pk4_fp8(v0[0], v0[1], v0[2], v0[3]); w.y = pk4_fp8(v1[0], v1[1], v1[2], v1[3]);
                *(u32x2*)rowp = w; }
    }
};
struct EpiPlainS {
    static constexpr bool PERM = true, AFTER_DRAIN = false;
    bf16_t* O; int ldc; float scale;
    __device__ __forceinline__ void operator()(const f32x4 (&acc)[2][2][4][2], const Unit& u, int wr, int wc, int fr, int fq) const {
        const int row0 = u.pm * BM + wr * 64 + fr, col0 = u.pn * BM + wc * 32 + 8 * fq;
#pragma unroll
        for (int ai = 0; ai < 2; ++ai)
#pragma unroll
            for (int m = 0; m < 4; ++m) { bf16_t* rowp = O + (size_t)(row0 + ai * HALF + m * 16) * ldc + col0;
#pragma unroll
                for (int bj = 0; bj < 2; ++bj) *(u32x4*)(rowp + bj * HALF) = pack8(acc[ai][bj][m][0] * scale, acc[ai][bj][m][1] * scale); }
    }
};
struct EpiProj {
    static constexpr bool PERM = true, AFTER_DRAIN = false;
    bf16_t *PA, *PG, *PK, *UA2;
    __device__ __forceinline__ void operator()(const f32x4 (&acc)[2][2][4][2], const Unit& u, int wr, int wc, int fr, int fq) const {
        if (u.pn < 2) {
#pragma unroll
            for (int ai = 0; ai < 2; ++ai)
#pragma unroll
                for (int m = 0; m < 4; ++m) { const int row = u.pm * BM + wr * 64 + fr + ai * HALF + m * 16, bb = row >> 11, t = row & 2047;
#pragma unroll
                    for (int bj = 0; bj < 2; ++bj) { const int col = 256 * u.pn + 128 * bj + wc * 32 + 8 * fq;
                        *(u32x4*)(UA2 + ((size_t)((bb * 32 + (col >> 4)) * 2048 + t)) * 16 + (col & 8)) = pack8(acc[ai][bj][m][0], acc[ai][bj][m][1]); } }
            return; }
        bf16_t* base; int ldc, colt;
        if (u.pn < 6) { base = PA; ldc = 1536; colt = 256 * u.pn; } else if (u.pn < 14) { base = PG; ldc = 2048; colt = 256 * (u.pn - 6); } else { base = PK; ldc = 256; colt = 0; }
        const int row0 = u.pm * BM + wr * 64 + fr, col0 = colt + wc * 32 + 8 * fq;
#pragma unroll
        for (int ai = 0; ai < 2; ++ai)
#pragma unroll
            for (int m = 0; m < 4; ++m) { bf16_t* rowp = base + (size_t)(row0 + ai * HALF + m * 16) * ldc + col0;
#pragma unroll
                for (int bj = 0; bj < 2; ++bj) *(u32x4*)(rowp + bj * HALF) = pack8(acc[ai][bj][m][0], acc[ai][bj][m][1]); }
    }
};
struct EpiGlu {
    static constexpr bool PERM = true, AFTER_DRAIN = false;
    const bf16_t* Y; bf16_t* O;
    __device__ __forceinline__ void operator()(const f32x4 (&acc)[2][2][4][2], const Unit& u, int wr, int wc, int fr, int fq) const {
        const int row0 = u.pm * BM + wr * 64 + fr, col0 = u.pn * BM + wc * 32 + 8 * fq;
#pragma unroll
        for (int ai = 0; ai < 2; ++ai)
#pragma unroll
            for (int m = 0; m < 4; ++m) { const size_t off = (size_t)(row0 + ai * HALF + m * 16) * 512 + col0;
#pragma unroll
                for (int bj = 0; bj < 2; ++bj) { f32x4 y0, y1; unpack8(*(const u32x4*)(Y + off + bj * HALF), y0, y1); f32x4 v0, v1;
#pragma unroll
                    for (int j = 0; j < 4; ++j) { v0[j] = y0[j] * fsigmoid(acc[ai][bj][m][0][j]); v1[j] = y1[j] * fsigmoid(acc[ai][bj][m][1][j]); }
                    *(u32x4*)(O + off + bj * HALF) = pack8(v0, v1); } }
    }
};
template <bool SECOND> struct EpiMerge {
    static constexpr bool PERM = true, AFTER_DRAIN = false;
    const bf16_t* G; int goff; const bf16_t* T; bf16_t* O;
    __device__ __forceinline__ void operator()(const f32x4 (&acc)[2][2][4][2], const Unit& u, int wr, int wc, int fr, int fq) const {
        const int row0 = u.pm * BM + wr * 64 + fr, col0 = u.pn * BM + wc * 32 + 8 * fq;
#pragma unroll
        for (int ai = 0; ai < 2; ++ai)
#pragma unroll
            for (int m = 0; m < 4; ++m) { const size_t row = (size_t)(row0 + ai * HALF + m * 16);
#pragma unroll
                for (int bj = 0; bj < 2; ++bj) { const int col = col0 + bj * HALF; f32x4 g0, g1; unpack8(*(const u32x4*)(G + row * 2048 + goff + col), g0, g1);
                    f32x4 t0 = (f32x4){0.f, 0.f, 0.f, 0.f}, t1 = t0; if (SECOND) unpack8(*(const u32x4*)(T + row * 1024 + col), t0, t1);
                    f32x4 v0, v1;
#pragma unroll
                    for (int j = 0; j < 4; ++j) { v0[j] = t0[j] + fsigmoid(g0[j]) * acc[ai][bj][m][0][j]; v1[j] = t1[j] + fsigmoid(g1[j]) * acc[ai][bj][m][1][j]; }
                    *(u32x4*)(O + row * 1024 + col) = pack8(v0, v1); } }
    }
};
typedef int i32x8 __attribute__((ext_vector_type(8)));
typedef int i32x4v __attribute__((ext_vector_type(4)));
__device__ __forceinline__ i32x8 cat8(const bf16x8 lo, const bf16x8 hi) { const i32x4v a = __builtin_bit_cast(i32x4v, lo), b = __builtin_bit_cast(i32x4v, hi); return __builtin_shufflevector(a, b, 0, 1, 2, 3, 4, 5, 6, 7); }
template <class Epi, class Sched, bool ALIGN_EPI = false, bool SP2 = false, bool F8 = false>
__device__ __forceinline__ void gemm_phase(PG8_LAS unsigned char* lds, const Gemm g, const Sched& S, const Epi& E) {
    const int tid = threadIdx.x, wid = __builtin_amdgcn_readfirstlane(tid >> 6), lane = tid & 63, wr = wid >> 2, wc = wid & 3, fr = lane & 15, fq = lane >> 4;
    const int K = g.K, KB = F8 ? K : 2 * K  , nt = KB / 128;
    unsigned voffA[2], voffB[2];
#pragma unroll
    for (int i = 0; i < 2; ++i) { int R, C; stage_rc(tid * 16 + i * 8192, R, C); const int Rb = Epi::PERM ? ((R & ~31) + perm32(R & 31)) : R;
        voffA[i] = (unsigned)(R * KB + C * 2); voffB[i] = (unsigned)(Rb * KB + C * 2); }
    const size_t kstep = (size_t)(BK * 2);
    const size_t hstep = (size_t)HALF * KB;
    const size_t tstep = 2 * hstep;
    const unsigned ldsw = (unsigned)wid * 1024u;
    const int aoff = lds_byte(wr * 64 + fr, fq * 8), boff = lds_byte(wc * 32 + fr, fq * 8);
#define PG8_SA(b, h) (((b) * 2 + (h)) * HTB)
#define PG8_SB(b, h) ((4 + (b) * 2 + (h)) * HTB)
#define PG8_STAGE(bufoff, gbase, voff) do { _Pragma("unroll") for (int _i = 0; _i < 2; ++_i) \
        __builtin_amdgcn_global_load_lds((const unsigned*)((const char*)(gbase) + (voff)[_i]), (PG8_LAS unsigned*)(lds + (bufoff) + ldsw + _i * 8192), 16, 0, 0); } while (0)
#define PG8_LDA(dst, b, h) do { if constexpr (F8) { _Pragma("unroll") for (int m = 0; m < 4; ++m) dst##8[m] = cat8(*(const PG8_LAS bf16x8*)(lds + PG8_SA(b, h) + aoff + m * 2048), *(const PG8_LAS bf16x8*)(lds + PG8_SA(b, h) + aoff + m * 2048 + 1024)); } else { \
        _Pragma("unroll") for (int m = 0; m < 4; ++m) _Pragma("unroll") for (int k = 0; k < 2; ++k) dst[m][k] = *(const PG8_LAS bf16x8*)(lds + PG8_SA(b, h) + aoff + m * 2048 + k * 1024); } } while (0)
#define PG8_LDB(dst, b, h) do { if constexpr (F8) { _Pragma("unroll") for (int n = 0; n < 2; ++n) dst##8[n] = cat8(*(const PG8_LAS bf16x8*)(lds + PG8_SB(b, h) + boff + n * 2048), *(const PG8_LAS bf16x8*)(lds + PG8_SB(b, h) + boff + n * 2048 + 1024)); } else { \
        _Pragma("unroll") for (int n = 0; n < 2; ++n) _Pragma("unroll") for (int k = 0; k < 2; ++k) dst[n][k] = *(const PG8_LAS bf16x8*)(lds + PG8_SB(b, h) + boff + n * 2048 + k * 1024); } } while (0)
#define PG8_MMA(ai, bj, At, Bt) do { __builtin_amdgcn_s_setprio(1); if constexpr (F8) { _Pragma("unroll") for (int m = 0; m < 4; ++m) _Pragma("unroll") for (int n = 0; n < 2; ++n) \
        acc[ai][bj][m][n] = __builtin_amdgcn_mfma_scale_f32_16x16x128_f8f6f4(Bt##8[n], At##8[m], acc[ai][bj][m][n], 0, 0, 0, 0x7F7F7F7F, 0, 0x7F7F7F7F); \
        _Pragma("unroll") for (int m = 0; m < 4; ++m) _Pragma("unroll") for (int n = 0; n < 2; ++n) asm volatile("" : "+v"(acc[ai][bj][m][n])); } else { \
        _Pragma("unroll") for (int m = 0; m < 4; ++m) _Pragma("unroll") for (int n = 0; n < 2; ++n) _Pragma("unroll") for (int k = 0; k < 2; ++k) \
        acc[ai][bj][m][n] = __builtin_amdgcn_mfma_f32_16x16x32_bf16(Bt[n][k], At[m][k], acc[ai][bj][m][n], 0, 0, 0); } __builtin_amdgcn_s_setprio(0); } while (0)
#define PG8_WAIT_V(n) asm volatile("s_waitcnt vmcnt(" #n ")" ::: "memory")
#define PG8_WAIT_L(n) asm volatile("s_waitcnt lgkmcnt(" #n ")" ::: "memory")
#define PG8_BAR __builtin_amdgcn_s_barrier()
#define PG8_SCHED __builtin_amdgcn_sched_barrier(0)
    Unit cur, nxt; int ui = 0;
    if (!S.next(0, cur)) return;
    f32x4 acc[2][2][4][2];
#pragma unroll
    for (int a = 0; a < 2; ++a)
#pragma unroll
        for (int b = 0; b < 2; ++b)
#pragma unroll
            for (int m = 0; m < 4; ++m)
#pragma unroll
                for (int n = 0; n < 2; ++n) acc[a][b][m][n] = (f32x4){0.f, 0.f, 0.f, 0.f};
    bf16x8 At[4][2], B0[2][2], B1[2][2]; i32x8 At8[4], B08[2], B18[2];
    const char* cA = (const char*)g.A + (size_t)cur.pm * tstep; const char* cB = (const char*)g.Bt + (size_t)cur.pn * tstep;
    S.a_ready(cur);
    if constexpr (SP2) {
        PG8_STAGE(PG8_SB(0, 0), cB, voffB); PG8_STAGE(PG8_SB(0, 1), cB + hstep, voffB); PG8_STAGE(PG8_SA(0, 0), cA, voffA); PG8_STAGE(PG8_SA(0, 1), cA + hstep, voffA);
        if (wr == 1) PG8_BAR;
        PG8_WAIT_V(2); PG8_BAR;
        PG8_STAGE(PG8_SB(1, 0), cB + kstep, voffB); PG8_STAGE(PG8_SA(1, 0), cA + kstep, voffA); PG8_STAGE(PG8_SB(1, 1), cB + hstep + kstep, voffB);
        PG8_WAIT_V(6); PG8_BAR;
    } else {
        PG8_STAGE(PG8_SB(0, 0), cB, voffB); PG8_STAGE(PG8_SA(0, 0), cA, voffA); PG8_STAGE(PG8_SB(0, 1), cB + hstep, voffB); PG8_STAGE(PG8_SA(0, 1), cA + hstep, voffA);
        if (wr == 1) PG8_BAR;
        PG8_WAIT_V(4); PG8_BAR;
        PG8_STAGE(PG8_SB(1, 0), cB + kstep, voffB); PG8_STAGE(PG8_SA(1, 0), cA + kstep, voffA); PG8_STAGE(PG8_SB(1, 1), cB + hstep + kstep, voffB);
        PG8_WAIT_V(6); PG8_BAR;
    }
    for (;;) {
        const bool has_next = S.next(ui + 1, nxt);
        const char* nA = has_next ? (const char*)g.A + (size_t)nxt.pm * tstep : cA; const char* nB = has_next ? (const char*)g.Bt + (size_t)nxt.pn * tstep : cB;
        for (int t = 0; t < nt; t += 2) {
            const bool last = (t == nt - 2);
            const char* a1 = cA + (size_t)(t + 1) * kstep;
            const char* a2 = last ? nA : cA + (size_t)(t + 2) * kstep; const char* b2 = last ? nB : cB + (size_t)(t + 2) * kstep;
            const char* a3 = a2 + kstep; const char* b3 = b2 + kstep;
            if (last && has_next) S.a_ready(nxt);
            if constexpr (SP2) {
            PG8_LDB(B0, 0, 0); PG8_LDB(B1, 0, 1); PG8_SCHED; PG8_LDA(At, 0, 0); PG8_STAGE(PG8_SA(1, 1), a1 + hstep, voffA);
            PG8_WAIT_V(8); PG8_WAIT_L(0); PG8_BAR; PG8_MMA(0, 0, At, B0); PG8_MMA(0, 1, At, B1); PG8_BAR; PG8_SCHED;
            PG8_LDA(At, 0, 1); PG8_STAGE(PG8_SB(0, 0), b2, voffB); PG8_STAGE(PG8_SB(0, 1), b2 + hstep, voffB); PG8_STAGE(PG8_SA(0, 0), a2, voffA);
            PG8_WAIT_V(8); PG8_WAIT_L(0); PG8_BAR; PG8_MMA(1, 0, At, B0); PG8_MMA(1, 1, At, B1); PG8_BAR; PG8_SCHED;
            PG8_LDB(B0, 1, 0); PG8_LDB(B1, 1, 1); PG8_SCHED; PG8_LDA(At, 1, 0); PG8_STAGE(PG8_SA(0, 1), a2 + hstep, voffA);
            PG8_WAIT_V(8); PG8_WAIT_L(0); PG8_BAR; PG8_MMA(0, 0, At, B0); PG8_MMA(0, 1, At, B1); PG8_BAR; PG8_SCHED;
            PG8_LDA(At, 1, 1); PG8_STAGE(PG8_SB(1, 0), b3, voffB); PG8_STAGE(PG8_SB(1, 1), b3 + hstep, voffB); PG8_STAGE(PG8_SA(1, 0), a3, voffA);
            PG8_WAIT_V(8); PG8_WAIT_L(0); PG8_BAR; PG8_MMA(1, 0, At, B0); PG8_MMA(1, 1, At, B1); PG8_BAR; PG8_SCHED;
            } else {
            PG8_LDB(B0, 0, 0); PG8_SCHED; PG8_LDA(At, 0, 0); PG8_STAGE(PG8_SA(1, 1), a1 + hstep, voffA);
            PG8_WAIT_L(8); PG8_BAR; PG8_WAIT_L(0); PG8_MMA(0, 0, At, B0); PG8_BAR; PG8_SCHED;
            PG8_LDB(B1, 0, 1); PG8_STAGE(PG8_SB(0, 0), b2, voffB);
            PG8_BAR; PG8_WAIT_L(0); PG8_MMA(0, 1, At, B1); PG8_BAR;
            PG8_LDA(At, 0, 1); PG8_STAGE(PG8_SA(0, 0), a2, voffA);
            PG8_BAR; PG8_WAIT_L(0); PG8_MMA(1, 0, At, B0); PG8_BAR; PG8_SCHED;
            PG8_STAGE(PG8_SB(0, 1), b2 + hstep, voffB);
            PG8_WAIT_V(6); PG8_BAR; PG8_MMA(1, 1, At, B1); PG8_BAR;
            PG8_LDB(B0, 1, 0); PG8_SCHED; PG8_LDA(At, 1, 0); PG8_STAGE(PG8_SA(0, 1), a2 + hstep, voffA);
            PG8_WAIT_L(8); PG8_BAR; PG8_WAIT_L(0); PG8_MMA(0, 0, At, B0); PG8_BAR; PG8_SCHED;
            PG8_LDB(B1, 1, 1); PG8_STAGE(PG8_SB(1, 0), b3, voffB);
            PG8_BAR; PG8_WAIT_L(0); PG8_MMA(0, 1, At, B1); PG8_BAR;
            PG8_LDA(At, 1, 1); PG8_STAGE(PG8_SA(1, 0), a3, voffA);
            PG8_BAR; PG8_WAIT_L(0); PG8_MMA(1, 0, At, B0); PG8_BAR; PG8_SCHED;
            PG8_STAGE(PG8_SB(1, 1), b3 + hstep, voffB);
            PG8_WAIT_V(6); PG8_BAR; PG8_MMA(1, 1, At, B1); PG8_BAR;
            }
        }
        if constexpr (ALIGN_EPI) { if (wr == 0) PG8_BAR; }
        if constexpr (!Epi::AFTER_DRAIN) { E(acc, cur, wr, wc, fr, fq); S.done(cur); }
        if (!has_next) break;
#pragma unroll
        for (int a = 0; a < 2; ++a)
#pragma unroll
            for (int b = 0; b < 2; ++b)
#pragma unroll
                for (int m = 0; m < 4; ++m)
#pragma unroll
                    for (int n = 0; n < 2; ++n) acc[a][b][m][n] = (f32x4){0.f, 0.f, 0.f, 0.f};
        cur = nxt; cA = nA; cB = nB; ++ui;
        if constexpr (ALIGN_EPI) { if (wr == 1) PG8_BAR; }
    }
    PG8_WAIT_V(0);
    if constexpr (!ALIGN_EPI) { if (wr == 0) PG8_BAR; }
    PG8_BAR;
    if constexpr (Epi::AFTER_DRAIN) { E.fused(acc, cur, wr, wc, fr, fq, lds, wid, lane); S.done(cur); }
#undef PG8_SA
#undef PG8_SB
#undef PG8_STAGE
#undef PG8_LDA
#undef PG8_LDB
#undef PG8_MMA
#undef PG8_WAIT_V
#undef PG8_WAIT_L
#undef PG8_BAR
#undef PG8_SCHED
}
}
#ifndef PG8_SP2
#define PG8_SP2 true
#endif
#ifndef PG8_ALIGN
#define PG8_ALIGN true
#endif
#ifndef MK_PER_PHASE
#define MK_PER_PHASE 0
#endif
#ifndef REP_S5
#define REP_S5 1
#endif
#ifndef REP_DSA
#define REP_DSA 1
#endif
#ifndef REP_G1
#define REP_G1 1
#endif
constexpr int NWAVES = 8;
constexpr int NPH = 14;

constexpr int NB = 16, SEQ = 2048, D = 1024, NMETA = 16, DFF = 2816;
constexpr int R = NB * SEQ;
constexpr int NG = 32, NP = 64, NM = 16;
constexpr float RMS_EPS = 1e-6f;

constexpr size_t MiB = 1u << 20;
constexpr size_t WS_CTL = 0, CTL_ZERO_BYTES = 1 * MiB;
constexpr size_t WS_WT1 = 2 * MiB, WS_WT2 = 13 * MiB, WS_WT3 = 19 * MiB, WS_WT4 = 27 * MiB, WS_WT5 = 38 * MiB;
constexpr size_t WS_WGLU = 44 * MiB, WS_WA = 45 * MiB, WS_WB = 46 * MiB, WS_WOUT = 47 * MiB;
constexpr size_t WS_KS = 50 * MiB, WS_KO = 58 * MiB, WS_KI = 66 * MiB;
constexpr size_t WS_META = 67 * MiB;
constexpr size_t MO_AM1 = 0, MO_ACTM = 32768, MO_FM = 131072, MO_AM2 = 262144, MO_PMU = 294912, MO_PMK = 311296;
constexpr size_t WS_HN = 68 * MiB;
constexpr size_t WS_F = 132 * MiB;
constexpr size_t WS_BIG = 196 * MiB;
constexpr size_t WS_PA = WS_BIG, WS_PG = WS_BIG + 96 * MiB, WS_PK = WS_BIG + 224 * MiB, WS_HB = WS_BIG + 240 * MiB  , WS_END = WS_BIG + 304 * MiB;
constexpr size_t WS_UA2 = WS_F + 32 * MiB;
constexpr int CW_BAR = 4096;

constexpr int LDS_BYTES = 155648;
constexpr int MISC_OFF = 154624;

#define GAS __attribute__((address_space(1)))
#define LAS __attribute__((address_space(3)))
typedef unsigned short bf16;
typedef unsigned v4u __attribute__((ext_vector_type(4)));
typedef unsigned v2u __attribute__((ext_vector_type(2)));
typedef float f32x4 __attribute__((ext_vector_type(4)));
typedef short bf16x8 __attribute__((ext_vector_type(8)));
#define LDS_WAIT() asm volatile("s_waitcnt lgkmcnt(0)" ::: "memory")
#define VM_WAIT() asm volatile("s_waitcnt vmcnt(0)" ::: "memory")
__device__ __forceinline__ unsigned f2bf(float f) { unsigned u = __builtin_bit_cast(unsigned, f); return (u + 0x7fffu + ((u >> 16) & 1u)) >> 16; }
__device__ __forceinline__ unsigned pk2(float lo, float hi) { return f2bf(lo) | (f2bf(hi) << 16); }
__device__ __forceinline__ float bflo(unsigned w) { return __uint_as_float(w << 16); }
__device__ __forceinline__ float bfhi(unsigned w) { return __uint_as_float(w & 0xffff0000u); }
__device__ __forceinline__ float bf2f(bf16 v) { return __uint_as_float(((unsigned)v) << 16); }
__device__ __forceinline__ float fsig(float x) { return __builtin_amdgcn_rcpf(1.0f + __expf(-x)); }

#define XB_TMO      128
#define XB_XCNT(j)  (256  + 64 * (j))
#define XB_XSUB(j)  (1280 + 64 * (j))
#define XB_XGEN(j)  (2304 + 64 * (j))
#define XB_TOP      3328
#define XB_TOPGEN   3392
#define XCD_BAR_WORDS 3456
#define XB_SPIN_CAP (1u << 18)
__device__ __forceinline__ unsigned xb_ld(unsigned* p)              { return __hip_atomic_load(p, __ATOMIC_RELAXED, __HIP_MEMORY_SCOPE_AGENT); }
__device__ __forceinline__ unsigned xb_add(unsigned* p, unsigned v) { return __hip_atomic_fetch_add(p, v, __ATOMIC_RELAXED, __HIP_MEMORY_SCOPE_AGENT); }
__device__ __forceinline__ unsigned xb_xcc_id() { return (unsigned)__builtin_amdgcn_s_getreg((3 << 11) | 20) & 0xFu; }
#define XB_SPIN(cond, bar) do { unsigned _sp = 0; while (cond) { __builtin_amdgcn_s_sleep(1); \
    if ((++_sp & 255u) == 0u) { if (xb_ld(&(bar)[XB_TMO])) break; if (_sp > XB_SPIN_CAP) { atomicAdd(&(bar)[XB_TMO], 1u); break; } } } } while (0)
struct XcdBarrier { unsigned* bar; unsigned x; volatile LAS unsigned* st; };
__device__ __forceinline__ XcdBarrier xcd_barrier_post(unsigned* bar, volatile LAS unsigned* st) {
    XcdBarrier b; b.bar = bar; b.x = xb_xcc_id(); b.st = st;
    if (threadIdx.x == 0) (void)xb_add(&bar[XB_XCNT(b.x)], 1u);
    return b;
}
__device__ __forceinline__ void xcd_barrier_complete(unsigned* bar, unsigned x, unsigned& nloc, unsigned& nx) {
    const unsigned G = gridDim.x * gridDim.y * gridDim.z;
    unsigned sum, cnt, mine, sp = 0u;
    for (;;) {
        sum = 0u; cnt = 0u; mine = 0u;
#pragma unroll
        for (unsigned j = 0; j < 16; ++j) { const unsigned c = xb_ld(&bar[XB_XCNT(j)]); sum += c; cnt += (c > 0u) ? 1u : 0u; mine = (j == x) ? c : mine; }
        if (sum == G) break;
        __builtin_amdgcn_s_sleep(1);
        if ((++sp & 255u) == 0u) { if (xb_ld(&bar[XB_TMO])) break; if (sp > XB_SPIN_CAP) { atomicAdd(&bar[XB_TMO], 1u); break; } }
    }
    nloc = mine > 0u ? mine : 1u; nx = cnt > 0u ? cnt : 1u;
}
__device__ __forceinline__ void xcd_barrier(const XcdBarrier& b) {
    asm volatile("s_waitcnt vmcnt(0)" ::: "memory");
    __syncthreads();
    if (threadIdx.x == 0) {
        unsigned* bar = b.bar;
        __builtin_amdgcn_s_waitcnt(0);
        unsigned nloc = b.st[0], nx = b.st[1];
        if (nloc == 0u) { xcd_barrier_complete(bar, b.x, nloc, nx); b.st[0] = nloc; b.st[1] = nx; }
        const unsigned old = xb_add(&bar[XB_XSUB(b.x)], 1u);
        const unsigned gen = old / nloc;
        if (old + 1u == (gen + 1u) * nloc) {
            __builtin_amdgcn_fence(__ATOMIC_RELEASE, "agent");
            asm volatile("s_waitcnt vmcnt(0)" ::: "memory");
            const unsigned og = xb_add(&bar[XB_TOP], 1u);
            const unsigned tg = og / nx;
            if (og + 1u == (tg + 1u) * nx) xb_add(&bar[XB_TOPGEN], 1u);
            else XB_SPIN(xb_ld(&bar[XB_TOPGEN]) == tg, bar);
            __builtin_amdgcn_fence(__ATOMIC_ACQUIRE, "agent");
            xb_add(&bar[XB_XGEN(b.x)], 1u);
            asm volatile("s_waitcnt vmcnt(0)" ::: "memory");
        } else {
            XB_SPIN(xb_ld(&bar[XB_XGEN(b.x)]) == gen, bar);
            __builtin_amdgcn_fence(__ATOMIC_ACQUIRE, "agent");
            asm volatile("s_waitcnt vmcnt(0)" ::: "memory");
        }
    }
    __syncthreads();
}

__device__ __forceinline__ float wave_sum(float v) {
#pragma unroll
    for (int o = 1; o < 64; o <<= 1) v += __shfl_xor(v, o);
    return v;
}
__device__ __forceinline__ f32x4 mfma16(bf16x8 a, bf16x8 b, f32x4 c) { return __builtin_amdgcn_mfma_f32_16x16x32_bf16(a, b, c, 0, 0, 0); }

__device__ __forceinline__ void transpose_item(const float* W, int Nsrc, int K, bf16* WT, int k0, int drow0, int srccol, LAS float* scr, int lane) {
#pragma unroll 8
    for (int i = 0; i < 32; ++i) { const int kk = 2 * i + (lane >> 5); scr[kk * 33 + (lane & 31)] = (srccol >= 0) ? W[(size_t)(k0 + kk) * Nsrc + srccol] : 0.f; }
    LDS_WAIT(); asm volatile("" ::: "memory");
    const int c = lane & 7;
#pragma unroll
    for (int j = 0; j < 4; ++j) { const int n = (lane >> 3) + 8 * j; const LAS float* s = scr + (8 * c) * 33 + n;
        v4u o; o.x = pk2(s[0 * 33], s[1 * 33]); o.y = pk2(s[2 * 33], s[3 * 33]); o.z = pk2(s[4 * 33], s[5 * 33]); o.w = pk2(s[6 * 33], s[7 * 33]);
        *(v4u*)(WT + (size_t)(drow0 + n) * K + k0 + 8 * c) = o; }
    LDS_WAIT(); asm volatile("" ::: "memory");
}

__device__ __forceinline__ unsigned pk4q(float a, float b, float c, float d) { int w = 0; w = __builtin_amdgcn_cvt_pk_fp8_f32(fminf(fmaxf(a, -448.f), 448.f), fminf(fmaxf(b, -448.f), 448.f), w, false);
    w = __builtin_amdgcn_cvt_pk_fp8_f32(fminf(fmaxf(c, -448.f), 448.f), fminf(fmaxf(d, -448.f), 448.f), w, true); return (unsigned)w; }
__device__ __forceinline__ void transpose_item8(const float* W, int Nsrc, int K, unsigned char* WT8, int k0, int drow0, int srccol, LAS float* scr, int lane) {
#pragma unroll 8
    for (int i = 0; i < 32; ++i) { const int kk = 2 * i + (lane >> 5); scr[kk * 33 + (lane & 31)] = W[(size_t)(k0 + kk) * Nsrc + srccol] * 64.0f; }
    LDS_WAIT(); asm volatile("" ::: "memory");
    const int c = lane & 7;
#pragma unroll
    for (int j = 0; j < 4; ++j) { const int n = (lane >> 3) + 8 * j; const LAS float* sp = scr + (8 * c) * 33 + n;
        v2u o; o.x = pk4q(sp[0 * 33], sp[1 * 33], sp[2 * 33], sp[3 * 33]); o.y = pk4q(sp[4 * 33], sp[5 * 33], sp[6 * 33], sp[7 * 33]);
        *(v2u*)(WT8 + (size_t)(drow0 + n) * K + k0 + 8 * c) = o; }
    LDS_WAIT(); asm volatile("" ::: "memory");
}
__device__ __forceinline__ int win_srccol(int d) {
    if (d < 1024) return d;
    if (d < 1536) return 1096 + (d - 1024);
    if (d < 3584) return 1736 + (d - 1536);
    if (d < 3648) return 1024 + (d - 3584);
    if (d < 3712) return 1608 + (d - 3648);
    if (d < 3776) return 1672 + (d - 3712);
    if (d < 3784) return 1088 + (d - 3776);
    return -1;
}
__device__ __forceinline__ void norm_row_to_bf16(const float* xrow, const float* g, bf16* orow, int lane) {
    f32x4 v[4]; float ss = 0.f;
#pragma unroll
    for (int j = 0; j < 4; ++j) { v[j] = ((const f32x4*)xrow)[lane + 64 * j]; ss += (v[j].x * v[j].x + v[j].y * v[j].y) + (v[j].z * v[j].z + v[j].w * v[j].w); }
    const float rs = rsqrtf(wave_sum(ss) * (1.f / D) + RMS_EPS);
#pragma unroll
    for (int j = 0; j < 4; ++j) { const f32x4 gv = ((const f32x4*)g)[lane + 64 * j]; v2u o; o.x = pk2(v[j].x * rs * gv.x, v[j].y * rs * gv.y); o.y = pk2(v[j].z * rs * gv.z, v[j].w * rs * gv.w);
        ((v2u*)orow)[lane + 64 * j] = o; }
}
template <bool BASE_BF16, bool OUT_BF16, bool HN_F8 = false>
__device__ __forceinline__ void row_update(const bf16* frow, const void* base, void* outrow, bf16* hnrow, const float* gpost, const float* gnext, float scale, int lane) {
    f32x4 f[4], h[4]; float ss = 0.f;
#pragma unroll
    for (int j = 0; j < 4; ++j) { const v2u w = ((const v2u*)frow)[lane + 64 * j]; f[j] = (f32x4){bflo(w.x), bfhi(w.x), bflo(w.y), bfhi(w.y)};
        ss += (f[j].x * f[j].x + f[j].y * f[j].y) + (f[j].z * f[j].z + f[j].w * f[j].w); }
    const float rs = rsqrtf(wave_sum(ss) * (1.f / D) + RMS_EPS) * scale; float s2 = 0.f;
#pragma unroll
    for (int j = 0; j < 4; ++j) { const f32x4 gv = ((const f32x4*)gpost)[lane + 64 * j]; f32x4 bv;
        if (BASE_BF16) { const v2u w = ((const v2u*)base)[lane + 64 * j]; bv = (f32x4){bflo(w.x), bfhi(w.x), bflo(w.y), bfhi(w.y)}; } else bv = ((const f32x4*)base)[lane + 64 * j];
        h[j] = bv + f[j] * rs * gv; s2 += (h[j].x * h[j].x + h[j].y * h[j].y) + (h[j].z * h[j].z + h[j].w * h[j].w); }
    if (outrow) {
#pragma unroll
        for (int j = 0; j < 4; ++j) { if (OUT_BF16) { v2u o; o.x = pk2(h[j].x, h[j].y); o.y = pk2(h[j].z, h[j].w); ((v2u*)outrow)[lane + 64 * j] = o; } else ((f32x4*)outrow)[lane + 64 * j] = h[j]; } }
    if (hnrow) { const float r2 = rsqrtf(wave_sum(s2) * (1.f / D) + RMS_EPS);
#pragma unroll
        for (int j = 0; j < 4; ++j) { const f32x4 gv = ((const f32x4*)gnext)[lane + 64 * j];
            if (HN_F8) { const float q = 4.0f * r2; ((unsigned*)hnrow)[lane + 64 * j] = pk4q(h[j].x * q * gv.x, h[j].y * q * gv.y, h[j].z * q * gv.z, h[j].w * q * gv.w); }
            else { v2u o; o.x = pk2(h[j].x * r2 * gv.x, h[j].y * r2 * gv.y); o.y = pk2(h[j].z * r2 * gv.z, h[j].w * r2 * gv.w); ((v2u*)hnrow)[lane + 64 * j] = o; } } }
}
__device__ __forceinline__ f32x4 meta_tile(const bf16* A, const bf16* B, int K, int lane) {
    const int fr = lane & 15, kq = lane >> 4; const bf16* ap = A + (size_t)fr * K + 8 * kq; const bf16* bp = B + (size_t)fr * K + 8 * kq;
    f32x4 acc = (f32x4){0.f, 0.f, 0.f, 0.f};
#pragma unroll 4
    for (int k = 0; k < K; k += 32) { const bf16x8 a = *(const bf16x8*)(ap + k); const bf16x8 b = *(const bf16x8*)(bp + k); acc = mfma16(a, b, acc); }
    return acc;
}

struct Args { const float* in[28]; float* out; unsigned char* ws; int ph_lo, ph_hi; };

__device__ __forceinline__ void s5_table_item(const Args& a, int item, LAS float* sc, int tid) {
    const float* lam_re = a.in[15]; const float* lam_im = a.in[16]; const float* log_dt = a.in[17];
    const float* b_re = a.in[18]; const float* b_im = a.in[19]; const float* c_re = a.in[20]; const float* c_im = a.in[21]; const float* dsk = a.in[22];
    const int type = item / 2048, g = (item % 2048) / 64, idx = item % 64;
    LAS float* ap_re = sc; LAS float* ap_im = sc + 64; LAS float* w_re = sc + 128; LAS float* w_im = sc + 192;
    __syncthreads();
    if (tid < 64) { const int p = tid; const float lr = lam_re[g * 64 + p], li = lam_im[g * 64 + p], dt = expf(log_dt[g]);
        const float ang = li * dt, mag = expf(lr * dt); float s1, c1; sincosf(ang, &s1, &c1);
        const float a_re = mag * c1, a_im = mag * s1, den = lr * lr + li * li, nr = a_re - 1.0f, ni = a_im;
        const float cf_re = (nr * lr + ni * li) / den, cf_im = (ni * lr - nr * li) / den;
        const int n = (type == 0) ? idx : (type == 1 ? 63 - idx : idx + 1);
        float sn, cn; sincosf((float)n * ang, &sn, &cn); const float mn = expf((float)n * lr * dt);
        const float pr = mn * cn, pi = mn * sn;
        ap_re[p] = pr; ap_im[p] = pi; w_re[p] = pr * cf_re - pi * cf_im; w_im[p] = pr * cf_im + pi * cf_re; }
    __syncthreads();
    if (type == 0) {
        if (tid < 256) { const int m = tid >> 4, mp = tid & 15; float s = 0.f;
            for (int p = 0; p < 64; ++p) { const float br = b_re[(g * 64 + p) * 16 + mp], bi = b_im[(g * 64 + p) * 16 + mp];
                const float zr = w_re[p] * br - w_im[p] * bi, zi = w_re[p] * bi + w_im[p] * br;
                s += c_re[(g * 16 + m) * 64 + p] * zr - c_im[(g * 16 + m) * 64 + p] * zi; }
            if (idx == 0 && m == mp) s += dsk[g * 16 + m];
            ((bf16*)(a.ws + WS_KI))[((g * 64 + idx) * 16 + m) * 16 + mp] = (bf16)f2bf(s); }
    } else if (type == 1) {
#pragma unroll
        for (int k = 0; k < 4; ++k) { const int e = tid + 512 * k, n = e >> 4, mp = e & 15, p = n & 63;
            const float br = b_re[(g * 64 + p) * 16 + mp], bi = b_im[(g * 64 + p) * 16 + mp];
            const float zr = w_re[p] * br - w_im[p] * bi, zi = w_re[p] * bi + w_im[p] * br;
            ((bf16*)(a.ws + WS_KS))[((size_t)(g * 64 + idx) * 128 + n) * 16 + mp] = (bf16)f2bf(n < 64 ? zr : zi); }
    } else {
#pragma unroll
        for (int k = 0; k < 4; ++k) { const int e = tid + 512 * k, m = e >> 7, kk = e & 127, p = kk & 63;
            const float cr = c_re[(g * 16 + m) * 64 + p], ci = c_im[(g * 16 + m) * 64 + p];
            const float wr_ = cr * ap_re[p] - ci * ap_im[p], wi_ = cr * ap_im[p] + ci * ap_re[p];
            ((bf16*)(a.ws + WS_KO))[((size_t)(g * 64 + idx) * 16 + m) * 128 + kk] = (bf16)f2bf(kk < 64 ? wr_ : -wi_); }
    }
}

constexpr int S5_U = 0, S5_USTR = 2064, S5_KI = 66048, S5_SLOC = 98816, S5_XINB = 115200, S5_XSTR = 272, S5_MISC = 123904;
__device__ __forceinline__ float gelu_tanh(float x) { const float z = 0.7978845608028654f * (x + 0.044715f * x * x * x); return x * fsig(2.0f * z); }
__device__ __forceinline__ void s5_meta(const Args& a, LAS unsigned char* L, int g, int tid) {
    const int lane = tid & 63; const bf16* PMU = (const bf16*)(a.ws + WS_META + MO_PMU); LAS float* MS = (LAS float*)(L + S5_MISC);
    if (tid < 64) { const int p = lane; const float lr = a.in[15][g * 64 + p], li = a.in[16][g * 64 + p], dt = expf(a.in[17][g]);
        const float ang = li * dt, mag = expf(lr * dt); float s1, c1; sincosf(ang, &s1, &c1);
        const float a_re = mag * c1, a_im = mag * s1, den = lr * lr + li * li, nr = a_re - 1.0f, ni = a_im;
        const float cf_re = (nr * lr + ni * li) / den, cf_im = (ni * lr - nr * li) / den;
        float bb_re[16], bb_im[16];
#pragma unroll
        for (int m = 0; m < 16; ++m) { const float br = a.in[18][(g * 64 + p) * 16 + m], bi = a.in[19][(g * 64 + p) * 16 + m]; bb_re[m] = cf_re * br - cf_im * bi; bb_im[m] = cf_re * bi + cf_im * br; }
        float xr = 0.f, xi = 0.f;
        for (int i = 0; i < 16; ++i) { float ur = 0.f, ui = 0.f;
#pragma unroll
            for (int m = 0; m < 16; ++m) { const float u = bf2f(PMU[i * 512 + 16 * g + m]); ur += bb_re[m] * u; ui += bb_im[m] * u; }
            const float nr2 = a_re * xr - a_im * xi + ur, ni2 = a_re * xi + a_im * xr + ui; xr = nr2; xi = ni2; }
        float s64, c64; sincosf(64.0f * ang, &s64, &c64); const float m64 = expf(64.0f * lr * dt);
        MS[p] = xr; MS[64 + p] = xi; MS[128 + p] = m64 * c64; MS[192 + p] = m64 * s64; }
}
__device__ __forceinline__ void s5_unit(const Args& a, LAS unsigned char* L, int b, int g, int tid) {
    const int lane = tid & 63, w = __builtin_amdgcn_readfirstlane(tid >> 6), fr = lane & 15, kq = lane >> 4;
    const bf16* UA2 = (const bf16*)(a.ws + WS_UA2) + (size_t)(b * 32 + g) * 2048 * 16;
    const bf16* KS = (const bf16*)(a.ws + WS_KS); const bf16* KO = (const bf16*)(a.ws + WS_KO); const bf16* KI = (const bf16*)(a.ws + WS_KI);
    bf16* YA = (bf16*)(a.ws + WS_F);
    LAS float* SLOC = (LAS float*)(L + S5_SLOC); LAS float* MS = (LAS float*)(L + S5_MISC);
    __syncthreads();
#pragma unroll
    for (int k = 0; k < 8; ++k) { const int idx = tid + 512 * k, t = idx >> 1, hf = idx & 1;
        const v4u v = *(const v4u*)(UA2 + (size_t)idx * 8);
        *(LAS v4u*)(L + S5_U + (t >> 6) * S5_USTR + (t & 63) * 32 + 16 * hf) = v; }
#pragma unroll
    for (int k = 0; k < 4; ++k) { const int idx = tid + 512 * k; *(LAS v4u*)(L + S5_KI + idx * 16) = *(const v4u*)(KI + (size_t)g * 16384 + idx * 8); }
    bf16x8 bfr[16];
#pragma unroll
    for (int k = 0; k < 16; ++k) { const int i = 2 * k + (kq >> 1); bfr[k] = *(const bf16x8*)(KS + ((size_t)(g * 64 + i) * 128 + 16 * w + fr) * 16 + 8 * (kq & 1)); }
    __syncthreads();
    { f32x4 acc0 = (f32x4){0.f, 0.f, 0.f, 0.f}, acc1 = acc0;
#pragma unroll
      for (int hb = 0; hb < 2; ++hb) {
          if (hb == 1) {
#pragma unroll
              for (int k = 0; k < 16; ++k) { const int i = 2 * (16 + k) + (kq >> 1); bfr[k] = *(const bf16x8*)(KS + ((size_t)(g * 64 + i) * 128 + 16 * w + fr) * 16 + 8 * (kq & 1)); } }
#pragma unroll
          for (int k = 0; k < 16; ++k) { const int ks = 16 * hb + k;
              const bf16x8 a0 = *(const LAS bf16x8*)(L + S5_U + fr * S5_USTR + (32 * ks + 8 * kq) * 2);
              const bf16x8 a1 = *(const LAS bf16x8*)(L + S5_U + (16 + fr) * S5_USTR + (32 * ks + 8 * kq) * 2);
              acc0 = mfma16(a0, bfr[k], acc0); acc1 = mfma16(a1, bfr[k], acc1); } }
#pragma unroll
      for (int r = 0; r < 4; ++r) { SLOC[(4 * kq + r) * 128 + 16 * w + fr] = acc0[r]; SLOC[(16 + 4 * kq + r) * 128 + 16 * w + fr] = acc1[r]; } }
    bf16x8 ko[4];
#pragma unroll
    for (int ks = 0; ks < 4; ++ks) ko[ks] = *(const bf16x8*)(KO + ((size_t)(g * 64 + w) * 16 + fr) * 128 + 32 * ks + 8 * kq);
    __syncthreads();
    if (w == 0) { const int p = lane; float sr[32], si[32];
#pragma unroll
        for (int c = 0; c < 32; ++c) { sr[c] = SLOC[c * 128 + p]; si[c] = SLOC[c * 128 + 64 + p]; }
        float xr = MS[p], xi = MS[64 + p]; const float ar = MS[128 + p], ai = MS[192 + p];
#pragma unroll
        for (int c = 0; c < 32; ++c) { *(LAS bf16*)(L + S5_XINB + c * S5_XSTR + p * 2) = (bf16)f2bf(xr); *(LAS bf16*)(L + S5_XINB + c * S5_XSTR + (64 + p) * 2) = (bf16)f2bf(xi);
            const float nr2 = ar * xr - ai * xi + sr[c], ni2 = ar * xi + ai * xr + si[c]; xr = nr2; xi = ni2; } }
    __syncthreads();
    for (int jj = 0; jj < 8; ++jj) { const int j = w + 8 * jj;
        bf16x8 kon[4];
#pragma unroll
        for (int ks = 0; ks < 4; ++ks) kon[ks] = ko[ks];
        if (jj < 7) {
#pragma unroll
            for (int ks = 0; ks < 4; ++ks) kon[ks] = *(const bf16x8*)(KO + ((size_t)(g * 64 + j + 8) * 16 + fr) * 128 + 32 * ks + 8 * kq); }
        f32x4 acc0 = (f32x4){0.f, 0.f, 0.f, 0.f}, acc1 = acc0;
#pragma unroll
        for (int ks = 0; ks < 4; ++ks) {
            const bf16x8 a0 = *(const LAS bf16x8*)(L + S5_XINB + fr * S5_XSTR + (32 * ks + 8 * kq) * 2);
            const bf16x8 a1 = *(const LAS bf16x8*)(L + S5_XINB + (16 + fr) * S5_XSTR + (32 * ks + 8 * kq) * 2);
            acc0 = mfma16(a0, ko[ks], acc0); acc1 = mfma16(a1, ko[ks], acc1); }
        const int nks = (j >> 1) + 1;
#pragma unroll 2
        for (int ks = 0; ks < nks; ++ks) { const int i = 2 * ks + (kq >> 1), tau = j - i;
            bf16x8 bq = *(const LAS bf16x8*)(L + S5_KI + (((tau < 0 ? 0 : tau) * 16 + fr) * 16 + 8 * (kq & 1)) * 2);
            if (tau < 0) bq = (bf16x8){0, 0, 0, 0, 0, 0, 0, 0};
            const bf16x8 a0 = *(const LAS bf16x8*)(L + S5_U + fr * S5_USTR + (32 * ks + 8 * kq) * 2);
            const bf16x8 a1 = *(const LAS bf16x8*)(L + S5_U + (16 + fr) * S5_USTR + (32 * ks + 8 * kq) * 2);
            acc0 = mfma16(a0, bq, acc0); acc1 = mfma16(a1, bq, acc1); }
#pragma unroll
        for (int r = 0; r < 4; ++r) { const int c0 = 4 * kq + r, c1 = 16 + 4 * kq + r;
            YA[(size_t)(b * 2048 + 64 * c0 + j) * 512 + 16 * g + fr] = (bf16)f2bf(gelu_tanh(acc0[r]));
            YA[(size_t)(b * 2048 + 64 * c1 + j) * 512 + 16 * g + fr] = (bf16)f2bf(gelu_tanh(acc1[r])); }
#pragma unroll
        for (int ks = 0; ks < 4; ++ks) ko[ks] = kon[ks]; }
}

constexpr int DS_SSTR = 2120, DS_TSTR = 144, DS_BUF = 18432  , DS_BT = 36864  , DS_HIST = 135680, DS_MASK = 143872, DS_RB = 152576, DS_TB = 153600;
typedef short s16x4 __attribute__((ext_vector_type(4)));
__device__ __forceinline__ s16x4 tr_read(unsigned addr) { s16x4 r; asm volatile("ds_read_b64_tr_b16 %0, %1" : "=&v"(r) : "v"(addr) : "memory"); return r; }
__device__ __forceinline__ unsigned f16key(float f) { const _Float16 hf = (_Float16)f; const unsigned h = (unsigned)__builtin_bit_cast(unsigned short, hf); return (h & 0x8000u) ? (~h & 0xffffu) : (h | 0x8000u); }
__device__ __forceinline__ unsigned cvtpk(float lo, float hi) { unsigned r; asm volatile("v_cvt_pk_bf16_f32 %0, %1, %2" : "=v"(r) : "v"(lo), "v"(hi)); return r; }
__device__ __forceinline__ void dsa_tables(const Args& a, LAS unsigned char* L, int tid) {
    if (tid < 256) { ((LAS float*)(L + DS_RB))[tid] = a.in[25][tid] * 1.44269504f;
        const int n = tid; const int lo = n < 8 ? n : (n < 12 ? 8 : n < 16 ? 9 : n < 23 ? 10 : n < 32 ? 11 : n < 46 ? 12 : n < 64 ? 13 : n < 91 ? 14 : 15);
        ((LAS int*)(L + DS_TB))[tid] = lo; }
}
__device__ __forceinline__ void dsa_unit(const Args& a, LAS unsigned char* L, int b, int uq, int tid) {
    const int lane = tid & 63, w = __builtin_amdgcn_readfirstlane(tid >> 6), fr = lane & 15, kq = lane >> 4;
    const bf16* PA = (const bf16*)(a.ws + WS_PA); const bf16* PK = (const bf16*)(a.ws + WS_PK); const bf16* PMK = (const bf16*)(a.ws + WS_META + MO_PMK);
    bf16* YB = (bf16*)(a.ws + WS_HN) + (size_t)R * 512;
    const int c = 1 + (uq >> 1), nt64 = c + 1, qrow0 = b * 2048 + 32 * uq;
    LAS unsigned short* S16 = (LAS unsigned short*)L; LAS unsigned long long* MASK = (LAS unsigned long long*)(L + DS_MASK);
    const LAS float* RB = (const LAS float*)(L + DS_RB); const LAS int* TB = (const LAS int*)(L + DS_TB);
    __syncthreads();
    { const int qh = w >> 2; bf16x8 qa[4][2][2]; float wv[4][2][4];
#pragma unroll
      for (int p = 0; p < 4; ++p) {
#pragma unroll
          for (int hf = 0; hf < 2; ++hf)
#pragma unroll
              for (int ks = 0; ks < 2; ++ks) qa[p][hf][ks] = *(const bf16x8*)(PA + (size_t)(qrow0 + 16 * qh + 4 * p + (fr >> 2)) * 1536 + 512 + (4 * hf + (fr & 3)) * 64 + 32 * ks + 8 * kq);
          const v4u wraw = *(const v4u*)(PK + (size_t)(qrow0 + 16 * qh + 4 * p + kq) * 256 + 192);
          wv[p][0][0] = bflo(wraw.x) * 0.04419417382f; wv[p][0][1] = bfhi(wraw.x) * 0.04419417382f; wv[p][0][2] = bflo(wraw.y) * 0.04419417382f; wv[p][0][3] = bfhi(wraw.y) * 0.04419417382f;
          wv[p][1][0] = bflo(wraw.z) * 0.04419417382f; wv[p][1][1] = bfhi(wraw.z) * 0.04419417382f; wv[p][1][2] = bflo(wraw.w) * 0.04419417382f; wv[p][1][3] = bfhi(wraw.w) * 0.04419417382f; }
      const int nkt = 4 * nt64;
      if ((w & 3) != 0) {
#pragma unroll
          for (int p = 0; p < 4; ++p) S16[(16 * qh + 4 * p + kq) * DS_SSTR + 16 * (w & 3) + fr] = (unsigned short)0; }
      int kt = (w & 3) == 0 ? 0 : (w & 3) + 4;
      bf16x8 kb0, kb1, kc0, kc1;
      { const bf16* krow = (kt == 0) ? PMK + fr * 256 : PK + (size_t)(b * 2048 + 16 * kt - 64 + fr) * 256; kb0 = *(const bf16x8*)(krow + 8 * kq); kb1 = *(const bf16x8*)(krow + 32 + 8 * kq); }
      { const int k1 = (kt == 0) ? 4 : kt + 4; kc0 = kb0; kc1 = kb1;
        if (k1 < nkt) { const bf16* krow = PK + (size_t)(b * 2048 + 16 * k1 - 64 + fr) * 256; kc0 = *(const bf16x8*)(krow + 8 * kq); kc1 = *(const bf16x8*)(krow + 32 + 8 * kq); } }
      while (kt < nkt) {
          const int ktn = (kt == 0) ? 4 : kt + 4, ktnn = ktn + 4; bf16x8 nb0 = kc0, nb1 = kc1;
          if (ktnn < nkt) { const bf16* krow = PK + (size_t)(b * 2048 + 16 * ktnn - 64 + fr) * 256; nb0 = *(const bf16x8*)(krow + 8 * kq); nb1 = *(const bf16x8*)(krow + 32 + 8 * kq); }
#pragma unroll
          for (int p = 0; p < 4; ++p) { f32x4 aA = (f32x4){0.f, 0.f, 0.f, 0.f}, aB = aA;
              aA = mfma16(qa[p][0][0], kb0, aA); aB = mfma16(qa[p][1][0], kb0, aB); aA = mfma16(qa[p][0][1], kb1, aA); aB = mfma16(qa[p][1][1], kb1, aB);
              const float v = (fmaxf(aA[0], 0.f) * wv[p][0][0] + fmaxf(aA[1], 0.f) * wv[p][0][1]) + (fmaxf(aA[2], 0.f) * wv[p][0][2] + fmaxf(aA[3], 0.f) * wv[p][0][3])
                            + (fmaxf(aB[0], 0.f) * wv[p][1][0] + fmaxf(aB[1], 0.f) * wv[p][1][1]) + (fmaxf(aB[2], 0.f) * wv[p][1][2] + fmaxf(aB[3], 0.f) * wv[p][1][3]);
              S16[(16 * qh + 4 * p + kq) * DS_SSTR + 16 * kt + fr] = (unsigned short)f16key(v); }
          kb0 = kc0; kb1 = kc1; kc0 = nb0; kc1 = nb1; kt = ktn; } }
    __syncthreads();
    bf16x8 qb[2][2]; unsigned mkoff[2];
#pragma unroll
    for (int cg = 0; cg < 2; ++cg) { const int q = 4 * w + 2 * cg + (fr >> 3), h = fr & 7; mkoff[cg] = q * 34;
#pragma unroll
        for (int ks = 0; ks < 2; ++ks) qb[cg][ks] = *(const bf16x8*)(PA + (size_t)(qrow0 + q) * 1536 + 1024 + h * 64 + 32 * ks + 8 * kq); }
    const int skey = tid >> 3, spiece = tid & 7;
    v4u kv0 = (v4u){0u, 0u, 0u, 0u}, vv0 = kv0, kv, vv;
    if (skey < 16) { const bf16* krow = PMK + skey * 256; kv0 = *(const v4u*)(krow + 64 + 8 * spiece); vv0 = *(const v4u*)(krow + 128 + 8 * spiece); }
    { const bf16* krow = PK + (size_t)(b * 2048 + skey) * 256; kv = *(const v4u*)(krow + 64 + 8 * spiece); vv = *(const v4u*)(krow + 128 + 8 * spiece); }
    { LAS unsigned* H = (LAS unsigned*)(L + DS_HIST) + w * 256;
      for (int qq = 0; qq < 4; ++qq) { const int q = 4 * w + qq; const LAS unsigned short* Sq = S16 + q * DS_SSTR; unsigned tkey = 0u;
          unsigned kr[33];
#pragma unroll
          for (int e = 0; e < 33; ++e) kr[e] = (e < nt64) ? (unsigned)Sq[64 * e + lane] : 0u;
          if (c >= 4) { unsigned prefix = 0u; int kth = 256;
#pragma unroll
              for (int pass = 0; pass < 2; ++pass) {
                  H[lane] = 0u; H[lane + 64] = 0u; H[lane + 128] = 0u; H[lane + 192] = 0u; LDS_WAIT();
#pragma unroll
                  for (int e = 0; e < 33; ++e) if (e < nt64) { const unsigned key = kr[e]; const bool in = (pass == 0) || ((key >> 8) == prefix);
                      if (in) (void)__hip_atomic_fetch_add(&H[pass == 0 ? (key >> 8) : (key & 255u)], 1u, __ATOMIC_RELAXED, __HIP_MEMORY_SCOPE_WORKGROUP); }
                  LDS_WAIT();
                  const unsigned h0 = H[4 * lane], h1 = H[4 * lane + 1], h2 = H[4 * lane + 2], h3 = H[4 * lane + 3]; const int t = (int)(h0 + h1 + h2 + h3);
                  int sfx = t;
#pragma unroll
                  for (int off = 1; off < 64; off <<= 1) { const int v = __shfl_down(sfx, off); if (lane + off < 64) sfx += v; }
                  const int above = sfx - t; const bool has = (above < kth) && (above + t >= kth);
                  const unsigned long long bm = __ballot(has); const int src = bm ? (__ffsll((long long)bm) - 1) : 0;
                  int cum = above, B; if (cum + (int)h3 >= kth) B = 3; else { cum += (int)h3; if (cum + (int)h2 >= kth) B = 2; else { cum += (int)h2; if (cum + (int)h1 >= kth) B = 1; else { cum += (int)h1; B = 0; } } }
                  const int bin = __shfl(4 * lane + B, src); kth = __shfl(kth - cum, src);
                  prefix = (prefix << 8) | (unsigned)bin; LDS_WAIT(); }
              tkey = prefix; }
          unsigned mlo = 0u, mhi = 0u;
#pragma unroll
          for (int e = 0; e < 33; ++e) if (e < nt64) { const int s = 64 * e + lane; const bool sel = ((s < 16) || (s >= 64)) && (kr[e] >= tkey);
              const unsigned long long m = __ballot(sel); mlo = (lane == e) ? (unsigned)m : mlo; mhi = (lane == e) ? (unsigned)(m >> 32) : mhi; }
          if (lane < nt64) MASK[q * 34 + lane] = ((unsigned long long)mhi << 32) | mlo; } }
    __syncthreads();
    {
      const int hh = fr & 7; const float bfar = RB[15 * 8 + hh];
      float mrun[2] = {-1.0e30f, -1.0e30f}, lrun[2] = {0.f, 0.f}; f32x4 O[2][4];
#pragma unroll
      for (int cg = 0; cg < 2; ++cg)
#pragma unroll
          for (int dt = 0; dt < 4; ++dt) O[cg][dt] = (f32x4){0.f, 0.f, 0.f, 0.f};
      const LAS float* BT = (const LAS float*)(L + DS_BT);
#pragma unroll
      for (int k = 0; k < 4; ++k) { const int e = tid + 512 * k, relc = (e >> 3) - 128, n = relc < 0 ? -relc : relc; ((LAS float*)(L + DS_BT))[e] = RB[(TB[n] + (relc > 0 ? 16 : 0)) * 8 + (e & 7)]; }
      const unsigned ldsV = (unsigned)(size_t)(L) + 9216u + (unsigned)((4 * kq + ((lane & 15) >> 2)) * DS_TSTR + 8 * (lane & 3));
      *(LAS v4u*)(L + skey * DS_TSTR + 16 * spiece) = kv0; *(LAS v4u*)(L + 9216 + skey * DS_TSTR + 16 * spiece) = vv0;
      __syncthreads();
      for (int T = 0; T < nt64; ++T) { const int buf = T & 1;
          v4u kn = kv, vn = vv;
          if (T + 2 < nt64) { const bf16* krow = PK + (size_t)(b * 2048 + 64 * (T + 1) + skey) * 256; kn = *(const v4u*)(krow + 64 + 8 * spiece); vn = *(const v4u*)(krow + 128 + 8 * spiece); }
          const bool nearT = (64 * T > 32 * uq - 90);
          f32x4 lg[2][4];
          { bf16x8 ka[4][2];
#pragma unroll
            for (int sub = 0; sub < 4; ++sub)
#pragma unroll
                for (int ks = 0; ks < 2; ++ks) ka[sub][ks] = *(const LAS bf16x8*)(L + buf * DS_BUF + fr * DS_TSTR + 16 * kq + sub * 16 * DS_TSTR + ks * 64);
#pragma unroll
            for (int cg = 0; cg < 2; ++cg)
#pragma unroll
                for (int sub = 0; sub < 4; ++sub) { f32x4 acc = (f32x4){0.f, 0.f, 0.f, 0.f}; acc = mfma16(ka[sub][0], qb[cg][0], acc); acc = mfma16(ka[sub][1], qb[cg][1], acc); lg[cg][sub] = acc; } }
          s16x4 vt[2][4][2];
#pragma unroll
          for (int cg = 0; cg < 2; ++cg) {
              float mxl = -1.0e30f;
              if (nearT) { const int relb = ((T == 0) ? 0 : 64 * T - 48) + 4 * kq - (16 + 32 * uq + 4 * w + 2 * cg + (fr >> 3));
#pragma unroll
                  for (int sub = 0; sub < 4; ++sub)
#pragma unroll
                      for (int r = 0; r < 4; ++r) { int idx = relb + 16 * sub + r; idx = idx < -128 ? -128 : idx; idx = idx > 127 ? 127 : idx;
                          const float v = lg[cg][sub][r] * 0.18033688f + BT[(idx + 128) * 8 + hh]; lg[cg][sub][r] = v; mxl = fmaxf(mxl, v); }
              } else {
#pragma unroll
                  for (int sub = 0; sub < 4; ++sub)
#pragma unroll
                      for (int r = 0; r < 4; ++r) { const float v = lg[cg][sub][r] * 0.18033688f + bfar; lg[cg][sub][r] = v; mxl = fmaxf(mxl, v); } }
              if (__ballot(mxl > mrun[cg] + 8.0f) != 0ull) { float mx = mxl; mx = fmaxf(mx, __shfl_xor(mx, 16)); mx = fmaxf(mx, __shfl_xor(mx, 32));
                  const float mn = fmaxf(mrun[cg], mx), sc = __builtin_amdgcn_exp2f(mrun[cg] - mn); mrun[cg] = mn; lrun[cg] *= sc;
#pragma unroll
                  for (int dt = 0; dt < 4; ++dt) O[cg][dt] = O[cg][dt] * sc; }
              const unsigned long long mword = MASK[mkoff[cg] + T] >> (4 * kq); const unsigned mlo = (unsigned)mword, mhi = (unsigned)(mword >> 32); const float mcur = mrun[cg]; float ls = 0.f;
#pragma unroll
              for (int sub = 0; sub < 4; ++sub)
#pragma unroll
                  for (int r = 0; r < 4; ++r) { const int keep = __builtin_amdgcn_sbfe((int)(sub < 2 ? mlo : mhi), 16 * (sub & 1) + r, 1);
                      const float p = __uint_as_float(__float_as_uint(__builtin_amdgcn_exp2f(lg[cg][sub][r] - mcur)) & (unsigned)keep); ls += p; lg[cg][sub][r] = p; }
              lrun[cg] += ls; }
          { const unsigned vaddr = ldsV + (unsigned)(buf * DS_BUF);
            asm volatile("ds_read_b64_tr_b16 %0, %16 offset:0\n\t"
                "ds_read_b64_tr_b16 %1, %16 offset:2304\n\t"
                "ds_read_b64_tr_b16 %2, %16 offset:32\n\t"
                "ds_read_b64_tr_b16 %3, %16 offset:2336\n\t"
                "ds_read_b64_tr_b16 %4, %16 offset:64\n\t"
                "ds_read_b64_tr_b16 %5, %16 offset:2368\n\t"
                "ds_read_b64_tr_b16 %6, %16 offset:96\n\t"
                "ds_read_b64_tr_b16 %7, %16 offset:2400\n\t"
                "ds_read_b64_tr_b16 %8, %16 offset:4608\n\t"
                "ds_read_b64_tr_b16 %9, %16 offset:6912\n\t"
                "ds_read_b64_tr_b16 %10, %16 offset:4640\n\t"
                "ds_read_b64_tr_b16 %11, %16 offset:6944\n\t"
                "ds_read_b64_tr_b16 %12, %16 offset:4672\n\t"
                "ds_read_b64_tr_b16 %13, %16 offset:6976\n\t"
                "ds_read_b64_tr_b16 %14, %16 offset:4704\n\t"
                "ds_read_b64_tr_b16 %15, %16 offset:7008\n\t"
                "s_waitcnt lgkmcnt(0)"
                : "=&v"(vt[0][0][0]), "=&v"(vt[0][0][1]), "=&v"(vt[0][1][0]), "=&v"(vt[0][1][1]), "=&v"(vt[0][2][0]), "=&v"(vt[0][2][1]), "=&v"(vt[0][3][0]), "=&v"(vt[0][3][1]), "=&v"(vt[1][0][0]), "=&v"(vt[1][0][1]), "=&v"(vt[1][1][0]), "=&v"(vt[1][1][1]), "=&v"(vt[1][2][0]), "=&v"(vt[1][2][1]), "=&v"(vt[1][3][0]), "=&v"(vt[1][3][1])
                : "v"(vaddr) : "memory"); }
#pragma unroll
          for (int ks2 = 0; ks2 < 2; ++ks2) { bf16x8 pb[2];
#pragma unroll
              for (int cg = 0; cg < 2; ++cg) { v4u pw; pw.x = cvtpk(lg[cg][2 * ks2][0], lg[cg][2 * ks2][1]); pw.y = cvtpk(lg[cg][2 * ks2][2], lg[cg][2 * ks2][3]);
                  pw.z = cvtpk(lg[cg][2 * ks2 + 1][0], lg[cg][2 * ks2 + 1][1]); pw.w = cvtpk(lg[cg][2 * ks2 + 1][2], lg[cg][2 * ks2 + 1][3]); pb[cg] = __builtin_bit_cast(bf16x8, pw); }
#pragma unroll
              for (int dt = 0; dt < 4; ++dt) { const bf16x8 va = __builtin_shufflevector(vt[ks2][dt][0], vt[ks2][dt][1], 0, 1, 2, 3, 4, 5, 6, 7);
#pragma unroll
                  for (int cg = 0; cg < 2; ++cg) O[cg][dt] = mfma16(va, pb[cg], O[cg][dt]); } }
          if (T + 1 < nt64) { *(LAS v4u*)(L + (buf ^ 1) * DS_BUF + skey * DS_TSTR + 16 * spiece) = kv; *(LAS v4u*)(L + (buf ^ 1) * DS_BUF + 9216 + skey * DS_TSTR + 16 * spiece) = vv; }
          kv = kn; vv = vn;
          __syncthreads();
      }
#pragma unroll
      for (int cg = 0; cg < 2; ++cg) { float v = lrun[cg]; v += __shfl_xor(v, 16); v += __shfl_xor(v, 32); const float inv = 1.0f / v;
          const int q = 4 * w + 2 * cg + (fr >> 3);
#pragma unroll
          for (int dt = 0; dt < 4; ++dt) { v2u o; o.x = cvtpk(O[cg][dt][0] * inv, O[cg][dt][1] * inv); o.y = cvtpk(O[cg][dt][2] * inv, O[cg][dt][3] * inv);
              *(v2u*)(YB + (size_t)(qrow0 + q) * 512 + hh * 64 + 16 * dt + 4 * kq) = o; } } }
}

__global__ void __launch_bounds__(NWAVES * 64, 2) mk_fwd(Args args) {
    extern __shared__ __attribute__((aligned(16))) unsigned char lds[];
    LAS unsigned char* L = (LAS unsigned char*)lds;
    volatile LAS unsigned* MISC = (volatile LAS unsigned*)(L + MISC_OFF);
    const int tid = threadIdx.x, lane = tid & 63, wave = __builtin_amdgcn_readfirstlane(tid >> 6);
    const int G = gridDim.x, bx = blockIdx.x;
    const int gw = bx * NWAVES + wave, NGW = G * NWAVES;
    unsigned char* ws = args.ws;
    if (tid < 32) MISC[tid] = 0u;
    __syncthreads();
    XcdBarrier bar; bar.bar = (unsigned*)(ws + WS_CTL) + CW_BAR; bar.x = 0; bar.st = nullptr;
    if (!MK_PER_PHASE) bar = xcd_barrier_post((unsigned*)(ws + WS_CTL) + CW_BAR, MISC + 8);
    const int lo = args.ph_lo, hi = args.ph_hi;
#define IN(k) (lo <= (k) && (k) < hi)
#define SEAM(k) do { if (IN(k) && IN((k) + 1)) xcd_barrier(bar); } while (0)
    bf16* WT1 = (bf16*)(ws + WS_WT1); bf16* WT2 = (bf16*)(ws + WS_WT2); bf16* WT3 = (bf16*)(ws + WS_WT3); bf16* WT4 = (bf16*)(ws + WS_WT4); bf16* WT5 = (bf16*)(ws + WS_WT5);
    bf16* WGLU = (bf16*)(ws + WS_WGLU); bf16* WA = (bf16*)(ws + WS_WA); bf16* WB = (bf16*)(ws + WS_WB); bf16* WOUT = (bf16*)(ws + WS_WOUT);
    bf16* HN = (bf16*)(ws + WS_HN); bf16* FB = (bf16*)(ws + WS_F); bf16* ACT = (bf16*)(ws + WS_BIG);
    bf16* PA = (bf16*)(ws + WS_PA); bf16* PG = (bf16*)(ws + WS_PG); bf16* PK = (bf16*)(ws + WS_PK);
    bf16* AM1 = (bf16*)(ws + WS_META + MO_AM1); bf16* ACTM = (bf16*)(ws + WS_META + MO_ACTM); bf16* FM = (bf16*)(ws + WS_META + MO_FM); bf16* AM2 = (bf16*)(ws + WS_META + MO_AM2);
    bf16* PMU = (bf16*)(ws + WS_META + MO_PMU); bf16* PMK = (bf16*)(ws + WS_META + MO_PMK);
    bf16* HB = (bf16*)(ws + WS_HB);
    bf16* YA = FB; bf16* YG = HN; bf16* YB = HN + (size_t)R * 512; bf16* MERGED = PA;
    const float* x = args.in[0]; float* out = args.out;

    if (IN(0)) {
        for (int item = bx; item < 3 * 2048; item += G) s5_table_item(args, item, (LAS float*)(L + 140000), tid);
        __syncthreads();
        LAS float* scr = (LAS float*)(L + wave * 16384);
        for (int it = gw; it < 11520; it += NGW) {
            int r = it;
            if (r < 6 * 1408) { const int mat = r / 1408; r -= mat * 1408;
                if (mat == 5) { const int kb = r / 32, nb = r % 32; transpose_item8(args.in[13], D, DFF, (unsigned char*)WT5, 64 * kb, 32 * nb, 32 * nb + (lane & 31), scr, lane); }
                else if (mat == 2) { const int kb = r / 32, nb = r % 32; transpose_item(args.in[10], D, DFF, WT2, 64 * kb, 32 * nb, 32 * nb + (lane & 31), scr, lane); }
                else if (mat >= 3) { const int kb = r / 88, nb = r % 88, d0 = 32 * nb, up = (mat == 4) ? 128 : 0; transpose_item8(args.in[mat == 3 ? 11 : 12], DFF, D, (unsigned char*)WT4, 64 * kb, 256 * (d0 >> 7) + (d0 & 127) + up, d0 + (lane & 31), scr, lane); }
                else { const int kb = r / 88, nb = r % 88, d0 = 32 * nb, up = (mat == 1 || mat == 4) ? 128 : 0;
                    transpose_item(args.in[mat == 0 ? 8 : mat == 1 ? 9 : mat == 3 ? 11 : 12], DFF, D, mat < 3 ? WT1 : WT4, 64 * kb, 256 * (d0 >> 7) + (d0 & 127) + up, d0 + (lane & 31), scr, lane); }
                continue; }
            r -= 6 * 1408;
            if (r < 1920) { const int kb = r / 120, nb = r % 120; transpose_item(args.in[14], 3784, D, WT3, 64 * kb, 32 * nb, win_srccol(32 * nb + (lane & 31)), scr, lane); continue; }
            r -= 1920;
            if (r < 128) { const int kb = r / 16, nb = r % 16; transpose_item(args.in[23], 512, 512, WGLU, 64 * kb, 32 * nb, 32 * nb + (lane & 31), scr, lane); continue; }
            r -= 128;
            if (r < 256) { const int kb = r / 32, nb = r % 32; transpose_item(args.in[24], D, 512, WA, 64 * kb, 32 * nb, 32 * nb + (lane & 31), scr, lane); continue; }
            r -= 256;
            if (r < 256) { const int kb = r / 32, nb = r % 32; transpose_item(args.in[26], D, 512, WB, 64 * kb, 32 * nb, 32 * nb + (lane & 31), scr, lane); continue; }
            r -= 256;
            { const int kb = r / 32, nb = r % 32; transpose_item(args.in[27], D, D, WOUT, 64 * kb, 32 * nb, 32 * nb + (lane & 31), scr, lane); }
        }
        for (int m = gw; m < R; m += NGW) norm_row_to_bf16(x + (size_t)m * D, args.in[2], HN + (size_t)m * D, lane);
        if (gw < NMETA) norm_row_to_bf16(args.in[1] + (size_t)gw * D, args.in[2], AM1 + (size_t)gw * D, lane);
    }
    SEAM(0);
    if (IN(1)) {
        if (gw < 176) { const int j0 = 16 * gw, grow = 256 * (j0 >> 7) + (j0 & 127); const f32x4 g4 = meta_tile(AM1, WT1 + (size_t)grow * D, D, lane), u4 = meta_tile(AM1, WT1 + (size_t)(grow + 128) * D, D, lane);
#pragma unroll
            for (int r = 0; r < 4; ++r) ACTM[(4 * (lane >> 4) + r) * DFF + j0 + (lane & 15)] = (bf16)f2bf(g4[r] * fsig(g4[r]) * u4[r]); }
        pg8::Gemm g{HN, WT1, R, 2 * DFF, D}; pg8::StaticOrder S; S.init(R, 2 * DFF, G, bx); pg8::EpiSwiglu E{ACT, DFF};
        pg8::gemm_phase<pg8::EpiSwiglu, pg8::StaticOrder, PG8_ALIGN, PG8_SP2>(L, g, S, E);
        if (REP_G1 > 1) pg8::gemm_phase<pg8::EpiSwiglu, pg8::StaticOrder, PG8_ALIGN, PG8_SP2>(L, g, S, E);
    }
    SEAM(1);
    if (IN(2)) {
        if (gw < 64) { const int n0 = 16 * gw; const f32x4 f4 = meta_tile(ACTM, WT2 + (size_t)n0 * DFF, DFF, lane);
#pragma unroll
            for (int r = 0; r < 4; ++r) FM[(4 * (lane >> 4) + r) * D + n0 + (lane & 15)] = (bf16)f2bf(f4[r]); }
        pg8::Gemm g{ACT, WT2, R, D, DFF}; pg8::StaticOrder S; S.init(R, D, G, bx); pg8::EpiPlain E{FB, D};
        pg8::gemm_phase<pg8::EpiPlain, pg8::StaticOrder, PG8_ALIGN, PG8_SP2>(L, g, S, E);
    }
    SEAM(2);
    if (IN(3)) {
        if (gw < NMETA) row_update<false, false>(FM + (size_t)gw * D, args.in[1] + (size_t)gw * D, nullptr, AM2 + (size_t)gw * D, args.in[3], args.in[4], 0.5f, lane);
        for (int m = gw; m < R; m += NGW) row_update<false, true>(FB + (size_t)m * D, x + (size_t)m * D, HB + (size_t)m * D, HN + (size_t)m * D, args.in[3], args.in[4], 0.5f, lane);
    }
    SEAM(3);
    if (IN(4)) {
        if (gw < 44) { const int n0 = gw < 32 ? 16 * gw : 3584 + 16 * (gw - 32); const f32x4 p4 = meta_tile(AM2, WT3 + (size_t)n0 * D, D, lane);
#pragma unroll
            for (int r = 0; r < 4; ++r) { const int row = 4 * (lane >> 4) + r; if (gw < 32) PMU[row * 512 + n0 + (lane & 15)] = (bf16)f2bf(p4[r]); else PMK[row * 256 + (n0 - 3584) + (lane & 15)] = (bf16)f2bf(p4[r]); } }
        pg8::Gemm g{HN, WT3, R, 3840, D}; pg8::StaticOrder S; S.init(R, 3840, G, bx); pg8::EpiProj E{PA, PG, PK, (bf16*)(ws + WS_UA2)};
        pg8::gemm_phase<pg8::EpiProj, pg8::StaticOrder, PG8_ALIGN, PG8_SP2>(L, g, S, E);
    }
    SEAM(4);
    if (IN(5)) {
        s5_meta(args, L, bx >> 3, tid);
        for (int rep = 0; rep < REP_S5; ++rep) for (int i = 0; i < 2; ++i) s5_unit(args, L, 2 * (bx & 7) + i, bx >> 3, tid);
        __syncthreads();
        dsa_tables(args, L, tid);
        for (int i = 0; i < 4 * REP_DSA; ++i) { const int up = 4 * (bx >> 3) + (i & 3), u2 = up >> 1, b = 2 * (bx & 7) + (u2 >> 5), xq = u2 & 31; dsa_unit(args, L, b, (up & 1) ? 63 - xq : xq, tid); }
        __syncthreads();
    }
    SEAM(5);
    if (IN(6)) { pg8::Gemm g{YA, WGLU, R, 512, 512}; pg8::StaticOrder S; S.init(R, 512, G, bx); pg8::EpiGlu E{YA, YG};
        pg8::gemm_phase<pg8::EpiGlu, pg8::StaticOrder, PG8_ALIGN, PG8_SP2>(L, g, S, E); }
    SEAM(6);
    if (IN(7)) { pg8::Gemm g{YG, WA, R, D, 512}; pg8::StaticOrder S; S.init(R, D, G, bx); pg8::EpiMerge<false> E{PG, 0, nullptr, FB};
        pg8::gemm_phase<pg8::EpiMerge<false>, pg8::StaticOrder, PG8_ALIGN, PG8_SP2>(L, g, S, E); }
    SEAM(7);
    if (IN(8)) { pg8::Gemm g{YB, WB, R, D, 512}; pg8::StaticOrder S; S.init(R, D, G, bx); pg8::EpiMerge<true> E{PG, 1024, FB, MERGED};
        pg8::gemm_phase<pg8::EpiMerge<true>, pg8::StaticOrder, PG8_ALIGN, PG8_SP2>(L, g, S, E); }
    SEAM(8);
    if (IN(9)) { pg8::Gemm g{MERGED, WOUT, R, D, D}; pg8::StaticOrder S; S.init(R, D, G, bx); pg8::EpiPlain E{FB, D};
        pg8::gemm_phase<pg8::EpiPlain, pg8::StaticOrder, PG8_ALIGN, PG8_SP2>(L, g, S, E); }
    SEAM(9);
    if (IN(10)) { for (int m = gw; m < R; m += NGW) row_update<true, true, true>(FB + (size_t)m * D, HB + (size_t)m * D, HB + (size_t)m * D, (bf16*)((unsigned char*)HN + (size_t)m * D), args.in[5], args.in[6], 1.0f, lane); }
    SEAM(10);
    if (IN(11)) { pg8::Gemm g{HN, WT4, R, 2 * DFF, D}; pg8::StaticOrder S; S.init(R, 2 * DFF, G, bx); pg8::EpiSwiglu8 E{(unsigned char*)ACT, DFF, 1.0f / 256.0f, 8.0f};
        pg8::gemm_phase<pg8::EpiSwiglu8, pg8::StaticOrder, PG8_ALIGN, PG8_SP2, true>(L, g, S, E); }
    SEAM(11);
    if (IN(12)) { pg8::Gemm g{ACT, WT5, R, D, DFF}; pg8::StaticOrder S; S.init(R, D, G, bx); pg8::EpiPlainS E{FB, D, 1.0f / 512.0f};
        pg8::gemm_phase<pg8::EpiPlainS, pg8::StaticOrder, PG8_ALIGN, PG8_SP2, true>(L, g, S, E); }
    SEAM(12);
    if (IN(13)) { for (int m = gw; m < R; m += NGW) row_update<true, false>(FB + (size_t)m * D, HB + (size_t)m * D, out + (size_t)m * D, nullptr, args.in[7], args.in[7], 0.5f, lane); }
#undef IN
#undef SEAM
}

extern "C" void kernel_launch(void* const* d_in, const int* in_sizes, int n_in, void* d_out, int out_size, void* d_ws, size_t ws_size, hipStream_t stream) {
    static int grid = 0;
    if (grid == 0) {
        if (n_in != 28 || out_size != R * D || ws_size < WS_END) { fprintf(stderr, "kernel_launch: unexpected shapes (n_in %d, out %d, ws %zu); nothing launched\n", n_in, out_size, ws_size); grid = -1; return; }
        int dev = 0, cus = 0, per_cu = 0;
        if (hipGetDevice(&dev) != hipSuccess || hipDeviceGetAttribute(&cus, hipDeviceAttributeMultiprocessorCount, dev) != hipSuccess) { grid = -1; return; }
        if (hipFuncSetAttribute((const void*)mk_fwd, hipFuncAttributeMaxDynamicSharedMemorySize, LDS_BYTES) != hipSuccess) { fprintf(stderr, "kernel_launch: hipFuncSetAttribute failed\n"); grid = -1; return; }
        if (hipOccupancyMaxActiveBlocksPerMultiprocessor(&per_cu, (const void*)mk_fwd, NWAVES * 64, LDS_BYTES) != hipSuccess || per_cu < 1) fprintf(stderr, "kernel_launch: note: occupancy query reports %d\n", per_cu);
        (void)hipGetLastError();
        grid = cus;
    }
    if (grid < 0) return;
    if (hipMemsetAsync((char*)d_ws + WS_CTL, 0, CTL_ZERO_BYTES, stream) != hipSuccess) return;
    Args a{};
    for (int i = 0; i < 28; ++i) a.in[i] = (const float*)d_in[i];
    a.out = (float*)d_out; a.ws = (unsigned char*)d_ws;
#if MK_PER_PHASE
    for (int ph = 0; ph < NPH; ++ph) { a.ph_lo = ph; a.ph_hi = ph + 1; hipLaunchKernelGGL(mk_fwd, dim3(grid), dim3(NWAVES * 64), LDS_BYTES, stream, a); }
#else
    a.ph_lo = 0; a.ph_hi = NPH;
    hipLaunchKernelGGL(mk_fwd, dim3(grid), dim3(NWAVES * 64), LDS_BYTES, stream, a);
#endif
}
```

```cpp
#include <hip/hip_runtime.h>
#include <cstdio>
#include <cstdint>
namespace pg8 {
#define PG8_LAS __attribute__((address_space(3)))
typedef unsigned short bf16_t;
typedef short bf16x8 __attribute__((ext_vector_type(8)));
typedef float f32x4 __attribute__((ext_vector_type(4)));
typedef unsigned u32x4 __attribute__((ext_vector_type(4)));
constexpr int BM = 256, BK = 64, HALF = 128, HTB = HALF * BK * 2  , STAGE_BYTES = 8 * HTB, NXCD = 8, WGM = 8;

__host__ __device__ __forceinline__ int lds_byte(int r, int c) { const int st = (r >> 4) * 2 + (c >> 5), rr = r & 15, cc = c & 31, ob = rr * 64 + cc * 2; return st * 1024 + (ob ^ (((ob >> 9) & 1) << 5)); }
__host__ __device__ __forceinline__ void stage_rc(int b, int& R, int& C) { const int st = b / 1024, sb = b % 1024, swz = sb ^ (((sb >> 9) & 1) << 5); R = (st >> 1) * 16 + swz / 64; C = (st & 1) * 32 + (swz % 64) / 2; }
__host__ __device__ __forceinline__ int perm32(int rho) { const int n = rho >> 4, i = rho & 15; return 8 * (i >> 2) + 4 * n + (i & 3); }

struct Unit { int pm, pn; };
struct Gemm { const bf16_t* A; const bf16_t* Bt; int M, N, K; };

struct StaticOrder {
    int nM, nN, nwg, G, c;
    __host__ __device__ void init(int M, int N, int G_, int c_) { nM = M / BM; nN = N / BM; nwg = nM * nN; G = G_; c = c_; }
    __host__ __device__ bool next(int i, Unit& u) const {
        const long L = (long)i * G + c; if (L >= nwg) return false;
        int wgid = (int)L; { const int q = nwg / NXCD, r = nwg % NXCD, xcd = wgid % NXCD, off = wgid / NXCD; wgid = (xcd < r ? xcd * (q + 1) : r * (q + 1) + (xcd - r) * q) + off; }
        const int nig = WGM * nN, gid = wgid / nig, fm = gid * WGM, gsz = (nM - fm) < WGM ? (nM - fm) : WGM;
        u.pm = fm + ((wgid % nig) % gsz); u.pn = (wgid % nig) / gsz; return true;
    }
    __device__ __forceinline__ void a_ready(const Unit&) const {}
    __device__ __forceinline__ void done(const Unit&) const {}
};
__device__ __forceinline__ unsigned cvt_pk_bf16(float lo, float hi) { unsigned r; asm volatile("v_cvt_pk_bf16_f32 %0, %1, %2" : "=v"(r) : "v"(lo), "v"(hi)); return r; }
__device__ __forceinline__ float fsigmoid(float x) { return __builtin_amdgcn_rcpf(1.0f + __expf(-x)); }
__device__ __forceinline__ float bf_lo(unsigned w) { return __uint_as_float(w << 16); }
__device__ __forceinline__ float bf_hi(unsigned w) { return __uint_as_float(w & 0xffff0000u); }
__device__ __forceinline__ u32x4 pack8(const f32x4 v0, const f32x4 v1) { u32x4 w; w.x = cvt_pk_bf16(v0[0], v0[1]); w.y = cvt_pk_bf16(v0[2], v0[3]); w.z = cvt_pk_bf16(v1[0], v1[1]); w.w = cvt_pk_bf16(v1[2], v1[3]); return w; }
__device__ __forceinline__ void unpack8(const u32x4 w, f32x4& v0, f32x4& v1) { v0 = (f32x4){bf_lo(w.x), bf_hi(w.x), bf_lo(w.y), bf_hi(w.y)}; v1 = (f32x4){bf_lo(w.z), bf_hi(w.z), bf_lo(w.w), bf_hi(w.w)}; }

struct EpiSwiglu {
    static constexpr bool PERM = true, AFTER_DRAIN = false;
    bf16_t* O; int ldc;
    __device__ __forceinline__ void operator()(const f32x4 (&acc)[2][2][4][2], const Unit& u, int wr, int wc, int fr, int fq) const {
        const int row0 = u.pm * BM + wr * 64 + fr, col0 = u.pn * HALF + wc * 32 + 8 * fq;
#pragma unroll
        for (int ai = 0; ai < 2; ++ai)
#pragma unroll
            for (int m = 0; m < 4; ++m) { bf16_t* rowp = O + (size_t)(row0 + ai * HALF + m * 16) * ldc + col0;
                f32x4 v0, v1;
#pragma unroll
                for (int j = 0; j < 4; ++j) { const float g0 = acc[ai][0][m][0][j], g1 = acc[ai][0][m][1][j];
                    v0[j] = g0 * fsigmoid(g0) * acc[ai][1][m][0][j]; v1[j] = g1 * fsigmoid(g1) * acc[ai][1][m][1][j]; }
                *(u32x4*)rowp = pack8(v0, v1); }
    }
};
struct EpiPlain {
    static constexpr bool PERM = true, AFTER_DRAIN = false;
    bf16_t* O; int ldc;
    __device__ __forceinline__ void operator()(const f32x4 (&acc)[2][2][4][2], const Unit& u, int wr, int wc, int fr, int fq) const {
        const int row0 = u.pm * BM + wr * 64 + fr, col0 = u.pn * BM + wc * 32 + 8 * fq;
#pragma unroll
        for (int ai = 0; ai < 2; ++ai)
#pragma unroll
            for (int m = 0; m < 4; ++m) { bf16_t* rowp = O + (size_t)(row0 + ai * HALF + m * 16) * ldc + col0;
#pragma unroll
                for (int bj = 0; bj < 2; ++bj) *(u32x4*)(rowp + bj * HALF) = pack8(acc[ai][bj][m][0], acc[ai][bj][m][1]); }
    }
};

__device__ __forceinline__ unsigned pk4_fp8(float a, float b, float c, float d) { int w = 0; w = __builtin_amdgcn_cvt_pk_fp8_f32(fminf(fmaxf(a, -448.f), 448.f), fminf(fmaxf(b, -448.f), 448.f), w, false);
    w = __builtin_amdgcn_cvt_pk_fp8_f32(fminf(fmaxf(c, -448.f), 448.f), fminf(fmaxf(d, -448.f), 448.f), w, true); return (unsigned)w; }
struct EpiSwiglu8 {
    static constexpr bool PERM = true, AFTER_DRAIN = false;
    unsigned char* O; int ldc; float ascale, oscale;
    __device__ __forceinline__ void operator()(const f32x4 (&acc)[2][2][4][2], const Unit& u, int wr, int wc, int fr, int fq) const {
        const int row0 = u.pm * BM + wr * 64 + fr, col0 = u.pn * HALF + wc * 32 + 8 * fq;
#pragma unroll
        for (int ai = 0; ai < 2; ++ai)
#pragma unroll
            for (int m = 0; m < 4; ++m) { unsigned char* rowp = O + (size_t)(row0 + ai * HALF + m * 16) * ldc + col0;
                f32x4 v0, v1;
#pragma unroll
                for (int j = 0; j < 4; ++j) { const float g0 = acc[ai][0][m][0][j] * ascale, g1 = acc[ai][0][m][1][j] * ascale;
                    v0[j] = g0 * fsigmoid(g0) * (acc[ai][1][m][0][j] * ascale) * oscale; v1[j] = g1 * fsigmoid(g1) * (acc[ai][1][m][1][j] * ascale) * oscale; }
                typedef unsigned u32x2 __attribute__((ext_vector_type(2))); u32x2 w; w.x = pk4_fp8(v0[0], v0[1], v0[2], v0[3]); w.y = pk4_fp8(v1[0], v1[1], v1[2], v1[3]);
                *(u32x2*)rowp = w; }
    }
};
struct EpiPlainS {
    static constexpr bool PERM = true, AFTER_DRAIN = false;
    bf16_t* O; int ldc; float scale;
    __device__ __forceinline__ void operator()(const f32x4 (&acc)[2][2][4][2], const Unit& u, int wr, int wc, int fr, int fq) const {
        const int row0 = u.pm * BM + wr * 64 + fr, col0 = u.pn * BM + wc * 32 + 8 * fq;
#pragma unroll
        for (int ai = 0; ai < 2; ++ai)
#pragma unroll
            for (int m = 0; m < 4; ++m) { bf16_t* rowp = O + (size_t)(row0 + ai * HALF + m * 16) * ldc + col0;
#pragma unroll
                for (int bj = 0; bj < 2; ++bj) *(u32x4*)(rowp + bj * HALF) = pack8(acc[ai][bj][m][0] * scale, acc[ai][bj][m][1] * scale); }
    }
};
struct EpiProj {
    static constexpr bool PERM = true, AFTER_DRAIN = false;
    bf16_t *PA, *PG, *PK, *UA2;
    __device__ __forceinline__ void operator()(const f32x4 (&acc)[2][2][4][2], const Unit& u, int wr, int wc, int fr, int fq) const {
        if (u.pn < 2) {
#pragma unroll
            for (int ai = 0; ai < 2; ++ai)
#pragma unroll
                for (int m = 0; m < 4; ++m) { const int row = u.pm * BM + wr * 64 + fr + ai * HALF + m * 16, bb = row >> 11, t = row & 2047;
#pragma unroll
                    for (int bj = 0; bj < 2; ++bj) { const int col = 256 * u.pn + 128 * bj + wc * 32 + 8 * fq;
                        *(u32x4*)(UA2 + ((size_t)((bb * 32 + (col >> 4)) * 2048 + t)) * 16 + (col & 8)) = pack8(acc[ai][bj][m][0], acc[ai][bj][m][1]); } }
            return; }
        bf16_t* base; int ldc, colt;
        if (u.pn < 6) { base = PA; ldc = 1536; colt = 256 * u.pn; } else if (u.pn < 14) { base = PG; ldc = 2048; colt = 256 * (u.pn - 6); } else { base = PK; ldc = 256; colt = 0; }
        const int row0 = u.pm * BM + wr * 64 + fr, col0 = colt + wc * 32 + 8 * fq;
#pragma unroll
        for (int ai = 0; ai < 2; ++ai)
#pragma unroll
            for (int m = 0; m < 4; ++m) { bf16_t* rowp = base + (size_t)(row0 + ai * HALF + m * 16) * ldc + col0;
#pragma unroll
                for (int bj = 0; bj < 2; ++bj) *(u32x4*)(rowp + bj * HALF) = pack8(acc[ai][bj][m][0], acc[ai][bj][m][1]); }
    }
};
struct EpiGlu {
    static constexpr bool PERM = true, AFTER_DRAIN = false;
    const bf16_t* Y; bf16_t* O;
    __device__ __forceinline__ void operator()(const f32x4 (&acc)[2][2][4][2], const Unit& u, int wr, int wc, int fr, int fq) const {
        const int row0 = u.pm * BM + wr * 64 + fr, col0 = u.pn * BM + wc * 32 + 8 * fq;
#pragma unroll
        for (int ai = 0; ai < 2; ++ai)
#pragma unroll
            for (int m = 0; m < 4; ++m) { const size_t off = (size_t)(row0 + ai * HALF + m * 16) * 512 + col0;
#pragma unroll
                for (int bj = 0; bj < 2; ++bj) { f32x4 y0, y1; unpack8(*(const u32x4*)(Y + off + bj * HALF), y0, y1); f32x4 v0, v1;
#pragma unroll
                    for (int j = 0; j < 4; ++j) { v0[j] = y0[j] * fsigmoid(acc[ai][bj][m][0][j]); v1[j] = y1[j] * fsigmoid(acc[ai][bj][m][1][j]); }
                    *(u32x4*)(O + off + bj * HALF) = pack8(v0, v1); } }
    }
};
template <bool SECOND> struct EpiMerge {
    static constexpr bool PERM = true, AFTER_DRAIN = false;
    const bf16_t* G; int goff; const bf16_t* T; bf16_t* O;
    __device__ __forceinline__ void operator()(const f32x4 (&acc)[2][2][4][2], const Unit& u, int wr, int wc, int fr, int fq) const {
        const int row0 = u.pm * BM + wr * 64 + fr, col0 = u.pn * BM + wc * 32 + 8 * fq;
#pragma unroll
        for (int ai = 0; ai < 2; ++ai)
#pragma unroll
            for (int m = 0; m < 4; ++m) { const size_t row = (size_t)(row0 + ai * HALF + m * 16);
#pragma unroll
                for (int bj = 0; bj < 2; ++bj) { const int col = col0 + bj * HALF; f32x4 g0, g1; unpack8(*(const u32x4*)(G + row * 2048 + goff + col), g0, g1);
                    f32x4 t0 = (f32x4){0.f, 0.f, 0.f, 0.f}, t1 = t0; if (SECOND) unpack8(*(const u32x4*)(T + row * 1024 + col), t0, t1);
                    f32x4 v0, v1;
#pragma unroll
                    for (int j = 0; j < 4; ++j) { v0[j] = t0[j] + fsigmoid(g0[j]) * acc[ai][bj][m][0][j]; v1[j] = t1[j] + fsigmoid(g1[j]) * acc[ai][bj][m][1][j]; }
                    *(u32x4*)(O + row * 1024 + col) = pack8(v0, v1); } }
    }
};
typedef int i32x8 __attribute__((ext_vector_type(8)));
typedef int i32x4v __attribute__((ext_vector_type(4)));
__device__ __forceinline__ i32x8 cat8(const bf16x8 lo, const bf16x8 hi) { const i32x4v a = __builtin_bit_cast(i32x4v, lo), b = __builtin_bit_cast(i32x4v, hi); return __builtin_shufflevector(a, b, 0, 1, 2, 3, 4, 5, 6, 7); }
template <class Epi, class Sched, bool ALIGN_EPI = false, bool SP2 = false, bool F8 = false>
__device__ __forceinline__ void gemm_phase(PG8_LAS unsigned char* lds, const Gemm g, const Sched& S, const Epi& E) {
    const int tid = threadIdx.x, wid = __builtin_amdgcn_readfirstlane(tid >> 6), lane = tid & 63, wr = wid >> 2, wc = wid & 3, fr = lane & 15, fq = lane >> 4;
    const int K = g.K, KB = F8 ? K : 2 * K  , nt = KB / 128;
    unsigned voffA[2], voffB[2];
#pragma unroll
    for (int i = 0; i < 2; ++i) { int R, C; stage_rc(tid * 16 + i * 8192, R, C); const int Rb = Epi::PERM ? ((R & ~31) + perm32(R & 31)) : R;
        voffA[i] = (unsigned)(R * KB + C * 2); voffB[i] = (unsigned)(Rb * KB + C * 2); }
    const size_t kstep = (size_t)(BK * 2);
    const size_t hstep = (size_t)HALF * KB;
    const size_t tstep = 2 * hstep;
    const unsigned ldsw = (unsigned)wid * 1024u;
    const int aoff = lds_byte(wr * 64 + fr, fq * 8), boff = lds_byte(wc * 32 + fr, fq * 8);
#define PG8_SA(b, h) (((b) * 2 + (h)) * HTB)
#define PG8_SB(b, h) ((4 + (b) * 2 + (h)) * HTB)
#define PG8_STAGE(bufoff, gbase, voff) do { _Pragma("unroll") for (int _i = 0; _i < 2; ++_i) \
        __builtin_amdgcn_global_load_lds((const unsigned*)((const char*)(gbase) + (voff)[_i]), (PG8_LAS unsigned*)(lds + (bufoff) + ldsw + _i * 8192), 16, 0, 0); } while (0)
#define PG8_LDA(dst, b, h) do { if constexpr (F8) { _Pragma("unroll") for (int m = 0; m < 4; ++m) dst##8[m] = cat8(*(const PG8_LAS bf16x8*)(lds + PG8_SA(b, h) + aoff + m * 2048), *(const PG8_LAS bf16x8*)(lds + PG8_SA(b, h) + aoff + m * 2048 + 1024)); } else { \
        _Pragma("unroll") for (int m = 0; m < 4; ++m) _Pragma("unroll") for (int k = 0; k < 2; ++k) dst[m][k] = *(const PG8_LAS bf16x8*)(lds + PG8_SA(b, h) + aoff + m * 2048 + k * 1024); } } while (0)
#define PG8_LDB(dst, b, h) do { if constexpr (F8) { _Pragma("unroll") for (int n = 0; n < 2; ++n) dst##8[n] = cat8(*(const PG8_LAS bf16x8*)(lds + PG8_SB(b, h) + boff + n * 2048), *(const PG8_LAS bf16x8*)(lds + PG8_SB(b, h) + boff + n * 2048 + 1024)); } else { \
        _Pragma("unroll") for (int n = 0; n < 2; ++n) _Pragma("unroll") for (int k = 0; k < 2; ++k) dst[n][k] = *(const PG8_LAS bf16x8*)(lds + PG8_SB(b, h) + boff + n * 2048 + k * 1024); } } while (0)
#define PG8_MMA(ai, bj, At, Bt) do { __builtin_amdgcn_s_setprio(1); if constexpr (F8) { _Pragma("unroll") for (int m = 0; m < 4; ++m) _Pragma("unroll") for (int n = 0; n < 2; ++n) \
        acc[ai][bj][m][n] = __builtin_amdgcn_mfma_scale_f32_16x16x128_f8f6f4(Bt##8[n], At##8[m], acc[ai][bj][m][n], 0, 0, 0, 0x7F7F7F7F, 0, 0x7F7F7F7F); \
        _Pragma("unroll") for (int m = 0; m < 4; ++m) _Pragma("unroll") for (int n = 0; n < 2; ++n) asm volatile("" : "+v"(acc[ai][bj][m][n])); } else { \
        _Pragma("unroll") for (int m = 0; m < 4; ++m) _Pragma("unroll") for (int n = 0; n < 2; ++n) _Pragma("unroll") for (int k = 0; k < 2; ++k) \
        acc[ai][bj][m][n] = __builtin_amdgcn_mfma_f32_16x16x32_bf16(Bt[n][k], At[m][k], acc[ai][bj][m][n], 0, 0, 0); } __builtin_amdgcn_s_setprio(0); } while (0)
#define PG8_WAIT_V(n) asm volatile("s_waitcnt vmcnt(" #n ")" ::: "memory")
#define PG8_WAIT_L(n) asm volatile("s_waitcnt lgkmcnt(" #n ")" ::: "memory")
#define PG8_BAR __builtin_amdgcn_s_barrier()
#define PG8_SCHED __builtin_amdgcn_sched_barrier(0)
    Unit cur, nxt; int ui = 0;
    if (!S.next(0, cur)) return;
    f32x4 acc[2][2][4][2];
#pragma unroll
    for (int a = 0; a < 2; ++a)
#pragma unroll
        for (int b = 0; b < 2; ++b)
#pragma unroll
            for (int m = 0; m < 4; ++m)
#pragma unroll
                for (int n = 0; n < 2; ++n) acc[a][b][m][n] = (f32x4){0.f, 0.f, 0.f, 0.f};
    bf16x8 At[4][2], B0[2][2], B1[2][2]; i32x8 At8[4], B08[2], B18[2];
    const char* cA = (const char*)g.A + (size_t)cur.pm * tstep; const char* cB = (const char*)g.Bt + (size_t)cur.pn * tstep;
    S.a_ready(cur);
    if constexpr (SP2) {
        PG8_STAGE(PG8_SB(0, 0), cB, voffB); PG8_STAGE(PG8_SB(0, 1), cB + hstep, voffB); PG8_STAGE(PG8_SA(0, 0), cA, voffA); PG8_STAGE(PG8_SA(0, 1), cA + hstep, voffA);
        if (wr == 1) PG8_BAR;
        PG8_WAIT_V(2); PG8_BAR;
        PG8_STAGE(PG8_SB(1, 0), cB + kstep, voffB); PG8_STAGE(PG8_SA(1, 0), cA + kstep, voffA); PG8_STAGE(PG8_SB(1, 1), cB + hstep + kstep, voffB);
        PG8_WAIT_V(6); PG8_BAR;
    } else {
        PG8_STAGE(PG8_SB(0, 0), cB, voffB); PG8_STAGE(PG8_SA(0, 0), cA, voffA); PG8_STAGE(PG8_SB(0, 1), cB + hstep, voffB); PG8_STAGE(PG8_SA(0, 1), cA + hstep, voffA);
        if (wr == 1) PG8_BAR;
        PG8_WAIT_V(4); PG8_BAR;
        PG8_STAGE(PG8_SB(1, 0), cB + kstep, voffB); PG8_STAGE(PG8_SA(1, 0), cA + kstep, voffA); PG8_STAGE(PG8_SB(1, 1), cB + hstep + kstep, voffB);
        PG8_WAIT_V(6); PG8_BAR;
    }
    for (;;) {
        const bool has_next = S.next(ui + 1, nxt);
        const char* nA = has_next ? (const char*)g.A + (size_t)nxt.pm * tstep : cA; const char* nB = has_next ? (const char*)g.Bt + (size_t)nxt.pn * tstep : cB;
        for (int t = 0; t < nt; t += 2) {
            const bool last = (t == nt - 2);
            const char* a1 = cA + (size_t)(t + 1) * kstep;
            const char* a2 = last ? nA : cA + (size_t)(t + 2) * kstep; const char* b2 = last ? nB : cB + (size_t)(t + 2) * kstep;
            const char* a3 = a2 + kstep; const char* b3 = b2 + kstep;
            if (last && has_next) S.a_ready(nxt);
            if constexpr (SP2) {
            PG8_LDB(B0, 0, 0); PG8_LDB(B1, 0, 1); PG8_SCHED; PG8_LDA(At, 0, 0); PG8_STAGE(PG8_SA(1, 1), a1 + hstep, voffA);
            PG8_WAIT_V(8); PG8_WAIT_L(0); PG8_BAR; PG8_MMA(0, 0, At, B0); PG8_MMA(0, 1, At, B1); PG8_BAR; PG8_SCHED;
            PG8_LDA(At, 0, 1); PG8_STAGE(PG8_SB(0, 0), b2, voffB); PG8_STAGE(PG8_SB(0, 1), b2 + hstep, voffB); PG8_STAGE(PG8_SA(0, 0), a2, voffA);
            PG8_WAIT_V(8); PG8_WAIT_L(0); PG8_BAR; PG8_MMA(1, 0, At, B0); PG8_MMA(1, 1, At, B1); PG8_BAR; PG8_SCHED;
            PG8_LDB(B0, 1, 0); PG8_LDB(B1, 1, 1); PG8_SCHED; PG8_LDA(At, 1, 0); PG8_STAGE(PG8_SA(0, 1), a2 + hstep, voffA);
            PG8_WAIT_V(8); PG8_WAIT_L(0); PG8_BAR; PG8_MMA(0, 0, At, B0); PG8_MMA(0, 1, At, B1); PG8_BAR; PG8_SCHED;
            PG8_LDA(At, 1, 1); PG8_STAGE(PG8_SB(1, 0), b3, voffB); PG8_STAGE(PG8_SB(1, 1), b3 + hstep, voffB); PG8_STAGE(PG8_SA(1, 0), a3, voffA);
            PG8_WAIT_V(8); PG8_WAIT_L(0); PG8_BAR; PG8_MMA(1, 0, At, B0); PG8_MMA(1, 1, At, B1); PG8_BAR; PG8_SCHED;
            } else {
            PG8_LDB(B0, 0, 0); PG8_SCHED; PG8_LDA(At, 0, 0); PG8_STAGE(PG8_SA(1, 1), a1 + hstep, voffA);
            PG8_WAIT_L(8); PG8_BAR; PG8_WAIT_L(0); PG8_MMA(0, 0, At, B0); PG8_BAR; PG8_SCHED;
            PG8_LDB(B1, 0, 1); PG8_STAGE(PG8_SB(0, 0), b2, voffB);
            PG8_BAR; PG8_WAIT_L(0); PG8_MMA(0, 1, At, B1); PG8_BAR;
            PG8_LDA(At, 0, 1); PG8_STAGE(PG8_SA(0, 0), a2, voffA);
            PG8_BAR; PG8_WAIT_L(0); PG8_MMA(1, 0, At, B0); PG8_BAR; PG8_SCHED;
            PG8_STAGE(PG8_SB(0, 1), b2 + hstep, voffB);
            PG8_WAIT_V(6); PG8_BAR; PG8_MMA(1, 1, At, B1); PG8_BAR;
            PG8_LDB(B0, 1, 0); PG8_SCHED; PG8_LDA(At, 1, 0); PG8_STAGE(PG8_SA(0, 1), a2 + hstep, voffA);
            PG8_WAIT_L(8); PG8_BAR; PG8_WAIT_L(0); PG8_MMA(0, 0, At, B0); PG8_BAR; PG8_SCHED;
            PG8_LDB(B1, 1, 1); PG8_STAGE(PG8_SB(1, 0), b3, voffB);
            PG8_BAR; PG8_WAIT_L(0); PG8_MMA(0, 1, At, B1); PG8_BAR;
            PG8_LDA(At, 1, 1); PG8_STAGE(PG8_SA(1, 0), a3, voffA);
            PG8_BAR; PG8_WAIT_L(0); PG8_MMA(1, 0, At, B0); PG8_BAR; PG8_SCHED;
            PG8_STAGE(PG8_SB(1, 1), b3 + hstep, voffB);
            PG8_WAIT_V(6); PG8_BAR; PG8_MMA(1, 1, At, B1); PG8_BAR;
            }
        }
        if constexpr (ALIGN_EPI) { if (wr == 0) PG8_BAR; }
        if constexpr (!Epi::AFTER_DRAIN) { E(acc, cur, wr, wc, fr, fq); S.done(cur); }
        if (!has_next) break;
#pragma unroll
        for (int a = 0; a < 2; ++a)
#pragma unroll
            for (int b = 0; b < 2; ++b)
#pragma unroll
                for (int m = 0; m < 4; ++m)
#pragma unroll
                    for (int n = 0; n < 2; ++n) acc[a][b][m][n] = (f32x4){0.f, 0.f, 0.f, 0.f};
        cur = nxt; cA = nA; cB = nB; ++ui;
        if constexpr (ALIGN_EPI) { if (wr == 1) PG8_BAR; }
    }
    PG8_WAIT_V(0);
    if constexpr (!ALIGN_EPI) { if (wr == 0) PG8_BAR; }
    PG8_BAR;
    if constexpr (Epi::AFTER_DRAIN) { E.fused(acc, cur, wr, wc, fr, fq, lds, wid, lane); S.done(cur); }
#undef PG8_SA
#undef PG8_SB
#undef PG8_STAGE
#undef PG8_LDA
#undef PG8_LDB
#undef PG8_MMA
#undef PG8_WAIT_V
#undef PG8_WAIT_L
#undef PG8_BAR
#undef PG8_SCHED
}
}
#ifndef PG8_SP2
#define PG8_SP2 true
#endif
#ifndef PG8_ALIGN
#define PG8_ALIGN true
#endif
#ifndef MK_PER_PHASE
#define MK_PER_PHASE 0
#endif
#ifndef REP_S5
#define REP_S5 1
#endif
#ifndef REP_DSA
#define REP_DSA 1
#endif
#ifndef REP_G1
#define REP_G1 1
#endif
constexpr int NWAVES = 8;
constexpr int NPH = 14;

constexpr int NB = 16, SEQ = 2048, D = 1024, NMETA = 16, DFF = 2816;
constexpr int R = NB * SEQ;
constexpr int NG = 32, NP = 64, NM = 16;
constexpr float RMS_EPS = 1e-6f;

constexpr size_t MiB = 1u << 20;
constexpr size_t WS_CTL = 0, CTL_ZERO_BYTES = 1 * MiB;
constexpr size_t WS_WT1 = 2 * MiB, WS_WT2 = 13 * MiB, WS_WT3 = 19 * MiB, WS_WT4 = 27 * MiB, WS_WT5 = 38 * MiB;
constexpr size_t WS_WGLU = 44 * MiB, WS_WA = 45 * MiB, WS_WB = 46 * MiB, WS_WOUT = 47 * MiB;
constexpr size_t WS_KS = 50 * MiB, WS_KO = 58 * MiB, WS_KI = 66 * MiB;
constexpr size_t WS_META = 67 * MiB;
constexpr size_t MO_AM1 = 0, MO_ACTM = 32768, MO_FM = 131072, MO_AM2 = 262144, MO_PMU = 294912, MO_PMK = 311296;
constexpr size_t WS_HN = 68 * MiB;
constexpr size_t WS_F = 132 * MiB;
constexpr size_t WS_BIG = 196 * MiB;
constexpr size_t WS_PA = WS_BIG, WS_PG = WS_BIG + 96 * MiB, WS_PK = WS_BIG + 224 * MiB, WS_HB = WS_BIG + 240 * MiB  , WS_END = WS_BIG + 304 * MiB;
constexpr size_t WS_UA2 = WS_F + 32 * MiB;
constexpr int CW_BAR = 4096;

constexpr int LDS_BYTES = 155648;
constexpr int MISC_OFF = 154624;

#define GAS __attribute__((address_space(1)))
#define LAS __attribute__((address_space(3)))
typedef unsigned short bf16;
typedef unsigned v4u __attribute__((ext_vector_type(4)));
typedef unsigned v2u __attribute__((ext_vector_type(2)));
typedef float f32x4 __attribute__((ext_vector_type(4)));
typedef short bf16x8 __attribute__((ext_vector_type(8)));
#define LDS_WAIT() asm volatile("s_waitcnt lgkmcnt(0)" ::: "memory")
#define VM_WAIT() asm volatile("s_waitcnt vmcnt(0)" ::: "memory")
__device__ __forceinline__ unsigned f2bf(float f) { unsigned u = __builtin_bit_cast(unsigned, f); return (u + 0x7fffu + ((u >> 16) & 1u)) >> 16; }
__device__ __forceinline__ unsigned pk2(float lo, float hi) { return f2bf(lo) | (f2bf(hi) << 16); }
__device__ __forceinline__ float bflo(unsigned w) { return __uint_as_float(w << 16); }
__device__ __forceinline__ float bfhi(unsigned w) { return __uint_as_float(w & 0xffff0000u); }
__device__ __forceinline__ float bf2f(bf16 v) { return __uint_as_float(((unsigned)v) << 16); }
__device__ __forceinline__ float fsig(float x) { return __builtin_amdgcn_rcpf(1.0f + __expf(-x)); }

#define XB_TMO      128
#define XB_XCNT(j)  (256  + 64 * (j))
#define XB_XSUB(j)  (1280 + 64 * (j))
#define XB_XGEN(j)  (2304 + 64 * (j))
#define XB_TOP      3328
#define XB_TOPGEN   3392
#define XCD_BAR_WORDS 3456
#define XB_SPIN_CAP (1u << 18)
__device__ __forceinline__ unsigned xb_ld(unsigned* p)              { return __hip_atomic_load(p, __ATOMIC_RELAXED, __HIP_MEMORY_SCOPE_AGENT); }
__device__ __forceinline__ unsigned xb_add(unsigned* p, unsigned v) { return __hip_atomic_fetch_add(p, v, __ATOMIC_RELAXED, __HIP_MEMORY_SCOPE_AGENT); }
__device__ __forceinline__ unsigned xb_xcc_id() { return (unsigned)__builtin_amdgcn_s_getreg((3 << 11) | 20) & 0xFu; }
#define XB_SPIN(cond, bar) do { unsigned _sp = 0; while (cond) { __builtin_amdgcn_s_sleep(1); \
    if ((++_sp & 255u) == 0u) { if (xb_ld(&(bar)[XB_TMO])) break; if (_sp > XB_SPIN_CAP) { atomicAdd(&(bar)[XB_TMO], 1u); break; } } } } while (0)
struct XcdBarrier { unsigned* bar; unsigned x; volatile LAS unsigned* st; };
__device__ __forceinline__ XcdBarrier xcd_barrier_post(unsigned* bar, volatile LAS unsigned* st) {
    XcdBarrier b; b.bar = bar; b.x = xb_xcc_id(); b.st = st;
    if (threadIdx.x == 0) (void)xb_add(&bar[XB_XCNT(b.x)], 1u);
    return b;
}
__device__ __forceinline__ void xcd_barrier_complete(unsigned* bar, unsigned x, unsigned& nloc, unsigned& nx) {
    const unsigned G = gridDim.x * gridDim.y * gridDim.z;
    unsigned sum, cnt, mine, sp = 0u;
    for (;;) {
        sum = 0u; cnt = 0u; mine = 0u;
#pragma unroll
        for (unsigned j = 0; j < 16; ++j) { const unsigned c = xb_ld(&bar[XB_XCNT(j)]); sum += c; cnt += (c > 0u) ? 1u : 0u; mine = (j == x) ? c : mine; }
        if (sum == G) break;
        __builtin_amdgcn_s_sleep(1);
        if ((++sp & 255u) == 0u) { if (xb_ld(&bar[XB_TMO])) break; if (sp > XB_SPIN_CAP) { atomicAdd(&bar[XB_TMO], 1u); break; } }
    }
    nloc = mine > 0u ? mine : 1u; nx = cnt > 0u ? cnt : 1u;
}
__device__ __forceinline__ void xcd_barrier(const XcdBarrier& b) {
    asm volatile("s_waitcnt vmcnt(0)" ::: "memory");
    __syncthreads();
    if (threadIdx.x == 0) {
        unsigned* bar = b.bar;
        __builtin_amdgcn_s_waitcnt(0);
        unsigned nloc = b.st[0], nx = b.st[1];
        if (nloc == 0u) { xcd_barrier_complete(bar, b.x, nloc, nx); b.st[0] = nloc; b.st[1] = nx; }
        const unsigned old = xb_add(&bar[XB_XSUB(b.x)], 1u);
        const unsigned gen = old / nloc;
        if (old + 1u == (gen + 1u) * nloc) {
            __builtin_amdgcn_fence(__ATOMIC_RELEASE, "agent");
            asm volatile("s_waitcnt vmcnt(0)" ::: "memory");
            const unsigned og = xb_add(&bar[XB_TOP], 1u);
            const unsigned tg = og / nx;
            if (og + 1u == (tg + 1u) * nx) xb_add(&bar[XB_TOPGEN], 1u);
            else XB_SPIN(xb_ld(&bar[XB_TOPGEN]) == tg, bar);
            __builtin_amdgcn_fence(__ATOMIC_ACQUIRE, "agent");
            xb_add(&bar[XB_XGEN(b.x)], 1u);
            asm volatile("s_waitcnt vmcnt(0)" ::: "memory");
        } else {
            XB_SPIN(xb_ld(&bar[XB_XGEN(b.x)]) == gen, bar);
            __builtin_amdgcn_fence(__ATOMIC_ACQUIRE, "agent");
            asm volatile("s_waitcnt vmcnt(0)" ::: "memory");
        }
    }
    __syncthreads();
}

__device__ __forceinline__ float wave_sum(float v) {
#pragma unroll
    for (int o = 1; o < 64; o <<= 1) v += __shfl_xor(v, o);
    return v;
}
__device__ __forceinline__ f32x4 mfma16(bf16x8 a, bf16x8 b, f32x4 c) { return __builtin_amdgcn_mfma_f32_16x16x32_bf16(a, b, c, 0, 0, 0); }

__device__ __forceinline__ void transpose_item(const float* W, int Nsrc, int K, bf16* WT, int k0, int drow0, int srccol, LAS float* scr, int lane) {
#pragma unroll 8
    for (int i = 0; i < 32; ++i) { const int kk = 2 * i + (lane >> 5); scr[kk * 33 + (lane & 31)] = (srccol >= 0) ? W[(size_t)(k0 + kk) * Nsrc + srccol] : 0.f; }
    LDS_WAIT(); asm volatile("" ::: "memory");
    const int c = lane & 7;
#pragma unroll
    for (int j = 0; j < 4; ++j) { const int n = (lane >> 3) + 8 * j; const LAS float* s = scr + (8 * c) * 33 + n;
        v4u o; o.x = pk2(s[0 * 33], s[1 * 33]); o.y = pk2(s[2 * 33], s[3 * 33]); o.z = pk2(s[4 * 33], s[5 * 33]); o.w = pk2(s[6 * 33], s[7 * 33]);
        *(v4u*)(WT + (size_t)(drow0 + n) * K + k0 + 8 * c) = o; }
    LDS_WAIT(); asm volatile("" ::: "memory");
}

__device__ __forceinline__ unsigned pk4q(float a, float b, float c, float d) { int w = 0; w = __builtin_amdgcn_cvt_pk_fp8_f32(fminf(fmaxf(a, -448.f), 448.f), fminf(fmaxf(b, -448.f), 448.f), w, false);
    w = __builtin_amdgcn_cvt_pk_fp8_f32(fminf(fmaxf(c, -448.f), 448.f), fminf(fmaxf(d, -448.f), 448.f), w, true); return (unsigned)w; }
__device__ __forceinline__ void transpose_item8(const float* W, int Nsrc, int K, unsigned char* WT8, int k0, int drow0, int srccol, LAS float* scr, int lane) {
#pragma unroll 8
    for (int i = 0; i < 32; ++i) { const int kk = 2 * i + (lane >> 5); scr[kk * 33 + (lane & 31)] = W[(size_t)(k0 + kk) * Nsrc + srccol] * 64.0f; }
    LDS_WAIT(); asm volatile("" ::: "memory");
    const int c = lane & 7;
#pragma unroll
    for (int j = 0; j < 4; ++j) { const int n = (lane >> 3) + 8 * j; const LAS float* sp = scr + (8 * c) * 33 + n;
        v2u o; o.x = pk4q(sp[0 * 33], sp[1 * 33], sp[2 * 33], sp[3 * 33]); o.y = pk4q(sp[4 * 33], sp[5 * 33], sp[6 * 33], sp[7 * 33]);
        *(v2u*)(WT8 + (size_t)(drow0 + n) * K + k0 + 8 * c) = o; }
    LDS_WAIT(); asm volatile("" ::: "memory");
}
__device__ __forceinline__ int win_srccol(int d) {
    if (d < 1024) return d;
    if (d < 1536) return 1096 + (d - 1024);
    if (d < 3584) return 1736 + (d - 1536);
    if (d < 3648) return 1024 + (d - 3584);
    if (d < 3712) return 1608 + (d - 3648);
    if (d < 3776) return 1672 + (d - 3712);
    if (d < 3784) return 1088 + (d - 3776);
    return -1;
}
__device__ __forceinline__ void norm_row_to_bf16(const float* xrow, const float* g, bf16* orow, int lane) {
    f32x4 v[4]; float ss = 0.f;
#pragma unroll
    for (int j = 0; j < 4; ++j) { v[j] = ((const f32x4*)xrow)[lane + 64 * j]; ss += (v[j].x * v[j].x + v[j].y * v[j].y) + (v[j].z * v[j].z + v[j].w * v[j].w); }
    const float rs = rsqrtf(wave_sum(ss) * (1.f / D) + RMS_EPS);
#pragma unroll
    for (int j = 0; j < 4; ++j) { const f32x4 gv = ((const f32x4*)g)[lane + 64 * j]; v2u o; o.x = pk2(v[j].x * rs * gv.x, v[j].y * rs * gv.y); o.y = pk2(v[j].z * rs * gv.z, v[j].w * rs * gv.w);
        ((v2u*)orow)[lane + 64 * j] = o; }
}
template <bool BASE_BF16, bool OUT_BF16, bool HN_F8 = false>
__device__ __forceinline__ void row_update(const bf16* frow, const void* base, void* outrow, bf16* hnrow, const float* gpost, const float* gnext, float scale, int lane) {
    f32x4 f[4], h[4]; float ss = 0.f;
#pragma unroll
    for (int j = 0; j < 4; ++j) { const v2u w = ((const v2u*)frow)[lane + 64 * j]; f[j] = (f32x4){bflo(w.x), bfhi(w.x), bflo(w.y), bfhi(w.y)};
        ss += (f[j].x * f[j].x + f[j].y * f[j].y) + (f[j].z * f[j].z + f[j].w * f[j].w); }
    const float rs = rsqrtf(wave_sum(ss) * (1.f / D) + RMS_EPS) * scale; float s2 = 0.f;
#pragma unroll
    for (int j = 0; j < 4; ++j) { const f32x4 gv = ((const f32x4*)gpost)[lane + 64 * j]; f32x4 bv;
        if (BASE_BF16) { const v2u w = ((const v2u*)base)[lane + 64 * j]; bv = (f32x4){bflo(w.x), bfhi(w.x), bflo(w.y), bfhi(w.y)}; } else bv = ((const f32x4*)base)[lane + 64 * j];
        h[j] = bv + f[j] * rs * gv; s2 += (h[j].x * h[j].x + h[j].y * h[j].y) + (h[j].z * h[j].z + h[j].w * h[j].w); }
    if (outrow) {
#pragma unroll
        for (int j = 0; j < 4; ++j) { if (OUT_BF16) { v2u o; o.x = pk2(h[j].x, h[j].y); o.y = pk2(h[j].z, h[j].w); ((v2u*)outrow)[lane + 64 * j] = o; } else ((f32x4*)outrow)[lane + 64 * j] = h[j]; } }
    if (hnrow) { const float r2 = rsqrtf(wave_sum(s2) * (1.f / D) + RMS_EPS);
#pragma unroll
        for (int j = 0; j < 4; ++j) { const f32x4 gv = ((const f32x4*)gnext)[lane + 64 * j];
            if (HN_F8) { const float q = 4.0f * r2; ((unsigned*)hnrow)[lane + 64 * j] = pk4q(h[j].x * q * gv.x, h[j].y * q * gv.y, h[j].z * q * gv.z, h[j].w * q * gv.w); }
            else { v2u o; o.x = pk2(h[j].x * r2 * gv.x, h[j].y * r2 * gv.y); o.y = pk2(h[j].z * r2 * gv.z, h[j].w * r2 * gv.w); ((v2u*)hnrow)[lane + 64 * j] = o; } } }
}
__device__ __forceinline__ f32x4 meta_tile(const bf16* A, const bf16* B, int K, int lane) {
    const int fr = lane & 15, kq = lane >> 4; const bf16* ap = A + (size_t)fr * K + 8 * kq; const bf16* bp = B + (size_t)fr * K + 8 * kq;
    f32x4 acc = (f32x4){0.f, 0.f, 0.f, 0.f};
#pragma unroll 4
    for (int k = 0; k < K; k += 32) { const bf16x8 a = *(const bf16x8*)(ap + k); const bf16x8 b = *(const bf16x8*)(bp + k); acc = mfma16(a, b, acc); }
    return acc;
}

struct Args { const float* in[28]; float* out; unsigned char* ws; int ph_lo, ph_hi; };

__device__ __forceinline__ void s5_table_item(const Args& a, int item, LAS float* sc, int tid) {
    const float* lam_re = a.in[15]; const float* lam_im = a.in[16]; const float* log_dt = a.in[17];
    const float* b_re = a.in[18]; const float* b_im = a.in[19]; const float* c_re = a.in[20]; const float* c_im = a.in[21]; const float* dsk = a.in[22];
    const int type = item / 2048, g = (item % 2048) / 64, idx = item % 64;
    LAS float* ap_re = sc; LAS float* ap_im = sc + 64; LAS float* w_re = sc + 128; LAS float* w_im = sc + 192;
    __syncthreads();
    if (tid < 64) { const int p = tid; const float lr = lam_re[g * 64 + p], li = lam_im[g * 64 + p], dt = expf(log_dt[g]);
        const float ang = li * dt, mag = expf(lr * dt); float s1, c1; sincosf(ang, &s1, &c1);
        const float a_re = mag * c1, a_im = mag * s1, den = lr * lr + li * li, nr = a_re - 1.0f, ni = a_im;
        const float cf_re = (nr * lr + ni * li) / den, cf_im = (ni * lr - nr * li) / den;
        const int n = (type == 0) ? idx : (type == 1 ? 63 - idx : idx + 1);
        float sn, cn; sincosf((float)n * ang, &sn, &cn); const float mn = expf((float)n * lr * dt);
        const float pr = mn * cn, pi = mn * sn;
        ap_re[p] = pr; ap_im[p] = pi; w_re[p] = pr * cf_re - pi * cf_im; w_im[p] = pr * cf_im + pi * cf_re; }
    __syncthreads();
    if (type == 0) {
        if (tid < 256) { const int m = tid >> 4, mp = tid & 15; float s = 0.f;
            for (int p = 0; p < 64; ++p) { const float br = b_re[(g * 64 + p) * 16 + mp], bi = b_im[(g * 64 + p) * 16 + mp];
                const float zr = w_re[p] * br - w_im[p] * bi, zi = w_re[p] * bi + w_im[p] * br;
                s += c_re[(g * 16 + m) * 64 + p] * zr - c_im[(g * 16 + m) * 64 + p] * zi; }
            if (idx == 0 && m == mp) s += dsk[g * 16 + m];
            ((bf16*)(a.ws + WS_KI))[((g * 64 + idx) * 16 + m) * 16 + mp] = (bf16)f2bf(s); }
    } else if (type == 1) {
#pragma unroll
        for (int k = 0; k < 4; ++k) { const int e = tid + 512 * k, n = e >> 4, mp = e & 15, p = n & 63;
            const float br = b_re[(g * 64 + p) * 16 + mp], bi = b_im[(g * 64 + p) * 16 + mp];
            const float zr = w_re[p] * br - w_im[p] * bi, zi = w_re[p] * bi + w_im[p] * br;
            ((bf16*)(a.ws + WS_KS))[((size_t)(g * 64 + idx) * 128 + n) * 16 + mp] = (bf16)f2bf(n < 64 ? zr : zi); }
    } else {
#pragma unroll
        for (int k = 0; k < 4; ++k) { const int e = tid + 512 * k, m = e >> 7, kk = e & 127, p = kk & 63;
            const float cr = c_re[(g * 16 + m) * 64 + p], ci = c_im[(g * 16 + m) * 64 + p];
            const float wr_ = cr * ap_re[p] - ci * ap_im[p], wi_ = cr * ap_im[p] + ci * ap_re[p];
            ((bf16*)(a.ws + WS_KO))[((size_t)(g * 64 + idx) * 16 + m) * 128 + kk] = (bf16)f2bf(kk < 64 ? wr_ : -wi_); }
    }
}

constexpr int S5_U = 0, S5_USTR = 2064, S5_KI = 66048, S5_SLOC = 98816, S5_XINB = 115200, S5_XSTR = 272, S5_MISC = 123904;
__device__ __forceinline__ float gelu_tanh(float x) { const float z = 0.7978845608028654f * (x + 0.044715f * x * x * x); return x * fsig(2.0f * z); }
__device__ __forceinline__ void s5_meta(const Args& a, LAS unsigned char* L, int g, int tid) {
    const int lane = tid & 63; const bf16* PMU = (const bf16*)(a.ws + WS_META + MO_PMU); LAS float* MS = (LAS float*)(L + S5_MISC);
    if (tid < 64) { const int p = lane; const float lr = a.in[15][g * 64 + p], li = a.in[16][g * 64 + p], dt = expf(a.in[17][g]);
        const float ang = li * dt, mag = expf(lr * dt); float s1, c1; sincosf(ang, &s1, &c1);
        const float a_re = mag * c1, a_im = mag * s1, den = lr * lr + li * li, nr = a_re - 1.0f, ni = a_im;
        const float cf_re = (nr * lr + ni * li) / den, cf_im = (ni * lr - nr * li) / den;
        float bb_re[16], bb_im[16];
#pragma unroll
        for (int m = 0; m < 16; ++m) { const float br = a.in[18][(g * 64 + p) * 16 + m], bi = a.in[19][(g * 64 + p) * 16 + m]; bb_re[m] = cf_re * br - cf_im * bi; bb_im[m] = cf_re * bi + cf_im * br; }
        float xr = 0.f, xi = 0.f;
        for (int i = 0; i < 16; ++i) { float ur = 0.f, ui = 0.f;
#pragma unroll
            for (int m = 0; m < 16; ++m) { const float u = bf2f(PMU[i * 512 + 16 * g + m]); ur += bb_re[m] * u; ui += bb_im[m] * u; }
            const float nr2 = a_re * xr - a_im * xi + ur, ni2 = a_re * xi + a_im * xr + ui; xr = nr2; xi = ni2; }
        float s64, c64; sincosf(64.0f * ang, &s64, &c64); const float m64 = expf(64.0f * lr * dt);
        MS[p] = xr; MS[64 + p] = xi; MS[128 + p] = m64 * c64; MS[192 + p] = m64 * s64; }
}
__device__ __forceinline__ void s5_unit(const Args& a, LAS unsigned char* L, int b, int g, int tid) {
    const int lane = tid & 63, w = __builtin_amdgcn_readfirstlane(tid >> 6), fr = lane & 15, kq = lane >> 4;
    const bf16* UA2 = (const bf16*)(a.ws + WS_UA2) + (size_t)(b * 32 + g) * 2048 * 16;
    const bf16* KS = (const bf16*)(a.ws + WS_KS); const bf16* KO = (const bf16*)(a.ws + WS_KO); const bf16* KI = (const bf16*)(a.ws + WS_KI);
    bf16* YA = (bf16*)(a.ws + WS_F);
    LAS float* SLOC = (LAS float*)(L + S5_SLOC); LAS float* MS = (LAS float*)(L + S5_MISC);
    __syncthreads();
#pragma unroll
    for (int k = 0; k < 8; ++k) { const int idx = tid + 512 * k, t = idx >> 1, hf = idx & 1;
        const v4u v = *(const v4u*)(UA2 + (size_t)idx * 8);
        *(LAS v4u*)(L + S5_U + (t >> 6) * S5_USTR + (t & 63) * 32 + 16 * hf) = v; }
#pragma unroll
    for (int k = 0; k < 4; ++k) { const int idx = tid + 512 * k; *(LAS v4u*)(L + S5_KI + idx * 16) = *(const v4u*)(KI + (size_t)g * 16384 + idx * 8); }
    bf16x8 bfr[16];
#pragma unroll
    for (int k = 0; k < 16; ++k) { const int i = 2 * k + (kq >> 1); bfr[k] = *(const bf16x8*)(KS + ((size_t)(g * 64 + i) * 128 + 16 * w + fr) * 16 + 8 * (kq & 1)); }
    __syncthreads();
    { f32x4 acc0 = (f32x4){0.f, 0.f, 0.f, 0.f}, acc1 = acc0;
#pragma unroll
      for (int hb = 0; hb < 2; ++hb) {
          if (hb == 1) {
#pragma unroll
              for (int k = 0; k < 16; ++k) { const int i = 2 * (16 + k) + (kq >> 1); bfr[k] = *(const bf16x8*)(KS + ((size_t)(g * 64 + i) * 128 + 16 * w + fr) * 16 + 8 * (kq & 1)); } }
#pragma unroll
          for (int k = 0; k < 16; ++k) { const int ks = 16 * hb + k;
              const bf16x8 a0 = *(const LAS bf16x8*)(L + S5_U + fr * S5_USTR + (32 * ks + 8 * kq) * 2);
              const bf16x8 a1 = *(const LAS bf16x8*)(L + S5_U + (16 + fr) * S5_USTR + (32 * ks + 8 * kq) * 2);
              acc0 = mfma16(a0, bfr[k], acc0); acc1 = mfma16(a1, bfr[k], acc1); } }
#pragma unroll
      for (int r = 0; r < 4; ++r) { SLOC[(4 * kq + r) * 128 + 16 * w + fr] = acc0[r]; SLOC[(16 + 4 * kq + r) * 128 + 16 * w + fr] = acc1[r]; } }
    bf16x8 ko[4];
#pragma unroll
    for (int ks = 0; ks < 4; ++ks) ko[ks] = *(const bf16x8*)(KO + ((size_t)(g * 64 + w) * 16 + fr) * 128 + 32 * ks + 8 * kq);
    __syncthreads();
    if (w == 0) { const int p = lane; float sr[32], si[32];
#pragma unroll
        for (int c = 0; c < 32; ++c) { sr[c] = SLOC[c * 128 + p]; si[c] = SLOC[c * 128 + 64 + p]; }
        float xr = MS[p], xi = MS[64 + p]; const float ar = MS[128 + p], ai = MS[192 + p];
#pragma unroll
        for (int c = 0; c < 32; ++c) { *(LAS bf16*)(L + S5_XINB + c * S5_XSTR + p * 2) = (bf16)f2bf(xr); *(LAS bf16*)(L + S5_XINB + c * S5_XSTR + (64 + p) * 2) = (bf16)f2bf(xi);
            const float nr2 = ar * xr - ai * xi + sr[c], ni2 = ar * xi + ai * xr + si[c]; xr = nr2; xi = ni2; } }
    __syncthreads();
    for (int jj = 0; jj < 8; ++jj) { const int j = w + 8 * jj;
        bf16x8 kon[4];
#pragma unroll
        for (int ks = 0; ks < 4; ++ks) kon[ks] = ko[ks];
        if (jj < 7) {
#pragma unroll
            for (int ks = 0; ks < 4; ++ks) kon[ks] = *(const bf16x8*)(KO + ((size_t)(g * 64 + j + 8) * 16 + fr) * 128 + 32 * ks + 8 * kq); }
        f32x4 acc0 = (f32x4){0.f, 0.f, 0.f, 0.f}, acc1 = acc0;
#pragma unroll
        for (int ks = 0; ks < 4; ++ks) {
            const bf16x8 a0 = *(const LAS bf16x8*)(L + S5_XINB + fr * S5_XSTR + (32 * ks + 8 * kq) * 2);
            const bf16x8 a1 = *(const LAS bf16x8*)(L + S5_XINB + (16 + fr) * S5_XSTR + (32 * ks + 8 * kq) * 2);
            acc0 = mfma16(a0, ko[ks], acc0); acc1 = mfma16(a1, ko[ks], acc1); }
        const int nks = (j >> 1) + 1;
#pragma unroll 2
        for (int ks = 0; ks < nks; ++ks) { const int i = 2 * ks + (kq >> 1), tau = j - i;
            bf16x8 bq = *(const LAS bf16x8*)(L + S5_KI + (((tau < 0 ? 0 : tau) * 16 + fr) * 16 + 8 * (kq & 1)) * 2);
            if (tau < 0) bq = (bf16x8){0, 0, 0, 0, 0, 0, 0, 0};
            const bf16x8 a0 = *(const LAS bf16x8*)(L + S5_U + fr * S5_USTR + (32 * ks + 8 * kq) * 2);
            const bf16x8 a1 = *(const LAS bf16x8*)(L + S5_U + (16 + fr) * S5_USTR + (32 * ks + 8 * kq) * 2);
            acc0 = mfma16(a0, bq, acc0); acc1 = mfma16(a1, bq, acc1); }
#pragma unroll
        for (int r = 0; r < 4; ++r) { const int c0 = 4 * kq + r, c1 = 16 + 4 * kq + r;
            YA[(size_t)(b * 2048 + 64 * c0 + j) * 512 + 16 * g + fr] = (bf16)f2bf(gelu_tanh(acc0[r]));
            YA[(size_t)(b * 2048 + 64 * c1 + j) * 512 + 16 * g + fr] = (bf16)f2bf(gelu_tanh(acc1[r])); }
#pragma unroll
        for (int ks = 0; ks < 4; ++ks) ko[ks] = kon[ks]; }
}

constexpr int DS_SSTR = 2120, DS_TSTR = 144, DS_BUF = 18432  , DS_BT = 36864  , DS_HIST = 135680, DS_MASK = 143872, DS_RB = 152576, DS_TB = 153600;
typedef short s16x4 __attribute__((ext_vector_type(4)));
__device__ __forceinline__ s16x4 tr_read(unsigned addr) { s16x4 r; asm volatile("ds_read_b64_tr_b16 %0, %1" : "=&v"(r) : "v"(addr) : "memory"); return r; }
__device__ __forceinline__ float relu_i(float x) { const int i = __builtin_bit_cast(int, x); return __builtin_bit_cast(float, i > 0 ? i : 0); }
__device__ __forceinline__ unsigned f16key(float f) { const _Float16 hf = (_Float16)f; const unsigned h = (unsigned)__builtin_bit_cast(unsigned short, hf); return (h & 0x8000u) ? (~h & 0xffffu) : (h | 0x8000u); }
__device__ __forceinline__ unsigned cvtpk(float lo, float hi) { unsigned r; asm volatile("v_cvt_pk_bf16_f32 %0, %1, %2" : "=v"(r) : "v"(lo), "v"(hi)); return r; }
__device__ __forceinline__ void dsa_tables(const Args& a, LAS unsigned char* L, int tid) {
    if (tid < 256) { ((LAS float*)(L + DS_RB))[tid] = a.in[25][tid] * 1.44269504f;
        const int n = tid; const int lo = n < 8 ? n : (n < 12 ? 8 : n < 16 ? 9 : n < 23 ? 10 : n < 32 ? 11 : n < 46 ? 12 : n < 64 ? 13 : n < 91 ? 14 : 15);
        ((LAS int*)(L + DS_TB))[tid] = lo; }
}

__device__ __forceinline__ int wave_incl_scan(int x) {
    int v = x;
    v += __builtin_amdgcn_update_dpp(0, v, 0x111, 0xf, 0xf, false);
    v += __builtin_amdgcn_update_dpp(0, v, 0x112, 0xf, 0xf, false);
    v += __builtin_amdgcn_update_dpp(0, v, 0x114, 0xf, 0xf, false);
    v += __builtin_amdgcn_update_dpp(0, v, 0x118, 0xf, 0xf, false);
    v += __builtin_amdgcn_update_dpp(0, v, 0x142, 0xa, 0xf, false);
    v += __builtin_amdgcn_update_dpp(0, v, 0x143, 0xc, 0xf, false);
    return v;
}
template <int NE>
__device__ __forceinline__ void dsa_select(LAS unsigned char* L, int c, int nt64, int w, int lane) {
    LAS unsigned short* S16 = (LAS unsigned short*)L; LAS unsigned long long* MASK = (LAS unsigned long long*)(L + DS_MASK);
    LAS unsigned* H = (LAS unsigned*)(L + DS_HIST) + w * 256;
    const int rl = 63 - lane;
    for (int qq = 0; qq < 4; ++qq) { const int q = 4 * w + qq; const LAS unsigned short* Sq = S16 + q * DS_SSTR; unsigned tkey = 0u;
        unsigned kr[NE];
#pragma unroll
        for (int e = 0; e < NE; ++e) kr[e] = (unsigned)Sq[64 * e + lane];
        if (c >= 4) { unsigned prefix = 0u; int kth = 256;
#pragma unroll
            for (int pass = 0; pass < 2; ++pass) {
                H[lane] = 0u; H[lane + 64] = 0u; H[lane + 128] = 0u; H[lane + 192] = 0u; LDS_WAIT();
#pragma unroll
                for (int e = 0; e < NE; ++e) { const unsigned key = kr[e]; const bool in = (pass == 0) ? (key != 0u) : ((key >> 8) == prefix);
                    if (in) (void)__hip_atomic_fetch_add(&H[pass == 0 ? (key >> 8) : (key & 255u)], 1u, __ATOMIC_RELAXED, __HIP_MEMORY_SCOPE_WORKGROUP); }
                LDS_WAIT();
                const unsigned h0 = H[4 * rl], h1 = H[4 * rl + 1], h2 = H[4 * rl + 2], h3 = H[4 * rl + 3]; const int t = (int)(h0 + h1 + h2 + h3);
                const int sfx = wave_incl_scan(t), above = sfx - t; const bool has = (above < kth) && (above + t >= kth);
                const unsigned long long bm = __ballot(has); const int src = bm ? (__ffsll((long long)bm) - 1) : 0;
                int cum = above, B; if (cum + (int)h3 >= kth) B = 3; else { cum += (int)h3; if (cum + (int)h2 >= kth) B = 2; else { cum += (int)h2; if (cum + (int)h1 >= kth) B = 1; else { cum += (int)h1; B = 0; } } }
                const int bin = __builtin_amdgcn_readlane(4 * rl + B, src); kth = __builtin_amdgcn_readlane(kth - cum, src);
                prefix = (prefix << 8) | (unsigned)bin; LDS_WAIT(); }
            tkey = prefix; }
        unsigned mlo = 0u, mhi = 0u;
#pragma unroll
        for (int e = 0; e < NE; ++e) { const int s = 64 * e + lane; const bool sel = ((s < 16) || (s >= 64)) && (kr[e] >= tkey);
            const unsigned long long m = __ballot(sel); mlo = (lane == e) ? (unsigned)m : mlo; mhi = (lane == e) ? (unsigned)(m >> 32) : mhi; }
        if (lane < nt64) MASK[q * 34 + lane] = ((unsigned long long)mhi << 32) | mlo; }
}
__device__ __forceinline__ void dsa_unit(const Args& a, LAS unsigned char* L, int b, int uq, int tid) {
    const int lane = tid & 63, w = __builtin_amdgcn_readfirstlane(tid >> 6), fr = lane & 15, kq = lane >> 4;
    const bf16* PA = (const bf16*)(a.ws + WS_PA); const bf16* PK = (const bf16*)(a.ws + WS_PK); const bf16* PMK = (const bf16*)(a.ws + WS_META + MO_PMK);
    bf16* YB = (bf16*)(a.ws + WS_HN) + (size_t)R * 512;
    const int c = 1 + (uq >> 1), nt64 = c + 1, qrow0 = b * 2048 + 32 * uq;
    LAS unsigned short* S16 = (LAS unsigned short*)L; LAS unsigned long long* MASK = (LAS unsigned long long*)(L + DS_MASK);
    const LAS float* RB = (const LAS float*)(L + DS_RB); const LAS int* TB = (const LAS int*)(L + DS_TB);
    __syncthreads();
    { const int qh = w >> 2; bf16x8 qa[4][2][2]; float wv[4][2][4];
#pragma unroll
      for (int p = 0; p < 4; ++p) {
#pragma unroll
          for (int hf = 0; hf < 2; ++hf)
#pragma unroll
              for (int ks = 0; ks < 2; ++ks) qa[p][hf][ks] = *(const bf16x8*)(PA + (size_t)(qrow0 + 16 * qh + 4 * p + (fr >> 2)) * 1536 + 512 + (4 * hf + (fr & 3)) * 64 + 32 * ks + 8 * kq);
          const v4u wraw = *(const v4u*)(PK + (size_t)(qrow0 + 16 * qh + 4 * p + kq) * 256 + 192);
          wv[p][0][0] = bflo(wraw.x) * 0.04419417382f; wv[p][0][1] = bfhi(wraw.x) * 0.04419417382f; wv[p][0][2] = bflo(wraw.y) * 0.04419417382f; wv[p][0][3] = bfhi(wraw.y) * 0.04419417382f;
          wv[p][1][0] = bflo(wraw.z) * 0.04419417382f; wv[p][1][1] = bfhi(wraw.z) * 0.04419417382f; wv[p][1][2] = bflo(wraw.w) * 0.04419417382f; wv[p][1][3] = bfhi(wraw.w) * 0.04419417382f; }
      const int nkt = 4 * nt64;
      { const int ner = nt64 <= 9 ? 9 : nt64 <= 17 ? 17 : nt64 <= 25 ? 25 : 33;
        for (int kz = 4 * nt64 + (w & 3); kz < 4 * ner; kz += 4) {
#pragma unroll
            for (int p = 0; p < 4; ++p) S16[(16 * qh + 4 * p + kq) * DS_SSTR + 16 * kz + fr] = (unsigned short)0; } }
      if ((w & 3) != 0) {
#pragma unroll
          for (int p = 0; p < 4; ++p) S16[(16 * qh + 4 * p + kq) * DS_SSTR + 16 * (w & 3) + fr] = (unsigned short)0; }
      int kt = (w & 3) == 0 ? 0 : (w & 3) + 4;
      bf16x8 kb0, kb1, kc0, kc1;
      { const bf16* krow = (kt == 0) ? PMK + fr * 256 : PK + (size_t)(b * 2048 + 16 * kt - 64 + fr) * 256; kb0 = *(const bf16x8*)(krow + 8 * kq); kb1 = *(const bf16x8*)(krow + 32 + 8 * kq); }
      { const int k1 = (kt == 0) ? 4 : kt + 4; kc0 = kb0; kc1 = kb1;
        if (k1 < nkt) { const bf16* krow = PK + (size_t)(b * 2048 + 16 * k1 - 64 + fr) * 256; kc0 = *(const bf16x8*)(krow + 8 * kq); kc1 = *(const bf16x8*)(krow + 32 + 8 * kq); } }
      while (kt < nkt) {
          const int ktn = (kt == 0) ? 4 : kt + 4, ktnn = ktn + 4; bf16x8 nb0 = kc0, nb1 = kc1;
          if (ktnn < nkt) { const bf16* krow = PK + (size_t)(b * 2048 + 16 * ktnn - 64 + fr) * 256; nb0 = *(const bf16x8*)(krow + 8 * kq); nb1 = *(const bf16x8*)(krow + 32 + 8 * kq); }
#pragma unroll
          for (int p = 0; p < 4; ++p) { f32x4 aA = (f32x4){0.f, 0.f, 0.f, 0.f}, aB = aA;
              aA = mfma16(qa[p][0][0], kb0, aA); aB = mfma16(qa[p][1][0], kb0, aB); aA = mfma16(qa[p][0][1], kb1, aA); aB = mfma16(qa[p][1][1], kb1, aB);
              const float v = (relu_i(aA[0]) * wv[p][0][0] + relu_i(aA[1]) * wv[p][0][1]) + (relu_i(aA[2]) * wv[p][0][2] + relu_i(aA[3]) * wv[p][0][3])
                            + (relu_i(aB[0]) * wv[p][1][0] + relu_i(aB[1]) * wv[p][1][1]) + (relu_i(aB[2]) * wv[p][1][2] + relu_i(aB[3]) * wv[p][1][3]);
              S16[(16 * qh + 4 * p + kq) * DS_SSTR + 16 * kt + fr] = (unsigned short)f16key(v); }
          kb0 = kc0; kb1 = kc1; kc0 = nb0; kc1 = nb1; kt = ktn; } }
    __syncthreads();
    bf16x8 qb[2][2]; unsigned mkoff[2];
#pragma unroll
    for (int cg = 0; cg < 2; ++cg) { const int q = 4 * w + 2 * cg + (fr >> 3), h = fr & 7; mkoff[cg] = q * 34;
#pragma unroll
        for (int ks = 0; ks < 2; ++ks) qb[cg][ks] = *(const bf16x8*)(PA + (size_t)(qrow0 + q) * 1536 + 1024 + h * 64 + 32 * ks + 8 * kq); }
    const int skey = tid >> 3, spiece = tid & 7;
    v4u kv0 = (v4u){0u, 0u, 0u, 0u}, vv0 = kv0, kv, vv;
    if (skey < 16) { const bf16* krow = PMK + skey * 256; kv0 = *(const v4u*)(krow + 64 + 8 * spiece); vv0 = *(const v4u*)(krow + 128 + 8 * spiece); }
    { const bf16* krow = PK + (size_t)(b * 2048 + skey) * 256; kv = *(const v4u*)(krow + 64 + 8 * spiece); vv = *(const v4u*)(krow + 128 + 8 * spiece); }
    if (nt64 <= 9) dsa_select<9>(L, c, nt64, w, lane);
    else if (nt64 <= 17) dsa_select<17>(L, c, nt64, w, lane);
    else if (nt64 <= 25) dsa_select<25>(L, c, nt64, w, lane);
    else dsa_select<33>(L, c, nt64, w, lane);
    __syncthreads();
    {
      const int hh = fr & 7; const float bfar = RB[15 * 8 + hh];
      float mrun[2] = {-1.0e30f, -1.0e30f}, lrun[2] = {0.f, 0.f}; f32x4 O[2][4];
#pragma unroll
      for (int cg = 0; cg < 2; ++cg)
#pragma unroll
          for (int dt = 0; dt < 4; ++dt) O[cg][dt] = (f32x4){0.f, 0.f, 0.f, 0.f};
      const LAS float* BT = (const LAS float*)(L + DS_BT);
#pragma unroll
      for (int k = 0; k < 4; ++k) { const int e = tid + 512 * k, relc = (e >> 3) - 128, n = relc < 0 ? -relc : relc; ((LAS float*)(L + DS_BT))[e] = RB[(TB[n] + (relc > 0 ? 16 : 0)) * 8 + (e & 7)]; }
      const unsigned ldsV = (unsigned)(size_t)(L) + 9216u + (unsigned)((4 * kq + ((lane & 15) >> 2)) * DS_TSTR + 8 * (lane & 3));
      *(LAS v4u*)(L + skey * DS_TSTR + 16 * spiece) = kv0; *(LAS v4u*)(L + 9216 + skey * DS_TSTR + 16 * spiece) = vv0;
      __syncthreads();
      for (int T = 0; T < nt64; ++T) { const int buf = T & 1;
          v4u kn = kv, vn = vv;
          if (T + 2 < nt64) { const bf16* krow = PK + (size_t)(b * 2048 + 64 * (T + 1) + skey) * 256; kn = *(const v4u*)(krow + 64 + 8 * spiece); vn = *(const v4u*)(krow + 128 + 8 * spiece); }
          const bool nearT = (64 * T > 32 * uq - 90);
          f32x4 lg[2][4];
          { bf16x8 ka[4][2];
#pragma unroll
            for (int sub = 0; sub < 4; ++sub)
#pragma unroll
                for (int ks = 0; ks < 2; ++ks) ka[sub][ks] = *(const LAS bf16x8*)(L + buf * DS_BUF + fr * DS_TSTR + 16 * kq + sub * 16 * DS_TSTR + ks * 64);
#pragma unroll
            for (int cg = 0; cg < 2; ++cg)
#pragma unroll
                for (int sub = 0; sub < 4; ++sub) { f32x4 acc = (f32x4){0.f, 0.f, 0.f, 0.f}; acc = mfma16(ka[sub][0], qb[cg][0], acc); acc = mfma16(ka[sub][1], qb[cg][1], acc); lg[cg][sub] = acc; } }
          s16x4 vt[2][4][2];
#pragma unroll
          for (int cg = 0; cg < 2; ++cg) {
              float mxl = -1.0e30f;
              if (nearT) { const int relb = ((T == 0) ? 0 : 64 * T - 48) + 4 * kq - (16 + 32 * uq + 4 * w + 2 * cg + (fr >> 3));
#pragma unroll
                  for (int sub = 0; sub < 4; ++sub)
#pragma unroll
                      for (int r = 0; r < 4; ++r) { int idx = relb + 16 * sub + r; idx = idx < -128 ? -128 : idx; idx = idx > 127 ? 127 : idx;
                          const float v = lg[cg][sub][r] * 0.18033688f + BT[(idx + 128) * 8 + hh]; lg[cg][sub][r] = v; mxl = fmaxf(mxl, v); }
              } else {
#pragma unroll
                  for (int sub = 0; sub < 4; ++sub)
#pragma unroll
                      for (int r = 0; r < 4; ++r) { const float v = lg[cg][sub][r] * 0.18033688f + bfar; lg[cg][sub][r] = v; mxl = fmaxf(mxl, v); } }
              if (__ballot(mxl > mrun[cg] + 8.0f) != 0ull) { float mx = mxl; mx = fmaxf(mx, __shfl_xor(mx, 16)); mx = fmaxf(mx, __shfl_xor(mx, 32));
                  const float mn = fmaxf(mrun[cg], mx), sc = __builtin_amdgcn_exp2f(mrun[cg] - mn); mrun[cg] = mn; lrun[cg] *= sc;
#pragma unroll
                  for (int dt = 0; dt < 4; ++dt) O[cg][dt] = O[cg][dt] * sc; }
              const unsigned long long mword = MASK[mkoff[cg] + T] >> (4 * kq); const unsigned mlo = (unsigned)mword, mhi = (unsigned)(mword >> 32); const float mcur = mrun[cg]; float ls = 0.f;
#pragma unroll
              for (int sub = 0; sub < 4; ++sub)
#pragma unroll
                  for (int r = 0; r < 4; ++r) { const int keep = __builtin_amdgcn_sbfe((int)(sub < 2 ? mlo : mhi), 16 * (sub & 1) + r, 1);
                      const float p = __uint_as_float(__float_as_uint(__builtin_amdgcn_exp2f(lg[cg][sub][r] - mcur)) & (unsigned)keep); ls += p; lg[cg][sub][r] = p; }
              lrun[cg] += ls; }
          { const unsigned vaddr = ldsV + (unsigned)(buf * DS_BUF);
            asm volatile("ds_read_b64_tr_b16 %0, %16 offset:0\n\t"
                "ds_read_b64_tr_b16 %1, %16 offset:2304\n\t"
                "ds_read_b64_tr_b16 %2, %16 offset:32\n\t"
                "ds_read_b64_tr_b16 %3, %16 offset:2336\n\t"
                "ds_read_b64_tr_b16 %4, %16 offset:64\n\t"
                "ds_read_b64_tr_b16 %5, %16 offset:2368\n\t"
                "ds_read_b64_tr_b16 %6, %16 offset:96\n\t"
                "ds_read_b64_tr_b16 %7, %16 offset:2400\n\t"
                "ds_read_b64_tr_b16 %8, %16 offset:4608\n\t"
                "ds_read_b64_tr_b16 %9, %16 offset:6912\n\t"
                "ds_read_b64_tr_b16 %10, %16 offset:4640\n\t"
                "ds_read_b64_tr_b16 %11, %16 offset:6944\n\t"
                "ds_read_b64_tr_b16 %12, %16 offset:4672\n\t"
                "ds_read_b64_tr_b16 %13, %16 offset:6976\n\t"
                "ds_read_b64_tr_b16 %14, %16 offset:4704\n\t"
                "ds_read_b64_tr_b16 %15, %16 offset:7008\n\t"
                "s_waitcnt lgkmcnt(0)"
                : "=&v"(vt[0][0][0]), "=&v"(vt[0][0][1]), "=&v"(vt[0][1][0]), "=&v"(vt[0][1][1]), "=&v"(vt[0][2][0]), "=&v"(vt[0][2][1]), "=&v"(vt[0][3][0]), "=&v"(vt[0][3][1]), "=&v"(vt[1][0][0]), "=&v"(vt[1][0][1]), "=&v"(vt[1][1][0]), "=&v"(vt[1][1][1]), "=&v"(vt[1][2][0]), "=&v"(vt[1][2][1]), "=&v"(vt[1][3][0]), "=&v"(vt[1][3][1])
                : "v"(vaddr) : "memory"); }
#pragma unroll
          for (int ks2 = 0; ks2 < 2; ++ks2) { bf16x8 pb[2];
#pragma unroll
              for (int cg = 0; cg < 2; ++cg) { v4u pw; pw.x = cvtpk(lg[cg][2 * ks2][0], lg[cg][2 * ks2][1]); pw.y = cvtpk(lg[cg][2 * ks2][2], lg[cg][2 * ks2][3]);
                  pw.z = cvtpk(lg[cg][2 * ks2 + 1][0], lg[cg][2 * ks2 + 1][1]); pw.w = cvtpk(lg[cg][2 * ks2 + 1][2], lg[cg][2 * ks2 + 1][3]); pb[cg] = __builtin_bit_cast(bf16x8, pw); }
#pragma unroll
              for (int dt = 0; dt < 4; ++dt) { const bf16x8 va = __builtin_shufflevector(vt[ks2][dt][0], vt[ks2][dt][1], 0, 1, 2, 3, 4, 5, 6, 7);
#pragma unroll
                  for (int cg = 0; cg < 2; ++cg) O[cg][dt] = mfma16(va, pb[cg], O[cg][dt]); } }
          if (T + 1 < nt64) { *(LAS v4u*)(L + (buf ^ 1) * DS_BUF + skey * DS_TSTR + 16 * spiece) = kv; *(LAS v4u*)(L + (buf ^ 1) * DS_BUF + 9216 + skey * DS_TSTR + 16 * spiece) = vv; }
          kv = kn; vv = vn;
          __syncthreads();
      }
#pragma unroll
      for (int cg = 0; cg < 2; ++cg) { float v = lrun[cg]; v += __shfl_xor(v, 16); v += __shfl_xor(v, 32); const float inv = 1.0f / v;
          const int q = 4 * w + 2 * cg + (fr >> 3);
#pragma unroll
          for (int dt = 0; dt < 4; ++dt) { v2u o; o.x = cvtpk(O[cg][dt][0] * inv, O[cg][dt][1] * inv); o.y = cvtpk(O[cg][dt][2] * inv, O[cg][dt][3] * inv);
              *(v2u*)(YB + (size_t)(qrow0 + q) * 512 + hh * 64 + 16 * dt + 4 * kq) = o; } } }
}

__global__ void __launch_bounds__(NWAVES * 64, 2) mk_fwd(Args args) {
    extern __shared__ __attribute__((aligned(16))) unsigned char lds[];
    LAS unsigned char* L = (LAS unsigned char*)lds;
    volatile LAS unsigned* MISC = (volatile LAS unsigned*)(L + MISC_OFF);
    const int tid = threadIdx.x, lane = tid & 63, wave = __builtin_amdgcn_readfirstlane(tid >> 6);
    const int G = gridDim.x, bx = blockIdx.x;
    const int gw = bx * NWAVES + wave, NGW = G * NWAVES;
    unsigned char* ws = args.ws;
    if (tid < 32) MISC[tid] = 0u;
    __syncthreads();
    XcdBarrier bar; bar.bar = (unsigned*)(ws + WS_CTL) + CW_BAR; bar.x = 0; bar.st = nullptr;
    if (!MK_PER_PHASE) bar = xcd_barrier_post((unsigned*)(ws + WS_CTL) + CW_BAR, MISC + 8);
    const int lo = args.ph_lo, hi = args.ph_hi;
#define IN(k) (lo <= (k) && (k) < hi)
#define SEAM(k) do { if (IN(k) && IN((k) + 1)) xcd_barrier(bar); } while (0)
    bf16* WT1 = (bf16*)(ws + WS_WT1); bf16* WT2 = (bf16*)(ws + WS_WT2); bf16* WT3 = (bf16*)(ws + WS_WT3); bf16* WT4 = (bf16*)(ws + WS_WT4); bf16* WT5 = (bf16*)(ws + WS_WT5);
    bf16* WGLU = (bf16*)(ws + WS_WGLU); bf16* WA = (bf16*)(ws + WS_WA); bf16* WB = (bf16*)(ws + WS_WB); bf16* WOUT = (bf16*)(ws + WS_WOUT);
    bf16* HN = (bf16*)(ws + WS_HN); bf16* FB = (bf16*)(ws + WS_F); bf16* ACT = (bf16*)(ws + WS_BIG);
    bf16* PA = (bf16*)(ws + WS_PA); bf16* PG = (bf16*)(ws + WS_PG); bf16* PK = (bf16*)(ws + WS_PK);
    bf16* AM1 = (bf16*)(ws + WS_META + MO_AM1); bf16* ACTM = (bf16*)(ws + WS_META + MO_ACTM); bf16* FM = (bf16*)(ws + WS_META + MO_FM); bf16* AM2 = (bf16*)(ws + WS_META + MO_AM2);
    bf16* PMU = (bf16*)(ws + WS_META + MO_PMU); bf16* PMK = (bf16*)(ws + WS_META + MO_PMK);
    bf16* HB = (bf16*)(ws + WS_HB);
    bf16* YA = FB; bf16* YG = HN; bf16* YB = HN + (size_t)R * 512; bf16* MERGED = PA;
    const float* x = args.in[0]; float* out = args.out;

    if (IN(0)) {
        for (int item = bx; item < 3 * 2048; item += G) s5_table_item(args, item, (LAS float*)(L + 140000), tid);
        __syncthreads();
        LAS float* scr = (LAS float*)(L + wave * 16384);
        for (int it = gw; it < 11520; it += NGW) {
            int r = it;
            if (r < 6 * 1408) { const int mat = r / 1408; r -= mat * 1408;
                if (mat == 5) { const int kb = r / 32, nb = r % 32; transpose_item8(args.in[13], D, DFF, (unsigned char*)WT5, 64 * kb, 32 * nb, 32 * nb + (lane & 31), scr, lane); }
                else if (mat == 2) { const int kb = r / 32, nb = r % 32; transpose_item(args.in[10], D, DFF, WT2, 64 * kb, 32 * nb, 32 * nb + (lane & 31), scr, lane); }
                else if (mat >= 3) { const int kb = r / 88, nb = r % 88, d0 = 32 * nb, up = (mat == 4) ? 128 : 0; transpose_item8(args.in[mat == 3 ? 11 : 12], DFF, D, (unsigned char*)WT4, 64 * kb, 256 * (d0 >> 7) + (d0 & 127) + up, d0 + (lane & 31), scr, lane); }
                else { const int kb = r / 88, nb = r % 88, d0 = 32 * nb, up = (mat == 1 || mat == 4) ? 128 : 0;
                    transpose_item(args.in[mat == 0 ? 8 : mat == 1 ? 9 : mat == 3 ? 11 : 12], DFF, D, mat < 3 ? WT1 : WT4, 64 * kb, 256 * (d0 >> 7) + (d0 & 127) + up, d0 + (lane & 31), scr, lane); }
                continue; }
            r -= 6 * 1408;
            if (r < 1920) { const int kb = r / 120, nb = r % 120; transpose_item(args.in[14], 3784, D, WT3, 64 * kb, 32 * nb, win_srccol(32 * nb + (lane & 31)), scr, lane); continue; }
            r -= 1920;
            if (r < 128) { const int kb = r / 16, nb = r % 16; transpose_item(args.in[23], 512, 512, WGLU, 64 * kb, 32 * nb, 32 * nb + (lane & 31), scr, lane); continue; }
            r -= 128;
            if (r < 256) { const int kb = r / 32, nb = r % 32; transpose_item(args.in[24], D, 512, WA, 64 * kb, 32 * nb, 32 * nb + (lane & 31), scr, lane); continue; }
            r -= 256;
            if (r < 256) { const int kb = r / 32, nb = r % 32; transpose_item(args.in[26], D, 512, WB, 64 * kb, 32 * nb, 32 * nb + (lane & 31), scr, lane); continue; }
            r -= 256;
            { const int kb = r / 32, nb = r % 32; transpose_item(args.in[27], D, D, WOUT, 64 * kb, 32 * nb, 32 * nb + (lane & 31), scr, lane); }
        }
        for (int m = gw; m < R; m += NGW) norm_row_to_bf16(x + (size_t)m * D, args.in[2], HN + (size_t)m * D, lane);
        if (gw < NMETA) norm_row_to_bf16(args.in[1] + (size_t)gw * D, args.in[2], AM1 + (size_t)gw * D, lane);
    }
    SEAM(0);
    if (IN(1)) {
        if (gw < 176) { const int j0 = 16 * gw, grow = 256 * (j0 >> 7) + (j0 & 127); const f32x4 g4 = meta_tile(AM1, WT1 + (size_t)grow * D, D, lane), u4 = meta_tile(AM1, WT1 + (size_t)(grow + 128) * D, D, lane);
#pragma unroll
            for (int r = 0; r < 4; ++r) ACTM[(4 * (lane >> 4) + r) * DFF + j0 + (lane & 15)] = (bf16)f2bf(g4[r] * fsig(g4[r]) * u4[r]); }
        pg8::Gemm g{HN, WT1, R, 2 * DFF, D}; pg8::StaticOrder S; S.init(R, 2 * DFF, G, bx); pg8::EpiSwiglu E{ACT, DFF};
        pg8::gemm_phase<pg8::EpiSwiglu, pg8::StaticOrder, PG8_ALIGN, PG8_SP2>(L, g, S, E);
        if (REP_G1 > 1) pg8::gemm_phase<pg8::EpiSwiglu, pg8::StaticOrder, PG8_ALIGN, PG8_SP2>(L, g, S, E);
    }
    SEAM(1);
    if (IN(2)) {
        if (gw < 64) { const int n0 = 16 * gw; const f32x4 f4 = meta_tile(ACTM, WT2 + (size_t)n0 * DFF, DFF, lane);
#pragma unroll
            for (int r = 0; r < 4; ++r) FM[(4 * (lane >> 4) + r) * D + n0 + (lane & 15)] = (bf16)f2bf(f4[r]); }
        pg8::Gemm g{ACT, WT2, R, D, DFF}; pg8::StaticOrder S; S.init(R, D, G, bx); pg8::EpiPlain E{FB, D};
        pg8::gemm_phase<pg8::EpiPlain, pg8::StaticOrder, PG8_ALIGN, PG8_SP2>(L, g, S, E);
    }
    SEAM(2);
    if (IN(3)) {
        if (gw < NMETA) row_update<false, false>(FM + (size_t)gw * D, args.in[1] + (size_t)gw * D, nullptr, AM2 + (size_t)gw * D, args.in[3], args.in[4], 0.5f, lane);
        for (int m = gw; m < R; m += NGW) row_update<false, true>(FB + (size_t)m * D, x + (size_t)m * D, HB + (size_t)m * D, HN + (size_t)m * D, args.in[3], args.in[4], 0.5f, lane);
    }
    SEAM(3);
    if (IN(4)) {
        if (gw < 44) { const int n0 = gw < 32 ? 16 * gw : 3584 + 16 * (gw - 32); const f32x4 p4 = meta_tile(AM2, WT3 + (size_t)n0 * D, D, lane);
#pragma unroll
            for (int r = 0; r < 4; ++r) { const int row = 4 * (lane >> 4) + r; if (gw < 32) PMU[row * 512 + n0 + (lane & 15)] = (bf16)f2bf(p4[r]); else PMK[row * 256 + (n0 - 3584) + (lane & 15)] = (bf16)f2bf(p4[r]); } }
        pg8::Gemm g{HN, WT3, R, 3840, D}; pg8::StaticOrder S; S.init(R, 3840, G, bx); pg8::EpiProj E{PA, PG, PK, (bf16*)(ws + WS_UA2)};
        pg8::gemm_phase<pg8::EpiProj, pg8::StaticOrder, PG8_ALIGN, PG8_SP2>(L, g, S, E);
    }
    SEAM(4);
    if (IN(5)) {
        s5_meta(args, L, bx >> 3, tid);
        for (int rep = 0; rep < REP_S5; ++rep) for (int i = 0; i < 2; ++i) s5_unit(args, L, 2 * (bx & 7) + i, bx >> 3, tid);
        __syncthreads();
        dsa_tables(args, L, tid);
        for (int i = 0; i < 4 * REP_DSA; ++i) { const int up = 4 * (bx >> 3) + (i & 3), u2 = up >> 1, b = 2 * (bx & 7) + (u2 >> 5), xq = u2 & 31; dsa_unit(args, L, b, (up & 1) ? 63 - xq : xq, tid); }
        __syncthreads();
    }
    SEAM(5);
    if (IN(6)) { pg8::Gemm g{YA, WGLU, R, 512, 512}; pg8::StaticOrder S; S.init(R, 512, G, bx); pg8::EpiGlu E{YA, YG};
        pg8::gemm_phase<pg8::EpiGlu, pg8::StaticOrder, PG8_ALIGN, PG8_SP2>(L, g, S, E); }
    SEAM(6);
    if (IN(7)) { pg8::Gemm g{YG, WA, R, D, 512}; pg8::StaticOrder S; S.init(R, D, G, bx); pg8::EpiMerge<false> E{PG, 0, nullptr, FB};
        pg8::gemm_phase<pg8::EpiMerge<false>, pg8::StaticOrder, PG8_ALIGN, PG8_SP2>(L, g, S, E); }
    SEAM(7);
    if (IN(8)) { pg8::Gemm g{YB, WB, R, D, 512}; pg8::StaticOrder S; S.init(R, D, G, bx); pg8::EpiMerge<true> E{PG, 1024, FB, MERGED};
        pg8::gemm_phase<pg8::EpiMerge<true>, pg8::StaticOrder, PG8_ALIGN, PG8_SP2>(L, g, S, E); }
    SEAM(8);
    if (IN(9)) { pg8::Gemm g{MERGED, WOUT, R, D, D}; pg8::StaticOrder S; S.init(R, D, G, bx); pg8::EpiPlain E{FB, D};
        pg8::gemm_phase<pg8::EpiPlain, pg8::StaticOrder, PG8_ALIGN, PG8_SP2>(L, g, S, E); }
    SEAM(9);
    if (IN(10)) { for (int m = gw; m < R; m += NGW) row_update<true, true, true>(FB + (size_t)m * D, HB + (size_t)m * D, HB + (size_t)m * D, (bf16*)((unsigned char*)HN + (size_t)m * D), args.in[5], args.in[6], 1.0f, lane); }
    SEAM(10);
    if (IN(11)) { pg8::Gemm g{HN, WT4, R, 2 * DFF, D}; pg8::StaticOrder S; S.init(R, 2 * DFF, G, bx); pg8::EpiSwiglu8 E{(unsigned char*)ACT, DFF, 1.0f / 256.0f, 8.0f};
        pg8::gemm_phase<pg8::EpiSwiglu8, pg8::StaticOrder, PG8_ALIGN, PG8_SP2, true>(L, g, S, E); }
    SEAM(11);
    if (IN(12)) { pg8::Gemm g{ACT, WT5, R, D, DFF}; pg8::StaticOrder S; S.init(R, D, G, bx); pg8::EpiPlainS E{FB, D, 1.0f / 512.0f};
        pg8::gemm_phase<pg8::EpiPlainS, pg8::StaticOrder, PG8_ALIGN, PG8_SP2, true>(L, g, S, E); }
    SEAM(12);
    if (IN(13)) { for (int m = gw; m < R; m += NGW) row_update<true, false>(FB + (size_t)m * D, HB + (size_t)m * D, out + (size_t)m * D, nullptr, args.in[7], args.in[7], 0.5f, lane); }
#undef IN
#undef SEAM
}

extern "C" void kernel_launch(void* const* d_in, const int* in_sizes, int n_in, void* d_out, int out_size, void* d_ws, size_t ws_size, hipStream_t stream) {
    static int grid = 0;
    if (grid == 0) {
        if (n_in != 28 || out_size != R * D || ws_size < WS_END) { fprintf(stderr, "kernel_launch: unexpected shapes (n_in %d, out %d, ws %zu); nothing launched\n", n_in, out_size, ws_size); grid = -1; return; }
        int dev = 0, cus = 0, per_cu = 0;
        if (hipGetDevice(&dev) != hipSuccess || hipDeviceGetAttribute(&cus, hipDeviceAttributeMultiprocessorCount, dev) != hipSuccess) { grid = -1; return; }
        if (hipFuncSetAttribute((const void*)mk_fwd, hipFuncAttributeMaxDynamicSharedMemorySize, LDS_BYTES) != hipSuccess) { fprintf(stderr, "kernel_launch: hipFuncSetAttribute failed\n"); grid = -1; return; }
        if (hipOccupancyMaxActiveBlocksPerMultiprocessor(&per_cu, (const void*)mk_fwd, NWAVES * 64, LDS_BYTES) != hipSuccess || per_cu < 1) fprintf(stderr, "kernel_launch: note: occupancy query reports %d\n", per_cu);
        (void)hipGetLastError();
        grid = cus;
    }
    if (grid < 0) return;
    if (hipMemsetAsync((char*)d_ws + WS_CTL, 0, CTL_ZERO_BYTES, stream) != hipSuccess) return;
    Args a{};
    for (int i = 0; i < 28; ++i) a.in[i] = (const float*)d_in[i];
    a.out = (float*)d_out; a.ws = (unsigned char*)d_ws;
#if MK_PER_PHASE
    for (int ph = 0; ph < NPH; ++ph) { a.ph_lo = ph; a.ph_hi = ph + 1; hipLaunchKernelGGL(mk_fwd, dim3(grid), dim3(NWAVES * 64), LDS_BYTES, stream, a); }
#else
    a.ph_lo = 0; a.ph_hi = NPH;
    hipLaunchKernelGGL(mk_fwd, dim3(grid), dim3(NWAVES * 64), LDS_BYTES, stream, a);
#endif
}
```

```cpp
#include <hip/hip_runtime.h>
#include <cstdio>
#include <cstdint>
namespace pg8 {
#define PG8_LAS __attribute__((address_space(3)))
typedef unsigned short bf16_t;
typedef short bf16x8 __attribute__((ext_vector_type(8)));
typedef float f32x4 __attribute__((ext_vector_type(4)));
typedef unsigned u32x4 __attribute__((ext_vector_type(4)));
constexpr int BM = 256, BK = 64, HALF = 128, HTB = HALF * BK * 2  , STAGE_BYTES = 8 * HTB, NXCD = 8, WGM = 8;

__host__ __device__ __forceinline__ int lds_byte(int r, int c) { const int st = (r >> 4) * 2 + (c >> 5), rr = r & 15, cc = c & 31, ob = rr * 64 + cc * 2; return st * 1024 + (ob ^ (((ob >> 9) & 1) << 5)); }
__host__ __device__ __forceinline__ void stage_rc(int b, int& R, int& C) { const int st = b / 1024, sb = b % 1024, swz = sb ^ (((sb >> 9) & 1) << 5); R = (st >> 1) * 16 + swz / 64; C = (st & 1) * 32 + (swz % 64) / 2; }
__host__ __device__ __forceinline__ int perm32(int rho) { const int n = rho >> 4, i = rho & 15; return 8 * (i >> 2) + 4 * n + (i & 3); }

struct Unit { int pm, pn; };
struct Gemm { const bf16_t* A; const bf16_t* Bt; int M, N, K; };

struct StaticOrder {
    int nM, nN, nwg, G, c;
    __host__ __device__ void init(int M, int N, int G_, int c_) { nM = M / BM; nN = N / BM; nwg = nM * nN; G = G_; c = c_; }
    __host__ __device__ bool next(int i, Unit& u) const {
        const long L = (long)i * G + c; if (L >= nwg) return false;
        int wgid = (int)L; { const int q = nwg / NXCD, r = nwg % NXCD, xcd = wgid % NXCD, off = wgid / NXCD; wgid = (xcd < r ? xcd * (q + 1) : r * (q + 1) + (xcd - r) * q) + off; }
        const int nig = WGM * nN, gid = wgid / nig, fm = gid * WGM, gsz = (nM - fm) < WGM ? (nM - fm) : WGM;
        u.pm = fm + ((wgid % nig) % gsz); u.pn = (wgid % nig) / gsz; return true;
    }
    __device__ __forceinline__ void a_ready(const Unit&) const {}
    __device__ __forceinline__ void done(const Unit&) const {}
};
__device__ __forceinline__ unsigned cvt_pk_bf16(float lo, float hi) { unsigned r; asm volatile("v_cvt_pk_bf16_f32 %0, %1, %2" : "=v"(r) : "v"(lo), "v"(hi)); return r; }
__device__ __forceinline__ float fsigmoid(float x) { return __builtin_amdgcn_rcpf(1.0f + __expf(-x)); }
__device__ __forceinline__ float bf_lo(unsigned w) { return __uint_as_float(w << 16); }
__device__ __forceinline__ float bf_hi(unsigned w) { return __uint_as_float(w & 0xffff0000u); }
__device__ __forceinline__ u32x4 pack8(const f32x4 v0, const f32x4 v1) { u32x4 w; w.x = cvt_pk_bf16(v0[0], v0[1]); w.y = cvt_pk_bf16(v0[2], v0[3]); w.z = cvt_pk_bf16(v1[0], v1[1]); w.w = cvt_pk_bf16(v1[2], v1[3]); return w; }
__device__ __forceinline__ void unpack8(const u32x4 w, f32x4& v0, f32x4& v1) { v0 = (f32x4){bf_lo(w.x), bf_hi(w.x), bf_lo(w.y), bf_hi(w.y)}; v1 = (f32x4){bf_lo(w.z), bf_hi(w.z), bf_lo(w.w), bf_hi(w.w)}; }

struct EpiSwiglu {
    static constexpr bool PERM = true, AFTER_DRAIN = false;
    bf16_t* O; int ldc; const float* rs;
    __device__ __forceinline__ void operator()(const f32x4 (&acc)[2][2][4][2], const Unit& u, int wr, int wc, int fr, int fq) const {
        const int row0 = u.pm * BM + wr * 64 + fr, col0 = u.pn * HALF + wc * 32 + 8 * fq;
#pragma unroll
        for (int ai = 0; ai < 2; ++ai)
#pragma unroll
            for (int m = 0; m < 4; ++m) { bf16_t* rowp = O + (size_t)(row0 + ai * HALF + m * 16) * ldc + col0; const float rsc = rs[row0 + ai * HALF + m * 16];
                f32x4 v0, v1;
#pragma unroll
                for (int j = 0; j < 4; ++j) { const float g0 = acc[ai][0][m][0][j] * rsc, g1 = acc[ai][0][m][1][j] * rsc;
                    v0[j] = g0 * fsigmoid(g0) * (acc[ai][1][m][0][j] * rsc); v1[j] = g1 * fsigmoid(g1) * (acc[ai][1][m][1][j] * rsc); }
                *(u32x4*)rowp = pack8(v0, v1); }
    }
};
struct EpiPlain {
    static constexpr bool PERM = true, AFTER_DRAIN = false;
    bf16_t* O; int ldc;
    __device__ __forceinline__ void operator()(const f32x4 (&acc)[2][2][4][2], const Unit& u, int wr, int wc, int fr, int fq) const {
        const int row0 = u.pm * BM + wr * 64 + fr, col0 = u.pn * BM + wc * 32 + 8 * fq;
#pragma unroll
        for (int ai = 0; ai < 2; ++ai)
#pragma unroll
            for (int m = 0; m < 4; ++m) { bf16_t* rowp = O + (size_t)(row0 + ai * HALF + m * 16) * ldc + col0;
#pragma unroll
                for (int bj = 0; bj < 2; ++bj) *(u32x4*)(rowp + bj * HALF) = pack8(acc[ai][bj][m][0], acc[ai][bj][m][1]); }
    }
};

__device__ __forceinline__ unsigned pk4_fp8(float a, float b, float c, float d) { int w = 0; w = __builtin_amdgcn_cvt_pk_fp8_f32(fminf(fmaxf(a, -448.f), 448.f), fminf(fmaxf(b, -448.f), 448.f), w, false);
    w = __builtin_amdgcn_cvt_pk_fp8_f32(fminf(fmaxf(c, -448.f), 448.f), fminf(fmaxf(d, -448.f), 448.f), w, true); return (unsigned)w; }
struct EpiSwiglu8 {
    static constexpr bool PERM = true, AFTER_DRAIN = false;
    unsigned char* O; int ldc; float ascale, oscale;
    __device__ __forceinline__ void operator()(const f32x4 (&acc)[2][2][4][2], const Unit& u, int wr, int wc, int fr, int fq) const {
        const int row0 = u.pm * BM + wr * 64 + fr, col0 = u.pn * HALF + wc * 32 + 8 * fq;
#pragma unroll
        for (int ai = 0; ai < 2; ++ai)
#pragma unroll
            for (int m = 0; m < 4; ++m) { unsigned char* rowp = O + (size_t)(row0 + ai * HALF + m * 16) * ldc + col0;
                f32x4 v0, v1;
#pragma unroll
                for (int j = 0; j < 4; ++j) { const float g0 = acc[ai][0][m][0][j] * ascale, g1 = acc[ai][0][m][1][j] * ascale;
                    v0[j] = g0 * fsigmoid(g0) * (acc[ai][1][m][0][j] * ascale) * oscale; v1[j] = g1 * fsigmoid(g1) * (acc[ai][1][m][1][j] * ascale) * oscale; }
                typedef unsigned u32x2 __attribute__((ext_vector_type(2))); u32x2 w; w.x = pk4_fp8(v0[0], v0[1], v0[2], v0[3]); w.y = pk4_fp8(v1[0], v1[1], v1[2], v1[3]);
                *(u32x2*)rowp = w; }
    }
};
struct EpiPlainS {
    static constexpr bool PERM = true, AFTER_DRAIN = false;
    bf16_t* O; int ldc; float scale;
    __device__ __forceinline__ void operator()(const f32x4 (&acc)[2][2][4][2], const Unit& u, int wr, int wc, int fr, int fq) const {
        const int row0 = u.pm * BM + wr * 64 + fr, col0 = u.pn * BM + wc * 32 + 8 * fq;
#pragma unroll
        for (int ai = 0; ai < 2; ++ai)
#pragma unroll
            for (int m = 0; m < 4; ++m) { bf16_t* rowp = O + (size_t)(row0 + ai * HALF + m * 16) * ldc + col0;
#pragma unroll
                for (int bj = 0; bj < 2; ++bj) *(u32x4*)(rowp + bj * HALF) = pack8(acc[ai][bj][m][0] * scale, acc[ai][bj][m][1] * scale); }
    }
};
struct EpiProj {
    static constexpr bool PERM = true, AFTER_DRAIN = false;
    bf16_t *PA, *PG, *PK, *UA2; const float* rs;
    __device__ __forceinline__ void operator()(const f32x4 (&acc)[2][2][4][2], const Unit& u, int wr, int wc, int fr, int fq) const {
        if (u.pn < 2) {
#pragma unroll
            for (int ai = 0; ai < 2; ++ai)
#pragma unroll
                for (int m = 0; m < 4; ++m) { const int row = u.pm * BM + wr * 64 + fr + ai * HALF + m * 16, bb = row >> 11, t = row & 2047;
#pragma unroll
                    for (int bj = 0; bj < 2; ++bj) { const int col = 256 * u.pn + 128 * bj + wc * 32 + 8 * fq;
                        const float rsc = rs[row]; *(u32x4*)(UA2 + ((size_t)((bb * 32 + (col >> 4)) * 2048 + t)) * 16 + (col & 8)) = pack8(acc[ai][bj][m][0] * rsc, acc[ai][bj][m][1] * rsc); } }
            return; }
        bf16_t* base; int ldc, colt;
        if (u.pn < 6) { base = PA; ldc = 1536; colt = 256 * u.pn; } else if (u.pn < 14) { base = PG; ldc = 2048; colt = 256 * (u.pn - 6); } else { base = PK; ldc = 256; colt = 0; }
        const int row0 = u.pm * BM + wr * 64 + fr, col0 = colt + wc * 32 + 8 * fq;
#pragma unroll
        for (int ai = 0; ai < 2; ++ai)
#pragma unroll
            for (int m = 0; m < 4; ++m) { bf16_t* rowp = base + (size_t)(row0 + ai * HALF + m * 16) * ldc + col0; const float rsc = rs[row0 + ai * HALF + m * 16];
#pragma unroll
                for (int bj = 0; bj < 2; ++bj) *(u32x4*)(rowp + bj * HALF) = pack8(acc[ai][bj][m][0] * rsc, acc[ai][bj][m][1] * rsc); }
    }
};
struct EpiGlu {
    static constexpr bool PERM = true, AFTER_DRAIN = false;
    const bf16_t* Y; bf16_t* O;
    __device__ __forceinline__ void operator()(const f32x4 (&acc)[2][2][4][2], const Unit& u, int wr, int wc, int fr, int fq) const {
        const int row0 = u.pm * BM + wr * 64 + fr, col0 = u.pn * BM + wc * 32 + 8 * fq;
#pragma unroll
        for (int ai = 0; ai < 2; ++ai)
#pragma unroll
            for (int m = 0; m < 4; ++m) { const size_t off = (size_t)(row0 + ai * HALF + m * 16) * 512 + col0;
#pragma unroll
                for (int bj = 0; bj < 2; ++bj) { f32x4 y0, y1; unpack8(*(const u32x4*)(Y + off + bj * HALF), y0, y1); f32x4 v0, v1;
#pragma unroll
                    for (int j = 0; j < 4; ++j) { v0[j] = y0[j] * fsigmoid(acc[ai][bj][m][0][j]); v1[j] = y1[j] * fsigmoid(acc[ai][bj][m][1][j]); }
                    *(u32x4*)(O + off + bj * HALF) = pack8(v0, v1); } }
    }
};
template <bool SECOND> struct EpiMerge {
    static constexpr bool PERM = true, AFTER_DRAIN = false;
    const bf16_t* G; int goff; const bf16_t* T; bf16_t* O;
    __device__ __forceinline__ void operator()(const f32x4 (&acc)[2][2][4][2], const Unit& u, int wr, int wc, int fr, int fq) const {
        const int row0 = u.pm * BM + wr * 64 + fr, col0 = u.pn * BM + wc * 32 + 8 * fq;
#pragma unroll
        for (int ai = 0; ai < 2; ++ai)
#pragma unroll
            for (int m = 0; m < 4; ++m) { const size_t row = (size_t)(row0 + ai * HALF + m * 16);
#pragma unroll
                for (int bj = 0; bj < 2; ++bj) { const int col = col0 + bj * HALF; f32x4 g0, g1; unpack8(*(const u32x4*)(G + row * 2048 + goff + col), g0, g1);
                    f32x4 t0 = (f32x4){0.f, 0.f, 0.f, 0.f}, t1 = t0; if (SECOND) unpack8(*(const u32x4*)(T + row * 1024 + col), t0, t1);
                    f32x4 v0, v1;
#pragma unroll
                    for (int j = 0; j < 4; ++j) { v0[j] = t0[j] + fsigmoid(g0[j]) * acc[ai][bj][m][0][j]; v1[j] = t1[j] + fsigmoid(g1[j]) * acc[ai][bj][m][1][j]; }
                    *(u32x4*)(O + row * 1024 + col) = pack8(v0, v1); } }
    }
};

struct MergeOrder {
    StaticOrder base;
    __device__ __forceinline__ bool next(int i, Unit& u) const { if (i >= 4) return false; if (!base.next(i & 1, u)) return false; if (i >= 2) { u.pm += 128; u.pn += 4; } return true; }
    __device__ __forceinline__ void a_ready(const Unit&) const {}
    __device__ __forceinline__ void done(const Unit&) const {}
};
struct EpiMerge2 {
    static constexpr bool PERM = true, AFTER_DRAIN = false;
    const bf16_t* G; bf16_t* T; bf16_t* O;
    __device__ __forceinline__ void operator()(const f32x4 (&acc)[2][2][4][2], const Unit& u, int wr, int wc, int fr, int fq) const {
        const bool second = u.pm >= 128; const int pm = second ? u.pm - 128 : u.pm, pn = second ? u.pn - 4 : u.pn, goff = second ? 1024 : 0;
        const int row0 = pm * BM + wr * 64 + fr, col0 = pn * BM + wc * 32 + 8 * fq;
#pragma unroll
        for (int ai = 0; ai < 2; ++ai)
#pragma unroll
            for (int m = 0; m < 4; ++m) { const size_t row = (size_t)(row0 + ai * HALF + m * 16);
#pragma unroll
                for (int bj = 0; bj < 2; ++bj) { const int col = col0 + bj * HALF; f32x4 g0, g1; unpack8(*(const u32x4*)(G + row * 2048 + goff + col), g0, g1);
                    f32x4 t0 = (f32x4){0.f, 0.f, 0.f, 0.f}, t1 = t0; if (second) unpack8(*(const u32x4*)(T + row * 1024 + col), t0, t1);
                    f32x4 v0, v1;
#pragma unroll
                    for (int j = 0; j < 4; ++j) { v0[j] = t0[j] + fsigmoid(g0[j]) * acc[ai][bj][m][0][j]; v1[j] = t1[j] + fsigmoid(g1[j]) * acc[ai][bj][m][1][j]; }
                    *(u32x4*)((second ? O : T) + row * 1024 + col) = pack8(v0, v1); } }
    }
};
typedef int i32x8 __attribute__((ext_vector_type(8)));
typedef int i32x4v __attribute__((ext_vector_type(4)));
__device__ __forceinline__ i32x8 cat8(const bf16x8 lo, const bf16x8 hi) { const i32x4v a = __builtin_bit_cast(i32x4v, lo), b = __builtin_bit_cast(i32x4v, hi); return __builtin_shufflevector(a, b, 0, 1, 2, 3, 4, 5, 6, 7); }
template <class Epi, class Sched, bool ALIGN_EPI = false, bool SP2 = false, bool F8 = false>
__device__ __forceinline__ void gemm_phase(PG8_LAS unsigned char* lds, const Gemm g, const Sched& S, const Epi& E) {
    const int tid = threadIdx.x, wid = __builtin_amdgcn_readfirstlane(tid >> 6), lane = tid & 63, wr = wid >> 2, wc = wid & 3, fr = lane & 15, fq = lane >> 4;
    const int K = g.K, KB = F8 ? K : 2 * K  , nt = KB / 128;
    unsigned voffA[2], voffB[2];
#pragma unroll
    for (int i = 0; i < 2; ++i) { int R, C; stage_rc(tid * 16 + i * 8192, R, C); const int Rb = Epi::PERM ? ((R & ~31) + perm32(R & 31)) : R;
        voffA[i] = (unsigned)(R * KB + C * 2); voffB[i] = (unsigned)(Rb * KB + C * 2); }
    const size_t kstep = (size_t)(BK * 2);
    const size_t hstep = (size_t)HALF * KB;
    const size_t tstep = 2 * hstep;
    const unsigned ldsw = (unsigned)wid * 1024u;
    const int aoff = lds_byte(wr * 64 + fr, fq * 8), boff = lds_byte(wc * 32 + fr, fq * 8);
#define PG8_SA(b, h) (((b) * 2 + (h)) * HTB)
#define PG8_SB(b, h) ((4 + (b) * 2 + (h)) * HTB)
#define PG8_STAGE(bufoff, gbase, voff) do { _Pragma("unroll") for (int _i = 0; _i < 2; ++_i) \
        __builtin_amdgcn_global_load_lds((const unsigned*)((const char*)(gbase) + (voff)[_i]), (PG8_LAS unsigned*)(lds + (bufoff) + ldsw + _i * 8192), 16, 0, 0); } while (0)
#define PG8_LDA(dst, b, h) do { if constexpr (F8) { _Pragma("unroll") for (int m = 0; m < 4; ++m) dst##8[m] = cat8(*(const PG8_LAS bf16x8*)(lds + PG8_SA(b, h) + aoff + m * 2048), *(const PG8_LAS bf16x8*)(lds + PG8_SA(b, h) + aoff + m * 2048 + 1024)); } else { \
        _Pragma("unroll") for (int m = 0; m < 4; ++m) _Pragma("unroll") for (int k = 0; k < 2; ++k) dst[m][k] = *(const PG8_LAS bf16x8*)(lds + PG8_SA(b, h) + aoff + m * 2048 + k * 1024); } } while (0)
#define PG8_LDB(dst, b, h) do { if constexpr (F8) { _Pragma("unroll") for (int n = 0; n < 2; ++n) dst##8[n] = cat8(*(const PG8_LAS bf16x8*)(lds + PG8_SB(b, h) + boff + n * 2048), *(const PG8_LAS bf16x8*)(lds + PG8_SB(b, h) + boff + n * 2048 + 1024)); } else { \
        _Pragma("unroll") for (int n = 0; n < 2; ++n) _Pragma("unroll") for (int k = 0; k < 2; ++k) dst[n][k] = *(const PG8_LAS bf16x8*)(lds + PG8_SB(b, h) + boff + n * 2048 + k * 1024); } } while (0)
#define PG8_MMA(ai, bj, At, Bt) do { __builtin_amdgcn_s_setprio(1); if constexpr (F8) { _Pragma("unroll") for (int m = 0; m < 4; ++m) _Pragma("unroll") for (int n = 0; n < 2; ++n) \
        acc[ai][bj][m][n] = __builtin_amdgcn_mfma_scale_f32_16x16x128_f8f6f4(Bt##8[n], At##8[m], acc[ai][bj][m][n], 0, 0, 0, 0x7F7F7F7F, 0, 0x7F7F7F7F); \
        _Pragma("unroll") for (int m = 0; m < 4; ++m) _Pragma("unroll") for (int n = 0; n < 2; ++n) asm volatile("" : "+v"(acc[ai][bj][m][n])); } else { \
        _Pragma("unroll") for (int m = 0; m < 4; ++m) _Pragma("unroll") for (int n = 0; n < 2; ++n) _Pragma("unroll") for (int k = 0; k < 2; ++k) \
        acc[ai][bj][m][n] = __builtin_amdgcn_mfma_f32_16x16x32_bf16(Bt[n][k], At[m][k], acc[ai][bj][m][n], 0, 0, 0); } __builtin_amdgcn_s_setprio(0); } while (0)
#define PG8_WAIT_V(n) asm volatile("s_waitcnt vmcnt(" #n ")" ::: "memory")
#define PG8_WAIT_L(n) asm volatile("s_waitcnt lgkmcnt(" #n ")" ::: "memory")
#define PG8_BAR __builtin_amdgcn_s_barrier()
#define PG8_SCHED __builtin_amdgcn_sched_barrier(0)
    Unit cur, nxt; int ui = 0;
    if (!S.next(0, cur)) return;
    f32x4 acc[2][2][4][2];
#pragma unroll
    for (int a = 0; a < 2; ++a)
#pragma unroll
        for (int b = 0; b < 2; ++b)
#pragma unroll
            for (int m = 0; m < 4; ++m)
#pragma unroll
                for (int n = 0; n < 2; ++n) acc[a][b][m][n] = (f32x4){0.f, 0.f, 0.f, 0.f};
    bf16x8 At[4][2], B0[2][2], B1[2][2]; i32x8 At8[4], B08[2], B18[2];
    const char* cA = (const char*)g.A + (size_t)cur.pm * tstep; const char* cB = (const char*)g.Bt + (size_t)cur.pn * tstep;
    S.a_ready(cur);
    if constexpr (SP2) {
        PG8_STAGE(PG8_SB(0, 0), cB, voffB); PG8_STAGE(PG8_SB(0, 1), cB + hstep, voffB); PG8_STAGE(PG8_SA(0, 0), cA, voffA); PG8_STAGE(PG8_SA(0, 1), cA + hstep, voffA);
        if (wr == 1) PG8_BAR;
        PG8_WAIT_V(2); PG8_BAR;
        PG8_STAGE(PG8_SB(1, 0), cB + kstep, voffB); PG8_STAGE(PG8_SA(1, 0), cA + kstep, voffA); PG8_STAGE(PG8_SB(1, 1), cB + hstep + kstep, voffB);
        PG8_WAIT_V(6); PG8_BAR;
    } else {
        PG8_STAGE(PG8_SB(0, 0), cB, voffB); PG8_STAGE(PG8_SA(0, 0), cA, voffA); PG8_STAGE(PG8_SB(0, 1), cB + hstep, voffB); PG8_STAGE(PG8_SA(0, 1), cA + hstep, voffA);
        if (wr == 1) PG8_BAR;
        PG8_WAIT_V(4); PG8_BAR;
        PG8_STAGE(PG8_SB(1, 0), cB + kstep, voffB); PG8_STAGE(PG8_SA(1, 0), cA + kstep, voffA); PG8_STAGE(PG8_SB(1, 1), cB + hstep + kstep, voffB);
        PG8_WAIT_V(6); PG8_BAR;
    }
    for (;;) {
        const bool has_next = S.next(ui + 1, nxt);
        const char* nA = has_next ? (const char*)g.A + (size_t)nxt.pm * tstep : cA; const char* nB = has_next ? (const char*)g.Bt + (size_t)nxt.pn * tstep : cB;
        for (int t = 0; t < nt; t += 2) {
            const bool last = (t == nt - 2);
            const char* a1 = cA + (size_t)(t + 1) * kstep;
            const char* a2 = last ? nA : cA + (size_t)(t + 2) * kstep; const char* b2 = last ? nB : cB + (size_t)(t + 2) * kstep;
            const char* a3 = a2 + kstep; const char* b3 = b2 + kstep;
            if (last && has_next) S.a_ready(nxt);
            if constexpr (SP2) {
            PG8_LDB(B0, 0, 0); PG8_LDB(B1, 0, 1); PG8_SCHED; PG8_LDA(At, 0, 0); PG8_STAGE(PG8_SA(1, 1), a1 + hstep, voffA);
            PG8_WAIT_V(8); PG8_WAIT_L(0); PG8_BAR; PG8_MMA(0, 0, At, B0); PG8_MMA(0, 1, At, B1); PG8_BAR; PG8_SCHED;
            PG8_LDA(At, 0, 1); PG8_STAGE(PG8_SB(0, 0), b2, voffB); PG8_STAGE(PG8_SB(0, 1), b2 + hstep, voffB); PG8_STAGE(PG8_SA(0, 0), a2, voffA);
            PG8_WAIT_V(8); PG8_WAIT_L(0); PG8_BAR; PG8_MMA(1, 0, At, B0); PG8_MMA(1, 1, At, B1); PG8_BAR; PG8_SCHED;
            PG8_LDB(B0, 1, 0); PG8_LDB(B1, 1, 1); PG8_SCHED; PG8_LDA(At, 1, 0); PG8_STAGE(PG8_SA(0, 1), a2 + hstep, voffA);
            PG8_WAIT_V(8); PG8_WAIT_L(0); PG8_BAR; PG8_MMA(0, 0, At, B0); PG8_MMA(0, 1, At, B1); PG8_BAR; PG8_SCHED;
            PG8_LDA(At, 1, 1); PG8_STAGE(PG8_SB(1, 0), b3, voffB); PG8_STAGE(PG8_SB(1, 1), b3 + hstep, voffB); PG8_STAGE(PG8_SA(1, 0), a3, voffA);
            PG8_WAIT_V(8); PG8_WAIT_L(0); PG8_BAR; PG8_MMA(1, 0, At, B0); PG8_MMA(1, 1, At, B1); PG8_BAR; PG8_SCHED;
            } else {
            PG8_LDB(B0, 0, 0); PG8_SCHED; PG8_LDA(At, 0, 0); PG8_STAGE(PG8_SA(1, 1), a1 + hstep, voffA);
            PG8_WAIT_L(8); PG8_BAR; PG8_WAIT_L(0); PG8_MMA(0, 0, At, B0); PG8_BAR; PG8_SCHED;
            PG8_LDB(B1, 0, 1); PG8_STAGE(PG8_SB(0, 0), b2, voffB);
            PG8_BAR; PG8_WAIT_L(0); PG8_MMA(0, 1, At, B1); PG8_BAR;
            PG8_LDA(At, 0, 1); PG8_STAGE(PG8_SA(0, 0), a2, voffA);
            PG8_BAR; PG8_WAIT_L(0); PG8_MMA(1, 0, At, B0); PG8_BAR; PG8_SCHED;
            PG8_STAGE(PG8_SB(0, 1), b2 + hstep, voffB);
            PG8_WAIT_V(6); PG8_BAR; PG8_MMA(1, 1, At, B1); PG8_BAR;
            PG8_LDB(B0, 1, 0); PG8_SCHED; PG8_LDA(At, 1, 0); PG8_STAGE(PG8_SA(0, 1), a2 + hstep, voffA);
            PG8_WAIT_L(8); PG8_BAR; PG8_WAIT_L(0); PG8_MMA(0, 0, At, B0); PG8_BAR; PG8_SCHED;
            PG8_LDB(B1, 1, 1); PG8_STAGE(PG8_SB(1, 0), b3, voffB);
            PG8_BAR; PG8_WAIT_L(0); PG8_MMA(0, 1, At, B1); PG8_BAR;
            PG8_LDA(At, 1, 1); PG8_STAGE(PG8_SA(1, 0), a3, voffA);
            PG8_BAR; PG8_WAIT_L(0); PG8_MMA(1, 0, At, B0); PG8_BAR; PG8_SCHED;
            PG8_STAGE(PG8_SB(1, 1), b3 + hstep, voffB);
            PG8_WAIT_V(6); PG8_BAR; PG8_MMA(1, 1, At, B1); PG8_BAR;
            }
        }
        if constexpr (ALIGN_EPI) { if (wr == 0) PG8_BAR; }
        if constexpr (!Epi::AFTER_DRAIN) { E(acc, cur, wr, wc, fr, fq); S.done(cur); }
        if (!has_next) break;
#pragma unroll
        for (int a = 0; a < 2; ++a)
#pragma unroll
            for (int b = 0; b < 2; ++b)
#pragma unroll
                for (int m = 0; m < 4; ++m)
#pragma unroll
                    for (int n = 0; n < 2; ++n) acc[a][b][m][n] = (f32x4){0.f, 0.f, 0.f, 0.f};
        cur = nxt; cA = nA; cB = nB; ++ui;
        if constexpr (ALIGN_EPI) { if (wr == 1) PG8_BAR; }
    }
    PG8_WAIT_V(0);
    if constexpr (!ALIGN_EPI) { if (wr == 0) PG8_BAR; }
    PG8_BAR;
    if constexpr (Epi::AFTER_DRAIN) { E.fused(acc, cur, wr, wc, fr, fq, lds, wid, lane); S.done(cur); }
#undef PG8_SA
#undef PG8_SB
#undef PG8_STAGE
#undef PG8_LDA
#undef PG8_LDB
#undef PG8_MMA
#undef PG8_WAIT_V
#undef PG8_WAIT_L
#undef PG8_BAR
#undef PG8_SCHED
}
}
#ifndef PG8_SP2
#define PG8_SP2 true
#endif
#ifndef PG8_ALIGN
#define PG8_ALIGN true
#endif
#ifndef MK_PER_PHASE
#define MK_PER_PHASE 0
#endif
#ifndef REP_S5
#define REP_S5 1
#endif
#ifndef REP_DSA
#define REP_DSA 1
#endif
#ifndef REP_G1
#define REP_G1 1
#endif
constexpr int NWAVES = 8;
constexpr int NPH = 14;

constexpr int NB = 16, SEQ = 2048, D = 1024, NMETA = 16, DFF = 2816;
constexpr int R = NB * SEQ;
constexpr int NG = 32, NP = 64, NM = 16;
constexpr float RMS_EPS = 1e-6f;

constexpr size_t MiB = 1u << 20;
constexpr size_t WS_CTL = 0, CTL_ZERO_BYTES = 1 * MiB;
constexpr size_t WS_WT1 = 2 * MiB, WS_WT2 = 13 * MiB, WS_WT3 = 19 * MiB, WS_WT4 = 27 * MiB, WS_WT5 = 38 * MiB;
constexpr size_t WS_WGLU = 44 * MiB, WS_WA = 45 * MiB, WS_WB = 46 * MiB, WS_WOUT = 47 * MiB;
constexpr size_t WS_KS = 50 * MiB, WS_KO = 58 * MiB, WS_KI = 66 * MiB;
constexpr size_t WS_META = 67 * MiB;
constexpr size_t MO_AM1 = 0, MO_ACTM = 32768, MO_FM = 131072, MO_AM2 = 262144, MO_PMU = 294912, MO_PMK = 311296;
constexpr size_t WS_HN = 68 * MiB;
constexpr size_t WS_F = 132 * MiB;
constexpr size_t WS_BIG = 196 * MiB;
constexpr size_t WS_PA = WS_BIG, WS_PG = WS_BIG + 96 * MiB, WS_PK = WS_BIG + 224 * MiB, WS_HB = WS_BIG + 240 * MiB  , WS_END = WS_BIG + 304 * MiB;
constexpr size_t WS_UA2 = WS_F + 32 * MiB;
constexpr int CW_BAR = 4096;

constexpr int LDS_BYTES = 155648;
constexpr int MISC_OFF = 154624;

#define GAS __attribute__((address_space(1)))
#define LAS __attribute__((address_space(3)))
typedef unsigned short bf16;
typedef unsigned v4u __attribute__((ext_vector_type(4)));
typedef unsigned v2u __attribute__((ext_vector_type(2)));
typedef float f32x4 __attribute__((ext_vector_type(4)));
typedef short bf16x8 __attribute__((ext_vector_type(8)));
#define LDS_WAIT() asm volatile("s_waitcnt lgkmcnt(0)" ::: "memory")
#define VM_WAIT() asm volatile("s_waitcnt vmcnt(0)" ::: "memory")
__device__ __forceinline__ unsigned f2bf(float f) { unsigned u = __builtin_bit_cast(unsigned, f); return (u + 0x7fffu + ((u >> 16) & 1u)) >> 16; }
__device__ __forceinline__ unsigned pk2(float lo, float hi) { return f2bf(lo) | (f2bf(hi) << 16); }
__device__ __forceinline__ float bflo(unsigned w) { return __uint_as_float(w << 16); }
__device__ __forceinline__ float bfhi(unsigned w) { return __uint_as_float(w & 0xffff0000u); }
__device__ __forceinline__ float bf2f(bf16 v) { return __uint_as_float(((unsigned)v) << 16); }
__device__ __forceinline__ float fsig(float x) { return __builtin_amdgcn_rcpf(1.0f + __expf(-x)); }

#define XB_TMO      128
#define XB_XCNT(j)  (256  + 64 * (j))
#define XB_XSUB(j)  (1280 + 64 * (j))
#define XB_XGEN(j)  (2304 + 64 * (j))
#define XB_TOP      3328
#define XB_TOPGEN   3392
#define XCD_BAR_WORDS 3456
#define XB_SPIN_CAP (1u << 18)
__device__ __forceinline__ unsigned xb_ld(unsigned* p)              { return __hip_atomic_load(p, __ATOMIC_RELAXED, __HIP_MEMORY_SCOPE_AGENT); }
__device__ __forceinline__ unsigned xb_add(unsigned* p, unsigned v) { return __hip_atomic_fetch_add(p, v, __ATOMIC_RELAXED, __HIP_MEMORY_SCOPE_AGENT); }
__device__ __forceinline__ unsigned xb_xcc_id() { return (unsigned)__builtin_amdgcn_s_getreg((3 << 11) | 20) & 0xFu; }
#define XB_SPIN(cond, bar) do { unsigned _sp = 0; while (cond) { __builtin_amdgcn_s_sleep(1); \
    if ((++_sp & 255u) == 0u) { if (xb_ld(&(bar)[XB_TMO])) break; if (_sp > XB_SPIN_CAP) { atomicAdd(&(bar)[XB_TMO], 1u); break; } } } } while (0)
struct XcdBarrier { unsigned* bar; unsigned x; volatile LAS unsigned* st; };
__device__ __forceinline__ XcdBarrier xcd_barrier_post(unsigned* bar, volatile LAS unsigned* st) {
    XcdBarrier b; b.bar = bar; b.x = xb_xcc_id(); b.st = st;
    if (threadIdx.x == 0) (void)xb_add(&bar[XB_XCNT(b.x)], 1u);
    return b;
}
__device__ __forceinline__ void xcd_barrier_complete(unsigned* bar, unsigned x, unsigned& nloc, unsigned& nx) {
    const unsigned G = gridDim.x * gridDim.y * gridDim.z;
    unsigned sum, cnt, mine, sp = 0u;
    for (;;) {
        sum = 0u; cnt = 0u; mine = 0u;
#pragma unroll
        for (unsigned j = 0; j < 16; ++j) { const unsigned c = xb_ld(&bar[XB_XCNT(j)]); sum += c; cnt += (c > 0u) ? 1u : 0u; mine = (j == x) ? c : mine; }
        if (sum == G) break;
        __builtin_amdgcn_s_sleep(1);
        if ((++sp & 255u) == 0u) { if (xb_ld(&bar[XB_TMO])) break; if (sp > XB_SPIN_CAP) { atomicAdd(&bar[XB_TMO], 1u); break; } }
    }
    nloc = mine > 0u ? mine : 1u; nx = cnt > 0u ? cnt : 1u;
}
__device__ __forceinline__ void xcd_barrier(const XcdBarrier& b) {
    asm volatile("s_waitcnt vmcnt(0)" ::: "memory");
    __syncthreads();
    if (threadIdx.x == 0) {
        unsigned* bar = b.bar;
        __builtin_amdgcn_s_waitcnt(0);
        unsigned nloc = b.st[0], nx = b.st[1];
        if (nloc == 0u) { xcd_barrier_complete(bar, b.x, nloc, nx); b.st[0] = nloc; b.st[1] = nx; }
        const unsigned old = xb_add(&bar[XB_XSUB(b.x)], 1u);
        const unsigned gen = old / nloc;
        if (old + 1u == (gen + 1u) * nloc) {
            __builtin_amdgcn_fence(__ATOMIC_RELEASE, "agent");
            asm volatile("s_waitcnt vmcnt(0)" ::: "memory");
            const unsigned og = xb_add(&bar[XB_TOP], 1u);
            const unsigned tg = og / nx;
            if (og + 1u == (tg + 1u) * nx) xb_add(&bar[XB_TOPGEN], 1u);
            else XB_SPIN(xb_ld(&bar[XB_TOPGEN]) == tg, bar);
            __builtin_amdgcn_fence(__ATOMIC_ACQUIRE, "agent");
            xb_add(&bar[XB_XGEN(b.x)], 1u);
            asm volatile("s_waitcnt vmcnt(0)" ::: "memory");
        } else {
            XB_SPIN(xb_ld(&bar[XB_XGEN(b.x)]) == gen, bar);
            __builtin_amdgcn_fence(__ATOMIC_ACQUIRE, "agent");
            asm volatile("s_waitcnt vmcnt(0)" ::: "memory");
        }
    }
    __syncthreads();
}

__device__ __forceinline__ float wave_sum(float v) {
#pragma unroll
    for (int o = 1; o < 64; o <<= 1) v += __shfl_xor(v, o);
    return v;
}
__device__ __forceinline__ f32x4 mfma16(bf16x8 a, bf16x8 b, f32x4 c) { return __builtin_amdgcn_mfma_f32_16x16x32_bf16(a, b, c, 0, 0, 0); }

__device__ __forceinline__ void transpose_item(const float* W, int Nsrc, int K, bf16* WT, int k0, int drow0, int srccol, LAS float* scr, int lane, const float* gk = nullptr) {
#pragma unroll 8
    for (int i = 0; i < 32; ++i) { const int kk = 2 * i + (lane >> 5); float wv_ = (srccol >= 0) ? W[(size_t)(k0 + kk) * Nsrc + srccol] : 0.f; if (gk) wv_ *= gk[k0 + kk]; scr[kk * 33 + (lane & 31)] = wv_; }
    LDS_WAIT(); asm volatile("" ::: "memory");
    const int c = lane & 7;
#pragma unroll
    for (int j = 0; j < 4; ++j) { const int n = (lane >> 3) + 8 * j; const LAS float* s = scr + (8 * c) * 33 + n;
        v4u o; o.x = pk2(s[0 * 33], s[1 * 33]); o.y = pk2(s[2 * 33], s[3 * 33]); o.z = pk2(s[4 * 33], s[5 * 33]); o.w = pk2(s[6 * 33], s[7 * 33]);
        *(v4u*)(WT + (size_t)(drow0 + n) * K + k0 + 8 * c) = o; }
    LDS_WAIT(); asm volatile("" ::: "memory");
}

__device__ __forceinline__ unsigned pk4q(float a, float b, float c, float d) { int w = 0; w = __builtin_amdgcn_cvt_pk_fp8_f32(fminf(fmaxf(a, -448.f), 448.f), fminf(fmaxf(b, -448.f), 448.f), w, false);
    w = __builtin_amdgcn_cvt_pk_fp8_f32(fminf(fmaxf(c, -448.f), 448.f), fminf(fmaxf(d, -448.f), 448.f), w, true); return (unsigned)w; }
__device__ __forceinline__ void transpose_item8(const float* W, int Nsrc, int K, unsigned char* WT8, int k0, int drow0, int srccol, LAS float* scr, int lane) {
#pragma unroll 8
    for (int i = 0; i < 32; ++i) { const int kk = 2 * i + (lane >> 5); scr[kk * 33 + (lane & 31)] = W[(size_t)(k0 + kk) * Nsrc + srccol] * 64.0f; }
    LDS_WAIT(); asm volatile("" ::: "memory");
    const int c = lane & 7;
#pragma unroll
    for (int j = 0; j < 4; ++j) { const int n = (lane >> 3) + 8 * j; const LAS float* sp = scr + (8 * c) * 33 + n;
        v2u o; o.x = pk4q(sp[0 * 33], sp[1 * 33], sp[2 * 33], sp[3 * 33]); o.y = pk4q(sp[4 * 33], sp[5 * 33], sp[6 * 33], sp[7 * 33]);
        *(v2u*)(WT8 + (size_t)(drow0 + n) * K + k0 + 8 * c) = o; }
    LDS_WAIT(); asm volatile("" ::: "memory");
}
__device__ __forceinline__ int win_srccol(int d) {
    if (d < 1024) return d;
    if (d < 1536) return 1096 + (d - 1024);
    if (d < 3584) return 1736 + (d - 1536);
    if (d < 3648) return 1024 + (d - 3584);
    if (d < 3712) return 1608 + (d - 3648);
    if (d < 3776) return 1672 + (d - 3712);
    if (d < 3784) return 1088 + (d - 3776);
    return -1;
}
__device__ __forceinline__ void norm_row_to_bf16(const float* xrow, const float* g, bf16* orow, int lane) {
    f32x4 v[4]; float ss = 0.f;
#pragma unroll
    for (int j = 0; j < 4; ++j) { v[j] = ((const f32x4*)xrow)[lane + 64 * j]; ss += (v[j].x * v[j].x + v[j].y * v[j].y) + (v[j].z * v[j].z + v[j].w * v[j].w); }
    const float rs = rsqrtf(wave_sum(ss) * (1.f / D) + RMS_EPS);
#pragma unroll
    for (int j = 0; j < 4; ++j) { const f32x4 gv = ((const f32x4*)g)[lane + 64 * j]; v2u o; o.x = pk2(v[j].x * rs * gv.x, v[j].y * rs * gv.y); o.y = pk2(v[j].z * rs * gv.z, v[j].w * rs * gv.w);
        ((v2u*)orow)[lane + 64 * j] = o; }
}
template <bool PRESCALE>
__device__ __forceinline__ void x_row_to_bf16(const float* xrow, bf16* orow, float* rs_out, int lane) {
    f32x4 v[4]; float ss = 0.f;
#pragma unroll
    for (int j = 0; j < 4; ++j) { v[j] = ((const f32x4*)xrow)[lane + 64 * j]; ss += (v[j].x * v[j].x + v[j].y * v[j].y) + (v[j].z * v[j].z + v[j].w * v[j].w); }
    const float rs = rsqrtf(wave_sum(ss) * (1.f / D) + RMS_EPS), pre = PRESCALE ? rs : 1.0f;
#pragma unroll
    for (int j = 0; j < 4; ++j) { v2u o; o.x = pk2(v[j].x * pre, v[j].y * pre); o.y = pk2(v[j].z * pre, v[j].w * pre); ((v2u*)orow)[lane + 64 * j] = o; }
    if (rs_out && lane == 0) *rs_out = rs;
}
template <bool BASE_BF16, bool OUT_BF16, bool HN_F8 = false>
__device__ __forceinline__ void row_update(const bf16* frow, const void* base, void* outrow, bf16* hnrow, const float* gpost, const float* gnext, float scale, int lane, float* rs_out = nullptr) {
    f32x4 f[4], h[4]; float ss = 0.f;
#pragma unroll
    for (int j = 0; j < 4; ++j) { const v2u w = ((const v2u*)frow)[lane + 64 * j]; f[j] = (f32x4){bflo(w.x), bfhi(w.x), bflo(w.y), bfhi(w.y)};
        ss += (f[j].x * f[j].x + f[j].y * f[j].y) + (f[j].z * f[j].z + f[j].w * f[j].w); }
    const float rs = rsqrtf(wave_sum(ss) * (1.f / D) + RMS_EPS) * scale; float s2 = 0.f;
#pragma unroll
    for (int j = 0; j < 4; ++j) { const f32x4 gv = ((const f32x4*)gpost)[lane + 64 * j]; f32x4 bv;
        if (BASE_BF16) { const v2u w = ((const v2u*)base)[lane + 64 * j]; bv = (f32x4){bflo(w.x), bfhi(w.x), bflo(w.y), bfhi(w.y)}; } else bv = ((const f32x4*)base)[lane + 64 * j];
        h[j] = bv + f[j] * rs * gv; s2 += (h[j].x * h[j].x + h[j].y * h[j].y) + (h[j].z * h[j].z + h[j].w * h[j].w); }
    if (outrow) {
#pragma unroll
        for (int j = 0; j < 4; ++j) { if (OUT_BF16) { v2u o; o.x = pk2(h[j].x, h[j].y); o.y = pk2(h[j].z, h[j].w); ((v2u*)outrow)[lane + 64 * j] = o; } else ((f32x4*)outrow)[lane + 64 * j] = h[j]; } }
    if (hnrow || rs_out) { const float r2 = rsqrtf(wave_sum(s2) * (1.f / D) + RMS_EPS); if (rs_out && lane == 0) *rs_out = r2;
        if (hnrow)
#pragma unroll
        for (int j = 0; j < 4; ++j) { const f32x4 gv = gnext ? ((const f32x4*)gnext)[lane + 64 * j] : (f32x4){1.f, 1.f, 1.f, 1.f};
            if (HN_F8) { const float q = 4.0f * r2; ((unsigned*)hnrow)[lane + 64 * j] = pk4q(h[j].x * q * gv.x, h[j].y * q * gv.y, h[j].z * q * gv.z, h[j].w * q * gv.w); }
            else { v2u o; o.x = pk2(h[j].x * r2 * gv.x, h[j].y * r2 * gv.y); o.y = pk2(h[j].z * r2 * gv.z, h[j].w * r2 * gv.w); ((v2u*)hnrow)[lane + 64 * j] = o; } } }
}
__device__ __forceinline__ f32x4 meta_tile(const bf16* A, const bf16* B, int K, int lane) {
    const int fr = lane & 15, kq = lane >> 4; const bf16* ap = A + (size_t)fr * K + 8 * kq; const bf16* bp = B + (size_t)fr * K + 8 * kq;
    f32x4 acc = (f32x4){0.f, 0.f, 0.f, 0.f};
#pragma unroll 4
    for (int k = 0; k < K; k += 32) { const bf16x8 a = *(const bf16x8*)(ap + k); const bf16x8 b = *(const bf16x8*)(bp + k); acc = mfma16(a, b, acc); }
    return acc;
}

struct Args { const float* in[28]; float* out; unsigned char* ws; int ph_lo, ph_hi; };

__device__ __forceinline__ void s5_tables_block(const Args& a, int g, int oct, LAS float* sc, int tid) {
    const float* lam_re = a.in[15]; const float* lam_im = a.in[16]; const float* log_dt = a.in[17];
    const float* b_re = a.in[18]; const float* b_im = a.in[19]; const float* c_re = a.in[20]; const float* c_im = a.in[21]; const float* dsk = a.in[22];
    LAS float* CR = sc; LAS float* CI = sc + 1024; LAS float* BR = sc + 2048; LAS float* BI = sc + 3072;
    LAS float* ANG = sc + 4096; LAS float* LRDT = sc + 4160; LAS float* CFR = sc + 4224; LAS float* CFI = sc + 4288;
    LAS float* WR = sc + 4352; LAS float* WI = sc + 4864;
    __syncthreads();
#pragma unroll
    for (int k = 0; k < 2; ++k) { const int e = tid + 512 * k; CR[e] = c_re[g * 1024 + e]; CI[e] = c_im[g * 1024 + e]; BR[e] = b_re[g * 1024 + e]; BI[e] = b_im[g * 1024 + e]; }
    if (tid < 64) { const int p = tid; const float lr = lam_re[g * 64 + p], li = lam_im[g * 64 + p], dt = expf(log_dt[g]);
        const float ang = li * dt, mag = expf(lr * dt); float s1, c1; sincosf(ang, &s1, &c1);
        const float a_re = mag * c1, a_im = mag * s1, den = lr * lr + li * li, nr = a_re - 1.0f, ni = a_im;
        ANG[p] = ang; LRDT[p] = lr * dt; CFR[p] = (nr * lr + ni * li) / den; CFI[p] = (ni * lr - nr * li) / den; }
    __syncthreads();
    const int ti = tid >> 6, p64 = tid & 63, idx0 = 8 * oct;
    { const float n = (float)(idx0 + ti); float sn, cn; sincosf(n * ANG[p64], &sn, &cn); const float mn = expf(n * LRDT[p64]); const float pr = mn * cn, pi = mn * sn;
      WR[tid] = pr * CFR[p64] - pi * CFI[p64]; WI[tid] = pr * CFI[p64] + pi * CFR[p64]; }
    __syncthreads();
#pragma unroll
    for (int k = 0; k < 4; ++k) { const int e = tid + 512 * k, t8 = e >> 8, m = (e >> 4) & 15, mp = e & 15; float s = 0.f;
        for (int p = 0; p < 64; ++p) { const float wr_ = WR[t8 * 64 + p], wi_ = WI[t8 * 64 + p], br = BR[p * 16 + mp], bi = BI[p * 16 + mp];
            const float zr = wr_ * br - wi_ * bi, zi = wr_ * bi + wi_ * br; s += CR[m * 64 + p] * zr - CI[m * 64 + p] * zi; }
        if (idx0 + t8 == 0 && m == mp) s += dsk[g * 16 + m];
        ((bf16*)(a.ws + WS_KI))[((g * 64 + idx0 + t8) * 16 + m) * 16 + mp] = (bf16)f2bf(s); }
    __syncthreads();
    { const float n = (float)(63 - (idx0 + ti)); float sn, cn; sincosf(n * ANG[p64], &sn, &cn); const float mn = expf(n * LRDT[p64]); const float pr = mn * cn, pi = mn * sn;
      WR[tid] = pr * CFR[p64] - pi * CFI[p64]; WI[tid] = pr * CFI[p64] + pi * CFR[p64]; }
    __syncthreads();
    for (int k = 0; k < 32; ++k) { const int e = tid + 512 * k, t8 = e >> 11, n_ = (e >> 4) & 127, mp = e & 15, p = n_ & 63;
        const float wr_ = WR[t8 * 64 + p], wi_ = WI[t8 * 64 + p], br = BR[p * 16 + mp], bi = BI[p * 16 + mp];
        const float zr = wr_ * br - wi_ * bi, zi = wr_ * bi + wi_ * br;
        ((bf16*)(a.ws + WS_KS))[((size_t)(g * 64 + idx0 + t8) * 128 + n_) * 16 + mp] = (bf16)f2bf(n_ < 64 ? zr : zi); }
    __syncthreads();
    { const float n = (float)(idx0 + ti + 1); float sn, cn; sincosf(n * ANG[p64], &sn, &cn); const float mn = expf(n * LRDT[p64]); WR[tid] = mn * cn; WI[tid] = mn * sn; }
    __syncthreads();
    for (int k = 0; k < 32; ++k) { const int e = tid + 512 * k, t8 = e >> 11, m = (e >> 7) & 15, kk = e & 127, p = kk & 63;
        const float cr = CR[m * 64 + p], ci = CI[m * 64 + p], ar_ = WR[t8 * 64 + p], ai_ = WI[t8 * 64 + p];
        const float wr_ = cr * ar_ - ci * ai_, wi_ = cr * ai_ + ci * ar_;
        ((bf16*)(a.ws + WS_KO))[((size_t)(g * 64 + idx0 + t8) * 16 + m) * 128 + kk] = (bf16)f2bf(kk < 64 ? wr_ : -wi_); }
}

constexpr int S5_U = 0, S5_USTR = 2064, S5_KI = 66048, S5_SLOC = 98816, S5_XINB = 115200, S5_XSTR = 272, S5_MISC = 123904;
__device__ __forceinline__ float gelu_tanh(float x) { const float z = 0.7978845608028654f * (x + 0.044715f * x * x * x); return x * fsig(2.0f * z); }
__device__ __forceinline__ void s5_meta(const Args& a, LAS unsigned char* L, int g, int tid) {
    const int lane = tid & 63; const bf16* PMU = (const bf16*)(a.ws + WS_META + MO_PMU); LAS float* MS = (LAS float*)(L + S5_MISC);
    if (tid < 64) { const int p = lane; const float lr = a.in[15][g * 64 + p], li = a.in[16][g * 64 + p], dt = expf(a.in[17][g]);
        const float ang = li * dt, mag = expf(lr * dt); float s1, c1; sincosf(ang, &s1, &c1);
        const float a_re = mag * c1, a_im = mag * s1, den = lr * lr + li * li, nr = a_re - 1.0f, ni = a_im;
        const float cf_re = (nr * lr + ni * li) / den, cf_im = (ni * lr - nr * li) / den;
        float bb_re[16], bb_im[16];
#pragma unroll
        for (int m = 0; m < 16; ++m) { const float br = a.in[18][(g * 64 + p) * 16 + m], bi = a.in[19][(g * 64 + p) * 16 + m]; bb_re[m] = cf_re * br - cf_im * bi; bb_im[m] = cf_re * bi + cf_im * br; }
        float xr = 0.f, xi = 0.f;
        for (int i = 0; i < 16; ++i) { float ur = 0.f, ui = 0.f;
#pragma unroll
            for (int m = 0; m < 16; ++m) { const float u = bf2f(PMU[i * 512 + 16 * g + m]); ur += bb_re[m] * u; ui += bb_im[m] * u; }
            const float nr2 = a_re * xr - a_im * xi + ur, ni2 = a_re * xi + a_im * xr + ui; xr = nr2; xi = ni2; }
        float s64, c64; sincosf(64.0f * ang, &s64, &c64); const float m64 = expf(64.0f * lr * dt);
        MS[p] = xr; MS[64 + p] = xi; MS[128 + p] = m64 * c64; MS[192 + p] = m64 * s64; }
}
__device__ __forceinline__ void s5_unit(const Args& a, LAS unsigned char* L, int b, int g, int tid) {
    const int lane = tid & 63, w = __builtin_amdgcn_readfirstlane(tid >> 6), fr = lane & 15, kq = lane >> 4;
    const bf16* UA2 = (const bf16*)(a.ws + WS_UA2) + (size_t)(b * 32 + g) * 2048 * 16;
    const bf16* KS = (const bf16*)(a.ws + WS_KS); const bf16* KO = (const bf16*)(a.ws + WS_KO); const bf16* KI = (const bf16*)(a.ws + WS_KI);
    bf16* YA = (bf16*)(a.ws + WS_F);
    LAS float* SLOC = (LAS float*)(L + S5_SLOC); LAS float* MS = (LAS float*)(L + S5_MISC);
    __syncthreads();
#pragma unroll
    for (int k = 0; k < 8; ++k) { const int idx = tid + 512 * k, t = idx >> 1, hf = idx & 1;
        const v4u v = *(const v4u*)(UA2 + (size_t)idx * 8);
        *(LAS v4u*)(L + S5_U + (t >> 6) * S5_USTR + (t & 63) * 32 + 16 * hf) = v; }
#pragma unroll
    for (int k = 0; k < 4; ++k) { const int idx = tid + 512 * k; *(LAS v4u*)(L + S5_KI + idx * 16) = *(const v4u*)(KI + (size_t)g * 16384 + idx * 8); }
    bf16x8 bfr[16];
#pragma unroll
    for (int k = 0; k < 16; ++k) { const int i = 2 * k + (kq >> 1); bfr[k] = *(const bf16x8*)(KS + ((size_t)(g * 64 + i) * 128 + 16 * w + fr) * 16 + 8 * (kq & 1)); }
    __syncthreads();
    { f32x4 acc0 = (f32x4){0.f, 0.f, 0.f, 0.f}, acc1 = acc0;
#pragma unroll
      for (int hb = 0; hb < 2; ++hb) {
          if (hb == 1) {
#pragma unroll
              for (int k = 0; k < 16; ++k) { const int i = 2 * (16 + k) + (kq >> 1); bfr[k] = *(const bf16x8*)(KS + ((size_t)(g * 64 + i) * 128 + 16 * w + fr) * 16 + 8 * (kq & 1)); } }
#pragma unroll
          for (int k = 0; k < 16; ++k) { const int ks = 16 * hb + k;
              const bf16x8 a0 = *(const LAS bf16x8*)(L + S5_U + fr * S5_USTR + (32 * ks + 8 * kq) * 2);
              const bf16x8 a1 = *(const LAS bf16x8*)(L + S5_U + (16 + fr) * S5_USTR + (32 * ks + 8 * kq) * 2);
              acc0 = mfma16(a0, bfr[k], acc0); acc1 = mfma16(a1, bfr[k], acc1); } }
#pragma unroll
      for (int r = 0; r < 4; ++r) { SLOC[(4 * kq + r) * 128 + 16 * w + fr] = acc0[r]; SLOC[(16 + 4 * kq + r) * 128 + 16 * w + fr] = acc1[r]; } }
    bf16x8 ko[4];
#pragma unroll
    for (int ks = 0; ks < 4; ++ks) ko[ks] = *(const bf16x8*)(KO + ((size_t)(g * 64 + w) * 16 + fr) * 128 + 32 * ks + 8 * kq);
    __syncthreads();
    if (w == 0) { const int p = lane; float sr[32], si[32];
#pragma unroll
        for (int c = 0; c < 32; ++c) { sr[c] = SLOC[c * 128 + p]; si[c] = SLOC[c * 128 + 64 + p]; }
        float xr = MS[p], xi = MS[64 + p]; const float ar = MS[128 + p], ai = MS[192 + p];
#pragma unroll
        for (int c = 0; c < 32; ++c) { *(LAS bf16*)(L + S5_XINB + c * S5_XSTR + p * 2) = (bf16)f2bf(xr); *(LAS bf16*)(L + S5_XINB + c * S5_XSTR + (64 + p) * 2) = (bf16)f2bf(xi);
            const float nr2 = ar * xr - ai * xi + sr[c], ni2 = ar * xi + ai * xr + si[c]; xr = nr2; xi = ni2; } }
    __syncthreads();
    for (int jj = 0; jj < 8; ++jj) { const int j = w + 8 * jj;
        bf16x8 kon[4];
#pragma unroll
        for (int ks = 0; ks < 4; ++ks) kon[ks] = ko[ks];
        if (jj < 7) {
#pragma unroll
            for (int ks = 0; ks < 4; ++ks) kon[ks] = *(const bf16x8*)(KO + ((size_t)(g * 64 + j + 8) * 16 + fr) * 128 + 32 * ks + 8 * kq); }
        f32x4 acc0 = (f32x4){0.f, 0.f, 0.f, 0.f}, acc1 = acc0;
#pragma unroll
        for (int ks = 0; ks < 4; ++ks) {
            const bf16x8 a0 = *(const LAS bf16x8*)(L + S5_XINB + fr * S5_XSTR + (32 * ks + 8 * kq) * 2);
            const bf16x8 a1 = *(const LAS bf16x8*)(L + S5_XINB + (16 + fr) * S5_XSTR + (32 * ks + 8 * kq) * 2);
            acc0 = mfma16(a0, ko[ks], acc0); acc1 = mfma16(a1, ko[ks], acc1); }
        const int nks = (j >> 1) + 1;
#pragma unroll 2
        for (int ks = 0; ks < nks; ++ks) { const int i = 2 * ks + (kq >> 1), tau = j - i;
            bf16x8 bq = *(const LAS bf16x8*)(L + S5_KI + (((tau < 0 ? 0 : tau) * 16 + fr) * 16 + 8 * (kq & 1)) * 2);
            if (tau < 0) bq = (bf16x8){0, 0, 0, 0, 0, 0, 0, 0};
            const bf16x8 a0 = *(const LAS bf16x8*)(L + S5_U + fr * S5_USTR + (32 * ks + 8 * kq) * 2);
            const bf16x8 a1 = *(const LAS bf16x8*)(L + S5_U + (16 + fr) * S5_USTR + (32 * ks + 8 * kq) * 2);
            acc0 = mfma16(a0, bq, acc0); acc1 = mfma16(a1, bq, acc1); }
#pragma unroll
        for (int r = 0; r < 4; ++r) { const int c0 = 4 * kq + r, c1 = 16 + 4 * kq + r;
            YA[(size_t)(b * 2048 + 64 * c0 + j) * 512 + 16 * g + fr] = (bf16)f2bf(gelu_tanh(acc0[r]));
            YA[(size_t)(b * 2048 + 64 * c1 + j) * 512 + 16 * g + fr] = (bf16)f2bf(gelu_tanh(acc1[r])); }
#pragma unroll
        for (int ks = 0; ks < 4; ++ks) ko[ks] = kon[ks]; }
}

constexpr int DS_SSTR = 2120, DS_TSTR = 144, DS_BUF = 18432  , DS_BT = 36864  , DS_HIST = 135680, DS_MASK = 143872, DS_RB = 152576, DS_TB = 153600;
typedef short s16x4 __attribute__((ext_vector_type(4)));
__device__ __forceinline__ s16x4 tr_read(unsigned addr) { s16x4 r; asm volatile("ds_read_b64_tr_b16 %0, %1" : "=&v"(r) : "v"(addr) : "memory"); return r; }
__device__ __forceinline__ float relu_i(float x) { const int i = __builtin_bit_cast(int, x); return __builtin_bit_cast(float, i > 0 ? i : 0); }
__device__ __forceinline__ unsigned f16key(float f) { const _Float16 hf = (_Float16)f; const unsigned h = (unsigned)__builtin_bit_cast(unsigned short, hf); return (h & 0x8000u) ? (~h & 0xffffu) : (h | 0x8000u); }
__device__ __forceinline__ unsigned cvtpk(float lo, float hi) { unsigned r; asm volatile("v_cvt_pk_bf16_f32 %0, %1, %2" : "=v"(r) : "v"(lo), "v"(hi)); return r; }
__device__ __forceinline__ void dsa_tables(const Args& a, LAS unsigned char* L, int tid) {
    if (tid < 256) { ((LAS float*)(L + DS_RB))[tid] = a.in[25][tid] * 1.44269504f;
        const int n = tid; const int lo = n < 8 ? n : (n < 12 ? 8 : n < 16 ? 9 : n < 23 ? 10 : n < 32 ? 11 : n < 46 ? 12 : n < 64 ? 13 : n < 91 ? 14 : 15);
        ((LAS int*)(L + DS_TB))[tid] = lo; }
}

__device__ __forceinline__ int wave_incl_scan(int x) {
    int v = x;
    v += __builtin_amdgcn_update_dpp(0, v, 0x111, 0xf, 0xf, false);
    v += __builtin_amdgcn_update_dpp(0, v, 0x112, 0xf, 0xf, false);
    v += __builtin_amdgcn_update_dpp(0, v, 0x114, 0xf, 0xf, false);
    v += __builtin_amdgcn_update_dpp(0, v, 0x118, 0xf, 0xf, false);
    v += __builtin_amdgcn_update_dpp(0, v, 0x142, 0xa, 0xf, false);
    v += __builtin_amdgcn_update_dpp(0, v, 0x143, 0xc, 0xf, false);
    return v;
}
template <int NE>
__device__ __forceinline__ void dsa_select(LAS unsigned char* L, int c, int nt64, int w, int lane) {
    LAS unsigned short* S16 = (LAS unsigned short*)L; LAS unsigned long long* MASK = (LAS unsigned long long*)(L + DS_MASK);
    LAS unsigned* H = (LAS unsigned*)(L + DS_HIST) + w * 256;
    const int rl = 63 - lane;
    for (int qq = 0; qq < 4; ++qq) { const int q = 4 * w + qq; const LAS unsigned short* Sq = S16 + q * DS_SSTR; unsigned tkey = 0u;
        unsigned kr[NE];
#pragma unroll
        for (int e = 0; e < NE; ++e) kr[e] = (unsigned)Sq[64 * e + lane];
        if (c >= 4) { unsigned prefix = 0u; int kth = 256;
#pragma unroll
            for (int pass = 0; pass < 2; ++pass) {
                H[lane] = 0u; H[lane + 64] = 0u; H[lane + 128] = 0u; H[lane + 192] = 0u; LDS_WAIT();
#pragma unroll
                for (int e = 0; e < NE; ++e) { const unsigned key = kr[e]; const bool in = (pass == 0) ? (key != 0u) : ((key >> 8) == prefix);
                    if (in) (void)__hip_atomic_fetch_add(&H[pass == 0 ? (key >> 8) : (key & 255u)], 1u, __ATOMIC_RELAXED, __HIP_MEMORY_SCOPE_WORKGROUP); }
                LDS_WAIT();
                const unsigned h0 = H[4 * rl], h1 = H[4 * rl + 1], h2 = H[4 * rl + 2], h3 = H[4 * rl + 3]; const int t = (int)(h0 + h1 + h2 + h3);
                const int sfx = wave_incl_scan(t), above = sfx - t; const bool has = (above < kth) && (above + t >= kth);
                const unsigned long long bm = __ballot(has); const int src = bm ? (__ffsll((long long)bm) - 1) : 0;
                int cum = above, B; if (cum + (int)h3 >= kth) B = 3; else { cum += (int)h3; if (cum + (int)h2 >= kth) B = 2; else { cum += (int)h2; if (cum + (int)h1 >= kth) B = 1; else { cum += (int)h1; B = 0; } } }
                const int bin = __builtin_amdgcn_readlane(4 * rl + B, src); kth = __builtin_amdgcn_readlane(kth - cum, src);
                prefix = (prefix << 8) | (unsigned)bin; LDS_WAIT(); }
            tkey = prefix; }
        unsigned mlo = 0u, mhi = 0u;
#pragma unroll
        for (int e = 0; e < NE; ++e) { const int s = 64 * e + lane; const bool sel = ((s < 16) || (s >= 64)) && (kr[e] >= tkey);
            const unsigned long long m = __ballot(sel); mlo = (lane == e) ? (unsigned)m : mlo; mhi = (lane == e) ? (unsigned)(m >> 32) : mhi; }
        if (lane < nt64) MASK[q * 34 + lane] = ((unsigned long long)mhi << 32) | mlo; }
}
__device__ __forceinline__ void dsa_unit(const Args& a, LAS unsigned char* L, int b, int uq, int tid) {
    const int lane = tid & 63, w = __builtin_amdgcn_readfirstlane(tid >> 6), fr = lane & 15, kq = lane >> 4;
    const bf16* PA = (const bf16*)(a.ws + WS_PA); const bf16* PK = (const bf16*)(a.ws + WS_PK); const bf16* PMK = (const bf16*)(a.ws + WS_META + MO_PMK);
    bf16* YB = (bf16*)(a.ws + WS_HN) + (size_t)R * 512;
    const int c = 1 + (uq >> 1), nt64 = c + 1, qrow0 = b * 2048 + 32 * uq;
    LAS unsigned short* S16 = (LAS unsigned short*)L; LAS unsigned long long* MASK = (LAS unsigned long long*)(L + DS_MASK);
    const LAS float* RB = (const LAS float*)(L + DS_RB); const LAS int* TB = (const LAS int*)(L + DS_TB);
    __syncthreads();
    { const int qh = w >> 2; bf16x8 qa[4][2][2]; float wv[4][2][4];
#pragma unroll
      for (int p = 0; p < 4; ++p) {
#pragma unroll
          for (int hf = 0; hf < 2; ++hf)
#pragma unroll
              for (int ks = 0; ks < 2; ++ks) qa[p][hf][ks] = *(const bf16x8*)(PA + (size_t)(qrow0 + 16 * qh + 4 * p + (fr >> 2)) * 1536 + 512 + (4 * hf + (fr & 3)) * 64 + 32 * ks + 8 * kq);
          const v4u wraw = *(const v4u*)(PK + (size_t)(qrow0 + 16 * qh + 4 * p + kq) * 256 + 192);
          wv[p][0][0] = bflo(wraw.x) * 0.04419417382f; wv[p][0][1] = bfhi(wraw.x) * 0.04419417382f; wv[p][0][2] = bflo(wraw.y) * 0.04419417382f; wv[p][0][3] = bfhi(wraw.y) * 0.04419417382f;
          wv[p][1][0] = bflo(wraw.z) * 0.04419417382f; wv[p][1][1] = bfhi(wraw.z) * 0.04419417382f; wv[p][1][2] = bflo(wraw.w) * 0.04419417382f; wv[p][1][3] = bfhi(wraw.w) * 0.04419417382f; }
      const int nkt = 4 * nt64;
      { const int ner = nt64 <= 9 ? 9 : nt64 <= 17 ? 17 : nt64 <= 25 ? 25 : 33;
        for (int kz = 4 * nt64 + (w & 3); kz < 4 * ner; kz += 4) {
#pragma unroll
            for (int p = 0; p < 4; ++p) S16[(16 * qh + 4 * p + kq) * DS_SSTR + 16 * kz + fr] = (unsigned short)0; } }
      if ((w & 3) != 0) {
#pragma unroll
          for (int p = 0; p < 4; ++p) S16[(16 * qh + 4 * p + kq) * DS_SSTR + 16 * (w & 3) + fr] = (unsigned short)0; }
      int kt = (w & 3) == 0 ? 0 : (w & 3) + 4;
      bf16x8 kb0, kb1, kc0, kc1;
      { const bf16* krow = (kt == 0) ? PMK + fr * 256 : PK + (size_t)(b * 2048 + 16 * kt - 64 + fr) * 256; kb0 = *(const bf16x8*)(krow + 8 * kq); kb1 = *(const bf16x8*)(krow + 32 + 8 * kq); }
      { const int k1 = (kt == 0) ? 4 : kt + 4; kc0 = kb0; kc1 = kb1;
        if (k1 < nkt) { const bf16* krow = PK + (size_t)(b * 2048 + 16 * k1 - 64 + fr) * 256; kc0 = *(const bf16x8*)(krow + 8 * kq); kc1 = *(const bf16x8*)(krow + 32 + 8 * kq); } }
      while (kt < nkt) {
          const int ktn = (kt == 0) ? 4 : kt + 4, ktnn = ktn + 4; bf16x8 nb0 = kc0, nb1 = kc1;
          if (ktnn < nkt) { const bf16* krow = PK + (size_t)(b * 2048 + 16 * ktnn - 64 + fr) * 256; nb0 = *(const bf16x8*)(krow + 8 * kq); nb1 = *(const bf16x8*)(krow + 32 + 8 * kq); }
#pragma unroll
          for (int p = 0; p < 4; ++p) { f32x4 aA = (f32x4){0.f, 0.f, 0.f, 0.f}, aB = aA;
              aA = mfma16(qa[p][0][0], kb0, aA); aB = mfma16(qa[p][1][0], kb0, aB); aA = mfma16(qa[p][0][1], kb1, aA); aB = mfma16(qa[p][1][1], kb1, aB);
              const float v = (relu_i(aA[0]) * wv[p][0][0] + relu_i(aA[1]) * wv[p][0][1]) + (relu_i(aA[2]) * wv[p][0][2] + relu_i(aA[3]) * wv[p][0][3])
                            + (relu_i(aB[0]) * wv[p][1][0] + relu_i(aB[1]) * wv[p][1][1]) + (relu_i(aB[2]) * wv[p][1][2] + relu_i(aB[3]) * wv[p][1][3]);
              S16[(16 * qh + 4 * p + kq) * DS_SSTR + 16 * kt + fr] = (unsigned short)f16key(v); }
          kb0 = kc0; kb1 = kc1; kc0 = nb0; kc1 = nb1; kt = ktn; } }
    __syncthreads();
    bf16x8 qb[2][2]; unsigned mkoff[2];
#pragma unroll
    for (int cg = 0; cg < 2; ++cg) { const int q = 4 * w + 2 * cg + (fr >> 3), h = fr & 7; mkoff[cg] = q * 34;
#pragma unroll
        for (int ks = 0; ks < 2; ++ks) qb[cg][ks] = *(const bf16x8*)(PA + (size_t)(qrow0 + q) * 1536 + 1024 + h * 64 + 32 * ks + 8 * kq); }
    const int skey = tid >> 3, spiece = tid & 7;
    v4u kv0 = (v4u){0u, 0u, 0u, 0u}, vv0 = kv0, kv, vv;
    if (skey < 16) { const bf16* krow = PMK + skey * 256; kv0 = *(const v4u*)(krow + 64 + 8 * spiece); vv0 = *(const v4u*)(krow + 128 + 8 * spiece); }
    { const bf16* krow = PK + (size_t)(b * 2048 + skey) * 256; kv = *(const v4u*)(krow + 64 + 8 * spiece); vv = *(const v4u*)(krow + 128 + 8 * spiece); }
    if (nt64 <= 9) dsa_select<9>(L, c, nt64, w, lane);
    else if (nt64 <= 17) dsa_select<17>(L, c, nt64, w, lane);
    else if (nt64 <= 25) dsa_select<25>(L, c, nt64, w, lane);
    else dsa_select<33>(L, c, nt64, w, lane);
    __syncthreads();
    {
      const int hh = fr & 7; const float bfar = RB[15 * 8 + hh];
      float mrun[2] = {-1.0e30f, -1.0e30f}, lrun[2] = {0.f, 0.f}; f32x4 O[2][4];
#pragma unroll
      for (int cg = 0; cg < 2; ++cg)
#pragma unroll
          for (int dt = 0; dt < 4; ++dt) O[cg][dt] = (f32x4){0.f, 0.f, 0.f, 0.f};
      const LAS float* BT = (const LAS float*)(L + DS_BT);
#pragma unroll
      for (int k = 0; k < 4; ++k) { const int e = tid + 512 * k, relc = (e >> 3) - 128, n = relc < 0 ? -relc : relc; ((LAS float*)(L + DS_BT))[e] = RB[(TB[n] + (relc > 0 ? 16 : 0)) * 8 + (e & 7)]; }
      const unsigned ldsV = (unsigned)(size_t)(L) + 9216u + (unsigned)((4 * kq + ((lane & 15) >> 2)) * DS_TSTR + 8 * (lane & 3));
      *(LAS v4u*)(L + skey * DS_TSTR + 16 * spiece) = kv0; *(LAS v4u*)(L + 9216 + skey * DS_TSTR + 16 * spiece) = vv0;
      __syncthreads();
      for (int T = 0; T < nt64; ++T) { const int buf = T & 1;
          v4u kn = kv, vn = vv;
          if (T + 2 < nt64) { const bf16* krow = PK + (size_t)(b * 2048 + 64 * (T + 1) + skey) * 256; kn = *(const v4u*)(krow + 64 + 8 * spiece); vn = *(const v4u*)(krow + 128 + 8 * spiece); }
          const bool nearT = (64 * T > 32 * uq - 90);
          f32x4 lg[2][4];
          { bf16x8 ka[4][2];
#pragma unroll
            for (int sub = 0; sub < 4; ++sub)
#pragma unroll
                for (int ks = 0; ks < 2; ++ks) ka[sub][ks] = *(const LAS bf16x8*)(L + buf * DS_BUF + fr * DS_TSTR + 16 * kq + sub * 16 * DS_TSTR + ks * 64);
#pragma unroll
            for (int cg = 0; cg < 2; ++cg)
#pragma unroll
                for (int sub = 0; sub < 4; ++sub) { f32x4 acc = (f32x4){0.f, 0.f, 0.f, 0.f}; acc = mfma16(ka[sub][0], qb[cg][0], acc); acc = mfma16(ka[sub][1], qb[cg][1], acc); lg[cg][sub] = acc; } }
          s16x4 vt[2][4][2];
#pragma unroll
          for (int cg = 0; cg < 2; ++cg) {
              float mxl = -1.0e30f;
              if (nearT) { const int relb = ((T == 0) ? 0 : 64 * T - 48) + 4 * kq - (16 + 32 * uq + 4 * w + 2 * cg + (fr >> 3));
#pragma unroll
                  for (int sub = 0; sub < 4; ++sub)
#pragma unroll
                      for (int r = 0; r < 4; ++r) { int idx = relb + 16 * sub + r; idx = idx < -128 ? -128 : idx; idx = idx > 127 ? 127 : idx;
                          const float v = lg[cg][sub][r] * 0.18033688f + BT[(idx + 128) * 8 + hh]; lg[cg][sub][r] = v; mxl = fmaxf(mxl, v); }
              } else {
#pragma unroll
                  for (int sub = 0; sub < 4; ++sub)
#pragma unroll
                      for (int r = 0; r < 4; ++r) { const float v = lg[cg][sub][r] * 0.18033688f + bfar; lg[cg][sub][r] = v; mxl = fmaxf(mxl, v); } }
              if (__ballot(mxl > mrun[cg] + 8.0f) != 0ull) { float mx = mxl; mx = fmaxf(mx, __shfl_xor(mx, 16)); mx = fmaxf(mx, __shfl_xor(mx, 32));
                  const float mn = fmaxf(mrun[cg], mx), sc = __builtin_amdgcn_exp2f(mrun[cg] - mn); mrun[cg] = mn; lrun[cg] *= sc;
#pragma unroll
                  for (int dt = 0; dt < 4; ++dt) O[cg][dt] = O[cg][dt] * sc; }
              const unsigned long long mword = MASK[mkoff[cg] + T] >> (4 * kq); const unsigned mlo = (unsigned)mword, mhi = (unsigned)(mword >> 32); const float mcur = mrun[cg]; float ls = 0.f;
#pragma unroll
              for (int sub = 0; sub < 4; ++sub)
#pragma unroll
                  for (int r = 0; r < 4; ++r) { const int keep = __builtin_amdgcn_sbfe((int)(sub < 2 ? mlo : mhi), 16 * (sub & 1) + r, 1);
                      const float p = __uint_as_float(__float_as_uint(__builtin_amdgcn_exp2f(lg[cg][sub][r] - mcur)) & (unsigned)keep); ls += p; lg[cg][sub][r] = p; }
              lrun[cg] += ls; }
          { const unsigned vaddr = ldsV + (unsigned)(buf * DS_BUF);
            asm volatile("ds_read_b64_tr_b16 %0, %16 offset:0\n\t"
                "ds_read_b64_tr_b16 %1, %16 offset:2304\n\t"
                "ds_read_b64_tr_b16 %2, %16 offset:32\n\t"
                "ds_read_b64_tr_b16 %3, %16 offset:2336\n\t"
                "ds_read_b64_tr_b16 %4, %16 offset:64\n\t"
                "ds_read_b64_tr_b16 %5, %16 offset:2368\n\t"
                "ds_read_b64_tr_b16 %6, %16 offset:96\n\t"
                "ds_read_b64_tr_b16 %7, %16 offset:2400\n\t"
                "ds_read_b64_tr_b16 %8, %16 offset:4608\n\t"
                "ds_read_b64_tr_b16 %9, %16 offset:6912\n\t"
                "ds_read_b64_tr_b16 %10, %16 offset:4640\n\t"
                "ds_read_b64_tr_b16 %11, %16 offset:6944\n\t"
                "ds_read_b64_tr_b16 %12, %16 offset:4672\n\t"
                "ds_read_b64_tr_b16 %13, %16 offset:6976\n\t"
                "ds_read_b64_tr_b16 %14, %16 offset:4704\n\t"
                "ds_read_b64_tr_b16 %15, %16 offset:7008\n\t"
                "s_waitcnt lgkmcnt(0)"
                : "=&v"(vt[0][0][0]), "=&v"(vt[0][0][1]), "=&v"(vt[0][1][0]), "=&v"(vt[0][1][1]), "=&v"(vt[0][2][0]), "=&v"(vt[0][2][1]), "=&v"(vt[0][3][0]), "=&v"(vt[0][3][1]), "=&v"(vt[1][0][0]), "=&v"(vt[1][0][1]), "=&v"(vt[1][1][0]), "=&v"(vt[1][1][1]), "=&v"(vt[1][2][0]), "=&v"(vt[1][2][1]), "=&v"(vt[1][3][0]), "=&v"(vt[1][3][1])
                : "v"(vaddr) : "memory"); }
#pragma unroll
          for (int ks2 = 0; ks2 < 2; ++ks2) { bf16x8 pb[2];
#pragma unroll
              for (int cg = 0; cg < 2; ++cg) { v4u pw; pw.x = cvtpk(lg[cg][2 * ks2][0], lg[cg][2 * ks2][1]); pw.y = cvtpk(lg[cg][2 * ks2][2], lg[cg][2 * ks2][3]);
                  pw.z = cvtpk(lg[cg][2 * ks2 + 1][0], lg[cg][2 * ks2 + 1][1]); pw.w = cvtpk(lg[cg][2 * ks2 + 1][2], lg[cg][2 * ks2 + 1][3]); pb[cg] = __builtin_bit_cast(bf16x8, pw); }
#pragma unroll
              for (int dt = 0; dt < 4; ++dt) { const bf16x8 va = __builtin_shufflevector(vt[ks2][dt][0], vt[ks2][dt][1], 0, 1, 2, 3, 4, 5, 6, 7);
#pragma unroll
                  for (int cg = 0; cg < 2; ++cg) O[cg][dt] = mfma16(va, pb[cg], O[cg][dt]); } }
          if (T + 1 < nt64) { *(LAS v4u*)(L + (buf ^ 1) * DS_BUF + skey * DS_TSTR + 16 * spiece) = kv; *(LAS v4u*)(L + (buf ^ 1) * DS_BUF + 9216 + skey * DS_TSTR + 16 * spiece) = vv; }
          kv = kn; vv = vn;
          __syncthreads();
      }
#pragma unroll
      for (int cg = 0; cg < 2; ++cg) { float v = lrun[cg]; v += __shfl_xor(v, 16); v += __shfl_xor(v, 32); const float inv = 1.0f / v;
          const int q = 4 * w + 2 * cg + (fr >> 3);
#pragma unroll
          for (int dt = 0; dt < 4; ++dt) { v2u o; o.x = cvtpk(O[cg][dt][0] * inv, O[cg][dt][1] * inv); o.y = cvtpk(O[cg][dt][2] * inv, O[cg][dt][3] * inv);
              *(v2u*)(YB + (size_t)(qrow0 + q) * 512 + hh * 64 + 16 * dt + 4 * kq) = o; } } }
}

__global__ void __launch_bounds__(NWAVES * 64, 2) mk_fwd(Args args) {
    extern __shared__ __attribute__((aligned(16))) unsigned char lds[];
    LAS unsigned char* L = (LAS unsigned char*)lds;
    volatile LAS unsigned* MISC = (volatile LAS unsigned*)(L + MISC_OFF);
    const int tid = threadIdx.x, lane = tid & 63, wave = __builtin_amdgcn_readfirstlane(tid >> 6);
    const int G = gridDim.x, bx = blockIdx.x;
    const int gw = bx * NWAVES + wave, NGW = G * NWAVES;
    unsigned char* ws = args.ws;
    if (tid < 32) MISC[tid] = 0u;
    __syncthreads();
    XcdBarrier bar; bar.bar = (unsigned*)(ws + WS_CTL) + CW_BAR; bar.x = 0; bar.st = nullptr;
    if (!MK_PER_PHASE) bar = xcd_barrier_post((unsigned*)(ws + WS_CTL) + CW_BAR, MISC + 8);
    const int lo = args.ph_lo, hi = args.ph_hi;
#define IN(k) (lo <= (k) && (k) < hi)
#define SEAM(k) do { if (IN(k) && IN((k) + 1)) xcd_barrier(bar); } while (0)
    bf16* WT1 = (bf16*)(ws + WS_WT1); bf16* WT2 = (bf16*)(ws + WS_WT2); bf16* WT3 = (bf16*)(ws + WS_WT3); bf16* WT4 = (bf16*)(ws + WS_WT4); bf16* WT5 = (bf16*)(ws + WS_WT5);
    bf16* WGLU = (bf16*)(ws + WS_WGLU); bf16* WA = (bf16*)(ws + WS_WA); bf16* WB = (bf16*)(ws + WS_WB); bf16* WOUT = (bf16*)(ws + WS_WOUT);
    bf16* HN = (bf16*)(ws + WS_HN); bf16* FB = (bf16*)(ws + WS_F); bf16* ACT = (bf16*)(ws + WS_BIG);
    bf16* PA = (bf16*)(ws + WS_PA); bf16* PG = (bf16*)(ws + WS_PG); bf16* PK = (bf16*)(ws + WS_PK);
    bf16* AM1 = (bf16*)(ws + WS_META + MO_AM1); bf16* ACTM = (bf16*)(ws + WS_META + MO_ACTM); bf16* FM = (bf16*)(ws + WS_META + MO_FM); bf16* AM2 = (bf16*)(ws + WS_META + MO_AM2);
    bf16* PMU = (bf16*)(ws + WS_META + MO_PMU); bf16* PMK = (bf16*)(ws + WS_META + MO_PMK);
    bf16* HB = (bf16*)(ws + WS_HB); float* RS1 = (float*)(ws + WS_META + 524288); float* RS2 = (float*)(ws + WS_META + 655360);
    bf16* YA = FB; bf16* YG = HN; bf16* YB = HN + (size_t)R * 512; bf16* MERGED = PA;
    const float* x = args.in[0]; float* out = args.out;

    if (IN(0)) {
        for (int item = bx; item < 256; item += G) s5_tables_block(args, item >> 3, item & 7, (LAS float*)L, tid);
        __syncthreads();
        LAS float* scr = (LAS float*)(L + wave * 16384);
        for (int it = gw; it < 11520; it += NGW) {
            int r = it;
            if (r < 6 * 1408) { const int mat = r / 1408; r -= mat * 1408;
                if (mat == 5) { const int kb = r / 32, nb = r % 32; transpose_item8(args.in[13], D, DFF, (unsigned char*)WT5, 64 * kb, 32 * nb, 32 * nb + (lane & 31), scr, lane); }
                else if (mat == 2) { const int kb = r / 32, nb = r % 32; transpose_item(args.in[10], D, DFF, WT2, 64 * kb, 32 * nb, 32 * nb + (lane & 31), scr, lane); }
                else if (mat >= 3) { const int kb = r / 88, nb = r % 88, d0 = 32 * nb, up = (mat == 4) ? 128 : 0; transpose_item8(args.in[mat == 3 ? 11 : 12], DFF, D, (unsigned char*)WT4, 64 * kb, 256 * (d0 >> 7) + (d0 & 127) + up, d0 + (lane & 31), scr, lane); }
                else { const int kb = r / 88, nb = r % 88, d0 = 32 * nb, up = (mat == 1 || mat == 4) ? 128 : 0;
                    transpose_item(args.in[mat == 0 ? 8 : mat == 1 ? 9 : mat == 3 ? 11 : 12], DFF, D, mat < 3 ? WT1 : WT4, 64 * kb, 256 * (d0 >> 7) + (d0 & 127) + up, d0 + (lane & 31), scr, lane, args.in[2]); }
                continue; }
            r -= 6 * 1408;
            if (r < 1920) { const int kb = r / 120, nb = r % 120; transpose_item(args.in[14], 3784, D, WT3, 64 * kb, 32 * nb, win_srccol(32 * nb + (lane & 31)), scr, lane, args.in[4]); continue; }
            r -= 1920;
            if (r < 128) { const int kb = r / 16, nb = r % 16; transpose_item(args.in[23], 512, 512, WGLU, 64 * kb, 32 * nb, 32 * nb + (lane & 31), scr, lane); continue; }
            r -= 128;
            if (r < 256) { const int kb = r / 32, nb = r % 32; transpose_item(args.in[24], D, 512, WA, 64 * kb, 32 * nb, 32 * nb + (lane & 31), scr, lane); continue; }
            r -= 256;
            if (r < 256) { const int kb = r / 32, nb = r % 32; transpose_item(args.in[26], D, 512, WB, 64 * kb, 32 * nb, 32 * nb + (lane & 31), scr, lane); continue; }
            r -= 256;
            { const int kb = r / 32, nb = r % 32; transpose_item(args.in[27], D, D, WOUT, 64 * kb, 32 * nb, 32 * nb + (lane & 31), scr, lane); }
        }
        for (int m = gw; m < R; m += NGW) x_row_to_bf16<false>(x + (size_t)m * D, HN + (size_t)m * D, RS1 + m, lane);
        if (gw < NMETA) x_row_to_bf16<true>(args.in[1] + (size_t)gw * D, AM1 + (size_t)gw * D, nullptr, lane);
    }
    SEAM(0);
    if (IN(1)) {
        if (gw < 176) { const int j0 = 16 * gw, grow = 256 * (j0 >> 7) + (j0 & 127); const f32x4 g4 = meta_tile(AM1, WT1 + (size_t)grow * D, D, lane), u4 = meta_tile(AM1, WT1 + (size_t)(grow + 128) * D, D, lane);
#pragma unroll
            for (int r = 0; r < 4; ++r) ACTM[(4 * (lane >> 4) + r) * DFF + j0 + (lane & 15)] = (bf16)f2bf(g4[r] * fsig(g4[r]) * u4[r]); }
        pg8::Gemm g{HN, WT1, R, 2 * DFF, D}; pg8::StaticOrder S; S.init(R, 2 * DFF, G, bx); pg8::EpiSwiglu E{ACT, DFF, RS1};
        pg8::gemm_phase<pg8::EpiSwiglu, pg8::StaticOrder, PG8_ALIGN, PG8_SP2>(L, g, S, E);
        if (REP_G1 > 1) pg8::gemm_phase<pg8::EpiSwiglu, pg8::StaticOrder, PG8_ALIGN, PG8_SP2>(L, g, S, E);
    }
    SEAM(1);
    if (IN(2)) {
        if (gw < 64) { const int n0 = 16 * gw; const f32x4 f4 = meta_tile(ACTM, WT2 + (size_t)n0 * DFF, DFF, lane);
#pragma unroll
            for (int r = 0; r < 4; ++r) FM[(4 * (lane >> 4) + r) * D + n0 + (lane & 15)] = (bf16)f2bf(f4[r]); }
        pg8::Gemm g{ACT, WT2, R, D, DFF}; pg8::StaticOrder S; S.init(R, D, G, bx); pg8::EpiPlain E{FB, D};
        pg8::gemm_phase<pg8::EpiPlain, pg8::StaticOrder, PG8_ALIGN, PG8_SP2>(L, g, S, E);
    }
    SEAM(2);
    if (IN(3)) {
        if (gw < NMETA) row_update<false, false>(FM + (size_t)gw * D, args.in[1] + (size_t)gw * D, nullptr, AM2 + (size_t)gw * D, args.in[3], nullptr, 0.5f, lane);
        for (int m = gw; m < R; m += NGW) row_update<true, true>(FB + (size_t)m * D, HN + (size_t)m * D, HB + (size_t)m * D, nullptr, args.in[3], nullptr, 0.5f, lane, RS2 + m);
    }
    SEAM(3);
    if (IN(4)) {
        if (gw < 44) { const int n0 = gw < 32 ? 16 * gw : 3584 + 16 * (gw - 32); const f32x4 p4 = meta_tile(AM2, WT3 + (size_t)n0 * D, D, lane);
#pragma unroll
            for (int r = 0; r < 4; ++r) { const int row = 4 * (lane >> 4) + r; if (gw < 32) PMU[row * 512 + n0 + (lane & 15)] = (bf16)f2bf(p4[r]); else PMK[row * 256 + (n0 - 3584) + (lane & 15)] = (bf16)f2bf(p4[r]); } }
        pg8::Gemm g{HB, WT3, R, 3840, D}; pg8::StaticOrder S; S.init(R, 3840, G, bx); pg8::EpiProj E{PA, PG, PK, (bf16*)(ws + WS_UA2), RS2};
        pg8::gemm_phase<pg8::EpiProj, pg8::StaticOrder, PG8_ALIGN, PG8_SP2>(L, g, S, E);
    }
    SEAM(4);
    if (IN(5)) {
        s5_meta(args, L, bx >> 3, tid);
        for (int rep = 0; rep < REP_S5; ++rep) for (int i = 0; i < 2; ++i) s5_unit(args, L, 2 * (bx & 7) + i, bx >> 3, tid);
        __syncthreads();
        dsa_tables(args, L, tid);
        for (int i = 0; i < 4 * REP_DSA; ++i) { const int up = 4 * (bx >> 3) + (i & 3), u2 = up >> 1, b = 2 * (bx & 7) + (u2 >> 5), xq = u2 & 31; dsa_unit(args, L, b, (up & 1) ? 63 - xq : xq, tid); }
        __syncthreads();
    }
    SEAM(5);
    if (IN(6)) { pg8::Gemm g{YA, WGLU, R, 512, 512}; pg8::StaticOrder S; S.init(R, 512, G, bx); pg8::EpiGlu E{YA, YG};
        pg8::gemm_phase<pg8::EpiGlu, pg8::StaticOrder, PG8_ALIGN, PG8_SP2>(L, g, S, E); }
    SEAM(6);
    if (IN(7)) { pg8::Gemm g{YG, WA, 2 * R, 2048, 512}; pg8::MergeOrder S; S.base.init(R, D, G, bx); pg8::EpiMerge2 E{PG, FB, MERGED};
        pg8::gemm_phase<pg8::EpiMerge2, pg8::MergeOrder, PG8_ALIGN, PG8_SP2>(L, g, S, E); }
    if (IN(7) && IN(9)) xcd_barrier(bar);
    if (IN(9)) { pg8::Gemm g{MERGED, WOUT, R, D, D}; pg8::StaticOrder S; S.init(R, D, G, bx); pg8::EpiPlain E{FB, D};
        pg8::gemm_phase<pg8::EpiPlain, pg8::StaticOrder, PG8_ALIGN, PG8_SP2>(L, g, S, E); }
    SEAM(9);
    if (IN(10)) { for (int m = gw; m < R; m += NGW) row_update<true, true, true>(FB + (size_t)m * D, HB + (size_t)m * D, HB + (size_t)m * D, (bf16*)((unsigned char*)HN + (size_t)m * D), args.in[5], args.in[6], 1.0f, lane); }
    SEAM(10);
    if (IN(11)) { pg8::Gemm g{HN, WT4, R, 2 * DFF, D}; pg8::StaticOrder S; S.init(R, 2 * DFF, G, bx); pg8::EpiSwiglu8 E{(unsigned char*)ACT, DFF, 1.0f / 256.0f, 8.0f};
        pg8::gemm_phase<pg8::EpiSwiglu8, pg8::StaticOrder, PG8_ALIGN, PG8_SP2, true>(L, g, S, E); }
    SEAM(11);
    if (IN(12)) { pg8::Gemm g{ACT, WT5, R, D, DFF}; pg8::StaticOrder S; S.init(R, D, G, bx); pg8::EpiPlainS E{FB, D, 1.0f / 512.0f};
        pg8::gemm_phase<pg8::EpiPlainS, pg8::StaticOrder, PG8_ALIGN, PG8_SP2, true>(L, g, S, E); }
    SEAM(12);
    if (IN(13)) { for (int m = gw; m < R; m += NGW) row_update<true, false>(FB + (size_t)m * D, HB + (size_t)m * D, out + (size_t)m * D, nullptr, args.in[7], args.in[7], 0.5f, lane); }
#undef IN
#undef SEAM
}

extern "C" void kernel_launch(void* const* d_in, const int* in_sizes, int n_in, void* d_out, int out_size, void* d_ws, size_t ws_size, hipStream_t stream) {
    static int grid = 0;
    if (grid == 0) {
        if (n_in != 28 || out_size != R * D || ws_size < WS_END) { fprintf(stderr, "kernel_launch: unexpected shapes (n_in %d, out %d, ws %zu); nothing launched\n", n_in, out_size, ws_size); grid = -1; return; }
        int dev = 0, cus = 0, per_cu = 0;
        if (hipGetDevice(&dev) != hipSuccess || hipDeviceGetAttribute(&cus, hipDeviceAttributeMultiprocessorCount, dev) != hipSuccess) { grid = -1; return; }
        if (hipFuncSetAttribute((const void*)mk_fwd, hipFuncAttributeMaxDynamicSharedMemorySize, LDS_BYTES) != hipSuccess) { fprintf(stderr, "kernel_launch: hipFuncSetAttribute failed\n"); grid = -1; return; }
        if (hipOccupancyMaxActiveBlocksPerMultiprocessor(&per_cu, (const void*)mk_fwd, NWAVES * 64, LDS_BYTES) != hipSuccess || per_cu < 1) fprintf(stderr, "kernel_launch: note: occupancy query reports %d\n", per_cu);
        (void)hipGetLastError();
        grid = cus;
    }
    if (grid < 0) return;
    if (hipMemsetAsync((char*)d_ws + WS_CTL, 0, CTL_ZERO_BYTES, stream) != hipSuccess) return;
    Args a{};
    for (int i = 0; i < 28; ++i) a.in[i] = (const float*)d_in[i];
    a.out = (float*)d_out; a.ws = (unsigned char*)d_ws;
#if MK_PER_PHASE
    for (int ph = 0; ph < NPH; ++ph) { a.ph_lo = ph; a.ph_hi = ph + 1; hipLaunchKernelGGL(mk_fwd, dim3(grid), dim3(NWAVES * 64), LDS_BYTES, stream, a); }
#else
    a.ph_lo = 0; a.ph_hi = NPH;
    hipLaunchKernelGGL(mk_fwd, dim3(grid), dim3(NWAVES * 64), LDS_BYTES, stream, a);
#endif
}
```

```cpp
#include <hip/hip_runtime.h>
#include <cstdio>
#include <cstdint>
namespace pg8 {
#define PG8_LAS __attribute__((address_space(3)))
typedef unsigned short bf16_t;
typedef short bf16x8 __attribute__((ext_vector_type(8)));
typedef float f32x4 __attribute__((ext_vector_type(4)));
typedef unsigned u32x4 __attribute__((ext_vector_type(4)));
constexpr int BM = 256, BK = 64, HALF = 128, HTB = HALF * BK * 2  , STAGE_BYTES = 8 * HTB, NXCD = 8, WGM = 8;

__host__ __device__ __forceinline__ int lds_byte(int r, int c) { const int st = (r >> 4) * 2 + (c >> 5), rr = r & 15, cc = c & 31, ob = rr * 64 + cc * 2; return st * 1024 + (ob ^ (((ob >> 9) & 1) << 5)); }
__host__ __device__ __forceinline__ void stage_rc(int b, int& R, int& C) { const int st = b / 1024, sb = b % 1024, swz = sb ^ (((sb >> 9) & 1) << 5); R = (st >> 1) * 16 + swz / 64; C = (st & 1) * 32 + (swz % 64) / 2; }
__host__ __device__ __forceinline__ int perm32(int rho) { const int n = rho >> 4, i = rho & 15; return 8 * (i >> 2) + 4 * n + (i & 3); }

struct Unit { int pm, pn; };
struct Gemm { const bf16_t* A; const bf16_t* Bt; int M, N, K; };

struct StaticOrder {
    int nM, nN, nwg, G, c;
    __host__ __device__ void init(int M, int N, int G_, int c_) { nM = M / BM; nN = N / BM; nwg = nM * nN; G = G_; c = c_; }
    __host__ __device__ bool next(int i, Unit& u) const {
        const long L = (long)i * G + c; if (L >= nwg) return false;
        int wgid = (int)L; { const int q = nwg / NXCD, r = nwg % NXCD, xcd = wgid % NXCD, off = wgid / NXCD; wgid = (xcd < r ? xcd * (q + 1) : r * (q + 1) + (xcd - r) * q) + off; }
        const int nig = WGM * nN, gid = wgid / nig, fm = gid * WGM, gsz = (nM - fm) < WGM ? (nM - fm) : WGM;
        u.pm = fm + ((wgid % nig) % gsz); u.pn = (wgid % nig) / gsz; return true;
    }
    __device__ __forceinline__ void a_ready(const Unit&) const {}
    __device__ __forceinline__ void done(const Unit&) const {}
};
__device__ __forceinline__ unsigned cvt_pk_bf16(float lo, float hi) { unsigned r; asm volatile("v_cvt_pk_bf16_f32 %0, %1, %2" : "=v"(r) : "v"(lo), "v"(hi)); return r; }
__device__ __forceinline__ float fsigmoid(float x) { return __builtin_amdgcn_rcpf(1.0f + __expf(-x)); }
__device__ __forceinline__ float bf_lo(unsigned w) { return __uint_as_float(w << 16); }
__device__ __forceinline__ float bf_hi(unsigned w) { return __uint_as_float(w & 0xffff0000u); }
__device__ __forceinline__ u32x4 pack8(const f32x4 v0, const f32x4 v1) { u32x4 w; w.x = cvt_pk_bf16(v0[0], v0[1]); w.y = cvt_pk_bf16(v0[2], v0[3]); w.z = cvt_pk_bf16(v1[0], v1[1]); w.w = cvt_pk_bf16(v1[2], v1[3]); return w; }
__device__ __forceinline__ void unpack8(const u32x4 w, f32x4& v0, f32x4& v1) { v0 = (f32x4){bf_lo(w.x), bf_hi(w.x), bf_lo(w.y), bf_hi(w.y)}; v1 = (f32x4){bf_lo(w.z), bf_hi(w.z), bf_lo(w.w), bf_hi(w.w)}; }

struct EpiSwiglu {
    static constexpr bool PERM = true, AFTER_DRAIN = false;
    bf16_t* O; int ldc; const float* rs;
    __device__ __forceinline__ void operator()(const f32x4 (&acc)[2][2][4][2], const Unit& u, int wr, int wc, int fr, int fq) const {
        const int row0 = u.pm * BM + wr * 64 + fr, col0 = u.pn * HALF + wc * 32 + 8 * fq;
#pragma unroll
        for (int ai = 0; ai < 2; ++ai)
#pragma unroll
            for (int m = 0; m < 4; ++m) { bf16_t* rowp = O + (size_t)(row0 + ai * HALF + m * 16) * ldc + col0; const float rsc = rs[row0 + ai * HALF + m * 16];
                f32x4 v0, v1;
#pragma unroll
                for (int j = 0; j < 4; ++j) { const float g0 = acc[ai][0][m][0][j] * rsc, g1 = acc[ai][0][m][1][j] * rsc;
                    v0[j] = g0 * fsigmoid(g0) * (acc[ai][1][m][0][j] * rsc); v1[j] = g1 * fsigmoid(g1) * (acc[ai][1][m][1][j] * rsc); }
                *(u32x4*)rowp = pack8(v0, v1); }
    }
};
struct EpiPlain {
    static constexpr bool PERM = true, AFTER_DRAIN = false;
    bf16_t* O; int ldc;
    __device__ __forceinline__ void operator()(const f32x4 (&acc)[2][2][4][2], const Unit& u, int wr, int wc, int fr, int fq) const {
        const int row0 = u.pm * BM + wr * 64 + fr, col0 = u.pn * BM + wc * 32 + 8 * fq;
#pragma unroll
        for (int ai = 0; ai < 2; ++ai)
#pragma unroll
            for (int m = 0; m < 4; ++m) { bf16_t* rowp = O + (size_t)(row0 + ai * HALF + m * 16) * ldc + col0;
#pragma unroll
                for (int bj = 0; bj < 2; ++bj) *(u32x4*)(rowp + bj * HALF) = pack8(acc[ai][bj][m][0], acc[ai][bj][m][1]); }
    }
};

__device__ __forceinline__ unsigned pk4_fp8(float a, float b, float c, float d) { int w = 0; w = __builtin_amdgcn_cvt_pk_fp8_f32(fminf(fmaxf(a, -448.f), 448.f), fminf(fmaxf(b, -448.f), 448.f), w, false);
    w = __builtin_amdgcn_cvt_pk_fp8_f32(fminf(fmaxf(c, -448.f), 448.f), fminf(fmaxf(d, -448.f), 448.f), w, true); return (unsigned)w; }
struct EpiSwiglu8 {
    static constexpr bool PERM = true, AFTER_DRAIN = false;
    unsigned char* O; int ldc; float ascale, oscale;
    __device__ __forceinline__ void operator()(const f32x4 (&acc)[2][2][4][2], const Unit& u, int wr, int wc, int fr, int fq) const {
        const int row0 = u.pm * BM + wr * 64 + fr, col0 = u.pn * HALF + wc * 32 + 8 * fq;
#pragma unroll
        for (int ai = 0; ai < 2; ++ai)
#pragma unroll
            for (int m = 0; m < 4; ++m) { unsigned char* rowp = O + (size_t)(row0 + ai * HALF + m * 16) * ldc + col0;
                f32x4 v0, v1;
#pragma unroll
                for (int j = 0; j < 4; ++j) { const float g0 = acc[ai][0][m][0][j] * ascale, g1 = acc[ai][0][m][1][j] * ascale;
                    v0[j] = g0 * fsigmoid(g0) * (acc[ai][1][m][0][j] * ascale) * oscale; v1[j] = g1 * fsigmoid(g1) * (acc[ai][1][m][1][j] * ascale) * oscale; }
                typedef unsigned u32x2 __attribute__((ext_vector_type(2))); u32x2 w; w.x = pk4_fp8(v0[0], v0[1], v0[2], v0[3]); w.y = pk4_fp8(v1[0], v1[1], v1[2], v1[3]);
                *(u32x2*)rowp = w; }
    }
};
struct EpiPlainS {
    static constexpr bool PERM = true, AFTER_DRAIN = false;
    bf16_t* O; int ldc; float scale;
    __device__ __forceinline__ void operator()(const f32x4 (&acc)[2][2][4][2], const Unit& u, int wr, int wc, int fr, int fq) const {
        const int row0 = u.pm * BM + wr * 64 + fr, col0 = u.pn * BM + wc * 32 + 8 * fq;
#pragma unroll
        for (int ai = 0; ai < 2; ++ai)
#pragma unroll
            for (int m = 0; m < 4; ++m) { bf16_t* rowp = O + (size_t)(row0 + ai * HALF + m * 16) * ldc + col0;
#pragma unroll
                for (int bj = 0; bj < 2; ++bj) *(u32x4*)(rowp + bj * HALF) = pack8(acc[ai][bj][m][0] * scale, acc[ai][bj][m][1] * scale); }
    }
};
struct EpiProj {
    static constexpr bool PERM = true, AFTER_DRAIN = false;
    bf16_t *PA, *PG, *PK, *UA2; const float* rs;
    __device__ __forceinline__ void operator()(const f32x4 (&acc)[2][2][4][2], const Unit& u, int wr, int wc, int fr, int fq) const {
        if (u.pn < 2) {
#pragma unroll
            for (int ai = 0; ai < 2; ++ai)
#pragma unroll
                for (int m = 0; m < 4; ++m) { const int row = u.pm * BM + wr * 64 + fr + ai * HALF + m * 16, bb = row >> 11, t = row & 2047;
#pragma unroll
                    for (int bj = 0; bj < 2; ++bj) { const int col = 256 * u.pn + 128 * bj + wc * 32 + 8 * fq;
                        const float rsc = rs[row]; *(u32x4*)(UA2 + ((size_t)((bb * 32 + (col >> 4)) * 2048 + t)) * 16 + (col & 8)) = pack8(acc[ai][bj][m][0] * rsc, acc[ai][bj][m][1] * rsc); } }
            return; }
        bf16_t* base; int ldc, colt;
        if (u.pn < 6) { base = PA; ldc = 1536; colt = 256 * u.pn; } else if (u.pn < 14) { base = PG; ldc = 2048; colt = 256 * (u.pn - 6); } else { base = PK; ldc = 256; colt = 0; }
        const int row0 = u.pm * BM + wr * 64 + fr, col0 = colt + wc * 32 + 8 * fq;
#pragma unroll
        for (int ai = 0; ai < 2; ++ai)
#pragma unroll
            for (int m = 0; m < 4; ++m) { bf16_t* rowp = base + (size_t)(row0 + ai * HALF + m * 16) * ldc + col0; const float rsc = rs[row0 + ai * HALF + m * 16];
#pragma unroll
                for (int bj = 0; bj < 2; ++bj) *(u32x4*)(rowp + bj * HALF) = pack8(acc[ai][bj][m][0] * rsc, acc[ai][bj][m][1] * rsc); }
    }
};
struct EpiGlu {
    static constexpr bool PERM = true, AFTER_DRAIN = false;
    const bf16_t* Y; bf16_t* O;
    __device__ __forceinline__ void operator()(const f32x4 (&acc)[2][2][4][2], const Unit& u, int wr, int wc, int fr, int fq) const {
        const int row0 = u.pm * BM + wr * 64 + fr, col0 = u.pn * BM + wc * 32 + 8 * fq;
#pragma unroll
        for (int ai = 0; ai < 2; ++ai)
#pragma unroll
            for (int m = 0; m < 4; ++m) { const size_t off = (size_t)(row0 + ai * HALF + m * 16) * 512 + col0;
#pragma unroll
                for (int bj = 0; bj < 2; ++bj) { f32x4 y0, y1; unpack8(*(const u32x4*)(Y + off + bj * HALF), y0, y1); f32x4 v0, v1;
#pragma unroll
                    for (int j = 0; j < 4; ++j) { v0[j] = y0[j] * fsigmoid(acc[ai][bj][m][0][j]); v1[j] = y1[j] * fsigmoid(acc[ai][bj][m][1][j]); }
                    *(u32x4*)(O + off + bj * HALF) = pack8(v0, v1); } }
    }
};
template <bool SECOND> struct EpiMerge {
    static constexpr bool PERM = true, AFTER_DRAIN = false;
    const bf16_t* G; int goff; const bf16_t* T; bf16_t* O;
    __device__ __forceinline__ void operator()(const f32x4 (&acc)[2][2][4][2], const Unit& u, int wr, int wc, int fr, int fq) const {
        const int row0 = u.pm * BM + wr * 64 + fr, col0 = u.pn * BM + wc * 32 + 8 * fq;
#pragma unroll
        for (int ai = 0; ai < 2; ++ai)
#pragma unroll
            for (int m = 0; m < 4; ++m) { const size_t row = (size_t)(row0 + ai * HALF + m * 16);
#pragma unroll
                for (int bj = 0; bj < 2; ++bj) { const int col = col0 + bj * HALF; f32x4 g0, g1; unpack8(*(const u32x4*)(G + row * 2048 + goff + col), g0, g1);
                    f32x4 t0 = (f32x4){0.f, 0.f, 0.f, 0.f}, t1 = t0; if (SECOND) unpack8(*(const u32x4*)(T + row * 1024 + col), t0, t1);
                    f32x4 v0, v1;
#pragma unroll
                    for (int j = 0; j < 4; ++j) { v0[j] = t0[j] + fsigmoid(g0[j]) * acc[ai][bj][m][0][j]; v1[j] = t1[j] + fsigmoid(g1[j]) * acc[ai][bj][m][1][j]; }
                    *(u32x4*)(O + row * 1024 + col) = pack8(v0, v1); } }
    }
};

struct MergeOrder {
    StaticOrder base;
    __device__ __forceinline__ bool next(int i, Unit& u) const { if (i >= 4) return false; if (!base.next(i & 1, u)) return false; if (i >= 2) { u.pm += 128; u.pn += 4; } return true; }
    __device__ __forceinline__ void a_ready(const Unit&) const {}
    __device__ __forceinline__ void done(const Unit&) const {}
};
struct EpiMerge2 {
    static constexpr bool PERM = true, AFTER_DRAIN = false;
    const bf16_t* G; bf16_t* T; bf16_t* O;
    __device__ __forceinline__ void operator()(const f32x4 (&acc)[2][2][4][2], const Unit& u, int wr, int wc, int fr, int fq) const {
        const bool second = u.pm >= 128; const int pm = second ? u.pm - 128 : u.pm, pn = second ? u.pn - 4 : u.pn, goff = second ? 1024 : 0;
        const int row0 = pm * BM + wr * 64 + fr, col0 = pn * BM + wc * 32 + 8 * fq;
#pragma unroll
        for (int ai = 0; ai < 2; ++ai)
#pragma unroll
            for (int m = 0; m < 4; ++m) { const size_t row = (size_t)(row0 + ai * HALF + m * 16);
#pragma unroll
                for (int bj = 0; bj < 2; ++bj) { const int col = col0 + bj * HALF; f32x4 g0, g1; unpack8(*(const u32x4*)(G + row * 2048 + goff + col), g0, g1);
                    f32x4 t0 = (f32x4){0.f, 0.f, 0.f, 0.f}, t1 = t0; if (second) unpack8(*(const u32x4*)(T + row * 1024 + col), t0, t1);
                    f32x4 v0, v1;
#pragma unroll
                    for (int j = 0; j < 4; ++j) { v0[j] = t0[j] + fsigmoid(g0[j]) * acc[ai][bj][m][0][j]; v1[j] = t1[j] + fsigmoid(g1[j]) * acc[ai][bj][m][1][j]; }
                    *(u32x4*)((second ? O : T) + row * 1024 + col) = pack8(v0, v1); } }
    }
};
typedef int i32x8 __attribute__((ext_vector_type(8)));
typedef int i32x4v __attribute__((ext_vector_type(4)));
__device__ __forceinline__ i32x8 cat8(const bf16x8 lo, const bf16x8 hi) { const i32x4v a = __builtin_bit_cast(i32x4v, lo), b = __builtin_bit_cast(i32x4v, hi); return __builtin_shufflevector(a, b, 0, 1, 2, 3, 4, 5, 6, 7); }
template <class Epi, class Sched, bool ALIGN_EPI = false, bool SP2 = false, bool F8 = false>
__device__ __forceinline__ void gemm_phase(PG8_LAS unsigned char* lds, const Gemm g, const Sched& S, const Epi& E) {
    const int tid = threadIdx.x, wid = __builtin_amdgcn_readfirstlane(tid >> 6), lane = tid & 63, wr = wid >> 2, wc = wid & 3, fr = lane & 15, fq = lane >> 4;
    const int K = g.K, KB = F8 ? K : 2 * K  , nt = KB / 128;
    unsigned voffA[2], voffB[2];
#pragma unroll
    for (int i = 0; i < 2; ++i) { int R, C; stage_rc(tid * 16 + i * 8192, R, C); const int Rb = Epi::PERM ? ((R & ~31) + perm32(R & 31)) : R;
        voffA[i] = (unsigned)(R * KB + C * 2); voffB[i] = (unsigned)(Rb * KB + C * 2); }
    const size_t kstep = (size_t)(BK * 2);
    const size_t hstep = (size_t)HALF * KB;
    const size_t tstep = 2 * hstep;
    const unsigned ldsw = (unsigned)wid * 1024u;
    const int aoff = lds_byte(wr * 64 + fr, fq * 8), boff = lds_byte(wc * 32 + fr, fq * 8);
#define PG8_SA(b, h) (((b) * 2 + (h)) * HTB)
#define PG8_SB(b, h) ((4 + (b) * 2 + (h)) * HTB)
#define PG8_STAGE(bufoff, gbase, voff) do { _Pragma("unroll") for (int _i = 0; _i < 2; ++_i) \
        __builtin_amdgcn_global_load_lds((const unsigned*)((const char*)(gbase) + (voff)[_i]), (PG8_LAS unsigned*)(lds + (bufoff) + ldsw + _i * 8192), 16, 0, 0); } while (0)
#define PG8_LDA(dst, b, h) do { if constexpr (F8) { _Pragma("unroll") for (int m = 0; m < 4; ++m) dst##8[m] = cat8(*(const PG8_LAS bf16x8*)(lds + PG8_SA(b, h) + aoff + m * 2048), *(const PG8_LAS bf16x8*)(lds + PG8_SA(b, h) + aoff + m * 2048 + 1024)); } else { \
        _Pragma("unroll") for (int m = 0; m < 4; ++m) _Pragma("unroll") for (int k = 0; k < 2; ++k) dst[m][k] = *(const PG8_LAS bf16x8*)(lds + PG8_SA(b, h) + aoff + m * 2048 + k * 1024); } } while (0)
#define PG8_LDB(dst, b, h) do { if constexpr (F8) { _Pragma("unroll") for (int n = 0; n < 2; ++n) dst##8[n] = cat8(*(const PG8_LAS bf16x8*)(lds + PG8_SB(b, h) + boff + n * 2048), *(const PG8_LAS bf16x8*)(lds + PG8_SB(b, h) + boff + n * 2048 + 1024)); } else { \
        _Pragma("unroll") for (int n = 0; n < 2; ++n) _Pragma("unroll") for (int k = 0; k < 2; ++k) dst[n][k] = *(const PG8_LAS bf16x8*)(lds + PG8_SB(b, h) + boff + n * 2048 + k * 1024); } } while (0)
#define PG8_MMA(ai, bj, At, Bt) do { __builtin_amdgcn_s_setprio(1); if constexpr (F8) { _Pragma("unroll") for (int m = 0; m < 4; ++m) _Pragma("unroll") for (int n = 0; n < 2; ++n) \
        acc[ai][bj][m][n] = __builtin_amdgcn_mfma_scale_f32_16x16x128_f8f6f4(Bt##8[n], At##8[m], acc[ai][bj][m][n], 0, 0, 0, 0x7F7F7F7F, 0, 0x7F7F7F7F); \
        _Pragma("unroll") for (int m = 0; m < 4; ++m) _Pragma("unroll") for (int n = 0; n < 2; ++n) asm volatile("" : "+v"(acc[ai][bj][m][n])); } else { \
        _Pragma("unroll") for (int m = 0; m < 4; ++m) _Pragma("unroll") for (int n = 0; n < 2; ++n) _Pragma("unroll") for (int k = 0; k < 2; ++k) \
        acc[ai][bj][m][n] = __builtin_amdgcn_mfma_f32_16x16x32_bf16(Bt[n][k], At[m][k], acc[ai][bj][m][n], 0, 0, 0); } __builtin_amdgcn_s_setprio(0); } while (0)
#define PG8_WAIT_V(n) asm volatile("s_waitcnt vmcnt(" #n ")" ::: "memory")
#define PG8_WAIT_L(n) asm volatile("s_waitcnt lgkmcnt(" #n ")" ::: "memory")
#define PG8_BAR __builtin_amdgcn_s_barrier()
#define PG8_SCHED __builtin_amdgcn_sched_barrier(0)
    Unit cur, nxt; int ui = 0;
    if (!S.next(0, cur)) return;
    f32x4 acc[2][2][4][2];
#pragma unroll
    for (int a = 0; a < 2; ++a)
#pragma unroll
        for (int b = 0; b < 2; ++b)
#pragma unroll
            for (int m = 0; m < 4; ++m)
#pragma unroll
                for (int n = 0; n < 2; ++n) acc[a][b][m][n] = (f32x4){0.f, 0.f, 0.f, 0.f};
    bf16x8 At[4][2], B0[2][2], B1[2][2]; i32x8 At8[4], B08[2], B18[2];
    const char* cA = (const char*)g.A + (size_t)cur.pm * tstep; const char* cB = (const char*)g.Bt + (size_t)cur.pn * tstep;
    S.a_ready(cur);
    if constexpr (SP2) {
        PG8_STAGE(PG8_SB(0, 0), cB, voffB); PG8_STAGE(PG8_SB(0, 1), cB + hstep, voffB); PG8_STAGE(PG8_SA(0, 0), cA, voffA); PG8_STAGE(PG8_SA(0, 1), cA + hstep, voffA);
        if (wr == 1) PG8_BAR;
        PG8_WAIT_V(2); PG8_BAR;
        PG8_STAGE(PG8_SB(1, 0), cB + kstep, voffB); PG8_STAGE(PG8_SA(1, 0), cA + kstep, voffA); PG8_STAGE(PG8_SB(1, 1), cB + hstep + kstep, voffB);
        PG8_WAIT_V(6); PG8_BAR;
    } else {
        PG8_STAGE(PG8_SB(0, 0), cB, voffB); PG8_STAGE(PG8_SA(0, 0), cA, voffA); PG8_STAGE(PG8_SB(0, 1), cB + hstep, voffB); PG8_STAGE(PG8_SA(0, 1), cA + hstep, voffA);
        if (wr == 1) PG8_BAR;
        PG8_WAIT_V(4); PG8_BAR;
        PG8_STAGE(PG8_SB(1, 0), cB + kstep, voffB); PG8_STAGE(PG8_SA(1, 0), cA + kstep, voffA); PG8_STAGE(PG8_SB(1, 1), cB + hstep + kstep, voffB);
        PG8_WAIT_V(6); PG8_BAR;
    }
    for (;;) {
        const bool has_next = S.next(ui + 1, nxt);
        const char* nA = has_next ? (const char*)g.A + (size_t)nxt.pm * tstep : cA; const char* nB = has_next ? (const char*)g.Bt + (size_t)nxt.pn * tstep : cB;
        for (int t = 0; t < nt; t += 2) {
            const bool last = (t == nt - 2);
            const char* a1 = cA + (size_t)(t + 1) * kstep;
            const char* a2 = last ? nA : cA + (size_t)(t + 2) * kstep; const char* b2 = last ? nB : cB + (size_t)(t + 2) * kstep;
            const char* a3 = a2 + kstep; const char* b3 = b2 + kstep;
            if (last && has_next) S.a_ready(nxt);
            if constexpr (SP2) {
            PG8_LDB(B0, 0, 0); PG8_LDB(B1, 0, 1); PG8_SCHED; PG8_LDA(At, 0, 0); PG8_STAGE(PG8_SA(1, 1), a1 + hstep, voffA);
            PG8_WAIT_V(8); PG8_WAIT_L(0); PG8_BAR; PG8_MMA(0, 0, At, B0); PG8_MMA(0, 1, At, B1); PG8_BAR; PG8_SCHED;
            PG8_LDA(At, 0, 1); PG8_STAGE(PG8_SB(0, 0), b2, voffB); PG8_STAGE(PG8_SB(0, 1), b2 + hstep, voffB); PG8_STAGE(PG8_SA(0, 0), a2, voffA);
            PG8_WAIT_V(8); PG8_WAIT_L(0); PG8_BAR; PG8_MMA(1, 0, At, B0); PG8_MMA(1, 1, At, B1); PG8_BAR; PG8_SCHED;
            PG8_LDB(B0, 1, 0); PG8_LDB(B1, 1, 1); PG8_SCHED; PG8_LDA(At, 1, 0); PG8_STAGE(PG8_SA(0, 1), a2 + hstep, voffA);
            PG8_WAIT_V(8); PG8_WAIT_L(0); PG8_BAR; PG8_MMA(0, 0, At, B0); PG8_MMA(0, 1, At, B1); PG8_BAR; PG8_SCHED;
            PG8_LDA(At, 1, 1); PG8_STAGE(PG8_SB(1, 0), b3, voffB); PG8_STAGE(PG8_SB(1, 1), b3 + hstep, voffB); PG8_STAGE(PG8_SA(1, 0), a3, voffA);
            PG8_WAIT_V(8); PG8_WAIT_L(0); PG8_BAR; PG8_MMA(1, 0, At, B0); PG8_MMA(1, 1, At, B1); PG8_BAR; PG8_SCHED;
            } else {
            PG8_LDB(B0, 0, 0); PG8_SCHED; PG8_LDA(At, 0, 0); PG8_STAGE(PG8_SA(1, 1), a1 + hstep, voffA);
            PG8_WAIT_L(8); PG8_BAR; PG8_WAIT_L(0); PG8_MMA(0, 0, At, B0); PG8_BAR; PG8_SCHED;
            PG8_LDB(B1, 0, 1); PG8_STAGE(PG8_SB(0, 0), b2, voffB);
            PG8_BAR; PG8_WAIT_L(0); PG8_MMA(0, 1, At, B1); PG8_BAR;
            PG8_LDA(At, 0, 1); PG8_STAGE(PG8_SA(0, 0), a2, voffA);
            PG8_BAR; PG8_WAIT_L(0); PG8_MMA(1, 0, At, B0); PG8_BAR; PG8_SCHED;
            PG8_STAGE(PG8_SB(0, 1), b2 + hstep, voffB);
            PG8_WAIT_V(6); PG8_BAR; PG8_MMA(1, 1, At, B1); PG8_BAR;
            PG8_LDB(B0, 1, 0); PG8_SCHED; PG8_LDA(At, 1, 0); PG8_STAGE(PG8_SA(0, 1), a2 + hstep, voffA);
            PG8_WAIT_L(8); PG8_BAR; PG8_WAIT_L(0); PG8_MMA(0, 0, At, B0); PG8_BAR; PG8_SCHED;
            PG8_LDB(B1, 1, 1); PG8_STAGE(PG8_SB(1, 0), b3, voffB);
            PG8_BAR; PG8_WAIT_L(0); PG8_MMA(0, 1, At, B1); PG8_BAR;
            PG8_LDA(At, 1, 1); PG8_STAGE(PG8_SA(1, 0), a3, voffA);
            PG8_BAR; PG8_WAIT_L(0); PG8_MMA(1, 0, At, B0); PG8_BAR; PG8_SCHED;
            PG8_STAGE(PG8_SB(1, 1), b3 + hstep, voffB);
            PG8_WAIT_V(6); PG8_BAR; PG8_MMA(1, 1, At, B1); PG8_BAR;
            }
        }
        if constexpr (ALIGN_EPI) { if (wr == 0) PG8_BAR; }
        if constexpr (!Epi::AFTER_DRAIN) { E(acc, cur, wr, wc, fr, fq); S.done(cur); }
        if (!has_next) break;
#pragma unroll
        for (int a = 0; a < 2; ++a)
#pragma unroll
            for (int b = 0; b < 2; ++b)
#pragma unroll
                for (int m = 0; m < 4; ++m)
#pragma unroll
                    for (int n = 0; n < 2; ++n) acc[a][b][m][n] = (f32x4){0.f, 0.f, 0.f, 0.f};
        cur = nxt; cA = nA; cB = nB; ++ui;
        if constexpr (ALIGN_EPI) { if (wr == 1) PG8_BAR; }
    }
    PG8_WAIT_V(0);
    if constexpr (!ALIGN_EPI) { if (wr == 0) PG8_BAR; }
    PG8_BAR;
    if constexpr (Epi::AFTER_DRAIN) { E.fused(acc, cur, wr, wc, fr, fq, lds, wid, lane); S.done(cur); }
#undef PG8_SA
#undef PG8_SB
#undef PG8_STAGE
#undef PG8_LDA
#undef PG8_LDB
#undef PG8_MMA
#undef PG8_WAIT_V
#undef PG8_WAIT_L
#undef PG8_BAR
#undef PG8_SCHED
}
}
#ifndef PG8_SP2
#define PG8_SP2 true
#endif
#ifndef PG8_ALIGN
#define PG8_ALIGN true
#endif
#ifndef MK_PER_PHASE
#define MK_PER_PHASE 0
#endif
#ifndef REP_S5
#define REP_S5 1
#endif
#ifndef REP_DSA
#define REP_DSA 1
#endif
#ifndef REP_G1
#define REP_G1 1
#endif
constexpr int NWAVES = 8;
constexpr int NPH = 14;

constexpr int NB = 16, SEQ = 2048, D = 1024, NMETA = 16, DFF = 2816;
constexpr int R = NB * SEQ;
constexpr int NG = 32, NP = 64, NM = 16;
constexpr float RMS_EPS = 1e-6f;

constexpr size_t MiB = 1u << 20;
constexpr size_t WS_CTL = 0, CTL_ZERO_BYTES = 1 * MiB;
constexpr size_t WS_WT1 = 2 * MiB, WS_WT2 = 13 * MiB, WS_WT3 = 19 * MiB, WS_WT4 = 27 * MiB, WS_WT5 = 38 * MiB;
constexpr size_t WS_WGLU = 44 * MiB, WS_WA = 45 * MiB, WS_WB = 46 * MiB, WS_WOUT = 47 * MiB;
constexpr size_t WS_KS = 50 * MiB, WS_KO = 58 * MiB, WS_KI = 66 * MiB;
constexpr size_t WS_META = 67 * MiB;
constexpr size_t MO_AM1 = 0, MO_ACTM = 32768, MO_FM = 131072, MO_AM2 = 262144, MO_PMU = 294912, MO_PMK = 311296;
constexpr size_t WS_HN = 68 * MiB;
constexpr size_t WS_F = 132 * MiB;
constexpr size_t WS_BIG = 196 * MiB;
constexpr size_t WS_PA = WS_BIG, WS_PG = WS_BIG + 96 * MiB, WS_PK = WS_BIG + 224 * MiB, WS_HB = WS_BIG + 240 * MiB  , WS_END = WS_BIG + 304 * MiB;
constexpr size_t WS_UA2 = WS_F + 32 * MiB;
constexpr int CW_BAR = 4096;

constexpr int LDS_BYTES = 155648;
constexpr int MISC_OFF = 154624;

#define GAS __attribute__((address_space(1)))
#define LAS __attribute__((address_space(3)))
typedef unsigned short bf16;
typedef unsigned v4u __attribute__((ext_vector_type(4)));
typedef unsigned v2u __attribute__((ext_vector_type(2)));
typedef float f32x4 __attribute__((ext_vector_type(4)));
typedef short bf16x8 __attribute__((ext_vector_type(8)));
#define LDS_WAIT() asm volatile("s_waitcnt lgkmcnt(0)" ::: "memory")
#define VM_WAIT() asm volatile("s_waitcnt vmcnt(0)" ::: "memory")
__device__ __forceinline__ unsigned f2bf(float f) { unsigned u = __builtin_bit_cast(unsigned, f); return (u + 0x7fffu + ((u >> 16) & 1u)) >> 16; }
__device__ __forceinline__ unsigned pk2(float lo, float hi) { return f2bf(lo) | (f2bf(hi) << 16); }
__device__ __forceinline__ float bflo(unsigned w) { return __uint_as_float(w << 16); }
__device__ __forceinline__ float bfhi(unsigned w) { return __uint_as_float(w & 0xffff0000u); }
__device__ __forceinline__ float bf2f(bf16 v) { return __uint_as_float(((unsigned)v) << 16); }
__device__ __forceinline__ float fsig(float x) { return __builtin_amdgcn_rcpf(1.0f + __expf(-x)); }

#define XB_TMO      128
#define XB_XCNT(j)  (256  + 64 * (j))
#define XB_XSUB(j)  (1280 + 64 * (j))
#define XB_XGEN(j)  (2304 + 64 * (j))
#define XB_TOP      3328
#define XB_TOPGEN   3392
#define XCD_BAR_WORDS 3456
#define XB_SPIN_CAP (1u << 18)
__device__ __forceinline__ unsigned xb_ld(unsigned* p)              { return __hip_atomic_load(p, __ATOMIC_RELAXED, __HIP_MEMORY_SCOPE_AGENT); }
__device__ __forceinline__ unsigned xb_add(unsigned* p, unsigned v) { return __hip_atomic_fetch_add(p, v, __ATOMIC_RELAXED, __HIP_MEMORY_SCOPE_AGENT); }
__device__ __forceinline__ unsigned xb_xcc_id() { return (unsigned)__builtin_amdgcn_s_getreg((3 << 11) | 20) & 0xFu; }
#define XB_SPIN(cond, bar) do { unsigned _sp = 0; while (cond) { __builtin_amdgcn_s_sleep(1); \
    if ((++_sp & 255u) == 0u) { if (xb_ld(&(bar)[XB_TMO])) break; if (_sp > XB_SPIN_CAP) { atomicAdd(&(bar)[XB_TMO], 1u); break; } } } } while (0)
struct XcdBarrier { unsigned* bar; unsigned x; volatile LAS unsigned* st; };
__device__ __forceinline__ XcdBarrier xcd_barrier_post(unsigned* bar, volatile LAS unsigned* st) {
    XcdBarrier b; b.bar = bar; b.x = xb_xcc_id(); b.st = st;
    if (threadIdx.x == 0) (void)xb_add(&bar[XB_XCNT(b.x)], 1u);
    return b;
}
__device__ __forceinline__ void xcd_barrier_complete(unsigned* bar, unsigned x, unsigned& nloc, unsigned& nx) {
    const unsigned G = gridDim.x * gridDim.y * gridDim.z;
    unsigned sum, cnt, mine, sp = 0u;
    for (;;) {
        sum = 0u; cnt = 0u; mine = 0u;
#pragma unroll
        for (unsigned j = 0; j < 16; ++j) { const unsigned c = xb_ld(&bar[XB_XCNT(j)]); sum += c; cnt += (c > 0u) ? 1u : 0u; mine = (j == x) ? c : mine; }
        if (sum == G) break;
        __builtin_amdgcn_s_sleep(1);
        if ((++sp & 255u) == 0u) { if (xb_ld(&bar[XB_TMO])) break; if (sp > XB_SPIN_CAP) { atomicAdd(&bar[XB_TMO], 1u); break; } }
    }
    nloc = mine > 0u ? mine : 1u; nx = cnt > 0u ? cnt : 1u;
}
__device__ __forceinline__ void xcd_barrier(const XcdBarrier& b) {
    asm volatile("s_waitcnt vmcnt(0)" ::: "memory");
    __syncthreads();
    if (threadIdx.x == 0) {
        unsigned* bar = b.bar;
        __builtin_amdgcn_s_waitcnt(0);
        unsigned nloc = b.st[0], nx = b.st[1];
        if (nloc == 0u) { xcd_barrier_complete(bar, b.x, nloc, nx); b.st[0] = nloc; b.st[1] = nx; }
        const unsigned old = xb_add(&bar[XB_XSUB(b.x)], 1u);
        const unsigned gen = old / nloc;
        if (old + 1u == (gen + 1u) * nloc) {
            __builtin_amdgcn_fence(__ATOMIC_RELEASE, "agent");
            asm volatile("s_waitcnt vmcnt(0)" ::: "memory");
            const unsigned og = xb_add(&bar[XB_TOP], 1u);
            const unsigned tg = og / nx;
            if (og + 1u == (tg + 1u) * nx) xb_add(&bar[XB_TOPGEN], 1u);
            else XB_SPIN(xb_ld(&bar[XB_TOPGEN]) == tg, bar);
            __builtin_amdgcn_fence(__ATOMIC_ACQUIRE, "agent");
            xb_add(&bar[XB_XGEN(b.x)], 1u);
            asm volatile("s_waitcnt vmcnt(0)" ::: "memory");
        } else {
            XB_SPIN(xb_ld(&bar[XB_XGEN(b.x)]) == gen, bar);
            __builtin_amdgcn_fence(__ATOMIC_ACQUIRE, "agent");
            asm volatile("s_waitcnt vmcnt(0)" ::: "memory");
        }
    }
    __syncthreads();
}

__device__ __forceinline__ float wave_sum(float v) {
#pragma unroll
    for (int o = 1; o < 64; o <<= 1) v += __shfl_xor(v, o);
    return v;
}
__device__ __forceinline__ f32x4 mfma16(bf16x8 a, bf16x8 b, f32x4 c) { return __builtin_amdgcn_mfma_f32_16x16x32_bf16(a, b, c, 0, 0, 0); }

__device__ __forceinline__ void transpose_item(const float* W, int Nsrc, int K, bf16* WT, int k0, int drow0, int srccol, LAS float* scr, int lane, const float* gk = nullptr) {
#pragma unroll 8
    for (int i = 0; i < 32; ++i) { const int kk = 2 * i + (lane >> 5); float wv_ = (srccol >= 0) ? W[(size_t)(k0 + kk) * Nsrc + srccol] : 0.f; if (gk) wv_ *= gk[k0 + kk]; scr[kk * 33 + (lane & 31)] = wv_; }
    LDS_WAIT(); asm volatile("" ::: "memory");
    const int c = lane & 7;
#pragma unroll
    for (int j = 0; j < 4; ++j) { const int n = (lane >> 3) + 8 * j; const LAS float* s = scr + (8 * c) * 33 + n;
        v4u o; o.x = pk2(s[0 * 33], s[1 * 33]); o.y = pk2(s[2 * 33], s[3 * 33]); o.z = pk2(s[4 * 33], s[5 * 33]); o.w = pk2(s[6 * 33], s[7 * 33]);
        *(v4u*)(WT + (size_t)(drow0 + n) * K + k0 + 8 * c) = o; }
    LDS_WAIT(); asm volatile("" ::: "memory");
}

__device__ __forceinline__ unsigned pk4q(float a, float b, float c, float d) { int w = 0; w = __builtin_amdgcn_cvt_pk_fp8_f32(fminf(fmaxf(a, -448.f), 448.f), fminf(fmaxf(b, -448.f), 448.f), w, false);
    w = __builtin_amdgcn_cvt_pk_fp8_f32(fminf(fmaxf(c, -448.f), 448.f), fminf(fmaxf(d, -448.f), 448.f), w, true); return (unsigned)w; }
__device__ __forceinline__ void transpose_item8(const float* W, int Nsrc, int K, unsigned char* WT8, int k0, int drow0, int srccol, LAS float* scr, int lane) {
#pragma unroll 8
    for (int i = 0; i < 32; ++i) { const int kk = 2 * i + (lane >> 5); scr[kk * 33 + (lane & 31)] = W[(size_t)(k0 + kk) * Nsrc + srccol] * 64.0f; }
    LDS_WAIT(); asm volatile("" ::: "memory");
    const int c = lane & 7;
#pragma unroll
    for (int j = 0; j < 4; ++j) { const int n = (lane >> 3) + 8 * j; const LAS float* sp = scr + (8 * c) * 33 + n;
        v2u o; o.x = pk4q(sp[0 * 33], sp[1 * 33], sp[2 * 33], sp[3 * 33]); o.y = pk4q(sp[4 * 33], sp[5 * 33], sp[6 * 33], sp[7 * 33]);
        *(v2u*)(WT8 + (size_t)(drow0 + n) * K + k0 + 8 * c) = o; }
    LDS_WAIT(); asm volatile("" ::: "memory");
}
__device__ __forceinline__ int win_srccol(int d) {
    if (d < 1024) return d;
    if (d < 1536) return 1096 + (d - 1024);
    if (d < 3584) return 1736 + (d - 1536);
    if (d < 3648) return 1024 + (d - 3584);
    if (d < 3712) return 1608 + (d - 3648);
    if (d < 3776) return 1672 + (d - 3712);
    if (d < 3784) return 1088 + (d - 3776);
    return -1;
}
__device__ __forceinline__ void norm_row_to_bf16(const float* xrow, const float* g, bf16* orow, int lane) {
    f32x4 v[4]; float ss = 0.f;
#pragma unroll
    for (int j = 0; j < 4; ++j) { v[j] = ((const f32x4*)xrow)[lane + 64 * j]; ss += (v[j].x * v[j].x + v[j].y * v[j].y) + (v[j].z * v[j].z + v[j].w * v[j].w); }
    const float rs = rsqrtf(wave_sum(ss) * (1.f / D) + RMS_EPS);
#pragma unroll
    for (int j = 0; j < 4; ++j) { const f32x4 gv = ((const f32x4*)g)[lane + 64 * j]; v2u o; o.x = pk2(v[j].x * rs * gv.x, v[j].y * rs * gv.y); o.y = pk2(v[j].z * rs * gv.z, v[j].w * rs * gv.w);
        ((v2u*)orow)[lane + 64 * j] = o; }
}
template <bool PRESCALE>
__device__ __forceinline__ void x_row_to_bf16(const float* xrow, bf16* orow, float* rs_out, int lane) {
    f32x4 v[4]; float ss = 0.f;
#pragma unroll
    for (int j = 0; j < 4; ++j) { v[j] = ((const f32x4*)xrow)[lane + 64 * j]; ss += (v[j].x * v[j].x + v[j].y * v[j].y) + (v[j].z * v[j].z + v[j].w * v[j].w); }
    const float rs = rsqrtf(wave_sum(ss) * (1.f / D) + RMS_EPS), pre = PRESCALE ? rs : 1.0f;
#pragma unroll
    for (int j = 0; j < 4; ++j) { v2u o; o.x = pk2(v[j].x * pre, v[j].y * pre); o.y = pk2(v[j].z * pre, v[j].w * pre); ((v2u*)orow)[lane + 64 * j] = o; }
    if (rs_out && lane == 0) *rs_out = rs;
}
template <bool BASE_BF16, bool OUT_BF16, bool HN_F8 = false>
__device__ __forceinline__ void row_update(const bf16* frow, const void* base, void* outrow, bf16* hnrow, const float* gpost, const float* gnext, float scale, int lane, float* rs_out = nullptr) {
    f32x4 f[4], h[4]; float ss = 0.f;
#pragma unroll
    for (int j = 0; j < 4; ++j) { const v2u w = ((const v2u*)frow)[lane + 64 * j]; f[j] = (f32x4){bflo(w.x), bfhi(w.x), bflo(w.y), bfhi(w.y)};
        ss += (f[j].x * f[j].x + f[j].y * f[j].y) + (f[j].z * f[j].z + f[j].w * f[j].w); }
    const float rs = rsqrtf(wave_sum(ss) * (1.f / D) + RMS_EPS) * scale; float s2 = 0.f;
#pragma unroll
    for (int j = 0; j < 4; ++j) { const f32x4 gv = ((const f32x4*)gpost)[lane + 64 * j]; f32x4 bv;
        if (BASE_BF16) { const v2u w = ((const v2u*)base)[lane + 64 * j]; bv = (f32x4){bflo(w.x), bfhi(w.x), bflo(w.y), bfhi(w.y)}; } else bv = ((const f32x4*)base)[lane + 64 * j];
        h[j] = bv + f[j] * rs * gv; s2 += (h[j].x * h[j].x + h[j].y * h[j].y) + (h[j].z * h[j].z + h[j].w * h[j].w); }
    if (outrow) {
#pragma unroll
        for (int j = 0; j < 4; ++j) { if (OUT_BF16) { v2u o; o.x = pk2(h[j].x, h[j].y); o.y = pk2(h[j].z, h[j].w); ((v2u*)outrow)[lane + 64 * j] = o; } else ((f32x4*)outrow)[lane + 64 * j] = h[j]; } }
    if (hnrow || rs_out) { const float r2 = rsqrtf(wave_sum(s2) * (1.f / D) + RMS_EPS); if (rs_out && lane == 0) *rs_out = r2;
        if (hnrow)
#pragma unroll
        for (int j = 0; j < 4; ++j) { const f32x4 gv = gnext ? ((const f32x4*)gnext)[lane + 64 * j] : (f32x4){1.f, 1.f, 1.f, 1.f};
            if (HN_F8) { const float q = 4.0f * r2; ((unsigned*)hnrow)[lane + 64 * j] = pk4q(h[j].x * q * gv.x, h[j].y * q * gv.y, h[j].z * q * gv.z, h[j].w * q * gv.w); }
            else { v2u o; o.x = pk2(h[j].x * r2 * gv.x, h[j].y * r2 * gv.y); o.y = pk2(h[j].z * r2 * gv.z, h[j].w * r2 * gv.w); ((v2u*)hnrow)[lane + 64 * j] = o; } } }
}
__device__ __forceinline__ f32x4 meta_tile(const bf16* A, const bf16* B, int K, int lane) {
    const int fr = lane & 15, kq = lane >> 4; const bf16* ap = A + (size_t)fr * K + 8 * kq; const bf16* bp = B + (size_t)fr * K + 8 * kq;
    f32x4 acc = (f32x4){0.f, 0.f, 0.f, 0.f};
#pragma unroll 4
    for (int k = 0; k < K; k += 32) { const bf16x8 a = *(const bf16x8*)(ap + k); const bf16x8 b = *(const bf16x8*)(bp + k); acc = mfma16(a, b, acc); }
    return acc;
}


template <int STEPS>
__device__ __forceinline__ void meta_tile_blk(const bf16* A, const bf16* B0, const bf16* B1, int K, LAS float* red, int wave, int lane, f32x4& c0, f32x4& c1) {
    const int fr = lane & 15, kq = lane >> 4, k0 = wave * (32 * STEPS);
    const bf16* ap = A + (size_t)fr * K + k0 + 8 * kq; const bf16* bp0 = B0 + (size_t)fr * K + k0 + 8 * kq; const bf16* bp1 = (B1 ? B1 : B0) + (size_t)fr * K + k0 + 8 * kq;
    bf16x8 av[STEPS], bv0[STEPS], bv1[STEPS];
#pragma unroll
    for (int i = 0; i < STEPS; ++i) { av[i] = *(const bf16x8*)(ap + 32 * i); bv0[i] = *(const bf16x8*)(bp0 + 32 * i); bv1[i] = *(const bf16x8*)(bp1 + 32 * i); }
    f32x4 a0 = (f32x4){0.f, 0.f, 0.f, 0.f}, a1 = a0;
#pragma unroll
    for (int i = 0; i < STEPS; ++i) { a0 = mfma16(av[i], bv0[i], a0); a1 = mfma16(av[i], bv1[i], a1); }
    *(LAS f32x4*)(red + (wave * 64 + lane) * 8) = a0; *(LAS f32x4*)(red + (wave * 64 + lane) * 8 + 4) = a1;
    __syncthreads();
    c0 = (f32x4){0.f, 0.f, 0.f, 0.f}; c1 = c0;
#pragma unroll
    for (int w2 = 0; w2 < 8; ++w2) { c0 += *(const LAS f32x4*)(red + (w2 * 64 + lane) * 8); c1 += *(const LAS f32x4*)(red + (w2 * 64 + lane) * 8 + 4); }
    __syncthreads();
}

struct Args { const float* in[28]; float* out; unsigned char* ws; int ph_lo, ph_hi; };

__device__ __forceinline__ void s5_tables_block(const Args& a, int g, int oct, LAS float* sc, int tid) {
    const float* lam_re = a.in[15]; const float* lam_im = a.in[16]; const float* log_dt = a.in[17];
    const float* b_re = a.in[18]; const float* b_im = a.in[19]; const float* c_re = a.in[20]; const float* c_im = a.in[21]; const float* dsk = a.in[22];
    LAS float* CR = sc; LAS float* CI = sc + 1024; LAS float* BR = sc + 2048; LAS float* BI = sc + 3072;
    LAS float* ANG = sc + 4096; LAS float* LRDT = sc + 4160; LAS float* CFR = sc + 4224; LAS float* CFI = sc + 4288;
    LAS float* WR = sc + 4352; LAS float* WI = sc + 4864;
    __syncthreads();
#pragma unroll
    for (int k = 0; k < 2; ++k) { const int e = tid + 512 * k; CR[e] = c_re[g * 1024 + e]; CI[e] = c_im[g * 1024 + e]; BR[e] = b_re[g * 1024 + e]; BI[e] = b_im[g * 1024 + e]; }
    if (tid < 64) { const int p = tid; const float lr = lam_re[g * 64 + p], li = lam_im[g * 64 + p], dt = expf(log_dt[g]);
        const float ang = li * dt, mag = expf(lr * dt); float s1, c1; sincosf(ang, &s1, &c1);
        const float a_re = mag * c1, a_im = mag * s1, den = lr * lr + li * li, nr = a_re - 1.0f, ni = a_im;
        ANG[p] = ang; LRDT[p] = lr * dt; CFR[p] = (nr * lr + ni * li) / den; CFI[p] = (ni * lr - nr * li) / den; }
    __syncthreads();
    const int ti = tid >> 6, p64 = tid & 63, idx0 = 8 * oct;
    { const float n = (float)(idx0 + ti); float sn, cn; sincosf(n * ANG[p64], &sn, &cn); const float mn = expf(n * LRDT[p64]); const float pr = mn * cn, pi = mn * sn;
      WR[tid] = pr * CFR[p64] - pi * CFI[p64]; WI[tid] = pr * CFI[p64] + pi * CFR[p64]; }
    __syncthreads();
#pragma unroll
    for (int k = 0; k < 4; ++k) { const int e = tid + 512 * k, t8 = e >> 8, m = (e >> 4) & 15, mp = e & 15; float s = 0.f;
        for (int p = 0; p < 64; ++p) { const float wr_ = WR[t8 * 64 + p], wi_ = WI[t8 * 64 + p], br = BR[p * 16 + mp], bi = BI[p * 16 + mp];
            const float zr = wr_ * br - wi_ * bi, zi = wr_ * bi + wi_ * br; s += CR[m * 64 + p] * zr - CI[m * 64 + p] * zi; }
        if (idx0 + t8 == 0 && m == mp) s += dsk[g * 16 + m];
        ((bf16*)(a.ws + WS_KI))[((g * 64 + idx0 + t8) * 16 + m) * 16 + mp] = (bf16)f2bf(s); }
    __syncthreads();
    { const float n = (float)(63 - (idx0 + ti)); float sn, cn; sincosf(n * ANG[p64], &sn, &cn); const float mn = expf(n * LRDT[p64]); const float pr = mn * cn, pi = mn * sn;
      WR[tid] = pr * CFR[p64] - pi * CFI[p64]; WI[tid] = pr * CFI[p64] + pi * CFR[p64]; }
    __syncthreads();
    for (int k = 0; k < 32; ++k) { const int e = tid + 512 * k, t8 = e >> 11, n_ = (e >> 4) & 127, mp = e & 15, p = n_ & 63;
        const float wr_ = WR[t8 * 64 + p], wi_ = WI[t8 * 64 + p], br = BR[p * 16 + mp], bi = BI[p * 16 + mp];
        const float zr = wr_ * br - wi_ * bi, zi = wr_ * bi + wi_ * br;
        ((bf16*)(a.ws + WS_KS))[((size_t)(g * 64 + idx0 + t8) * 128 + n_) * 16 + mp] = (bf16)f2bf(n_ < 64 ? zr : zi); }
    __syncthreads();
    { const float n = (float)(idx0 + ti + 1); float sn, cn; sincosf(n * ANG[p64], &sn, &cn); const float mn = expf(n * LRDT[p64]); WR[tid] = mn * cn; WI[tid] = mn * sn; }
    __syncthreads();
    for (int k = 0; k < 32; ++k) { const int e = tid + 512 * k, t8 = e >> 11, m = (e >> 7) & 15, kk = e & 127, p = kk & 63;
        const float cr = CR[m * 64 + p], ci = CI[m * 64 + p], ar_ = WR[t8 * 64 + p], ai_ = WI[t8 * 64 + p];
        const float wr_ = cr * ar_ - ci * ai_, wi_ = cr * ai_ + ci * ar_;
        ((bf16*)(a.ws + WS_KO))[((size_t)(g * 64 + idx0 + t8) * 16 + m) * 128 + kk] = (bf16)f2bf(kk < 64 ? wr_ : -wi_); }
}

constexpr int S5_U = 0, S5_USTR = 2064, S5_KI = 66048, S5_SLOC = 98816, S5_XINB = 115200, S5_XSTR = 272, S5_MISC = 123904;
__device__ __forceinline__ float gelu_tanh(float x) { const float z = 0.7978845608028654f * (x + 0.044715f * x * x * x); return x * fsig(2.0f * z); }
__device__ __forceinline__ void s5_meta(const Args& a, LAS unsigned char* L, int g, int tid) {
    const int lane = tid & 63; const bf16* PMU = (const bf16*)(a.ws + WS_META + MO_PMU); LAS float* MS = (LAS float*)(L + S5_MISC);
    if (tid < 64) { const int p = lane; const float lr = a.in[15][g * 64 + p], li = a.in[16][g * 64 + p], dt = expf(a.in[17][g]);
        const float ang = li * dt, mag = expf(lr * dt); float s1, c1; sincosf(ang, &s1, &c1);
        const float a_re = mag * c1, a_im = mag * s1, den = lr * lr + li * li, nr = a_re - 1.0f, ni = a_im;
        const float cf_re = (nr * lr + ni * li) / den, cf_im = (ni * lr - nr * li) / den;
        float bb_re[16], bb_im[16];
#pragma unroll
        for (int m = 0; m < 16; ++m) { const float br = a.in[18][(g * 64 + p) * 16 + m], bi = a.in[19][(g * 64 + p) * 16 + m]; bb_re[m] = cf_re * br - cf_im * bi; bb_im[m] = cf_re * bi + cf_im * br; }
        LAS bf16* UM = (LAS bf16*)(L + S5_MISC + 1024);
        if (lane < 32) *(LAS v4u*)(UM + lane * 8) = *(const v4u*)(PMU + (lane >> 1) * 512 + 16 * g + 8 * (lane & 1));
        LDS_WAIT();
        float xr = 0.f, xi = 0.f;
#pragma unroll
        for (int i = 0; i < 16; ++i) { float ur = 0.f, ui = 0.f; const v4u w0 = *(const LAS v4u*)(UM + i * 16), w1 = *(const LAS v4u*)(UM + i * 16 + 8);
            const float uu[16] = {bflo(w0.x), bfhi(w0.x), bflo(w0.y), bfhi(w0.y), bflo(w0.z), bfhi(w0.z), bflo(w0.w), bfhi(w0.w), bflo(w1.x), bfhi(w1.x), bflo(w1.y), bfhi(w1.y), bflo(w1.z), bfhi(w1.z), bflo(w1.w), bfhi(w1.w)};
#pragma unroll
            for (int m = 0; m < 16; ++m) { ur += bb_re[m] * uu[m]; ui += bb_im[m] * uu[m]; }
            const float nr2 = a_re * xr - a_im * xi + ur, ni2 = a_re * xi + a_im * xr + ui; xr = nr2; xi = ni2; }
        float s64, c64; sincosf(64.0f * ang, &s64, &c64); const float m64 = expf(64.0f * lr * dt);
        MS[p] = xr; MS[64 + p] = xi; MS[128 + p] = m64 * c64; MS[192 + p] = m64 * s64; }
}
__device__ __forceinline__ void s5_unit(const Args& a, LAS unsigned char* L, int b, int g, int tid) {
    const int lane = tid & 63, w = __builtin_amdgcn_readfirstlane(tid >> 6), fr = lane & 15, kq = lane >> 4;
    const bf16* UA2 = (const bf16*)(a.ws + WS_UA2) + (size_t)(b * 32 + g) * 2048 * 16;
    const bf16* KS = (const bf16*)(a.ws + WS_KS); const bf16* KO = (const bf16*)(a.ws + WS_KO); const bf16* KI = (const bf16*)(a.ws + WS_KI);
    bf16* YA = (bf16*)(a.ws + WS_F);
    LAS float* SLOC = (LAS float*)(L + S5_SLOC); LAS float* MS = (LAS float*)(L + S5_MISC);
    __syncthreads();
#pragma unroll
    for (int k = 0; k < 8; ++k) { const int idx = tid + 512 * k, t = idx >> 1, hf = idx & 1;
        const v4u v = *(const v4u*)(UA2 + (size_t)idx * 8);
        *(LAS v4u*)(L + S5_U + (t >> 6) * S5_USTR + (t & 63) * 32 + 16 * hf) = v; }
#pragma unroll
    for (int k = 0; k < 4; ++k) { const int idx = tid + 512 * k; *(LAS v4u*)(L + S5_KI + idx * 16) = *(const v4u*)(KI + (size_t)g * 16384 + idx * 8); }
    bf16x8 bfr[16];
#pragma unroll
    for (int k = 0; k < 16; ++k) { const int i = 2 * k + (kq >> 1); bfr[k] = *(const bf16x8*)(KS + ((size_t)(g * 64 + i) * 128 + 16 * w + fr) * 16 + 8 * (kq & 1)); }
    __syncthreads();
    { f32x4 acc0 = (f32x4){0.f, 0.f, 0.f, 0.f}, acc1 = acc0;
#pragma unroll
      for (int hb = 0; hb < 2; ++hb) {
          if (hb == 1) {
#pragma unroll
              for (int k = 0; k < 16; ++k) { const int i = 2 * (16 + k) + (kq >> 1); bfr[k] = *(const bf16x8*)(KS + ((size_t)(g * 64 + i) * 128 + 16 * w + fr) * 16 + 8 * (kq & 1)); } }
#pragma unroll
          for (int k = 0; k < 16; ++k) { const int ks = 16 * hb + k;
              const bf16x8 a0 = *(const LAS bf16x8*)(L + S5_U + fr * S5_USTR + (32 * ks + 8 * kq) * 2);
              const bf16x8 a1 = *(const LAS bf16x8*)(L + S5_U + (16 + fr) * S5_USTR + (32 * ks + 8 * kq) * 2);
              acc0 = mfma16(a0, bfr[k], acc0); acc1 = mfma16(a1, bfr[k], acc1); } }
#pragma unroll
      for (int r = 0; r < 4; ++r) { SLOC[(4 * kq + r) * 128 + 16 * w + fr] = acc0[r]; SLOC[(16 + 4 * kq + r) * 128 + 16 * w + fr] = acc1[r]; } }
    bf16x8 ko[4];
#pragma unroll
    for (int ks = 0; ks < 4; ++ks) ko[ks] = *(const bf16x8*)(KO + ((size_t)(g * 64 + w) * 16 + fr) * 128 + 32 * ks + 8 * kq);
    __syncthreads();
    if (w == 0) { const int p = lane; float sr[32], si[32];
#pragma unroll
        for (int c = 0; c < 32; ++c) { sr[c] = SLOC[c * 128 + p]; si[c] = SLOC[c * 128 + 64 + p]; }
        float xr = MS[p], xi = MS[64 + p]; const float ar = MS[128 + p], ai = MS[192 + p];
#pragma unroll
        for (int c = 0; c < 32; ++c) { *(LAS bf16*)(L + S5_XINB + c * S5_XSTR + p * 2) = (bf16)f2bf(xr); *(LAS bf16*)(L + S5_XINB + c * S5_XSTR + (64 + p) * 2) = (bf16)f2bf(xi);
            const float nr2 = ar * xr - ai * xi + sr[c], ni2 = ar * xi + ai * xr + si[c]; xr = nr2; xi = ni2; } }
    __syncthreads();
    for (int jj = 0; jj < 8; ++jj) { const int j = w + 8 * jj;
        bf16x8 kon[4];
#pragma unroll
        for (int ks = 0; ks < 4; ++ks) kon[ks] = ko[ks];
        if (jj < 7) {
#pragma unroll
            for (int ks = 0; ks < 4; ++ks) kon[ks] = *(const bf16x8*)(KO + ((size_t)(g * 64 + j + 8) * 16 + fr) * 128 + 32 * ks + 8 * kq); }
        f32x4 acc0 = (f32x4){0.f, 0.f, 0.f, 0.f}, acc1 = acc0;
#pragma unroll
        for (int ks = 0; ks < 4; ++ks) {
            const bf16x8 a0 = *(const LAS bf16x8*)(L + S5_XINB + fr * S5_XSTR + (32 * ks + 8 * kq) * 2);
            const bf16x8 a1 = *(const LAS bf16x8*)(L + S5_XINB + (16 + fr) * S5_XSTR + (32 * ks + 8 * kq) * 2);
            acc0 = mfma16(a0, ko[ks], acc0); acc1 = mfma16(a1, ko[ks], acc1); }
        const int nks = (j >> 1) + 1;
#pragma unroll 2
        for (int ks = 0; ks < nks; ++ks) { const int i = 2 * ks + (kq >> 1), tau = j - i;
            bf16x8 bq = *(const LAS bf16x8*)(L + S5_KI + (((tau < 0 ? 0 : tau) * 16 + fr) * 16 + 8 * (kq & 1)) * 2);
            if (tau < 0) bq = (bf16x8){0, 0, 0, 0, 0, 0, 0, 0};
            const bf16x8 a0 = *(const LAS bf16x8*)(L + S5_U + fr * S5_USTR + (32 * ks + 8 * kq) * 2);
            const bf16x8 a1 = *(const LAS bf16x8*)(L + S5_U + (16 + fr) * S5_USTR + (32 * ks + 8 * kq) * 2);
            acc0 = mfma16(a0, bq, acc0); acc1 = mfma16(a1, bq, acc1); }
#pragma unroll
        for (int r = 0; r < 4; ++r) { const int c0 = 4 * kq + r, c1 = 16 + 4 * kq + r;
            YA[(size_t)(b * 2048 + 64 * c0 + j) * 512 + 16 * g + fr] = (bf16)f2bf(gelu_tanh(acc0[r]));
            YA[(size_t)(b * 2048 + 64 * c1 + j) * 512 + 16 * g + fr] = (bf16)f2bf(gelu_tanh(acc1[r])); }
#pragma unroll
        for (int ks = 0; ks < 4; ++ks) ko[ks] = kon[ks]; }
}

constexpr int DS_SSTR = 2120, DS_TSTR = 144, DS_BUF = 18432  , DS_BT = 36864  , DS_HIST = 135680, DS_MASK = 143872, DS_RB = 152576, DS_TB = 153600;
typedef short s16x4 __attribute__((ext_vector_type(4)));
__device__ __forceinline__ s16x4 tr_read(unsigned addr) { s16x4 r; asm volatile("ds_read_b64_tr_b16 %0, %1" : "=&v"(r) : "v"(addr) : "memory"); return r; }
__device__ __forceinline__ float relu_i(float x) { const int i = __builtin_bit_cast(int, x); return __builtin_bit_cast(float, i > 0 ? i : 0); }
__device__ __forceinline__ unsigned f16key(float f) { const _Float16 hf = (_Float16)f; const unsigned h = (unsigned)__builtin_bit_cast(unsigned short, hf); return (h & 0x8000u) ? (~h & 0xffffu) : (h | 0x8000u); }
__device__ __forceinline__ unsigned cvtpk(float lo, float hi) { unsigned r; asm volatile("v_cvt_pk_bf16_f32 %0, %1, %2" : "=v"(r) : "v"(lo), "v"(hi)); return r; }
__device__ __forceinline__ void dsa_tables(const Args& a, LAS unsigned char* L, int tid) {
    if (tid < 256) { ((LAS float*)(L + DS_RB))[tid] = a.in[25][tid] * 1.44269504f;
        const int n = tid; const int lo = n < 8 ? n : (n < 12 ? 8 : n < 16 ? 9 : n < 23 ? 10 : n < 32 ? 11 : n < 46 ? 12 : n < 64 ? 13 : n < 91 ? 14 : 15);
        ((LAS int*)(L + DS_TB))[tid] = lo; }
}

__device__ __forceinline__ int wave_incl_scan(int x) {
    int v = x;
    v += __builtin_amdgcn_update_dpp(0, v, 0x111, 0xf, 0xf, false);
    v += __builtin_amdgcn_update_dpp(0, v, 0x112, 0xf, 0xf, false);
    v += __builtin_amdgcn_update_dpp(0, v, 0x114, 0xf, 0xf, false);
    v += __builtin_amdgcn_update_dpp(0, v, 0x118, 0xf, 0xf, false);
    v += __builtin_amdgcn_update_dpp(0, v, 0x142, 0xa, 0xf, false);
    v += __builtin_amdgcn_update_dpp(0, v, 0x143, 0xc, 0xf, false);
    return v;
}
template <int NE>
__device__ __forceinline__ void dsa_select(LAS unsigned char* L, int c, int nt64, int w, int lane) {
    LAS unsigned short* S16 = (LAS unsigned short*)L; LAS unsigned long long* MASK = (LAS unsigned long long*)(L + DS_MASK);
    LAS unsigned* H = (LAS unsigned*)(L + DS_HIST) + w * 256;
    const int rl = 63 - lane;
    for (int qq = 0; qq < 4; ++qq) { const int q = 4 * w + qq; const LAS unsigned short* Sq = S16 + q * DS_SSTR; unsigned tkey = 0u;
        unsigned kr[NE];
#pragma unroll
        for (int e = 0; e < NE; ++e) kr[e] = (unsigned)Sq[64 * e + lane];
        if (c >= 4) { unsigned prefix = 0u; int kth = 256;
#pragma unroll
            for (int pass = 0; pass < 2; ++pass) {
                H[lane] = 0u; H[lane + 64] = 0u; H[lane + 128] = 0u; H[lane + 192] = 0u; LDS_WAIT();
#pragma unroll
                for (int e = 0; e < NE; ++e) { const unsigned key = kr[e]; const bool in = (pass == 0) ? (key != 0u) : ((key >> 8) == prefix);
                    if (in) (void)__hip_atomic_fetch_add(&H[pass == 0 ? (key >> 8) : (key & 255u)], 1u, __ATOMIC_RELAXED, __HIP_MEMORY_SCOPE_WORKGROUP); }
                LDS_WAIT();
                const unsigned h0 = H[4 * rl], h1 = H[4 * rl + 1], h2 = H[4 * rl + 2], h3 = H[4 * rl + 3]; const int t = (int)(h0 + h1 + h2 + h3);
                const int sfx = wave_incl_scan(t), above = sfx - t; const bool has = (above < kth) && (above + t >= kth);
                const unsigned long long bm = __ballot(has); const int src = bm ? (__ffsll((long long)bm) - 1) : 0;
                int cum = above, B; if (cum + (int)h3 >= kth) B = 3; else { cum += (int)h3; if (cum + (int)h2 >= kth) B = 2; else { cum += (int)h2; if (cum + (int)h1 >= kth) B = 1; else { cum += (int)h1; B = 0; } } }
                const int bin = __builtin_amdgcn_readlane(4 * rl + B, src); kth = __builtin_amdgcn_readlane(kth - cum, src);
                prefix = (prefix << 8) | (unsigned)bin; LDS_WAIT(); }
            tkey = prefix; }
        unsigned mlo = 0u, mhi = 0u;
#pragma unroll
        for (int e = 0; e < NE; ++e) { const int s = 64 * e + lane; const bool sel = ((s < 16) || (s >= 64)) && (kr[e] >= tkey);
            const unsigned long long m = __ballot(sel); mlo = (lane == e) ? (unsigned)m : mlo; mhi = (lane == e) ? (unsigned)(m >> 32) : mhi; }
        if (lane < nt64) MASK[q * 34 + lane] = ((unsigned long long)mhi << 32) | mlo; }
}
__device__ __forceinline__ void dsa_unit(const Args& a, LAS unsigned char* L, int b, int uq, int tid) {
    const int lane = tid & 63, w = __builtin_amdgcn_readfirstlane(tid >> 6), fr = lane & 15, kq = lane >> 4;
    const bf16* PA = (const bf16*)(a.ws + WS_PA); const bf16* PK = (const bf16*)(a.ws + WS_PK); const bf16* PMK = (const bf16*)(a.ws + WS_META + MO_PMK);
    bf16* YB = (bf16*)(a.ws + WS_HN) + (size_t)R * 512;
    const int c = 1 + (uq >> 1), nt64 = c + 1, qrow0 = b * 2048 + 32 * uq;
    LAS unsigned short* S16 = (LAS unsigned short*)L; LAS unsigned long long* MASK = (LAS unsigned long long*)(L + DS_MASK);
    const LAS float* RB = (const LAS float*)(L + DS_RB); const LAS int* TB = (const LAS int*)(L + DS_TB);
    __syncthreads();
    { const int qh = w >> 2; bf16x8 qa[4][2][2]; float wv[4][2][4];
#pragma unroll
      for (int p = 0; p < 4; ++p) {
#pragma unroll
          for (int hf = 0; hf < 2; ++hf)
#pragma unroll
              for (int ks = 0; ks < 2; ++ks) qa[p][hf][ks] = *(const bf16x8*)(PA + (size_t)(qrow0 + 16 * qh + 4 * p + (fr >> 2)) * 1536 + 512 + (4 * hf + (fr & 3)) * 64 + 32 * ks + 8 * kq);
          const v4u wraw = *(const v4u*)(PK + (size_t)(qrow0 + 16 * qh + 4 * p + kq) * 256 + 192);
          wv[p][0][0] = bflo(wraw.x) * 0.04419417382f; wv[p][0][1] = bfhi(wraw.x) * 0.04419417382f; wv[p][0][2] = bflo(wraw.y) * 0.04419417382f; wv[p][0][3] = bfhi(wraw.y) * 0.04419417382f;
          wv[p][1][0] = bflo(wraw.z) * 0.04419417382f; wv[p][1][1] = bfhi(wraw.z) * 0.04419417382f; wv[p][1][2] = bflo(wraw.w) * 0.04419417382f; wv[p][1][3] = bfhi(wraw.w) * 0.04419417382f; }
      const int nkt = 4 * nt64;
      { const int ner = nt64 <= 9 ? 9 : nt64 <= 17 ? 17 : nt64 <= 25 ? 25 : 33;
        for (int kz = 4 * nt64 + (w & 3); kz < 4 * ner; kz += 4) {
#pragma unroll
            for (int p = 0; p < 4; ++p) S16[(16 * qh + 4 * p + kq) * DS_SSTR + 16 * kz + fr] = (unsigned short)0; } }
      if ((w & 3) != 0) {
#pragma unroll
          for (int p = 0; p < 4; ++p) S16[(16 * qh + 4 * p + kq) * DS_SSTR + 16 * (w & 3) + fr] = (unsigned short)0; }
      int kt = (w & 3) == 0 ? 0 : (w & 3) + 4;
      bf16x8 kb0, kb1, kc0, kc1;
      { const bf16* krow = (kt == 0) ? PMK + fr * 256 : PK + (size_t)(b * 2048 + 16 * kt - 64 + fr) * 256; kb0 = *(const bf16x8*)(krow + 8 * kq); kb1 = *(const bf16x8*)(krow + 32 + 8 * kq); }
      { const int k1 = (kt == 0) ? 4 : kt + 4; kc0 = kb0; kc1 = kb1;
        if (k1 < nkt) { const bf16* krow = PK + (size_t)(b * 2048 + 16 * k1 - 64 + fr) * 256; kc0 = *(const bf16x8*)(krow + 8 * kq); kc1 = *(const bf16x8*)(krow + 32 + 8 * kq); } }
      while (kt < nkt) {
          const int ktn = (kt == 0) ? 4 : kt + 4, ktnn = ktn + 4; bf16x8 nb0 = kc0, nb1 = kc1;
          if (ktnn < nkt) { const bf16* krow = PK + (size_t)(b * 2048 + 16 * ktnn - 64 + fr) * 256; nb0 = *(const bf16x8*)(krow + 8 * kq); nb1 = *(const bf16x8*)(krow + 32 + 8 * kq); }
#pragma unroll
          for (int p = 0; p < 4; ++p) { f32x4 aA = (f32x4){0.f, 0.f, 0.f, 0.f}, aB = aA;
              aA = mfma16(qa[p][0][0], kb0, aA); aB = mfma16(qa[p][1][0], kb0, aB); aA = mfma16(qa[p][0][1], kb1, aA); aB = mfma16(qa[p][1][1], kb1, aB);
              const float v = (relu_i(aA[0]) * wv[p][0][0] + relu_i(aA[1]) * wv[p][0][1]) + (relu_i(aA[2]) * wv[p][0][2] + relu_i(aA[3]) * wv[p][0][3])
                            + (relu_i(aB[0]) * wv[p][1][0] + relu_i(aB[1]) * wv[p][1][1]) + (relu_i(aB[2]) * wv[p][1][2] + relu_i(aB[3]) * wv[p][1][3]);
              S16[(16 * qh + 4 * p + kq) * DS_SSTR + 16 * kt + fr] = (unsigned short)f16key(v); }
          kb0 = kc0; kb1 = kc1; kc0 = nb0; kc1 = nb1; kt = ktn; } }
    __syncthreads();
    bf16x8 qb[2][2]; unsigned mkoff[2];
#pragma unroll
    for (int cg = 0; cg < 2; ++cg) { const int q = 4 * w + 2 * cg + (fr >> 3), h = fr & 7; mkoff[cg] = q * 34;
#pragma unroll
        for (int ks = 0; ks < 2; ++ks) qb[cg][ks] = *(const bf16x8*)(PA + (size_t)(qrow0 + q) * 1536 + 1024 + h * 64 + 32 * ks + 8 * kq); }
    const int skey = tid >> 3, spiece = tid & 7;
    v4u kv0 = (v4u){0u, 0u, 0u, 0u}, vv0 = kv0, kv, vv;
    if (skey < 16) { const bf16* krow = PMK + skey * 256; kv0 = *(const v4u*)(krow + 64 + 8 * spiece); vv0 = *(const v4u*)(krow + 128 + 8 * spiece); }
    { const bf16* krow = PK + (size_t)(b * 2048 + skey) * 256; kv = *(const v4u*)(krow + 64 + 8 * spiece); vv = *(const v4u*)(krow + 128 + 8 * spiece); }
    if (nt64 <= 9) dsa_select<9>(L, c, nt64, w, lane);
    else if (nt64 <= 17) dsa_select<17>(L, c, nt64, w, lane);
    else if (nt64 <= 25) dsa_select<25>(L, c, nt64, w, lane);
    else dsa_select<33>(L, c, nt64, w, lane);
    __syncthreads();
    {
      const int hh = fr & 7; const float bfar = RB[15 * 8 + hh];
      float mrun[2] = {-1.0e30f, -1.0e30f}, lrun[2] = {0.f, 0.f}; f32x4 O[2][4];
#pragma unroll
      for (int cg = 0; cg < 2; ++cg)
#pragma unroll
          for (int dt = 0; dt < 4; ++dt) O[cg][dt] = (f32x4){0.f, 0.f, 0.f, 0.f};
      const LAS float* BT = (const LAS float*)(L + DS_BT);
#pragma unroll
      for (int k = 0; k < 4; ++k) { const int e = tid + 512 * k, relc = (e >> 3) - 128, n = relc < 0 ? -relc : relc; ((LAS float*)(L + DS_BT))[e] = RB[(TB[n] + (relc > 0 ? 16 : 0)) * 8 + (e & 7)]; }
      const unsigned ldsV = (unsigned)(size_t)(L) + 9216u + (unsigned)((4 * kq + ((lane & 15) >> 2)) * DS_TSTR + 8 * (lane & 3));
      *(LAS v4u*)(L + skey * DS_TSTR + 16 * spiece) = kv0; *(LAS v4u*)(L + 9216 + skey * DS_TSTR + 16 * spiece) = vv0;
      __syncthreads();
      for (int T = 0; T < nt64; ++T) { const int buf = T & 1;
          v4u kn = kv, vn = vv;
          if (T + 2 < nt64) { const bf16* krow = PK + (size_t)(b * 2048 + 64 * (T + 1) + skey) * 256; kn = *(const v4u*)(krow + 64 + 8 * spiece); vn = *(const v4u*)(krow + 128 + 8 * spiece); }
          const bool nearT = (64 * T > 32 * uq - 90);
          f32x4 lg[2][4];
          { bf16x8 ka[4][2];
#pragma unroll
            for (int sub = 0; sub < 4; ++sub)
#pragma unroll
                for (int ks = 0; ks < 2; ++ks) ka[sub][ks] = *(const LAS bf16x8*)(L + buf * DS_BUF + fr * DS_TSTR + 16 * kq + sub * 16 * DS_TSTR + ks * 64);
#pragma unroll
            for (int cg = 0; cg < 2; ++cg)
#pragma unroll
                for (int sub = 0; sub < 4; ++sub) { f32x4 acc = (f32x4){0.f, 0.f, 0.f, 0.f}; acc = mfma16(ka[sub][0], qb[cg][0], acc); acc = mfma16(ka[sub][1], qb[cg][1], acc); lg[cg][sub] = acc; } }
          s16x4 vt[2][4][2];
#pragma unroll
          for (int cg = 0; cg < 2; ++cg) {
              float mxl = -1.0e30f;
              if (nearT) { const int relb = ((T == 0) ? 0 : 64 * T - 48) + 4 * kq - (16 + 32 * uq + 4 * w + 2 * cg + (fr >> 3));
#pragma unroll
                  for (int sub = 0; sub < 4; ++sub)
#pragma unroll
                      for (int r = 0; r < 4; ++r) { int idx = relb + 16 * sub + r; idx = idx < -128 ? -128 : idx; idx = idx > 127 ? 127 : idx;
                          const float v = lg[cg][sub][r] * 0.18033688f + BT[(idx + 128) * 8 + hh]; lg[cg][sub][r] = v; mxl = fmaxf(mxl, v); }
              } else {
#pragma unroll
                  for (int sub = 0; sub < 4; ++sub)
#pragma unroll
                      for (int r = 0; r < 4; ++r) { const float v = lg[cg][sub][r] * 0.18033688f + bfar; lg[cg][sub][r] = v; mxl = fmaxf(mxl, v); } }
              if (__ballot(mxl > mrun[cg] + 8.0f) != 0ull) { float mx = mxl; mx = fmaxf(mx, __shfl_xor(mx, 16)); mx = fmaxf(mx, __shfl_xor(mx, 32));
                  const float mn = fmaxf(mrun[cg], mx), sc = __builtin_amdgcn_exp2f(mrun[cg] - mn); mrun[cg] = mn; lrun[cg] *= sc;
#pragma unroll
                  for (int dt = 0; dt < 4; ++dt) O[cg][dt] = O[cg][dt] * sc; }
              const unsigned long long mword = MASK[mkoff[cg] + T] >> (4 * kq); const unsigned mlo = (unsigned)mword, mhi = (unsigned)(mword >> 32); const float mcur = mrun[cg]; float ls = 0.f;
#pragma unroll
              for (int sub = 0; sub < 4; ++sub)
#pragma unroll
                  for (int r = 0; r < 4; ++r) { const int keep = __builtin_amdgcn_sbfe((int)(sub < 2 ? mlo : mhi), 16 * (sub & 1) + r, 1);
                      const float p = __uint_as_float(__float_as_uint(__builtin_amdgcn_exp2f(lg[cg][sub][r] - mcur)) & (unsigned)keep); ls += p; lg[cg][sub][r] = p; }
              lrun[cg] += ls; }
          { const unsigned vaddr = ldsV + (unsigned)(buf * DS_BUF);
            asm volatile("ds_read_b64_tr_b16 %0, %16 offset:0\n\t"
                "ds_read_b64_tr_b16 %1, %16 offset:2304\n\t"
                "ds_read_b64_tr_b16 %2, %16 offset:32\n\t"
                "ds_read_b64_tr_b16 %3, %16 offset:2336\n\t"
                "ds_read_b64_tr_b16 %4, %16 offset:64\n\t"
                "ds_read_b64_tr_b16 %5, %16 offset:2368\n\t"
                "ds_read_b64_tr_b16 %6, %16 offset:96\n\t"
                "ds_read_b64_tr_b16 %7, %16 offset:2400\n\t"
                "ds_read_b64_tr_b16 %8, %16 offset:4608\n\t"
                "ds_read_b64_tr_b16 %9, %16 offset:6912\n\t"
                "ds_read_b64_tr_b16 %10, %16 offset:4640\n\t"
                "ds_read_b64_tr_b16 %11, %16 offset:6944\n\t"
                "ds_read_b64_tr_b16 %12, %16 offset:4672\n\t"
                "ds_read_b64_tr_b16 %13, %16 offset:6976\n\t"
                "ds_read_b64_tr_b16 %14, %16 offset:4704\n\t"
                "ds_read_b64_tr_b16 %15, %16 offset:7008\n\t"
                "s_waitcnt lgkmcnt(0)"
                : "=&v"(vt[0][0][0]), "=&v"(vt[0][0][1]), "=&v"(vt[0][1][0]), "=&v"(vt[0][1][1]), "=&v"(vt[0][2][0]), "=&v"(vt[0][2][1]), "=&v"(vt[0][3][0]), "=&v"(vt[0][3][1]), "=&v"(vt[1][0][0]), "=&v"(vt[1][0][1]), "=&v"(vt[1][1][0]), "=&v"(vt[1][1][1]), "=&v"(vt[1][2][0]), "=&v"(vt[1][2][1]), "=&v"(vt[1][3][0]), "=&v"(vt[1][3][1])
                : "v"(vaddr) : "memory"); }
#pragma unroll
          for (int ks2 = 0; ks2 < 2; ++ks2) { bf16x8 pb[2];
#pragma unroll
              for (int cg = 0; cg < 2; ++cg) { v4u pw; pw.x = cvtpk(lg[cg][2 * ks2][0], lg[cg][2 * ks2][1]); pw.y = cvtpk(lg[cg][2 * ks2][2], lg[cg][2 * ks2][3]);
                  pw.z = cvtpk(lg[cg][2 * ks2 + 1][0], lg[cg][2 * ks2 + 1][1]); pw.w = cvtpk(lg[cg][2 * ks2 + 1][2], lg[cg][2 * ks2 + 1][3]); pb[cg] = __builtin_bit_cast(bf16x8, pw); }
#pragma unroll
              for (int dt = 0; dt < 4; ++dt) { const bf16x8 va = __builtin_shufflevector(vt[ks2][dt][0], vt[ks2][dt][1], 0, 1, 2, 3, 4, 5, 6, 7);
#pragma unroll
                  for (int cg = 0; cg < 2; ++cg) O[cg][dt] = mfma16(va, pb[cg], O[cg][dt]); } }
          if (T + 1 < nt64) { *(LAS v4u*)(L + (buf ^ 1) * DS_BUF + skey * DS_TSTR + 16 * spiece) = kv; *(LAS v4u*)(L + (buf ^ 1) * DS_BUF + 9216 + skey * DS_TSTR + 16 * spiece) = vv; }
          kv = kn; vv = vn;
          __syncthreads();
      }
#pragma unroll
      for (int cg = 0; cg < 2; ++cg) { float v = lrun[cg]; v += __shfl_xor(v, 16); v += __shfl_xor(v, 32); const float inv = 1.0f / v;
          const int q = 4 * w + 2 * cg + (fr >> 3);
#pragma unroll
          for (int dt = 0; dt < 4; ++dt) { v2u o; o.x = cvtpk(O[cg][dt][0] * inv, O[cg][dt][1] * inv); o.y = cvtpk(O[cg][dt][2] * inv, O[cg][dt][3] * inv);
              *(v2u*)(YB + (size_t)(qrow0 + q) * 512 + hh * 64 + 16 * dt + 4 * kq) = o; } } }
}

__global__ void __launch_bounds__(NWAVES * 64, 2) mk_fwd(Args args) {
    extern __shared__ __attribute__((aligned(16))) unsigned char lds[];
    LAS unsigned char* L = (LAS unsigned char*)lds;
    volatile LAS unsigned* MISC = (volatile LAS unsigned*)(L + MISC_OFF);
    const int tid = threadIdx.x, lane = tid & 63, wave = __builtin_amdgcn_readfirstlane(tid >> 6);
    const int G = gridDim.x, bx = blockIdx.x;
    const int gw = bx * NWAVES + wave, NGW = G * NWAVES;
    unsigned char* ws = args.ws;
    if (tid < 32) MISC[tid] = 0u;
    __syncthreads();
    XcdBarrier bar; bar.bar = (unsigned*)(ws + WS_CTL) + CW_BAR; bar.x = 0; bar.st = nullptr;
    if (!MK_PER_PHASE) bar = xcd_barrier_post((unsigned*)(ws + WS_CTL) + CW_BAR, MISC + 8);
    const int lo = args.ph_lo, hi = args.ph_hi;
#define IN(k) (lo <= (k) && (k) < hi)
#define SEAM(k) do { if (IN(k) && IN((k) + 1)) xcd_barrier(bar); } while (0)
    bf16* WT1 = (bf16*)(ws + WS_WT1); bf16* WT2 = (bf16*)(ws + WS_WT2); bf16* WT3 = (bf16*)(ws + WS_WT3); bf16* WT4 = (bf16*)(ws + WS_WT4); bf16* WT5 = (bf16*)(ws + WS_WT5);
    bf16* WGLU = (bf16*)(ws + WS_WGLU); bf16* WA = (bf16*)(ws + WS_WA); bf16* WB = (bf16*)(ws + WS_WB); bf16* WOUT = (bf16*)(ws + WS_WOUT);
    bf16* HN = (bf16*)(ws + WS_HN); bf16* FB = (bf16*)(ws + WS_F); bf16* ACT = (bf16*)(ws + WS_BIG);
    bf16* PA = (bf16*)(ws + WS_PA); bf16* PG = (bf16*)(ws + WS_PG); bf16* PK = (bf16*)(ws + WS_PK);
    bf16* AM1 = (bf16*)(ws + WS_META + MO_AM1); bf16* ACTM = (bf16*)(ws + WS_META + MO_ACTM); bf16* FM = (bf16*)(ws + WS_META + MO_FM); bf16* AM2 = (bf16*)(ws + WS_META + MO_AM2);
    bf16* PMU = (bf16*)(ws + WS_META + MO_PMU); bf16* PMK = (bf16*)(ws + WS_META + MO_PMK);
    bf16* HB = (bf16*)(ws + WS_HB); float* RS1 = (float*)(ws + WS_META + 524288); float* RS2 = (float*)(ws + WS_META + 655360);
    bf16* YA = FB; bf16* YG = HN; bf16* YB = HN + (size_t)R * 512; bf16* MERGED = PA;
    const float* x = args.in[0]; float* out = args.out;

    if (IN(0)) {
        for (int item = bx; item < 256; item += G) s5_tables_block(args, item >> 3, item & 7, (LAS float*)L, tid);
        __syncthreads();
        LAS float* scr = (LAS float*)(L + wave * 16384);
        for (int it = gw; it < 11520; it += NGW) {
            int r = it;
            if (r < 6 * 1408) { const int mat = r / 1408; r -= mat * 1408;
                if (mat == 5) { const int kb = r / 32, nb = r % 32; transpose_item8(args.in[13], D, DFF, (unsigned char*)WT5, 64 * kb, 32 * nb, 32 * nb + (lane & 31), scr, lane); }
                else if (mat == 2) { const int kb = r / 32, nb = r % 32; transpose_item(args.in[10], D, DFF, WT2, 64 * kb, 32 * nb, 32 * nb + (lane & 31), scr, lane); }
                else if (mat >= 3) { const int kb = r / 88, nb = r % 88, d0 = 32 * nb, up = (mat == 4) ? 128 : 0; transpose_item8(args.in[mat == 3 ? 11 : 12], DFF, D, (unsigned char*)WT4, 64 * kb, 256 * (d0 >> 7) + (d0 & 127) + up, d0 + (lane & 31), scr, lane); }
                else { const int kb = r / 88, nb = r % 88, d0 = 32 * nb, up = (mat == 1 || mat == 4) ? 128 : 0;
                    transpose_item(args.in[mat == 0 ? 8 : mat == 1 ? 9 : mat == 3 ? 11 : 12], DFF, D, mat < 3 ? WT1 : WT4, 64 * kb, 256 * (d0 >> 7) + (d0 & 127) + up, d0 + (lane & 31), scr, lane, args.in[2]); }
                continue; }
            r -= 6 * 1408;
            if (r < 1920) { const int kb = r / 120, nb = r % 120; transpose_item(args.in[14], 3784, D, WT3, 64 * kb, 32 * nb, win_srccol(32 * nb + (lane & 31)), scr, lane, args.in[4]); continue; }
            r -= 1920;
            if (r < 128) { const int kb = r / 16, nb = r % 16; transpose_item(args.in[23], 512, 512, WGLU, 64 * kb, 32 * nb, 32 * nb + (lane & 31), scr, lane); continue; }
            r -= 128;
            if (r < 256) { const int kb = r / 32, nb = r % 32; transpose_item(args.in[24], D, 512, WA, 64 * kb, 32 * nb, 32 * nb + (lane & 31), scr, lane); continue; }
            r -= 256;
            if (r < 256) { const int kb = r / 32, nb = r % 32; transpose_item(args.in[26], D, 512, WB, 64 * kb, 32 * nb, 32 * nb + (lane & 31), scr, lane); continue; }
            r -= 256;
            { const int kb = r / 32, nb = r % 32; transpose_item(args.in[27], D, D, WOUT, 64 * kb, 32 * nb, 32 * nb + (lane & 31), scr, lane); }
        }
        for (int m = gw; m < R; m += NGW) x_row_to_bf16<false>(x + (size_t)m * D, HN + (size_t)m * D, RS1 + m, lane);
        if (gw < NMETA) x_row_to_bf16<true>(args.in[1] + (size_t)gw * D, AM1 + (size_t)gw * D, nullptr, lane);
    }
    SEAM(0);
    if (IN(1)) {
        if (bx < 176) { const int j0 = 16 * bx, grow = 256 * (j0 >> 7) + (j0 & 127); f32x4 g4, u4;
            meta_tile_blk<4>(AM1, WT1 + (size_t)grow * D, WT1 + (size_t)(grow + 128) * D, D, (LAS float*)L, wave, lane, g4, u4);
            if (wave == 0) {
#pragma unroll
                for (int r = 0; r < 4; ++r) ACTM[(4 * (lane >> 4) + r) * DFF + j0 + (lane & 15)] = (bf16)f2bf(g4[r] * fsig(g4[r]) * u4[r]); } }
        pg8::Gemm g{HN, WT1, R, 2 * DFF, D}; pg8::StaticOrder S; S.init(R, 2 * DFF, G, bx); pg8::EpiSwiglu E{ACT, DFF, RS1};
        pg8::gemm_phase<pg8::EpiSwiglu, pg8::StaticOrder, PG8_ALIGN, PG8_SP2>(L, g, S, E);
        if (REP_G1 > 1) pg8::gemm_phase<pg8::EpiSwiglu, pg8::StaticOrder, PG8_ALIGN, PG8_SP2>(L, g, S, E);
    }
    SEAM(1);
    if (IN(2)) {
        if (bx < 64) { const int n0 = 16 * bx; f32x4 f4, dummy;
            meta_tile_blk<11>(ACTM, WT2 + (size_t)n0 * DFF, nullptr, DFF, (LAS float*)L, wave, lane, f4, dummy);
            if (wave == 0) {
#pragma unroll
                for (int r = 0; r < 4; ++r) FM[(4 * (lane >> 4) + r) * D + n0 + (lane & 15)] = (bf16)f2bf(f4[r]); } }
        pg8::Gemm g{ACT, WT2, R, D, DFF}; pg8::StaticOrder S; S.init(R, D, G, bx); pg8::EpiPlain E{FB, D};
        pg8::gemm_phase<pg8::EpiPlain, pg8::StaticOrder, PG8_ALIGN, PG8_SP2>(L, g, S, E);
    }
    SEAM(2);
    if (IN(3)) {
        if (gw < NMETA) row_update<false, false>(FM + (size_t)gw * D, args.in[1] + (size_t)gw * D, nullptr, AM2 + (size_t)gw * D, args.in[3], nullptr, 0.5f, lane);
        for (int m = gw; m < R; m += NGW) row_update<true, true>(FB + (size_t)m * D, HN + (size_t)m * D, HB + (size_t)m * D, nullptr, args.in[3], nullptr, 0.5f, lane, RS2 + m);
    }
    SEAM(3);
    if (IN(4)) {
        if (bx < 44) { const int n0 = bx < 32 ? 16 * bx : 3584 + 16 * (bx - 32); f32x4 p4, dummy;
            meta_tile_blk<4>(AM2, WT3 + (size_t)n0 * D, nullptr, D, (LAS float*)L, wave, lane, p4, dummy);
            if (wave == 0) {
#pragma unroll
                for (int r = 0; r < 4; ++r) { const int row = 4 * (lane >> 4) + r; if (bx < 32) PMU[row * 512 + n0 + (lane & 15)] = (bf16)f2bf(p4[r]); else PMK[row * 256 + (n0 - 3584) + (lane & 15)] = (bf16)f2bf(p4[r]); } } }
        pg8::Gemm g{HB, WT3, R, 3840, D}; pg8::StaticOrder S; S.init(R, 3840, G, bx); pg8::EpiProj E{PA, PG, PK, (bf16*)(ws + WS_UA2), RS2};
        pg8::gemm_phase<pg8::EpiProj, pg8::StaticOrder, PG8_ALIGN, PG8_SP2>(L, g, S, E);
    }
    SEAM(4);
    if (IN(5)) {
        s5_meta(args, L, bx >> 3, tid);
        for (int rep = 0; rep < REP_S5; ++rep) for (int i = 0; i < 2; ++i) s5_unit(args, L, 2 * (bx & 7) + i, bx >> 3, tid);
        __syncthreads();
        dsa_tables(args, L, tid);
        for (int i = 0; i < 4 * REP_DSA; ++i) { const int up = 4 * (bx >> 3) + (i & 3), u2 = up >> 1, b = 2 * (bx & 7) + (u2 >> 5), xq = u2 & 31; dsa_unit(args, L, b, (up & 1) ? 63 - xq : xq, tid); }
        __syncthreads();
    }
    SEAM(5);
    if (IN(6)) { pg8::Gemm g{YA, WGLU, R, 512, 512}; pg8::StaticOrder S; S.init(R, 512, G, bx); pg8::EpiGlu E{YA, YG};
        pg8::gemm_phase<pg8::EpiGlu, pg8::StaticOrder, PG8_ALIGN, PG8_SP2>(L, g, S, E); }
    SEAM(6);
    if (IN(7)) { pg8::Gemm g{YG, WA, 2 * R, 2048, 512}; pg8::MergeOrder S; S.base.init(R, D, G, bx); pg8::EpiMerge2 E{PG, FB, MERGED};
        pg8::gemm_phase<pg8::EpiMerge2, pg8::MergeOrder, PG8_ALIGN, PG8_SP2>(L, g, S, E); }
    if (IN(7) && IN(9)) xcd_barrier(bar);
    if (IN(9)) { pg8::Gemm g{MERGED, WOUT, R, D, D}; pg8::StaticOrder S; S.init(R, D, G, bx); pg8::EpiPlain E{FB, D};
        pg8::gemm_phase<pg8::EpiPlain, pg8::StaticOrder, PG8_ALIGN, PG8_SP2>(L, g, S, E); }
    SEAM(9);
    if (IN(10)) { for (int m = gw; m < R; m += NGW) row_update<true, true, true>(FB + (size_t)m * D, HB + (size_t)m * D, HB + (size_t)m * D, (bf16*)((unsigned char*)HN + (size_t)m * D), args.in[5], args.in[6], 1.0f, lane); }
    SEAM(10);
    if (IN(11)) { pg8::Gemm g{HN, WT4, R, 2 * DFF, D}; pg8::StaticOrder S; S.init(R, 2 * DFF, G, bx); pg8::EpiSwiglu8 E{(unsigned char*)ACT, DFF, 1.0f / 256.0f, 8.0f};
        pg8::gemm_phase<pg8::EpiSwiglu8, pg8::StaticOrder, PG8_ALIGN, PG8_SP2, true>(L, g, S, E); }
    SEAM(11);
    if (IN(12)) { pg8::Gemm g{ACT, WT5, R, D, DFF}; pg8::StaticOrder S; S.init(R, D, G, bx); pg8::EpiPlainS E{FB, D, 1.0f / 512.0f};
        pg8::gemm_phase<pg8::EpiPlainS, pg8::StaticOrder, PG8_ALIGN, PG8_SP2, true>(L, g, S, E); }
    SEAM(12);
    if (IN(13)) { for (int m = gw; m < R; m += NGW) row_update<true, false>(FB + (size_t)m * D, HB + (size_t)m * D, out + (size_t)m * D, nullptr, args.in[7], args.in[7], 0.5f, lane); }
#undef IN
#undef SEAM
}

extern "C" void kernel_launch(void* const* d_in, const int* in_sizes, int n_in, void* d_out, int out_size, void* d_ws, size_t ws_size, hipStream_t stream) {
    static int grid = 0;
    if (grid == 0) {
        if (n_in != 28 || out_size != R * D || ws_size < WS_END) { fprintf(stderr, "kernel_launch: unexpected shapes (n_in %d, out %d, ws %zu); nothing launched\n", n_in, out_size, ws_size); grid = -1; return; }
        int dev = 0, cus = 0, per_cu = 0;
        if (hipGetDevice(&dev) != hipSuccess || hipDeviceGetAttribute(&cus, hipDeviceAttributeMultiprocessorCount, dev) != hipSuccess) { grid = -1; return; }
        if (hipFuncSetAttribute((const void*)mk_fwd, hipFuncAttributeMaxDynamicSharedMemorySize, LDS_BYTES) != hipSuccess) { fprintf(stderr, "kernel_launch: hipFuncSetAttribute failed\n"); grid = -1; return; }
        if (hipOccupancyMaxActiveBlocksPerMultiprocessor(&per_cu, (const void*)mk_fwd, NWAVES * 64, LDS_BYTES) != hipSuccess || per_cu < 1) fprintf(stderr, "kernel_launch: note: occupancy query reports %d\n", per_cu);
        (void)hipGetLastError();
        grid = cus;
    }
    if (grid < 0) return;
    if (hipMemsetAsync((char*)d_ws + WS_CTL, 0, CTL_ZERO_BYTES, stream) != hipSuccess) return;
    Args a{};
    for (int i = 0; i < 28; ++i) a.in[i] = (const float*)d_in[i];
    a.out = (float*)d_out; a.ws = (unsigned char*)d_ws;
#if MK_PER_PHASE
    for (int ph = 0; ph < NPH; ++ph) { a.ph_lo = ph; a.ph_hi = ph + 1; hipLaunchKernelGGL(mk_fwd, dim3(grid), dim3(NWAVES * 64), LDS_BYTES, stream, a); }
#else
    a.ph_lo = 0; a.ph_hi = NPH;
    hipLaunchKernelGGL(mk_fwd, dim3(grid), dim3(NWAVES * 64), LDS_BYTES, stream, a);
#endif
}
```

```cpp
#include <hip/hip_runtime.h>
#include <cstdio>
#include <cstdint>
namespace pg8 {
#define PG8_LAS __attribute__((address_space(3)))
typedef unsigned short bf16_t;
typedef short bf16x8 __attribute__((ext_vector_type(8)));
typedef float f32x4 __attribute__((ext_vector_type(4)));
typedef unsigned u32x4 __attribute__((ext_vector_type(4)));
constexpr int BM = 256, BK = 64, HALF = 128, HTB = HALF * BK * 2  , STAGE_BYTES = 8 * HTB, NXCD = 8, WGM = 8;

__host__ __device__ __forceinline__ int lds_byte(int r, int c) { const int st = (r >> 4) * 2 + (c >> 5), rr = r & 15, cc = c & 31, ob = rr * 64 + cc * 2; return st * 1024 + (ob ^ (((ob >> 9) & 1) << 5)); }
__host__ __device__ __forceinline__ void stage_rc(int b, int& R, int& C) { const int st = b / 1024, sb = b % 1024, swz = sb ^ (((sb >> 9) & 1) << 5); R = (st >> 1) * 16 + swz / 64; C = (st & 1) * 32 + (swz % 64) / 2; }
__host__ __device__ __forceinline__ int perm32(int rho) { const int n = rho >> 4, i = rho & 15; return 8 * (i >> 2) + 4 * n + (i & 3); }

struct Unit { int pm, pn; };
struct Gemm { const bf16_t* A; const bf16_t* Bt; int M, N, K; };

struct StaticOrder {
    int nM, nN, nwg, G, c;
    __host__ __device__ void init(int M, int N, int G_, int c_) { nM = M / BM; nN = N / BM; nwg = nM * nN; G = G_; c = c_; }
    __host__ __device__ bool next(int i, Unit& u) const {
        const long L = (long)i * G + c; if (L >= nwg) return false;
        int wgid = (int)L; { const int q = nwg / NXCD, r = nwg % NXCD, xcd = wgid % NXCD, off = wgid / NXCD; wgid = (xcd < r ? xcd * (q + 1) : r * (q + 1) + (xcd - r) * q) + off; }
        const int nig = WGM * nN, gid = wgid / nig, fm = gid * WGM, gsz = (nM - fm) < WGM ? (nM - fm) : WGM;
        u.pm = fm + ((wgid % nig) % gsz); u.pn = (wgid % nig) / gsz; return true;
    }
    __device__ __forceinline__ void a_ready(const Unit&) const {}
    __device__ __forceinline__ void done(const Unit&) const {}
};
__device__ __forceinline__ unsigned cvt_pk_bf16(float lo, float hi) { unsigned r; asm volatile("v_cvt_pk_bf16_f32 %0, %1, %2" : "=v"(r) : "v"(lo), "v"(hi)); return r; }
__device__ __forceinline__ float fsigmoid(float x) { return __builtin_amdgcn_rcpf(1.0f + __expf(-x)); }
__device__ __forceinline__ float bf_lo(unsigned w) { return __uint_as_float(w << 16); }
__device__ __forceinline__ float bf_hi(unsigned w) { return __uint_as_float(w & 0xffff0000u); }
__device__ __forceinline__ u32x4 pack8(const f32x4 v0, const f32x4 v1) { u32x4 w; w.x = cvt_pk_bf16(v0[0], v0[1]); w.y = cvt_pk_bf16(v0[2], v0[3]); w.z = cvt_pk_bf16(v1[0], v1[1]); w.w = cvt_pk_bf16(v1[2], v1[3]); return w; }
__device__ __forceinline__ void unpack8(const u32x4 w, f32x4& v0, f32x4& v1) { v0 = (f32x4){bf_lo(w.x), bf_hi(w.x), bf_lo(w.y), bf_hi(w.y)}; v1 = (f32x4){bf_lo(w.z), bf_hi(w.z), bf_lo(w.w), bf_hi(w.w)}; }

struct EpiSwiglu {
    static constexpr bool PERM = true, AFTER_DRAIN = false;
    bf16_t* O; int ldc; const float* rs;
    __device__ __forceinline__ void operator()(const f32x4 (&acc)[2][2][4][2], const Unit& u, int wr, int wc, int fr, int fq) const {
        const int row0 = u.pm * BM + wr * 64 + fr, col0 = u.pn * HALF + wc * 32 + 8 * fq;
#pragma unroll
        for (int ai = 0; ai < 2; ++ai)
#pragma unroll
            for (int m = 0; m < 4; ++m) { bf16_t* rowp = O + (size_t)(row0 + ai * HALF + m * 16) * ldc + col0; const float rsc = rs[row0 + ai * HALF + m * 16];
                f32x4 v0, v1;
#pragma unroll
                for (int j = 0; j < 4; ++j) { const float g0 = acc[ai][0][m][0][j] * rsc, g1 = acc[ai][0][m][1][j] * rsc;
                    v0[j] = g0 * fsigmoid(g0) * (acc[ai][1][m][0][j] * rsc); v1[j] = g1 * fsigmoid(g1) * (acc[ai][1][m][1][j] * rsc); }
                *(u32x4*)rowp = pack8(v0, v1); }
    }
};
struct EpiPlain {
    static constexpr bool PERM = true, AFTER_DRAIN = false;
    bf16_t* O; int ldc;
    __device__ __forceinline__ void operator()(const f32x4 (&acc)[2][2][4][2], const Unit& u, int wr, int wc, int fr, int fq) const {
        const int row0 = u.pm * BM + wr * 64 + fr, col0 = u.pn * BM + wc * 32 + 8 * fq;
#pragma unroll
        for (int ai = 0; ai < 2; ++ai)
#pragma unroll
            for (int m = 0; m < 4; ++m) { bf16_t* rowp = O + (size_t)(row0 + ai * HALF + m * 16) * ldc + col0;
#pragma unroll
                for (int bj = 0; bj < 2; ++bj) *(u32x4*)(rowp + bj * HALF) = pack8(acc[ai][bj][m][0], acc[ai][bj][m][1]); }
    }
};

__device__ __forceinline__ unsigned pk4_fp8(float a, float b, float c, float d) { int w = 0; w = __builtin_amdgcn_cvt_pk_fp8_f32(fminf(fmaxf(a, -448.f), 448.f), fminf(fmaxf(b, -448.f), 448.f), w, false);
    w = __builtin_amdgcn_cvt_pk_fp8_f32(fminf(fmaxf(c, -448.f), 448.f), fminf(fmaxf(d, -448.f), 448.f), w, true); return (unsigned)w; }
struct EpiSwiglu8 {
    static constexpr bool PERM = true, AFTER_DRAIN = false;
    unsigned char* O; int ldc; float ascale, oscale;
    __device__ __forceinline__ void operator()(const f32x4 (&acc)[2][2][4][2], const Unit& u, int wr, int wc, int fr, int fq) const {
        const int row0 = u.pm * BM + wr * 64 + fr, col0 = u.pn * HALF + wc * 32 + 8 * fq;
#pragma unroll
        for (int ai = 0; ai < 2; ++ai)
#pragma unroll
            for (int m = 0; m < 4; ++m) { unsigned char* rowp = O + (size_t)(row0 + ai * HALF + m * 16) * ldc + col0;
                f32x4 v0, v1;
#pragma unroll
                for (int j = 0; j < 4; ++j) { const float g0 = acc[ai][0][m][0][j] * ascale, g1 = acc[ai][0][m][1][j] * ascale;
                    v0[j] = g0 * fsigmoid(g0) * (acc[ai][1][m][0][j] * ascale) * oscale; v1[j] = g1 * fsigmoid(g1) * (acc[ai][1][m][1][j] * ascale) * oscale; }
                typedef unsigned u32x2 __attribute__((ext_vector_type(2))); u32x2 w; w.x = pk4_fp8(v0[0], v0[1], v0[2], v0[3]); w.y = pk4_fp8(v1[0], v1[1], v1[2], v1[3]);
                *(u32x2*)rowp = w; }
    }
};
struct EpiPlainS {
    static constexpr bool PERM = true, AFTER_DRAIN = false;
    bf16_t* O; int ldc; float scale;
    __device__ __forceinline__ void operator()(const f32x4 (&acc)[2][2][4][2], const Unit& u, int wr, int wc, int fr, int fq) const {
        const int row0 = u.pm * BM + wr * 64 + fr, col0 = u.pn * BM + wc * 32 + 8 * fq;
#pragma unroll
        for (int ai = 0; ai < 2; ++ai)
#pragma unroll
            for (int m = 0; m < 4; ++m) { bf16_t* rowp = O + (size_t)(row0 + ai * HALF + m * 16) * ldc + col0;
#pragma unroll
                for (int bj = 0; bj < 2; ++bj) *(u32x4*)(rowp + bj * HALF) = pack8(acc[ai][bj][m][0] * scale, acc[ai][bj][m][1] * scale); }
    }
};
struct EpiProj {
    static constexpr bool PERM = true, AFTER_DRAIN = false;
    bf16_t *PA, *PG, *PK, *UA2; const float* rs;
    __device__ __forceinline__ void operator()(const f32x4 (&acc)[2][2][4][2], const Unit& u, int wr, int wc, int fr, int fq) const {
        if (u.pn < 2) {
#pragma unroll
            for (int ai = 0; ai < 2; ++ai)
#pragma unroll
                for (int m = 0; m < 4; ++m) { const int row = u.pm * BM + wr * 64 + fr + ai * HALF + m * 16, bb = row >> 11, t = row & 2047;
#pragma unroll
                    for (int bj = 0; bj < 2; ++bj) { const int col = 256 * u.pn + 128 * bj + wc * 32 + 8 * fq;
                        const float rsc = rs[row]; *(u32x4*)(UA2 + ((size_t)((bb * 32 + (col >> 4)) * 2048 + t)) * 16 + (col & 8)) = pack8(acc[ai][bj][m][0] * rsc, acc[ai][bj][m][1] * rsc); } }
            return; }
        bf16_t* base; int ldc, colt;
        if (u.pn < 6) { base = PA; ldc = 1536; colt = 256 * u.pn; } else if (u.pn < 14) { base = PG; ldc = 2048; colt = 256 * (u.pn - 6); } else { base = PK; ldc = 256; colt = 0; }
        const int row0 = u.pm * BM + wr * 64 + fr, col0 = colt + wc * 32 + 8 * fq;
#pragma unroll
        for (int ai = 0; ai < 2; ++ai)
#pragma unroll
            for (int m = 0; m < 4; ++m) { bf16_t* rowp = base + (size_t)(row0 + ai * HALF + m * 16) * ldc + col0; const float rsc = rs[row0 + ai * HALF + m * 16];
#pragma unroll
                for (int bj = 0; bj < 2; ++bj) *(u32x4*)(rowp + bj * HALF) = pack8(acc[ai][bj][m][0] * rsc, acc[ai][bj][m][1] * rsc); }
    }
};
struct EpiGlu {
    static constexpr bool PERM = true, AFTER_DRAIN = false;
    const bf16_t* Y; bf16_t* O;
    __device__ __forceinline__ void operator()(const f32x4 (&acc)[2][2][4][2], const Unit& u, int wr, int wc, int fr, int fq) const {
        const int row0 = u.pm * BM + wr * 64 + fr, col0 = u.pn * BM + wc * 32 + 8 * fq;
#pragma unroll
        for (int ai = 0; ai < 2; ++ai)
#pragma unroll
            for (int m = 0; m < 4; ++m) { const size_t off = (size_t)(row0 + ai * HALF + m * 16) * 512 + col0;
#pragma unroll
                for (int bj = 0; bj < 2; ++bj) { f32x4 y0, y1; unpack8(*(const u32x4*)(Y + off + bj * HALF), y0, y1); f32x4 v0, v1;
#pragma unroll
                    for (int j = 0; j < 4; ++j) { v0[j] = y0[j] * fsigmoid(acc[ai][bj][m][0][j]); v1[j] = y1[j] * fsigmoid(acc[ai][bj][m][1][j]); }
                    *(u32x4*)(O + off + bj * HALF) = pack8(v0, v1); } }
    }
};
template <bool SECOND> struct EpiMerge {
    static constexpr bool PERM = true, AFTER_DRAIN = false;
    const bf16_t* G; int goff; const bf16_t* T; bf16_t* O;
    __device__ __forceinline__ void operator()(const f32x4 (&acc)[2][2][4][2], const Unit& u, int wr, int wc, int fr, int fq) const {
        const int row0 = u.pm * BM + wr * 64 + fr, col0 = u.pn * BM + wc * 32 + 8 * fq;
#pragma unroll
        for (int ai = 0; ai < 2; ++ai)
#pragma unroll
            for (int m = 0; m < 4; ++m) { const size_t row = (size_t)(row0 + ai * HALF + m * 16);
#pragma unroll
                for (int bj = 0; bj < 2; ++bj) { const int col = col0 + bj * HALF; f32x4 g0, g1; unpack8(*(const u32x4*)(G + row * 2048 + goff + col), g0, g1);
                    f32x4 t0 = (f32x4){0.f, 0.f, 0.f, 0.f}, t1 = t0; if (SECOND) unpack8(*(const u32x4*)(T + row * 1024 + col), t0, t1);
                    f32x4 v0, v1;
#pragma unroll
                    for (int j = 0; j < 4; ++j) { v0[j] = t0[j] + fsigmoid(g0[j]) * acc[ai][bj][m][0][j]; v1[j] = t1[j] + fsigmoid(g1[j]) * acc[ai][bj][m][1][j]; }
                    *(u32x4*)(O + row * 1024 + col) = pack8(v0, v1); } }
    }
};

struct MergeOrder {
    StaticOrder base;
    __device__ __forceinline__ bool next(int i, Unit& u) const { if (i >= 4) return false; if (!base.next(i & 1, u)) return false; if (i >= 2) { u.pm += 128; u.pn += 4; } return true; }
    __device__ __forceinline__ void a_ready(const Unit&) const {}
    __device__ __forceinline__ void done(const Unit&) const {}
};
struct EpiMerge2 {
    static constexpr bool PERM = true, AFTER_DRAIN = false;
    const bf16_t* G; bf16_t* T; bf16_t* O;
    __device__ __forceinline__ void operator()(const f32x4 (&acc)[2][2][4][2], const Unit& u, int wr, int wc, int fr, int fq) const {
        const bool second = u.pm >= 128; const int pm = second ? u.pm - 128 : u.pm, pn = second ? u.pn - 4 : u.pn, goff = second ? 1024 : 0;
        const int row0 = pm * BM + wr * 64 + fr, col0 = pn * BM + wc * 32 + 8 * fq;
#pragma unroll
        for (int ai = 0; ai < 2; ++ai)
#pragma unroll
            for (int m = 0; m < 4; ++m) { const size_t row = (size_t)(row0 + ai * HALF + m * 16);
#pragma unroll
                for (int bj = 0; bj < 2; ++bj) { const int col = col0 + bj * HALF; f32x4 g0, g1; unpack8(*(const u32x4*)(G + row * 2048 + goff + col), g0, g1);
                    f32x4 t0 = (f32x4){0.f, 0.f, 0.f, 0.f}, t1 = t0; if (second) unpack8(*(const u32x4*)(T + row * 1024 + col), t0, t1);
                    f32x4 v0, v1;
#pragma unroll
                    for (int j = 0; j < 4; ++j) { v0[j] = t0[j] + fsigmoid(g0[j]) * acc[ai][bj][m][0][j]; v1[j] = t1[j] + fsigmoid(g1[j]) * acc[ai][bj][m][1][j]; }
                    *(u32x4*)((second ? O : T) + row * 1024 + col) = pack8(v0, v1); } }
    }
};
typedef int i32x8 __attribute__((ext_vector_type(8)));
typedef int i32x4v __attribute__((ext_vector_type(4)));
__device__ __forceinline__ i32x8 cat8(const bf16x8 lo, const bf16x8 hi) { const i32x4v a = __builtin_bit_cast(i32x4v, lo), b = __builtin_bit_cast(i32x4v, hi); return __builtin_shufflevector(a, b, 0, 1, 2, 3, 4, 5, 6, 7); }
template <class Epi, class Sched, bool ALIGN_EPI = false, bool SP2 = false, bool F8 = false>
__device__ __forceinline__ void gemm_phase(PG8_LAS unsigned char* lds, const Gemm g, const Sched& S, const Epi& E) {
    const int tid = threadIdx.x, wid = __builtin_amdgcn_readfirstlane(tid >> 6), lane = tid & 63, wr = wid >> 2, wc = wid & 3, fr = lane & 15, fq = lane >> 4;
    const int K = g.K, KB = F8 ? K : 2 * K  , nt = KB / 128;
    unsigned voffA[2], voffB[2];
#pragma unroll
    for (int i = 0; i < 2; ++i) { int R, C; stage_rc(tid * 16 + i * 8192, R, C); const int Rb = Epi::PERM ? ((R & ~31) + perm32(R & 31)) : R;
        voffA[i] = (unsigned)(R * KB + C * 2); voffB[i] = (unsigned)(Rb * KB + C * 2); }
    const size_t kstep = (size_t)(BK * 2);
    const size_t hstep = (size_t)HALF * KB;
    const size_t tstep = 2 * hstep;
    const unsigned ldsw = (unsigned)wid * 1024u;
    const int aoff = lds_byte(wr * 64 + fr, fq * 8), boff = lds_byte(wc * 32 + fr, fq * 8);
#define PG8_SA(b, h) (((b) * 2 + (h)) * HTB)
#define PG8_SB(b, h) ((4 + (b) * 2 + (h)) * HTB)
#define PG8_STAGE(bufoff, gbase, voff) do { _Pragma("unroll") for (int _i = 0; _i < 2; ++_i) \
        __builtin_amdgcn_global_load_lds((const unsigned*)((const char*)(gbase) + (voff)[_i]), (PG8_LAS unsigned*)(lds + (bufoff) + ldsw + _i * 8192), 16, 0, 0); } while (0)
#define PG8_LDA(dst, b, h) do { if constexpr (F8) { _Pragma("unroll") for (int m = 0; m < 4; ++m) dst##8[m] = cat8(*(const PG8_LAS bf16x8*)(lds + PG8_SA(b, h) + aoff + m * 2048), *(const PG8_LAS bf16x8*)(lds + PG8_SA(b, h) + aoff + m * 2048 + 1024)); } else { \
        _Pragma("unroll") for (int m = 0; m < 4; ++m) _Pragma("unroll") for (int k = 0; k < 2; ++k) dst[m][k] = *(const PG8_LAS bf16x8*)(lds + PG8_SA(b, h) + aoff + m * 2048 + k * 1024); } } while (0)
#define PG8_LDB(dst, b, h) do { if constexpr (F8) { _Pragma("unroll") for (int n = 0; n < 2; ++n) dst##8[n] = cat8(*(const PG8_LAS bf16x8*)(lds + PG8_SB(b, h) + boff + n * 2048), *(const PG8_LAS bf16x8*)(lds + PG8_SB(b, h) + boff + n * 2048 + 1024)); } else { \
        _Pragma("unroll") for (int n = 0; n < 2; ++n) _Pragma("unroll") for (int k = 0; k < 2; ++k) dst[n][k] = *(const PG8_LAS bf16x8*)(lds + PG8_SB(b, h) + boff + n * 2048 + k * 1024); } } while (0)
#define PG8_MMA(ai, bj, At, Bt) do { __builtin_amdgcn_s_setprio(1); if constexpr (F8) { _Pragma("unroll") for (int m = 0; m < 4; ++m) _Pragma("unroll") for (int n = 0; n < 2; ++n) \
        acc[ai][bj][m][n] = __builtin_amdgcn_mfma_scale_f32_16x16x128_f8f6f4(Bt##8[n], At##8[m], acc[ai][bj][m][n], 0, 0, 0, 0x7F7F7F7F, 0, 0x7F7F7F7F); \
        _Pragma("unroll") for (int m = 0; m < 4; ++m) _Pragma("unroll") for (int n = 0; n < 2; ++n) asm volatile("" : "+v"(acc[ai][bj][m][n])); } else { \
        _Pragma("unroll") for (int m = 0; m < 4; ++m) _Pragma("unroll") for (int n = 0; n < 2; ++n) _Pragma("unroll") for (int k = 0; k < 2; ++k) \
        acc[ai][bj][m][n] = __builtin_amdgcn_mfma_f32_16x16x32_bf16(Bt[n][k], At[m][k], acc[ai][bj][m][n], 0, 0, 0); } __builtin_amdgcn_s_setprio(0); } while (0)
#define PG8_WAIT_V(n) asm volatile("s_waitcnt vmcnt(" #n ")" ::: "memory")
#define PG8_WAIT_L(n) asm volatile("s_waitcnt lgkmcnt(" #n ")" ::: "memory")
#define PG8_BAR __builtin_amdgcn_s_barrier()
#define PG8_SCHED __builtin_amdgcn_sched_barrier(0)
    Unit cur, nxt; int ui = 0;
    if (!S.next(0, cur)) return;
    f32x4 acc[2][2][4][2];
#pragma unroll
    for (int a = 0; a < 2; ++a)
#pragma unroll
        for (int b = 0; b < 2; ++b)
#pragma unroll
            for (int m = 0; m < 4; ++m)
#pragma unroll
                for (int n = 0; n < 2; ++n) acc[a][b][m][n] = (f32x4){0.f, 0.f, 0.f, 0.f};
    bf16x8 At[4][2], B0[2][2], B1[2][2]; i32x8 At8[4], B08[2], B18[2];
    const char* cA = (const char*)g.A + (size_t)cur.pm * tstep; const char* cB = (const char*)g.Bt + (size_t)cur.pn * tstep;
    S.a_ready(cur);
    if constexpr (SP2) {
        PG8_STAGE(PG8_SB(0, 0), cB, voffB); PG8_STAGE(PG8_SB(0, 1), cB + hstep, voffB); PG8_STAGE(PG8_SA(0, 0), cA, voffA); PG8_STAGE(PG8_SA(0, 1), cA + hstep, voffA);
        if (wr == 1) PG8_BAR;
        PG8_WAIT_V(2); PG8_BAR;
        PG8_STAGE(PG8_SB(1, 0), cB + kstep, voffB); PG8_STAGE(PG8_SA(1, 0), cA + kstep, voffA); PG8_STAGE(PG8_SB(1, 1), cB + hstep + kstep, voffB);
        PG8_WAIT_V(6); PG8_BAR;
    } else {
        PG8_STAGE(PG8_SB(0, 0), cB, voffB); PG8_STAGE(PG8_SA(0, 0), cA, voffA); PG8_STAGE(PG8_SB(0, 1), cB + hstep, voffB); PG8_STAGE(PG8_SA(0, 1), cA + hstep, voffA);
        if (wr == 1) PG8_BAR;
        PG8_WAIT_V(4); PG8_BAR;
        PG8_STAGE(PG8_SB(1, 0), cB + kstep, voffB); PG8_STAGE(PG8_SA(1, 0), cA + kstep, voffA); PG8_STAGE(PG8_SB(1, 1), cB + hstep + kstep, voffB);
        PG8_WAIT_V(6); PG8_BAR;
    }
    for (;;) {
        const bool has_next = S.next(ui + 1, nxt);
        const char* nA = has_next ? (const char*)g.A + (size_t)nxt.pm * tstep : cA; const char* nB = has_next ? (const char*)g.Bt + (size_t)nxt.pn * tstep : cB;
        for (int t = 0; t < nt; t += 2) {
            const bool last = (t == nt - 2);
            const char* a1 = cA + (size_t)(t + 1) * kstep;
            const char* a2 = last ? nA : cA + (size_t)(t + 2) * kstep; const char* b2 = last ? nB : cB + (size_t)(t + 2) * kstep;
            const char* a3 = a2 + kstep; const char* b3 = b2 + kstep;
            if (last && has_next) S.a_ready(nxt);
            if constexpr (SP2) {
            PG8_LDB(B0, 0, 0); PG8_LDB(B1, 0, 1); PG8_SCHED; PG8_LDA(At, 0, 0); PG8_STAGE(PG8_SA(1, 1), a1 + hstep, voffA);
            PG8_WAIT_V(8); PG8_WAIT_L(0); PG8_BAR; PG8_MMA(0, 0, At, B0); PG8_MMA(0, 1, At, B1); PG8_BAR; PG8_SCHED;
            PG8_LDA(At, 0, 1); PG8_STAGE(PG8_SB(0, 0), b2, voffB); PG8_STAGE(PG8_SB(0, 1), b2 + hstep, voffB); PG8_STAGE(PG8_SA(0, 0), a2, voffA);
            PG8_WAIT_V(8); PG8_WAIT_L(0); PG8_BAR; PG8_MMA(1, 0, At, B0); PG8_MMA(1, 1, At, B1); PG8_BAR; PG8_SCHED;
            PG8_LDB(B0, 1, 0); PG8_LDB(B1, 1, 1); PG8_SCHED; PG8_LDA(At, 1, 0); PG8_STAGE(PG8_SA(0, 1), a2 + hstep, voffA);
            PG8_WAIT_V(8); PG8_WAIT_L(0); PG8_BAR; PG8_MMA(0, 0, At, B0); PG8_MMA(0, 1, At, B1); PG8_BAR; PG8_SCHED;
            PG8_LDA(At, 1, 1); PG8_STAGE(PG8_SB(1, 0), b3, voffB); PG8_STAGE(PG8_SB(1, 1), b3 + hstep, voffB); PG8_STAGE(PG8_SA(1, 0), a3, voffA);
            PG8_WAIT_V(8); PG8_WAIT_L(0); PG8_BAR; PG8_MMA(1, 0, At, B0); PG8_MMA(1, 1, At, B1); PG8_BAR; PG8_SCHED;
            } else {
            PG8_LDB(B0, 0, 0); PG8_SCHED; PG8_LDA(At, 0, 0); PG8_STAGE(PG8_SA(1, 1), a1 + hstep, voffA);
            PG8_WAIT_L(8); PG8_BAR; PG8_WAIT_L(0); PG8_MMA(0, 0, At, B0); PG8_BAR; PG8_SCHED;
            PG8_LDB(B1, 0, 1); PG8_STAGE(PG8_SB(0, 0), b2, voffB);
            PG8_BAR; PG8_WAIT_L(0); PG8_MMA(0, 1, At, B1); PG8_BAR;
            PG8_LDA(At, 0, 1); PG8_STAGE(PG8_SA(0, 0), a2, voffA);
            PG8_BAR; PG8_WAIT_L(0); PG8_MMA(1, 0, At, B0); PG8_BAR; PG8_SCHED;
            PG8_STAGE(PG8_SB(0, 1), b2 + hstep, voffB);
            PG8_WAIT_V(6); PG8_BAR; PG8_MMA(1, 1, At, B1); PG8_BAR;
            PG8_LDB(B0, 1, 0); PG8_SCHED; PG8_LDA(At, 1, 0); PG8_STAGE(PG8_SA(0, 1), a2 + hstep, voffA);
            PG8_WAIT_L(8); PG8_BAR; PG8_WAIT_L(0); PG8_MMA(0, 0, At, B0); PG8_BAR; PG8_SCHED;
            PG8_LDB(B1, 1, 1); PG8_STAGE(PG8_SB(1, 0), b3, voffB);
            PG8_BAR; PG8_WAIT_L(0); PG8_MMA(0, 1, At, B1); PG8_BAR;
            PG8_LDA(At, 1, 1); PG8_STAGE(PG8_SA(1, 0), a3, voffA);
            PG8_BAR; PG8_WAIT_L(0); PG8_MMA(1, 0, At, B0); PG8_BAR; PG8_SCHED;
            PG8_STAGE(PG8_SB(1, 1), b3 + hstep, voffB);
            PG8_WAIT_V(6); PG8_BAR; PG8_MMA(1, 1, At, B1); PG8_BAR;
            }
        }
        if constexpr (ALIGN_EPI) { if (wr == 0) PG8_BAR; }
        if constexpr (!Epi::AFTER_DRAIN) { E(acc, cur, wr, wc, fr, fq); S.done(cur); }
        if (!has_next) break;
#pragma unroll
        for (int a = 0; a < 2; ++a)
#pragma unroll
            for (int b = 0; b < 2; ++b)
#pragma unroll
                for (int m = 0; m < 4; ++m)
#pragma unroll
                    for (int n = 0; n < 2; ++n) acc[a][b][m][n] = (f32x4){0.f, 0.f, 0.f, 0.f};
        cur = nxt; cA = nA; cB = nB; ++ui;
        if constexpr (ALIGN_EPI) { if (wr == 1) PG8_BAR; }
    }
    PG8_WAIT_V(0);
    if constexpr (!ALIGN_EPI) { if (wr == 0) PG8_BAR; }
    PG8_BAR;
    if constexpr (Epi::AFTER_DRAIN) { E.fused(acc, cur, wr, wc, fr, fq, lds, wid, lane); S.done(cur); }
#undef PG8_SA
#undef PG8_SB
#undef PG8_STAGE
#undef PG8_LDA
#undef PG8_LDB
#undef PG8_MMA
#undef PG8_WAIT_V
#undef PG8_WAIT_L
#undef PG8_BAR
#undef PG8_SCHED
}
}
#ifndef PG8_SP2
#define PG8_SP2 true
#endif
#ifndef PG8_ALIGN
#define PG8_ALIGN true
#endif
#ifndef MK_PER_PHASE
#define MK_PER_PHASE 0
#endif
#ifndef REP_S5
#define REP_S5 1
#endif
#ifndef REP_DSA
#define REP_DSA 1
#endif
#ifndef REP_G1
#define REP_G1 1
#endif
constexpr int NWAVES = 8;
constexpr int NPH = 14;

constexpr int NB = 16, SEQ = 2048, D = 1024, NMETA = 16, DFF = 2816;
constexpr int R = NB * SEQ;
constexpr int NG = 32, NP = 64, NM = 16;
constexpr float RMS_EPS = 1e-6f;

constexpr size_t MiB = 1u << 20;
constexpr size_t WS_CTL = 0, CTL_ZERO_BYTES = 1 * MiB;
constexpr size_t WS_WT1 = 2 * MiB, WS_WT2 = 13 * MiB, WS_WT3 = 19 * MiB, WS_WT4 = 27 * MiB, WS_WT5 = 38 * MiB;
constexpr size_t WS_WGLU = 44 * MiB, WS_WA = 45 * MiB, WS_WB = 46 * MiB, WS_WOUT = 47 * MiB;
constexpr size_t WS_KS = 50 * MiB, WS_KO = 58 * MiB, WS_KI = 66 * MiB;
constexpr size_t WS_META = 67 * MiB;
constexpr size_t MO_AM1 = 0, MO_ACTM = 32768, MO_FM = 131072, MO_AM2 = 262144, MO_PMU = 294912, MO_PMK = 311296;
constexpr size_t WS_HN = 68 * MiB;
constexpr size_t WS_F = 132 * MiB;
constexpr size_t WS_BIG = 196 * MiB;
constexpr size_t WS_PA = WS_BIG, WS_PG = WS_BIG + 96 * MiB, WS_PK = WS_BIG + 224 * MiB, WS_HB = WS_BIG + 240 * MiB  , WS_END = WS_BIG + 304 * MiB;
constexpr size_t WS_UA2 = WS_F + 32 * MiB;
constexpr int CW_BAR = 4096;

constexpr int LDS_BYTES = 155648;
constexpr int MISC_OFF = 154624;

#define GAS __attribute__((address_space(1)))
#define LAS __attribute__((address_space(3)))
typedef unsigned short bf16;
typedef unsigned v4u __attribute__((ext_vector_type(4)));
typedef unsigned v2u __attribute__((ext_vector_type(2)));
typedef float f32x4 __attribute__((ext_vector_type(4)));
typedef short bf16x8 __attribute__((ext_vector_type(8)));
#define LDS_WAIT() asm volatile("s_waitcnt lgkmcnt(0)" ::: "memory")
#define VM_WAIT() asm volatile("s_waitcnt vmcnt(0)" ::: "memory")
__device__ __forceinline__ unsigned f2bf(float f) { unsigned u = __builtin_bit_cast(unsigned, f); return (u + 0x7fffu + ((u >> 16) & 1u)) >> 16; }
__device__ __forceinline__ unsigned pk2(float lo, float hi) { return f2bf(lo) | (f2bf(hi) << 16); }
__device__ __forceinline__ float bflo(unsigned w) { return __uint_as_float(w << 16); }
__device__ __forceinline__ float bfhi(unsigned w) { return __uint_as_float(w & 0xffff0000u); }
__device__ __forceinline__ float bf2f(bf16 v) { return __uint_as_float(((unsigned)v) << 16); }
__device__ __forceinline__ float fsig(float x) { return __builtin_amdgcn_rcpf(1.0f + __expf(-x)); }

#define XB_TMO      128
#define XB_XCNT(j)  (256  + 64 * (j))
#define XB_XSUB(j)  (1280 + 64 * (j))
#define XB_XGEN(j)  (2304 + 64 * (j))
#define XB_TOP      3328
#define XB_TOPGEN   3392
#define XCD_BAR_WORDS 3456
#define XB_SPIN_CAP (1u << 18)
__device__ __forceinline__ unsigned xb_ld(unsigned* p)              { return __hip_atomic_load(p, __ATOMIC_RELAXED, __HIP_MEMORY_SCOPE_AGENT); }
__device__ __forceinline__ unsigned xb_add(unsigned* p, unsigned v) { return __hip_atomic_fetch_add(p, v, __ATOMIC_RELAXED, __HIP_MEMORY_SCOPE_AGENT); }
__device__ __forceinline__ unsigned xb_xcc_id() { return (unsigned)__builtin_amdgcn_s_getreg((3 << 11) | 20) & 0xFu; }
#define XB_SPIN(cond, bar) do { unsigned _sp = 0; while (cond) { __builtin_amdgcn_s_sleep(1); \
    if ((++_sp & 255u) == 0u) { if (xb_ld(&(bar)[XB_TMO])) break; if (_sp > XB_SPIN_CAP) { atomicAdd(&(bar)[XB_TMO], 1u); break; } } } } while (0)
struct XcdBarrier { unsigned* bar; unsigned x; volatile LAS unsigned* st; };
__device__ __forceinline__ XcdBarrier xcd_barrier_post(unsigned* bar, volatile LAS unsigned* st) {
    XcdBarrier b; b.bar = bar; b.x = xb_xcc_id(); b.st = st;
    if (threadIdx.x == 0) (void)xb_add(&bar[XB_XCNT(b.x)], 1u);
    return b;
}
__device__ __forceinline__ void xcd_barrier_complete(unsigned* bar, unsigned x, unsigned& nloc, unsigned& nx) {
    const unsigned G = gridDim.x * gridDim.y * gridDim.z;
    unsigned sum, cnt, mine, sp = 0u;
    for (;;) {
        sum = 0u; cnt = 0u; mine = 0u;
#pragma unroll
        for (unsigned j = 0; j < 16; ++j) { const unsigned c = xb_ld(&bar[XB_XCNT(j)]); sum += c; cnt += (c > 0u) ? 1u : 0u; mine = (j == x) ? c : mine; }
        if (sum == G) break;
        __builtin_amdgcn_s_sleep(1);
        if ((++sp & 255u) == 0u) { if (xb_ld(&bar[XB_TMO])) break; if (sp > XB_SPIN_CAP) { atomicAdd(&bar[XB_TMO], 1u); break; } }
    }
    nloc = mine > 0u ? mine : 1u; nx = cnt > 0u ? cnt : 1u;
}
__device__ __forceinline__ void xcd_barrier(const XcdBarrier& b) {
    asm volatile("s_waitcnt vmcnt(0)" ::: "memory");
    __syncthreads();
    if (threadIdx.x == 0) {
        unsigned* bar = b.bar;
        __builtin_amdgcn_s_waitcnt(0);
        unsigned nloc = b.st[0], nx = b.st[1];
        if (nloc == 0u) { xcd_barrier_complete(bar, b.x, nloc, nx); b.st[0] = nloc; b.st[1] = nx; }
        const unsigned old = xb_add(&bar[XB_XSUB(b.x)], 1u);
        const unsigned gen = old / nloc;
        if (old + 1u == (gen + 1u) * nloc) {
            __builtin_amdgcn_fence(__ATOMIC_RELEASE, "agent");
            asm volatile("s_waitcnt vmcnt(0)" ::: "memory");
            const unsigned og = xb_add(&bar[XB_TOP], 1u);
            const unsigned tg = og / nx;
            if (og + 1u == (tg + 1u) * nx) xb_add(&bar[XB_TOPGEN], 1u);
            else XB_SPIN(xb_ld(&bar[XB_TOPGEN]) == tg, bar);
            __builtin_amdgcn_fence(__ATOMIC_ACQUIRE, "agent");
            xb_add(&bar[XB_XGEN(b.x)], 1u);
            asm volatile("s_waitcnt vmcnt(0)" ::: "memory");
        } else {
            XB_SPIN(xb_ld(&bar[XB_XGEN(b.x)]) == gen, bar);
            __builtin_amdgcn_fence(__ATOMIC_ACQUIRE, "agent");
            asm volatile("s_waitcnt vmcnt(0)" ::: "memory");
        }
    }
    __syncthreads();
}

__device__ __forceinline__ float wave_sum(float v) {
#pragma unroll
    for (int o = 1; o < 64; o <<= 1) v += __shfl_xor(v, o);
    return v;
}
__device__ __forceinline__ f32x4 mfma16(bf16x8 a, bf16x8 b, f32x4 c) { return __builtin_amdgcn_mfma_f32_16x16x32_bf16(a, b, c, 0, 0, 0); }

__device__ __forceinline__ void transpose_item(const float* W, int Nsrc, int K, bf16* WT, int k0, int drow0, int srccol, LAS float* scr, int lane, const float* gk = nullptr) {
#pragma unroll 8
    for (int i = 0; i < 32; ++i) { const int kk = 2 * i + (lane >> 5); float wv_ = (srccol >= 0) ? W[(size_t)(k0 + kk) * Nsrc + srccol] : 0.f; if (gk) wv_ *= gk[k0 + kk]; scr[kk * 33 + (lane & 31)] = wv_; }
    LDS_WAIT(); asm volatile("" ::: "memory");
    const int c = lane & 7;
#pragma unroll
    for (int j = 0; j < 4; ++j) { const int n = (lane >> 3) + 8 * j; const LAS float* s = scr + (8 * c) * 33 + n;
        v4u o; o.x = pk2(s[0 * 33], s[1 * 33]); o.y = pk2(s[2 * 33], s[3 * 33]); o.z = pk2(s[4 * 33], s[5 * 33]); o.w = pk2(s[6 * 33], s[7 * 33]);
        *(v4u*)(WT + (size_t)(drow0 + n) * K + k0 + 8 * c) = o; }
    LDS_WAIT(); asm volatile("" ::: "memory");
}

__device__ __forceinline__ unsigned pk4q(float a, float b, float c, float d) { int w = 0; w = __builtin_amdgcn_cvt_pk_fp8_f32(fminf(fmaxf(a, -448.f), 448.f), fminf(fmaxf(b, -448.f), 448.f), w, false);
    w = __builtin_amdgcn_cvt_pk_fp8_f32(fminf(fmaxf(c, -448.f), 448.f), fminf(fmaxf(d, -448.f), 448.f), w, true); return (unsigned)w; }
__device__ __forceinline__ void transpose_item8(const float* W, int Nsrc, int K, unsigned char* WT8, int k0, int drow0, int srccol, LAS float* scr, int lane) {
#pragma unroll 8
    for (int i = 0; i < 32; ++i) { const int kk = 2 * i + (lane >> 5); scr[kk * 33 + (lane & 31)] = W[(size_t)(k0 + kk) * Nsrc + srccol] * 64.0f; }
    LDS_WAIT(); asm volatile("" ::: "memory");
    const int c = lane & 7;
#pragma unroll
    for (int j = 0; j < 4; ++j) { const int n = (lane >> 3) + 8 * j; const LAS float* sp = scr + (8 * c) * 33 + n;
        v2u o; o.x = pk4q(sp[0 * 33], sp[1 * 33], sp[2 * 33], sp[3 * 33]); o.y = pk4q(sp[4 * 33], sp[5 * 33], sp[6 * 33], sp[7 * 33]);
        *(v2u*)(WT8 + (size_t)(drow0 + n) * K + k0 + 8 * c) = o; }
    LDS_WAIT(); asm volatile("" ::: "memory");
}
__device__ __forceinline__ int win_srccol(int d) {
    if (d < 1024) return d;
    if (d < 1536) return 1096 + (d - 1024);
    if (d < 3584) return 1736 + (d - 1536);
    if (d < 3648) return 1024 + (d - 3584);
    if (d < 3712) return 1608 + (d - 3648);
    if (d < 3776) return 1672 + (d - 3712);
    if (d < 3784) return 1088 + (d - 3776);
    return -1;
}
__device__ __forceinline__ void norm_row_to_bf16(const float* xrow, const float* g, bf16* orow, int lane) {
    f32x4 v[4]; float ss = 0.f;
#pragma unroll
    for (int j = 0; j < 4; ++j) { v[j] = ((const f32x4*)xrow)[lane + 64 * j]; ss += (v[j].x * v[j].x + v[j].y * v[j].y) + (v[j].z * v[j].z + v[j].w * v[j].w); }
    const float rs = rsqrtf(wave_sum(ss) * (1.f / D) + RMS_EPS);
#pragma unroll
    for (int j = 0; j < 4; ++j) { const f32x4 gv = ((const f32x4*)g)[lane + 64 * j]; v2u o; o.x = pk2(v[j].x * rs * gv.x, v[j].y * rs * gv.y); o.y = pk2(v[j].z * rs * gv.z, v[j].w * rs * gv.w);
        ((v2u*)orow)[lane + 64 * j] = o; }
}
template <bool PRESCALE>
__device__ __forceinline__ void x_row_to_bf16(const float* xrow, bf16* orow, float* rs_out, int lane) {
    f32x4 v[4]; float ss = 0.f;
#pragma unroll
    for (int j = 0; j < 4; ++j) { v[j] = ((const f32x4*)xrow)[lane + 64 * j]; ss += (v[j].x * v[j].x + v[j].y * v[j].y) + (v[j].z * v[j].z + v[j].w * v[j].w); }
    const float rs = rsqrtf(wave_sum(ss) * (1.f / D) + RMS_EPS), pre = PRESCALE ? rs : 1.0f;
#pragma unroll
    for (int j = 0; j < 4; ++j) { v2u o; o.x = pk2(v[j].x * pre, v[j].y * pre); o.y = pk2(v[j].z * pre, v[j].w * pre); ((v2u*)orow)[lane + 64 * j] = o; }
    if (rs_out && lane == 0) *rs_out = rs;
}
template <bool BASE_BF16, bool OUT_BF16, bool HN_F8 = false>
__device__ __forceinline__ void row_update(const bf16* frow, const void* base, void* outrow, bf16* hnrow, const float* gpost, const float* gnext, float scale, int lane, float* rs_out = nullptr) {
    f32x4 f[4], h[4]; float ss = 0.f;
#pragma unroll
    for (int j = 0; j < 4; ++j) { const v2u w = ((const v2u*)frow)[lane + 64 * j]; f[j] = (f32x4){bflo(w.x), bfhi(w.x), bflo(w.y), bfhi(w.y)};
        ss += (f[j].x * f[j].x + f[j].y * f[j].y) + (f[j].z * f[j].z + f[j].w * f[j].w); }
    const float rs = rsqrtf(wave_sum(ss) * (1.f / D) + RMS_EPS) * scale; float s2 = 0.f;
#pragma unroll
    for (int j = 0; j < 4; ++j) { const f32x4 gv = ((const f32x4*)gpost)[lane + 64 * j]; f32x4 bv;
        if (BASE_BF16) { const v2u w = ((const v2u*)base)[lane + 64 * j]; bv = (f32x4){bflo(w.x), bfhi(w.x), bflo(w.y), bfhi(w.y)}; } else bv = ((const f32x4*)base)[lane + 64 * j];
        h[j] = bv + f[j] * rs * gv; s2 += (h[j].x * h[j].x + h[j].y * h[j].y) + (h[j].z * h[j].z + h[j].w * h[j].w); }
    if (outrow) {
#pragma unroll
        for (int j = 0; j < 4; ++j) { if (OUT_BF16) { v2u o; o.x = pk2(h[j].x, h[j].y); o.y = pk2(h[j].z, h[j].w); ((v2u*)outrow)[lane + 64 * j] = o; } else ((f32x4*)outrow)[lane + 64 * j] = h[j]; } }
    if (hnrow || rs_out) { const float r2 = rsqrtf(wave_sum(s2) * (1.f / D) + RMS_EPS); if (rs_out && lane == 0) *rs_out = r2;
        if (hnrow)
#pragma unroll
        for (int j = 0; j < 4; ++j) { const f32x4 gv = gnext ? ((const f32x4*)gnext)[lane + 64 * j] : (f32x4){1.f, 1.f, 1.f, 1.f};
            if (HN_F8) { const float q = 4.0f * r2; ((unsigned*)hnrow)[lane + 64 * j] = pk4q(h[j].x * q * gv.x, h[j].y * q * gv.y, h[j].z * q * gv.z, h[j].w * q * gv.w); }
            else { v2u o; o.x = pk2(h[j].x * r2 * gv.x, h[j].y * r2 * gv.y); o.y = pk2(h[j].z * r2 * gv.z, h[j].w * r2 * gv.w); ((v2u*)hnrow)[lane + 64 * j] = o; } } }
}
__device__ __forceinline__ f32x4 meta_tile(const bf16* A, const bf16* B, int K, int lane) {
    const int fr = lane & 15, kq = lane >> 4; const bf16* ap = A + (size_t)fr * K + 8 * kq; const bf16* bp = B + (size_t)fr * K + 8 * kq;
    f32x4 acc = (f32x4){0.f, 0.f, 0.f, 0.f};
#pragma unroll 4
    for (int k = 0; k < K; k += 32) { const bf16x8 a = *(const bf16x8*)(ap + k); const bf16x8 b = *(const bf16x8*)(bp + k); acc = mfma16(a, b, acc); }
    return acc;
}


template <int STEPS>
__device__ __forceinline__ void meta_tile_blk(const bf16* A, const bf16* B0, const bf16* B1, int K, LAS float* red, int wave, int lane, f32x4& c0, f32x4& c1) {
    const int fr = lane & 15, kq = lane >> 4, k0 = wave * (32 * STEPS);
    const bf16* ap = A + (size_t)fr * K + k0 + 8 * kq; const bf16* bp0 = B0 + (size_t)fr * K + k0 + 8 * kq; const bf16* bp1 = (B1 ? B1 : B0) + (size_t)fr * K + k0 + 8 * kq;
    bf16x8 av[STEPS], bv0[STEPS], bv1[STEPS];
#pragma unroll
    for (int i = 0; i < STEPS; ++i) { av[i] = *(const bf16x8*)(ap + 32 * i); bv0[i] = *(const bf16x8*)(bp0 + 32 * i); bv1[i] = *(const bf16x8*)(bp1 + 32 * i); }
    f32x4 a0 = (f32x4){0.f, 0.f, 0.f, 0.f}, a1 = a0;
#pragma unroll
    for (int i = 0; i < STEPS; ++i) { a0 = mfma16(av[i], bv0[i], a0); a1 = mfma16(av[i], bv1[i], a1); }
    *(LAS f32x4*)(red + (wave * 64 + lane) * 8) = a0; *(LAS f32x4*)(red + (wave * 64 + lane) * 8 + 4) = a1;
    __syncthreads();
    c0 = (f32x4){0.f, 0.f, 0.f, 0.f}; c1 = c0;
#pragma unroll
    for (int w2 = 0; w2 < 8; ++w2) { c0 += *(const LAS f32x4*)(red + (w2 * 64 + lane) * 8); c1 += *(const LAS f32x4*)(red + (w2 * 64 + lane) * 8 + 4); }
    __syncthreads();
}

struct Args { const float* in[28]; float* out; unsigned char* ws; int ph_lo, ph_hi; };

__device__ __forceinline__ void s5_tables_block(const Args& a, int g, int oct, LAS float* sc, int tid) {
    const float* lam_re = a.in[15]; const float* lam_im = a.in[16]; const float* log_dt = a.in[17];
    const float* b_re = a.in[18]; const float* b_im = a.in[19]; const float* c_re = a.in[20]; const float* c_im = a.in[21]; const float* dsk = a.in[22];
    LAS float* CR = sc; LAS float* CI = sc + 1024; LAS float* BR = sc + 2048; LAS float* BI = sc + 3072;
    LAS float* ANG = sc + 4096; LAS float* LRDT = sc + 4160; LAS float* CFR = sc + 4224; LAS float* CFI = sc + 4288;
    LAS float* WR = sc + 4352; LAS float* WI = sc + 4864;
    __syncthreads();
#pragma unroll
    for (int k = 0; k < 2; ++k) { const int e = tid + 512 * k; CR[e] = c_re[g * 1024 + e]; CI[e] = c_im[g * 1024 + e]; BR[e] = b_re[g * 1024 + e]; BI[e] = b_im[g * 1024 + e]; }
    if (tid < 64) { const int p = tid; const float lr = lam_re[g * 64 + p], li = lam_im[g * 64 + p], dt = expf(log_dt[g]);
        const float ang = li * dt, mag = expf(lr * dt); float s1, c1; sincosf(ang, &s1, &c1);
        const float a_re = mag * c1, a_im = mag * s1, den = lr * lr + li * li, nr = a_re - 1.0f, ni = a_im;
        ANG[p] = ang; LRDT[p] = lr * dt; CFR[p] = (nr * lr + ni * li) / den; CFI[p] = (ni * lr - nr * li) / den; }
    __syncthreads();
    const int ti = tid >> 6, p64 = tid & 63, idx0 = 8 * oct;
    { const float n = (float)(idx0 + ti); float sn, cn; sincosf(n * ANG[p64], &sn, &cn); const float mn = expf(n * LRDT[p64]); const float pr = mn * cn, pi = mn * sn;
      WR[tid] = pr * CFR[p64] - pi * CFI[p64]; WI[tid] = pr * CFI[p64] + pi * CFR[p64]; }
    __syncthreads();
#pragma unroll
    for (int k = 0; k < 4; ++k) { const int e = tid + 512 * k, t8 = e >> 8, m = (e >> 4) & 15, mp = e & 15; float s = 0.f;
        for (int p = 0; p < 64; ++p) { const float wr_ = WR[t8 * 64 + p], wi_ = WI[t8 * 64 + p], br = BR[p * 16 + mp], bi = BI[p * 16 + mp];
            const float zr = wr_ * br - wi_ * bi, zi = wr_ * bi + wi_ * br; s += CR[m * 64 + p] * zr - CI[m * 64 + p] * zi; }
        if (idx0 + t8 == 0 && m == mp) s += dsk[g * 16 + m];
        ((bf16*)(a.ws + WS_KI))[((g * 64 + idx0 + t8) * 16 + m) * 16 + mp] = (bf16)f2bf(s); }
    __syncthreads();
    { const float n = (float)(63 - (idx0 + ti)); float sn, cn; sincosf(n * ANG[p64], &sn, &cn); const float mn = expf(n * LRDT[p64]); const float pr = mn * cn, pi = mn * sn;
      WR[tid] = pr * CFR[p64] - pi * CFI[p64]; WI[tid] = pr * CFI[p64] + pi * CFR[p64]; }
    __syncthreads();
    for (int k = 0; k < 32; ++k) { const int e = tid + 512 * k, t8 = e >> 11, n_ = (e >> 4) & 127, mp = e & 15, p = n_ & 63;
        const float wr_ = WR[t8 * 64 + p], wi_ = WI[t8 * 64 + p], br = BR[p * 16 + mp], bi = BI[p * 16 + mp];
        const float zr = wr_ * br - wi_ * bi, zi = wr_ * bi + wi_ * br;
        ((bf16*)(a.ws + WS_KS))[((size_t)(g * 64 + idx0 + t8) * 128 + n_) * 16 + mp] = (bf16)f2bf(n_ < 64 ? zr : zi); }
    __syncthreads();
    { const float n = (float)(idx0 + ti + 1); float sn, cn; sincosf(n * ANG[p64], &sn, &cn); const float mn = expf(n * LRDT[p64]); WR[tid] = mn * cn; WI[tid] = mn * sn; }
    __syncthreads();
    for (int k = 0; k < 32; ++k) { const int e = tid + 512 * k, t8 = e >> 11, m = (e >> 7) & 15, kk = e & 127, p = kk & 63;
        const float cr = CR[m * 64 + p], ci = CI[m * 64 + p], ar_ = WR[t8 * 64 + p], ai_ = WI[t8 * 64 + p];
        const float wr_ = cr * ar_ - ci * ai_, wi_ = cr * ai_ + ci * ar_;
        ((bf16*)(a.ws + WS_KO))[((size_t)(g * 64 + idx0 + t8) * 16 + m) * 128 + kk] = (bf16)f2bf(kk < 64 ? wr_ : -wi_); }
}

constexpr int S5_U = 0, S5_USTR = 2064, S5_KI = 66048, S5_SLOC = 98816, S5_XINB = 115200, S5_XSTR = 272, S5_MISC = 123904;
__device__ __forceinline__ float gelu_tanh(float x) { const float z = 0.7978845608028654f * (x + 0.044715f * x * x * x); return x * fsig(2.0f * z); }
__device__ __forceinline__ void s5_meta(const Args& a, LAS unsigned char* L, int g, int tid) {
    const int lane = tid & 63; const bf16* PMU = (const bf16*)(a.ws + WS_META + MO_PMU); LAS float* MS = (LAS float*)(L + S5_MISC);
    if (tid < 64) { const int p = lane; const float lr = a.in[15][g * 64 + p], li = a.in[16][g * 64 + p], dt = expf(a.in[17][g]);
        const float ang = li * dt, mag = expf(lr * dt); float s1, c1; sincosf(ang, &s1, &c1);
        const float a_re = mag * c1, a_im = mag * s1, den = lr * lr + li * li, nr = a_re - 1.0f, ni = a_im;
        const float cf_re = (nr * lr + ni * li) / den, cf_im = (ni * lr - nr * li) / den;
        float bb_re[16], bb_im[16];
#pragma unroll
        for (int m = 0; m < 16; ++m) { const float br = a.in[18][(g * 64 + p) * 16 + m], bi = a.in[19][(g * 64 + p) * 16 + m]; bb_re[m] = cf_re * br - cf_im * bi; bb_im[m] = cf_re * bi + cf_im * br; }
        LAS bf16* UM = (LAS bf16*)(L + S5_MISC + 1024);
        if (lane < 32) *(LAS v4u*)(UM + lane * 8) = *(const v4u*)(PMU + (lane >> 1) * 512 + 16 * g + 8 * (lane & 1));
        LDS_WAIT();
        float xr = 0.f, xi = 0.f;
#pragma unroll
        for (int i = 0; i < 16; ++i) { float ur = 0.f, ui = 0.f; const v4u w0 = *(const LAS v4u*)(UM + i * 16), w1 = *(const LAS v4u*)(UM + i * 16 + 8);
            const float uu[16] = {bflo(w0.x), bfhi(w0.x), bflo(w0.y), bfhi(w0.y), bflo(w0.z), bfhi(w0.z), bflo(w0.w), bfhi(w0.w), bflo(w1.x), bfhi(w1.x), bflo(w1.y), bfhi(w1.y), bflo(w1.z), bfhi(w1.z), bflo(w1.w), bfhi(w1.w)};
#pragma unroll
            for (int m = 0; m < 16; ++m) { ur += bb_re[m] * uu[m]; ui += bb_im[m] * uu[m]; }
            const float nr2 = a_re * xr - a_im * xi + ur, ni2 = a_re * xi + a_im * xr + ui; xr = nr2; xi = ni2; }
        float s64, c64; sincosf(64.0f * ang, &s64, &c64); const float m64 = expf(64.0f * lr * dt);
        MS[p] = xr; MS[64 + p] = xi; MS[128 + p] = m64 * c64; MS[192 + p] = m64 * s64; }
}
__device__ __forceinline__ void s5_unit(const Args& a, LAS unsigned char* L, int b, int g, int tid) {
    const int lane = tid & 63, w = __builtin_amdgcn_readfirstlane(tid >> 6), fr = lane & 15, kq = lane >> 4;
    const bf16* UA2 = (const bf16*)(a.ws + WS_UA2) + (size_t)(b * 32 + g) * 2048 * 16;
    const bf16* KS = (const bf16*)(a.ws + WS_KS); const bf16* KO = (const bf16*)(a.ws + WS_KO); const bf16* KI = (const bf16*)(a.ws + WS_KI);
    bf16* YA = (bf16*)(a.ws + WS_F);
    LAS float* SLOC = (LAS float*)(L + S5_SLOC); LAS float* MS = (LAS float*)(L + S5_MISC);
    __syncthreads();
#pragma unroll
    for (int k = 0; k < 8; ++k) { const int idx = tid + 512 * k, t = idx >> 1, hf = idx & 1;
        const v4u v = *(const v4u*)(UA2 + (size_t)idx * 8);
        *(LAS v4u*)(L + S5_U + (t >> 6) * S5_USTR + (t & 63) * 32 + 16 * hf) = v; }
#pragma unroll
    for (int k = 0; k < 4; ++k) { const int idx = tid + 512 * k; *(LAS v4u*)(L + S5_KI + idx * 16) = *(const v4u*)(KI + (size_t)g * 16384 + idx * 8); }
    bf16x8 bfr[16];
#pragma unroll
    for (int k = 0; k < 16; ++k) { const int i = 2 * k + (kq >> 1); bfr[k] = *(const bf16x8*)(KS + ((size_t)(g * 64 + i) * 128 + 16 * w + fr) * 16 + 8 * (kq & 1)); }
    __syncthreads();
    { f32x4 acc0 = (f32x4){0.f, 0.f, 0.f, 0.f}, acc1 = acc0;
#pragma unroll
      for (int hb = 0; hb < 2; ++hb) {
          if (hb == 1) {
#pragma unroll
              for (int k = 0; k < 16; ++k) { const int i = 2 * (16 + k) + (kq >> 1); bfr[k] = *(const bf16x8*)(KS + ((size_t)(g * 64 + i) * 128 + 16 * w + fr) * 16 + 8 * (kq & 1)); } }
#pragma unroll
          for (int k = 0; k < 16; ++k) { const int ks = 16 * hb + k;
              const bf16x8 a0 = *(const LAS bf16x8*)(L + S5_U + fr * S5_USTR + (32 * ks + 8 * kq) * 2);
              const bf16x8 a1 = *(const LAS bf16x8*)(L + S5_U + (16 + fr) * S5_USTR + (32 * ks + 8 * kq) * 2);
              acc0 = mfma16(a0, bfr[k], acc0); acc1 = mfma16(a1, bfr[k], acc1); } }
#pragma unroll
      for (int r = 0; r < 4; ++r) { SLOC[(4 * kq + r) * 128 + 16 * w + fr] = acc0[r]; SLOC[(16 + 4 * kq + r) * 128 + 16 * w + fr] = acc1[r]; } }
    bf16x8 ko[4];
#pragma unroll
    for (int ks = 0; ks < 4; ++ks) ko[ks] = *(const bf16x8*)(KO + ((size_t)(g * 64 + w) * 16 + fr) * 128 + 32 * ks + 8 * kq);
    __syncthreads();
    if (w == 0) { const int p = lane; float sr[32], si[32];
#pragma unroll
        for (int c = 0; c < 32; ++c) { sr[c] = SLOC[c * 128 + p]; si[c] = SLOC[c * 128 + 64 + p]; }
        float xr = MS[p], xi = MS[64 + p]; const float ar = MS[128 + p], ai = MS[192 + p];
#pragma unroll
        for (int c = 0; c < 32; ++c) { *(LAS bf16*)(L + S5_XINB + c * S5_XSTR + p * 2) = (bf16)f2bf(xr); *(LAS bf16*)(L + S5_XINB + c * S5_XSTR + (64 + p) * 2) = (bf16)f2bf(xi);
            const float nr2 = ar * xr - ai * xi + sr[c], ni2 = ar * xi + ai * xr + si[c]; xr = nr2; xi = ni2; } }
    __syncthreads();
    for (int jj = 0; jj < 8; ++jj) { const int j = w + 8 * jj;
        bf16x8 kon[4];
#pragma unroll
        for (int ks = 0; ks < 4; ++ks) kon[ks] = ko[ks];
        if (jj < 7) {
#pragma unroll
            for (int ks = 0; ks < 4; ++ks) kon[ks] = *(const bf16x8*)(KO + ((size_t)(g * 64 + j + 8) * 16 + fr) * 128 + 32 * ks + 8 * kq); }
        f32x4 acc0 = (f32x4){0.f, 0.f, 0.f, 0.f}, acc1 = acc0;
#pragma unroll
        for (int ks = 0; ks < 4; ++ks) {
            const bf16x8 a0 = *(const LAS bf16x8*)(L + S5_XINB + fr * S5_XSTR + (32 * ks + 8 * kq) * 2);
            const bf16x8 a1 = *(const LAS bf16x8*)(L + S5_XINB + (16 + fr) * S5_XSTR + (32 * ks + 8 * kq) * 2);
            acc0 = mfma16(a0, ko[ks], acc0); acc1 = mfma16(a1, ko[ks], acc1); }
        const int nks = (j >> 1) + 1;
#pragma unroll 2
        for (int ks = 0; ks < nks; ++ks) { const int i = 2 * ks + (kq >> 1), tau = j - i;
            bf16x8 bq = *(const LAS bf16x8*)(L + S5_KI + (((tau < 0 ? 0 : tau) * 16 + fr) * 16 + 8 * (kq & 1)) * 2);
            if (tau < 0) bq = (bf16x8){0, 0, 0, 0, 0, 0, 0, 0};
            const bf16x8 a0 = *(const LAS bf16x8*)(L + S5_U + fr * S5_USTR + (32 * ks + 8 * kq) * 2);
            const bf16x8 a1 = *(const LAS bf16x8*)(L + S5_U + (16 + fr) * S5_USTR + (32 * ks + 8 * kq) * 2);
            acc0 = mfma16(a0, bq, acc0); acc1 = mfma16(a1, bq, acc1); }
#pragma unroll
        for (int r = 0; r < 4; ++r) { const int c0 = 4 * kq + r, c1 = 16 + 4 * kq + r;
            YA[(size_t)(b * 2048 + 64 * c0 + j) * 512 + 16 * g + fr] = (bf16)f2bf(gelu_tanh(acc0[r]));
            YA[(size_t)(b * 2048 + 64 * c1 + j) * 512 + 16 * g + fr] = (bf16)f2bf(gelu_tanh(acc1[r])); }
#pragma unroll
        for (int ks = 0; ks < 4; ++ks) ko[ks] = kon[ks]; }
}

constexpr int DS_SSTR = 2120, DS_TSTR = 144, DS_BUF = 18432  , DS_BT = 36864  , DS_HIST = 135680, DS_MASK = 143872, DS_RB = 152576, DS_TB = 153600;
typedef short s16x4 __attribute__((ext_vector_type(4)));
__device__ __forceinline__ s16x4 tr_read(unsigned addr) { s16x4 r; asm volatile("ds_read_b64_tr_b16 %0, %1" : "=&v"(r) : "v"(addr) : "memory"); return r; }
__device__ __forceinline__ float relu_i(float x) { const int i = __builtin_bit_cast(int, x); return __builtin_bit_cast(float, i > 0 ? i : 0); }
__device__ __forceinline__ unsigned f16key(float f) { const _Float16 hf = (_Float16)f; const unsigned h = (unsigned)__builtin_bit_cast(unsigned short, hf); return (h & 0x8000u) ? (~h & 0xffffu) : (h | 0x8000u); }
__device__ __forceinline__ unsigned cvtpk(float lo, float hi) { unsigned r; asm volatile("v_cvt_pk_bf16_f32 %0, %1, %2" : "=v"(r) : "v"(lo), "v"(hi)); return r; }
__device__ __forceinline__ void dsa_tables(const Args& a, LAS unsigned char* L, int tid) {
    if (tid < 256) { ((LAS float*)(L + DS_RB))[tid] = a.in[25][tid] * 1.44269504f;
        const int n = tid; const int lo = n < 8 ? n : (n < 12 ? 8 : n < 16 ? 9 : n < 23 ? 10 : n < 32 ? 11 : n < 46 ? 12 : n < 64 ? 13 : n < 91 ? 14 : 15);
        ((LAS int*)(L + DS_TB))[tid] = lo; }
}

__device__ __forceinline__ int wave_incl_scan(int x) {
    int v = x;
    v += __builtin_amdgcn_update_dpp(0, v, 0x111, 0xf, 0xf, false);
    v += __builtin_amdgcn_update_dpp(0, v, 0x112, 0xf, 0xf, false);
    v += __builtin_amdgcn_update_dpp(0, v, 0x114, 0xf, 0xf, false);
    v += __builtin_amdgcn_update_dpp(0, v, 0x118, 0xf, 0xf, false);
    v += __builtin_amdgcn_update_dpp(0, v, 0x142, 0xa, 0xf, false);
    v += __builtin_amdgcn_update_dpp(0, v, 0x143, 0xc, 0xf, false);
    return v;
}
template <int NE>
__device__ __forceinline__ void dsa_select(LAS unsigned char* L, int c, int nt64, int w, int lane) {
    LAS unsigned short* S16 = (LAS unsigned short*)L; LAS unsigned long long* MASK = (LAS unsigned long long*)(L + DS_MASK);
    LAS unsigned* H = (LAS unsigned*)(L + DS_HIST) + w * 256;
    const int rl = 63 - lane;
    for (int qq = 0; qq < 4; ++qq) { const int q = 4 * w + qq; const LAS unsigned short* Sq = S16 + q * DS_SSTR; unsigned tkey = 0u;
        unsigned kr[NE];
#pragma unroll
        for (int e = 0; e < NE; ++e) kr[e] = (unsigned)Sq[64 * e + lane];
        if (c >= 4) { unsigned prefix = 0u; int kth = 256;
#pragma unroll
            for (int pass = 0; pass < 2; ++pass) {
                H[lane] = 0u; H[lane + 64] = 0u; H[lane + 128] = 0u; H[lane + 192] = 0u; LDS_WAIT();
#pragma unroll
                for (int e = 0; e < NE; ++e) { const unsigned key = kr[e]; const bool in = (pass == 0) ? (key != 0u) : ((key >> 8) == prefix);
                    if (in) (void)__hip_atomic_fetch_add(&H[pass == 0 ? (key >> 8) : (key & 255u)], 1u, __ATOMIC_RELAXED, __HIP_MEMORY_SCOPE_WORKGROUP); }
                LDS_WAIT();
                const unsigned h0 = H[4 * rl], h1 = H[4 * rl + 1], h2 = H[4 * rl + 2], h3 = H[4 * rl + 3]; const int t = (int)(h0 + h1 + h2 + h3);
                const int sfx = wave_incl_scan(t), above = sfx - t; const bool has = (above < kth) && (above + t >= kth);
                const unsigned long long bm = __ballot(has); const int src = bm ? (__ffsll((long long)bm) - 1) : 0;
                int cum = above, B; if (cum + (int)h3 >= kth) B = 3; else { cum += (int)h3; if (cum + (int)h2 >= kth) B = 2; else { cum += (int)h2; if (cum + (int)h1 >= kth) B = 1; else { cum += (int)h1; B = 0; } } }
                const int bin = __builtin_amdgcn_readlane(4 * rl + B, src); kth = __builtin_amdgcn_readlane(kth - cum, src);
                prefix = (prefix << 8) | (unsigned)bin; LDS_WAIT(); }
            tkey = prefix; }
        unsigned mlo = 0u, mhi = 0u;
#pragma unroll
        for (int e = 0; e < NE; ++e) { const int s = 64 * e + lane; const bool sel = ((s < 16) || (s >= 64)) && (kr[e] >= tkey);
            const unsigned long long m = __ballot(sel); mlo = (lane == e) ? (unsigned)m : mlo; mhi = (lane == e) ? (unsigned)(m >> 32) : mhi; }
        if (lane < nt64) MASK[q * 34 + lane] = ((unsigned long long)mhi << 32) | mlo; }
}
__device__ __forceinline__ void dsa_unit(const Args& a, LAS unsigned char* L, int b, int uq, int tid) {
    const int lane = tid & 63, w = __builtin_amdgcn_readfirstlane(tid >> 6), fr = lane & 15, kq = lane >> 4;
    const bf16* PA = (const bf16*)(a.ws + WS_PA); const bf16* PK = (const bf16*)(a.ws + WS_PK); const bf16* PMK = (const bf16*)(a.ws + WS_META + MO_PMK);
    bf16* YB = (bf16*)(a.ws + WS_HN) + (size_t)R * 512;
    const int c = 1 + (uq >> 1), nt64 = c + 1, qrow0 = b * 2048 + 32 * uq;
    LAS unsigned short* S16 = (LAS unsigned short*)L; LAS unsigned long long* MASK = (LAS unsigned long long*)(L + DS_MASK);
    const LAS float* RB = (const LAS float*)(L + DS_RB); const LAS int* TB = (const LAS int*)(L + DS_TB);
    __syncthreads();
    { const int qh = w >> 2; bf16x8 qa[4][2][2]; float wv[4][2][4];
#pragma unroll
      for (int p = 0; p < 4; ++p) {
#pragma unroll
          for (int hf = 0; hf < 2; ++hf)
#pragma unroll
              for (int ks = 0; ks < 2; ++ks) qa[p][hf][ks] = *(const bf16x8*)(PA + (size_t)(qrow0 + 16 * qh + 4 * p + (fr >> 2)) * 1536 + 512 + (4 * hf + (fr & 3)) * 64 + 32 * ks + 8 * kq);
          const v4u wraw = *(const v4u*)(PK + (size_t)(qrow0 + 16 * qh + 4 * p + kq) * 256 + 192);
          wv[p][0][0] = bflo(wraw.x) * 0.04419417382f; wv[p][0][1] = bfhi(wraw.x) * 0.04419417382f; wv[p][0][2] = bflo(wraw.y) * 0.04419417382f; wv[p][0][3] = bfhi(wraw.y) * 0.04419417382f;
          wv[p][1][0] = bflo(wraw.z) * 0.04419417382f; wv[p][1][1] = bfhi(wraw.z) * 0.04419417382f; wv[p][1][2] = bflo(wraw.w) * 0.04419417382f; wv[p][1][3] = bfhi(wraw.w) * 0.04419417382f; }
      const int nkt = 4 * nt64;
      { const int ner = nt64 <= 9 ? 9 : nt64 <= 17 ? 17 : nt64 <= 25 ? 25 : 33;
        for (int kz = 4 * nt64 + (w & 3); kz < 4 * ner; kz += 4) {
#pragma unroll
            for (int p = 0; p < 4; ++p) S16[(16 * qh + 4 * p + kq) * DS_SSTR + 16 * kz + fr] = (unsigned short)0; } }
      if ((w & 3) != 0) {
#pragma unroll
          for (int p = 0; p < 4; ++p) S16[(16 * qh + 4 * p + kq) * DS_SSTR + 16 * (w & 3) + fr] = (unsigned short)0; }
      int kt = (w & 3) == 0 ? 0 : (w & 3) + 4;
      bf16x8 kb0, kb1, kc0, kc1;
      { const bf16* krow = (kt == 0) ? PMK + fr * 256 : PK + (size_t)(b * 2048 + 16 * kt - 64 + fr) * 256; kb0 = *(const bf16x8*)(krow + 8 * kq); kb1 = *(const bf16x8*)(krow + 32 + 8 * kq); }
      { const int k1 = (kt == 0) ? 4 : kt + 4; kc0 = kb0; kc1 = kb1;
        if (k1 < nkt) { const bf16* krow = PK + (size_t)(b * 2048 + 16 * k1 - 64 + fr) * 256; kc0 = *(const bf16x8*)(krow + 8 * kq); kc1 = *(const bf16x8*)(krow + 32 + 8 * kq); } }
      while (kt < nkt) {
          const int ktn = (kt == 0) ? 4 : kt + 4, ktnn = ktn + 4; bf16x8 nb0 = kc0, nb1 = kc1;
          if (ktnn < nkt) { const bf16* krow = PK + (size_t)(b * 2048 + 16 * ktnn - 64 + fr) * 256; nb0 = *(const bf16x8*)(krow + 8 * kq); nb1 = *(const bf16x8*)(krow + 32 + 8 * kq); }
#pragma unroll
          for (int p = 0; p < 4; ++p) { f32x4 aA = (f32x4){0.f, 0.f, 0.f, 0.f}, aB = aA;
              aA = mfma16(qa[p][0][0], kb0, aA); aB = mfma16(qa[p][1][0], kb0, aB); aA = mfma16(qa[p][0][1], kb1, aA); aB = mfma16(qa[p][1][1], kb1, aB);
              const float v = (relu_i(aA[0]) * wv[p][0][0] + relu_i(aA[1]) * wv[p][0][1]) + (relu_i(aA[2]) * wv[p][0][2] + relu_i(aA[3]) * wv[p][0][3])
                            + (relu_i(aB[0]) * wv[p][1][0] + relu_i(aB[1]) * wv[p][1][1]) + (relu_i(aB[2]) * wv[p][1][2] + relu_i(aB[3]) * wv[p][1][3]);
              S16[(16 * qh + 4 * p + kq) * DS_SSTR + 16 * kt + fr] = (unsigned short)f16key(v); }
          kb0 = kc0; kb1 = kc1; kc0 = nb0; kc1 = nb1; kt = ktn; } }
    __syncthreads();
    bf16x8 qb[2][2]; unsigned mkoff[2];
#pragma unroll
    for (int cg = 0; cg < 2; ++cg) { const int q = 4 * w + 2 * cg + (fr >> 3), h = fr & 7; mkoff[cg] = q * 34;
#pragma unroll
        for (int ks = 0; ks < 2; ++ks) qb[cg][ks] = *(const bf16x8*)(PA + (size_t)(qrow0 + q) * 1536 + 1024 + h * 64 + 32 * ks + 8 * kq); }
    const int skey = tid >> 3, spiece = tid & 7;
    v4u kv0 = (v4u){0u, 0u, 0u, 0u}, vv0 = kv0, kv, vv;
    if (skey < 16) { const bf16* krow = PMK + skey * 256; kv0 = *(const v4u*)(krow + 64 + 8 * spiece); vv0 = *(const v4u*)(krow + 128 + 8 * spiece); }
    { const bf16* krow = PK + (size_t)(b * 2048 + skey) * 256; kv = *(const v4u*)(krow + 64 + 8 * spiece); vv = *(const v4u*)(krow + 128 + 8 * spiece); }
    if (nt64 <= 9) dsa_select<9>(L, c, nt64, w, lane);
    else if (nt64 <= 17) dsa_select<17>(L, c, nt64, w, lane);
    else if (nt64 <= 25) dsa_select<25>(L, c, nt64, w, lane);
    else dsa_select<33>(L, c, nt64, w, lane);
    __syncthreads();
    {
      const int hh = fr & 7; const float bfar = RB[15 * 8 + hh];
      float mrun[2] = {0.f, 0.f}, lrun[2] = {0.f, 0.f}; f32x4 O[2][4];
#pragma unroll
      for (int cg = 0; cg < 2; ++cg)
#pragma unroll
          for (int dt = 0; dt < 4; ++dt) O[cg][dt] = (f32x4){0.f, 0.f, 0.f, 0.f};
      const LAS float* BT = (const LAS float*)(L + DS_BT);
#pragma unroll
      for (int k = 0; k < 4; ++k) { const int e = tid + 512 * k, relc = (e >> 3) - 128, n = relc < 0 ? -relc : relc; ((LAS float*)(L + DS_BT))[e] = RB[(TB[n] + (relc > 0 ? 16 : 0)) * 8 + (e & 7)]; }
      const unsigned ldsV = (unsigned)(size_t)(L) + 9216u + (unsigned)((4 * kq + ((lane & 15) >> 2)) * DS_TSTR + 8 * (lane & 3));
      *(LAS v4u*)(L + skey * DS_TSTR + 16 * spiece) = kv0; *(LAS v4u*)(L + 9216 + skey * DS_TSTR + 16 * spiece) = vv0;
      __syncthreads();
      for (int T = 0; T < nt64; ++T) { const int buf = T & 1;
          v4u kn = kv, vn = vv;
          if (T + 2 < nt64) { const bf16* krow = PK + (size_t)(b * 2048 + 64 * (T + 1) + skey) * 256; kn = *(const v4u*)(krow + 64 + 8 * spiece); vn = *(const v4u*)(krow + 128 + 8 * spiece); }
          const bool nearT = (64 * T > 32 * uq - 90);
          f32x4 lg[2][4];
          { bf16x8 ka[4][2];
#pragma unroll
            for (int sub = 0; sub < 4; ++sub)
#pragma unroll
                for (int ks = 0; ks < 2; ++ks) ka[sub][ks] = *(const LAS bf16x8*)(L + buf * DS_BUF + fr * DS_TSTR + 16 * kq + sub * 16 * DS_TSTR + ks * 64);
#pragma unroll
            for (int cg = 0; cg < 2; ++cg)
#pragma unroll
                for (int sub = 0; sub < 4; ++sub) { f32x4 acc = (f32x4){0.f, 0.f, 0.f, 0.f}; acc = mfma16(ka[sub][0], qb[cg][0], acc); acc = mfma16(ka[sub][1], qb[cg][1], acc); lg[cg][sub] = acc; } }
          s16x4 vt[2][4][2];
#pragma unroll
          for (int cg = 0; cg < 2; ++cg) {
              const float mc = mrun[cg]; float mxl = -1.0e30f;
              if (nearT) { const int relb = ((T == 0) ? 0 : 64 * T - 48) + 4 * kq - (16 + 32 * uq + 4 * w + 2 * cg + (fr >> 3));
#pragma unroll
                  for (int sub = 0; sub < 4; ++sub)
#pragma unroll
                      for (int r = 0; r < 4; ++r) { int idx = relb + 16 * sub + r; idx = idx < -128 ? -128 : idx; idx = idx > 127 ? 127 : idx;
                          const float v = lg[cg][sub][r] * 0.18033688f + (BT[(idx + 128) * 8 + hh] - mc); lg[cg][sub][r] = v; mxl = fmaxf(mxl, v); }
              } else { const float bm = bfar - mc;
#pragma unroll
                  for (int sub = 0; sub < 4; ++sub)
#pragma unroll
                      for (int r = 0; r < 4; ++r) { const float v = lg[cg][sub][r] * 0.18033688f + bm; lg[cg][sub][r] = v; mxl = fmaxf(mxl, v); } }
              if (T == 0 || __ballot(mxl > 8.0f) != 0ull) {
                  float mx = mxl; mx = fmaxf(mx, __shfl_xor(mx, 16)); mx = fmaxf(mx, __shfl_xor(mx, 32));
                  const float delta = (T == 0) ? mx : fmaxf(mx, 0.f), sc = __builtin_amdgcn_exp2f(-delta); mrun[cg] = mc + delta; lrun[cg] *= sc;
#pragma unroll
                  for (int dt = 0; dt < 4; ++dt) O[cg][dt] = O[cg][dt] * sc;
#pragma unroll
                  for (int sub = 0; sub < 4; ++sub)
#pragma unroll
                      for (int r = 0; r < 4; ++r) lg[cg][sub][r] -= delta; }
              const unsigned long long mword = MASK[mkoff[cg] + T] >> (4 * kq); const unsigned mlo = (unsigned)mword, mhi = (unsigned)(mword >> 32); float ls = 0.f;
#pragma unroll
              for (int sub = 0; sub < 4; ++sub)
#pragma unroll
                  for (int r = 0; r < 4; ++r) { const int keep = __builtin_amdgcn_sbfe((int)(sub < 2 ? mlo : mhi), 16 * (sub & 1) + r, 1);
                      const float p = __uint_as_float(__float_as_uint(__builtin_amdgcn_exp2f(lg[cg][sub][r])) & (unsigned)keep); ls += p; lg[cg][sub][r] = p; }
              lrun[cg] += ls; }
          { const unsigned vaddr = ldsV + (unsigned)(buf * DS_BUF);
            asm volatile("ds_read_b64_tr_b16 %0, %16 offset:0\n\t"
                "ds_read_b64_tr_b16 %1, %16 offset:2304\n\t"
                "ds_read_b64_tr_b16 %2, %16 offset:32\n\t"
                "ds_read_b64_tr_b16 %3, %16 offset:2336\n\t"
                "ds_read_b64_tr_b16 %4, %16 offset:64\n\t"
                "ds_read_b64_tr_b16 %5, %16 offset:2368\n\t"
                "ds_read_b64_tr_b16 %6, %16 offset:96\n\t"
                "ds_read_b64_tr_b16 %7, %16 offset:2400\n\t"
                "ds_read_b64_tr_b16 %8, %16 offset:4608\n\t"
                "ds_read_b64_tr_b16 %9, %16 offset:6912\n\t"
                "ds_read_b64_tr_b16 %10, %16 offset:4640\n\t"
                "ds_read_b64_tr_b16 %11, %16 offset:6944\n\t"
                "ds_read_b64_tr_b16 %12, %16 offset:4672\n\t"
                "ds_read_b64_tr_b16 %13, %16 offset:6976\n\t"
                "ds_read_b64_tr_b16 %14, %16 offset:4704\n\t"
                "ds_read_b64_tr_b16 %15, %16 offset:7008\n\t"
                "s_waitcnt lgkmcnt(0)"
                : "=&v"(vt[0][0][0]), "=&v"(vt[0][0][1]), "=&v"(vt[0][1][0]), "=&v"(vt[0][1][1]), "=&v"(vt[0][2][0]), "=&v"(vt[0][2][1]), "=&v"(vt[0][3][0]), "=&v"(vt[0][3][1]), "=&v"(vt[1][0][0]), "=&v"(vt[1][0][1]), "=&v"(vt[1][1][0]), "=&v"(vt[1][1][1]), "=&v"(vt[1][2][0]), "=&v"(vt[1][2][1]), "=&v"(vt[1][3][0]), "=&v"(vt[1][3][1])
                : "v"(vaddr) : "memory"); }
#pragma unroll
          for (int ks2 = 0; ks2 < 2; ++ks2) { bf16x8 pb[2];
#pragma unroll
              for (int cg = 0; cg < 2; ++cg) { v4u pw; pw.x = cvtpk(lg[cg][2 * ks2][0], lg[cg][2 * ks2][1]); pw.y = cvtpk(lg[cg][2 * ks2][2], lg[cg][2 * ks2][3]);
                  pw.z = cvtpk(lg[cg][2 * ks2 + 1][0], lg[cg][2 * ks2 + 1][1]); pw.w = cvtpk(lg[cg][2 * ks2 + 1][2], lg[cg][2 * ks2 + 1][3]); pb[cg] = __builtin_bit_cast(bf16x8, pw); }
#pragma unroll
              for (int dt = 0; dt < 4; ++dt) { const bf16x8 va = __builtin_shufflevector(vt[ks2][dt][0], vt[ks2][dt][1], 0, 1, 2, 3, 4, 5, 6, 7);
#pragma unroll
                  for (int cg = 0; cg < 2; ++cg) O[cg][dt] = mfma16(va, pb[cg], O[cg][dt]); } }
          if (T + 1 < nt64) { *(LAS v4u*)(L + (buf ^ 1) * DS_BUF + skey * DS_TSTR + 16 * spiece) = kv; *(LAS v4u*)(L + (buf ^ 1) * DS_BUF + 9216 + skey * DS_TSTR + 16 * spiece) = vv; }
          kv = kn; vv = vn;
          __syncthreads();
      }
#pragma unroll
      for (int cg = 0; cg < 2; ++cg) { float v = lrun[cg]; v += __shfl_xor(v, 16); v += __shfl_xor(v, 32); const float inv = 1.0f / v;
          const int q = 4 * w + 2 * cg + (fr >> 3);
#pragma unroll
          for (int dt = 0; dt < 4; ++dt) { v2u o; o.x = cvtpk(O[cg][dt][0] * inv, O[cg][dt][1] * inv); o.y = cvtpk(O[cg][dt][2] * inv, O[cg][dt][3] * inv);
              *(v2u*)(YB + (size_t)(qrow0 + q) * 512 + hh * 64 + 16 * dt + 4 * kq) = o; } } }
}

__global__ void __launch_bounds__(NWAVES * 64, 2) mk_fwd(Args args) {
    extern __shared__ __attribute__((aligned(16))) unsigned char lds[];
    LAS unsigned char* L = (LAS unsigned char*)lds;
    volatile LAS unsigned* MISC = (volatile LAS unsigned*)(L + MISC_OFF);
    const int tid = threadIdx.x, lane = tid & 63, wave = __builtin_amdgcn_readfirstlane(tid >> 6);
    const int G = gridDim.x, bx = blockIdx.x;
    const int gw = bx * NWAVES + wave, NGW = G * NWAVES;
    unsigned char* ws = args.ws;
    if (tid < 32) MISC[tid] = 0u;
    __syncthreads();
    XcdBarrier bar; bar.bar = (unsigned*)(ws + WS_CTL) + CW_BAR; bar.x = 0; bar.st = nullptr;
    if (!MK_PER_PHASE) bar = xcd_barrier_post((unsigned*)(ws + WS_CTL) + CW_BAR, MISC + 8);
    const int lo = args.ph_lo, hi = args.ph_hi;
#define IN(k) (lo <= (k) && (k) < hi)
#define SEAM(k) do { if (IN(k) && IN((k) + 1)) xcd_barrier(bar); } while (0)
    bf16* WT1 = (bf16*)(ws + WS_WT1); bf16* WT2 = (bf16*)(ws + WS_WT2); bf16* WT3 = (bf16*)(ws + WS_WT3); bf16* WT4 = (bf16*)(ws + WS_WT4); bf16* WT5 = (bf16*)(ws + WS_WT5);
    bf16* WGLU = (bf16*)(ws + WS_WGLU); bf16* WA = (bf16*)(ws + WS_WA); bf16* WB = (bf16*)(ws + WS_WB); bf16* WOUT = (bf16*)(ws + WS_WOUT);
    bf16* HN = (bf16*)(ws + WS_HN); bf16* FB = (bf16*)(ws + WS_F); bf16* ACT = (bf16*)(ws + WS_BIG);
    bf16* PA = (bf16*)(ws + WS_PA); bf16* PG = (bf16*)(ws + WS_PG); bf16* PK = (bf16*)(ws + WS_PK);
    bf16* AM1 = (bf16*)(ws + WS_META + MO_AM1); bf16* ACTM = (bf16*)(ws + WS_META + MO_ACTM); bf16* FM = (bf16*)(ws + WS_META + MO_FM); bf16* AM2 = (bf16*)(ws + WS_META + MO_AM2);
    bf16* PMU = (bf16*)(ws + WS_META + MO_PMU); bf16* PMK = (bf16*)(ws + WS_META + MO_PMK);
    bf16* HB = (bf16*)(ws + WS_HB); float* RS1 = (float*)(ws + WS_META + 524288); float* RS2 = (float*)(ws + WS_META + 655360);
    bf16* YA = FB; bf16* YG = HN; bf16* YB = HN + (size_t)R * 512; bf16* MERGED = PA;
    const float* x = args.in[0]; float* out = args.out;

    if (IN(0)) {
        for (int item = bx; item < 256; item += G) s5_tables_block(args, item >> 3, item & 7, (LAS float*)L, tid);
        __syncthreads();
        LAS float* scr = (LAS float*)(L + wave * 16384);
        for (int it = gw; it < 11520; it += NGW) {
            int r = it;
            if (r < 6 * 1408) { const int mat = r / 1408; r -= mat * 1408;
                if (mat == 5) { const int kb = r / 32, nb = r % 32; transpose_item8(args.in[13], D, DFF, (unsigned char*)WT5, 64 * kb, 32 * nb, 32 * nb + (lane & 31), scr, lane); }
                else if (mat == 2) { const int kb = r / 32, nb = r % 32; transpose_item(args.in[10], D, DFF, WT2, 64 * kb, 32 * nb, 32 * nb + (lane & 31), scr, lane); }
                else if (mat >= 3) { const int kb = r / 88, nb = r % 88, d0 = 32 * nb, up = (mat == 4) ? 128 : 0; transpose_item8(args.in[mat == 3 ? 11 : 12], DFF, D, (unsigned char*)WT4, 64 * kb, 256 * (d0 >> 7) + (d0 & 127) + up, d0 + (lane & 31), scr, lane); }
                else { const int kb = r / 88, nb = r % 88, d0 = 32 * nb, up = (mat == 1 || mat == 4) ? 128 : 0;
                    transpose_item(args.in[mat == 0 ? 8 : mat == 1 ? 9 : mat == 3 ? 11 : 12], DFF, D, mat < 3 ? WT1 : WT4, 64 * kb, 256 * (d0 >> 7) + (d0 & 127) + up, d0 + (lane & 31), scr, lane, args.in[2]); }
                continue; }
            r -= 6 * 1408;
            if (r < 1920) { const int kb = r / 120, nb = r % 120; transpose_item(args.in[14], 3784, D, WT3, 64 * kb, 32 * nb, win_srccol(32 * nb + (lane & 31)), scr, lane, args.in[4]); continue; }
            r -= 1920;
            if (r < 128) { const int kb = r / 16, nb = r % 16; transpose_item(args.in[23], 512, 512, WGLU, 64 * kb, 32 * nb, 32 * nb + (lane & 31), scr, lane); continue; }
            r -= 128;
            if (r < 256) { const int kb = r / 32, nb = r % 32; transpose_item(args.in[24], D, 512, WA, 64 * kb, 32 * nb, 32 * nb + (lane & 31), scr, lane); continue; }
            r -= 256;
            if (r < 256) { const int kb = r / 32, nb = r % 32; transpose_item(args.in[26], D, 512, WB, 64 * kb, 32 * nb, 32 * nb + (lane & 31), scr, lane); continue; }
            r -= 256;
            { const int kb = r / 32, nb = r % 32; transpose_item(args.in[27], D, D, WOUT, 64 * kb, 32 * nb, 32 * nb + (lane & 31), scr, lane); }
        }
        for (int m = gw; m < R; m += NGW) x_row_to_bf16<false>(x + (size_t)m * D, HN + (size_t)m * D, RS1 + m, lane);
        if (gw < NMETA) x_row_to_bf16<true>(args.in[1] + (size_t)gw * D, AM1 + (size_t)gw * D, nullptr, lane);
    }
    SEAM(0);
    if (IN(1)) {
        if (bx < 176) { const int j0 = 16 * bx, grow = 256 * (j0 >> 7) + (j0 & 127); f32x4 g4, u4;
            meta_tile_blk<4>(AM1, WT1 + (size_t)grow * D, WT1 + (size_t)(grow + 128) * D, D, (LAS float*)L, wave, lane, g4, u4);
            if (wave == 0) {
#pragma unroll
                for (int r = 0; r < 4; ++r) ACTM[(4 * (lane >> 4) + r) * DFF + j0 + (lane & 15)] = (bf16)f2bf(g4[r] * fsig(g4[r]) * u4[r]); } }
        pg8::Gemm g{HN, WT1, R, 2 * DFF, D}; pg8::StaticOrder S; S.init(R, 2 * DFF, G, bx); pg8::EpiSwiglu E{ACT, DFF, RS1};
        pg8::gemm_phase<pg8::EpiSwiglu, pg8::StaticOrder, PG8_ALIGN, PG8_SP2>(L, g, S, E);
        if (REP_G1 > 1) pg8::gemm_phase<pg8::EpiSwiglu, pg8::StaticOrder, PG8_ALIGN, PG8_SP2>(L, g, S, E);
    }
    SEAM(1);
    if (IN(2)) {
        if (bx < 64) { const int n0 = 16 * bx; f32x4 f4, dummy;
            meta_tile_blk<11>(ACTM, WT2 + (size_t)n0 * DFF, nullptr, DFF, (LAS float*)L, wave, lane, f4, dummy);
            if (wave == 0) {
#pragma unroll
                for (int r = 0; r < 4; ++r) FM[(4 * (lane >> 4) + r) * D + n0 + (lane & 15)] = (bf16)f2bf(f4[r]); } }
        pg8::Gemm g{ACT, WT2, R, D, DFF}; pg8::StaticOrder S; S.init(R, D, G, bx); pg8::EpiPlain E{FB, D};
        pg8::gemm_phase<pg8::EpiPlain, pg8::StaticOrder, PG8_ALIGN, PG8_SP2>(L, g, S, E);
    }
    SEAM(2);
    if (IN(3)) {
        if (gw < NMETA) row_update<false, false>(FM + (size_t)gw * D, args.in[1] + (size_t)gw * D, nullptr, AM2 + (size_t)gw * D, args.in[3], nullptr, 0.5f, lane);
        for (int m = gw; m < R; m += NGW) row_update<true, true>(FB + (size_t)m * D, HN + (size_t)m * D, HB + (size_t)m * D, nullptr, args.in[3], nullptr, 0.5f, lane, RS2 + m);
    }
    SEAM(3);
    if (IN(4)) {
        if (bx < 44) { const int n0 = bx < 32 ? 16 * bx : 3584 + 16 * (bx - 32); f32x4 p4, dummy;
            meta_tile_blk<4>(AM2, WT3 + (size_t)n0 * D, nullptr, D, (LAS float*)L, wave, lane, p4, dummy);
            if (wave == 0) {
#pragma unroll
                for (int r = 0; r < 4; ++r) { const int row = 4 * (lane >> 4) + r; if (bx < 32) PMU[row * 512 + n0 + (lane & 15)] = (bf16)f2bf(p4[r]); else PMK[row * 256 + (n0 - 3584) + (lane & 15)] = (bf16)f2bf(p4[r]); } } }
        pg8::Gemm g{HB, WT3, R, 3840, D}; pg8::StaticOrder S; S.init(R, 3840, G, bx); pg8::EpiProj E{PA, PG, PK, (bf16*)(ws + WS_UA2), RS2};
        pg8::gemm_phase<pg8::EpiProj, pg8::StaticOrder, PG8_ALIGN, PG8_SP2>(L, g, S, E);
    }
    SEAM(4);
    if (IN(5)) {
        { const int v0 = 2 * (bx >> 3), gS = 4 * (bx & 7) + (v0 >> 4);
          s5_meta(args, L, gS, tid);
          for (int rep = 0; rep < REP_S5; ++rep) for (int i = 0; i < 2; ++i) s5_unit(args, L, (v0 + i) & 15, gS, tid); }
        __syncthreads();
        dsa_tables(args, L, tid);
        for (int i = 0; i < 4 * REP_DSA; ++i) { const int up = 4 * (bx >> 3) + (i & 3), u2 = up >> 1, b = 2 * (bx & 7) + (u2 >> 5), xq = u2 & 31; dsa_unit(args, L, b, (up & 1) ? 63 - xq : xq, tid); }
        __syncthreads();
    }
    SEAM(5);
    if (IN(6)) { pg8::Gemm g{YA, WGLU, R, 512, 512}; pg8::StaticOrder S; S.init(R, 512, G, bx); pg8::EpiGlu E{YA, YG};
        pg8::gemm_phase<pg8::EpiGlu, pg8::StaticOrder, PG8_ALIGN, PG8_SP2>(L, g, S, E); }
    SEAM(6);
    if (IN(7)) { pg8::Gemm g{YG, WA, 2 * R, 2048, 512}; pg8::MergeOrder S; S.base.init(R, D, G, bx); pg8::EpiMerge2 E{PG, FB, MERGED};
        pg8::gemm_phase<pg8::EpiMerge2, pg8::MergeOrder, PG8_ALIGN, PG8_SP2>(L, g, S, E); }
    if (IN(7) && IN(9)) xcd_barrier(bar);
    if (IN(9)) { pg8::Gemm g{MERGED, WOUT, R, D, D}; pg8::StaticOrder S; S.init(R, D, G, bx); pg8::EpiPlain E{FB, D};
        pg8::gemm_phase<pg8::EpiPlain, pg8::StaticOrder, PG8_ALIGN, PG8_SP2>(L, g, S, E); }
    SEAM(9);
    if (IN(10)) { for (int m = gw; m < R; m += NGW) row_update<true, true, true>(FB + (size_t)m * D, HB + (size_t)m * D, HB + (size_t)m * D, (bf16*)((unsigned char*)HN + (size_t)m * D), args.in[5], args.in[6], 1.0f, lane); }
    SEAM(10);
    if (IN(11)) { pg8::Gemm g{HN, WT4, R, 2 * DFF, D}; pg8::StaticOrder S; S.init(R, 2 * DFF, G, bx); pg8::EpiSwiglu8 E{(unsigned char*)ACT, DFF, 1.0f / 256.0f, 8.0f};
        pg8::gemm_phase<pg8::EpiSwiglu8, pg8::StaticOrder, PG8_ALIGN, PG8_SP2, true>(L, g, S, E); }
    SEAM(11);
    if (IN(12)) { pg8::Gemm g{ACT, WT5, R, D, DFF}; pg8::StaticOrder S; S.init(R, D, G, bx); pg8::EpiPlainS E{FB, D, 1.0f / 512.0f};
        pg8::gemm_phase<pg8::EpiPlainS, pg8::StaticOrder, PG8_ALIGN, PG8_SP2, true>(L, g, S, E); }
    SEAM(12);
    if (IN(13)) { for (int m = gw; m < R; m += NGW) row_update<true, false>(FB + (size_t)m * D, HB + (size_t)m * D, out + (size_t)m * D, nullptr, args.in[7], args.in[7], 0.5f, lane); }
#undef IN
#undef SEAM
}

extern "C" void kernel_launch(void* const* d_in, const int* in_sizes, int n_in, void* d_out, int out_size, void* d_ws, size_t ws_size, hipStream_t stream) {
    static int grid = 0;
    if (grid == 0) {
        if (n_in != 28 || out_size != R * D || ws_size < WS_END) { fprintf(stderr, "kernel_launch: unexpected shapes (n_in %d, out %d, ws %zu); nothing launched\n", n_in, out_size, ws_size); grid = -1; return; }
        int dev = 0, cus = 0, per_cu = 0;
        if (hipGetDevice(&dev) != hipSuccess || hipDeviceGetAttribute(&cus, hipDeviceAttributeMultiprocessorCount, dev) != hipSuccess) { grid = -1; return; }
        if (hipFuncSetAttribute((const void*)mk_fwd, hipFuncAttributeMaxDynamicSharedMemorySize, LDS_BYTES) != hipSuccess) { fprintf(stderr, "kernel_launch: hipFuncSetAttribute failed\n"); grid = -1; return; }
        if (hipOccupancyMaxActiveBlocksPerMultiprocessor(&per_cu, (const void*)mk_fwd, NWAVES * 64, LDS_BYTES) != hipSuccess || per_cu < 1) fprintf(stderr, "kernel_launch: note: occupancy query reports %d\n", per_cu);
        (void)hipGetLastError();
        grid = cus;
    }
    if (grid < 0) return;
    if (hipMemsetAsync((char*)d_ws + WS_CTL, 0, CTL_ZERO_BYTES, stream) != hipSuccess) return;
    Args a{};
    for (int i = 0; i < 28; ++i) a.in[i] = (const float*)d_in[i];
    a.out = (float*)d_out; a.ws = (unsigned char*)d_ws;
#if MK_PER_PHASE
    for (int ph = 0; ph < NPH; ++ph) { a.ph_lo = ph; a.ph_hi = ph + 1; hipLaunchKernelGGL(mk_fwd, dim3(grid), dim3(NWAVES * 64), LDS_BYTES, stream, a); }
#else
    a.ph_lo = 0; a.ph_hi = NPH;
    hipLaunchKernelGGL(mk_fwd, dim3(grid), dim3(NWAVES * 64), LDS_BYTES, stream, a);
#endif
}
```

```cpp
#include <hip/hip_runtime.h>
#include <cstdio>
#include <cstdint>
namespace pg8 {
#define PG8_LAS __attribute__((address_space(3)))
typedef unsigned short bf16_t;
typedef short bf16x8 __attribute__((ext_vector_type(8)));
typedef float f32x4 __attribute__((ext_vector_type(4)));
typedef unsigned u32x4 __attribute__((ext_vector_type(4)));
constexpr int BM = 256, BK = 64, HALF = 128, HTB = HALF * BK * 2  , STAGE_BYTES = 8 * HTB, NXCD = 8, WGM = 8;

__host__ __device__ __forceinline__ int lds_byte(int r, int c) { const int st = (r >> 4) * 2 + (c >> 5), rr = r & 15, cc = c & 31, ob = rr * 64 + cc * 2; return st * 1024 + (ob ^ (((ob >> 9) & 1) << 5)); }
__host__ __device__ __forceinline__ void stage_rc(int b, int& R, int& C) { const int st = b / 1024, sb = b % 1024, swz = sb ^ (((sb >> 9) & 1) << 5); R = (st >> 1) * 16 + swz / 64; C = (st & 1) * 32 + (swz % 64) / 2; }
__host__ __device__ __forceinline__ int perm32(int rho) { const int n = rho >> 4, i = rho & 15; return 8 * (i >> 2) + 4 * n + (i & 3); }

struct Unit { int pm, pn; };
struct Gemm { const bf16_t* A; const bf16_t* Bt; int M, N, K; };

struct StaticOrder {
    int nM, nN, nwg, G, c;
    __host__ __device__ void init(int M, int N, int G_, int c_) { nM = M / BM; nN = N / BM; nwg = nM * nN; G = G_; c = c_; }
    __host__ __device__ bool next(int i, Unit& u) const {
        const long L = (long)i * G + c; if (L >= nwg) return false;
        int wgid = (int)L; { const int q = nwg / NXCD, r = nwg % NXCD, xcd = wgid % NXCD, off = wgid / NXCD; wgid = (xcd < r ? xcd * (q + 1) : r * (q + 1) + (xcd - r) * q) + off; }
        const int nig = WGM * nN, gid = wgid / nig, fm = gid * WGM, gsz = (nM - fm) < WGM ? (nM - fm) : WGM;
        u.pm = fm + ((wgid % nig) % gsz); u.pn = (wgid % nig) / gsz; return true;
    }
    __device__ __forceinline__ void a_ready(const Unit&) const {}
    __device__ __forceinline__ void done(const Unit&) const {}
};
__device__ __forceinline__ unsigned cvt_pk_bf16(float lo, float hi) { unsigned r; asm volatile("v_cvt_pk_bf16_f32 %0, %1, %2" : "=v"(r) : "v"(lo), "v"(hi)); return r; }
__device__ __forceinline__ float fsigmoid(float x) { return __builtin_amdgcn_rcpf(1.0f + __expf(-x)); }
__device__ __forceinline__ float bf_lo(unsigned w) { return __uint_as_float(w << 16); }
__device__ __forceinline__ float bf_hi(unsigned w) { return __uint_as_float(w & 0xffff0000u); }
__device__ __forceinline__ u32x4 pack8(const f32x4 v0, const f32x4 v1) { u32x4 w; w.x = cvt_pk_bf16(v0[0], v0[1]); w.y = cvt_pk_bf16(v0[2], v0[3]); w.z = cvt_pk_bf16(v1[0], v1[1]); w.w = cvt_pk_bf16(v1[2], v1[3]); return w; }
__device__ __forceinline__ void unpack8(const u32x4 w, f32x4& v0, f32x4& v1) { v0 = (f32x4){bf_lo(w.x), bf_hi(w.x), bf_lo(w.y), bf_hi(w.y)}; v1 = (f32x4){bf_lo(w.z), bf_hi(w.z), bf_lo(w.w), bf_hi(w.w)}; }

struct EpiSwiglu {
    static constexpr bool PERM = true, AFTER_DRAIN = false;
    bf16_t* O; int ldc; const float* rs;
    __device__ __forceinline__ void operator()(const f32x4 (&acc)[2][2][4][2], const Unit& u, int wr, int wc, int fr, int fq) const {
        const int row0 = u.pm * BM + wr * 64 + fr, col0 = u.pn * HALF + wc * 32 + 8 * fq;
#pragma unroll
        for (int ai = 0; ai < 2; ++ai)
#pragma unroll
            for (int m = 0; m < 4; ++m) { bf16_t* rowp = O + (size_t)(row0 + ai * HALF + m * 16) * ldc + col0; const float rsc = rs[row0 + ai * HALF + m * 16];
                f32x4 v0, v1;
#pragma unroll
                for (int j = 0; j < 4; ++j) { const float g0 = acc[ai][0][m][0][j] * rsc, g1 = acc[ai][0][m][1][j] * rsc;
                    v0[j] = g0 * fsigmoid(g0) * (acc[ai][1][m][0][j] * rsc); v1[j] = g1 * fsigmoid(g1) * (acc[ai][1][m][1][j] * rsc); }
                *(u32x4*)rowp = pack8(v0, v1); }
    }
};
struct EpiPlain {
    static constexpr bool PERM = true, AFTER_DRAIN = false;
    bf16_t* O; int ldc;
    __device__ __forceinline__ void operator()(const f32x4 (&acc)[2][2][4][2], const Unit& u, int wr, int wc, int fr, int fq) const {
        const int row0 = u.pm * BM + wr * 64 + fr, col0 = u.pn * BM + wc * 32 + 8 * fq;
#pragma unroll
        for (int ai = 0; ai < 2; ++ai)
#pragma unroll
            for (int m = 0; m < 4; ++m) { bf16_t* rowp = O + (size_t)(row0 + ai * HALF + m * 16) * ldc + col0;
#pragma unroll
                for (int bj = 0; bj < 2; ++bj) *(u32x4*)(rowp + bj * HALF) = pack8(acc[ai][bj][m][0], acc[ai][bj][m][1]); }
    }
};

__device__ __forceinline__ unsigned pk4_fp8(float a, float b, float c, float d) { int w = 0; w = __builtin_amdgcn_cvt_pk_fp8_f32(fminf(fmaxf(a, -448.f), 448.f), fminf(fmaxf(b, -448.f), 448.f), w, false);
    w = __builtin_amdgcn_cvt_pk_fp8_f32(fminf(fmaxf(c, -448.f), 448.f), fminf(fmaxf(d, -448.f), 448.f), w, true); return (unsigned)w; }
struct EpiSwiglu8 {
    static constexpr bool PERM = true, AFTER_DRAIN = false;
    unsigned char* O; int ldc; float ascale, oscale;
    __device__ __forceinline__ void operator()(const f32x4 (&acc)[2][2][4][2], const Unit& u, int wr, int wc, int fr, int fq) const {
        const int row0 = u.pm * BM + wr * 64 + fr, col0 = u.pn * HALF + wc * 32 + 8 * fq;
#pragma unroll
        for (int ai = 0; ai < 2; ++ai)
#pragma unroll
            for (int m = 0; m < 4; ++m) { unsigned char* rowp = O + (size_t)(row0 + ai * HALF + m * 16) * ldc + col0;
                f32x4 v0, v1;
#pragma unroll
                for (int j = 0; j < 4; ++j) { const float g0 = acc[ai][0][m][0][j] * ascale, g1 = acc[ai][0][m][1][j] * ascale;
                    v0[j] = g0 * fsigmoid(g0) * (acc[ai][1][m][0][j] * ascale) * oscale; v1[j] = g1 * fsigmoid(g1) * (acc[ai][1][m][1][j] * ascale) * oscale; }
                typedef unsigned u32x2 __attribute__((ext_vector_type(2))); u32x2 w; w.x = pk4_fp8(v0[0], v0[1], v0[2], v0[3]); w.y = pk4_fp8(v1[0], v1[1], v1[2], v1[3]);
                *(u32x2*)rowp = w; }
    }
};
struct EpiPlainS {
    static constexpr bool PERM = true, AFTER_DRAIN = false;
    bf16_t* O; int ldc; float scale;
    __device__ __forceinline__ void operator()(const f32x4 (&acc)[2][2][4][2], const Unit& u, int wr, int wc, int fr, int fq) const {
        const int row0 = u.pm * BM + wr * 64 + fr, col0 = u.pn * BM + wc * 32 + 8 * fq;
#pragma unroll
        for (int ai = 0; ai < 2; ++ai)
#pragma unroll
            for (int m = 0; m < 4; ++m) { bf16_t* rowp = O + (size_t)(row0 + ai * HALF + m * 16) * ldc + col0;
#pragma unroll
                for (int bj = 0; bj < 2; ++bj) *(u32x4*)(rowp + bj * HALF) = pack8(acc[ai][bj][m][0] * scale, acc[ai][bj][m][1] * scale); }
    }
};
struct EpiProj {
    static constexpr bool PERM = true, AFTER_DRAIN = false;
    bf16_t *PA, *PK, *UA2; const float* rs;
    __device__ __forceinline__ void operator()(const f32x4 (&acc)[2][2][4][2], const Unit& u, int wr, int wc, int fr, int fq) const {
        if (u.pn < 2) {
#pragma unroll
            for (int ai = 0; ai < 2; ++ai)
#pragma unroll
                for (int m = 0; m < 4; ++m) { const int row = u.pm * BM + wr * 64 + fr + ai * HALF + m * 16, bb = row >> 11, t = row & 2047; const float rsc = rs[row];
#pragma unroll
                    for (int bj = 0; bj < 2; ++bj) { const int col = 256 * u.pn + 128 * bj + wc * 32 + 8 * fq;
                        *(u32x4*)(UA2 + ((size_t)((bb * 32 + (col >> 4)) * 2048 + t)) * 16 + (col & 8)) = pack8(acc[ai][bj][m][0] * rsc, acc[ai][bj][m][1] * rsc); } }
            return; }
        bf16_t* base; int ldc, colt;
        if (u.pn < 6) { base = PA; ldc = 1024; colt = 256 * (u.pn - 2); } else { base = PK; ldc = 256; colt = 0; }
        const int row0 = u.pm * BM + wr * 64 + fr, col0 = colt + wc * 32 + 8 * fq;
#pragma unroll
        for (int ai = 0; ai < 2; ++ai)
#pragma unroll
            for (int m = 0; m < 4; ++m) { bf16_t* rowp = base + (size_t)(row0 + ai * HALF + m * 16) * ldc + col0; const float rsc = rs[row0 + ai * HALF + m * 16];
#pragma unroll
                for (int bj = 0; bj < 2; ++bj) *(u32x4*)(rowp + bj * HALF) = pack8(acc[ai][bj][m][0] * rsc, acc[ai][bj][m][1] * rsc); }
    }
};
struct EpiGates8 {
    static constexpr bool PERM = true, AFTER_DRAIN = false;
    bf16_t* PG; const float* rs;
    __device__ __forceinline__ void operator()(const f32x4 (&acc)[2][2][4][2], const Unit& u, int wr, int wc, int fr, int fq) const {
        const int row0 = u.pm * BM + wr * 64 + fr, col0 = u.pn * BM + wc * 32 + 8 * fq;
#pragma unroll
        for (int ai = 0; ai < 2; ++ai)
#pragma unroll
            for (int m = 0; m < 4; ++m) { bf16_t* rowp = PG + (size_t)(row0 + ai * HALF + m * 16) * 2048 + col0; const float rsc = rs[row0 + ai * HALF + m * 16] * (1.0f / 256.0f);
#pragma unroll
                for (int bj = 0; bj < 2; ++bj) *(u32x4*)(rowp + bj * HALF) = pack8(acc[ai][bj][m][0] * rsc, acc[ai][bj][m][1] * rsc); }
    }
};
struct ProjOrderA {
    StaticOrder base; int c;
    __device__ __forceinline__ bool next(int i, Unit& u) const { if (i < 3) return base.next(i, u); if (i == 3 && c < 128) { u.pm = c; u.pn = 6; return true; } return false; }
    __device__ __forceinline__ void a_ready(const Unit&) const {}
    __device__ __forceinline__ void done(const Unit&) const {}
};
struct ProjOrderB {
    int c;
    __device__ __forceinline__ bool next(int i, Unit& u) const {
        int Lx; if (c < 128) { if (i >= 3) return false; Lx = c + 128 * i; } else { if (i >= 5) return false; Lx = 384 + (c - 128) + 128 * i; }
        const int wgid = (Lx % NXCD) * 128 + Lx / NXCD, nig = WGM * 8;
        u.pm = (wgid / nig) * WGM + (wgid % nig) % WGM; u.pn = (wgid % nig) / WGM; return true; }
    __device__ __forceinline__ void a_ready(const Unit&) const {}
    __device__ __forceinline__ void done(const Unit&) const {}
};
struct EpiGlu {
    static constexpr bool PERM = true, AFTER_DRAIN = false;
    const bf16_t* Y; bf16_t* O;
    __device__ __forceinline__ void operator()(const f32x4 (&acc)[2][2][4][2], const Unit& u, int wr, int wc, int fr, int fq) const {
        const int row0 = u.pm * BM + wr * 64 + fr, col0 = u.pn * BM + wc * 32 + 8 * fq;
#pragma unroll
        for (int ai = 0; ai < 2; ++ai)
#pragma unroll
            for (int m = 0; m < 4; ++m) { const size_t off = (size_t)(row0 + ai * HALF + m * 16) * 512 + col0;
#pragma unroll
                for (int bj = 0; bj < 2; ++bj) { f32x4 y0, y1; unpack8(*(const u32x4*)(Y + off + bj * HALF), y0, y1); f32x4 v0, v1;
#pragma unroll
                    for (int j = 0; j < 4; ++j) { v0[j] = y0[j] * fsigmoid(acc[ai][bj][m][0][j]); v1[j] = y1[j] * fsigmoid(acc[ai][bj][m][1][j]); }
                    *(u32x4*)(O + off + bj * HALF) = pack8(v0, v1); } }
    }
};
template <bool SECOND> struct EpiMerge {
    static constexpr bool PERM = true, AFTER_DRAIN = false;
    const bf16_t* G; int goff; const bf16_t* T; bf16_t* O;
    __device__ __forceinline__ void operator()(const f32x4 (&acc)[2][2][4][2], const Unit& u, int wr, int wc, int fr, int fq) const {
        const int row0 = u.pm * BM + wr * 64 + fr, col0 = u.pn * BM + wc * 32 + 8 * fq;
#pragma unroll
        for (int ai = 0; ai < 2; ++ai)
#pragma unroll
            for (int m = 0; m < 4; ++m) { const size_t row = (size_t)(row0 + ai * HALF + m * 16);
#pragma unroll
                for (int bj = 0; bj < 2; ++bj) { const int col = col0 + bj * HALF; f32x4 g0, g1; unpack8(*(const u32x4*)(G + row * 2048 + goff + col), g0, g1);
                    f32x4 t0 = (f32x4){0.f, 0.f, 0.f, 0.f}, t1 = t0; if (SECOND) unpack8(*(const u32x4*)(T + row * 1024 + col), t0, t1);
                    f32x4 v0, v1;
#pragma unroll
                    for (int j = 0; j < 4; ++j) { v0[j] = t0[j] + fsigmoid(g0[j]) * acc[ai][bj][m][0][j]; v1[j] = t1[j] + fsigmoid(g1[j]) * acc[ai][bj][m][1][j]; }
                    *(u32x4*)(O + row * 1024 + col) = pack8(v0, v1); } }
    }
};

struct MergeOrder {
    StaticOrder base;
    __device__ __forceinline__ bool next(int i, Unit& u) const { if (i >= 4) return false; if (!base.next(i & 1, u)) return false; if (i >= 2) { u.pm += 128; u.pn += 4; } return true; }
    __device__ __forceinline__ void a_ready(const Unit&) const {}
    __device__ __forceinline__ void done(const Unit&) const {}
};
struct EpiMerge2 {
    static constexpr bool PERM = true, AFTER_DRAIN = false;
    const bf16_t* G; bf16_t* T; bf16_t* O;
    __device__ __forceinline__ void operator()(const f32x4 (&acc)[2][2][4][2], const Unit& u, int wr, int wc, int fr, int fq) const {
        const bool second = u.pm >= 128; const int pm = second ? u.pm - 128 : u.pm, pn = second ? u.pn - 4 : u.pn, goff = second ? 1024 : 0;
        const int row0 = pm * BM + wr * 64 + fr, col0 = pn * BM + wc * 32 + 8 * fq;
#pragma unroll
        for (int ai = 0; ai < 2; ++ai)
#pragma unroll
            for (int m = 0; m < 4; ++m) { const size_t row = (size_t)(row0 + ai * HALF + m * 16);
#pragma unroll
                for (int bj = 0; bj < 2; ++bj) { const int col = col0 + bj * HALF; f32x4 g0, g1; unpack8(*(const u32x4*)(G + row * 2048 + goff + col), g0, g1);
                    f32x4 t0 = (f32x4){0.f, 0.f, 0.f, 0.f}, t1 = t0; if (second) unpack8(*(const u32x4*)(T + row * 1024 + col), t0, t1);
                    f32x4 v0, v1;
#pragma unroll
                    for (int j = 0; j < 4; ++j) { v0[j] = t0[j] + fsigmoid(g0[j]) * acc[ai][bj][m][0][j]; v1[j] = t1[j] + fsigmoid(g1[j]) * acc[ai][bj][m][1][j]; }
                    *(u32x4*)((second ? O : T) + row * 1024 + col) = pack8(v0, v1); } }
    }
};
typedef int i32x8 __attribute__((ext_vector_type(8)));
typedef int i32x4v __attribute__((ext_vector_type(4)));
__device__ __forceinline__ i32x8 cat8(const bf16x8 lo, const bf16x8 hi) { const i32x4v a = __builtin_bit_cast(i32x4v, lo), b = __builtin_bit_cast(i32x4v, hi); return __builtin_shufflevector(a, b, 0, 1, 2, 3, 4, 5, 6, 7); }
template <class Epi, class Sched, bool ALIGN_EPI = false, bool SP2 = false, bool F8 = false>
__device__ __forceinline__ void gemm_phase(PG8_LAS unsigned char* lds, const Gemm g, const Sched& S, const Epi& E) {
    const int tid = threadIdx.x, wid = __builtin_amdgcn_readfirstlane(tid >> 6), lane = tid & 63, wr = wid >> 2, wc = wid & 3, fr = lane & 15, fq = lane >> 4;
    const int K = g.K, KB = F8 ? K : 2 * K  , nt = KB / 128;
    unsigned voffA[2], voffB[2];
#pragma unroll
    for (int i = 0; i < 2; ++i) { int R, C; stage_rc(tid * 16 + i * 8192, R, C); const int Rb = Epi::PERM ? ((R & ~31) + perm32(R & 31)) : R;
        voffA[i] = (unsigned)(R * KB + C * 2); voffB[i] = (unsigned)(Rb * KB + C * 2); }
    const size_t kstep = (size_t)(BK * 2);
    const size_t hstep = (size_t)HALF * KB;
    const size_t tstep = 2 * hstep;
    const unsigned ldsw = (unsigned)wid * 1024u;
    const int aoff = lds_byte(wr * 64 + fr, fq * 8), boff = lds_byte(wc * 32 + fr, fq * 8);
#define PG8_SA(b, h) (((b) * 2 + (h)) * HTB)
#define PG8_SB(b, h) ((4 + (b) * 2 + (h)) * HTB)
#define PG8_STAGE(bufoff, gbase, voff) do { _Pragma("unroll") for (int _i = 0; _i < 2; ++_i) \
        __builtin_amdgcn_global_load_lds((const unsigned*)((const char*)(gbase) + (voff)[_i]), (PG8_LAS unsigned*)(lds + (bufoff) + ldsw + _i * 8192), 16, 0, 0); } while (0)
#define PG8_LDA(dst, b, h) do { if constexpr (F8) { _Pragma("unroll") for (int m = 0; m < 4; ++m) dst##8[m] = cat8(*(const PG8_LAS bf16x8*)(lds + PG8_SA(b, h) + aoff + m * 2048), *(const PG8_LAS bf16x8*)(lds + PG8_SA(b, h) + aoff + m * 2048 + 1024)); } else { \
        _Pragma("unroll") for (int m = 0; m < 4; ++m) _Pragma("unroll") for (int k = 0; k < 2; ++k) dst[m][k] = *(const PG8_LAS bf16x8*)(lds + PG8_SA(b, h) + aoff + m * 2048 + k * 1024); } } while (0)
#define PG8_LDB(dst, b, h) do { if constexpr (F8) { _Pragma("unroll") for (int n = 0; n < 2; ++n) dst##8[n] = cat8(*(const PG8_LAS bf16x8*)(lds + PG8_SB(b, h) + boff + n * 2048), *(const PG8_LAS bf16x8*)(lds + PG8_SB(b, h) + boff + n * 2048 + 1024)); } else { \
        _Pragma("unroll") for (int n = 0; n < 2; ++n) _Pragma("unroll") for (int k = 0; k < 2; ++k) dst[n][k] = *(const PG8_LAS bf16x8*)(lds + PG8_SB(b, h) + boff + n * 2048 + k * 1024); } } while (0)
#define PG8_MMA(ai, bj, At, Bt) do { __builtin_amdgcn_s_setprio(1); if constexpr (F8) { _Pragma("unroll") for (int m = 0; m < 4; ++m) _Pragma("unroll") for (int n = 0; n < 2; ++n) \
        acc[ai][bj][m][n] = __builtin_amdgcn_mfma_scale_f32_16x16x128_f8f6f4(Bt##8[n], At##8[m], acc[ai][bj][m][n], 0, 0, 0, 0x7F7F7F7F, 0, 0x7F7F7F7F); \
        _Pragma("unroll") for (int m = 0; m < 4; ++m) _Pragma("unroll") for (int n = 0; n < 2; ++n) asm volatile("" : "+v"(acc[ai][bj][m][n])); } else { \
        _Pragma("unroll") for (int m = 0; m < 4; ++m) _Pragma("unroll") for (int n = 0; n < 2; ++n) _Pragma("unroll") for (int k = 0; k < 2; ++k) \
        acc[ai][bj][m][n] = __builtin_amdgcn_mfma_f32_16x16x32_bf16(Bt[n][k], At[m][k], acc[ai][bj][m][n], 0, 0, 0); } __builtin_amdgcn_s_setprio(0); } while (0)
#define PG8_WAIT_V(n) asm volatile("s_waitcnt vmcnt(" #n ")" ::: "memory")
#define PG8_WAIT_L(n) asm volatile("s_waitcnt lgkmcnt(" #n ")" ::: "memory")
#define PG8_BAR __builtin_amdgcn_s_barrier()
#define PG8_SCHED __builtin_amdgcn_sched_barrier(0)
    Unit cur, nxt; int ui = 0;
    if (!S.next(0, cur)) return;
    f32x4 acc[2][2][4][2];
#pragma unroll
    for (int a = 0; a < 2; ++a)
#pragma unroll
        for (int b = 0; b < 2; ++b)
#pragma unroll
            for (int m = 0; m < 4; ++m)
#pragma unroll
                for (int n = 0; n < 2; ++n) acc[a][b][m][n] = (f32x4){0.f, 0.f, 0.f, 0.f};
    bf16x8 At[4][2], B0[2][2], B1[2][2]; i32x8 At8[4], B08[2], B18[2];
    const char* cA = (const char*)g.A + (size_t)cur.pm * tstep; const char* cB = (const char*)g.Bt + (size_t)cur.pn * tstep;
    S.a_ready(cur);
    if constexpr (SP2) {
        PG8_STAGE(PG8_SB(0, 0), cB, voffB); PG8_STAGE(PG8_SB(0, 1), cB + hstep, voffB); PG8_STAGE(PG8_SA(0, 0), cA, voffA); PG8_STAGE(PG8_SA(0, 1), cA + hstep, voffA);
        if (wr == 1) PG8_BAR;
        PG8_WAIT_V(2); PG8_BAR;
        PG8_STAGE(PG8_SB(1, 0), cB + kstep, voffB); PG8_STAGE(PG8_SA(1, 0), cA + kstep, voffA); PG8_STAGE(PG8_SB(1, 1), cB + hstep + kstep, voffB);
        PG8_WAIT_V(6); PG8_BAR;
    } else {
        PG8_STAGE(PG8_SB(0, 0), cB, voffB); PG8_STAGE(PG8_SA(0, 0), cA, voffA); PG8_STAGE(PG8_SB(0, 1), cB + hstep, voffB); PG8_STAGE(PG8_SA(0, 1), cA + hstep, voffA);
        if (wr == 1) PG8_BAR;
        PG8_WAIT_V(4); PG8_BAR;
        PG8_STAGE(PG8_SB(1, 0), cB + kstep, voffB); PG8_STAGE(PG8_SA(1, 0), cA + kstep, voffA); PG8_STAGE(PG8_SB(1, 1), cB + hstep + kstep, voffB);
        PG8_WAIT_V(6); PG8_BAR;
    }
    for (;;) {
        const bool has_next = S.next(ui + 1, nxt);
        const char* nA = has_next ? (const char*)g.A + (size_t)nxt.pm * tstep : cA; const char* nB = has_next ? (const char*)g.Bt + (size_t)nxt.pn * tstep : cB;
        for (int t = 0; t < nt; t += 2) {
            const bool last = (t == nt - 2);
            const char* a1 = cA + (size_t)(t + 1) * kstep;
            const char* a2 = last ? nA : cA + (size_t)(t + 2) * kstep; const char* b2 = last ? nB : cB + (size_t)(t + 2) * kstep;
            const char* a3 = a2 + kstep; const char* b3 = b2 + kstep;
            if (last && has_next) S.a_ready(nxt);
            if constexpr (SP2) {
            PG8_LDB(B0, 0, 0); PG8_LDB(B1, 0, 1); PG8_SCHED; PG8_LDA(At, 0, 0); PG8_STAGE(PG8_SA(1, 1), a1 + hstep, voffA);
            PG8_WAIT_V(8); PG8_WAIT_L(0); PG8_BAR; PG8_MMA(0, 0, At, B0); PG8_MMA(0, 1, At, B1); PG8_BAR; PG8_SCHED;
            PG8_LDA(At, 0, 1); PG8_STAGE(PG8_SB(0, 0), b2, voffB); PG8_STAGE(PG8_SB(0, 1), b2 + hstep, voffB); PG8_STAGE(PG8_SA(0, 0), a2, voffA);
            PG8_WAIT_V(8); PG8_WAIT_L(0); PG8_BAR; PG8_MMA(1, 0, At, B0); PG8_MMA(1, 1, At, B1); PG8_BAR; PG8_SCHED;
            PG8_LDB(B0, 1, 0); PG8_LDB(B1, 1, 1); PG8_SCHED; PG8_LDA(At, 1, 0); PG8_STAGE(PG8_SA(0, 1), a2 + hstep, voffA);
            PG8_WAIT_V(8); PG8_WAIT_L(0); PG8_BAR; PG8_MMA(0, 0, At, B0); PG8_MMA(0, 1, At, B1); PG8_BAR; PG8_SCHED;
            PG8_LDA(At, 1, 1); PG8_STAGE(PG8_SB(1, 0), b3, voffB); PG8_STAGE(PG8_SB(1, 1), b3 + hstep, voffB); PG8_STAGE(PG8_SA(1, 0), a3, voffA);
            PG8_WAIT_V(8); PG8_WAIT_L(0); PG8_BAR; PG8_MMA(1, 0, At, B0); PG8_MMA(1, 1, At, B1); PG8_BAR; PG8_SCHED;
            } else {
            PG8_LDB(B0, 0, 0); PG8_SCHED; PG8_LDA(At, 0, 0); PG8_STAGE(PG8_SA(1, 1), a1 + hstep, voffA);
            PG8_WAIT_L(8); PG8_BAR; PG8_WAIT_L(0); PG8_MMA(0, 0, At, B0); PG8_BAR; PG8_SCHED;
            PG8_LDB(B1, 0, 1); PG8_STAGE(PG8_SB(0, 0), b2, voffB);
            PG8_BAR; PG8_WAIT_L(0); PG8_MMA(0, 1, At, B1); PG8_BAR;
            PG8_LDA(At, 0, 1); PG8_STAGE(PG8_SA(0, 0), a2, voffA);
            PG8_BAR; PG8_WAIT_L(0); PG8_MMA(1, 0, At, B0); PG8_BAR; PG8_SCHED;
            PG8_STAGE(PG8_SB(0, 1), b2 + hstep, voffB);
            PG8_WAIT_V(6); PG8_BAR; PG8_MMA(1, 1, At, B1); PG8_BAR;
            PG8_LDB(B0, 1, 0); PG8_SCHED; PG8_LDA(At, 1, 0); PG8_STAGE(PG8_SA(0, 1), a2 + hstep, voffA);
            PG8_WAIT_L(8); PG8_BAR; PG8_WAIT_L(0); PG8_MMA(0, 0, At, B0); PG8_BAR; PG8_SCHED;
            PG8_LDB(B1, 1, 1); PG8_STAGE(PG8_SB(1, 0), b3, voffB);
            PG8_BAR; PG8_WAIT_L(0); PG8_MMA(0, 1, At, B1); PG8_BAR;
            PG8_LDA(At, 1, 1); PG8_STAGE(PG8_SA(1, 0), a3, voffA);
            PG8_BAR; PG8_WAIT_L(0); PG8_MMA(1, 0, At, B0); PG8_BAR; PG8_SCHED;
            PG8_STAGE(PG8_SB(1, 1), b3 + hstep, voffB);
            PG8_WAIT_V(6); PG8_BAR; PG8_MMA(1, 1, At, B1); PG8_BAR;
            }
        }
        if constexpr (ALIGN_EPI) { if (wr == 0) PG8_BAR; }
        if constexpr (!Epi::AFTER_DRAIN) { E(acc, cur, wr, wc, fr, fq); S.done(cur); }
        if (!has_next) break;
#pragma unroll
        for (int a = 0; a < 2; ++a)
#pragma unroll
            for (int b = 0; b < 2; ++b)
#pragma unroll
                for (int m = 0; m < 4; ++m)
#pragma unroll
                    for (int n = 0; n < 2; ++n) acc[a][b][m][n] = (f32x4){0.f, 0.f, 0.f, 0.f};
        cur = nxt; cA = nA; cB = nB; ++ui;
        if constexpr (ALIGN_EPI) { if (wr == 1) PG8_BAR; }
    }
    PG8_WAIT_V(0);
    if constexpr (!ALIGN_EPI) { if (wr == 0) PG8_BAR; }
    PG8_BAR;
    if constexpr (Epi::AFTER_DRAIN) { E.fused(acc, cur, wr, wc, fr, fq, lds, wid, lane); S.done(cur); }
#undef PG8_SA
#undef PG8_SB
#undef PG8_STAGE
#undef PG8_LDA
#undef PG8_LDB
#undef PG8_MMA
#undef PG8_WAIT_V
#undef PG8_WAIT_L
#undef PG8_BAR
#undef PG8_SCHED
}
}
#ifndef PG8_SP2
#define PG8_SP2 true
#endif
#ifndef PG8_ALIGN
#define PG8_ALIGN true
#endif
#ifndef MK_PER_PHASE
#define MK_PER_PHASE 0
#endif
#ifndef REP_S5
#define REP_S5 1
#endif
#ifndef REP_DSA
#define REP_DSA 1
#endif
#ifndef REP_G1
#define REP_G1 1
#endif
constexpr int NWAVES = 8;
constexpr int NPH = 14;

constexpr int NB = 16, SEQ = 2048, D = 1024, NMETA = 16, DFF = 2816;
constexpr int R = NB * SEQ;
constexpr int NG = 32, NP = 64, NM = 16;
constexpr float RMS_EPS = 1e-6f;

constexpr size_t MiB = 1u << 20;
constexpr size_t WS_CTL = 0, CTL_ZERO_BYTES = 1 * MiB;
constexpr size_t WS_WT3B = 23 * MiB  ;
constexpr size_t WS_WT1 = 2 * MiB, WS_WT2 = 13 * MiB, WS_WT3 = 19 * MiB, WS_WT4 = 27 * MiB, WS_WT5 = 38 * MiB;
constexpr size_t WS_WGLU = 44 * MiB, WS_WA = 45 * MiB, WS_WB = 46 * MiB, WS_WOUT = 47 * MiB;
constexpr size_t WS_KS = 50 * MiB, WS_KO = 58 * MiB, WS_KI = 66 * MiB;
constexpr size_t WS_META = 67 * MiB;
constexpr size_t MO_AM1 = 0, MO_ACTM = 32768, MO_FM = 131072, MO_AM2 = 262144, MO_PMU = 294912, MO_PMK = 311296;
constexpr size_t WS_HN = 68 * MiB;
constexpr size_t WS_F = 132 * MiB;
constexpr size_t WS_BIG = 196 * MiB;
constexpr size_t WS_PA = WS_BIG, WS_PG = WS_BIG + 96 * MiB, WS_PK = WS_BIG + 224 * MiB, WS_HB = WS_BIG + 240 * MiB  , WS_END = WS_BIG + 304 * MiB;
constexpr size_t WS_HB8 = WS_BIG + 64 * MiB;
constexpr size_t WS_UA2 = WS_F + 32 * MiB;
constexpr int CW_BAR = 4096;

constexpr int LDS_BYTES = 155648;
constexpr int MISC_OFF = 154624;

#define GAS __attribute__((address_space(1)))
#define LAS __attribute__((address_space(3)))
typedef unsigned short bf16;
typedef unsigned v4u __attribute__((ext_vector_type(4)));
typedef unsigned v2u __attribute__((ext_vector_type(2)));
typedef float f32x4 __attribute__((ext_vector_type(4)));
typedef short bf16x8 __attribute__((ext_vector_type(8)));
#define LDS_WAIT() asm volatile("s_waitcnt lgkmcnt(0)" ::: "memory")
#define VM_WAIT() asm volatile("s_waitcnt vmcnt(0)" ::: "memory")
__device__ __forceinline__ unsigned f2bf(float f) { unsigned u = __builtin_bit_cast(unsigned, f); return (u + 0x7fffu + ((u >> 16) & 1u)) >> 16; }
__device__ __forceinline__ unsigned pk2(float lo, float hi) { return f2bf(lo) | (f2bf(hi) << 16); }
__device__ __forceinline__ float bflo(unsigned w) { return __uint_as_float(w << 16); }
__device__ __forceinline__ float bfhi(unsigned w) { return __uint_as_float(w & 0xffff0000u); }
__device__ __forceinline__ float bf2f(bf16 v) { return __uint_as_float(((unsigned)v) << 16); }
__device__ __forceinline__ float fsig(float x) { return __builtin_amdgcn_rcpf(1.0f + __expf(-x)); }

#define XB_TMO      128
#define XB_XCNT(j)  (256  + 64 * (j))
#define XB_XSUB(j)  (1280 + 64 * (j))
#define XB_XGEN(j)  (2304 + 64 * (j))
#define XB_TOP      3328
#define XB_TOPGEN   3392
#define XCD_BAR_WORDS 3456
#define XB_SPIN_CAP (1u << 18)
__device__ __forceinline__ unsigned xb_ld(unsigned* p)              { return __hip_atomic_load(p, __ATOMIC_RELAXED, __HIP_MEMORY_SCOPE_AGENT); }
__device__ __forceinline__ unsigned xb_add(unsigned* p, unsigned v) { return __hip_atomic_fetch_add(p, v, __ATOMIC_RELAXED, __HIP_MEMORY_SCOPE_AGENT); }
__device__ __forceinline__ unsigned xb_xcc_id() { return (unsigned)__builtin_amdgcn_s_getreg((3 << 11) | 20) & 0xFu; }
#define XB_SPIN(cond, bar) do { unsigned _sp = 0; while (cond) { __builtin_amdgcn_s_sleep(1); \
    if ((++_sp & 255u) == 0u) { if (xb_ld(&(bar)[XB_TMO])) break; if (_sp > XB_SPIN_CAP) { atomicAdd(&(bar)[XB_TMO], 1u); break; } } } } while (0)
struct XcdBarrier { unsigned* bar; unsigned x; volatile LAS unsigned* st; };
__device__ __forceinline__ XcdBarrier xcd_barrier_post(unsigned* bar, volatile LAS unsigned* st) {
    XcdBarrier b; b.bar = bar; b.x = xb_xcc_id(); b.st = st;
    if (threadIdx.x == 0) (void)xb_add(&bar[XB_XCNT(b.x)], 1u);
    return b;
}
__device__ __forceinline__ void xcd_barrier_complete(unsigned* bar, unsigned x, unsigned& nloc, unsigned& nx) {
    const unsigned G = gridDim.x * gridDim.y * gridDim.z;
    unsigned sum, cnt, mine, sp = 0u;
    for (;;) {
        sum = 0u; cnt = 0u; mine = 0u;
#pragma unroll
        for (unsigned j = 0; j < 16; ++j) { const unsigned c = xb_ld(&bar[XB_XCNT(j)]); sum += c; cnt += (c > 0u) ? 1u : 0u; mine = (j == x) ? c : mine; }
        if (sum == G) break;
        __builtin_amdgcn_s_sleep(1);
        if ((++sp & 255u) == 0u) { if (xb_ld(&bar[XB_TMO])) break; if (sp > XB_SPIN_CAP) { atomicAdd(&bar[XB_TMO], 1u); break; } }
    }
    nloc = mine > 0u ? mine : 1u; nx = cnt > 0u ? cnt : 1u;
}
__device__ __forceinline__ void xcd_barrier(const XcdBarrier& b) {
    asm volatile("s_waitcnt vmcnt(0)" ::: "memory");
    __syncthreads();
    if (threadIdx.x == 0) {
        unsigned* bar = b.bar;
        __builtin_amdgcn_s_waitcnt(0);
        unsigned nloc = b.st[0], nx = b.st[1];
        if (nloc == 0u) { xcd_barrier_complete(bar, b.x, nloc, nx); b.st[0] = nloc; b.st[1] = nx; }
        const unsigned old = xb_add(&bar[XB_XSUB(b.x)], 1u);
        const unsigned gen = old / nloc;
        if (old + 1u == (gen + 1u) * nloc) {
            __builtin_amdgcn_fence(__ATOMIC_RELEASE, "agent");
            asm volatile("s_waitcnt vmcnt(0)" ::: "memory");
            const unsigned og = xb_add(&bar[XB_TOP], 1u);
            const unsigned tg = og / nx;
            if (og + 1u == (tg + 1u) * nx) xb_add(&bar[XB_TOPGEN], 1u);
            else XB_SPIN(xb_ld(&bar[XB_TOPGEN]) == tg, bar);
            __builtin_amdgcn_fence(__ATOMIC_ACQUIRE, "agent");
            xb_add(&bar[XB_XGEN(b.x)], 1u);
            asm volatile("s_waitcnt vmcnt(0)" ::: "memory");
        } else {
            XB_SPIN(xb_ld(&bar[XB_XGEN(b.x)]) == gen, bar);
            __builtin_amdgcn_fence(__ATOMIC_ACQUIRE, "agent");
            asm volatile("s_waitcnt vmcnt(0)" ::: "memory");
        }
    }
    __syncthreads();
}

__device__ __forceinline__ float wave_sum(float v) {
#pragma unroll
    for (int o = 1; o < 64; o <<= 1) v += __shfl_xor(v, o);
    return v;
}
__device__ __forceinline__ f32x4 mfma16(bf16x8 a, bf16x8 b, f32x4 c) { return __builtin_amdgcn_mfma_f32_16x16x32_bf16(a, b, c, 0, 0, 0); }

__device__ __forceinline__ void transpose_item(const float* W, int Nsrc, int K, bf16* WT, int k0, int drow0, int srccol, LAS float* scr, int lane, const float* gk = nullptr) {
#pragma unroll 8
    for (int i = 0; i < 32; ++i) { const int kk = 2 * i + (lane >> 5); float wv_ = (srccol >= 0) ? W[(size_t)(k0 + kk) * Nsrc + srccol] : 0.f; if (gk) wv_ *= gk[k0 + kk]; scr[kk * 33 + (lane & 31)] = wv_; }
    LDS_WAIT(); asm volatile("" ::: "memory");
    const int c = lane & 7;
#pragma unroll
    for (int j = 0; j < 4; ++j) { const int n = (lane >> 3) + 8 * j; const LAS float* s = scr + (8 * c) * 33 + n;
        v4u o; o.x = pk2(s[0 * 33], s[1 * 33]); o.y = pk2(s[2 * 33], s[3 * 33]); o.z = pk2(s[4 * 33], s[5 * 33]); o.w = pk2(s[6 * 33], s[7 * 33]);
        *(v4u*)(WT + (size_t)(drow0 + n) * K + k0 + 8 * c) = o; }
    LDS_WAIT(); asm volatile("" ::: "memory");
}

__device__ __forceinline__ unsigned pk4q(float a, float b, float c, float d) { int w = 0; w = __builtin_amdgcn_cvt_pk_fp8_f32(fminf(fmaxf(a, -448.f), 448.f), fminf(fmaxf(b, -448.f), 448.f), w, false);
    w = __builtin_amdgcn_cvt_pk_fp8_f32(fminf(fmaxf(c, -448.f), 448.f), fminf(fmaxf(d, -448.f), 448.f), w, true); return (unsigned)w; }
__device__ __forceinline__ void transpose_item8(const float* W, int Nsrc, int K, unsigned char* WT8, int k0, int drow0, int srccol, LAS float* scr, int lane, const float* gk = nullptr) {
#pragma unroll 8
    for (int i = 0; i < 32; ++i) { const int kk = 2 * i + (lane >> 5); float wv_ = W[(size_t)(k0 + kk) * Nsrc + srccol] * 64.0f; if (gk) wv_ *= gk[k0 + kk]; scr[kk * 33 + (lane & 31)] = wv_; }
    LDS_WAIT(); asm volatile("" ::: "memory");
    const int c = lane & 7;
#pragma unroll
    for (int j = 0; j < 4; ++j) { const int n = (lane >> 3) + 8 * j; const LAS float* sp = scr + (8 * c) * 33 + n;
        v2u o; o.x = pk4q(sp[0 * 33], sp[1 * 33], sp[2 * 33], sp[3 * 33]); o.y = pk4q(sp[4 * 33], sp[5 * 33], sp[6 * 33], sp[7 * 33]);
        *(v2u*)(WT8 + (size_t)(drow0 + n) * K + k0 + 8 * c) = o; }
    LDS_WAIT(); asm volatile("" ::: "memory");
}
__device__ __forceinline__ int win_srccol(int d) {
    if (d < 1024) return d;
    if (d < 1536) return 1096 + (d - 1024);
    if (d < 1600) return 1024 + (d - 1536);
    if (d < 1664) return 1608 + (d - 1600);
    if (d < 1728) return 1672 + (d - 1664);
    if (d < 1736) return 1088 + (d - 1728);
    return -1;
}
__device__ __forceinline__ void norm_row_to_bf16(const float* xrow, const float* g, bf16* orow, int lane) {
    f32x4 v[4]; float ss = 0.f;
#pragma unroll
    for (int j = 0; j < 4; ++j) { v[j] = ((const f32x4*)xrow)[lane + 64 * j]; ss += (v[j].x * v[j].x + v[j].y * v[j].y) + (v[j].z * v[j].z + v[j].w * v[j].w); }
    const float rs = rsqrtf(wave_sum(ss) * (1.f / D) + RMS_EPS);
#pragma unroll
    for (int j = 0; j < 4; ++j) { const f32x4 gv = ((const f32x4*)g)[lane + 64 * j]; v2u o; o.x = pk2(v[j].x * rs * gv.x, v[j].y * rs * gv.y); o.y = pk2(v[j].z * rs * gv.z, v[j].w * rs * gv.w);
        ((v2u*)orow)[lane + 64 * j] = o; }
}
template <bool PRESCALE>
__device__ __forceinline__ void x_row_to_bf16(const float* xrow, bf16* orow, float* rs_out, int lane) {
    f32x4 v[4]; float ss = 0.f;
#pragma unroll
    for (int j = 0; j < 4; ++j) { v[j] = ((const f32x4*)xrow)[lane + 64 * j]; ss += (v[j].x * v[j].x + v[j].y * v[j].y) + (v[j].z * v[j].z + v[j].w * v[j].w); }
    const float rs = rsqrtf(wave_sum(ss) * (1.f / D) + RMS_EPS), pre = PRESCALE ? rs : 1.0f;
#pragma unroll
    for (int j = 0; j < 4; ++j) { v2u o; o.x = pk2(v[j].x * pre, v[j].y * pre); o.y = pk2(v[j].z * pre, v[j].w * pre); ((v2u*)orow)[lane + 64 * j] = o; }
    if (rs_out && lane == 0) *rs_out = rs;
}
template <bool BASE_BF16, bool OUT_BF16, bool HN_F8 = false>
__device__ __forceinline__ void row_update(const bf16* frow, const void* base, void* outrow, bf16* hnrow, const float* gpost, const float* gnext, float scale, int lane, float* rs_out = nullptr, unsigned* h8row = nullptr) {
    f32x4 f[4], h[4]; float ss = 0.f;
#pragma unroll
    for (int j = 0; j < 4; ++j) { const v2u w = ((const v2u*)frow)[lane + 64 * j]; f[j] = (f32x4){bflo(w.x), bfhi(w.x), bflo(w.y), bfhi(w.y)};
        ss += (f[j].x * f[j].x + f[j].y * f[j].y) + (f[j].z * f[j].z + f[j].w * f[j].w); }
    const float rs = rsqrtf(wave_sum(ss) * (1.f / D) + RMS_EPS) * scale; float s2 = 0.f;
#pragma unroll
    for (int j = 0; j < 4; ++j) { const f32x4 gv = ((const f32x4*)gpost)[lane + 64 * j]; f32x4 bv;
        if (BASE_BF16) { const v2u w = ((const v2u*)base)[lane + 64 * j]; bv = (f32x4){bflo(w.x), bfhi(w.x), bflo(w.y), bfhi(w.y)}; } else bv = ((const f32x4*)base)[lane + 64 * j];
        h[j] = bv + f[j] * rs * gv; s2 += (h[j].x * h[j].x + h[j].y * h[j].y) + (h[j].z * h[j].z + h[j].w * h[j].w); }
    if (h8row) {
#pragma unroll
        for (int j = 0; j < 4; ++j) h8row[lane + 64 * j] = pk4q(4.0f * h[j].x, 4.0f * h[j].y, 4.0f * h[j].z, 4.0f * h[j].w); }
    if (outrow) {
#pragma unroll
        for (int j = 0; j < 4; ++j) { if (OUT_BF16) { v2u o; o.x = pk2(h[j].x, h[j].y); o.y = pk2(h[j].z, h[j].w); ((v2u*)outrow)[lane + 64 * j] = o; } else ((f32x4*)outrow)[lane + 64 * j] = h[j]; } }
    if (hnrow || rs_out) { const float r2 = rsqrtf(wave_sum(s2) * (1.f / D) + RMS_EPS); if (rs_out && lane == 0) *rs_out = r2;
        if (hnrow)
#pragma unroll
        for (int j = 0; j < 4; ++j) { const f32x4 gv = gnext ? ((const f32x4*)gnext)[lane + 64 * j] : (f32x4){1.f, 1.f, 1.f, 1.f};
            if (HN_F8) { const float q = 4.0f * r2; ((unsigned*)hnrow)[lane + 64 * j] = pk4q(h[j].x * q * gv.x, h[j].y * q * gv.y, h[j].z * q * gv.z, h[j].w * q * gv.w); }
            else { v2u o; o.x = pk2(h[j].x * r2 * gv.x, h[j].y * r2 * gv.y); o.y = pk2(h[j].z * r2 * gv.z, h[j].w * r2 * gv.w); ((v2u*)hnrow)[lane + 64 * j] = o; } } }
}
__device__ __forceinline__ f32x4 meta_tile(const bf16* A, const bf16* B, int K, int lane) {
    const int fr = lane & 15, kq = lane >> 4; const bf16* ap = A + (size_t)fr * K + 8 * kq; const bf16* bp = B + (size_t)fr * K + 8 * kq;
    f32x4 acc = (f32x4){0.f, 0.f, 0.f, 0.f};
#pragma unroll 4
    for (int k = 0; k < K; k += 32) { const bf16x8 a = *(const bf16x8*)(ap + k); const bf16x8 b = *(const bf16x8*)(bp + k); acc = mfma16(a, b, acc); }
    return acc;
}


template <int STEPS>
__device__ __forceinline__ void meta_tile_blk(const bf16* A, const bf16* B0, const bf16* B1, int K, LAS float* red, int wave, int lane, f32x4& c0, f32x4& c1) {
    const int fr = lane & 15, kq = lane >> 4, k0 = wave * (32 * STEPS);
    const bf16* ap = A + (size_t)fr * K + k0 + 8 * kq; const bf16* bp0 = B0 + (size_t)fr * K + k0 + 8 * kq; const bf16* bp1 = (B1 ? B1 : B0) + (size_t)fr * K + k0 + 8 * kq;
    bf16x8 av[STEPS], bv0[STEPS], bv1[STEPS];
#pragma unroll
    for (int i = 0; i < STEPS; ++i) { av[i] = *(const bf16x8*)(ap + 32 * i); bv0[i] = *(const bf16x8*)(bp0 + 32 * i); bv1[i] = *(const bf16x8*)(bp1 + 32 * i); }
    f32x4 a0 = (f32x4){0.f, 0.f, 0.f, 0.f}, a1 = a0;
#pragma unroll
    for (int i = 0; i < STEPS; ++i) { a0 = mfma16(av[i], bv0[i], a0); a1 = mfma16(av[i], bv1[i], a1); }
    *(LAS f32x4*)(red + (wave * 64 + lane) * 8) = a0; *(LAS f32x4*)(red + (wave * 64 + lane) * 8 + 4) = a1;
    __syncthreads();
    c0 = (f32x4){0.f, 0.f, 0.f, 0.f}; c1 = c0;
#pragma unroll
    for (int w2 = 0; w2 < 8; ++w2) { c0 += *(const LAS f32x4*)(red + (w2 * 64 + lane) * 8); c1 += *(const LAS f32x4*)(red + (w2 * 64 + lane) * 8 + 4); }
    __syncthreads();
}

struct Args { const float* in[28]; float* out; unsigned char* ws; int ph_lo, ph_hi; };

__device__ __forceinline__ void s5_tables_block(const Args& a, int g, int oct, LAS float* sc, int tid) {
    const float* lam_re = a.in[15]; const float* lam_im = a.in[16]; const float* log_dt = a.in[17];
    const float* b_re = a.in[18]; const float* b_im = a.in[19]; const float* c_re = a.in[20]; const float* c_im = a.in[21]; const float* dsk = a.in[22];
    LAS float* CR = sc; LAS float* CI = sc + 1024; LAS float* BR = sc + 2048; LAS float* BI = sc + 3072;
    LAS float* ANG = sc + 4096; LAS float* LRDT = sc + 4160; LAS float* CFR = sc + 4224; LAS float* CFI = sc + 4288;
    LAS float* WR = sc + 4352; LAS float* WI = sc + 4864;
    __syncthreads();
#pragma unroll
    for (int k = 0; k < 2; ++k) { const int e = tid + 512 * k; CR[e] = c_re[g * 1024 + e]; CI[e] = c_im[g * 1024 + e]; BR[e] = b_re[g * 1024 + e]; BI[e] = b_im[g * 1024 + e]; }
    if (tid < 64) { const int p = tid; const float lr = lam_re[g * 64 + p], li = lam_im[g * 64 + p], dt = expf(log_dt[g]);
        const float ang = li * dt, mag = expf(lr * dt); float s1, c1; sincosf(ang, &s1, &c1);
        const float a_re = mag * c1, a_im = mag * s1, den = lr * lr + li * li, nr = a_re - 1.0f, ni = a_im;
        ANG[p] = ang; LRDT[p] = lr * dt; CFR[p] = (nr * lr + ni * li) / den; CFI[p] = (ni * lr - nr * li) / den; }
    __syncthreads();
    const int ti = tid >> 6, p64 = tid & 63, idx0 = 8 * oct;
    { const float n = (float)(idx0 + ti); float sn, cn; sincosf(n * ANG[p64], &sn, &cn); const float mn = expf(n * LRDT[p64]); const float pr = mn * cn, pi = mn * sn;
      WR[tid] = pr * CFR[p64] - pi * CFI[p64]; WI[tid] = pr * CFI[p64] + pi * CFR[p64]; }
    __syncthreads();
#pragma unroll
    for (int k = 0; k < 4; ++k) { const int e = tid + 512 * k, t8 = e >> 8, m = (e >> 4) & 15, mp = e & 15; float s = 0.f;
        for (int p = 0; p < 64; ++p) { const float wr_ = WR[t8 * 64 + p], wi_ = WI[t8 * 64 + p], br = BR[p * 16 + mp], bi = BI[p * 16 + mp];
            const float zr = wr_ * br - wi_ * bi, zi = wr_ * bi + wi_ * br; s += CR[m * 64 + p] * zr - CI[m * 64 + p] * zi; }
        if (idx0 + t8 == 0 && m == mp) s += dsk[g * 16 + m];
        ((bf16*)(a.ws + WS_KI))[((g * 64 + idx0 + t8) * 16 + m) * 16 + mp] = (bf16)f2bf(s); }
    __syncthreads();
    { const float n = (float)(63 - (idx0 + ti)); float sn, cn; sincosf(n * ANG[p64], &sn, &cn); const float mn = expf(n * LRDT[p64]); const float pr = mn * cn, pi = mn * sn;
      WR[tid] = pr * CFR[p64] - pi * CFI[p64]; WI[tid] = pr * CFI[p64] + pi * CFR[p64]; }
    __syncthreads();
    for (int k = 0; k < 32; ++k) { const int e = tid + 512 * k, t8 = e >> 11, n_ = (e >> 4) & 127, mp = e & 15, p = n_ & 63;
        const float wr_ = WR[t8 * 64 + p], wi_ = WI[t8 * 64 + p], br = BR[p * 16 + mp], bi = BI[p * 16 + mp];
        const float zr = wr_ * br - wi_ * bi, zi = wr_ * bi + wi_ * br;
        ((bf16*)(a.ws + WS_KS))[((size_t)(g * 64 + idx0 + t8) * 128 + n_) * 16 + mp] = (bf16)f2bf(n_ < 64 ? zr : zi); }
    __syncthreads();
    { const float n = (float)(idx0 + ti + 1); float sn, cn; sincosf(n * ANG[p64], &sn, &cn); const float mn = expf(n * LRDT[p64]); WR[tid] = mn * cn; WI[tid] = mn * sn; }
    __syncthreads();
    for (int k = 0; k < 32; ++k) { const int e = tid + 512 * k, t8 = e >> 11, m = (e >> 7) & 15, kk = e & 127, p = kk & 63;
        const float cr = CR[m * 64 + p], ci = CI[m * 64 + p], ar_ = WR[t8 * 64 + p], ai_ = WI[t8 * 64 + p];
        const float wr_ = cr * ar_ - ci * ai_, wi_ = cr * ai_ + ci * ar_;
        ((bf16*)(a.ws + WS_KO))[((size_t)(g * 64 + idx0 + t8) * 16 + m) * 128 + kk] = (bf16)f2bf(kk < 64 ? wr_ : -wi_); }
}

constexpr int S5_U = 0, S5_USTR = 2064, S5_KI = 66048, S5_SLOC = 98816, S5_XINB = 115200, S5_XSTR = 272, S5_MISC = 123904;
__device__ __forceinline__ float gelu_tanh(float x) { const float z = 0.7978845608028654f * (x + 0.044715f * x * x * x); return x * fsig(2.0f * z); }
__device__ __forceinline__ void s5_meta(const Args& a, LAS unsigned char* L, int g, int tid) {
    const int lane = tid & 63; const bf16* PMU = (const bf16*)(a.ws + WS_META + MO_PMU); LAS float* MS = (LAS float*)(L + S5_MISC);
    if (tid < 64) { const int p = lane; const float lr = a.in[15][g * 64 + p], li = a.in[16][g * 64 + p], dt = expf(a.in[17][g]);
        const float ang = li * dt, mag = expf(lr * dt); float s1, c1; sincosf(ang, &s1, &c1);
        const float a_re = mag * c1, a_im = mag * s1, den = lr * lr + li * li, nr = a_re - 1.0f, ni = a_im;
        const float cf_re = (nr * lr + ni * li) / den, cf_im = (ni * lr - nr * li) / den;
        float bb_re[16], bb_im[16];
#pragma unroll
        for (int m = 0; m < 16; ++m) { const float br = a.in[18][(g * 64 + p) * 16 + m], bi = a.in[19][(g * 64 + p) * 16 + m]; bb_re[m] = cf_re * br - cf_im * bi; bb_im[m] = cf_re * bi + cf_im * br; }
        LAS bf16* UM = (LAS bf16*)(L + S5_MISC + 1024);
        if (lane < 32) *(LAS v4u*)(UM + lane * 8) = *(const v4u*)(PMU + (lane >> 1) * 512 + 16 * g + 8 * (lane & 1));
        LDS_WAIT();
        float xr = 0.f, xi = 0.f;
#pragma unroll
        for (int i = 0; i < 16; ++i) { float ur = 0.f, ui = 0.f; const v4u w0 = *(const LAS v4u*)(UM + i * 16), w1 = *(const LAS v4u*)(UM + i * 16 + 8);
            const float uu[16] = {bflo(w0.x), bfhi(w0.x), bflo(w0.y), bfhi(w0.y), bflo(w0.z), bfhi(w0.z), bflo(w0.w), bfhi(w0.w), bflo(w1.x), bfhi(w1.x), bflo(w1.y), bfhi(w1.y), bflo(w1.z), bfhi(w1.z), bflo(w1.w), bfhi(w1.w)};
#pragma unroll
            for (int m = 0; m < 16; ++m) { ur += bb_re[m] * uu[m]; ui += bb_im[m] * uu[m]; }
            const float nr2 = a_re * xr - a_im * xi + ur, ni2 = a_re * xi + a_im * xr + ui; xr = nr2; xi = ni2; }
        float s64, c64; sincosf(64.0f * ang, &s64, &c64); const float m64 = expf(64.0f * lr * dt);
        MS[p] = xr; MS[64 + p] = xi; MS[128 + p] = m64 * c64; MS[192 + p] = m64 * s64; }
}
__device__ __forceinline__ void s5_unit(const Args& a, LAS unsigned char* L, int b, int g, int tid) {
    const int lane = tid & 63, w = __builtin_amdgcn_readfirstlane(tid >> 6), fr = lane & 15, kq = lane >> 4;
    const bf16* UA2 = (const bf16*)(a.ws + WS_UA2) + (size_t)(b * 32 + g) * 2048 * 16;
    const bf16* KS = (const bf16*)(a.ws + WS_KS); const bf16* KO = (const bf16*)(a.ws + WS_KO); const bf16* KI = (const bf16*)(a.ws + WS_KI);
    bf16* YA = (bf16*)(a.ws + WS_F);
    LAS float* SLOC = (LAS float*)(L + S5_SLOC); LAS float* MS = (LAS float*)(L + S5_MISC);
    __syncthreads();
#pragma unroll
    for (int k = 0; k < 8; ++k) { const int idx = tid + 512 * k, t = idx >> 1, hf = idx & 1;
        const v4u v = *(const v4u*)(UA2 + (size_t)idx * 8);
        *(LAS v4u*)(L + S5_U + (t >> 6) * S5_USTR + (t & 63) * 32 + 16 * hf) = v; }
#pragma unroll
    for (int k = 0; k < 4; ++k) { const int idx = tid + 512 * k; *(LAS v4u*)(L + S5_KI + idx * 16) = *(const v4u*)(KI + (size_t)g * 16384 + idx * 8); }
    bf16x8 bfr[16];
#pragma unroll
    for (int k = 0; k < 16; ++k) { const int i = 2 * k + (kq >> 1); bfr[k] = *(const bf16x8*)(KS + ((size_t)(g * 64 + i) * 128 + 16 * w + fr) * 16 + 8 * (kq & 1)); }
    __syncthreads();
    { f32x4 acc0 = (f32x4){0.f, 0.f, 0.f, 0.f}, acc1 = acc0;
#pragma unroll
      for (int hb = 0; hb < 2; ++hb) {
          if (hb == 1) {
#pragma unroll
              for (int k = 0; k < 16; ++k) { const int i = 2 * (16 + k) + (kq >> 1); bfr[k] = *(const bf16x8*)(KS + ((size_t)(g * 64 + i) * 128 + 16 * w + fr) * 16 + 8 * (kq & 1)); } }
#pragma unroll
          for (int k = 0; k < 16; ++k) { const int ks = 16 * hb + k;
              const bf16x8 a0 = *(const LAS bf16x8*)(L + S5_U + fr * S5_USTR + (32 * ks + 8 * kq) * 2);
              const bf16x8 a1 = *(const LAS bf16x8*)(L + S5_U + (16 + fr) * S5_USTR + (32 * ks + 8 * kq) * 2);
              acc0 = mfma16(a0, bfr[k], acc0); acc1 = mfma16(a1, bfr[k], acc1); } }
#pragma unroll
      for (int r = 0; r < 4; ++r) { SLOC[(4 * kq + r) * 128 + 16 * w + fr] = acc0[r]; SLOC[(16 + 4 * kq + r) * 128 + 16 * w + fr] = acc1[r]; } }
    bf16x8 ko[4];
#pragma unroll
    for (int ks = 0; ks < 4; ++ks) ko[ks] = *(const bf16x8*)(KO + ((size_t)(g * 64 + w) * 16 + fr) * 128 + 32 * ks + 8 * kq);
    __syncthreads();
    if (w == 0) { const int p = lane; float sr[32], si[32];
#pragma unroll
        for (int c = 0; c < 32; ++c) { sr[c] = SLOC[c * 128 + p]; si[c] = SLOC[c * 128 + 64 + p]; }
        float xr = MS[p], xi = MS[64 + p]; const float ar = MS[128 + p], ai = MS[192 + p];
#pragma unroll
        for (int c = 0; c < 32; ++c) { *(LAS bf16*)(L + S5_XINB + c * S5_XSTR + p * 2) = (bf16)f2bf(xr); *(LAS bf16*)(L + S5_XINB + c * S5_XSTR + (64 + p) * 2) = (bf16)f2bf(xi);
            const float nr2 = ar * xr - ai * xi + sr[c], ni2 = ar * xi + ai * xr + si[c]; xr = nr2; xi = ni2; } }
    __syncthreads();
    for (int jj = 0; jj < 8; ++jj) { const int j = w + 8 * jj;
        bf16x8 kon[4];
#pragma unroll
        for (int ks = 0; ks < 4; ++ks) kon[ks] = ko[ks];
        if (jj < 7) {
#pragma unroll
            for (int ks = 0; ks < 4; ++ks) kon[ks] = *(const bf16x8*)(KO + ((size_t)(g * 64 + j + 8) * 16 + fr) * 128 + 32 * ks + 8 * kq); }
        f32x4 acc0 = (f32x4){0.f, 0.f, 0.f, 0.f}, acc1 = acc0;
#pragma unroll
        for (int ks = 0; ks < 4; ++ks) {
            const bf16x8 a0 = *(const LAS bf16x8*)(L + S5_XINB + fr * S5_XSTR + (32 * ks + 8 * kq) * 2);
            const bf16x8 a1 = *(const LAS bf16x8*)(L + S5_XINB + (16 + fr) * S5_XSTR + (32 * ks + 8 * kq) * 2);
            acc0 = mfma16(a0, ko[ks], acc0); acc1 = mfma16(a1, ko[ks], acc1); }
        const int nks = (j >> 1) + 1;
#pragma unroll 2
        for (int ks = 0; ks < nks; ++ks) { const int i = 2 * ks + (kq >> 1), tau = j - i;
            bf16x8 bq = *(const LAS bf16x8*)(L + S5_KI + (((tau < 0 ? 0 : tau) * 16 + fr) * 16 + 8 * (kq & 1)) * 2);
            if (tau < 0) bq = (bf16x8){0, 0, 0, 0, 0, 0, 0, 0};
            const bf16x8 a0 = *(const LAS bf16x8*)(L + S5_U + fr * S5_USTR + (32 * ks + 8 * kq) * 2);
            const bf16x8 a1 = *(const LAS bf16x8*)(L + S5_U + (16 + fr) * S5_USTR + (32 * ks + 8 * kq) * 2);
            acc0 = mfma16(a0, bq, acc0); acc1 = mfma16(a1, bq, acc1); }
#pragma unroll
        for (int r = 0; r < 4; ++r) { const int c0 = 4 * kq + r, c1 = 16 + 4 * kq + r;
            YA[(size_t)(b * 2048 + 64 * c0 + j) * 512 + 16 * g + fr] = (bf16)f2bf(gelu_tanh(acc0[r]));
            YA[(size_t)(b * 2048 + 64 * c1 + j) * 512 + 16 * g + fr] = (bf16)f2bf(gelu_tanh(acc1[r])); }
#pragma unroll
        for (int ks = 0; ks < 4; ++ks) ko[ks] = kon[ks]; }
}

constexpr int DS_SSTR = 2120, DS_TSTR = 144, DS_BUF = 18432  , DS_BT = 36864  , DS_HIST = 135680, DS_MASK = 143872, DS_RB = 152576, DS_TB = 153600;
typedef short s16x4 __attribute__((ext_vector_type(4)));
__device__ __forceinline__ s16x4 tr_read(unsigned addr) { s16x4 r; asm volatile("ds_read_b64_tr_b16 %0, %1" : "=&v"(r) : "v"(addr) : "memory"); return r; }
__device__ __forceinline__ float relu_i(float x) { const int i = __builtin_bit_cast(int, x); return __builtin_bit_cast(float, i > 0 ? i : 0); }
__device__ __forceinline__ unsigned f16key(float f) { const _Float16 hf = (_Float16)f; const unsigned h = (unsigned)__builtin_bit_cast(unsigned short, hf); return (h & 0x8000u) ? (~h & 0xffffu) : (h | 0x8000u); }
__device__ __forceinline__ unsigned cvtpk(float lo, float hi) { unsigned r; asm volatile("v_cvt_pk_bf16_f32 %0, %1, %2" : "=v"(r) : "v"(lo), "v"(hi)); return r; }
__device__ __forceinline__ void dsa_tables(const Args& a, LAS unsigned char* L, int tid) {
    if (tid < 256) { ((LAS float*)(L + DS_RB))[tid] = a.in[25][tid] * 1.44269504f;
        const int n = tid; const int lo = n < 8 ? n : (n < 12 ? 8 : n < 16 ? 9 : n < 23 ? 10 : n < 32 ? 11 : n < 46 ? 12 : n < 64 ? 13 : n < 91 ? 14 : 15);
        ((LAS int*)(L + DS_TB))[tid] = lo; }
}

__device__ __forceinline__ int wave_incl_scan(int x) {
    int v = x;
    v += __builtin_amdgcn_update_dpp(0, v, 0x111, 0xf, 0xf, false);
    v += __builtin_amdgcn_update_dpp(0, v, 0x112, 0xf, 0xf, false);
    v += __builtin_amdgcn_update_dpp(0, v, 0x114, 0xf, 0xf, false);
    v += __builtin_amdgcn_update_dpp(0, v, 0x118, 0xf, 0xf, false);
    v += __builtin_amdgcn_update_dpp(0, v, 0x142, 0xa, 0xf, false);
    v += __builtin_amdgcn_update_dpp(0, v, 0x143, 0xc, 0xf, false);
    return v;
}
template <int NE>
__device__ __forceinline__ void dsa_select(LAS unsigned char* L, int c, int nt64, int w, int lane) {
    LAS unsigned short* S16 = (LAS unsigned short*)L; LAS unsigned long long* MASK = (LAS unsigned long long*)(L + DS_MASK);
    LAS unsigned* H = (LAS unsigned*)(L + DS_HIST) + w * 256;
    const int rl = 63 - lane;
    for (int qq = 0; qq < 4; ++qq) { const int q = 4 * w + qq; const LAS unsigned short* Sq = S16 + q * DS_SSTR; unsigned tkey = 0u;
        unsigned kr[NE];
#pragma unroll
        for (int e = 0; e < NE; ++e) kr[e] = (unsigned)Sq[64 * e + lane];
        if (c >= 4) { unsigned prefix = 0u; int kth = 256;
#pragma unroll
            for (int pass = 0; pass < 2; ++pass) {
                H[lane] = 0u; H[lane + 64] = 0u; H[lane + 128] = 0u; H[lane + 192] = 0u; LDS_WAIT();
#pragma unroll
                for (int e = 0; e < NE; ++e) { const unsigned key = kr[e]; const bool in = (pass == 0) ? (key != 0u) : ((key >> 8) == prefix);
                    if (in) (void)__hip_atomic_fetch_add(&H[pass == 0 ? (key >> 8) : (key & 255u)], 1u, __ATOMIC_RELAXED, __HIP_MEMORY_SCOPE_WORKGROUP); }
                LDS_WAIT();
                const unsigned h0 = H[4 * rl], h1 = H[4 * rl + 1], h2 = H[4 * rl + 2], h3 = H[4 * rl + 3]; const int t = (int)(h0 + h1 + h2 + h3);
                const int sfx = wave_incl_scan(t), above = sfx - t; const bool has = (above < kth) && (above + t >= kth);
                const unsigned long long bm = __ballot(has); const int src = bm ? (__ffsll((long long)bm) - 1) : 0;
                int cum = above, B; if (cum + (int)h3 >= kth) B = 3; else { cum += (int)h3; if (cum + (int)h2 >= kth) B = 2; else { cum += (int)h2; if (cum + (int)h1 >= kth) B = 1; else { cum += (int)h1; B = 0; } } }
                const int bin = __builtin_amdgcn_readlane(4 * rl + B, src); kth = __builtin_amdgcn_readlane(kth - cum, src);
                prefix = (prefix << 8) | (unsigned)bin; LDS_WAIT(); }
            tkey = prefix; }
        unsigned mlo = 0u, mhi = 0u;
#pragma unroll
        for (int e = 0; e < NE; ++e) { const int s = 64 * e + lane; const bool sel = ((s < 16) || (s >= 64)) && (kr[e] >= tkey);
            const unsigned long long m = __ballot(sel); mlo = (lane == e) ? (unsigned)m : mlo; mhi = (lane == e) ? (unsigned)(m >> 32) : mhi; }
        if (lane < nt64) MASK[q * 34 + lane] = ((unsigned long long)mhi << 32) | mlo; }
}
__device__ __forceinline__ void dsa_unit(const Args& a, LAS unsigned char* L, int b, int uq, int tid) {
    const int lane = tid & 63, w = __builtin_amdgcn_readfirstlane(tid >> 6), fr = lane & 15, kq = lane >> 4;
    const bf16* PA = (const bf16*)(a.ws + WS_PA); const bf16* PK = (const bf16*)(a.ws + WS_PK); const bf16* PMK = (const bf16*)(a.ws + WS_META + MO_PMK);
    bf16* YB = (bf16*)(a.ws + WS_HN) + (size_t)R * 512;
    const int c = 1 + (uq >> 1), nt64 = c + 1, qrow0 = b * 2048 + 32 * uq;
    LAS unsigned short* S16 = (LAS unsigned short*)L; LAS unsigned long long* MASK = (LAS unsigned long long*)(L + DS_MASK);
    const LAS float* RB = (const LAS float*)(L + DS_RB); const LAS int* TB = (const LAS int*)(L + DS_TB);
    __syncthreads();
    { const int qh = w >> 2; bf16x8 qa[4][2][2]; float wv[4][2][4];
#pragma unroll
      for (int p = 0; p < 4; ++p) {
#pragma unroll
          for (int hf = 0; hf < 2; ++hf)
#pragma unroll
              for (int ks = 0; ks < 2; ++ks) qa[p][hf][ks] = *(const bf16x8*)(PA + (size_t)(qrow0 + 16 * qh + 4 * p + (fr >> 2)) * 1024 + (4 * hf + (fr & 3)) * 64 + 32 * ks + 8 * kq);
          const v4u wraw = *(const v4u*)(PK + (size_t)(qrow0 + 16 * qh + 4 * p + kq) * 256 + 192);
          wv[p][0][0] = bflo(wraw.x) * 0.04419417382f; wv[p][0][1] = bfhi(wraw.x) * 0.04419417382f; wv[p][0][2] = bflo(wraw.y) * 0.04419417382f; wv[p][0][3] = bfhi(wraw.y) * 0.04419417382f;
          wv[p][1][0] = bflo(wraw.z) * 0.04419417382f; wv[p][1][1] = bfhi(wraw.z) * 0.04419417382f; wv[p][1][2] = bflo(wraw.w) * 0.04419417382f; wv[p][1][3] = bfhi(wraw.w) * 0.04419417382f; }
      const int nkt = 4 * nt64;
      { const int ner = nt64 <= 9 ? 9 : nt64 <= 17 ? 17 : nt64 <= 25 ? 25 : 33;
        for (int kz = 4 * nt64 + (w & 3); kz < 4 * ner; kz += 4) {
#pragma unroll
            for (int p = 0; p < 4; ++p) S16[(16 * qh + 4 * p + kq) * DS_SSTR + 16 * kz + fr] = (unsigned short)0; } }
      if ((w & 3) != 0) {
#pragma unroll
          for (int p = 0; p < 4; ++p) S16[(16 * qh + 4 * p + kq) * DS_SSTR + 16 * (w & 3) + fr] = (unsigned short)0; }
      int kt = (w & 3) == 0 ? 0 : (w & 3) + 4;
      bf16x8 kb0, kb1, kc0, kc1;
      { const bf16* krow = (kt == 0) ? PMK + fr * 256 : PK + (size_t)(b * 2048 + 16 * kt - 64 + fr) * 256; kb0 = *(const bf16x8*)(krow + 8 * kq); kb1 = *(const bf16x8*)(krow + 32 + 8 * kq); }
      { const int k1 = (kt == 0) ? 4 : kt + 4; kc0 = kb0; kc1 = kb1;
        if (k1 < nkt) { const bf16* krow = PK + (size_t)(b * 2048 + 16 * k1 - 64 + fr) * 256; kc0 = *(const bf16x8*)(krow + 8 * kq); kc1 = *(const bf16x8*)(krow + 32 + 8 * kq); } }
      while (kt < nkt) {
          const int ktn = (kt == 0) ? 4 : kt + 4, ktnn = ktn + 4; bf16x8 nb0 = kc0, nb1 = kc1;
          if (ktnn < nkt) { const bf16* krow = PK + (size_t)(b * 2048 + 16 * ktnn - 64 + fr) * 256; nb0 = *(const bf16x8*)(krow + 8 * kq); nb1 = *(const bf16x8*)(krow + 32 + 8 * kq); }
#pragma unroll
          for (int p = 0; p < 4; ++p) { f32x4 aA = (f32x4){0.f, 0.f, 0.f, 0.f}, aB = aA;
              aA = mfma16(qa[p][0][0], kb0, aA); aB = mfma16(qa[p][1][0], kb0, aB); aA = mfma16(qa[p][0][1], kb1, aA); aB = mfma16(qa[p][1][1], kb1, aB);
              const float v = (relu_i(aA[0]) * wv[p][0][0] + relu_i(aA[1]) * wv[p][0][1]) + (relu_i(aA[2]) * wv[p][0][2] + relu_i(aA[3]) * wv[p][0][3])
                            + (relu_i(aB[0]) * wv[p][1][0] + relu_i(aB[1]) * wv[p][1][1]) + (relu_i(aB[2]) * wv[p][1][2] + relu_i(aB[3]) * wv[p][1][3]);
              S16[(16 * qh + 4 * p + kq) * DS_SSTR + 16 * kt + fr] = (unsigned short)f16key(v); }
          kb0 = kc0; kb1 = kc1; kc0 = nb0; kc1 = nb1; kt = ktn; } }
    __syncthreads();
    bf16x8 qb[2][2]; unsigned mkoff[2];
#pragma unroll
    for (int cg = 0; cg < 2; ++cg) { const int q = 4 * w + 2 * cg + (fr >> 3), h = fr & 7; mkoff[cg] = q * 34;
#pragma unroll
        for (int ks = 0; ks < 2; ++ks) qb[cg][ks] = *(const bf16x8*)(PA + (size_t)(qrow0 + q) * 1024 + 512 + h * 64 + 32 * ks + 8 * kq); }
    const int skey = tid >> 3, spiece = tid & 7;
    v4u kv0 = (v4u){0u, 0u, 0u, 0u}, vv0 = kv0, kv, vv;
    if (skey < 16) { const bf16* krow = PMK + skey * 256; kv0 = *(const v4u*)(krow + 64 + 8 * spiece); vv0 = *(const v4u*)(krow + 128 + 8 * spiece); }
    { const bf16* krow = PK + (size_t)(b * 2048 + skey) * 256; kv = *(const v4u*)(krow + 64 + 8 * spiece); vv = *(const v4u*)(krow + 128 + 8 * spiece); }
    if (nt64 <= 9) dsa_select<9>(L, c, nt64, w, lane);
    else if (nt64 <= 17) dsa_select<17>(L, c, nt64, w, lane);
    else if (nt64 <= 25) dsa_select<25>(L, c, nt64, w, lane);
    else dsa_select<33>(L, c, nt64, w, lane);
    __syncthreads();
    {
      const int hh = fr & 7; const float bfar = RB[15 * 8 + hh];
      float mrun[2] = {0.f, 0.f}, lrun[2] = {0.f, 0.f}; f32x4 O[2][4];
#pragma unroll
      for (int cg = 0; cg < 2; ++cg)
#pragma unroll
          for (int dt = 0; dt < 4; ++dt) O[cg][dt] = (f32x4){0.f, 0.f, 0.f, 0.f};
      const LAS float* BT = (const LAS float*)(L + DS_BT);
#pragma unroll
      for (int k = 0; k < 4; ++k) { const int e = tid + 512 * k, relc = (e >> 3) - 128, n = relc < 0 ? -relc : relc; ((LAS float*)(L + DS_BT))[e] = RB[(TB[n] + (relc > 0 ? 16 : 0)) * 8 + (e & 7)]; }
      const unsigned ldsV = (unsigned)(size_t)(L) + 9216u + (unsigned)((4 * kq + ((lane & 15) >> 2)) * DS_TSTR + 8 * (lane & 3));
      *(LAS v4u*)(L + skey * DS_TSTR + 16 * spiece) = kv0; *(LAS v4u*)(L + 9216 + skey * DS_TSTR + 16 * spiece) = vv0;
      __syncthreads();
      for (int T = 0; T < nt64; ++T) { const int buf = T & 1;
          v4u kn = kv, vn = vv;
          if (T + 2 < nt64) { const bf16* krow = PK + (size_t)(b * 2048 + 64 * (T + 1) + skey) * 256; kn = *(const v4u*)(krow + 64 + 8 * spiece); vn = *(const v4u*)(krow + 128 + 8 * spiece); }
          const bool nearT = (64 * T > 32 * uq - 90);
          f32x4 lg[2][4];
          { bf16x8 ka[4][2];
#pragma unroll
            for (int sub = 0; sub < 4; ++sub)
#pragma unroll
                for (int ks = 0; ks < 2; ++ks) ka[sub][ks] = *(const LAS bf16x8*)(L + buf * DS_BUF + fr * DS_TSTR + 16 * kq + sub * 16 * DS_TSTR + ks * 64);
#pragma unroll
            for (int cg = 0; cg < 2; ++cg)
#pragma unroll
                for (int sub = 0; sub < 4; ++sub) { f32x4 acc = (f32x4){0.f, 0.f, 0.f, 0.f}; acc = mfma16(ka[sub][0], qb[cg][0], acc); acc = mfma16(ka[sub][1], qb[cg][1], acc); lg[cg][sub] = acc; } }
          s16x4 vt[2][4][2];
#pragma unroll
          for (int cg = 0; cg < 2; ++cg) {
              const float mc = mrun[cg]; float mxl = -1.0e30f;
              if (nearT) { const int relb = ((T == 0) ? 0 : 64 * T - 48) + 4 * kq - (16 + 32 * uq + 4 * w + 2 * cg + (fr >> 3));
#pragma unroll
                  for (int sub = 0; sub < 4; ++sub)
#pragma unroll
                      for (int r = 0; r < 4; ++r) { int idx = relb + 16 * sub + r; idx = idx < -128 ? -128 : idx; idx = idx > 127 ? 127 : idx;
                          const float v = lg[cg][sub][r] * 0.18033688f + (BT[(idx + 128) * 8 + hh] - mc); lg[cg][sub][r] = v; mxl = fmaxf(mxl, v); }
              } else { const float bm = bfar - mc;
#pragma unroll
                  for (int sub = 0; sub < 4; ++sub)
#pragma unroll
                      for (int r = 0; r < 4; ++r) { const float v = lg[cg][sub][r] * 0.18033688f + bm; lg[cg][sub][r] = v; mxl = fmaxf(mxl, v); } }
              if (T == 0 || __ballot(mxl > 8.0f) != 0ull) {
                  float mx = mxl; mx = fmaxf(mx, __shfl_xor(mx, 16)); mx = fmaxf(mx, __shfl_xor(mx, 32));
                  const float delta = (T == 0) ? mx : fmaxf(mx, 0.f), sc = __builtin_amdgcn_exp2f(-delta); mrun[cg] = mc + delta; lrun[cg] *= sc;
#pragma unroll
                  for (int dt = 0; dt < 4; ++dt) O[cg][dt] = O[cg][dt] * sc;
#pragma unroll
                  for (int sub = 0; sub < 4; ++sub)
#pragma unroll
                      for (int r = 0; r < 4; ++r) lg[cg][sub][r] -= delta; }
              const unsigned long long mword = MASK[mkoff[cg] + T] >> (4 * kq); const unsigned mlo = (unsigned)mword, mhi = (unsigned)(mword >> 32); float ls = 0.f;
#pragma unroll
              for (int sub = 0; sub < 4; ++sub)
#pragma unroll
                  for (int r = 0; r < 4; ++r) { const int keep = __builtin_amdgcn_sbfe((int)(sub < 2 ? mlo : mhi), 16 * (sub & 1) + r, 1);
                      const float p = __uint_as_float(__float_as_uint(__builtin_amdgcn_exp2f(lg[cg][sub][r])) & (unsigned)keep); ls += p; lg[cg][sub][r] = p; }
              lrun[cg] += ls; }
          { const unsigned vaddr = ldsV + (unsigned)(buf * DS_BUF);
            asm volatile("ds_read_b64_tr_b16 %0, %16 offset:0\n\t"
                "ds_read_b64_tr_b16 %1, %16 offset:2304\n\t"
                "ds_read_b64_tr_b16 %2, %16 offset:32\n\t"
                "ds_read_b64_tr_b16 %3, %16 offset:2336\n\t"
                "ds_read_b64_tr_b16 %4, %16 offset:64\n\t"
                "ds_read_b64_tr_b16 %5, %16 offset:2368\n\t"
                "ds_read_b64_tr_b16 %6, %16 offset:96\n\t"
                "ds_read_b64_tr_b16 %7, %16 offset:2400\n\t"
                "ds_read_b64_tr_b16 %8, %16 offset:4608\n\t"
                "ds_read_b64_tr_b16 %9, %16 offset:6912\n\t"
                "ds_read_b64_tr_b16 %10, %16 offset:4640\n\t"
                "ds_read_b64_tr_b16 %11, %16 offset:6944\n\t"
                "ds_read_b64_tr_b16 %12, %16 offset:4672\n\t"
                "ds_read_b64_tr_b16 %13, %16 offset:6976\n\t"
                "ds_read_b64_tr_b16 %14, %16 offset:4704\n\t"
                "ds_read_b64_tr_b16 %15, %16 offset:7008\n\t"
                "s_waitcnt lgkmcnt(0)"
                : "=&v"(vt[0][0][0]), "=&v"(vt[0][0][1]), "=&v"(vt[0][1][0]), "=&v"(vt[0][1][1]), "=&v"(vt[0][2][0]), "=&v"(vt[0][2][1]), "=&v"(vt[0][3][0]), "=&v"(vt[0][3][1]), "=&v"(vt[1][0][0]), "=&v"(vt[1][0][1]), "=&v"(vt[1][1][0]), "=&v"(vt[1][1][1]), "=&v"(vt[1][2][0]), "=&v"(vt[1][2][1]), "=&v"(vt[1][3][0]), "=&v"(vt[1][3][1])
                : "v"(vaddr) : "memory"); }
#pragma unroll
          for (int ks2 = 0; ks2 < 2; ++ks2) { bf16x8 pb[2];
#pragma unroll
              for (int cg = 0; cg < 2; ++cg) { v4u pw; pw.x = cvtpk(lg[cg][2 * ks2][0], lg[cg][2 * ks2][1]); pw.y = cvtpk(lg[cg][2 * ks2][2], lg[cg][2 * ks2][3]);
                  pw.z = cvtpk(lg[cg][2 * ks2 + 1][0], lg[cg][2 * ks2 + 1][1]); pw.w = cvtpk(lg[cg][2 * ks2 + 1][2], lg[cg][2 * ks2 + 1][3]); pb[cg] = __builtin_bit_cast(bf16x8, pw); }
#pragma unroll
              for (int dt = 0; dt < 4; ++dt) { const bf16x8 va = __builtin_shufflevector(vt[ks2][dt][0], vt[ks2][dt][1], 0, 1, 2, 3, 4, 5, 6, 7);
#pragma unroll
                  for (int cg = 0; cg < 2; ++cg) O[cg][dt] = mfma16(va, pb[cg], O[cg][dt]); } }
          if (T + 1 < nt64) { *(LAS v4u*)(L + (buf ^ 1) * DS_BUF + skey * DS_TSTR + 16 * spiece) = kv; *(LAS v4u*)(L + (buf ^ 1) * DS_BUF + 9216 + skey * DS_TSTR + 16 * spiece) = vv; }
          kv = kn; vv = vn;
          __syncthreads();
      }
#pragma unroll
      for (int cg = 0; cg < 2; ++cg) { float v = lrun[cg]; v += __shfl_xor(v, 16); v += __shfl_xor(v, 32); const float inv = 1.0f / v;
          const int q = 4 * w + 2 * cg + (fr >> 3);
#pragma unroll
          for (int dt = 0; dt < 4; ++dt) { v2u o; o.x = cvtpk(O[cg][dt][0] * inv, O[cg][dt][1] * inv); o.y = cvtpk(O[cg][dt][2] * inv, O[cg][dt][3] * inv);
              *(v2u*)(YB + (size_t)(qrow0 + q) * 512 + hh * 64 + 16 * dt + 4 * kq) = o; } } }
}

__global__ void __launch_bounds__(NWAVES * 64, 2) mk_fwd(Args args) {
    extern __shared__ __attribute__((aligned(16))) unsigned char lds[];
    LAS unsigned char* L = (LAS unsigned char*)lds;
    volatile LAS unsigned* MISC = (volatile LAS unsigned*)(L + MISC_OFF);
    const int tid = threadIdx.x, lane = tid & 63, wave = __builtin_amdgcn_readfirstlane(tid >> 6);
    const int G = gridDim.x, bx = blockIdx.x;
    const int gw = bx * NWAVES + wave, NGW = G * NWAVES;
    unsigned char* ws = args.ws;
    if (tid < 32) MISC[tid] = 0u;
    __syncthreads();
    XcdBarrier bar; bar.bar = (unsigned*)(ws + WS_CTL) + CW_BAR; bar.x = 0; bar.st = nullptr;
    if (!MK_PER_PHASE) bar = xcd_barrier_post((unsigned*)(ws + WS_CTL) + CW_BAR, MISC + 8);
    const int lo = args.ph_lo, hi = args.ph_hi;
#define IN(k) (lo <= (k) && (k) < hi)
#define SEAM(k) do { if (IN(k) && IN((k) + 1)) xcd_barrier(bar); } while (0)
    bf16* WT1 = (bf16*)(ws + WS_WT1); bf16* WT2 = (bf16*)(ws + WS_WT2); bf16* WT3 = (bf16*)(ws + WS_WT3); bf16* WT4 = (bf16*)(ws + WS_WT4); bf16* WT5 = (bf16*)(ws + WS_WT5);
    bf16* WGLU = (bf16*)(ws + WS_WGLU); bf16* WA = (bf16*)(ws + WS_WA); bf16* WB = (bf16*)(ws + WS_WB); bf16* WOUT = (bf16*)(ws + WS_WOUT);
    bf16* HN = (bf16*)(ws + WS_HN); bf16* FB = (bf16*)(ws + WS_F); bf16* ACT = (bf16*)(ws + WS_BIG);
    bf16* PA = (bf16*)(ws + WS_PA); bf16* PG = (bf16*)(ws + WS_PG); bf16* PK = (bf16*)(ws + WS_PK);
    bf16* AM1 = (bf16*)(ws + WS_META + MO_AM1); bf16* ACTM = (bf16*)(ws + WS_META + MO_ACTM); bf16* FM = (bf16*)(ws + WS_META + MO_FM); bf16* AM2 = (bf16*)(ws + WS_META + MO_AM2);
    bf16* PMU = (bf16*)(ws + WS_META + MO_PMU); bf16* PMK = (bf16*)(ws + WS_META + MO_PMK);
    bf16* HB = (bf16*)(ws + WS_HB); float* RS1 = (float*)(ws + WS_META + 524288); float* RS2 = (float*)(ws + WS_META + 655360);
    bf16* YA = FB; bf16* YG = HN; bf16* YB = HN + (size_t)R * 512; bf16* MERGED = PA;
    const float* x = args.in[0]; float* out = args.out;

    if (IN(0)) {
        for (int item = bx; item < 256; item += G) s5_tables_block(args, item >> 3, item & 7, (LAS float*)L, tid);
        __syncthreads();
        LAS float* scr = (LAS float*)(L + wave * 16384);
        for (int it = gw; it < 11520; it += NGW) {
            int r = it;
            if (r < 6 * 1408) { const int mat = r / 1408; r -= mat * 1408;
                if (mat == 5) { const int kb = r / 32, nb = r % 32; transpose_item8(args.in[13], D, DFF, (unsigned char*)WT5, 64 * kb, 32 * nb, 32 * nb + (lane & 31), scr, lane); }
                else if (mat == 2) { const int kb = r / 32, nb = r % 32; transpose_item(args.in[10], D, DFF, WT2, 64 * kb, 32 * nb, 32 * nb + (lane & 31), scr, lane); }
                else if (mat >= 3) { const int kb = r / 88, nb = r % 88, d0 = 32 * nb, up = (mat == 4) ? 128 : 0; transpose_item8(args.in[mat == 3 ? 11 : 12], DFF, D, (unsigned char*)WT4, 64 * kb, 256 * (d0 >> 7) + (d0 & 127) + up, d0 + (lane & 31), scr, lane); }
                else { const int kb = r / 88, nb = r % 88, d0 = 32 * nb, up = (mat == 1 || mat == 4) ? 128 : 0;
                    transpose_item(args.in[mat == 0 ? 8 : mat == 1 ? 9 : mat == 3 ? 11 : 12], DFF, D, mat < 3 ? WT1 : WT4, 64 * kb, 256 * (d0 >> 7) + (d0 & 127) + up, d0 + (lane & 31), scr, lane, args.in[2]); }
                continue; }
            r -= 6 * 1408;
            if (r < 896) { const int kb = r / 56, nb = r % 56; transpose_item(args.in[14], 3784, D, WT3, 64 * kb, 32 * nb, win_srccol(32 * nb + (lane & 31)), scr, lane, args.in[4]); continue; }
            r -= 896;
            if (r < 1024) { const int kb = r / 64, nb = r % 64; transpose_item8(args.in[14], 3784, D, (unsigned char*)(ws + WS_WT3B), 64 * kb, 32 * nb, 1736 + 32 * nb + (lane & 31), scr, lane, args.in[4]); continue; }
            r -= 1024;
            if (r < 128) { const int kb = r / 16, nb = r % 16; transpose_item(args.in[23], 512, 512, WGLU, 64 * kb, 32 * nb, 32 * nb + (lane & 31), scr, lane); continue; }
            r -= 128;
            if (r < 256) { const int kb = r / 32, nb = r % 32; transpose_item(args.in[24], D, 512, WA, 64 * kb, 32 * nb, 32 * nb + (lane & 31), scr, lane); continue; }
            r -= 256;
            if (r < 256) { const int kb = r / 32, nb = r % 32; transpose_item(args.in[26], D, 512, WB, 64 * kb, 32 * nb, 32 * nb + (lane & 31), scr, lane); continue; }
            r -= 256;
            { const int kb = r / 32, nb = r % 32; transpose_item(args.in[27], D, D, WOUT, 64 * kb, 32 * nb, 32 * nb + (lane & 31), scr, lane); }
        }
        for (int m = gw; m < R; m += NGW) x_row_to_bf16<false>(x + (size_t)m * D, HN + (size_t)m * D, RS1 + m, lane);
        if (gw < NMETA) x_row_to_bf16<true>(args.in[1] + (size_t)gw * D, AM1 + (size_t)gw * D, nullptr, lane);
    }
    SEAM(0);
    if (IN(1)) {
        if (bx < 176) { const int j0 = 16 * bx, grow = 256 * (j0 >> 7) + (j0 & 127); f32x4 g4, u4;
            meta_tile_blk<4>(AM1, WT1 + (size_t)grow * D, WT1 + (size_t)(grow + 128) * D, D, (LAS float*)L, wave, lane, g4, u4);
            if (wave == 0) {
#pragma unroll
                for (int r = 0; r < 4; ++r) ACTM[(4 * (lane >> 4) + r) * DFF + j0 + (lane & 15)] = (bf16)f2bf(g4[r] * fsig(g4[r]) * u4[r]); } }
        pg8::Gemm g{HN, WT1, R, 2 * DFF, D}; pg8::StaticOrder S; S.init(R, 2 * DFF, G, bx); pg8::EpiSwiglu E{ACT, DFF, RS1};
        pg8::gemm_phase<pg8::EpiSwiglu, pg8::StaticOrder, PG8_ALIGN, PG8_SP2>(L, g, S, E);
        if (REP_G1 > 1) pg8::gemm_phase<pg8::EpiSwiglu, pg8::StaticOrder, PG8_ALIGN, PG8_SP2>(L, g, S, E);
    }
    SEAM(1);
    if (IN(2)) {
        if (bx < 64) { const int n0 = 16 * bx; f32x4 f4, dummy;
            meta_tile_blk<11>(ACTM, WT2 + (size_t)n0 * DFF, nullptr, DFF, (LAS float*)L, wave, lane, f4, dummy);
            if (wave == 0) {
#pragma unroll
                for (int r = 0; r < 4; ++r) FM[(4 * (lane >> 4) + r) * D + n0 + (lane & 15)] = (bf16)f2bf(f4[r]); } }
        pg8::Gemm g{ACT, WT2, R, D, DFF}; pg8::StaticOrder S; S.init(R, D, G, bx); pg8::EpiPlain E{FB, D};
        pg8::gemm_phase<pg8::EpiPlain, pg8::StaticOrder, PG8_ALIGN, PG8_SP2>(L, g, S, E);
    }
    SEAM(2);
    if (IN(3)) {
        if (gw < NMETA) row_update<false, false>(FM + (size_t)gw * D, args.in[1] + (size_t)gw * D, nullptr, AM2 + (size_t)gw * D, args.in[3], nullptr, 0.5f, lane);
        for (int m = gw; m < R; m += NGW) row_update<true, true>(FB + (size_t)m * D, HN + (size_t)m * D, HB + (size_t)m * D, nullptr, args.in[3], nullptr, 0.5f, lane, RS2 + m, (unsigned*)(ws + WS_HB8 + (size_t)m * D));
    }
    SEAM(3);
    if (IN(4)) {
        if (bx < 44) { const int n0 = bx < 32 ? 16 * bx : 1536 + 16 * (bx - 32); f32x4 p4, dummy;
            meta_tile_blk<4>(AM2, WT3 + (size_t)n0 * D, nullptr, D, (LAS float*)L, wave, lane, p4, dummy);
            if (wave == 0) {
#pragma unroll
                for (int r = 0; r < 4; ++r) { const int row = 4 * (lane >> 4) + r; if (bx < 32) PMU[row * 512 + n0 + (lane & 15)] = (bf16)f2bf(p4[r]); else PMK[row * 256 + (n0 - 1536) + (lane & 15)] = (bf16)f2bf(p4[r]); } } }
        { pg8::Gemm g{HB, WT3, R, 1792, D}; pg8::ProjOrderA S; S.base.init(R, 1536, G, bx); S.c = bx; pg8::EpiProj E{PA, PK, (bf16*)(ws + WS_UA2), RS2};
          pg8::gemm_phase<pg8::EpiProj, pg8::ProjOrderA, PG8_ALIGN, PG8_SP2>(L, g, S, E); }
        { pg8::Gemm g{(const bf16*)(ws + WS_HB8), (const bf16*)(ws + WS_WT3B), R, 2048, D}; pg8::ProjOrderB S{bx}; pg8::EpiGates8 E{PG, RS2};
          pg8::gemm_phase<pg8::EpiGates8, pg8::ProjOrderB, PG8_ALIGN, PG8_SP2, true>(L, g, S, E); }
    }
    SEAM(4);
    if (IN(5)) {
        { const int v0 = 2 * (bx >> 3), gS = 4 * (bx & 7) + (v0 >> 4);
          s5_meta(args, L, gS, tid);
          for (int rep = 0; rep < REP_S5; ++rep) for (int i = 0; i < 2; ++i) s5_unit(args, L, (v0 + i) & 15, gS, tid); }
        __syncthreads();
        dsa_tables(args, L, tid);
        for (int i = 0; i < 4 * REP_DSA; ++i) { const int up = 4 * (bx >> 3) + (i & 3), u2 = up >> 1, b = 2 * (bx & 7) + (u2 >> 5), xq = u2 & 31; dsa_unit(args, L, b, (up & 1) ? 63 - xq : xq, tid); }
        __syncthreads();
    }
    SEAM(5);
    if (IN(6)) { pg8::Gemm g{YA, WGLU, R, 512, 512}; pg8::StaticOrder S; S.init(R, 512, G, bx); pg8::EpiGlu E{YA, YG};
        pg8::gemm_phase<pg8::EpiGlu, pg8::StaticOrder, PG8_ALIGN, PG8_SP2>(L, g, S, E); }
    SEAM(6);
    if (IN(7)) { pg8::Gemm g{YG, WA, 2 * R, 2048, 512}; pg8::MergeOrder S; S.base.init(R, D, G, bx); pg8::EpiMerge2 E{PG, FB, MERGED};
        pg8::gemm_phase<pg8::EpiMerge2, pg8::MergeOrder, PG8_ALIGN, PG8_SP2>(L, g, S, E); }
    if (IN(7) && IN(9)) xcd_barrier(bar);
    if (IN(9)) { pg8::Gemm g{MERGED, WOUT, R, D, D}; pg8::StaticOrder S; S.init(R, D, G, bx); pg8::EpiPlain E{FB, D};
        pg8::gemm_phase<pg8::EpiPlain, pg8::StaticOrder, PG8_ALIGN, PG8_SP2>(L, g, S, E); }
    SEAM(9);
    if (IN(10)) { for (int m = gw; m < R; m += NGW) row_update<true, true, true>(FB + (size_t)m * D, HB + (size_t)m * D, HB + (size_t)m * D, (bf16*)((unsigned char*)HN + (size_t)m * D), args.in[5], args.in[6], 1.0f, lane); }
    SEAM(10);
    if (IN(11)) { pg8::Gemm g{HN, WT4, R, 2 * DFF, D}; pg8::StaticOrder S; S.init(R, 2 * DFF, G, bx); pg8::EpiSwiglu8 E{(unsigned char*)ACT, DFF, 1.0f / 256.0f, 8.0f};
        pg8::gemm_phase<pg8::EpiSwiglu8, pg8::StaticOrder, PG8_ALIGN, PG8_SP2, true>(L, g, S, E); }
    SEAM(11);
    if (IN(12)) { pg8::Gemm g{ACT, WT5, R, D, DFF}; pg8::StaticOrder S; S.init(R, D, G, bx); pg8::EpiPlainS E{FB, D, 1.0f / 512.0f};
        pg8::gemm_phase<pg8::EpiPlainS, pg8::StaticOrder, PG8_ALIGN, PG8_SP2, true>(L, g, S, E); }
    SEAM(12);
    if (IN(13)) { for (int m = gw; m < R; m += NGW) row_update<true, false>(FB + (size_t)m * D, HB + (size_t)m * D, out + (size_t)m * D, nullptr, args.in[7], args.in[7], 0.5f, lane); }
#undef IN
#undef SEAM
}

extern "C" void kernel_launch(void* const* d_in, const int* in_sizes, int n_in, void* d_out, int out_size, void* d_ws, size_t ws_size, hipStream_t stream) {
    static int grid = 0;
    if (grid == 0) {
        if (n_in != 28 || out_size != R * D || ws_size < WS_END) { fprintf(stderr, "kernel_launch: unexpected shapes (n_in %d, out %d, ws %zu); nothing launched\n", n_in, out_size, ws_size); grid = -1; return; }
        int dev = 0, cus = 0, per_cu = 0;
        if (hipGetDevice(&dev) != hipSuccess || hipDeviceGetAttribute(&cus, hipDeviceAttributeMultiprocessorCount, dev) != hipSuccess) { grid = -1; return; }
        if (hipFuncSetAttribute((const void*)mk_fwd, hipFuncAttributeMaxDynamicSharedMemorySize, LDS_BYTES) != hipSuccess) { fprintf(stderr, "kernel_launch: hipFuncSetAttribute failed\n"); grid = -1; return; }
        if (hipOccupancyMaxActiveBlocksPerMultiprocessor(&per_cu, (const void*)mk_fwd, NWAVES * 64, LDS_BYTES) != hipSuccess || per_cu < 1) fprintf(stderr, "kernel_launch: note: occupancy query reports %d\n", per_cu);
        (void)hipGetLastError();
        grid = cus;
    }
    if (grid < 0) return;
    if (hipMemsetAsync((char*)d_ws + WS_CTL, 0, CTL_ZERO_BYTES, stream) != hipSuccess) return;
    Args a{};
    for (int i = 0; i < 28; ++i) a.in[i] = (const float*)d_in[i];
    a.out = (float*)d_out; a.ws = (unsigned char*)d_ws;
#if MK_PER_PHASE
    for (int ph = 0; ph < NPH; ++ph) { a.ph_lo = ph; a.ph_hi = ph + 1; hipLaunchKernelGGL(mk_fwd, dim3(grid), dim3(NWAVES * 64), LDS_BYTES, stream, a); }
#else
    a.ph_lo = 0; a.ph_hi = NPH;
    hipLaunchKernelGGL(mk_fwd, dim3(grid), dim3(NWAVES * 64), LDS_BYTES, stream, a);
#endif
}
```

```cpp
#include <hip/hip_runtime.h>
#include <cstdio>
#include <cstdint>
namespace pg8 {
#define PG8_LAS __attribute__((address_space(3)))
typedef unsigned short bf16_t;
typedef short bf16x8 __attribute__((ext_vector_type(8)));
typedef float f32x4 __attribute__((ext_vector_type(4)));
typedef unsigned u32x4 __attribute__((ext_vector_type(4)));
constexpr int BM = 256, BK = 64, HALF = 128, HTB = HALF * BK * 2  , STAGE_BYTES = 8 * HTB, NXCD = 8, WGM = 8;

__host__ __device__ __forceinline__ int lds_byte(int r, int c) { const int st = (r >> 4) * 2 + (c >> 5), rr = r & 15, cc = c & 31, ob = rr * 64 + cc * 2; return st * 1024 + (ob ^ (((ob >> 9) & 1) << 5)); }
__host__ __device__ __forceinline__ void stage_rc(int b, int& R, int& C) { const int st = b / 1024, sb = b % 1024, swz = sb ^ (((sb >> 9) & 1) << 5); R = (st >> 1) * 16 + swz / 64; C = (st & 1) * 32 + (swz % 64) / 2; }
__host__ __device__ __forceinline__ int perm32(int rho) { const int n = rho >> 4, i = rho & 15; return 8 * (i >> 2) + 4 * n + (i & 3); }

struct Unit { int pm, pn; };
struct Gemm { const bf16_t* A; const bf16_t* Bt; int M, N, K; };

struct StaticOrder {
    int nM, nN, nwg, G, c;
    __host__ __device__ void init(int M, int N, int G_, int c_) { nM = M / BM; nN = N / BM; nwg = nM * nN; G = G_; c = c_; }
    __host__ __device__ bool next(int i, Unit& u) const {
        const long L = (long)i * G + c; if (L >= nwg) return false;
        int wgid = (int)L; { const int q = nwg / NXCD, r = nwg % NXCD, xcd = wgid % NXCD, off = wgid / NXCD; wgid = (xcd < r ? xcd * (q + 1) : r * (q + 1) + (xcd - r) * q) + off; }
        const int nig = WGM * nN, gid = wgid / nig, fm = gid * WGM, gsz = (nM - fm) < WGM ? (nM - fm) : WGM;
        u.pm = fm + ((wgid % nig) % gsz); u.pn = (wgid % nig) / gsz; return true;
    }
    __device__ __forceinline__ void a_ready(const Unit&) const {}
    __device__ __forceinline__ void done(const Unit&) const {}
};
__device__ __forceinline__ unsigned cvt_pk_bf16(float lo, float hi) { unsigned r; asm volatile("v_cvt_pk_bf16_f32 %0, %1, %2" : "=v"(r) : "v"(lo), "v"(hi)); return r; }
__device__ __forceinline__ float fsigmoid(float x) { return __builtin_amdgcn_rcpf(1.0f + __expf(-x)); }
__device__ __forceinline__ float bf_lo(unsigned w) { return __uint_as_float(w << 16); }
__device__ __forceinline__ float bf_hi(unsigned w) { return __uint_as_float(w & 0xffff0000u); }
__device__ __forceinline__ u32x4 pack8(const f32x4 v0, const f32x4 v1) { u32x4 w; w.x = cvt_pk_bf16(v0[0], v0[1]); w.y = cvt_pk_bf16(v0[2], v0[3]); w.z = cvt_pk_bf16(v1[0], v1[1]); w.w = cvt_pk_bf16(v1[2], v1[3]); return w; }
__device__ __forceinline__ void unpack8(const u32x4 w, f32x4& v0, f32x4& v1) { v0 = (f32x4){bf_lo(w.x), bf_hi(w.x), bf_lo(w.y), bf_hi(w.y)}; v1 = (f32x4){bf_lo(w.z), bf_hi(w.z), bf_lo(w.w), bf_hi(w.w)}; }

struct EpiSwiglu {
    static constexpr bool PERM = true, AFTER_DRAIN = false;
    bf16_t* O; int ldc; const float* rs;
    __device__ __forceinline__ void operator()(const f32x4 (&acc)[2][2][4][2], const Unit& u, int wr, int wc, int fr, int fq) const {
        const int row0 = u.pm * BM + wr * 64 + fr, col0 = u.pn * HALF + wc * 32 + 8 * fq;
#pragma unroll
        for (int ai = 0; ai < 2; ++ai)
#pragma unroll
            for (int m = 0; m < 4; ++m) { bf16_t* rowp = O + (size_t)(row0 + ai * HALF + m * 16) * ldc + col0; const float rsc = rs[row0 + ai * HALF + m * 16];
                f32x4 v0, v1;
#pragma unroll
                for (int j = 0; j < 4; ++j) { const float g0 = acc[ai][0][m][0][j] * rsc, g1 = acc[ai][0][m][1][j] * rsc;
                    v0[j] = g0 * fsigmoid(g0) * (acc[ai][1][m][0][j] * rsc); v1[j] = g1 * fsigmoid(g1) * (acc[ai][1][m][1][j] * rsc); }
                *(u32x4*)rowp = pack8(v0, v1); }
    }
};
struct EpiPlain {
    static constexpr bool PERM = true, AFTER_DRAIN = false;
    bf16_t* O; int ldc;
    __device__ __forceinline__ void operator()(const f32x4 (&acc)[2][2][4][2], const Unit& u, int wr, int wc, int fr, int fq) const {
        const int row0 = u.pm * BM + wr * 64 + fr, col0 = u.pn * BM + wc * 32 + 8 * fq;
#pragma unroll
        for (int ai = 0; ai < 2; ++ai)
#pragma unroll
            for (int m = 0; m < 4; ++m) { bf16_t* rowp = O + (size_t)(row0 + ai * HALF + m * 16) * ldc + col0;
#pragma unroll
                for (int bj = 0; bj < 2; ++bj) *(u32x4*)(rowp + bj * HALF) = pack8(acc[ai][bj][m][0], acc[ai][bj][m][1]); }
    }
};

__device__ __forceinline__ unsigned pk4_fp8(float a, float b, float c, float d) { int w = 0; w = __builtin_amdgcn_cvt_pk_fp8_f32(fminf(fmaxf(a, -448.f), 448.f), fminf(fmaxf(b, -448.f), 448.f), w, false);
    w = __builtin_amdgcn_cvt_pk_fp8_f32(fminf(fmaxf(c, -448.f), 448.f), fminf(fmaxf(d, -448.f), 448.f), w, true); return (unsigned)w; }
struct EpiSwiglu8 {
    static constexpr bool PERM = true, AFTER_DRAIN = false;
    unsigned char* O; int ldc; float ascale, oscale;
    __device__ __forceinline__ void operator()(const f32x4 (&acc)[2][2][4][2], const Unit& u, int wr, int wc, int fr, int fq) const {
        const int row0 = u.pm * BM + wr * 64 + fr, col0 = u.pn * HALF + wc * 32 + 8 * fq;
#pragma unroll
        for (int ai = 0; ai < 2; ++ai)
#pragma unroll
            for (int m = 0; m < 4; ++m) { unsigned char* rowp = O + (size_t)(row0 + ai * HALF + m * 16) * ldc + col0;
                f32x4 v0, v1;
#pragma unroll
                for (int j = 0; j < 4; ++j) { const float g0 = acc[ai][0][m][0][j] * ascale, g1 = acc[ai][0][m][1][j] * ascale;
                    v0[j] = g0 * fsigmoid(g0) * (acc[ai][1][m][0][j] * ascale) * oscale; v1[j] = g1 * fsigmoid(g1) * (acc[ai][1][m][1][j] * ascale) * oscale; }
                typedef unsigned u32x2 __attribute__((ext_vector_type(2))); u32x2 w; w.x = pk4_fp8(v0[0], v0[1], v0[2], v0[3]); w.y = pk4_fp8(v1[0], v1[1], v1[2], v1[3]);
                *(u32x2*)rowp = w; }
    }
};

struct EpiSwigluR8 {
    static constexpr bool PERM = true, AFTER_DRAIN = false;
    unsigned char* O; int ldc; const float* rs; float oscale;
    __device__ __forceinline__ void operator()(const f32x4 (&acc)[2][2][4][2], const Unit& u, int wr, int wc, int fr, int fq) const {
        const int row0 = u.pm * BM + wr * 64 + fr, col0 = u.pn * HALF + wc * 32 + 8 * fq;
#pragma unroll
        for (int ai = 0; ai < 2; ++ai)
#pragma unroll
            for (int m = 0; m < 4; ++m) { unsigned char* rowp = O + (size_t)(row0 + ai * HALF + m * 16) * ldc + col0; const float rsc = rs[row0 + ai * HALF + m * 16];
                f32x4 v0, v1;
#pragma unroll
                for (int j = 0; j < 4; ++j) { const float g0 = acc[ai][0][m][0][j] * rsc, g1 = acc[ai][0][m][1][j] * rsc;
                    v0[j] = g0 * fsigmoid(g0) * (acc[ai][1][m][0][j] * rsc) * oscale; v1[j] = g1 * fsigmoid(g1) * (acc[ai][1][m][1][j] * rsc) * oscale; }
                typedef unsigned u32x2 __attribute__((ext_vector_type(2))); u32x2 w; w.x = pk4_fp8(v0[0], v0[1], v0[2], v0[3]); w.y = pk4_fp8(v1[0], v1[1], v1[2], v1[3]);
                *(u32x2*)rowp = w; }
    }
};
struct EpiPlainS {
    static constexpr bool PERM = true, AFTER_DRAIN = false;
    bf16_t* O; int ldc; float scale;
    __device__ __forceinline__ void operator()(const f32x4 (&acc)[2][2][4][2], const Unit& u, int wr, int wc, int fr, int fq) const {
        const int row0 = u.pm * BM + wr * 64 + fr, col0 = u.pn * BM + wc * 32 + 8 * fq;
#pragma unroll
        for (int ai = 0; ai < 2; ++ai)
#pragma unroll
            for (int m = 0; m < 4; ++m) { bf16_t* rowp = O + (size_t)(row0 + ai * HALF + m * 16) * ldc + col0;
#pragma unroll
                for (int bj = 0; bj < 2; ++bj) *(u32x4*)(rowp + bj * HALF) = pack8(acc[ai][bj][m][0] * scale, acc[ai][bj][m][1] * scale); }
    }
};
struct EpiProj {
    static constexpr bool PERM = true, AFTER_DRAIN = false;
    bf16_t *PA, *PK, *UA2; const float* rs;
    __device__ __forceinline__ void operator()(const f32x4 (&acc)[2][2][4][2], const Unit& u, int wr, int wc, int fr, int fq) const {
        if (u.pn < 2) {
#pragma unroll
            for (int ai = 0; ai < 2; ++ai)
#pragma unroll
                for (int m = 0; m < 4; ++m) { const int row = u.pm * BM + wr * 64 + fr + ai * HALF + m * 16, bb = row >> 11, t = row & 2047; const float rsc = rs[row];
#pragma unroll
                    for (int bj = 0; bj < 2; ++bj) { const int col = 256 * u.pn + 128 * bj + wc * 32 + 8 * fq;
                        *(u32x4*)(UA2 + ((size_t)((bb * 32 + (col >> 4)) * 2048 + t)) * 16 + (col & 8)) = pack8(acc[ai][bj][m][0] * rsc, acc[ai][bj][m][1] * rsc); } }
            return; }
        bf16_t* base; int ldc, colt;
        if (u.pn < 6) { base = PA; ldc = 1024; colt = 256 * (u.pn - 2); } else { base = PK; ldc = 256; colt = 0; }
        const int row0 = u.pm * BM + wr * 64 + fr, col0 = colt + wc * 32 + 8 * fq;
#pragma unroll
        for (int ai = 0; ai < 2; ++ai)
#pragma unroll
            for (int m = 0; m < 4; ++m) { bf16_t* rowp = base + (size_t)(row0 + ai * HALF + m * 16) * ldc + col0; const float rsc = rs[row0 + ai * HALF + m * 16];
#pragma unroll
                for (int bj = 0; bj < 2; ++bj) *(u32x4*)(rowp + bj * HALF) = pack8(acc[ai][bj][m][0] * rsc, acc[ai][bj][m][1] * rsc); }
    }
};
struct EpiGates8 {
    static constexpr bool PERM = true, AFTER_DRAIN = false;
    bf16_t* PG; const float* rs;
    __device__ __forceinline__ void operator()(const f32x4 (&acc)[2][2][4][2], const Unit& u, int wr, int wc, int fr, int fq) const {
        const int row0 = u.pm * BM + wr * 64 + fr, col0 = u.pn * BM + wc * 32 + 8 * fq;
#pragma unroll
        for (int ai = 0; ai < 2; ++ai)
#pragma unroll
            for (int m = 0; m < 4; ++m) { bf16_t* rowp = PG + (size_t)(row0 + ai * HALF + m * 16) * 2048 + col0; const float rsc = rs[row0 + ai * HALF + m * 16] * (1.0f / 256.0f);
#pragma unroll
                for (int bj = 0; bj < 2; ++bj) *(u32x4*)(rowp + bj * HALF) = pack8(acc[ai][bj][m][0] * rsc, acc[ai][bj][m][1] * rsc); }
    }
};
struct ProjOrderA {
    StaticOrder base; int c;
    __device__ __forceinline__ bool next(int i, Unit& u) const { if (i < 3) return base.next(i, u); if (i == 3 && c < 128) { u.pm = c; u.pn = 6; return true; } return false; }
    __device__ __forceinline__ void a_ready(const Unit&) const {}
    __device__ __forceinline__ void done(const Unit&) const {}
};
struct ProjOrderB {
    int c;
    __device__ __forceinline__ bool next(int i, Unit& u) const {
        int Lx; if (c < 128) { if (i >= 3) return false; Lx = c + 128 * i; } else { if (i >= 5) return false; Lx = 384 + (c - 128) + 128 * i; }
        const int wgid = (Lx % NXCD) * 128 + Lx / NXCD, nig = WGM * 8;
        u.pm = (wgid / nig) * WGM + (wgid % nig) % WGM; u.pn = (wgid % nig) / WGM; return true; }
    __device__ __forceinline__ void a_ready(const Unit&) const {}
    __device__ __forceinline__ void done(const Unit&) const {}
};
struct EpiGlu {
    static constexpr bool PERM = true, AFTER_DRAIN = false;
    const bf16_t* Y; bf16_t* O;
    __device__ __forceinline__ void operator()(const f32x4 (&acc)[2][2][4][2], const Unit& u, int wr, int wc, int fr, int fq) const {
        const int row0 = u.pm * BM + wr * 64 + fr, col0 = u.pn * BM + wc * 32 + 8 * fq;
#pragma unroll
        for (int ai = 0; ai < 2; ++ai)
#pragma unroll
            for (int m = 0; m < 4; ++m) { const size_t off = (size_t)(row0 + ai * HALF + m * 16) * 512 + col0;
#pragma unroll
                for (int bj = 0; bj < 2; ++bj) { f32x4 y0, y1; unpack8(*(const u32x4*)(Y + off + bj * HALF), y0, y1); f32x4 v0, v1;
#pragma unroll
                    for (int j = 0; j < 4; ++j) { v0[j] = y0[j] * fsigmoid(acc[ai][bj][m][0][j]); v1[j] = y1[j] * fsigmoid(acc[ai][bj][m][1][j]); }
                    *(u32x4*)(O + off + bj * HALF) = pack8(v0, v1); } }
    }
};
template <bool SECOND> struct EpiMerge {
    static constexpr bool PERM = true, AFTER_DRAIN = false;
    const bf16_t* G; int goff; const bf16_t* T; bf16_t* O;
    __device__ __forceinline__ void operator()(const f32x4 (&acc)[2][2][4][2], const Unit& u, int wr, int wc, int fr, int fq) const {
        const int row0 = u.pm * BM + wr * 64 + fr, col0 = u.pn * BM + wc * 32 + 8 * fq;
#pragma unroll
        for (int ai = 0; ai < 2; ++ai)
#pragma unroll
            for (int m = 0; m < 4; ++m) { const size_t row = (size_t)(row0 + ai * HALF + m * 16);
#pragma unroll
                for (int bj = 0; bj < 2; ++bj) { const int col = col0 + bj * HALF; f32x4 g0, g1; unpack8(*(const u32x4*)(G + row * 2048 + goff + col), g0, g1);
                    f32x4 t0 = (f32x4){0.f, 0.f, 0.f, 0.f}, t1 = t0; if (SECOND) unpack8(*(const u32x4*)(T + row * 1024 + col), t0, t1);
                    f32x4 v0, v1;
#pragma unroll
                    for (int j = 0; j < 4; ++j) { v0[j] = t0[j] + fsigmoid(g0[j]) * acc[ai][bj][m][0][j]; v1[j] = t1[j] + fsigmoid(g1[j]) * acc[ai][bj][m][1][j]; }
                    *(u32x4*)(O + row * 1024 + col) = pack8(v0, v1); } }
    }
};

struct MergeOrder {
    StaticOrder base;
    __device__ __forceinline__ bool next(int i, Unit& u) const { if (i >= 4) return false; if (!base.next(i & 1, u)) return false; if (i >= 2) { u.pm += 128; u.pn += 4; } return true; }
    __device__ __forceinline__ void a_ready(const Unit&) const {}
    __device__ __forceinline__ void done(const Unit&) const {}
};
struct EpiMerge2 {
    static constexpr bool PERM = true, AFTER_DRAIN = false;
    const bf16_t* G; bf16_t* T; bf16_t* O;
    __device__ __forceinline__ void operator()(const f32x4 (&acc)[2][2][4][2], const Unit& u, int wr, int wc, int fr, int fq) const {
        const bool second = u.pm >= 128; const int pm = second ? u.pm - 128 : u.pm, pn = second ? u.pn - 4 : u.pn, goff = second ? 1024 : 0;
        const int row0 = pm * BM + wr * 64 + fr, col0 = pn * BM + wc * 32 + 8 * fq;
#pragma unroll
        for (int ai = 0; ai < 2; ++ai)
#pragma unroll
            for (int m = 0; m < 4; ++m) { const size_t row = (size_t)(row0 + ai * HALF + m * 16);
#pragma unroll
                for (int bj = 0; bj < 2; ++bj) { const int col = col0 + bj * HALF; f32x4 g0, g1; unpack8(*(const u32x4*)(G + row * 2048 + goff + col), g0, g1);
                    f32x4 t0 = (f32x4){0.f, 0.f, 0.f, 0.f}, t1 = t0; if (second) unpack8(*(const u32x4*)(T + row * 1024 + col), t0, t1);
                    f32x4 v0, v1;
#pragma unroll
                    for (int j = 0; j < 4; ++j) { v0[j] = t0[j] + fsigmoid(g0[j]) * acc[ai][bj][m][0][j]; v1[j] = t1[j] + fsigmoid(g1[j]) * acc[ai][bj][m][1][j]; }
                    *(u32x4*)((second ? O : T) + row * 1024 + col) = pack8(v0, v1); } }
    }
};
typedef int i32x8 __attribute__((ext_vector_type(8)));
typedef int i32x4v __attribute__((ext_vector_type(4)));
__device__ __forceinline__ i32x8 cat8(const bf16x8 lo, const bf16x8 hi) { const i32x4v a = __builtin_bit_cast(i32x4v, lo), b = __builtin_bit_cast(i32x4v, hi); return __builtin_shufflevector(a, b, 0, 1, 2, 3, 4, 5, 6, 7); }
template <class Epi, class Sched, bool ALIGN_EPI = false, bool SP2 = false, bool F8 = false>
__device__ __forceinline__ void gemm_phase(PG8_LAS unsigned char* lds, const Gemm g, const Sched& S, const Epi& E) {
    const int tid = threadIdx.x, wid = __builtin_amdgcn_readfirstlane(tid >> 6), lane = tid & 63, wr = wid >> 2, wc = wid & 3, fr = lane & 15, fq = lane >> 4;
    const int K = g.K, KB = F8 ? K : 2 * K  , nt = KB / 128;
    unsigned voffA[2], voffB[2];
#pragma unroll
    for (int i = 0; i < 2; ++i) { int R, C; stage_rc(tid * 16 + i * 8192, R, C); const int Rb = Epi::PERM ? ((R & ~31) + perm32(R & 31)) : R;
        voffA[i] = (unsigned)(R * KB + C * 2); voffB[i] = (unsigned)(Rb * KB + C * 2); }
    const size_t kstep = (size_t)(BK * 2);
    const size_t hstep = (size_t)HALF * KB;
    const size_t tstep = 2 * hstep;
    const unsigned ldsw = (unsigned)wid * 1024u;
    const int aoff = lds_byte(wr * 64 + fr, fq * 8), boff = lds_byte(wc * 32 + fr, fq * 8);
#define PG8_SA(b, h) (((b) * 2 + (h)) * HTB)
#define PG8_SB(b, h) ((4 + (b) * 2 + (h)) * HTB)
#define PG8_STAGE(bufoff, gbase, voff) do { _Pragma("unroll") for (int _i = 0; _i < 2; ++_i) \
        __builtin_amdgcn_global_load_lds((const unsigned*)((const char*)(gbase) + (voff)[_i]), (PG8_LAS unsigned*)(lds + (bufoff) + ldsw + _i * 8192), 16, 0, 0); } while (0)
#define PG8_LDA(dst, b, h) do { if constexpr (F8) { _Pragma("unroll") for (int m = 0; m < 4; ++m) dst##8[m] = cat8(*(const PG8_LAS bf16x8*)(lds + PG8_SA(b, h) + aoff + m * 2048), *(const PG8_LAS bf16x8*)(lds + PG8_SA(b, h) + aoff + m * 2048 + 1024)); } else { \
        _Pragma("unroll") for (int m = 0; m < 4; ++m) _Pragma("unroll") for (int k = 0; k < 2; ++k) dst[m][k] = *(const PG8_LAS bf16x8*)(lds + PG8_SA(b, h) + aoff + m * 2048 + k * 1024); } } while (0)
#define PG8_LDB(dst, b, h) do { if constexpr (F8) { _Pragma("unroll") for (int n = 0; n < 2; ++n) dst##8[n] = cat8(*(const PG8_LAS bf16x8*)(lds + PG8_SB(b, h) + boff + n * 2048), *(const PG8_LAS bf16x8*)(lds + PG8_SB(b, h) + boff + n * 2048 + 1024)); } else { \
        _Pragma("unroll") for (int n = 0; n < 2; ++n) _Pragma("unroll") for (int k = 0; k < 2; ++k) dst[n][k] = *(const PG8_LAS bf16x8*)(lds + PG8_SB(b, h) + boff + n * 2048 + k * 1024); } } while (0)
#define PG8_MMA(ai, bj, At, Bt) do { __builtin_amdgcn_s_setprio(1); if constexpr (F8) { _Pragma("unroll") for (int m = 0; m < 4; ++m) _Pragma("unroll") for (int n = 0; n < 2; ++n) \
        acc[ai][bj][m][n] = __builtin_amdgcn_mfma_scale_f32_16x16x128_f8f6f4(Bt##8[n], At##8[m], acc[ai][bj][m][n], 0, 0, 0, 0x7F7F7F7F, 0, 0x7F7F7F7F); \
        _Pragma("unroll") for (int m = 0; m < 4; ++m) _Pragma("unroll") for (int n = 0; n < 2; ++n) asm volatile("" : "+v"(acc[ai][bj][m][n])); } else { \
        _Pragma("unroll") for (int m = 0; m < 4; ++m) _Pragma("unroll") for (int n = 0; n < 2; ++n) _Pragma("unroll") for (int k = 0; k < 2; ++k) \
        acc[ai][bj][m][n] = __builtin_amdgcn_mfma_f32_16x16x32_bf16(Bt[n][k], At[m][k], acc[ai][bj][m][n], 0, 0, 0); } __builtin_amdgcn_s_setprio(0); } while (0)
#define PG8_WAIT_V(n) asm volatile("s_waitcnt vmcnt(" #n ")" ::: "memory")
#define PG8_WAIT_L(n) asm volatile("s_waitcnt lgkmcnt(" #n ")" ::: "memory")
#define PG8_BAR __builtin_amdgcn_s_barrier()
#define PG8_SCHED __builtin_amdgcn_sched_barrier(0)
    Unit cur, nxt; int ui = 0;
    if (!S.next(0, cur)) return;
    f32x4 acc[2][2][4][2];
#pragma unroll
    for (int a = 0; a < 2; ++a)
#pragma unroll
        for (int b = 0; b < 2; ++b)
#pragma unroll
            for (int m = 0; m < 4; ++m)
#pragma unroll
                for (int n = 0; n < 2; ++n) acc[a][b][m][n] = (f32x4){0.f, 0.f, 0.f, 0.f};
    bf16x8 At[4][2], B0[2][2], B1[2][2]; i32x8 At8[4], B08[2], B18[2];
    const char* cA = (const char*)g.A + (size_t)cur.pm * tstep; const char* cB = (const char*)g.Bt + (size_t)cur.pn * tstep;
    S.a_ready(cur);
    if constexpr (SP2) {
        PG8_STAGE(PG8_SB(0, 0), cB, voffB); PG8_STAGE(PG8_SB(0, 1), cB + hstep, voffB); PG8_STAGE(PG8_SA(0, 0), cA, voffA); PG8_STAGE(PG8_SA(0, 1), cA + hstep, voffA);
        if (wr == 1) PG8_BAR;
        PG8_WAIT_V(2); PG8_BAR;
        PG8_STAGE(PG8_SB(1, 0), cB + kstep, voffB); PG8_STAGE(PG8_SA(1, 0), cA + kstep, voffA); PG8_STAGE(PG8_SB(1, 1), cB + hstep + kstep, voffB);
        PG8_WAIT_V(6); PG8_BAR;
    } else {
        PG8_STAGE(PG8_SB(0, 0), cB, voffB); PG8_STAGE(PG8_SA(0, 0), cA, voffA); PG8_STAGE(PG8_SB(0, 1), cB + hstep, voffB); PG8_STAGE(PG8_SA(0, 1), cA + hstep, voffA);
        if (wr == 1) PG8_BAR;
        PG8_WAIT_V(4); PG8_BAR;
        PG8_STAGE(PG8_SB(1, 0), cB + kstep, voffB); PG8_STAGE(PG8_SA(1, 0), cA + kstep, voffA); PG8_STAGE(PG8_SB(1, 1), cB + hstep + kstep, voffB);
        PG8_WAIT_V(6); PG8_BAR;
    }
    for (;;) {
        const bool has_next = S.next(ui + 1, nxt);
        const char* nA = has_next ? (const char*)g.A + (size_t)nxt.pm * tstep : cA; const char* nB = has_next ? (const char*)g.Bt + (size_t)nxt.pn * tstep : cB;
        for (int t = 0; t < nt; t += 2) {
            const bool last = (t == nt - 2);
            const char* a1 = cA + (size_t)(t + 1) * kstep;
            const char* a2 = last ? nA : cA + (size_t)(t + 2) * kstep; const char* b2 = last ? nB : cB + (size_t)(t + 2) * kstep;
            const char* a3 = a2 + kstep; const char* b3 = b2 + kstep;
            if (last && has_next) S.a_ready(nxt);
            if constexpr (SP2) {
            PG8_LDB(B0, 0, 0); PG8_LDB(B1, 0, 1); PG8_SCHED; PG8_LDA(At, 0, 0); PG8_STAGE(PG8_SA(1, 1), a1 + hstep, voffA);
            PG8_WAIT_V(8); PG8_WAIT_L(0); PG8_BAR; PG8_MMA(0, 0, At, B0); PG8_MMA(0, 1, At, B1); PG8_BAR; PG8_SCHED;
            PG8_LDA(At, 0, 1); PG8_STAGE(PG8_SB(0, 0), b2, voffB); PG8_STAGE(PG8_SB(0, 1), b2 + hstep, voffB); PG8_STAGE(PG8_SA(0, 0), a2, voffA);
            PG8_WAIT_V(8); PG8_WAIT_L(0); PG8_BAR; PG8_MMA(1, 0, At, B0); PG8_MMA(1, 1, At, B1); PG8_BAR; PG8_SCHED;
            PG8_LDB(B0, 1, 0); PG8_LDB(B1, 1, 1); PG8_SCHED; PG8_LDA(At, 1, 0); PG8_STAGE(PG8_SA(0, 1), a2 + hstep, voffA);
            PG8_WAIT_V(8); PG8_WAIT_L(0); PG8_BAR; PG8_MMA(0, 0, At, B0); PG8_MMA(0, 1, At, B1); PG8_BAR; PG8_SCHED;
            PG8_LDA(At, 1, 1); PG8_STAGE(PG8_SB(1, 0), b3, voffB); PG8_STAGE(PG8_SB(1, 1), b3 + hstep, voffB); PG8_STAGE(PG8_SA(1, 0), a3, voffA);
            PG8_WAIT_V(8); PG8_WAIT_L(0); PG8_BAR; PG8_MMA(1, 0, At, B0); PG8_MMA(1, 1, At, B1); PG8_BAR; PG8_SCHED;
            } else {
            PG8_LDB(B0, 0, 0); PG8_SCHED; PG8_LDA(At, 0, 0); PG8_STAGE(PG8_SA(1, 1), a1 + hstep, voffA);
            PG8_WAIT_L(8); PG8_BAR; PG8_WAIT_L(0); PG8_MMA(0, 0, At, B0); PG8_BAR; PG8_SCHED;
            PG8_LDB(B1, 0, 1); PG8_STAGE(PG8_SB(0, 0), b2, voffB);
            PG8_BAR; PG8_WAIT_L(0); PG8_MMA(0, 1, At, B1); PG8_BAR;
            PG8_LDA(At, 0, 1); PG8_STAGE(PG8_SA(0, 0), a2, voffA);
            PG8_BAR; PG8_WAIT_L(0); PG8_MMA(1, 0, At, B0); PG8_BAR; PG8_SCHED;
            PG8_STAGE(PG8_SB(0, 1), b2 + hstep, voffB);
            PG8_WAIT_V(6); PG8_BAR; PG8_MMA(1, 1, At, B1); PG8_BAR;
            PG8_LDB(B0, 1, 0); PG8_SCHED; PG8_LDA(At, 1, 0); PG8_STAGE(PG8_SA(0, 1), a2 + hstep, voffA);
            PG8_WAIT_L(8); PG8_BAR; PG8_WAIT_L(0); PG8_MMA(0, 0, At, B0); PG8_BAR; PG8_SCHED;
            PG8_LDB(B1, 1, 1); PG8_STAGE(PG8_SB(1, 0), b3, voffB);
            PG8_BAR; PG8_WAIT_L(0); PG8_MMA(0, 1, At, B1); PG8_BAR;
            PG8_LDA(At, 1, 1); PG8_STAGE(PG8_SA(1, 0), a3, voffA);
            PG8_BAR; PG8_WAIT_L(0); PG8_MMA(1, 0, At, B0); PG8_BAR; PG8_SCHED;
            PG8_STAGE(PG8_SB(1, 1), b3 + hstep, voffB);
            PG8_WAIT_V(6); PG8_BAR; PG8_MMA(1, 1, At, B1); PG8_BAR;
            }
        }
        if constexpr (ALIGN_EPI) { if (wr == 0) PG8_BAR; }
        if constexpr (!Epi::AFTER_DRAIN) { E(acc, cur, wr, wc, fr, fq); S.done(cur); }
        if (!has_next) break;
#pragma unroll
        for (int a = 0; a < 2; ++a)
#pragma unroll
            for (int b = 0; b < 2; ++b)
#pragma unroll
                for (int m = 0; m < 4; ++m)
#pragma unroll
                    for (int n = 0; n < 2; ++n) acc[a][b][m][n] = (f32x4){0.f, 0.f, 0.f, 0.f};
        cur = nxt; cA = nA; cB = nB; ++ui;
        if constexpr (ALIGN_EPI) { if (wr == 1) PG8_BAR; }
    }
    PG8_WAIT_V(0);
    if constexpr (!ALIGN_EPI) { if (wr == 0) PG8_BAR; }
    PG8_BAR;
    if constexpr (Epi::AFTER_DRAIN) { E.fused(acc, cur, wr, wc, fr, fq, lds, wid, lane); S.done(cur); }
#undef PG8_SA
#undef PG8_SB
#undef PG8_STAGE
#undef PG8_LDA
#undef PG8_LDB
#undef PG8_MMA
#undef PG8_WAIT_V
#undef PG8_WAIT_L
#undef PG8_BAR
#undef PG8_SCHED
}
}
#ifndef PG8_SP2
#define PG8_SP2 true
#endif
#ifndef PG8_ALIGN
#define PG8_ALIGN true
#endif
#ifndef MK_PER_PHASE
#define MK_PER_PHASE 0
#endif
#ifndef REP_S5
#define REP_S5 1
#endif
#ifndef REP_DSA
#define REP_DSA 1
#endif
#ifndef REP_G1
#define REP_G1 1
#endif
constexpr int NWAVES = 8;
constexpr int NPH = 14;

constexpr int NB = 16, SEQ = 2048, D = 1024, NMETA = 16, DFF = 2816;
constexpr int R = NB * SEQ;
constexpr int NG = 32, NP = 64, NM = 16;
constexpr float RMS_EPS = 1e-6f;

constexpr size_t MiB = 1u << 20;
constexpr size_t WS_CTL = 0, CTL_ZERO_BYTES = 1 * MiB;
constexpr size_t WS_WT3B = 23 * MiB  ;
constexpr size_t WS_WT1 = 2 * MiB, WS_WT2 = 13 * MiB, WS_WT3 = 19 * MiB, WS_WT4 = 27 * MiB, WS_WT5 = 38 * MiB;
constexpr size_t WS_WGLU = 44 * MiB, WS_WA = 45 * MiB, WS_WB = 46 * MiB, WS_WOUT = 47 * MiB;
constexpr size_t WS_KS = 50 * MiB, WS_KO = 58 * MiB, WS_KI = 66 * MiB;
constexpr size_t WS_META = 67 * MiB;
constexpr size_t MO_AM1 = 0, MO_ACTM = 32768, MO_FM = 131072, MO_AM2 = 262144, MO_PMU = 294912, MO_PMK = 311296;
constexpr size_t WS_HN = 68 * MiB;
constexpr size_t WS_F = 132 * MiB;
constexpr size_t WS_BIG = 196 * MiB;
constexpr size_t WS_PA = WS_BIG, WS_PG = WS_BIG + 96 * MiB, WS_PK = WS_BIG + 224 * MiB, WS_HB = WS_BIG + 240 * MiB  , WS_END = 503 * MiB;
constexpr size_t WS_WT2Q = 500 * MiB;
constexpr size_t WS_HB8 = WS_BIG + 64 * MiB;
constexpr size_t WS_UA2 = WS_F + 32 * MiB;
constexpr int CW_BAR = 4096;

constexpr int LDS_BYTES = 155648;
constexpr int MISC_OFF = 154624;

#define GAS __attribute__((address_space(1)))
#define LAS __attribute__((address_space(3)))
typedef unsigned short bf16;
typedef unsigned v4u __attribute__((ext_vector_type(4)));
typedef unsigned v2u __attribute__((ext_vector_type(2)));
typedef float f32x4 __attribute__((ext_vector_type(4)));
typedef short bf16x8 __attribute__((ext_vector_type(8)));
#define LDS_WAIT() asm volatile("s_waitcnt lgkmcnt(0)" ::: "memory")
#define VM_WAIT() asm volatile("s_waitcnt vmcnt(0)" ::: "memory")
__device__ __forceinline__ unsigned f2bf(float f) { unsigned u = __builtin_bit_cast(unsigned, f); return (u + 0x7fffu + ((u >> 16) & 1u)) >> 16; }
__device__ __forceinline__ unsigned pk2(float lo, float hi) { return f2bf(lo) | (f2bf(hi) << 16); }
__device__ __forceinline__ float bflo(unsigned w) { return __uint_as_float(w << 16); }
__device__ __forceinline__ float bfhi(unsigned w) { return __uint_as_float(w & 0xffff0000u); }
__device__ __forceinline__ float bf2f(bf16 v) { return __uint_as_float(((unsigned)v) << 16); }
__device__ __forceinline__ float fsig(float x) { return __builtin_amdgcn_rcpf(1.0f + __expf(-x)); }

#define XB_TMO      128
#define XB_XCNT(j)  (256  + 64 * (j))
#define XB_XSUB(j)  (1280 + 64 * (j))
#define XB_XGEN(j)  (2304 + 64 * (j))
#define XB_TOP      3328
#define XB_TOPGEN   3392
#define XCD_BAR_WORDS 3456
#define XB_SPIN_CAP (1u << 18)
__device__ __forceinline__ unsigned xb_ld(unsigned* p)              { return __hip_atomic_load(p, __ATOMIC_RELAXED, __HIP_MEMORY_SCOPE_AGENT); }
__device__ __forceinline__ unsigned xb_add(unsigned* p, unsigned v) { return __hip_atomic_fetch_add(p, v, __ATOMIC_RELAXED, __HIP_MEMORY_SCOPE_AGENT); }
__device__ __forceinline__ unsigned xb_xcc_id() { return (unsigned)__builtin_amdgcn_s_getreg((3 << 11) | 20) & 0xFu; }
#define XB_SPIN(cond, bar) do { unsigned _sp = 0; while (cond) { __builtin_amdgcn_s_sleep(1); \
    if ((++_sp & 255u) == 0u) { if (xb_ld(&(bar)[XB_TMO])) break; if (_sp > XB_SPIN_CAP) { atomicAdd(&(bar)[XB_TMO], 1u); break; } } } } while (0)
struct XcdBarrier { unsigned* bar; unsigned x; volatile LAS unsigned* st; };
__device__ __forceinline__ XcdBarrier xcd_barrier_post(unsigned* bar, volatile LAS unsigned* st) {
    XcdBarrier b; b.bar = bar; b.x = xb_xcc_id(); b.st = st;
    if (threadIdx.x == 0) (void)xb_add(&bar[XB_XCNT(b.x)], 1u);
    return b;
}
__device__ __forceinline__ void xcd_barrier_complete(unsigned* bar, unsigned x, unsigned& nloc, unsigned& nx) {
    const unsigned G = gridDim.x * gridDim.y * gridDim.z;
    unsigned sum, cnt, mine, sp = 0u;
    for (;;) {
        sum = 0u; cnt = 0u; mine = 0u;
#pragma unroll
        for (unsigned j = 0; j < 16; ++j) { const unsigned c = xb_ld(&bar[XB_XCNT(j)]); sum += c; cnt += (c > 0u) ? 1u : 0u; mine = (j == x) ? c : mine; }
        if (sum == G) break;
        __builtin_amdgcn_s_sleep(1);
        if ((++sp & 255u) == 0u) { if (xb_ld(&bar[XB_TMO])) break; if (sp > XB_SPIN_CAP) { atomicAdd(&bar[XB_TMO], 1u); break; } }
    }
    nloc = mine > 0u ? mine : 1u; nx = cnt > 0u ? cnt : 1u;
}
__device__ __forceinline__ void xcd_barrier(const XcdBarrier& b) {
    asm volatile("s_waitcnt vmcnt(0)" ::: "memory");
    __syncthreads();
    if (threadIdx.x == 0) {
        unsigned* bar = b.bar;
        __builtin_amdgcn_s_waitcnt(0);
        unsigned nloc = b.st[0], nx = b.st[1];
        if (nloc == 0u) { xcd_barrier_complete(bar, b.x, nloc, nx); b.st[0] = nloc; b.st[1] = nx; }
        const unsigned old = xb_add(&bar[XB_XSUB(b.x)], 1u);
        const unsigned gen = old / nloc;
        if (old + 1u == (gen + 1u) * nloc) {
            __builtin_amdgcn_fence(__ATOMIC_RELEASE, "agent");
            asm volatile("s_waitcnt vmcnt(0)" ::: "memory");
            const unsigned og = xb_add(&bar[XB_TOP], 1u);
            const unsigned tg = og / nx;
            if (og + 1u == (tg + 1u) * nx) xb_add(&bar[XB_TOPGEN], 1u);
            else XB_SPIN(xb_ld(&bar[XB_TOPGEN]) == tg, bar);
            __builtin_amdgcn_fence(__ATOMIC_ACQUIRE, "agent");
            xb_add(&bar[XB_XGEN(b.x)], 1u);
            asm volatile("s_waitcnt vmcnt(0)" ::: "memory");
        } else {
            XB_SPIN(xb_ld(&bar[XB_XGEN(b.x)]) == gen, bar);
            __builtin_amdgcn_fence(__ATOMIC_ACQUIRE, "agent");
            asm volatile("s_waitcnt vmcnt(0)" ::: "memory");
        }
    }
    __syncthreads();
}

__device__ __forceinline__ float wave_sum(float v) {
#pragma unroll
    for (int o = 1; o < 64; o <<= 1) v += __shfl_xor(v, o);
    return v;
}
__device__ __forceinline__ f32x4 mfma16(bf16x8 a, bf16x8 b, f32x4 c) { return __builtin_amdgcn_mfma_f32_16x16x32_bf16(a, b, c, 0, 0, 0); }

__device__ __forceinline__ void transpose_item(const float* W, int Nsrc, int K, bf16* WT, int k0, int drow0, int srccol, LAS float* scr, int lane, const float* gk = nullptr) {
#pragma unroll 8
    for (int i = 0; i < 32; ++i) { const int kk = 2 * i + (lane >> 5); float wv_ = (srccol >= 0) ? W[(size_t)(k0 + kk) * Nsrc + srccol] : 0.f; if (gk) wv_ *= gk[k0 + kk]; scr[kk * 33 + (lane & 31)] = wv_; }
    LDS_WAIT(); asm volatile("" ::: "memory");
    const int c = lane & 7;
#pragma unroll
    for (int j = 0; j < 4; ++j) { const int n = (lane >> 3) + 8 * j; const LAS float* s = scr + (8 * c) * 33 + n;
        v4u o; o.x = pk2(s[0 * 33], s[1 * 33]); o.y = pk2(s[2 * 33], s[3 * 33]); o.z = pk2(s[4 * 33], s[5 * 33]); o.w = pk2(s[6 * 33], s[7 * 33]);
        *(v4u*)(WT + (size_t)(drow0 + n) * K + k0 + 8 * c) = o; }
    LDS_WAIT(); asm volatile("" ::: "memory");
}

__device__ __forceinline__ unsigned pk4q(float a, float b, float c, float d) { int w = 0; w = __builtin_amdgcn_cvt_pk_fp8_f32(fminf(fmaxf(a, -448.f), 448.f), fminf(fmaxf(b, -448.f), 448.f), w, false);
    w = __builtin_amdgcn_cvt_pk_fp8_f32(fminf(fmaxf(c, -448.f), 448.f), fminf(fmaxf(d, -448.f), 448.f), w, true); return (unsigned)w; }
__device__ __forceinline__ void transpose_item8(const float* W, int Nsrc, int K, unsigned char* WT8, int k0, int drow0, int srccol, LAS float* scr, int lane, const float* gk = nullptr) {
#pragma unroll 8
    for (int i = 0; i < 32; ++i) { const int kk = 2 * i + (lane >> 5); float wv_ = W[(size_t)(k0 + kk) * Nsrc + srccol] * 64.0f; if (gk) wv_ *= gk[k0 + kk]; scr[kk * 33 + (lane & 31)] = wv_; }
    LDS_WAIT(); asm volatile("" ::: "memory");
    const int c = lane & 7;
#pragma unroll
    for (int j = 0; j < 4; ++j) { const int n = (lane >> 3) + 8 * j; const LAS float* sp = scr + (8 * c) * 33 + n;
        v2u o; o.x = pk4q(sp[0 * 33], sp[1 * 33], sp[2 * 33], sp[3 * 33]); o.y = pk4q(sp[4 * 33], sp[5 * 33], sp[6 * 33], sp[7 * 33]);
        *(v2u*)(WT8 + (size_t)(drow0 + n) * K + k0 + 8 * c) = o; }
    LDS_WAIT(); asm volatile("" ::: "memory");
}
__device__ __forceinline__ int win_srccol(int d) {
    if (d < 1024) return d;
    if (d < 1536) return 1096 + (d - 1024);
    if (d < 1600) return 1024 + (d - 1536);
    if (d < 1664) return 1608 + (d - 1600);
    if (d < 1728) return 1672 + (d - 1664);
    if (d < 1736) return 1088 + (d - 1728);
    return -1;
}
__device__ __forceinline__ void norm_row_to_bf16(const float* xrow, const float* g, bf16* orow, int lane) {
    f32x4 v[4]; float ss = 0.f;
#pragma unroll
    for (int j = 0; j < 4; ++j) { v[j] = ((const f32x4*)xrow)[lane + 64 * j]; ss += (v[j].x * v[j].x + v[j].y * v[j].y) + (v[j].z * v[j].z + v[j].w * v[j].w); }
    const float rs = rsqrtf(wave_sum(ss) * (1.f / D) + RMS_EPS);
#pragma unroll
    for (int j = 0; j < 4; ++j) { const f32x4 gv = ((const f32x4*)g)[lane + 64 * j]; v2u o; o.x = pk2(v[j].x * rs * gv.x, v[j].y * rs * gv.y); o.y = pk2(v[j].z * rs * gv.z, v[j].w * rs * gv.w);
        ((v2u*)orow)[lane + 64 * j] = o; }
}
template <bool PRESCALE>
__device__ __forceinline__ void x_row_to_bf16(const float* xrow, bf16* orow, float* rs_out, int lane) {
    f32x4 v[4]; float ss = 0.f;
#pragma unroll
    for (int j = 0; j < 4; ++j) { v[j] = ((const f32x4*)xrow)[lane + 64 * j]; ss += (v[j].x * v[j].x + v[j].y * v[j].y) + (v[j].z * v[j].z + v[j].w * v[j].w); }
    const float rs = rsqrtf(wave_sum(ss) * (1.f / D) + RMS_EPS), pre = PRESCALE ? rs : 1.0f;
#pragma unroll
    for (int j = 0; j < 4; ++j) { v2u o; o.x = pk2(v[j].x * pre, v[j].y * pre); o.y = pk2(v[j].z * pre, v[j].w * pre); ((v2u*)orow)[lane + 64 * j] = o; }
    if (rs_out && lane == 0) *rs_out = rs;
}
template <bool BASE_BF16, bool OUT_BF16, bool HN_F8 = false>
__device__ __forceinline__ void row_update(const bf16* frow, const void* base, void* outrow, bf16* hnrow, const float* gpost, const float* gnext, float scale, int lane, float* rs_out = nullptr, unsigned* h8row = nullptr) {
    f32x4 f[4], h[4]; float ss = 0.f;
#pragma unroll
    for (int j = 0; j < 4; ++j) { const v2u w = ((const v2u*)frow)[lane + 64 * j]; f[j] = (f32x4){bflo(w.x), bfhi(w.x), bflo(w.y), bfhi(w.y)};
        ss += (f[j].x * f[j].x + f[j].y * f[j].y) + (f[j].z * f[j].z + f[j].w * f[j].w); }
    const float rs = rsqrtf(wave_sum(ss) * (1.f / D) + RMS_EPS) * scale; float s2 = 0.f;
#pragma unroll
    for (int j = 0; j < 4; ++j) { const f32x4 gv = ((const f32x4*)gpost)[lane + 64 * j]; f32x4 bv;
        if (BASE_BF16) { const v2u w = ((const v2u*)base)[lane + 64 * j]; bv = (f32x4){bflo(w.x), bfhi(w.x), bflo(w.y), bfhi(w.y)}; } else bv = ((const f32x4*)base)[lane + 64 * j];
        h[j] = bv + f[j] * rs * gv; s2 += (h[j].x * h[j].x + h[j].y * h[j].y) + (h[j].z * h[j].z + h[j].w * h[j].w); }
    if (h8row) {
#pragma unroll
        for (int j = 0; j < 4; ++j) h8row[lane + 64 * j] = pk4q(4.0f * h[j].x, 4.0f * h[j].y, 4.0f * h[j].z, 4.0f * h[j].w); }
    if (outrow) {
#pragma unroll
        for (int j = 0; j < 4; ++j) { if (OUT_BF16) { v2u o; o.x = pk2(h[j].x, h[j].y); o.y = pk2(h[j].z, h[j].w); ((v2u*)outrow)[lane + 64 * j] = o; } else ((f32x4*)outrow)[lane + 64 * j] = h[j]; } }
    if (hnrow || rs_out) { const float r2 = rsqrtf(wave_sum(s2) * (1.f / D) + RMS_EPS); if (rs_out && lane == 0) *rs_out = r2;
        if (hnrow)
#pragma unroll
        for (int j = 0; j < 4; ++j) { const f32x4 gv = gnext ? ((const f32x4*)gnext)[lane + 64 * j] : (f32x4){1.f, 1.f, 1.f, 1.f};
            if (HN_F8) { const float q = 4.0f * r2; ((unsigned*)hnrow)[lane + 64 * j] = pk4q(h[j].x * q * gv.x, h[j].y * q * gv.y, h[j].z * q * gv.z, h[j].w * q * gv.w); }
            else { v2u o; o.x = pk2(h[j].x * r2 * gv.x, h[j].y * r2 * gv.y); o.y = pk2(h[j].z * r2 * gv.z, h[j].w * r2 * gv.w); ((v2u*)hnrow)[lane + 64 * j] = o; } } }
}
__device__ __forceinline__ f32x4 meta_tile(const bf16* A, const bf16* B, int K, int lane) {
    const int fr = lane & 15, kq = lane >> 4; const bf16* ap = A + (size_t)fr * K + 8 * kq; const bf16* bp = B + (size_t)fr * K + 8 * kq;
    f32x4 acc = (f32x4){0.f, 0.f, 0.f, 0.f};
#pragma unroll 4
    for (int k = 0; k < K; k += 32) { const bf16x8 a = *(const bf16x8*)(ap + k); const bf16x8 b = *(const bf16x8*)(bp + k); acc = mfma16(a, b, acc); }
    return acc;
}


template <int STEPS>
__device__ __forceinline__ void meta_tile_blk(const bf16* A, const bf16* B0, const bf16* B1, int K, LAS float* red, int wave, int lane, f32x4& c0, f32x4& c1) {
    const int fr = lane & 15, kq = lane >> 4, k0 = wave * (32 * STEPS);
    const bf16* ap = A + (size_t)fr * K + k0 + 8 * kq; const bf16* bp0 = B0 + (size_t)fr * K + k0 + 8 * kq; const bf16* bp1 = (B1 ? B1 : B0) + (size_t)fr * K + k0 + 8 * kq;
    bf16x8 av[STEPS], bv0[STEPS], bv1[STEPS];
#pragma unroll
    for (int i = 0; i < STEPS; ++i) { av[i] = *(const bf16x8*)(ap + 32 * i); bv0[i] = *(const bf16x8*)(bp0 + 32 * i); bv1[i] = *(const bf16x8*)(bp1 + 32 * i); }
    f32x4 a0 = (f32x4){0.f, 0.f, 0.f, 0.f}, a1 = a0;
#pragma unroll
    for (int i = 0; i < STEPS; ++i) { a0 = mfma16(av[i], bv0[i], a0); a1 = mfma16(av[i], bv1[i], a1); }
    *(LAS f32x4*)(red + (wave * 64 + lane) * 8) = a0; *(LAS f32x4*)(red + (wave * 64 + lane) * 8 + 4) = a1;
    __syncthreads();
    c0 = (f32x4){0.f, 0.f, 0.f, 0.f}; c1 = c0;
#pragma unroll
    for (int w2 = 0; w2 < 8; ++w2) { c0 += *(const LAS f32x4*)(red + (w2 * 64 + lane) * 8); c1 += *(const LAS f32x4*)(red + (w2 * 64 + lane) * 8 + 4); }
    __syncthreads();
}

struct Args { const float* in[28]; float* out; unsigned char* ws; int ph_lo, ph_hi; };

__device__ __forceinline__ void s5_tables_block(const Args& a, int g, int oct, LAS float* sc, int tid) {
    const float* lam_re = a.in[15]; const float* lam_im = a.in[16]; const float* log_dt = a.in[17];
    const float* b_re = a.in[18]; const float* b_im = a.in[19]; const float* c_re = a.in[20]; const float* c_im = a.in[21]; const float* dsk = a.in[22];
    LAS float* CR = sc; LAS float* CI = sc + 1024; LAS float* BR = sc + 2048; LAS float* BI = sc + 3072;
    LAS float* ANG = sc + 4096; LAS float* LRDT = sc + 4160; LAS float* CFR = sc + 4224; LAS float* CFI = sc + 4288;
    LAS float* WR = sc + 4352; LAS float* WI = sc + 4864;
    __syncthreads();
#pragma unroll
    for (int k = 0; k < 2; ++k) { const int e = tid + 512 * k; CR[e] = c_re[g * 1024 + e]; CI[e] = c_im[g * 1024 + e]; BR[e] = b_re[g * 1024 + e]; BI[e] = b_im[g * 1024 + e]; }
    if (tid < 64) { const int p = tid; const float lr = lam_re[g * 64 + p], li = lam_im[g * 64 + p], dt = expf(log_dt[g]);
        const float ang = li * dt, mag = expf(lr * dt); float s1, c1; sincosf(ang, &s1, &c1);
        const float a_re = mag * c1, a_im = mag * s1, den = lr * lr + li * li, nr = a_re - 1.0f, ni = a_im;
        ANG[p] = ang; LRDT[p] = lr * dt; CFR[p] = (nr * lr + ni * li) / den; CFI[p] = (ni * lr - nr * li) / den; }
    __syncthreads();
    const int ti = tid >> 6, p64 = tid & 63, idx0 = 8 * oct;
    { const float n = (float)(idx0 + ti); float sn, cn; sincosf(n * ANG[p64], &sn, &cn); const float mn = expf(n * LRDT[p64]); const float pr = mn * cn, pi = mn * sn;
      WR[tid] = pr * CFR[p64] - pi * CFI[p64]; WI[tid] = pr * CFI[p64] + pi * CFR[p64]; }
    __syncthreads();
#pragma unroll
    for (int k = 0; k < 4; ++k) { const int e = tid + 512 * k, t8 = e >> 8, m = (e >> 4) & 15, mp = e & 15; float s = 0.f;
        for (int p = 0; p < 64; ++p) { const float wr_ = WR[t8 * 64 + p], wi_ = WI[t8 * 64 + p], br = BR[p * 16 + mp], bi = BI[p * 16 + mp];
            const float zr = wr_ * br - wi_ * bi, zi = wr_ * bi + wi_ * br; s += CR[m * 64 + p] * zr - CI[m * 64 + p] * zi; }
        if (idx0 + t8 == 0 && m == mp) s += dsk[g * 16 + m];
        ((bf16*)(a.ws + WS_KI))[((g * 64 + idx0 + t8) * 16 + m) * 16 + mp] = (bf16)f2bf(s); }
    __syncthreads();
    { const float n = (float)(63 - (idx0 + ti)); float sn, cn; sincosf(n * ANG[p64], &sn, &cn); const float mn = expf(n * LRDT[p64]); const float pr = mn * cn, pi = mn * sn;
      WR[tid] = pr * CFR[p64] - pi * CFI[p64]; WI[tid] = pr * CFI[p64] + pi * CFR[p64]; }
    __syncthreads();
    for (int k = 0; k < 32; ++k) { const int e = tid + 512 * k, t8 = e >> 11, n_ = (e >> 4) & 127, mp = e & 15, p = n_ & 63;
        const float wr_ = WR[t8 * 64 + p], wi_ = WI[t8 * 64 + p], br = BR[p * 16 + mp], bi = BI[p * 16 + mp];
        const float zr = wr_ * br - wi_ * bi, zi = wr_ * bi + wi_ * br;
        ((bf16*)(a.ws + WS_KS))[((size_t)(g * 64 + idx0 + t8) * 128 + n_) * 16 + mp] = (bf16)f2bf(n_ < 64 ? zr : zi); }
    __syncthreads();
    { const float n = (float)(idx0 + ti + 1); float sn, cn; sincosf(n * ANG[p64], &sn, &cn); const float mn = expf(n * LRDT[p64]); WR[tid] = mn * cn; WI[tid] = mn * sn; }
    __syncthreads();
    for (int k = 0; k < 32; ++k) { const int e = tid + 512 * k, t8 = e >> 11, m = (e >> 7) & 15, kk = e & 127, p = kk & 63;
        const float cr = CR[m * 64 + p], ci = CI[m * 64 + p], ar_ = WR[t8 * 64 + p], ai_ = WI[t8 * 64 + p];
        const float wr_ = cr * ar_ - ci * ai_, wi_ = cr * ai_ + ci * ar_;
        ((bf16*)(a.ws + WS_KO))[((size_t)(g * 64 + idx0 + t8) * 16 + m) * 128 + kk] = (bf16)f2bf(kk < 64 ? wr_ : -wi_); }
}

constexpr int S5_U = 0, S5_USTR = 2064, S5_KI = 66048, S5_SLOC = 98816, S5_XINB = 115200, S5_XSTR = 272, S5_MISC = 123904;
__device__ __forceinline__ float gelu_tanh(float x) { const float z = 0.7978845608028654f * (x + 0.044715f * x * x * x); return x * fsig(2.0f * z); }
__device__ __forceinline__ void s5_meta(const Args& a, LAS unsigned char* L, int g, int tid) {
    const int lane = tid & 63; const bf16* PMU = (const bf16*)(a.ws + WS_META + MO_PMU); LAS float* MS = (LAS float*)(L + S5_MISC);
    if (tid < 64) { const int p = lane; const float lr = a.in[15][g * 64 + p], li = a.in[16][g * 64 + p], dt = expf(a.in[17][g]);
        const float ang = li * dt, mag = expf(lr * dt); float s1, c1; sincosf(ang, &s1, &c1);
        const float a_re = mag * c1, a_im = mag * s1, den = lr * lr + li * li, nr = a_re - 1.0f, ni = a_im;
        const float cf_re = (nr * lr + ni * li) / den, cf_im = (ni * lr - nr * li) / den;
        float bb_re[16], bb_im[16];
#pragma unroll
        for (int m = 0; m < 16; ++m) { const float br = a.in[18][(g * 64 + p) * 16 + m], bi = a.in[19][(g * 64 + p) * 16 + m]; bb_re[m] = cf_re * br - cf_im * bi; bb_im[m] = cf_re * bi + cf_im * br; }
        LAS bf16* UM = (LAS bf16*)(L + S5_MISC + 1024);
        if (lane < 32) *(LAS v4u*)(UM + lane * 8) = *(const v4u*)(PMU + (lane >> 1) * 512 + 16 * g + 8 * (lane & 1));
        LDS_WAIT();
        float xr = 0.f, xi = 0.f;
#pragma unroll
        for (int i = 0; i < 16; ++i) { float ur = 0.f, ui = 0.f; const v4u w0 = *(const LAS v4u*)(UM + i * 16), w1 = *(const LAS v4u*)(UM + i * 16 + 8);
            const float uu[16] = {bflo(w0.x), bfhi(w0.x), bflo(w0.y), bfhi(w0.y), bflo(w0.z), bfhi(w0.z), bflo(w0.w), bfhi(w0.w), bflo(w1.x), bfhi(w1.x), bflo(w1.y), bfhi(w1.y), bflo(w1.z), bfhi(w1.z), bflo(w1.w), bfhi(w1.w)};
#pragma unroll
            for (int m = 0; m < 16; ++m) { ur += bb_re[m] * uu[m]; ui += bb_im[m] * uu[m]; }
            const float nr2 = a_re * xr - a_im * xi + ur, ni2 = a_re * xi + a_im * xr + ui; xr = nr2; xi = ni2; }
        float s64, c64; sincosf(64.0f * ang, &s64, &c64); const float m64 = expf(64.0f * lr * dt);
        MS[p] = xr; MS[64 + p] = xi; MS[128 + p] = m64 * c64; MS[192 + p] = m64 * s64; }
}
__device__ __forceinline__ void s5_unit(const Args& a, LAS unsigned char* L, int b, int g, int tid) {
    const int lane = tid & 63, w = __builtin_amdgcn_readfirstlane(tid >> 6), fr = lane & 15, kq = lane >> 4;
    const bf16* UA2 = (const bf16*)(a.ws + WS_UA2) + (size_t)(b * 32 + g) * 2048 * 16;
    const bf16* KS = (const bf16*)(a.ws + WS_KS); const bf16* KO = (const bf16*)(a.ws + WS_KO); const bf16* KI = (const bf16*)(a.ws + WS_KI);
    bf16* YA = (bf16*)(a.ws + WS_F);
    LAS float* SLOC = (LAS float*)(L + S5_SLOC); LAS float* MS = (LAS float*)(L + S5_MISC);
    __syncthreads();
#pragma unroll
    for (int k = 0; k < 8; ++k) { const int idx = tid + 512 * k, t = idx >> 1, hf = idx & 1;
        const v4u v = *(const v4u*)(UA2 + (size_t)idx * 8);
        *(LAS v4u*)(L + S5_U + (t >> 6) * S5_USTR + (t & 63) * 32 + 16 * hf) = v; }
#pragma unroll
    for (int k = 0; k < 4; ++k) { const int idx = tid + 512 * k; *(LAS v4u*)(L + S5_KI + idx * 16) = *(const v4u*)(KI + (size_t)g * 16384 + idx * 8); }
    bf16x8 bfr[16];
#pragma unroll
    for (int k = 0; k < 16; ++k) { const int i = 2 * k + (kq >> 1); bfr[k] = *(const bf16x8*)(KS + ((size_t)(g * 64 + i) * 128 + 16 * w + fr) * 16 + 8 * (kq & 1)); }
    __syncthreads();
    { f32x4 acc0 = (f32x4){0.f, 0.f, 0.f, 0.f}, acc1 = acc0;
#pragma unroll
      for (int hb = 0; hb < 2; ++hb) {
          if (hb == 1) {
#pragma unroll
              for (int k = 0; k < 16; ++k) { const int i = 2 * (16 + k) + (kq >> 1); bfr[k] = *(const bf16x8*)(KS + ((size_t)(g * 64 + i) * 128 + 16 * w + fr) * 16 + 8 * (kq & 1)); } }
#pragma unroll
          for (int k = 0; k < 16; ++k) { const int ks = 16 * hb + k;
              const bf16x8 a0 = *(const LAS bf16x8*)(L + S5_U + fr * S5_USTR + (32 * ks + 8 * kq) * 2);
              const bf16x8 a1 = *(const LAS bf16x8*)(L + S5_U + (16 + fr) * S5_USTR + (32 * ks + 8 * kq) * 2);
              acc0 = mfma16(a0, bfr[k], acc0); acc1 = mfma16(a1, bfr[k], acc1); } }
#pragma unroll
      for (int r = 0; r < 4; ++r) { SLOC[(4 * kq + r) * 128 + 16 * w + fr] = acc0[r]; SLOC[(16 + 4 * kq + r) * 128 + 16 * w + fr] = acc1[r]; } }
    bf16x8 ko[4];
#pragma unroll
    for (int ks = 0; ks < 4; ++ks) ko[ks] = *(const bf16x8*)(KO + ((size_t)(g * 64 + w) * 16 + fr) * 128 + 32 * ks + 8 * kq);
    __syncthreads();
    if (w == 0) { const int p = lane; float sr[32], si[32];
#pragma unroll
        for (int c = 0; c < 32; ++c) { sr[c] = SLOC[c * 128 + p]; si[c] = SLOC[c * 128 + 64 + p]; }
        float xr = MS[p], xi = MS[64 + p]; const float ar = MS[128 + p], ai = MS[192 + p];
#pragma unroll
        for (int c = 0; c < 32; ++c) { *(LAS bf16*)(L + S5_XINB + c * S5_XSTR + p * 2) = (bf16)f2bf(xr); *(LAS bf16*)(L + S5_XINB + c * S5_XSTR + (64 + p) * 2) = (bf16)f2bf(xi);
            const float nr2 = ar * xr - ai * xi + sr[c], ni2 = ar * xi + ai * xr + si[c]; xr = nr2; xi = ni2; } }
    __syncthreads();
    for (int jj = 0; jj < 8; ++jj) { const int j = w + 8 * jj;
        bf16x8 kon[4];
#pragma unroll
        for (int ks = 0; ks < 4; ++ks) kon[ks] = ko[ks];
        if (jj < 7) {
#pragma unroll
            for (int ks = 0; ks < 4; ++ks) kon[ks] = *(const bf16x8*)(KO + ((size_t)(g * 64 + j + 8) * 16 + fr) * 128 + 32 * ks + 8 * kq); }
        f32x4 acc0 = (f32x4){0.f, 0.f, 0.f, 0.f}, acc1 = acc0;
#pragma unroll
        for (int ks = 0; ks < 4; ++ks) {
            const bf16x8 a0 = *(const LAS bf16x8*)(L + S5_XINB + fr * S5_XSTR + (32 * ks + 8 * kq) * 2);
            const bf16x8 a1 = *(const LAS bf16x8*)(L + S5_XINB + (16 + fr) * S5_XSTR + (32 * ks + 8 * kq) * 2);
            acc0 = mfma16(a0, ko[ks], acc0); acc1 = mfma16(a1, ko[ks], acc1); }
        const int nks = (j >> 1) + 1;
#pragma unroll 2
        for (int ks = 0; ks < nks; ++ks) { const int i = 2 * ks + (kq >> 1), tau = j - i;
            bf16x8 bq = *(const LAS bf16x8*)(L + S5_KI + (((tau < 0 ? 0 : tau) * 16 + fr) * 16 + 8 * (kq & 1)) * 2);
            if (tau < 0) bq = (bf16x8){0, 0, 0, 0, 0, 0, 0, 0};
            const bf16x8 a0 = *(const LAS bf16x8*)(L + S5_U + fr * S5_USTR + (32 * ks + 8 * kq) * 2);
            const bf16x8 a1 = *(const LAS bf16x8*)(L + S5_U + (16 + fr) * S5_USTR + (32 * ks + 8 * kq) * 2);
            acc0 = mfma16(a0, bq, acc0); acc1 = mfma16(a1, bq, acc1); }
#pragma unroll
        for (int r = 0; r < 4; ++r) { const int c0 = 4 * kq + r, c1 = 16 + 4 * kq + r;
            YA[(size_t)(b * 2048 + 64 * c0 + j) * 512 + 16 * g + fr] = (bf16)f2bf(gelu_tanh(acc0[r]));
            YA[(size_t)(b * 2048 + 64 * c1 + j) * 512 + 16 * g + fr] = (bf16)f2bf(gelu_tanh(acc1[r])); }
#pragma unroll
        for (int ks = 0; ks < 4; ++ks) ko[ks] = kon[ks]; }
}

constexpr int DS_SSTR = 2120, DS_TSTR = 144, DS_BUF = 18432  , DS_BT = 36864  , DS_HIST = 135680, DS_MASK = 143872, DS_RB = 152576, DS_TB = 153600;
typedef short s16x4 __attribute__((ext_vector_type(4)));
__device__ __forceinline__ s16x4 tr_read(unsigned addr) { s16x4 r; asm volatile("ds_read_b64_tr_b16 %0, %1" : "=&v"(r) : "v"(addr) : "memory"); return r; }
__device__ __forceinline__ float relu_i(float x) { const int i = __builtin_bit_cast(int, x); return __builtin_bit_cast(float, i > 0 ? i : 0); }
__device__ __forceinline__ unsigned f16key(float f) { const _Float16 hf = (_Float16)f; const unsigned h = (unsigned)__builtin_bit_cast(unsigned short, hf); return (h & 0x8000u) ? (~h & 0xffffu) : (h | 0x8000u); }
__device__ __forceinline__ unsigned cvtpk(float lo, float hi) { unsigned r; asm volatile("v_cvt_pk_bf16_f32 %0, %1, %2" : "=v"(r) : "v"(lo), "v"(hi)); return r; }
__device__ __forceinline__ void dsa_tables(const Args& a, LAS unsigned char* L, int tid) {
    if (tid < 256) { ((LAS float*)(L + DS_RB))[tid] = a.in[25][tid] * 1.44269504f;
        const int n = tid; const int lo = n < 8 ? n : (n < 12 ? 8 : n < 16 ? 9 : n < 23 ? 10 : n < 32 ? 11 : n < 46 ? 12 : n < 64 ? 13 : n < 91 ? 14 : 15);
        ((LAS int*)(L + DS_TB))[tid] = lo; }
}

__device__ __forceinline__ int wave_incl_scan(int x) {
    int v = x;
    v += __builtin_amdgcn_update_dpp(0, v, 0x111, 0xf, 0xf, false);
    v += __builtin_amdgcn_update_dpp(0, v, 0x112, 0xf, 0xf, false);
    v += __builtin_amdgcn_update_dpp(0, v, 0x114, 0xf, 0xf, false);
    v += __builtin_amdgcn_update_dpp(0, v, 0x118, 0xf, 0xf, false);
    v += __builtin_amdgcn_update_dpp(0, v, 0x142, 0xa, 0xf, false);
    v += __builtin_amdgcn_update_dpp(0, v, 0x143, 0xc, 0xf, false);
    return v;
}
template <int NE>
__device__ __forceinline__ void dsa_select(LAS unsigned char* L, int c, int nt64, int w, int lane) {
    LAS unsigned short* S16 = (LAS unsigned short*)L; LAS unsigned long long* MASK = (LAS unsigned long long*)(L + DS_MASK);
    LAS unsigned* H = (LAS unsigned*)(L + DS_HIST) + w * 256;
    const int rl = 63 - lane;
    for (int qq = 0; qq < 4; ++qq) { const int q = 4 * w + qq; const LAS unsigned short* Sq = S16 + q * DS_SSTR; unsigned tkey = 0u;
        unsigned kr[NE];
#pragma unroll
        for (int e = 0; e < NE; ++e) kr[e] = (unsigned)Sq[64 * e + lane];
        if (c >= 4) { unsigned prefix = 0u; int kth = 256;
#pragma unroll
            for (int pass = 0; pass < 2; ++pass) {
                H[lane] = 0u; H[lane + 64] = 0u; H[lane + 128] = 0u; H[lane + 192] = 0u; LDS_WAIT();
#pragma unroll
                for (int e = 0; e < NE; ++e) { const unsigned key = kr[e]; const bool in = (pass == 0) ? (key != 0u) : ((key >> 8) == prefix);
                    if (in) (void)__hip_atomic_fetch_add(&H[pass == 0 ? (key >> 8) : (key & 255u)], 1u, __ATOMIC_RELAXED, __HIP_MEMORY_SCOPE_WORKGROUP); }
                LDS_WAIT();
                const unsigned h0 = H[4 * rl], h1 = H[4 * rl + 1], h2 = H[4 * rl + 2], h3 = H[4 * rl + 3]; const int t = (int)(h0 + h1 + h2 + h3);
                const int sfx = wave_incl_scan(t), above = sfx - t; const bool has = (above < kth) && (above + t >= kth);
                const unsigned long long bm = __ballot(has); const int src = bm ? (__ffsll((long long)bm) - 1) : 0;
                int cum = above, B; if (cum + (int)h3 >= kth) B = 3; else { cum += (int)h3; if (cum + (int)h2 >= kth) B = 2; else { cum += (int)h2; if (cum + (int)h1 >= kth) B = 1; else { cum += (int)h1; B = 0; } } }
                const int bin = __builtin_amdgcn_readlane(4 * rl + B, src); kth = __builtin_amdgcn_readlane(kth - cum, src);
                prefix = (prefix << 8) | (unsigned)bin; LDS_WAIT(); }
            tkey = prefix; }
        unsigned mlo = 0u, mhi = 0u;
#pragma unroll
        for (int e = 0; e < NE; ++e) { const int s = 64 * e + lane; const bool sel = ((s < 16) || (s >= 64)) && (kr[e] >= tkey);
            const unsigned long long m = __ballot(sel); mlo = (lane == e) ? (unsigned)m : mlo; mhi = (lane == e) ? (unsigned)(m >> 32) : mhi; }
        if (lane < nt64) MASK[q * 34 + lane] = ((unsigned long long)mhi << 32) | mlo; }
}
__device__ __forceinline__ void dsa_unit(const Args& a, LAS unsigned char* L, int b, int uq, int tid) {
    const int lane = tid & 63, w = __builtin_amdgcn_readfirstlane(tid >> 6), fr = lane & 15, kq = lane >> 4;
    const bf16* PA = (const bf16*)(a.ws + WS_PA); const bf16* PK = (const bf16*)(a.ws + WS_PK); const bf16* PMK = (const bf16*)(a.ws + WS_META + MO_PMK);
    bf16* YB = (bf16*)(a.ws + WS_HN) + (size_t)R * 512;
    const int c = 1 + (uq >> 1), nt64 = c + 1, qrow0 = b * 2048 + 32 * uq;
    LAS unsigned short* S16 = (LAS unsigned short*)L; LAS unsigned long long* MASK = (LAS unsigned long long*)(L + DS_MASK);
    const LAS float* RB = (const LAS float*)(L + DS_RB); const LAS int* TB = (const LAS int*)(L + DS_TB);
    __syncthreads();
    { const int qh = w >> 2; bf16x8 qa[4][2][2]; float wv[4][2][4];
#pragma unroll
      for (int p = 0; p < 4; ++p) {
#pragma unroll
          for (int hf = 0; hf < 2; ++hf)
#pragma unroll
              for (int ks = 0; ks < 2; ++ks) qa[p][hf][ks] = *(const bf16x8*)(PA + (size_t)(qrow0 + 16 * qh + 4 * p + (fr >> 2)) * 1024 + (4 * hf + (fr & 3)) * 64 + 32 * ks + 8 * kq);
          const v4u wraw = *(const v4u*)(PK + (size_t)(qrow0 + 16 * qh + 4 * p + kq) * 256 + 192);
          wv[p][0][0] = bflo(wraw.x) * 0.04419417382f; wv[p][0][1] = bfhi(wraw.x) * 0.04419417382f; wv[p][0][2] = bflo(wraw.y) * 0.04419417382f; wv[p][0][3] = bfhi(wraw.y) * 0.04419417382f;
          wv[p][1][0] = bflo(wraw.z) * 0.04419417382f; wv[p][1][1] = bfhi(wraw.z) * 0.04419417382f; wv[p][1][2] = bflo(wraw.w) * 0.04419417382f; wv[p][1][3] = bfhi(wraw.w) * 0.04419417382f; }
      const int nkt = 4 * nt64;
      { const int ner = nt64 <= 9 ? 9 : nt64 <= 17 ? 17 : nt64 <= 25 ? 25 : 33;
        for (int kz = 4 * nt64 + (w & 3); kz < 4 * ner; kz += 4) {
#pragma unroll
            for (int p = 0; p < 4; ++p) S16[(16 * qh + 4 * p + kq) * DS_SSTR + 16 * kz + fr] = (unsigned short)0; } }
      if ((w & 3) != 0) {
#pragma unroll
          for (int p = 0; p < 4; ++p) S16[(16 * qh + 4 * p + kq) * DS_SSTR + 16 * (w & 3) + fr] = (unsigned short)0; }
      int kt = (w & 3) == 0 ? 0 : (w & 3) + 4;
      bf16x8 kb0, kb1, kc0, kc1;
      { const bf16* krow = (kt == 0) ? PMK + fr * 256 : PK + (size_t)(b * 2048 + 16 * kt - 64 + fr) * 256; kb0 = *(const bf16x8*)(krow + 8 * kq); kb1 = *(const bf16x8*)(krow + 32 + 8 * kq); }
      { const int k1 = (kt == 0) ? 4 : kt + 4; kc0 = kb0; kc1 = kb1;
        if (k1 < nkt) { const bf16* krow = PK + (size_t)(b * 2048 + 16 * k1 - 64 + fr) * 256; kc0 = *(const bf16x8*)(krow + 8 * kq); kc1 = *(const bf16x8*)(krow + 32 + 8 * kq); } }
      while (kt < nkt) {
          const int ktn = (kt == 0) ? 4 : kt + 4, ktnn = ktn + 4; bf16x8 nb0 = kc0, nb1 = kc1;
          if (ktnn < nkt) { const bf16* krow = PK + (size_t)(b * 2048 + 16 * ktnn - 64 + fr) * 256; nb0 = *(const bf16x8*)(krow + 8 * kq); nb1 = *(const bf16x8*)(krow + 32 + 8 * kq); }
#pragma unroll
          for (int p = 0; p < 4; ++p) { f32x4 aA = (f32x4){0.f, 0.f, 0.f, 0.f}, aB = aA;
              aA = mfma16(qa[p][0][0], kb0, aA); aB = mfma16(qa[p][1][0], kb0, aB); aA = mfma16(qa[p][0][1], kb1, aA); aB = mfma16(qa[p][1][1], kb1, aB);
              const float v = (relu_i(aA[0]) * wv[p][0][0] + relu_i(aA[1]) * wv[p][0][1]) + (relu_i(aA[2]) * wv[p][0][2] + relu_i(aA[3]) * wv[p][0][3])
                            + (relu_i(aB[0]) * wv[p][1][0] + relu_i(aB[1]) * wv[p][1][1]) + (relu_i(aB[2]) * wv[p][1][2] + relu_i(aB[3]) * wv[p][1][3]);
              S16[(16 * qh + 4 * p + kq) * DS_SSTR + 16 * kt + fr] = (unsigned short)f16key(v); }
          kb0 = kc0; kb1 = kc1; kc0 = nb0; kc1 = nb1; kt = ktn; } }
    __syncthreads();
    bf16x8 qb[2][2]; unsigned mkoff[2];
#pragma unroll
    for (int cg = 0; cg < 2; ++cg) { const int q = 4 * w + 2 * cg + (fr >> 3), h = fr & 7; mkoff[cg] = q * 34;
#pragma unroll
        for (int ks = 0; ks < 2; ++ks) qb[cg][ks] = *(const bf16x8*)(PA + (size_t)(qrow0 + q) * 1024 + 512 + h * 64 + 32 * ks + 8 * kq); }
    const int skey = tid >> 3, spiece = tid & 7;
    v4u kv0 = (v4u){0u, 0u, 0u, 0u}, vv0 = kv0, kv, vv;
    if (skey < 16) { const bf16* krow = PMK + skey * 256; kv0 = *(const v4u*)(krow + 64 + 8 * spiece); vv0 = *(const v4u*)(krow + 128 + 8 * spiece); }
    { const bf16* krow = PK + (size_t)(b * 2048 + skey) * 256; kv = *(const v4u*)(krow + 64 + 8 * spiece); vv = *(const v4u*)(krow + 128 + 8 * spiece); }
    if (nt64 <= 9) dsa_select<9>(L, c, nt64, w, lane);
    else if (nt64 <= 17) dsa_select<17>(L, c, nt64, w, lane);
    else if (nt64 <= 25) dsa_select<25>(L, c, nt64, w, lane);
    else dsa_select<33>(L, c, nt64, w, lane);
    __syncthreads();
    {
      const int hh = fr & 7; const float bfar = RB[15 * 8 + hh];
      float mrun[2] = {0.f, 0.f}, lrun[2] = {0.f, 0.f}; f32x4 O[2][4];
#pragma unroll
      for (int cg = 0; cg < 2; ++cg)
#pragma unroll
          for (int dt = 0; dt < 4; ++dt) O[cg][dt] = (f32x4){0.f, 0.f, 0.f, 0.f};
      const LAS float* BT = (const LAS float*)(L + DS_BT);
#pragma unroll
      for (int k = 0; k < 4; ++k) { const int e = tid + 512 * k, relc = (e >> 3) - 128, n = relc < 0 ? -relc : relc; ((LAS float*)(L + DS_BT))[e] = RB[(TB[n] + (relc > 0 ? 16 : 0)) * 8 + (e & 7)]; }
      const unsigned ldsV = (unsigned)(size_t)(L) + 9216u + (unsigned)((4 * kq + ((lane & 15) >> 2)) * DS_TSTR + 8 * (lane & 3));
      *(LAS v4u*)(L + skey * DS_TSTR + 16 * spiece) = kv0; *(LAS v4u*)(L + 9216 + skey * DS_TSTR + 16 * spiece) = vv0;
      __syncthreads();
      for (int T = 0; T < nt64; ++T) { const int buf = T & 1;
          v4u kn = kv, vn = vv;
          if (T + 2 < nt64) { const bf16* krow = PK + (size_t)(b * 2048 + 64 * (T + 1) + skey) * 256; kn = *(const v4u*)(krow + 64 + 8 * spiece); vn = *(const v4u*)(krow + 128 + 8 * spiece); }
          const bool nearT = (64 * T > 32 * uq - 90);
          f32x4 lg[2][4];
          { bf16x8 ka[4][2];
#pragma unroll
            for (int sub = 0; sub < 4; ++sub)
#pragma unroll
                for (int ks = 0; ks < 2; ++ks) ka[sub][ks] = *(const LAS bf16x8*)(L + buf * DS_BUF + fr * DS_TSTR + 16 * kq + sub * 16 * DS_TSTR + ks * 64);
#pragma unroll
            for (int cg = 0; cg < 2; ++cg)
#pragma unroll
                for (int sub = 0; sub < 4; ++sub) { f32x4 acc = (f32x4){0.f, 0.f, 0.f, 0.f}; acc = mfma16(ka[sub][0], qb[cg][0], acc); acc = mfma16(ka[sub][1], qb[cg][1], acc); lg[cg][sub] = acc; } }
          s16x4 vt[2][4][2];
#pragma unroll
          for (int cg = 0; cg < 2; ++cg) {
              const float mc = mrun[cg]; float mxl = -1.0e30f;
              if (nearT) { const int relb = ((T == 0) ? 0 : 64 * T - 48) + 4 * kq - (16 + 32 * uq + 4 * w + 2 * cg + (fr >> 3));
#pragma unroll
                  for (int sub = 0; sub < 4; ++sub)
#pragma unroll
                      for (int r = 0; r < 4; ++r) { int idx = relb + 16 * sub + r; idx = idx < -128 ? -128 : idx; idx = idx > 127 ? 127 : idx;
                          const float v = lg[cg][sub][r] * 0.18033688f + (BT[(idx + 128) * 8 + hh] - mc); lg[cg][sub][r] = v; mxl = fmaxf(mxl, v); }
              } else { const float bm = bfar - mc;
#pragma unroll
                  for (int sub = 0; sub < 4; ++sub)
#pragma unroll
                      for (int r = 0; r < 4; ++r) { const float v = lg[cg][sub][r] * 0.18033688f + bm; lg[cg][sub][r] = v; mxl = fmaxf(mxl, v); } }
              if (T == 0 || __ballot(mxl > 8.0f) != 0ull) {
                  float mx = mxl; mx = fmaxf(mx, __shfl_xor(mx, 16)); mx = fmaxf(mx, __shfl_xor(mx, 32));
                  const float delta = (T == 0) ? mx : fmaxf(mx, 0.f), sc = __builtin_amdgcn_exp2f(-delta); mrun[cg] = mc + delta; lrun[cg] *= sc;
#pragma unroll
                  for (int dt = 0; dt < 4; ++dt) O[cg][dt] = O[cg][dt] * sc;
#pragma unroll
                  for (int sub = 0; sub < 4; ++sub)
#pragma unroll
                      for (int r = 0; r < 4; ++r) lg[cg][sub][r] -= delta; }
              const unsigned long long mword = MASK[mkoff[cg] + T] >> (4 * kq); const unsigned mlo = (unsigned)mword, mhi = (unsigned)(mword >> 32); float ls = 0.f;
#pragma unroll
              for (int sub = 0; sub < 4; ++sub)
#pragma unroll
                  for (int r = 0; r < 4; ++r) { const int keep = __builtin_amdgcn_sbfe((int)(sub < 2 ? mlo : mhi), 16 * (sub & 1) + r, 1);
                      const float p = __uint_as_float(__float_as_uint(__builtin_amdgcn_exp2f(lg[cg][sub][r])) & (unsigned)keep); ls += p; lg[cg][sub][r] = p; }
              lrun[cg] += ls; }
          { const unsigned vaddr = ldsV + (unsigned)(buf * DS_BUF);
            asm volatile("ds_read_b64_tr_b16 %0, %16 offset:0\n\t"
                "ds_read_b64_tr_b16 %1, %16 offset:2304\n\t"
                "ds_read_b64_tr_b16 %2, %16 offset:32\n\t"
                "ds_read_b64_tr_b16 %3, %16 offset:2336\n\t"
                "ds_read_b64_tr_b16 %4, %16 offset:64\n\t"
                "ds_read_b64_tr_b16 %5, %16 offset:2368\n\t"
                "ds_read_b64_tr_b16 %6, %16 offset:96\n\t"
                "ds_read_b64_tr_b16 %7, %16 offset:2400\n\t"
                "ds_read_b64_tr_b16 %8, %16 offset:4608\n\t"
                "ds_read_b64_tr_b16 %9, %16 offset:6912\n\t"
                "ds_read_b64_tr_b16 %10, %16 offset:4640\n\t"
                "ds_read_b64_tr_b16 %11, %16 offset:6944\n\t"
                "ds_read_b64_tr_b16 %12, %16 offset:4672\n\t"
                "ds_read_b64_tr_b16 %13, %16 offset:6976\n\t"
                "ds_read_b64_tr_b16 %14, %16 offset:4704\n\t"
                "ds_read_b64_tr_b16 %15, %16 offset:7008\n\t"
                "s_waitcnt lgkmcnt(0)"
                : "=&v"(vt[0][0][0]), "=&v"(vt[0][0][1]), "=&v"(vt[0][1][0]), "=&v"(vt[0][1][1]), "=&v"(vt[0][2][0]), "=&v"(vt[0][2][1]), "=&v"(vt[0][3][0]), "=&v"(vt[0][3][1]), "=&v"(vt[1][0][0]), "=&v"(vt[1][0][1]), "=&v"(vt[1][1][0]), "=&v"(vt[1][1][1]), "=&v"(vt[1][2][0]), "=&v"(vt[1][2][1]), "=&v"(vt[1][3][0]), "=&v"(vt[1][3][1])
                : "v"(vaddr) : "memory"); }
#pragma unroll
          for (int ks2 = 0; ks2 < 2; ++ks2) { bf16x8 pb[2];
#pragma unroll
              for (int cg = 0; cg < 2; ++cg) { v4u pw; pw.x = cvtpk(lg[cg][2 * ks2][0], lg[cg][2 * ks2][1]); pw.y = cvtpk(lg[cg][2 * ks2][2], lg[cg][2 * ks2][3]);
                  pw.z = cvtpk(lg[cg][2 * ks2 + 1][0], lg[cg][2 * ks2 + 1][1]); pw.w = cvtpk(lg[cg][2 * ks2 + 1][2], lg[cg][2 * ks2 + 1][3]); pb[cg] = __builtin_bit_cast(bf16x8, pw); }
#pragma unroll
              for (int dt = 0; dt < 4; ++dt) { const bf16x8 va = __builtin_shufflevector(vt[ks2][dt][0], vt[ks2][dt][1], 0, 1, 2, 3, 4, 5, 6, 7);
#pragma unroll
                  for (int cg = 0; cg < 2; ++cg) O[cg][dt] = mfma16(va, pb[cg], O[cg][dt]); } }
          if (T + 1 < nt64) { *(LAS v4u*)(L + (buf ^ 1) * DS_BUF + skey * DS_TSTR + 16 * spiece) = kv; *(LAS v4u*)(L + (buf ^ 1) * DS_BUF + 9216 + skey * DS_TSTR + 16 * spiece) = vv; }
          kv = kn; vv = vn;
          __syncthreads();
      }
#pragma unroll
      for (int cg = 0; cg < 2; ++cg) { float v = lrun[cg]; v += __shfl_xor(v, 16); v += __shfl_xor(v, 32); const float inv = 1.0f / v;
          const int q = 4 * w + 2 * cg + (fr >> 3);
#pragma unroll
          for (int dt = 0; dt < 4; ++dt) { v2u o; o.x = cvtpk(O[cg][dt][0] * inv, O[cg][dt][1] * inv); o.y = cvtpk(O[cg][dt][2] * inv, O[cg][dt][3] * inv);
              *(v2u*)(YB + (size_t)(qrow0 + q) * 512 + hh * 64 + 16 * dt + 4 * kq) = o; } } }
}

__global__ void __launch_bounds__(NWAVES * 64, 2) mk_fwd(Args args) {
    extern __shared__ __attribute__((aligned(16))) unsigned char lds[];
    LAS unsigned char* L = (LAS unsigned char*)lds;
    volatile LAS unsigned* MISC = (volatile LAS unsigned*)(L + MISC_OFF);
    const int tid = threadIdx.x, lane = tid & 63, wave = __builtin_amdgcn_readfirstlane(tid >> 6);
    const int G = gridDim.x, bx = blockIdx.x;
    const int gw = bx * NWAVES + wave, NGW = G * NWAVES;
    unsigned char* ws = args.ws;
    if (tid < 32) MISC[tid] = 0u;
    __syncthreads();
    XcdBarrier bar; bar.bar = (unsigned*)(ws + WS_CTL) + CW_BAR; bar.x = 0; bar.st = nullptr;
    if (!MK_PER_PHASE) bar = xcd_barrier_post((unsigned*)(ws + WS_CTL) + CW_BAR, MISC + 8);
    const int lo = args.ph_lo, hi = args.ph_hi;
#define IN(k) (lo <= (k) && (k) < hi)
#define SEAM(k) do { if (IN(k) && IN((k) + 1)) xcd_barrier(bar); } while (0)
    bf16* WT1 = (bf16*)(ws + WS_WT1); bf16* WT2 = (bf16*)(ws + WS_WT2); bf16* WT3 = (bf16*)(ws + WS_WT3); bf16* WT4 = (bf16*)(ws + WS_WT4); bf16* WT5 = (bf16*)(ws + WS_WT5);
    bf16* WGLU = (bf16*)(ws + WS_WGLU); bf16* WA = (bf16*)(ws + WS_WA); bf16* WB = (bf16*)(ws + WS_WB); bf16* WOUT = (bf16*)(ws + WS_WOUT);
    bf16* HN = (bf16*)(ws + WS_HN); bf16* FB = (bf16*)(ws + WS_F); bf16* ACT = (bf16*)(ws + WS_BIG);
    bf16* PA = (bf16*)(ws + WS_PA); bf16* PG = (bf16*)(ws + WS_PG); bf16* PK = (bf16*)(ws + WS_PK);
    bf16* AM1 = (bf16*)(ws + WS_META + MO_AM1); bf16* ACTM = (bf16*)(ws + WS_META + MO_ACTM); bf16* FM = (bf16*)(ws + WS_META + MO_FM); bf16* AM2 = (bf16*)(ws + WS_META + MO_AM2);
    bf16* PMU = (bf16*)(ws + WS_META + MO_PMU); bf16* PMK = (bf16*)(ws + WS_META + MO_PMK);
    bf16* HB = (bf16*)(ws + WS_HB); float* RS1 = (float*)(ws + WS_META + 524288); float* RS2 = (float*)(ws + WS_META + 655360);
    bf16* YA = FB; bf16* YG = HN; bf16* YB = HN + (size_t)R * 512; bf16* MERGED = PA;
    const float* x = args.in[0]; float* out = args.out;

    if (IN(0)) {
        for (int item = bx; item < 256; item += G) s5_tables_block(args, item >> 3, item & 7, (LAS float*)L, tid);
        __syncthreads();
        LAS float* scr = (LAS float*)(L + wave * 16384);
        for (int it = gw; it < 11520; it += NGW) {
            int r = it;
            if (r < 6 * 1408) { const int mat = r / 1408; r -= mat * 1408;
                if (mat == 5) { const int kb = r / 32, nb = r % 32; transpose_item8(args.in[13], D, DFF, (unsigned char*)WT5, 64 * kb, 32 * nb, 32 * nb + (lane & 31), scr, lane); }
                else if (mat == 2) { const int kb = r / 32, nb = r % 32; transpose_item(args.in[10], D, DFF, WT2, 64 * kb, 32 * nb, 32 * nb + (lane & 31), scr, lane);
                    transpose_item8(args.in[10], D, DFF, (unsigned char*)(ws + WS_WT2Q), 64 * kb, 32 * nb, 32 * nb + (lane & 31), scr, lane); }
                else if (mat >= 3) { const int kb = r / 88, nb = r % 88, d0 = 32 * nb, up = (mat == 4) ? 128 : 0; transpose_item8(args.in[mat == 3 ? 11 : 12], DFF, D, (unsigned char*)WT4, 64 * kb, 256 * (d0 >> 7) + (d0 & 127) + up, d0 + (lane & 31), scr, lane); }
                else { const int kb = r / 88, nb = r % 88, d0 = 32 * nb, up = (mat == 1 || mat == 4) ? 128 : 0;
                    transpose_item(args.in[mat == 0 ? 8 : mat == 1 ? 9 : mat == 3 ? 11 : 12], DFF, D, mat < 3 ? WT1 : WT4, 64 * kb, 256 * (d0 >> 7) + (d0 & 127) + up, d0 + (lane & 31), scr, lane, args.in[2]); }
                continue; }
            r -= 6 * 1408;
            if (r < 896) { const int kb = r / 56, nb = r % 56; transpose_item(args.in[14], 3784, D, WT3, 64 * kb, 32 * nb, win_srccol(32 * nb + (lane & 31)), scr, lane, args.in[4]); continue; }
            r -= 896;
            if (r < 1024) { const int kb = r / 64, nb = r % 64; transpose_item8(args.in[14], 3784, D, (unsigned char*)(ws + WS_WT3B), 64 * kb, 32 * nb, 1736 + 32 * nb + (lane & 31), scr, lane, args.in[4]); continue; }
            r -= 1024;
            if (r < 128) { const int kb = r / 16, nb = r % 16; transpose_item(args.in[23], 512, 512, WGLU, 64 * kb, 32 * nb, 32 * nb + (lane & 31), scr, lane); continue; }
            r -= 128;
            if (r < 256) { const int kb = r / 32, nb = r % 32; transpose_item(args.in[24], D, 512, WA, 64 * kb, 32 * nb, 32 * nb + (lane & 31), scr, lane); continue; }
            r -= 256;
            if (r < 256) { const int kb = r / 32, nb = r % 32; transpose_item(args.in[26], D, 512, WB, 64 * kb, 32 * nb, 32 * nb + (lane & 31), scr, lane); continue; }
            r -= 256;
            { const int kb = r / 32, nb = r % 32; transpose_item(args.in[27], D, D, WOUT, 64 * kb, 32 * nb, 32 * nb + (lane & 31), scr, lane); }
        }
        for (int m = gw; m < R; m += NGW) x_row_to_bf16<false>(x + (size_t)m * D, HN + (size_t)m * D, RS1 + m, lane);
        if (gw < NMETA) x_row_to_bf16<true>(args.in[1] + (size_t)gw * D, AM1 + (size_t)gw * D, nullptr, lane);
    }
    SEAM(0);
    if (IN(1)) {
        if (bx < 176) { const int j0 = 16 * bx, grow = 256 * (j0 >> 7) + (j0 & 127); f32x4 g4, u4;
            meta_tile_blk<4>(AM1, WT1 + (size_t)grow * D, WT1 + (size_t)(grow + 128) * D, D, (LAS float*)L, wave, lane, g4, u4);
            if (wave == 0) {
#pragma unroll
                for (int r = 0; r < 4; ++r) ACTM[(4 * (lane >> 4) + r) * DFF + j0 + (lane & 15)] = (bf16)f2bf(g4[r] * fsig(g4[r]) * u4[r]); } }
        pg8::Gemm g{HN, WT1, R, 2 * DFF, D}; pg8::StaticOrder S; S.init(R, 2 * DFF, G, bx); pg8::EpiSwigluR8 E{(unsigned char*)ACT, DFF, RS1, 8.0f};
        pg8::gemm_phase<pg8::EpiSwigluR8, pg8::StaticOrder, PG8_ALIGN, PG8_SP2>(L, g, S, E);
    }
    SEAM(1);
    if (IN(2)) {
        if (bx < 64) { const int n0 = 16 * bx; f32x4 f4, dummy;
            meta_tile_blk<11>(ACTM, WT2 + (size_t)n0 * DFF, nullptr, DFF, (LAS float*)L, wave, lane, f4, dummy);
            if (wave == 0) {
#pragma unroll
                for (int r = 0; r < 4; ++r) FM[(4 * (lane >> 4) + r) * D + n0 + (lane & 15)] = (bf16)f2bf(f4[r]); } }
        pg8::Gemm g{ACT, (const bf16*)(ws + WS_WT2Q), R, D, DFF}; pg8::StaticOrder S; S.init(R, D, G, bx); pg8::EpiPlainS E{FB, D, 1.0f / 512.0f};
        pg8::gemm_phase<pg8::EpiPlainS, pg8::StaticOrder, PG8_ALIGN, PG8_SP2, true>(L, g, S, E);
    }
    SEAM(2);
    if (IN(3)) {
        if (gw < NMETA) row_update<false, false>(FM + (size_t)gw * D, args.in[1] + (size_t)gw * D, nullptr, AM2 + (size_t)gw * D, args.in[3], nullptr, 0.5f, lane);
        for (int m = gw; m < R; m += NGW) row_update<true, true>(FB + (size_t)m * D, HN + (size_t)m * D, HB + (size_t)m * D, nullptr, args.in[3], nullptr, 0.5f, lane, RS2 + m, (unsigned*)(ws + WS_HB8 + (size_t)m * D));
    }
    SEAM(3);
    if (IN(4)) {
        if (bx < 44) { const int n0 = bx < 32 ? 16 * bx : 1536 + 16 * (bx - 32); f32x4 p4, dummy;
            meta_tile_blk<4>(AM2, WT3 + (size_t)n0 * D, nullptr, D, (LAS float*)L, wave, lane, p4, dummy);
            if (wave == 0) {
#pragma unroll
                for (int r = 0; r < 4; ++r) { const int row = 4 * (lane >> 4) + r; if (bx < 32) PMU[row * 512 + n0 + (lane & 15)] = (bf16)f2bf(p4[r]); else PMK[row * 256 + (n0 - 1536) + (lane & 15)] = (bf16)f2bf(p4[r]); } } }
        { pg8::Gemm g{HB, WT3, R, 1792, D}; pg8::ProjOrderA S; S.base.init(R, 1536, G, bx); S.c = bx; pg8::EpiProj E{PA, PK, (bf16*)(ws + WS_UA2), RS2};
          pg8::gemm_phase<pg8::EpiProj, pg8::ProjOrderA, PG8_ALIGN, PG8_SP2>(L, g, S, E); }
        { pg8::Gemm g{(const bf16*)(ws + WS_HB8), (const bf16*)(ws + WS_WT3B), R, 2048, D}; pg8::ProjOrderB S{bx}; pg8::EpiGates8 E{PG, RS2};
          pg8::gemm_phase<pg8::EpiGates8, pg8::ProjOrderB, PG8_ALIGN, PG8_SP2, true>(L, g, S, E); }
    }
    SEAM(4);
    if (IN(5)) {
        { const int v0 = 2 * (bx >> 3), gS = 4 * (bx & 7) + (v0 >> 4);
          s5_meta(args, L, gS, tid);
          for (int rep = 0; rep < REP_S5; ++rep) for (int i = 0; i < 2; ++i) s5_unit(args, L, (v0 + i) & 15, gS, tid); }
        __syncthreads();
        dsa_tables(args, L, tid);
        for (int i = 0; i < 4 * REP_DSA; ++i) { const int up = 4 * (bx >> 3) + (i & 3), u2 = up >> 1, b = 2 * (bx & 7) + (u2 >> 5), xq = u2 & 31; dsa_unit(args, L, b, (up & 1) ? 63 - xq : xq, tid); }
        __syncthreads();
    }
    SEAM(5);
    if (IN(6)) { pg8::Gemm g{YA, WGLU, R, 512, 512}; pg8::StaticOrder S; S.init(R, 512, G, bx); pg8::EpiGlu E{YA, YG};
        pg8::gemm_phase<pg8::EpiGlu, pg8::StaticOrder, PG8_ALIGN, PG8_SP2>(L, g, S, E); }
    SEAM(6);
    if (IN(7)) { pg8::Gemm g{YG, WA, 2 * R, 2048, 512}; pg8::MergeOrder S; S.base.init(R, D, G, bx); pg8::EpiMerge2 E{PG, FB, MERGED};
        pg8::gemm_phase<pg8::EpiMerge2, pg8::MergeOrder, PG8_ALIGN, PG8_SP2>(L, g, S, E); }
    if (IN(7) && IN(9)) xcd_barrier(bar);
    if (IN(9)) { pg8::Gemm g{MERGED, WOUT, R, D, D}; pg8::StaticOrder S; S.init(R, D, G, bx); pg8::EpiPlain E{FB, D};
        pg8::gemm_phase<pg8::EpiPlain, pg8::StaticOrder, PG8_ALIGN, PG8_SP2>(L, g, S, E); }
    SEAM(9);
    if (IN(10)) { for (int m = gw; m < R; m += NGW) row_update<true, true, true>(FB + (size_t)m * D, HB + (size_t)m * D, HB + (size_t)m * D, (bf16*)((unsigned char*)HN + (size_t)m * D), args.in[5], args.in[6], 1.0f, lane); }
    SEAM(10);
    if (IN(11)) { pg8::Gemm g{HN, WT4, R, 2 * DFF, D}; pg8::StaticOrder S; S.init(R, 2 * DFF, G, bx); pg8::EpiSwiglu8 E{(unsigned char*)ACT, DFF, 1.0f / 256.0f, 8.0f};
        pg8::gemm_phase<pg8::EpiSwiglu8, pg8::StaticOrder, PG8_ALIGN, PG8_SP2, true>(L, g, S, E); }
    SEAM(11);
    if (IN(12)) { pg8::Gemm g{ACT, WT5, R, D, DFF}; pg8::StaticOrder S; S.init(R, D, G, bx); pg8::EpiPlainS E{FB, D, 1.0f / 512.0f};
        pg8::gemm_phase<pg8::EpiPlainS, pg8::StaticOrder, PG8_ALIGN, PG8_SP2, true>(L, g, S, E); }
    SEAM(12);
    if (IN(13)) { for (int m = gw; m < R; m += NGW) row_update<true, false>(FB + (size_t)m * D, HB + (size_t)m * D, out + (size_t)m * D, nullptr, args.in[7], args.in[7], 0.5f, lane); }
#undef IN
#undef SEAM
}

extern "C" void kernel_launch(void* const* d_in, const int* in_sizes, int n_in, void* d_out, int out_size, void* d_ws, size_t ws_size, hipStream_t stream) {
    static int grid = 0;
    if (grid == 0) {
        if (n_in != 28 || out_size != R * D || ws_size < WS_END) { fprintf(stderr, "kernel_launch: unexpected shapes (n_in %d, out %d, ws %zu); nothing launched\n", n_in, out_size, ws_size); grid = -1; return; }
        int dev = 0, cus = 0, per_cu = 0;
        if (hipGetDevice(&dev) != hipSuccess || hipDeviceGetAttribute(&cus, hipDeviceAttributeMultiprocessorCount, dev) != hipSuccess) { grid = -1; return; }
        if (hipFuncSetAttribute((const void*)mk_fwd, hipFuncAttributeMaxDynamicSharedMemorySize, LDS_BYTES) != hipSuccess) { fprintf(stderr, "kernel_launch: hipFuncSetAttribute failed\n"); grid = -1; return; }
        if (hipOccupancyMaxActiveBlocksPerMultiprocessor(&per_cu, (const void*)mk_fwd, NWAVES * 64, LDS_BYTES) != hipSuccess || per_cu < 1) fprintf(stderr, "kernel_launch: note: occupancy query reports %d\n", per_cu);
        (void)hipGetLastError();
        grid = cus;
    }
    if (grid < 0) return;
    if (hipMemsetAsync((char*)d_ws + WS_CTL, 0, CTL_ZERO_BYTES, stream) != hipSuccess) return;
    Args a{};
    for (int i = 0; i < 28; ++i) a.in[i] = (const float*)d_in[i];
    a.out = (float*)d_out; a.ws = (unsigned char*)d_ws;
#if MK_PER_PHASE
    for (int ph = 0; ph < NPH; ++ph) { a.ph_lo = ph; a.ph_hi = ph + 1; hipLaunchKernelGGL(mk_fwd, dim3(grid), dim3(NWAVES * 64), LDS_BYTES, stream, a); }
#else
    a.ph_lo = 0; a.ph_hi = NPH;
    hipLaunchKernelGGL(mk_fwd, dim3(grid), dim3(NWAVES * 64), LDS_BYTES, stream, a);
#endif
}
```

```cpp
#include <hip/hip_runtime.h>
#include <cstdio>
#include <cstdint>
namespace pg8 {
#define PG8_LAS __attribute__((address_space(3)))
typedef unsigned short bf16_t;
typedef short bf16x8 __attribute__((ext_vector_type(8)));
typedef float f32x4 __attribute__((ext_vector_type(4)));
typedef unsigned u32x4 __attribute__((ext_vector_type(4)));
constexpr int BM = 256, BK = 64, HALF = 128, HTB = HALF * BK * 2  , STAGE_BYTES = 8 * HTB, NXCD = 8, WGM = 8;

__host__ __device__ __forceinline__ int lds_byte(int r, int c) { const int st = (r >> 4) * 2 + (c >> 5), rr = r & 15, cc = c & 31, ob = rr * 64 + cc * 2; return st * 1024 + (ob ^ (((ob >> 9) & 1) << 5)); }
__host__ __device__ __forceinline__ void stage_rc(int b, int& R, int& C) { const int st = b / 1024, sb = b % 1024, swz = sb ^ (((sb >> 9) & 1) << 5); R = (st >> 1) * 16 + swz / 64; C = (st & 1) * 32 + (swz % 64) / 2; }
__host__ __device__ __forceinline__ int perm32(int rho) { const int n = rho >> 4, i = rho & 15; return 8 * (i >> 2) + 4 * n + (i & 3); }

struct Unit { int pm, pn; };
struct Gemm { const bf16_t* A; const bf16_t* Bt; int M, N, K; };

struct StaticOrder {
    int nM, nN, nwg, G, c;
    __host__ __device__ void init(int M, int N, int G_, int c_) { nM = M / BM; nN = N / BM; nwg = nM * nN; G = G_; c = c_; }
    __host__ __device__ bool next(int i, Unit& u) const {
        const long L = (long)i * G + c; if (L >= nwg) return false;
        int wgid = (int)L; { const int q = nwg / NXCD, r = nwg % NXCD, xcd = wgid % NXCD, off = wgid / NXCD; wgid = (xcd < r ? xcd * (q + 1) : r * (q + 1) + (xcd - r) * q) + off; }
        const int nig = WGM * nN, gid = wgid / nig, fm = gid * WGM, gsz = (nM - fm) < WGM ? (nM - fm) : WGM;
        u.pm = fm + ((wgid % nig) % gsz); u.pn = (wgid % nig) / gsz; return true;
    }
    __device__ __forceinline__ void a_ready(const Unit&) const {}
    __device__ __forceinline__ void done(const Unit&) const {}
};
__device__ __forceinline__ unsigned cvt_pk_bf16(float lo, float hi) { unsigned r; asm volatile("v_cvt_pk_bf16_f32 %0, %1, %2" : "=v"(r) : "v"(lo), "v"(hi)); return r; }
__device__ __forceinline__ float fsigmoid(float x) { return __builtin_amdgcn_rcpf(1.0f + __expf(-x)); }
__device__ __forceinline__ float bf_lo(unsigned w) { return __uint_as_float(w << 16); }
__device__ __forceinline__ float bf_hi(unsigned w) { return __uint_as_float(w & 0xffff0000u); }
__device__ __forceinline__ u32x4 pack8(const f32x4 v0, const f32x4 v1) { u32x4 w; w.x = cvt_pk_bf16(v0[0], v0[1]); w.y = cvt_pk_bf16(v0[2], v0[3]); w.z = cvt_pk_bf16(v1[0], v1[1]); w.w = cvt_pk_bf16(v1[2], v1[3]); return w; }
__device__ __forceinline__ void unpack8(const u32x4 w, f32x4& v0, f32x4& v1) { v0 = (f32x4){bf_lo(w.x), bf_hi(w.x), bf_lo(w.y), bf_hi(w.y)}; v1 = (f32x4){bf_lo(w.z), bf_hi(w.z), bf_lo(w.w), bf_hi(w.w)}; }

struct EpiSwiglu {
    static constexpr bool PERM = true, AFTER_DRAIN = false;
    bf16_t* O; int ldc; const float* rs;
    __device__ __forceinline__ void operator()(const f32x4 (&acc)[2][2][4][2], const Unit& u, int wr, int wc, int fr, int fq) const {
        const int row0 = u.pm * BM + wr * 64 + fr, col0 = u.pn * HALF + wc * 32 + 8 * fq;
#pragma unroll
        for (int ai = 0; ai < 2; ++ai)
#pragma unroll
            for (int m = 0; m < 4; ++m) { bf16_t* rowp = O + (size_t)(row0 + ai * HALF + m * 16) * ldc + col0; const float rsc = rs[row0 + ai * HALF + m * 16];
                f32x4 v0, v1;
#pragma unroll
                for (int j = 0; j < 4; ++j) { const float g0 = acc[ai][0][m][0][j] * rsc, g1 = acc[ai][0][m][1][j] * rsc;
                    v0[j] = g0 * fsigmoid(g0) * (acc[ai][1][m][0][j] * rsc); v1[j] = g1 * fsigmoid(g1) * (acc[ai][1][m][1][j] * rsc); }
                *(u32x4*)rowp = pack8(v0, v1); }
    }
};
struct EpiPlain {
    static constexpr bool PERM = true, AFTER_DRAIN = false;
    bf16_t* O; int ldc;
    __device__ __forceinline__ void operator()(const f32x4 (&acc)[2][2][4][2], const Unit& u, int wr, int wc, int fr, int fq) const {
        const int row0 = u.pm * BM + wr * 64 + fr, col0 = u.pn * BM + wc * 32 + 8 * fq;
#pragma unroll
        for (int ai = 0; ai < 2; ++ai)
#pragma unroll
            for (int m = 0; m < 4; ++m) { bf16_t* rowp = O + (size_t)(row0 + ai * HALF + m * 16) * ldc + col0;
#pragma unroll
                for (int bj = 0; bj < 2; ++bj) *(u32x4*)(rowp + bj * HALF) = pack8(acc[ai][bj][m][0], acc[ai][bj][m][1]); }
    }
};

__device__ __forceinline__ unsigned pk4_fp8(float a, float b, float c, float d) { int w = 0; w = __builtin_amdgcn_cvt_pk_fp8_f32(fminf(fmaxf(a, -448.f), 448.f), fminf(fmaxf(b, -448.f), 448.f), w, false);
    w = __builtin_amdgcn_cvt_pk_fp8_f32(fminf(fmaxf(c, -448.f), 448.f), fminf(fmaxf(d, -448.f), 448.f), w, true); return (unsigned)w; }
struct EpiSwiglu8 {
    static constexpr bool PERM = true, AFTER_DRAIN = false;
    unsigned char* O; int ldc; float ascale, oscale;
    __device__ __forceinline__ void operator()(const f32x4 (&acc)[2][2][4][2], const Unit& u, int wr, int wc, int fr, int fq) const {
        const int row0 = u.pm * BM + wr * 64 + fr, col0 = u.pn * HALF + wc * 32 + 8 * fq;
#pragma unroll
        for (int ai = 0; ai < 2; ++ai)
#pragma unroll
            for (int m = 0; m < 4; ++m) { unsigned char* rowp = O + (size_t)(row0 + ai * HALF + m * 16) * ldc + col0;
                f32x4 v0, v1;
#pragma unroll
                for (int j = 0; j < 4; ++j) { const float g0 = acc[ai][0][m][0][j] * ascale, g1 = acc[ai][0][m][1][j] * ascale;
                    v0[j] = g0 * fsigmoid(g0) * (acc[ai][1][m][0][j] * ascale) * oscale; v1[j] = g1 * fsigmoid(g1) * (acc[ai][1][m][1][j] * ascale) * oscale; }
                typedef unsigned u32x2 __attribute__((ext_vector_type(2))); u32x2 w; w.x = pk4_fp8(v0[0], v0[1], v0[2], v0[3]); w.y = pk4_fp8(v1[0], v1[1], v1[2], v1[3]);
                *(u32x2*)rowp = w; }
    }
};
struct EpiPlainS {
    static constexpr bool PERM = true, AFTER_DRAIN = false;
    bf16_t* O; int ldc; float scale;
    __device__ __forceinline__ void operator()(const f32x4 (&acc)[2][2][4][2], const Unit& u, int wr, int wc, int fr, int fq) const {
        const int row0 = u.pm * BM + wr * 64 + fr, col0 = u.pn * BM + wc * 32 + 8 * fq;
#pragma unroll
        for (int ai = 0; ai < 2; ++ai)
#pragma unroll
            for (int m = 0; m < 4; ++m) { bf16_t* rowp = O + (size_t)(row0 + ai * HALF + m * 16) * ldc + col0;
#pragma unroll
                for (int bj = 0; bj < 2; ++bj) *(u32x4*)(rowp + bj * HALF) = pack8(acc[ai][bj][m][0] * scale, acc[ai][bj][m][1] * scale); }
    }
};
struct EpiProj {
    static constexpr bool PERM = true, AFTER_DRAIN = false;
    bf16_t *PA, *PK, *UA2; const float* rs;
    __device__ __forceinline__ void operator()(const f32x4 (&acc)[2][2][4][2], const Unit& u, int wr, int wc, int fr, int fq) const {
        if (u.pn < 2) {
#pragma unroll
            for (int ai = 0; ai < 2; ++ai)
#pragma unroll
                for (int m = 0; m < 4; ++m) { const int row = u.pm * BM + wr * 64 + fr + ai * HALF + m * 16, bb = row >> 11, t = row & 2047; const float rsc = rs[row];
#pragma unroll
                    for (int bj = 0; bj < 2; ++bj) { const int col = 256 * u.pn + 128 * bj + wc * 32 + 8 * fq;
                        *(u32x4*)(UA2 + ((size_t)((bb * 32 + (col >> 4)) * 2048 + t)) * 16 + (col & 8)) = pack8(acc[ai][bj][m][0] * rsc, acc[ai][bj][m][1] * rsc); } }
            return; }
        bf16_t* base; int ldc, colt;
        if (u.pn < 6) { base = PA; ldc = 1024; colt = 256 * (u.pn - 2); } else { base = PK; ldc = 256; colt = 0; }
        const int row0 = u.pm * BM + wr * 64 + fr, col0 = colt + wc * 32 + 8 * fq;
#pragma unroll
        for (int ai = 0; ai < 2; ++ai)
#pragma unroll
            for (int m = 0; m < 4; ++m) { bf16_t* rowp = base + (size_t)(row0 + ai * HALF + m * 16) * ldc + col0; const float rsc = rs[row0 + ai * HALF + m * 16];
#pragma unroll
                for (int bj = 0; bj < 2; ++bj) *(u32x4*)(rowp + bj * HALF) = pack8(acc[ai][bj][m][0] * rsc, acc[ai][bj][m][1] * rsc); }
    }
};
struct EpiGates8 {
    static constexpr bool PERM = true, AFTER_DRAIN = false;
    bf16_t* PG; const float* rs;
    __device__ __forceinline__ void operator()(const f32x4 (&acc)[2][2][4][2], const Unit& u, int wr, int wc, int fr, int fq) const {
        const int row0 = u.pm * BM + wr * 64 + fr, col0 = u.pn * BM + wc * 32 + 8 * fq;
#pragma unroll
        for (int ai = 0; ai < 2; ++ai)
#pragma unroll
            for (int m = 0; m < 4; ++m) { bf16_t* rowp = PG + (size_t)(row0 + ai * HALF + m * 16) * 2048 + col0; const float rsc = rs[row0 + ai * HALF + m * 16] * (1.0f / 256.0f);
#pragma unroll
                for (int bj = 0; bj < 2; ++bj) *(u32x4*)(rowp + bj * HALF) = pack8(acc[ai][bj][m][0] * rsc, acc[ai][bj][m][1] * rsc); }
    }
};
struct ProjOrderA {
    StaticOrder base; int c;
    __device__ __forceinline__ bool next(int i, Unit& u) const { if (i < 3) return base.next(i, u); if (i == 3 && c < 128) { u.pm = c; u.pn = 6; return true; } return false; }
    __device__ __forceinline__ void a_ready(const Unit&) const {}
    __device__ __forceinline__ void done(const Unit&) const {}
};
struct ProjOrderB {
    int c;
    __device__ __forceinline__ bool next(int i, Unit& u) const {
        int Lx; if (c < 128) { if (i >= 3) return false; Lx = c + 128 * i; } else { if (i >= 5) return false; Lx = 384 + (c - 128) + 128 * i; }
        const int wgid = (Lx % NXCD) * 128 + Lx / NXCD, nig = WGM * 8;
        u.pm = (wgid / nig) * WGM + (wgid % nig) % WGM; u.pn = (wgid % nig) / WGM; return true; }
    __device__ __forceinline__ void a_ready(const Unit&) const {}
    __device__ __forceinline__ void done(const Unit&) const {}
};
struct EpiGlu {
    static constexpr bool PERM = true, AFTER_DRAIN = false;
    const bf16_t* Y; bf16_t* O;
    __device__ __forceinline__ void operator()(const f32x4 (&acc)[2][2][4][2], const Unit& u, int wr, int wc, int fr, int fq) const {
        const int row0 = u.pm * BM + wr * 64 + fr, col0 = u.pn * BM + wc * 32 + 8 * fq;
#pragma unroll
        for (int ai = 0; ai < 2; ++ai)
#pragma unroll
            for (int m = 0; m < 4; ++m) { const size_t off = (size_t)(row0 + ai * HALF + m * 16) * 512 + col0;
#pragma unroll
                for (int bj = 0; bj < 2; ++bj) { f32x4 y0, y1; unpack8(*(const u32x4*)(Y + off + bj * HALF), y0, y1); f32x4 v0, v1;
#pragma unroll
                    for (int j = 0; j < 4; ++j) { v0[j] = y0[j] * fsigmoid(acc[ai][bj][m][0][j]); v1[j] = y1[j] * fsigmoid(acc[ai][bj][m][1][j]); }
                    *(u32x4*)(O + off + bj * HALF) = pack8(v0, v1); } }
    }
};
template <bool SECOND> struct EpiMerge {
    static constexpr bool PERM = true, AFTER_DRAIN = false;
    const bf16_t* G; int goff; const bf16_t* T; bf16_t* O;
    __device__ __forceinline__ void operator()(const f32x4 (&acc)[2][2][4][2], const Unit& u, int wr, int wc, int fr, int fq) const {
        const int row0 = u.pm * BM + wr * 64 + fr, col0 = u.pn * BM + wc * 32 + 8 * fq;
#pragma unroll
        for (int ai = 0; ai < 2; ++ai)
#pragma unroll
            for (int m = 0; m < 4; ++m) { const size_t row = (size_t)(row0 + ai * HALF + m * 16);
#pragma unroll
                for (int bj = 0; bj < 2; ++bj) { const int col = col0 + bj * HALF; f32x4 g0, g1; unpack8(*(const u32x4*)(G + row * 2048 + goff + col), g0, g1);
                    f32x4 t0 = (f32x4){0.f, 0.f, 0.f, 0.f}, t1 = t0; if (SECOND) unpack8(*(const u32x4*)(T + row * 1024 + col), t0, t1);
                    f32x4 v0, v1;
#pragma unroll
                    for (int j = 0; j < 4; ++j) { v0[j] = t0[j] + fsigmoid(g0[j]) * acc[ai][bj][m][0][j]; v1[j] = t1[j] + fsigmoid(g1[j]) * acc[ai][bj][m][1][j]; }
                    *(u32x4*)(O + row * 1024 + col) = pack8(v0, v1); } }
    }
};

struct MergeOrder {
    StaticOrder base;
    __device__ __forceinline__ bool next(int i, Unit& u) const { if (i >= 4) return false; if (!base.next(i & 1, u)) return false; if (i >= 2) { u.pm += 128; u.pn += 4; } return true; }
    __device__ __forceinline__ void a_ready(const Unit&) const {}
    __device__ __forceinline__ void done(const Unit&) const {}
};
struct EpiMerge2 {
    static constexpr bool PERM = true, AFTER_DRAIN = false;
    const bf16_t* G; bf16_t* T; bf16_t* O;
    __device__ __forceinline__ void operator()(const f32x4 (&acc)[2][2][4][2], const Unit& u, int wr, int wc, int fr, int fq) const {
        const bool second = u.pm >= 128; const int pm = second ? u.pm - 128 : u.pm, pn = second ? u.pn - 4 : u.pn, goff = second ? 1024 : 0;
        const int row0 = pm * BM + wr * 64 + fr, col0 = pn * BM + wc * 32 + 8 * fq;
#pragma unroll
        for (int ai = 0; ai < 2; ++ai)
#pragma unroll
            for (int m = 0; m < 4; ++m) { const size_t row = (size_t)(row0 + ai * HALF + m * 16);
#pragma unroll
                for (int bj = 0; bj < 2; ++bj) { const int col = col0 + bj * HALF; f32x4 g0, g1; unpack8(*(const u32x4*)(G + row * 2048 + goff + col), g0, g1);
                    f32x4 t0 = (f32x4){0.f, 0.f, 0.f, 0.f}, t1 = t0; if (second) unpack8(*(const u32x4*)(T + row * 1024 + col), t0, t1);
                    f32x4 v0, v1;
#pragma unroll
                    for (int j = 0; j < 4; ++j) { v0[j] = t0[j] + fsigmoid(g0[j]) * acc[ai][bj][m][0][j]; v1[j] = t1[j] + fsigmoid(g1[j]) * acc[ai][bj][m][1][j]; }
                    *(u32x4*)((second ? O : T) + row * 1024 + col) = pack8(v0, v1); } }
    }
};
typedef int i32x8 __attribute__((ext_vector_type(8)));
typedef int i32x4v __attribute__((ext_vector_type(4)));
__device__ __forceinline__ i32x8 cat8(const bf16x8 lo, const bf16x8 hi) { const i32x4v a = __builtin_bit_cast(i32x4v, lo), b = __builtin_bit_cast(i32x4v, hi); return __builtin_shufflevector(a, b, 0, 1, 2, 3, 4, 5, 6, 7); }
template <class Epi, class Sched, bool ALIGN_EPI = false, bool SP2 = false, bool F8 = false>
__device__ __forceinline__ void gemm_phase(PG8_LAS unsigned char* lds, const Gemm g, const Sched& S, const Epi& E) {
    const int tid = threadIdx.x, wid = __builtin_amdgcn_readfirstlane(tid >> 6), lane = tid & 63, wr = wid >> 2, wc = wid & 3, fr = lane & 15, fq = lane >> 4;
    const int K = g.K, KB = F8 ? K : 2 * K  , nt = KB / 128;
    unsigned voffA[2], voffB[2];
#pragma unroll
    for (int i = 0; i < 2; ++i) { int R, C; stage_rc(tid * 16 + i * 8192, R, C); const int Rb = Epi::PERM ? ((R & ~31) + perm32(R & 31)) : R;
        voffA[i] = (unsigned)(R * KB + C * 2); voffB[i] = (unsigned)(Rb * KB + C * 2); }
    const size_t kstep = (size_t)(BK * 2);
    const size_t hstep = (size_t)HALF * KB;
    const size_t tstep = 2 * hstep;
    const unsigned ldsw = (unsigned)wid * 1024u;
    const int aoff = lds_byte(wr * 64 + fr, fq * 8), boff = lds_byte(wc * 32 + fr, fq * 8);
#define PG8_SA(b, h) (((b) * 2 + (h)) * HTB)
#define PG8_SB(b, h) ((4 + (b) * 2 + (h)) * HTB)
#define PG8_STAGE(bufoff, gbase, voff) do { _Pragma("unroll") for (int _i = 0; _i < 2; ++_i) \
        __builtin_amdgcn_global_load_lds((const unsigned*)((const char*)(gbase) + (voff)[_i]), (PG8_LAS unsigned*)(lds + (bufoff) + ldsw + _i * 8192), 16, 0, 0); } while (0)
#define PG8_LDA(dst, b, h) do { if constexpr (F8) { _Pragma("unroll") for (int m = 0; m < 4; ++m) dst##8[m] = cat8(*(const PG8_LAS bf16x8*)(lds + PG8_SA(b, h) + aoff + m * 2048), *(const PG8_LAS bf16x8*)(lds + PG8_SA(b, h) + aoff + m * 2048 + 1024)); } else { \
        _Pragma("unroll") for (int m = 0; m < 4; ++m) _Pragma("unroll") for (int k = 0; k < 2; ++k) dst[m][k] = *(const PG8_LAS bf16x8*)(lds + PG8_SA(b, h) + aoff + m * 2048 + k * 1024); } } while (0)
#define PG8_LDB(dst, b, h) do { if constexpr (F8) { _Pragma("unroll") for (int n = 0; n < 2; ++n) dst##8[n] = cat8(*(const PG8_LAS bf16x8*)(lds + PG8_SB(b, h) + boff + n * 2048), *(const PG8_LAS bf16x8*)(lds + PG8_SB(b, h) + boff + n * 2048 + 1024)); } else { \
        _Pragma("unroll") for (int n = 0; n < 2; ++n) _Pragma("unroll") for (int k = 0; k < 2; ++k) dst[n][k] = *(const PG8_LAS bf16x8*)(lds + PG8_SB(b, h) + boff + n * 2048 + k * 1024); } } while (0)
#define PG8_MMA(ai, bj, At, Bt) do { __builtin_amdgcn_s_setprio(1); if constexpr (F8) { _Pragma("unroll") for (int m = 0; m < 4; ++m) _Pragma("unroll") for (int n = 0; n < 2; ++n) \
        acc[ai][bj][m][n] = __builtin_amdgcn_mfma_scale_f32_16x16x128_f8f6f4(Bt##8[n], At##8[m], acc[ai][bj][m][n], 0, 0, 0, 0x7F7F7F7F, 0, 0x7F7F7F7F); \
        _Pragma("unroll") for (int m = 0; m < 4; ++m) _Pragma("unroll") for (int n = 0; n < 2; ++n) asm volatile("" : "+v"(acc[ai][bj][m][n])); } else { \
        _Pragma("unroll") for (int m = 0; m < 4; ++m) _Pragma("unroll") for (int n = 0; n < 2; ++n) _Pragma("unroll") for (int k = 0; k < 2; ++k) \
        acc[ai][bj][m][n] = __builtin_amdgcn_mfma_f32_16x16x32_bf16(Bt[n][k], At[m][k], acc[ai][bj][m][n], 0, 0, 0); } __builtin_amdgcn_s_setprio(0); } while (0)
#define PG8_WAIT_V(n) asm volatile("s_waitcnt vmcnt(" #n ")" ::: "memory")
#define PG8_WAIT_L(n) asm volatile("s_waitcnt lgkmcnt(" #n ")" ::: "memory")
#define PG8_BAR __builtin_amdgcn_s_barrier()
#define PG8_SCHED __builtin_amdgcn_sched_barrier(0)
    Unit cur, nxt; int ui = 0;
    if (!S.next(0, cur)) return;
    f32x4 acc[2][2][4][2];
#pragma unroll
    for (int a = 0; a < 2; ++a)
#pragma unroll
        for (int b = 0; b < 2; ++b)
#pragma unroll
            for (int m = 0; m < 4; ++m)
#pragma unroll
                for (int n = 0; n < 2; ++n) acc[a][b][m][n] = (f32x4){0.f, 0.f, 0.f, 0.f};
    bf16x8 At[4][2], B0[2][2], B1[2][2]; i32x8 At8[4], B08[2], B18[2];
    const char* cA = (const char*)g.A + (size_t)cur.pm * tstep; const char* cB = (const char*)g.Bt + (size_t)cur.pn * tstep;
    S.a_ready(cur);
    if constexpr (SP2) {
        PG8_STAGE(PG8_SB(0, 0), cB, voffB); PG8_STAGE(PG8_SB(0, 1), cB + hstep, voffB); PG8_STAGE(PG8_SA(0, 0), cA, voffA); PG8_STAGE(PG8_SA(0, 1), cA + hstep, voffA);
        if (wr == 1) PG8_BAR;
        PG8_WAIT_V(2); PG8_BAR;
        PG8_STAGE(PG8_SB(1, 0), cB + kstep, voffB); PG8_STAGE(PG8_SA(1, 0), cA + kstep, voffA); PG8_STAGE(PG8_SB(1, 1), cB + hstep + kstep, voffB);
        PG8_WAIT_V(6); PG8_BAR;
    } else {
        PG8_STAGE(PG8_SB(0, 0), cB, voffB); PG8_STAGE(PG8_SA(0, 0), cA, voffA); PG8_STAGE(PG8_SB(0, 1), cB + hstep, voffB); PG8_STAGE(PG8_SA(0, 1), cA + hstep, voffA);
        if (wr == 1) PG8_BAR;
        PG8_WAIT_V(4); PG8_BAR;
        PG8_STAGE(PG8_SB(1, 0), cB + kstep, voffB); PG8_STAGE(PG8_SA(1, 0), cA + kstep, voffA); PG8_STAGE(PG8_SB(1, 1), cB + hstep + kstep, voffB);
        PG8_WAIT_V(6); PG8_BAR;
    }
    for (;;) {
        const bool has_next = S.next(ui + 1, nxt);
        const char* nA = has_next ? (const char*)g.A + (size_t)nxt.pm * tstep : cA; const char* nB = has_next ? (const char*)g.Bt + (size_t)nxt.pn * tstep : cB;
        for (int t = 0; t < nt; t += 2) {
            const bool last = (t == nt - 2);
            const char* a1 = cA + (size_t)(t + 1) * kstep;
            const char* a2 = last ? nA : cA + (size_t)(t + 2) * kstep; const char* b2 = last ? nB : cB + (size_t)(t + 2) * kstep;
            const char* a3 = a2 + kstep; const char* b3 = b2 + kstep;
            if (last && has_next) S.a_ready(nxt);
            if constexpr (SP2) {
            PG8_LDB(B0, 0, 0); PG8_LDB(B1, 0, 1); PG8_SCHED; PG8_LDA(At, 0, 0); PG8_STAGE(PG8_SA(1, 1), a1 + hstep, voffA);
            PG8_WAIT_V(8); PG8_WAIT_L(0); PG8_BAR; PG8_MMA(0, 0, At, B0); PG8_MMA(0, 1, At, B1); PG8_BAR; PG8_SCHED;
            PG8_LDA(At, 0, 1); PG8_STAGE(PG8_SB(0, 0), b2, voffB); PG8_STAGE(PG8_SB(0, 1), b2 + hstep, voffB); PG8_STAGE(PG8_SA(0, 0), a2, voffA);
            PG8_WAIT_V(8); PG8_WAIT_L(0); PG8_BAR; PG8_MMA(1, 0, At, B0); PG8_MMA(1, 1, At, B1); PG8_BAR; PG8_SCHED;
            PG8_LDB(B0, 1, 0); PG8_LDB(B1, 1, 1); PG8_SCHED; PG8_LDA(At, 1, 0); PG8_STAGE(PG8_SA(0, 1), a2 + hstep, voffA);
            PG8_WAIT_V(8); PG8_WAIT_L(0); PG8_BAR; PG8_MMA(0, 0, At, B0); PG8_MMA(0, 1, At, B1); PG8_BAR; PG8_SCHED;
            PG8_LDA(At, 1, 1); PG8_STAGE(PG8_SB(1, 0), b3, voffB); PG8_STAGE(PG8_SB(1, 1), b3 + hstep, voffB); PG8_STAGE(PG8_SA(1, 0), a3, voffA);
            PG8_WAIT_V(8); PG8_WAIT_L(0); PG8_BAR; PG8_MMA(1, 0, At, B0); PG8_MMA(1, 1, At, B1); PG8_BAR; PG8_SCHED;
            } else {
            PG8_LDB(B0, 0, 0); PG8_SCHED; PG8_LDA(At, 0, 0); PG8_STAGE(PG8_SA(1, 1), a1 + hstep, voffA);
            PG8_WAIT_L(8); PG8_BAR; PG8_WAIT_L(0); PG8_MMA(0, 0, At, B0); PG8_BAR; PG8_SCHED;
            PG8_LDB(B1, 0, 1); PG8_STAGE(PG8_SB(0, 0), b2, voffB);
            PG8_BAR; PG8_WAIT_L(0); PG8_MMA(0, 1, At, B1); PG8_BAR;
            PG8_LDA(At, 0, 1); PG8_STAGE(PG8_SA(0, 0), a2, voffA);
            PG8_BAR; PG8_WAIT_L(0); PG8_MMA(1, 0, At, B0); PG8_BAR; PG8_SCHED;
            PG8_STAGE(PG8_SB(0, 1), b2 + hstep, voffB);
            PG8_WAIT_V(6); PG8_BAR; PG8_MMA(1, 1, At, B1); PG8_BAR;
            PG8_LDB(B0, 1, 0); PG8_SCHED; PG8_LDA(At, 1, 0); PG8_STAGE(PG8_SA(0, 1), a2 + hstep, voffA);
            PG8_WAIT_L(8); PG8_BAR; PG8_WAIT_L(0); PG8_MMA(0, 0, At, B0); PG8_BAR; PG8_SCHED;
            PG8_LDB(B1, 1, 1); PG8_STAGE(PG8_SB(1, 0), b3, voffB);
            PG8_BAR; PG8_WAIT_L(0); PG8_MMA(0, 1, At, B1); PG8_BAR;
            PG8_LDA(At, 1, 1); PG8_STAGE(PG8_SA(1, 0), a3, voffA);
            PG8_BAR; PG8_WAIT_L(0); PG8_MMA(1, 0, At, B0); PG8_BAR; PG8_SCHED;
            PG8_STAGE(PG8_SB(1, 1), b3 + hstep, voffB);
            PG8_WAIT_V(6); PG8_BAR; PG8_MMA(1, 1, At, B1); PG8_BAR;
            }
        }
        if constexpr (ALIGN_EPI) { if (wr == 0) PG8_BAR; }
        if constexpr (!Epi::AFTER_DRAIN) { E(acc, cur, wr, wc, fr, fq); S.done(cur); }
        if (!has_next) break;
#pragma unroll
        for (int a = 0; a < 2; ++a)
#pragma unroll
            for (int b = 0; b < 2; ++b)
#pragma unroll
                for (int m = 0; m < 4; ++m)
#pragma unroll
                    for (int n = 0; n < 2; ++n) acc[a][b][m][n] = (f32x4){0.f, 0.f, 0.f, 0.f};
        cur = nxt; cA = nA; cB = nB; ++ui;
        if constexpr (ALIGN_EPI) { if (wr == 1) PG8_BAR; }
    }
    PG8_WAIT_V(0);
    if constexpr (!ALIGN_EPI) { if (wr == 0) PG8_BAR; }
    PG8_BAR;
    if constexpr (Epi::AFTER_DRAIN) { E.fused(acc, cur, wr, wc, fr, fq, lds, wid, lane); S.done(cur); }
#undef PG8_SA
#undef PG8_SB
#undef PG8_STAGE
#undef PG8_LDA
#undef PG8_LDB
#undef PG8_MMA
#undef PG8_WAIT_V
#undef PG8_WAIT_L
#undef PG8_BAR
#undef PG8_SCHED
}
}
#ifndef PG8_SP2
#define PG8_SP2 true
#endif
#ifndef PG8_ALIGN
#define PG8_ALIGN true
#endif
#ifndef MK_PER_PHASE
#define MK_PER_PHASE 0
#endif
#ifndef REP_S5
#define REP_S5 1
#endif
#ifndef REP_DSA
#define REP_DSA 1
#endif
#ifndef REP_G1
#define REP_G1 1
#endif
constexpr int NWAVES = 8;
constexpr int NPH = 14;

constexpr int NB = 16, SEQ = 2048, D = 1024, NMETA = 16, DFF = 2816;
constexpr int R = NB * SEQ;
constexpr int NG = 32, NP = 64, NM = 16;
constexpr float RMS_EPS = 1e-6f;

constexpr size_t MiB = 1u << 20;
constexpr size_t WS_CTL = 0, CTL_ZERO_BYTES = 1 * MiB;
constexpr size_t WS_WT3B = 23 * MiB  ;
constexpr size_t WS_WT1 = 2 * MiB, WS_WT2 = 13 * MiB, WS_WT3 = 19 * MiB, WS_WT4 = 27 * MiB, WS_WT5 = 38 * MiB;
constexpr size_t WS_WGLU = 44 * MiB, WS_WA = 45 * MiB, WS_WB = 46 * MiB, WS_WOUT = 47 * MiB;
constexpr size_t WS_KS = 50 * MiB, WS_KO = 58 * MiB, WS_KI = 66 * MiB;
constexpr size_t WS_META = 67 * MiB;
constexpr size_t MO_AM1 = 0, MO_ACTM = 32768, MO_FM = 131072, MO_AM2 = 262144, MO_PMU = 294912, MO_PMK = 311296;
constexpr size_t WS_HN = 68 * MiB;
constexpr size_t WS_F = 132 * MiB;
constexpr size_t WS_BIG = 196 * MiB;
constexpr size_t WS_PA = WS_BIG, WS_PG = WS_BIG + 96 * MiB, WS_PK = WS_BIG + 224 * MiB, WS_HB = WS_BIG + 240 * MiB  , WS_END = WS_BIG + 304 * MiB;
constexpr size_t WS_HB8 = WS_BIG + 64 * MiB;
constexpr size_t WS_UA2 = WS_F + 32 * MiB;
constexpr int CW_BAR = 4096;

constexpr int LDS_BYTES = 155648;
constexpr int MISC_OFF = 154624;

#define GAS __attribute__((address_space(1)))
#define LAS __attribute__((address_space(3)))
typedef unsigned short bf16;
typedef unsigned v4u __attribute__((ext_vector_type(4)));
typedef unsigned v2u __attribute__((ext_vector_type(2)));
typedef float f32x4 __attribute__((ext_vector_type(4)));
typedef short bf16x8 __attribute__((ext_vector_type(8)));
#define LDS_WAIT() asm volatile("s_waitcnt lgkmcnt(0)" ::: "memory")
#define VM_WAIT() asm volatile("s_waitcnt vmcnt(0)" ::: "memory")
__device__ __forceinline__ unsigned f2bf(float f) { unsigned u = __builtin_bit_cast(unsigned, f); return (u + 0x7fffu + ((u >> 16) & 1u)) >> 16; }
__device__ __forceinline__ unsigned pk2(float lo, float hi) { return f2bf(lo) | (f2bf(hi) << 16); }
__device__ __forceinline__ float bflo(unsigned w) { return __uint_as_float(w << 16); }
__device__ __forceinline__ float bfhi(unsigned w) { return __uint_as_float(w & 0xffff0000u); }
__device__ __forceinline__ float bf2f(bf16 v) { return __uint_as_float(((unsigned)v) << 16); }
__device__ __forceinline__ float fsig(float x) { return __builtin_amdgcn_rcpf(1.0f + __expf(-x)); }

#define XB_TMO      128
#define XB_XCNT(j)  (256  + 64 * (j))
#define XB_XSUB(j)  (1280 + 64 * (j))
#define XB_XGEN(j)  (2304 + 64 * (j))
#define XB_TOP      3328
#define XB_TOPGEN   3392
#define XCD_BAR_WORDS 3456
#define XB_SPIN_CAP (1u << 18)
__device__ __forceinline__ unsigned xb_ld(unsigned* p)              { return __hip_atomic_load(p, __ATOMIC_RELAXED, __HIP_MEMORY_SCOPE_AGENT); }
__device__ __forceinline__ unsigned xb_add(unsigned* p, unsigned v) { return __hip_atomic_fetch_add(p, v, __ATOMIC_RELAXED, __HIP_MEMORY_SCOPE_AGENT); }
__device__ __forceinline__ unsigned xb_xcc_id() { return (unsigned)__builtin_amdgcn_s_getreg((3 << 11) | 20) & 0xFu; }
#define XB_SPIN(cond, bar) do { unsigned _sp = 0; while (cond) { __builtin_amdgcn_s_sleep(1); \
    if ((++_sp & 255u) == 0u) { if (xb_ld(&(bar)[XB_TMO])) break; if (_sp > XB_SPIN_CAP) { atomicAdd(&(bar)[XB_TMO], 1u); break; } } } } while (0)
struct XcdBarrier { unsigned* bar; unsigned x; volatile LAS unsigned* st; };
__device__ __forceinline__ XcdBarrier xcd_barrier_post(unsigned* bar, volatile LAS unsigned* st) {
    XcdBarrier b; b.bar = bar; b.x = xb_xcc_id(); b.st = st;
    if (threadIdx.x == 0) (void)xb_add(&bar[XB_XCNT(b.x)], 1u);
    return b;
}
__device__ __forceinline__ void xcd_barrier_complete(unsigned* bar, unsigned x, unsigned& nloc, unsigned& nx) {
    const unsigned G = gridDim.x * gridDim.y * gridDim.z;
    unsigned sum, cnt, mine, sp = 0u;
    for (;;) {
        sum = 0u; cnt = 0u; mine = 0u;
#pragma unroll
        for (unsigned j = 0; j < 16; ++j) { const unsigned c = xb_ld(&bar[XB_XCNT(j)]); sum += c; cnt += (c > 0u) ? 1u : 0u; mine = (j == x) ? c : mine; }
        if (sum == G) break;
        __builtin_amdgcn_s_sleep(1);
        if ((++sp & 255u) == 0u) { if (xb_ld(&bar[XB_TMO])) break; if (sp > XB_SPIN_CAP) { atomicAdd(&bar[XB_TMO], 1u); break; } }
    }
    nloc = mine > 0u ? mine : 1u; nx = cnt > 0u ? cnt : 1u;
}
__device__ __forceinline__ void xcd_barrier(const XcdBarrier& b) {
    asm volatile("s_waitcnt vmcnt(0)" ::: "memory");
    __syncthreads();
    if (threadIdx.x == 0) {
        unsigned* bar = b.bar;
        __builtin_amdgcn_s_waitcnt(0);
        unsigned nloc = b.st[0], nx = b.st[1];
        if (nloc == 0u) { xcd_barrier_complete(bar, b.x, nloc, nx); b.st[0] = nloc; b.st[1] = nx; }
        const unsigned old = xb_add(&bar[XB_XSUB(b.x)], 1u);
        const unsigned gen = old / nloc;
        if (old + 1u == (gen + 1u) * nloc) {
            __builtin_amdgcn_fence(__ATOMIC_RELEASE, "agent");
            asm volatile("s_waitcnt vmcnt(0)" ::: "memory");
            const unsigned og = xb_add(&bar[XB_TOP], 1u);
            const unsigned tg = og / nx;
            if (og + 1u == (tg + 1u) * nx) xb_add(&bar[XB_TOPGEN], 1u);
            else XB_SPIN(xb_ld(&bar[XB_TOPGEN]) == tg, bar);
            __builtin_amdgcn_fence(__ATOMIC_ACQUIRE, "agent");
            xb_add(&bar[XB_XGEN(b.x)], 1u);
            asm volatile("s_waitcnt vmcnt(0)" ::: "memory");
        } else {
            XB_SPIN(xb_ld(&bar[XB_XGEN(b.x)]) == gen, bar);
            __builtin_amdgcn_fence(__ATOMIC_ACQUIRE, "agent");
            asm volatile("s_waitcnt vmcnt(0)" ::: "memory");
        }
    }
    __syncthreads();
}

__device__ __forceinline__ float wave_sum(float v) {
#pragma unroll
    for (int o = 1; o < 64; o <<= 1) v += __shfl_xor(v, o);
    return v;
}
__device__ __forceinline__ f32x4 mfma16(bf16x8 a, bf16x8 b, f32x4 c) { return __builtin_amdgcn_mfma_f32_16x16x32_bf16(a, b, c, 0, 0, 0); }

__device__ __forceinline__ void transpose_item(const float* W, int Nsrc, int K, bf16* WT, int k0, int drow0, int srccol, LAS float* scr, int lane, const float* gk = nullptr) {
    f32x4 wl[8];
#pragma unroll
    for (int i = 0; i < 8; ++i) { const int kk = 8 * i + (lane >> 3); wl[i] = (srccol >= 0) ? *(const f32x4*)(W + (size_t)(k0 + kk) * Nsrc + srccol) : (f32x4){0.f, 0.f, 0.f, 0.f}; }
#pragma unroll
    for (int i = 0; i < 8; ++i) { const int kk = 8 * i + (lane >> 3); f32x4 v = wl[i]; if (gk) v = v * gk[k0 + kk]; LAS float* d = scr + kk * 33 + 4 * (lane & 7); d[0] = v.x; d[1] = v.y; d[2] = v.z; d[3] = v.w; }
    LDS_WAIT(); asm volatile("" ::: "memory");
    const int c = lane & 7;
#pragma unroll
    for (int j = 0; j < 4; ++j) { const int n = (lane >> 3) + 8 * j; const LAS float* s = scr + (8 * c) * 33 + n;
        v4u o; o.x = pk2(s[0 * 33], s[1 * 33]); o.y = pk2(s[2 * 33], s[3 * 33]); o.z = pk2(s[4 * 33], s[5 * 33]); o.w = pk2(s[6 * 33], s[7 * 33]);
        *(v4u*)(WT + (size_t)(drow0 + n) * K + k0 + 8 * c) = o; }
    LDS_WAIT(); asm volatile("" ::: "memory");
}

__device__ __forceinline__ unsigned pk4q(float a, float b, float c, float d) { int w = 0; w = __builtin_amdgcn_cvt_pk_fp8_f32(fminf(fmaxf(a, -448.f), 448.f), fminf(fmaxf(b, -448.f), 448.f), w, false);
    w = __builtin_amdgcn_cvt_pk_fp8_f32(fminf(fmaxf(c, -448.f), 448.f), fminf(fmaxf(d, -448.f), 448.f), w, true); return (unsigned)w; }
__device__ __forceinline__ void transpose_item8(const float* W, int Nsrc, int K, unsigned char* WT8, int k0, int drow0, int srccol, LAS float* scr, int lane, const float* gk = nullptr) {
    f32x4 wl[8];
#pragma unroll
    for (int i = 0; i < 8; ++i) { const int kk = 8 * i + (lane >> 3); wl[i] = *(const f32x4*)(W + (size_t)(k0 + kk) * Nsrc + srccol); }
#pragma unroll
    for (int i = 0; i < 8; ++i) { const int kk = 8 * i + (lane >> 3); f32x4 v = wl[i] * 64.0f; if (gk) v = v * gk[k0 + kk]; LAS float* d = scr + kk * 33 + 4 * (lane & 7); d[0] = v.x; d[1] = v.y; d[2] = v.z; d[3] = v.w; }
    LDS_WAIT(); asm volatile("" ::: "memory");
    const int c = lane & 7;
#pragma unroll
    for (int j = 0; j < 4; ++j) { const int n = (lane >> 3) + 8 * j; const LAS float* sp = scr + (8 * c) * 33 + n;
        v2u o; o.x = pk4q(sp[0 * 33], sp[1 * 33], sp[2 * 33], sp[3 * 33]); o.y = pk4q(sp[4 * 33], sp[5 * 33], sp[6 * 33], sp[7 * 33]);
        *(v2u*)(WT8 + (size_t)(drow0 + n) * K + k0 + 8 * c) = o; }
    LDS_WAIT(); asm volatile("" ::: "memory");
}
__device__ __forceinline__ int win_srccol(int d) {
    if (d < 1024) return d;
    if (d < 1536) return 1096 + (d - 1024);
    if (d < 1600) return 1024 + (d - 1536);
    if (d < 1664) return 1608 + (d - 1600);
    if (d < 1728) return 1672 + (d - 1664);
    if (d < 1736) return 1088 + (d - 1728);
    return -1;
}
__device__ __forceinline__ void norm_row_to_bf16(const float* xrow, const float* g, bf16* orow, int lane) {
    f32x4 v[4]; float ss = 0.f;
#pragma unroll
    for (int j = 0; j < 4; ++j) { v[j] = ((const f32x4*)xrow)[lane + 64 * j]; ss += (v[j].x * v[j].x + v[j].y * v[j].y) + (v[j].z * v[j].z + v[j].w * v[j].w); }
    const float rs = rsqrtf(wave_sum(ss) * (1.f / D) + RMS_EPS);
#pragma unroll
    for (int j = 0; j < 4; ++j) { const f32x4 gv = ((const f32x4*)g)[lane + 64 * j]; v2u o; o.x = pk2(v[j].x * rs * gv.x, v[j].y * rs * gv.y); o.y = pk2(v[j].z * rs * gv.z, v[j].w * rs * gv.w);
        ((v2u*)orow)[lane + 64 * j] = o; }
}

struct Args { const float* in[28]; float* out; unsigned char* ws; int ph_lo, ph_hi; };
struct TrDesc { const float* src; const float* gk; unsigned char* dst; int nsrc, K, k0, drow0; int f8; int valid; };
__device__ __forceinline__ void tr_decode(const Args& a, unsigned char* ws, int it, int lane, TrDesc& d) {
    const int n4 = 4 * (lane & 7); int r = it; d.gk = nullptr; d.f8 = 0; d.valid = 1; int srccol;
    if (r < 6 * 1408) { const int mat = r / 1408; r -= mat * 1408;
        if (mat == 2 || mat == 5) { const int kb = r / 32, nb = r % 32; d.nsrc = D; d.K = DFF; d.k0 = 64 * kb; d.drow0 = 32 * nb; srccol = 32 * nb + n4;
            d.src = a.in[mat == 2 ? 10 : 13]; d.dst = ws + (mat == 2 ? WS_WT2 : WS_WT5); d.f8 = (mat == 5); }
        else { const int kb = r / 88, nb = r % 88, d0 = 32 * nb, up = (mat == 1 || mat == 4) ? 128 : 0; d.nsrc = DFF; d.K = D; d.k0 = 64 * kb; d.drow0 = 256 * (d0 >> 7) + (d0 & 127) + up; srccol = d0 + n4;
            d.src = a.in[mat == 0 ? 8 : mat == 1 ? 9 : mat == 3 ? 11 : 12]; d.dst = ws + (mat < 3 ? WS_WT1 : WS_WT4); d.f8 = (mat >= 3); if (mat < 3) d.gk = a.in[2]; }
    } else { r -= 6 * 1408;
        if (r < 896) { const int kb = r / 56, nb = r % 56; d.nsrc = 3784; d.K = D; d.k0 = 64 * kb; d.drow0 = 32 * nb; srccol = win_srccol(32 * nb + n4); d.src = a.in[14]; d.dst = ws + WS_WT3; d.gk = a.in[4]; if (srccol < 0) { d.valid = 0; srccol = 0; } }
        else { r -= 896;
            if (r < 1024) { const int kb = r / 64, nb = r % 64; d.nsrc = 3784; d.K = D; d.k0 = 64 * kb; d.drow0 = 32 * nb; srccol = 1736 + 32 * nb + n4; d.src = a.in[14]; d.dst = ws + WS_WT3B; d.gk = a.in[4]; d.f8 = 1; }
            else { r -= 1024;
                if (r < 128) { const int kb = r / 16, nb = r % 16; d.nsrc = 512; d.K = 512; d.k0 = 64 * kb; d.drow0 = 32 * nb; srccol = 32 * nb + n4; d.src = a.in[23]; d.dst = ws + WS_WGLU; }
                else { r -= 128; const int which = r / 256; r -= which * 256;
                    if (which < 2) { const int kb = r / 32, nb = r % 32; d.nsrc = D; d.K = 512; d.k0 = 64 * kb; d.drow0 = 32 * nb; srccol = 32 * nb + n4; d.src = a.in[which == 0 ? 24 : 26]; d.dst = ws + (which == 0 ? WS_WA : WS_WB); }
                    else { const int r2 = r + (which - 2) * 256; const int kb = r2 / 32, nb = r2 % 32; d.nsrc = D; d.K = D; d.k0 = 64 * kb; d.drow0 = 32 * nb; srccol = 32 * nb + n4; d.src = a.in[27]; d.dst = ws + WS_WOUT; } } } } }
    d.src += (size_t)(d.k0 + (lane >> 3)) * d.nsrc + srccol;
}
__device__ __forceinline__ void tr_load(const TrDesc& d, f32x4 (&wl)[8]) {
#pragma unroll
    for (int i = 0; i < 8; ++i) wl[i] = d.valid ? *(const f32x4*)(d.src + (size_t)(8 * i) * d.nsrc) : (f32x4){0.f, 0.f, 0.f, 0.f};
}
__device__ __forceinline__ void tr_finish(const TrDesc& d, const f32x4 (&wl)[8], LAS float* scr, int lane) {
    const float sc8 = d.f8 ? 64.0f : 1.0f;
#pragma unroll
    for (int i = 0; i < 8; ++i) { const int kk = 8 * i + (lane >> 3); f32x4 v = wl[i] * sc8; if (d.gk) v = v * d.gk[d.k0 + kk]; LAS float* p = scr + kk * 33 + 4 * (lane & 7); p[0] = v.x; p[1] = v.y; p[2] = v.z; p[3] = v.w; }
    LDS_WAIT(); asm volatile("" ::: "memory");
    const int c = lane & 7;
#pragma unroll
    for (int j = 0; j < 4; ++j) { const int n = (lane >> 3) + 8 * j; const LAS float* sp = scr + (8 * c) * 33 + n;
        if (d.f8) { v2u o; o.x = pk4q(sp[0 * 33], sp[1 * 33], sp[2 * 33], sp[3 * 33]); o.y = pk4q(sp[4 * 33], sp[5 * 33], sp[6 * 33], sp[7 * 33]); *(v2u*)(d.dst + (size_t)(d.drow0 + n) * d.K + d.k0 + 8 * c) = o; }
        else { v4u o; o.x = pk2(sp[0 * 33], sp[1 * 33]); o.y = pk2(sp[2 * 33], sp[3 * 33]); o.z = pk2(sp[4 * 33], sp[5 * 33]); o.w = pk2(sp[6 * 33], sp[7 * 33]); *(v4u*)((bf16*)d.dst + (size_t)(d.drow0 + n) * d.K + d.k0 + 8 * c) = o; } }
    LDS_WAIT(); asm volatile("" ::: "memory");
}
template <bool PRESCALE>
__device__ __forceinline__ void x_row_to_bf16(const float* xrow, bf16* orow, float* rs_out, int lane) {
    f32x4 v[4]; float ss = 0.f;
#pragma unroll
    for (int j = 0; j < 4; ++j) { v[j] = ((const f32x4*)xrow)[lane + 64 * j]; ss += (v[j].x * v[j].x + v[j].y * v[j].y) + (v[j].z * v[j].z + v[j].w * v[j].w); }
    const float rs = rsqrtf(wave_sum(ss) * (1.f / D) + RMS_EPS), pre = PRESCALE ? rs : 1.0f;
#pragma unroll
    for (int j = 0; j < 4; ++j) { v2u o; o.x = pk2(v[j].x * pre, v[j].y * pre); o.y = pk2(v[j].z * pre, v[j].w * pre); ((v2u*)orow)[lane + 64 * j] = o; }
    if (rs_out && lane == 0) *rs_out = rs;
}
template <bool BASE_BF16, bool OUT_BF16, bool HN_F8 = false>
__device__ __forceinline__ void row_update(const bf16* frow, const void* base, void* outrow, bf16* hnrow, const float* gpost, const float* gnext, float scale, int lane, float* rs_out = nullptr, unsigned* h8row = nullptr) {
    f32x4 f[4], h[4]; float ss = 0.f;
#pragma unroll
    for (int j = 0; j < 4; ++j) { const v2u w = ((const v2u*)frow)[lane + 64 * j]; f[j] = (f32x4){bflo(w.x), bfhi(w.x), bflo(w.y), bfhi(w.y)};
        ss += (f[j].x * f[j].x + f[j].y * f[j].y) + (f[j].z * f[j].z + f[j].w * f[j].w); }
    const float rs = rsqrtf(wave_sum(ss) * (1.f / D) + RMS_EPS) * scale; float s2 = 0.f;
#pragma unroll
    for (int j = 0; j < 4; ++j) { const f32x4 gv = ((const f32x4*)gpost)[lane + 64 * j]; f32x4 bv;
        if (BASE_BF16) { const v2u w = ((const v2u*)base)[lane + 64 * j]; bv = (f32x4){bflo(w.x), bfhi(w.x), bflo(w.y), bfhi(w.y)}; } else bv = ((const f32x4*)base)[lane + 64 * j];
        h[j] = bv + f[j] * rs * gv; s2 += (h[j].x * h[j].x + h[j].y * h[j].y) + (h[j].z * h[j].z + h[j].w * h[j].w); }
    if (h8row) {
#pragma unroll
        for (int j = 0; j < 4; ++j) h8row[lane + 64 * j] = pk4q(4.0f * h[j].x, 4.0f * h[j].y, 4.0f * h[j].z, 4.0f * h[j].w); }
    if (outrow) {
#pragma unroll
        for (int j = 0; j < 4; ++j) { if (OUT_BF16) { v2u o; o.x = pk2(h[j].x, h[j].y); o.y = pk2(h[j].z, h[j].w); ((v2u*)outrow)[lane + 64 * j] = o; } else ((f32x4*)outrow)[lane + 64 * j] = h[j]; } }
    if (hnrow || rs_out) { const float r2 = rsqrtf(wave_sum(s2) * (1.f / D) + RMS_EPS); if (rs_out && lane == 0) *rs_out = r2;
        if (hnrow)
#pragma unroll
        for (int j = 0; j < 4; ++j) { const f32x4 gv = gnext ? ((const f32x4*)gnext)[lane + 64 * j] : (f32x4){1.f, 1.f, 1.f, 1.f};
            if (HN_F8) { const float q = 4.0f * r2; ((unsigned*)hnrow)[lane + 64 * j] = pk4q(h[j].x * q * gv.x, h[j].y * q * gv.y, h[j].z * q * gv.z, h[j].w * q * gv.w); }
            else { v2u o; o.x = pk2(h[j].x * r2 * gv.x, h[j].y * r2 * gv.y); o.y = pk2(h[j].z * r2 * gv.z, h[j].w * r2 * gv.w); ((v2u*)hnrow)[lane + 64 * j] = o; } } }
}

template <bool OUT_BF16, bool HAS_HN8, bool HAS_RS, bool HAS_H8, int NR = 2>
__device__ __forceinline__ void rows_phase(const bf16* F, const bf16* BASE, void* OUT, unsigned char* HN8, const float* gpost, const float* gnext, float scale, float* RS, unsigned char* H8, int gw, int NGW, int lane) {
    f32x4 gp[4], gn[4];
#pragma unroll
    for (int j = 0; j < 4; ++j) { gp[j] = ((const f32x4*)gpost)[lane + 64 * j]; gn[j] = HAS_HN8 ? ((const f32x4*)gnext)[lane + 64 * j] : (f32x4){1.f, 1.f, 1.f, 1.f}; }
    for (int m0 = gw; m0 < R; m0 += NR * NGW) {
        v2u fw[NR][4], bw[NR][4];
#pragma unroll
        for (int t = 0; t < NR; ++t) { const size_t m = (size_t)(m0 + t * NGW);
#pragma unroll
            for (int j = 0; j < 4; ++j) { fw[t][j] = ((const v2u*)(F + m * D))[lane + 64 * j]; bw[t][j] = ((const v2u*)(BASE + m * D))[lane + 64 * j]; } }
#pragma unroll
        for (int t = 0; t < NR; ++t) { const size_t m = (size_t)(m0 + t * NGW);
            f32x4 f[4], h[4]; float ss = 0.f;
#pragma unroll
            for (int j = 0; j < 4; ++j) { f[j] = (f32x4){bflo(fw[t][j].x), bfhi(fw[t][j].x), bflo(fw[t][j].y), bfhi(fw[t][j].y)}; ss += (f[j].x * f[j].x + f[j].y * f[j].y) + (f[j].z * f[j].z + f[j].w * f[j].w); }
            const float rs = rsqrtf(wave_sum(ss) * (1.f / D) + RMS_EPS) * scale; float s2 = 0.f;
#pragma unroll
            for (int j = 0; j < 4; ++j) { const f32x4 bv = (f32x4){bflo(bw[t][j].x), bfhi(bw[t][j].x), bflo(bw[t][j].y), bfhi(bw[t][j].y)};
                h[j] = bv + f[j] * rs * gp[j]; s2 += (h[j].x * h[j].x + h[j].y * h[j].y) + (h[j].z * h[j].z + h[j].w * h[j].w); }
            if (HAS_H8) {
#pragma unroll
                for (int j = 0; j < 4; ++j) ((unsigned*)(H8 + m * D))[lane + 64 * j] = pk4q(4.0f * h[j].x, 4.0f * h[j].y, 4.0f * h[j].z, 4.0f * h[j].w); }
#pragma unroll
            for (int j = 0; j < 4; ++j) { if (OUT_BF16) { v2u o; o.x = pk2(h[j].x, h[j].y); o.y = pk2(h[j].z, h[j].w); ((v2u*)((bf16*)OUT + m * D))[lane + 64 * j] = o; } else ((f32x4*)((float*)OUT + m * D))[lane + 64 * j] = h[j]; }
            if (HAS_HN8 || HAS_RS) { const float r2 = rsqrtf(wave_sum(s2) * (1.f / D) + RMS_EPS); if (HAS_RS && lane == 0) RS[m] = r2;
                if (HAS_HN8) { const float q = 4.0f * r2;
#pragma unroll
                    for (int j = 0; j < 4; ++j) ((unsigned*)(HN8 + m * D))[lane + 64 * j] = pk4q(h[j].x * q * gn[j].x, h[j].y * q * gn[j].y, h[j].z * q * gn[j].z, h[j].w * q * gn[j].w); } } }
    }
}
__device__ __forceinline__ f32x4 meta_tile(const bf16* A, const bf16* B, int K, int lane) {
    const int fr = lane & 15, kq = lane >> 4; const bf16* ap = A + (size_t)fr * K + 8 * kq; const bf16* bp = B + (size_t)fr * K + 8 * kq;
    f32x4 acc = (f32x4){0.f, 0.f, 0.f, 0.f};
#pragma unroll 4
    for (int k = 0; k < K; k += 32) { const bf16x8 a = *(const bf16x8*)(ap + k); const bf16x8 b = *(const bf16x8*)(bp + k); acc = mfma16(a, b, acc); }
    return acc;
}


template <int STEPS>
__device__ __forceinline__ void meta_tile_blk(const bf16* A, const bf16* B0, const bf16* B1, int K, LAS float* red, int wave, int lane, f32x4& c0, f32x4& c1) {
    const int fr = lane & 15, kq = lane >> 4, k0 = wave * (32 * STEPS);
    const bf16* ap = A + (size_t)fr * K + k0 + 8 * kq; const bf16* bp0 = B0 + (size_t)fr * K + k0 + 8 * kq; const bf16* bp1 = (B1 ? B1 : B0) + (size_t)fr * K + k0 + 8 * kq;
    bf16x8 av[STEPS], bv0[STEPS], bv1[STEPS];
#pragma unroll
    for (int i = 0; i < STEPS; ++i) { av[i] = *(const bf16x8*)(ap + 32 * i); bv0[i] = *(const bf16x8*)(bp0 + 32 * i); bv1[i] = *(const bf16x8*)(bp1 + 32 * i); }
    f32x4 a0 = (f32x4){0.f, 0.f, 0.f, 0.f}, a1 = a0;
#pragma unroll
    for (int i = 0; i < STEPS; ++i) { a0 = mfma16(av[i], bv0[i], a0); a1 = mfma16(av[i], bv1[i], a1); }
    *(LAS f32x4*)(red + (wave * 64 + lane) * 8) = a0; *(LAS f32x4*)(red + (wave * 64 + lane) * 8 + 4) = a1;
    __syncthreads();
    c0 = (f32x4){0.f, 0.f, 0.f, 0.f}; c1 = c0;
#pragma unroll
    for (int w2 = 0; w2 < 8; ++w2) { c0 += *(const LAS f32x4*)(red + (w2 * 64 + lane) * 8); c1 += *(const LAS f32x4*)(red + (w2 * 64 + lane) * 8 + 4); }
    __syncthreads();
}


__device__ __forceinline__ void s5_tables_block(const Args& a, int g, int oct, LAS float* sc, int tid) {
    const float* lam_re = a.in[15]; const float* lam_im = a.in[16]; const float* log_dt = a.in[17];
    const float* b_re = a.in[18]; const float* b_im = a.in[19]; const float* c_re = a.in[20]; const float* c_im = a.in[21]; const float* dsk = a.in[22];
    LAS float* CR = sc; LAS float* CI = sc + 1024; LAS float* BR = sc + 2048; LAS float* BI = sc + 3072;
    LAS float* ANG = sc + 4096; LAS float* LRDT = sc + 4160; LAS float* CFR = sc + 4224; LAS float* CFI = sc + 4288;
    LAS float* WR = sc + 4352; LAS float* WI = sc + 4864;
    __syncthreads();
#pragma unroll
    for (int k = 0; k < 2; ++k) { const int e = tid + 512 * k; CR[e] = c_re[g * 1024 + e]; CI[e] = c_im[g * 1024 + e]; BR[e] = b_re[g * 1024 + e]; BI[e] = b_im[g * 1024 + e]; }
    if (tid < 64) { const int p = tid; const float lr = lam_re[g * 64 + p], li = lam_im[g * 64 + p], dt = expf(log_dt[g]);
        const float ang = li * dt, mag = expf(lr * dt); float s1, c1; sincosf(ang, &s1, &c1);
        const float a_re = mag * c1, a_im = mag * s1, den = lr * lr + li * li, nr = a_re - 1.0f, ni = a_im;
        ANG[p] = ang; LRDT[p] = lr * dt; CFR[p] = (nr * lr + ni * li) / den; CFI[p] = (ni * lr - nr * li) / den; }
    __syncthreads();
    const int ti = tid >> 6, p64 = tid & 63, idx0 = 8 * oct;
    { const float n = (float)(idx0 + ti); float sn, cn; sincosf(n * ANG[p64], &sn, &cn); const float mn = expf(n * LRDT[p64]); const float pr = mn * cn, pi = mn * sn;
      WR[tid] = pr * CFR[p64] - pi * CFI[p64]; WI[tid] = pr * CFI[p64] + pi * CFR[p64]; }
    __syncthreads();
#pragma unroll
    for (int k = 0; k < 4; ++k) { const int e = tid + 512 * k, t8 = e >> 8, m = (e >> 4) & 15, mp = e & 15; float s = 0.f;
        for (int p = 0; p < 64; ++p) { const float wr_ = WR[t8 * 64 + p], wi_ = WI[t8 * 64 + p], br = BR[p * 16 + mp], bi = BI[p * 16 + mp];
            const float zr = wr_ * br - wi_ * bi, zi = wr_ * bi + wi_ * br; s += CR[m * 64 + p] * zr - CI[m * 64 + p] * zi; }
        if (idx0 + t8 == 0 && m == mp) s += dsk[g * 16 + m];
        ((bf16*)(a.ws + WS_KI))[((g * 64 + idx0 + t8) * 16 + m) * 16 + mp] = (bf16)f2bf(s); }
    __syncthreads();
    { const float n = (float)(63 - (idx0 + ti)); float sn, cn; sincosf(n * ANG[p64], &sn, &cn); const float mn = expf(n * LRDT[p64]); const float pr = mn * cn, pi = mn * sn;
      WR[tid] = pr * CFR[p64] - pi * CFI[p64]; WI[tid] = pr * CFI[p64] + pi * CFR[p64]; }
    __syncthreads();
    for (int k = 0; k < 32; ++k) { const int e = tid + 512 * k, t8 = e >> 11, n_ = (e >> 4) & 127, mp = e & 15, p = n_ & 63;
        const float wr_ = WR[t8 * 64 + p], wi_ = WI[t8 * 64 + p], br = BR[p * 16 + mp], bi = BI[p * 16 + mp];
        const float zr = wr_ * br - wi_ * bi, zi = wr_ * bi + wi_ * br;
        ((bf16*)(a.ws + WS_KS))[((size_t)(g * 64 + idx0 + t8) * 128 + n_) * 16 + mp] = (bf16)f2bf(n_ < 64 ? zr : zi); }
    __syncthreads();
    { const float n = (float)(idx0 + ti + 1); float sn, cn; sincosf(n * ANG[p64], &sn, &cn); const float mn = expf(n * LRDT[p64]); WR[tid] = mn * cn; WI[tid] = mn * sn; }
    __syncthreads();
    for (int k = 0; k < 32; ++k) { const int e = tid + 512 * k, t8 = e >> 11, m = (e >> 7) & 15, kk = e & 127, p = kk & 63;
        const float cr = CR[m * 64 + p], ci = CI[m * 64 + p], ar_ = WR[t8 * 64 + p], ai_ = WI[t8 * 64 + p];
        const float wr_ = cr * ar_ - ci * ai_, wi_ = cr * ai_ + ci * ar_;
        ((bf16*)(a.ws + WS_KO))[((size_t)(g * 64 + idx0 + t8) * 16 + m) * 128 + kk] = (bf16)f2bf(kk < 64 ? wr_ : -wi_); }
}

constexpr int S5_U = 0, S5_USTR = 2064, S5_KI = 66048, S5_SLOC = 98816, S5_XINB = 115200, S5_XSTR = 272, S5_MISC = 123904;
__device__ __forceinline__ float gelu_tanh(float x) { const float z = 0.7978845608028654f * (x + 0.044715f * x * x * x); return x * fsig(2.0f * z); }
__device__ __forceinline__ void s5_meta(const Args& a, LAS unsigned char* L, int g, int tid) {
    const int lane = tid & 63; const bf16* PMU = (const bf16*)(a.ws + WS_META + MO_PMU); LAS float* MS = (LAS float*)(L + S5_MISC);
    if (tid < 64) { const int p = lane; const float lr = a.in[15][g * 64 + p], li = a.in[16][g * 64 + p], dt = expf(a.in[17][g]);
        const float ang = li * dt, mag = expf(lr * dt); float s1, c1; sincosf(ang, &s1, &c1);
        const float a_re = mag * c1, a_im = mag * s1, den = lr * lr + li * li, nr = a_re - 1.0f, ni = a_im;
        const float cf_re = (nr * lr + ni * li) / den, cf_im = (ni * lr - nr * li) / den;
        float bb_re[16], bb_im[16];
#pragma unroll
        for (int m = 0; m < 16; ++m) { const float br = a.in[18][(g * 64 + p) * 16 + m], bi = a.in[19][(g * 64 + p) * 16 + m]; bb_re[m] = cf_re * br - cf_im * bi; bb_im[m] = cf_re * bi + cf_im * br; }
        LAS bf16* UM = (LAS bf16*)(L + S5_MISC + 1024);
        if (lane < 32) *(LAS v4u*)(UM + lane * 8) = *(const v4u*)(PMU + (lane >> 1) * 512 + 16 * g + 8 * (lane & 1));
        LDS_WAIT();
        float xr = 0.f, xi = 0.f;
#pragma unroll
        for (int i = 0; i < 16; ++i) { float ur = 0.f, ui = 0.f; const v4u w0 = *(const LAS v4u*)(UM + i * 16), w1 = *(const LAS v4u*)(UM + i * 16 + 8);
            const float uu[16] = {bflo(w0.x), bfhi(w0.x), bflo(w0.y), bfhi(w0.y), bflo(w0.z), bfhi(w0.z), bflo(w0.w), bfhi(w0.w), bflo(w1.x), bfhi(w1.x), bflo(w1.y), bfhi(w1.y), bflo(w1.z), bfhi(w1.z), bflo(w1.w), bfhi(w1.w)};
#pragma unroll
            for (int m = 0; m < 16; ++m) { ur += bb_re[m] * uu[m]; ui += bb_im[m] * uu[m]; }
            const float nr2 = a_re * xr - a_im * xi + ur, ni2 = a_re * xi + a_im * xr + ui; xr = nr2; xi = ni2; }
        float s64, c64; sincosf(64.0f * ang, &s64, &c64); const float m64 = expf(64.0f * lr * dt);
        MS[p] = xr; MS[64 + p] = xi; MS[128 + p] = m64 * c64; MS[192 + p] = m64 * s64; }
}
__device__ __forceinline__ void s5_unit(const Args& a, LAS unsigned char* L, int b, int g, int tid) {
    const int lane = tid & 63, w = __builtin_amdgcn_readfirstlane(tid >> 6), fr = lane & 15, kq = lane >> 4;
    const bf16* UA2 = (const bf16*)(a.ws + WS_UA2) + (size_t)(b * 32 + g) * 2048 * 16;
    const bf16* KS = (const bf16*)(a.ws + WS_KS); const bf16* KO = (const bf16*)(a.ws + WS_KO); const bf16* KI = (const bf16*)(a.ws + WS_KI);
    bf16* YA = (bf16*)(a.ws + WS_F);
    LAS float* SLOC = (LAS float*)(L + S5_SLOC); LAS float* MS = (LAS float*)(L + S5_MISC);
    __syncthreads();
#pragma unroll
    for (int k = 0; k < 8; ++k) { const int idx = tid + 512 * k, t = idx >> 1, hf = idx & 1;
        const v4u v = *(const v4u*)(UA2 + (size_t)idx * 8);
        *(LAS v4u*)(L + S5_U + (t >> 6) * S5_USTR + (t & 63) * 32 + 16 * hf) = v; }
#pragma unroll
    for (int k = 0; k < 4; ++k) { const int idx = tid + 512 * k; *(LAS v4u*)(L + S5_KI + idx * 16) = *(const v4u*)(KI + (size_t)g * 16384 + idx * 8); }
    bf16x8 bfr[16];
#pragma unroll
    for (int k = 0; k < 16; ++k) { const int i = 2 * k + (kq >> 1); bfr[k] = *(const bf16x8*)(KS + ((size_t)(g * 64 + i) * 128 + 16 * w + fr) * 16 + 8 * (kq & 1)); }
    __syncthreads();
    { f32x4 acc0 = (f32x4){0.f, 0.f, 0.f, 0.f}, acc1 = acc0;
#pragma unroll
      for (int hb = 0; hb < 2; ++hb) {
          if (hb == 1) {
#pragma unroll
              for (int k = 0; k < 16; ++k) { const int i = 2 * (16 + k) + (kq >> 1); bfr[k] = *(const bf16x8*)(KS + ((size_t)(g * 64 + i) * 128 + 16 * w + fr) * 16 + 8 * (kq & 1)); } }
#pragma unroll
          for (int k = 0; k < 16; ++k) { const int ks = 16 * hb + k;
              const bf16x8 a0 = *(const LAS bf16x8*)(L + S5_U + fr * S5_USTR + (32 * ks + 8 * kq) * 2);
              const bf16x8 a1 = *(const LAS bf16x8*)(L + S5_U + (16 + fr) * S5_USTR + (32 * ks + 8 * kq) * 2);
              acc0 = mfma16(a0, bfr[k], acc0); acc1 = mfma16(a1, bfr[k], acc1); } }
#pragma unroll
      for (int r = 0; r < 4; ++r) { SLOC[(4 * kq + r) * 128 + 16 * w + fr] = acc0[r]; SLOC[(16 + 4 * kq + r) * 128 + 16 * w + fr] = acc1[r]; } }
    bf16x8 ko[4];
#pragma unroll
    for (int ks = 0; ks < 4; ++ks) ko[ks] = *(const bf16x8*)(KO + ((size_t)(g * 64 + w) * 16 + fr) * 128 + 32 * ks + 8 * kq);
    __syncthreads();
    if (w == 0) { const int p = lane; float sr[32], si[32];
#pragma unroll
        for (int c = 0; c < 32; ++c) { sr[c] = SLOC[c * 128 + p]; si[c] = SLOC[c * 128 + 64 + p]; }
        float xr = MS[p], xi = MS[64 + p]; const float ar = MS[128 + p], ai = MS[192 + p];
#pragma unroll
        for (int c = 0; c < 32; ++c) { *(LAS bf16*)(L + S5_XINB + c * S5_XSTR + p * 2) = (bf16)f2bf(xr); *(LAS bf16*)(L + S5_XINB + c * S5_XSTR + (64 + p) * 2) = (bf16)f2bf(xi);
            const float nr2 = ar * xr - ai * xi + sr[c], ni2 = ar * xi + ai * xr + si[c]; xr = nr2; xi = ni2; } }
    __syncthreads();
    for (int jj = 0; jj < 8; ++jj) { const int j = w + 8 * jj;
        bf16x8 kon[4];
#pragma unroll
        for (int ks = 0; ks < 4; ++ks) kon[ks] = ko[ks];
        if (jj < 7) {
#pragma unroll
            for (int ks = 0; ks < 4; ++ks) kon[ks] = *(const bf16x8*)(KO + ((size_t)(g * 64 + j + 8) * 16 + fr) * 128 + 32 * ks + 8 * kq); }
        f32x4 acc0 = (f32x4){0.f, 0.f, 0.f, 0.f}, acc1 = acc0;
#pragma unroll
        for (int ks = 0; ks < 4; ++ks) {
            const bf16x8 a0 = *(const LAS bf16x8*)(L + S5_XINB + fr * S5_XSTR + (32 * ks + 8 * kq) * 2);
            const bf16x8 a1 = *(const LAS bf16x8*)(L + S5_XINB + (16 + fr) * S5_XSTR + (32 * ks + 8 * kq) * 2);
            acc0 = mfma16(a0, ko[ks], acc0); acc1 = mfma16(a1, ko[ks], acc1); }
        const int nks = (j >> 1) + 1;
#pragma unroll 2
        for (int ks = 0; ks < nks; ++ks) { const int i = 2 * ks + (kq >> 1), tau = j - i;
            bf16x8 bq = *(const LAS bf16x8*)(L + S5_KI + (((tau < 0 ? 0 : tau) * 16 + fr) * 16 + 8 * (kq & 1)) * 2);
            if (tau < 0) bq = (bf16x8){0, 0, 0, 0, 0, 0, 0, 0};
            const bf16x8 a0 = *(const LAS bf16x8*)(L + S5_U + fr * S5_USTR + (32 * ks + 8 * kq) * 2);
            const bf16x8 a1 = *(const LAS bf16x8*)(L + S5_U + (16 + fr) * S5_USTR + (32 * ks + 8 * kq) * 2);
            acc0 = mfma16(a0, bq, acc0); acc1 = mfma16(a1, bq, acc1); }
#pragma unroll
        for (int r = 0; r < 4; ++r) { const int c0 = 4 * kq + r, c1 = 16 + 4 * kq + r;
            YA[(size_t)(b * 2048 + 64 * c0 + j) * 512 + 16 * g + fr] = (bf16)f2bf(gelu_tanh(acc0[r]));
            YA[(size_t)(b * 2048 + 64 * c1 + j) * 512 + 16 * g + fr] = (bf16)f2bf(gelu_tanh(acc1[r])); }
#pragma unroll
        for (int ks = 0; ks < 4; ++ks) ko[ks] = kon[ks]; }
}

constexpr int DS_SSTR = 2120, DS_TSTR = 144, DS_BUF = 18432  , DS_BT = 36864  , DS_HIST = 135680, DS_MASK = 143872, DS_RB = 152576, DS_TB = 153600;
typedef short s16x4 __attribute__((ext_vector_type(4)));
__device__ __forceinline__ s16x4 tr_read(unsigned addr) { s16x4 r; asm volatile("ds_read_b64_tr_b16 %0, %1" : "=&v"(r) : "v"(addr) : "memory"); return r; }
__device__ __forceinline__ float relu_i(float x) { const int i = __builtin_bit_cast(int, x); return __builtin_bit_cast(float, i > 0 ? i : 0); }
__device__ __forceinline__ unsigned f16key(float f) { const _Float16 hf = (_Float16)f; const unsigned h = (unsigned)__builtin_bit_cast(unsigned short, hf); return (h & 0x8000u) ? (~h & 0xffffu) : (h | 0x8000u); }
__device__ __forceinline__ unsigned cvtpk(float lo, float hi) { unsigned r; asm volatile("v_cvt_pk_bf16_f32 %0, %1, %2" : "=v"(r) : "v"(lo), "v"(hi)); return r; }
__device__ __forceinline__ void dsa_tables(const Args& a, LAS unsigned char* L, int tid) {
    if (tid < 256) { ((LAS float*)(L + DS_RB))[tid] = a.in[25][tid] * 1.44269504f;
        const int n = tid; const int lo = n < 8 ? n : (n < 12 ? 8 : n < 16 ? 9 : n < 23 ? 10 : n < 32 ? 11 : n < 46 ? 12 : n < 64 ? 13 : n < 91 ? 14 : 15);
        ((LAS int*)(L + DS_TB))[tid] = lo; }
}

__device__ __forceinline__ int wave_incl_scan(int x) {
    int v = x;
    v += __builtin_amdgcn_update_dpp(0, v, 0x111, 0xf, 0xf, false);
    v += __builtin_amdgcn_update_dpp(0, v, 0x112, 0xf, 0xf, false);
    v += __builtin_amdgcn_update_dpp(0, v, 0x114, 0xf, 0xf, false);
    v += __builtin_amdgcn_update_dpp(0, v, 0x118, 0xf, 0xf, false);
    v += __builtin_amdgcn_update_dpp(0, v, 0x142, 0xa, 0xf, false);
    v += __builtin_amdgcn_update_dpp(0, v, 0x143, 0xc, 0xf, false);
    return v;
}
template <int NE>
__device__ __forceinline__ void dsa_select(LAS unsigned char* L, int c, int nt64, int w, int lane) {
    LAS unsigned short* S16 = (LAS unsigned short*)L; LAS unsigned long long* MASK = (LAS unsigned long long*)(L + DS_MASK);
    LAS unsigned* H = (LAS unsigned*)(L + DS_HIST) + w * 256;
    const int rl = 63 - lane;
    for (int qq = 0; qq < 4; ++qq) { const int q = 4 * w + qq; const LAS unsigned short* Sq = S16 + q * DS_SSTR; unsigned tkey = 0u;
        unsigned kr[NE];
#pragma unroll
        for (int e = 0; e < NE; ++e) kr[e] = (unsigned)Sq[64 * e + lane];
        if (c >= 4) { unsigned prefix = 0u; int kth = 256;
#pragma unroll
            for (int pass = 0; pass < 2; ++pass) {
                H[lane] = 0u; H[lane + 64] = 0u; H[lane + 128] = 0u; H[lane + 192] = 0u; LDS_WAIT();
#pragma unroll
                for (int e = 0; e < NE; ++e) { const unsigned key = kr[e]; const bool in = (pass == 0) ? (key != 0u) : ((key >> 8) == prefix);
                    if (in) (void)__hip_atomic_fetch_add(&H[pass == 0 ? (key >> 8) : (key & 255u)], 1u, __ATOMIC_RELAXED, __HIP_MEMORY_SCOPE_WORKGROUP); }
                LDS_WAIT();
                const unsigned h0 = H[4 * rl], h1 = H[4 * rl + 1], h2 = H[4 * rl + 2], h3 = H[4 * rl + 3]; const int t = (int)(h0 + h1 + h2 + h3);
                const int sfx = wave_incl_scan(t), above = sfx - t; const bool has = (above < kth) && (above + t >= kth);
                const unsigned long long bm = __ballot(has); const int src = bm ? (__ffsll((long long)bm) - 1) : 0;
                int cum = above, B; if (cum + (int)h3 >= kth) B = 3; else { cum += (int)h3; if (cum + (int)h2 >= kth) B = 2; else { cum += (int)h2; if (cum + (int)h1 >= kth) B = 1; else { cum += (int)h1; B = 0; } } }
                const int bin = __builtin_amdgcn_readlane(4 * rl + B, src); kth = __builtin_amdgcn_readlane(kth - cum, src);
                prefix = (prefix << 8) | (unsigned)bin; LDS_WAIT(); }
            tkey = prefix; }
        unsigned mlo = 0u, mhi = 0u;
#pragma unroll
        for (int e = 0; e < NE; ++e) { const int s = 64 * e + lane; const bool sel = ((s < 16) || (s >= 64)) && (kr[e] >= tkey);
            const unsigned long long m = __ballot(sel); mlo = (lane == e) ? (unsigned)m : mlo; mhi = (lane == e) ? (unsigned)(m >> 32) : mhi; }
        if (lane < nt64) MASK[q * 34 + lane] = ((unsigned long long)mhi << 32) | mlo; }
}
__device__ __forceinline__ void dsa_unit(const Args& a, LAS unsigned char* L, int b, int uq, int tid) {
    const int lane = tid & 63, w = __builtin_amdgcn_readfirstlane(tid >> 6), fr = lane & 15, kq = lane >> 4;
    const bf16* PA = (const bf16*)(a.ws + WS_PA); const bf16* PK = (const bf16*)(a.ws + WS_PK); const bf16* PMK = (const bf16*)(a.ws + WS_META + MO_PMK);
    bf16* YB = (bf16*)(a.ws + WS_HN) + (size_t)R * 512;
    const int c = 1 + (uq >> 1), nt64 = c + 1, qrow0 = b * 2048 + 32 * uq;
    LAS unsigned short* S16 = (LAS unsigned short*)L; LAS unsigned long long* MASK = (LAS unsigned long long*)(L + DS_MASK);
    const LAS float* RB = (const LAS float*)(L + DS_RB); const LAS int* TB = (const LAS int*)(L + DS_TB);
    __syncthreads();
    { const int qh = w >> 2; bf16x8 qa[4][2][2]; float wv[4][2][4];
#pragma unroll
      for (int p = 0; p < 4; ++p) {
#pragma unroll
          for (int hf = 0; hf < 2; ++hf)
#pragma unroll
              for (int ks = 0; ks < 2; ++ks) qa[p][hf][ks] = *(const bf16x8*)(PA + (size_t)(qrow0 + 16 * qh + 4 * p + (fr >> 2)) * 1024 + (4 * hf + (fr & 3)) * 64 + 32 * ks + 8 * kq);
          const v4u wraw = *(const v4u*)(PK + (size_t)(qrow0 + 16 * qh + 4 * p + kq) * 256 + 192);
          wv[p][0][0] = bflo(wraw.x) * 0.04419417382f; wv[p][0][1] = bfhi(wraw.x) * 0.04419417382f; wv[p][0][2] = bflo(wraw.y) * 0.04419417382f; wv[p][0][3] = bfhi(wraw.y) * 0.04419417382f;
          wv[p][1][0] = bflo(wraw.z) * 0.04419417382f; wv[p][1][1] = bfhi(wraw.z) * 0.04419417382f; wv[p][1][2] = bflo(wraw.w) * 0.04419417382f; wv[p][1][3] = bfhi(wraw.w) * 0.04419417382f; }
      const int nkt = 4 * nt64;
      { const int ner = nt64 <= 9 ? 9 : nt64 <= 17 ? 17 : nt64 <= 25 ? 25 : 33;
        for (int kz = 4 * nt64 + (w & 3); kz < 4 * ner; kz += 4) {
#pragma unroll
            for (int p = 0; p < 4; ++p) S16[(16 * qh + 4 * p + kq) * DS_SSTR + 16 * kz + fr] = (unsigned short)0; } }
      if ((w & 3) != 0) {
#pragma unroll
          for (int p = 0; p < 4; ++p) S16[(16 * qh + 4 * p + kq) * DS_SSTR + 16 * (w & 3) + fr] = (unsigned short)0; }
      int kt = (w & 3) == 0 ? 0 : (w & 3) + 4;
      bf16x8 kb0, kb1, kc0, kc1;
      { const bf16* krow = (kt == 0) ? PMK + fr * 256 : PK + (size_t)(b * 2048 + 16 * kt - 64 + fr) * 256; kb0 = *(const bf16x8*)(krow + 8 * kq); kb1 = *(const bf16x8*)(krow + 32 + 8 * kq); }
      { const int k1 = (kt == 0) ? 4 : kt + 4; kc0 = kb0; kc1 = kb1;
        if (k1 < nkt) { const bf16* krow = PK + (size_t)(b * 2048 + 16 * k1 - 64 + fr) * 256; kc0 = *(const bf16x8*)(krow + 8 * kq); kc1 = *(const bf16x8*)(krow + 32 + 8 * kq); } }
      while (kt < nkt) {
          const int ktn = (kt == 0) ? 4 : kt + 4, ktnn = ktn + 4; bf16x8 nb0 = kc0, nb1 = kc1;
          if (ktnn < nkt) { const bf16* krow = PK + (size_t)(b * 2048 + 16 * ktnn - 64 + fr) * 256; nb0 = *(const bf16x8*)(krow + 8 * kq); nb1 = *(const bf16x8*)(krow + 32 + 8 * kq); }
#pragma unroll
          for (int p = 0; p < 4; ++p) { f32x4 aA = (f32x4){0.f, 0.f, 0.f, 0.f}, aB = aA;
              aA = mfma16(qa[p][0][0], kb0, aA); aB = mfma16(qa[p][1][0], kb0, aB); aA = mfma16(qa[p][0][1], kb1, aA); aB = mfma16(qa[p][1][1], kb1, aB);
              const float v = (relu_i(aA[0]) * wv[p][0][0] + relu_i(aA[1]) * wv[p][0][1]) + (relu_i(aA[2]) * wv[p][0][2] + relu_i(aA[3]) * wv[p][0][3])
                            + (relu_i(aB[0]) * wv[p][1][0] + relu_i(aB[1]) * wv[p][1][1]) + (relu_i(aB[2]) * wv[p][1][2] + relu_i(aB[3]) * wv[p][1][3]);
              S16[(16 * qh + 4 * p + kq) * DS_SSTR + 16 * kt + fr] = (unsigned short)f16key(v); }
          kb0 = kc0; kb1 = kc1; kc0 = nb0; kc1 = nb1; kt = ktn; } }
    __syncthreads();
    bf16x8 qb[2][2]; unsigned mkoff[2];
#pragma unroll
    for (int cg = 0; cg < 2; ++cg) { const int q = 4 * w + 2 * cg + (fr >> 3), h = fr & 7; mkoff[cg] = q * 34;
#pragma unroll
        for (int ks = 0; ks < 2; ++ks) qb[cg][ks] = *(const bf16x8*)(PA + (size_t)(qrow0 + q) * 1024 + 512 + h * 64 + 32 * ks + 8 * kq); }
    const int skey = tid >> 3, spiece = tid & 7;
    v4u kv0 = (v4u){0u, 0u, 0u, 0u}, vv0 = kv0, kv, vv;
    if (skey < 16) { const bf16* krow = PMK + skey * 256; kv0 = *(const v4u*)(krow + 64 + 8 * spiece); vv0 = *(const v4u*)(krow + 128 + 8 * spiece); }
    { const bf16* krow = PK + (size_t)(b * 2048 + skey) * 256; kv = *(const v4u*)(krow + 64 + 8 * spiece); vv = *(const v4u*)(krow + 128 + 8 * spiece); }
    if (nt64 <= 9) dsa_select<9>(L, c, nt64, w, lane);
    else if (nt64 <= 17) dsa_select<17>(L, c, nt64, w, lane);
    else if (nt64 <= 25) dsa_select<25>(L, c, nt64, w, lane);
    else dsa_select<33>(L, c, nt64, w, lane);
    __syncthreads();
    {
      const int hh = fr & 7; const float bfar = RB[15 * 8 + hh];
      float mrun[2] = {0.f, 0.f}, lrun[2] = {0.f, 0.f}; f32x4 O[2][4];
#pragma unroll
      for (int cg = 0; cg < 2; ++cg)
#pragma unroll
          for (int dt = 0; dt < 4; ++dt) O[cg][dt] = (f32x4){0.f, 0.f, 0.f, 0.f};
      const LAS float* BT = (const LAS float*)(L + DS_BT);
#pragma unroll
      for (int k = 0; k < 4; ++k) { const int e = tid + 512 * k, relc = (e >> 3) - 128, n = relc < 0 ? -relc : relc; ((LAS float*)(L + DS_BT))[e] = RB[(TB[n] + (relc > 0 ? 16 : 0)) * 8 + (e & 7)]; }
      const unsigned ldsV = (unsigned)(size_t)(L) + 9216u + (unsigned)((4 * kq + ((lane & 15) >> 2)) * DS_TSTR + 8 * (lane & 3));
      *(LAS v4u*)(L + skey * DS_TSTR + 16 * spiece) = kv0; *(LAS v4u*)(L + 9216 + skey * DS_TSTR + 16 * spiece) = vv0;
      __syncthreads();
      for (int T = 0; T < nt64; ++T) { const int buf = T & 1;
          v4u kn = kv, vn = vv;
          if (T + 2 < nt64) { const bf16* krow = PK + (size_t)(b * 2048 + 64 * (T + 1) + skey) * 256; kn = *(const v4u*)(krow + 64 + 8 * spiece); vn = *(const v4u*)(krow + 128 + 8 * spiece); }
          const bool nearT = (64 * T > 32 * uq - 90);
          f32x4 lg[2][4];
          { bf16x8 ka[4][2];
#pragma unroll
            for (int sub = 0; sub < 4; ++sub)
#pragma unroll
                for (int ks = 0; ks < 2; ++ks) ka[sub][ks] = *(const LAS bf16x8*)(L + buf * DS_BUF + fr * DS_TSTR + 16 * kq + sub * 16 * DS_TSTR + ks * 64);
#pragma unroll
            for (int cg = 0; cg < 2; ++cg)
#pragma unroll
                for (int sub = 0; sub < 4; ++sub) { f32x4 acc = (f32x4){0.f, 0.f, 0.f, 0.f}; acc = mfma16(ka[sub][0], qb[cg][0], acc); acc = mfma16(ka[sub][1], qb[cg][1], acc); lg[cg][sub] = acc; } }
          s16x4 vt[2][4][2];
#pragma unroll
          for (int cg = 0; cg < 2; ++cg) {
              const float mc = mrun[cg]; float mxl = -1.0e30f;
              if (nearT) { const int relb = ((T == 0) ? 0 : 64 * T - 48) + 4 * kq - (16 + 32 * uq + 4 * w + 2 * cg + (fr >> 3));
#pragma unroll
                  for (int sub = 0; sub < 4; ++sub)
#pragma unroll
                      for (int r = 0; r < 4; ++r) { int idx = relb + 16 * sub + r; idx = idx < -128 ? -128 : idx; idx = idx > 127 ? 127 : idx;
                          const float v = lg[cg][sub][r] * 0.18033688f + (BT[(idx + 128) * 8 + hh] - mc); lg[cg][sub][r] = v; mxl = fmaxf(mxl, v); }
              } else { const float bm = bfar - mc;
#pragma unroll
                  for (int sub = 0; sub < 4; ++sub)
#pragma unroll
                      for (int r = 0; r < 4; ++r) { const float v = lg[cg][sub][r] * 0.18033688f + bm; lg[cg][sub][r] = v; mxl = fmaxf(mxl, v); } }
              if (T == 0 || __ballot(mxl > 8.0f) != 0ull) {
                  float mx = mxl; mx = fmaxf(mx, __shfl_xor(mx, 16)); mx = fmaxf(mx, __shfl_xor(mx, 32));
                  const float delta = (T == 0) ? mx : fmaxf(mx, 0.f), sc = __builtin_amdgcn_exp2f(-delta); mrun[cg] = mc + delta; lrun[cg] *= sc;
#pragma unroll
                  for (int dt = 0; dt < 4; ++dt) O[cg][dt] = O[cg][dt] * sc;
#pragma unroll
                  for (int sub = 0; sub < 4; ++sub)
#pragma unroll
                      for (int r = 0; r < 4; ++r) lg[cg][sub][r] -= delta; }
              const unsigned long long mword = MASK[mkoff[cg] + T] >> (4 * kq); const unsigned mlo = (unsigned)mword, mhi = (unsigned)(mword >> 32); float ls = 0.f;
#pragma unroll
              for (int sub = 0; sub < 4; ++sub)
#pragma unroll
                  for (int r = 0; r < 4; ++r) { const int keep = __builtin_amdgcn_sbfe((int)(sub < 2 ? mlo : mhi), 16 * (sub & 1) + r, 1);
                      const float p = __uint_as_float(__float_as_uint(__builtin_amdgcn_exp2f(lg[cg][sub][r])) & (unsigned)keep); ls += p; lg[cg][sub][r] = p; }
              lrun[cg] += ls; }
          { const unsigned vaddr = ldsV + (unsigned)(buf * DS_BUF);
            asm volatile("ds_read_b64_tr_b16 %0, %16 offset:0\n\t"
                "ds_read_b64_tr_b16 %1, %16 offset:2304\n\t"
                "ds_read_b64_tr_b16 %2, %16 offset:32\n\t"
                "ds_read_b64_tr_b16 %3, %16 offset:2336\n\t"
                "ds_read_b64_tr_b16 %4, %16 offset:64\n\t"
                "ds_read_b64_tr_b16 %5, %16 offset:2368\n\t"
                "ds_read_b64_tr_b16 %6, %16 offset:96\n\t"
                "ds_read_b64_tr_b16 %7, %16 offset:2400\n\t"
                "ds_read_b64_tr_b16 %8, %16 offset:4608\n\t"
                "ds_read_b64_tr_b16 %9, %16 offset:6912\n\t"
                "ds_read_b64_tr_b16 %10, %16 offset:4640\n\t"
                "ds_read_b64_tr_b16 %11, %16 offset:6944\n\t"
                "ds_read_b64_tr_b16 %12, %16 offset:4672\n\t"
                "ds_read_b64_tr_b16 %13, %16 offset:6976\n\t"
                "ds_read_b64_tr_b16 %14, %16 offset:4704\n\t"
                "ds_read_b64_tr_b16 %15, %16 offset:7008\n\t"
                "s_waitcnt lgkmcnt(0)"
                : "=&v"(vt[0][0][0]), "=&v"(vt[0][0][1]), "=&v"(vt[0][1][0]), "=&v"(vt[0][1][1]), "=&v"(vt[0][2][0]), "=&v"(vt[0][2][1]), "=&v"(vt[0][3][0]), "=&v"(vt[0][3][1]), "=&v"(vt[1][0][0]), "=&v"(vt[1][0][1]), "=&v"(vt[1][1][0]), "=&v"(vt[1][1][1]), "=&v"(vt[1][2][0]), "=&v"(vt[1][2][1]), "=&v"(vt[1][3][0]), "=&v"(vt[1][3][1])
                : "v"(vaddr) : "memory"); }
#pragma unroll
          for (int ks2 = 0; ks2 < 2; ++ks2) { bf16x8 pb[2];
#pragma unroll
              for (int cg = 0; cg < 2; ++cg) { v4u pw; pw.x = cvtpk(lg[cg][2 * ks2][0], lg[cg][2 * ks2][1]); pw.y = cvtpk(lg[cg][2 * ks2][2], lg[cg][2 * ks2][3]);
                  pw.z = cvtpk(lg[cg][2 * ks2 + 1][0], lg[cg][2 * ks2 + 1][1]); pw.w = cvtpk(lg[cg][2 * ks2 + 1][2], lg[cg][2 * ks2 + 1][3]); pb[cg] = __builtin_bit_cast(bf16x8, pw); }
#pragma unroll
              for (int dt = 0; dt < 4; ++dt) { const bf16x8 va = __builtin_shufflevector(vt[ks2][dt][0], vt[ks2][dt][1], 0, 1, 2, 3, 4, 5, 6, 7);
#pragma unroll
                  for (int cg = 0; cg < 2; ++cg) O[cg][dt] = mfma16(va, pb[cg], O[cg][dt]); } }
          if (T + 1 < nt64) { *(LAS v4u*)(L + (buf ^ 1) * DS_BUF + skey * DS_TSTR + 16 * spiece) = kv; *(LAS v4u*)(L + (buf ^ 1) * DS_BUF + 9216 + skey * DS_TSTR + 16 * spiece) = vv; }
          kv = kn; vv = vn;
          __syncthreads();
      }
#pragma unroll
      for (int cg = 0; cg < 2; ++cg) { float v = lrun[cg]; v += __shfl_xor(v, 16); v += __shfl_xor(v, 32); const float inv = 1.0f / v;
          const int q = 4 * w + 2 * cg + (fr >> 3);
#pragma unroll
          for (int dt = 0; dt < 4; ++dt) { v2u o; o.x = cvtpk(O[cg][dt][0] * inv, O[cg][dt][1] * inv); o.y = cvtpk(O[cg][dt][2] * inv, O[cg][dt][3] * inv);
              *(v2u*)(YB + (size_t)(qrow0 + q) * 512 + hh * 64 + 16 * dt + 4 * kq) = o; } } }
}

__global__ void __launch_bounds__(NWAVES * 64, 2) mk_fwd(Args args) {
    extern __shared__ __attribute__((aligned(16))) unsigned char lds[];
    LAS unsigned char* L = (LAS unsigned char*)lds;
    volatile LAS unsigned* MISC = (volatile LAS unsigned*)(L + MISC_OFF);
    const int tid = threadIdx.x, lane = tid & 63, wave = __builtin_amdgcn_readfirstlane(tid >> 6);
    const int G = gridDim.x, bx = blockIdx.x;
    const int gw = bx * NWAVES + wave, NGW = G * NWAVES;
    unsigned char* ws = args.ws;
    if (tid < 32) MISC[tid] = 0u;
    __syncthreads();
    XcdBarrier bar; bar.bar = (unsigned*)(ws + WS_CTL) + CW_BAR; bar.x = 0; bar.st = nullptr;
    if (!MK_PER_PHASE) bar = xcd_barrier_post((unsigned*)(ws + WS_CTL) + CW_BAR, MISC + 8);
    const int lo = args.ph_lo, hi = args.ph_hi;
#define IN(k) (lo <= (k) && (k) < hi)
#define SEAM(k) do { if (IN(k) && IN((k) + 1)) xcd_barrier(bar); } while (0)
    bf16* WT1 = (bf16*)(ws + WS_WT1); bf16* WT2 = (bf16*)(ws + WS_WT2); bf16* WT3 = (bf16*)(ws + WS_WT3); bf16* WT4 = (bf16*)(ws + WS_WT4); bf16* WT5 = (bf16*)(ws + WS_WT5);
    bf16* WGLU = (bf16*)(ws + WS_WGLU); bf16* WA = (bf16*)(ws + WS_WA); bf16* WB = (bf16*)(ws + WS_WB); bf16* WOUT = (bf16*)(ws + WS_WOUT);
    bf16* HN = (bf16*)(ws + WS_HN); bf16* FB = (bf16*)(ws + WS_F); bf16* ACT = (bf16*)(ws + WS_BIG);
    bf16* PA = (bf16*)(ws + WS_PA); bf16* PG = (bf16*)(ws + WS_PG); bf16* PK = (bf16*)(ws + WS_PK);
    bf16* AM1 = (bf16*)(ws + WS_META + MO_AM1); bf16* ACTM = (bf16*)(ws + WS_META + MO_ACTM); bf16* FM = (bf16*)(ws + WS_META + MO_FM); bf16* AM2 = (bf16*)(ws + WS_META + MO_AM2);
    bf16* PMU = (bf16*)(ws + WS_META + MO_PMU); bf16* PMK = (bf16*)(ws + WS_META + MO_PMK);
    bf16* HB = (bf16*)(ws + WS_HB); float* RS1 = (float*)(ws + WS_META + 524288); float* RS2 = (float*)(ws + WS_META + 655360);
    bf16* YA = FB; bf16* YG = HN; bf16* YB = HN + (size_t)R * 512; bf16* MERGED = PA;
    const float* x = args.in[0]; float* out = args.out;

    if (IN(0)) {
        for (int item = bx; item < 256; item += G) s5_tables_block(args, item >> 3, item & 7, (LAS float*)L, tid);
        __syncthreads();
        LAS float* scr = (LAS float*)(L + wave * 16384);
        { TrDesc da, db; f32x4 wa[8], wb[8];
          int it = gw; bool ha = it < 11520, hb;
          if (ha) { tr_decode(args, ws, it, lane, da); tr_load(da, wa); }
          while (ha) {
              hb = it + NGW < 11520; if (hb) { tr_decode(args, ws, it + NGW, lane, db); tr_load(db, wb); }
              tr_finish(da, wa, scr, lane);
              it += NGW; if (!hb) break;
              ha = it + NGW < 11520; if (ha) { tr_decode(args, ws, it + NGW, lane, da); tr_load(da, wa); }
              tr_finish(db, wb, scr, lane);
              it += NGW; } }
        for (int m0 = gw; m0 < R; m0 += 2 * NGW) {
            f32x4 xv[2][4];
#pragma unroll
            for (int t = 0; t < 2; ++t)
#pragma unroll
                for (int j = 0; j < 4; ++j) xv[t][j] = ((const f32x4*)(x + (size_t)(m0 + t * NGW) * D))[lane + 64 * j];
#pragma unroll
            for (int t = 0; t < 2; ++t) { const size_t m = (size_t)(m0 + t * NGW); float ss = 0.f;
#pragma unroll
                for (int j = 0; j < 4; ++j) { const f32x4 v = xv[t][j]; ss += (v.x * v.x + v.y * v.y) + (v.z * v.z + v.w * v.w); v2u o; o.x = pk2(v.x, v.y); o.y = pk2(v.z, v.w); ((v2u*)(HN + m * D))[lane + 64 * j] = o; }
                const float rs = rsqrtf(wave_sum(ss) * (1.f / D) + RMS_EPS); if (lane == 0) RS1[m] = rs; } }
        if (gw < NMETA) x_row_to_bf16<true>(args.in[1] + (size_t)gw * D, AM1 + (size_t)gw * D, nullptr, lane);
    }
    SEAM(0);
    if (IN(1)) {
        if (bx < 176) { const int j0 = 16 * bx, grow = 256 * (j0 >> 7) + (j0 & 127); f32x4 g4, u4;
            meta_tile_blk<4>(AM1, WT1 + (size_t)grow * D, WT1 + (size_t)(grow + 128) * D, D, (LAS float*)L, wave, lane, g4, u4);
            if (wave == 0) {
#pragma unroll
                for (int r = 0; r < 4; ++r) ACTM[(4 * (lane >> 4) + r) * DFF + j0 + (lane & 15)] = (bf16)f2bf(g4[r] * fsig(g4[r]) * u4[r]); } }
        pg8::Gemm g{HN, WT1, R, 2 * DFF, D}; pg8::StaticOrder S; S.init(R, 2 * DFF, G, bx); pg8::EpiSwiglu E{ACT, DFF, RS1};
        pg8::gemm_phase<pg8::EpiSwiglu, pg8::StaticOrder, PG8_ALIGN, PG8_SP2>(L, g, S, E);
        if (REP_G1 > 1) pg8::gemm_phase<pg8::EpiSwiglu, pg8::StaticOrder, PG8_ALIGN, PG8_SP2>(L, g, S, E);
    }
    SEAM(1);
    if (IN(2)) {
        if (bx < 64) { const int n0 = 16 * bx; f32x4 f4, dummy;
            meta_tile_blk<11>(ACTM, WT2 + (size_t)n0 * DFF, nullptr, DFF, (LAS float*)L, wave, lane, f4, dummy);
            if (wave == 0) {
#pragma unroll
                for (int r = 0; r < 4; ++r) FM[(4 * (lane >> 4) + r) * D + n0 + (lane & 15)] = (bf16)f2bf(f4[r]); } }
        pg8::Gemm g{ACT, WT2, R, D, DFF}; pg8::StaticOrder S; S.init(R, D, G, bx); pg8::EpiPlain E{FB, D};
        pg8::gemm_phase<pg8::EpiPlain, pg8::StaticOrder, PG8_ALIGN, PG8_SP2>(L, g, S, E);
    }
    SEAM(2);
    if (IN(3)) {
        if (gw < NMETA) row_update<false, false>(FM + (size_t)gw * D, args.in[1] + (size_t)gw * D, nullptr, AM2 + (size_t)gw * D, args.in[3], nullptr, 0.5f, lane);
        rows_phase<true, false, true, true>(FB, HN, HB, nullptr, args.in[3], nullptr, 0.5f, RS2, (unsigned char*)(ws + WS_HB8), gw, NGW, lane);
    }
    SEAM(3);
    if (IN(4)) {
        if (bx < 44) { const int n0 = bx < 32 ? 16 * bx : 1536 + 16 * (bx - 32); f32x4 p4, dummy;
            meta_tile_blk<4>(AM2, WT3 + (size_t)n0 * D, nullptr, D, (LAS float*)L, wave, lane, p4, dummy);
            if (wave == 0) {
#pragma unroll
                for (int r = 0; r < 4; ++r) { const int row = 4 * (lane >> 4) + r; if (bx < 32) PMU[row * 512 + n0 + (lane & 15)] = (bf16)f2bf(p4[r]); else PMK[row * 256 + (n0 - 1536) + (lane & 15)] = (bf16)f2bf(p4[r]); } } }
        { pg8::Gemm g{HB, WT3, R, 1792, D}; pg8::ProjOrderA S; S.base.init(R, 1536, G, bx); S.c = bx; pg8::EpiProj E{PA, PK, (bf16*)(ws + WS_UA2), RS2};
          pg8::gemm_phase<pg8::EpiProj, pg8::ProjOrderA, PG8_ALIGN, PG8_SP2>(L, g, S, E); }
        { pg8::Gemm g{(const bf16*)(ws + WS_HB8), (const bf16*)(ws + WS_WT3B), R, 2048, D}; pg8::ProjOrderB S{bx}; pg8::EpiGates8 E{PG, RS2};
          pg8::gemm_phase<pg8::EpiGates8, pg8::ProjOrderB, PG8_ALIGN, PG8_SP2, true>(L, g, S, E); }
    }
    SEAM(4);
    if (IN(5)) {
        { const int v0 = 2 * (bx >> 3), gS = 4 * (bx & 7) + (v0 >> 4);
          s5_meta(args, L, gS, tid);
          for (int rep = 0; rep < REP_S5; ++rep) for (int i = 0; i < 2; ++i) s5_unit(args, L, (v0 + i) & 15, gS, tid); }
        __syncthreads();
        dsa_tables(args, L, tid);
        for (int i = 0; i < 4 * REP_DSA; ++i) { const int up = 4 * (bx >> 3) + (i & 3), u2 = up >> 1, b = 2 * (bx & 7) + (u2 >> 5), xq = u2 & 31; dsa_unit(args, L, b, (up & 1) ? 63 - xq : xq, tid); }
        __syncthreads();
    }
    SEAM(5);
    if (IN(6)) { pg8::Gemm g{YA, WGLU, R, 512, 512}; pg8::StaticOrder S; S.init(R, 512, G, bx); pg8::EpiGlu E{YA, YG};
        pg8::gemm_phase<pg8::EpiGlu, pg8::StaticOrder, PG8_ALIGN, PG8_SP2>(L, g, S, E); }
    SEAM(6);
    if (IN(7)) { pg8::Gemm g{YG, WA, 2 * R, 2048, 512}; pg8::MergeOrder S; S.base.init(R, D, G, bx); pg8::EpiMerge2 E{PG, FB, MERGED};
        pg8::gemm_phase<pg8::EpiMerge2, pg8::MergeOrder, PG8_ALIGN, PG8_SP2>(L, g, S, E); }
    if (IN(7) && IN(9)) xcd_barrier(bar);
    if (IN(9)) { pg8::Gemm g{MERGED, WOUT, R, D, D}; pg8::StaticOrder S; S.init(R, D, G, bx); pg8::EpiPlain E{FB, D};
        pg8::gemm_phase<pg8::EpiPlain, pg8::StaticOrder, PG8_ALIGN, PG8_SP2>(L, g, S, E); }
    SEAM(9);
    if (IN(10)) { rows_phase<true, true, false, false>(FB, HB, HB, (unsigned char*)HN, args.in[5], args.in[6], 1.0f, nullptr, nullptr, gw, NGW, lane); }
    SEAM(10);
    if (IN(11)) { pg8::Gemm g{HN, WT4, R, 2 * DFF, D}; pg8::StaticOrder S; S.init(R, 2 * DFF, G, bx); pg8::EpiSwiglu8 E{(unsigned char*)ACT, DFF, 1.0f / 256.0f, 8.0f};
        pg8::gemm_phase<pg8::EpiSwiglu8, pg8::StaticOrder, PG8_ALIGN, PG8_SP2, true>(L, g, S, E); }
    SEAM(11);
    if (IN(12)) { pg8::Gemm g{ACT, WT5, R, D, DFF}; pg8::StaticOrder S; S.init(R, D, G, bx); pg8::EpiPlainS E{FB, D, 1.0f / 512.0f};
        pg8::gemm_phase<pg8::EpiPlainS, pg8::StaticOrder, PG8_ALIGN, PG8_SP2, true>(L, g, S, E); }
    SEAM(12);
    if (IN(13)) { rows_phase<false, false, false, false>(FB, HB, out, nullptr, args.in[7], nullptr, 0.5f, nullptr, nullptr, gw, NGW, lane); }
#undef IN
#undef SEAM
}

extern "C" void kernel_launch(void* const* d_in, const int* in_sizes, int n_in, void* d_out, int out_size, void* d_ws, size_t ws_size, hipStream_t stream) {
    static int grid = 0;
    if (grid == 0) {
        if (n_in != 28 || out_size != R * D || ws_size < WS_END) { fprintf(stderr, "kernel_launch: unexpected shapes (n_in %d, out %d, ws %zu); nothing launched\n", n_in, out_size, ws_size); grid = -1; return; }
        int dev = 0, cus = 0, per_cu = 0;
        if (hipGetDevice(&dev) != hipSuccess || hipDeviceGetAttribute(&cus, hipDeviceAttributeMultiprocessorCount, dev) != hipSuccess) { grid = -1; return; }
        if (hipFuncSetAttribute((const void*)mk_fwd, hipFuncAttributeMaxDynamicSharedMemorySize, LDS_BYTES) != hipSuccess) { fprintf(stderr, "kernel_launch: hipFuncSetAttribute failed\n"); grid = -1; return; }
        if (hipOccupancyMaxActiveBlocksPerMultiprocessor(&per_cu, (const void*)mk_fwd, NWAVES * 64, LDS_BYTES) != hipSuccess || per_cu < 1) fprintf(stderr, "kernel_launch: note: occupancy query reports %d\n", per_cu);
        (void)hipGetLastError();
        grid = cus;
    }
    if (grid < 0) return;
    if (hipMemsetAsync((char*)d_ws + WS_CTL, 0, CTL_ZERO_BYTES, stream) != hipSuccess) return;
    Args a{};
    for (int i = 0; i < 28; ++i) a.in[i] = (const float*)d_in[i];
    a.out = (float*)d_out; a.ws = (unsigned char*)d_ws;
#if MK_PER_PHASE
    for (int ph = 0; ph < NPH; ++ph) { a.ph_lo = ph; a.ph_hi = ph + 1; hipLaunchKernelGGL(mk_fwd, dim3(grid), dim3(NWAVES * 64), LDS_BYTES, stream, a); }
#else
    a.ph_lo = 0; a.ph_hi = NPH;
    hipLaunchKernelGGL(mk_fwd, dim3(grid), dim3(NWAVES * 64), LDS_BYTES, stream, a);
#endif
}
```

```cpp
#include <hip/hip_runtime.h>
#include <cstdio>
#include <cstdint>
namespace pg8 {
#define PG8_LAS __attribute__((address_space(3)))
typedef unsigned short bf16_t;
typedef short bf16x8 __attribute__((ext_vector_type(8)));
typedef float f32x4 __attribute__((ext_vector_type(4)));
typedef unsigned u32x4 __attribute__((ext_vector_type(4)));
constexpr int BM = 256, BK = 64, HALF = 128, HTB = HALF * BK * 2  , STAGE_BYTES = 8 * HTB, NXCD = 8, WGM = 8;

__host__ __device__ __forceinline__ int lds_byte(int r, int c) { const int st = (r >> 4) * 2 + (c >> 5), rr = r & 15, cc = c & 31, ob = rr * 64 + cc * 2; return st * 1024 + (ob ^ (((ob >> 9) & 1) << 5)); }
__host__ __device__ __forceinline__ void stage_rc(int b, int& R, int& C) { const int st = b / 1024, sb = b % 1024, swz = sb ^ (((sb >> 9) & 1) << 5); R = (st >> 1) * 16 + swz / 64; C = (st & 1) * 32 + (swz % 64) / 2; }
__host__ __device__ __forceinline__ int perm32(int rho) { const int n = rho >> 4, i = rho & 15; return 8 * (i >> 2) + 4 * n + (i & 3); }

struct Unit { int pm, pn; };
struct Gemm { const bf16_t* A; const bf16_t* Bt; int M, N, K; };

struct StaticOrder {
    int nM, nN, nwg, G, c;
    __host__ __device__ void init(int M, int N, int G_, int c_) { nM = M / BM; nN = N / BM; nwg = nM * nN; G = G_; c = c_; }
    __host__ __device__ bool next(int i, Unit& u) const {
        const long L = (long)i * G + c; if (L >= nwg) return false;
        int wgid = (int)L; { const int q = nwg / NXCD, r = nwg % NXCD, xcd = wgid % NXCD, off = wgid / NXCD; wgid = (xcd < r ? xcd * (q + 1) : r * (q + 1) + (xcd - r) * q) + off; }
        const int nig = WGM * nN, gid = wgid / nig, fm = gid * WGM, gsz = (nM - fm) < WGM ? (nM - fm) : WGM;
        u.pm = fm + ((wgid % nig) % gsz); u.pn = (wgid % nig) / gsz; return true;
    }
    __device__ __forceinline__ void a_ready(const Unit&) const {}
    __device__ __forceinline__ void done(const Unit&) const {}
};
__device__ __forceinline__ unsigned cvt_pk_bf16(float lo, float hi) { unsigned r; asm volatile("v_cvt_pk_bf16_f32 %0, %1, %2" : "=v"(r) : "v"(lo), "v"(hi)); return r; }
__device__ __forceinline__ float fsigmoid(float x) { return __builtin_amdgcn_rcpf(1.0f + __expf(-x)); }
__device__ __forceinline__ float bf_lo(unsigned w) { return __uint_as_float(w << 16); }
__device__ __forceinline__ float bf_hi(unsigned w) { return __uint_as_float(w & 0xffff0000u); }
__device__ __forceinline__ u32x4 pack8(const f32x4 v0, const f32x4 v1) { u32x4 w; w.x = cvt_pk_bf16(v0[0], v0[1]); w.y = cvt_pk_bf16(v0[2], v0[3]); w.z = cvt_pk_bf16(v1[0], v1[1]); w.w = cvt_pk_bf16(v1[2], v1[3]); return w; }
__device__ __forceinline__ void unpack8(const u32x4 w, f32x4& v0, f32x4& v1) { v0 = (f32x4){bf_lo(w.x), bf_hi(w.x), bf_lo(w.y), bf_hi(w.y)}; v1 = (f32x4){bf_lo(w.z), bf_hi(w.z), bf_lo(w.w), bf_hi(w.w)}; }

struct EpiSwiglu {
    static constexpr bool PERM = true, AFTER_DRAIN = false;
    bf16_t* O; int ldc; const float* rs;
    __device__ __forceinline__ void operator()(const f32x4 (&acc)[2][2][4][2], const Unit& u, int wr, int wc, int fr, int fq) const {
        const int row0 = u.pm * BM + wr * 64 + fr, col0 = u.pn * HALF + wc * 32 + 8 * fq;
#pragma unroll
        for (int ai = 0; ai < 2; ++ai)
#pragma unroll
            for (int m = 0; m < 4; ++m) { bf16_t* rowp = O + (size_t)(row0 + ai * HALF + m * 16) * ldc + col0; const float rsc = rs[row0 + ai * HALF + m * 16];
                f32x4 v0, v1;
#pragma unroll
                for (int j = 0; j < 4; ++j) { const float a0 = acc[ai][0][m][0][j], a1 = acc[ai][0][m][1][j], k1 = -1.44269504f * rsc, k2 = rsc * rsc;
                    v0[j] = (a0 * acc[ai][1][m][0][j]) * __builtin_amdgcn_rcpf(1.0f + __builtin_amdgcn_exp2f(a0 * k1)) * k2; v1[j] = (a1 * acc[ai][1][m][1][j]) * __builtin_amdgcn_rcpf(1.0f + __builtin_amdgcn_exp2f(a1 * k1)) * k2; }
                *(u32x4*)rowp = pack8(v0, v1); }
    }
};
struct EpiPlain {
    static constexpr bool PERM = true, AFTER_DRAIN = false;
    bf16_t* O; int ldc;
    __device__ __forceinline__ void operator()(const f32x4 (&acc)[2][2][4][2], const Unit& u, int wr, int wc, int fr, int fq) const {
        const int row0 = u.pm * BM + wr * 64 + fr, col0 = u.pn * BM + wc * 32 + 8 * fq;
#pragma unroll
        for (int ai = 0; ai < 2; ++ai)
#pragma unroll
            for (int m = 0; m < 4; ++m) { bf16_t* rowp = O + (size_t)(row0 + ai * HALF + m * 16) * ldc + col0;
#pragma unroll
                for (int bj = 0; bj < 2; ++bj) *(u32x4*)(rowp + bj * HALF) = pack8(acc[ai][bj][m][0], acc[ai][bj][m][1]); }
    }
};

__device__ __forceinline__ unsigned pk4_fp8(float a, float b, float c, float d) { int w = 0; w = __builtin_amdgcn_cvt_pk_fp8_f32(__builtin_amdgcn_fmed3f(a, -448.f, 448.f), __builtin_amdgcn_fmed3f(b, -448.f, 448.f), w, false);
    w = __builtin_amdgcn_cvt_pk_fp8_f32(__builtin_amdgcn_fmed3f(c, -448.f, 448.f), __builtin_amdgcn_fmed3f(d, -448.f, 448.f), w, true); return (unsigned)w; }
struct EpiSwiglu8 {
    static constexpr bool PERM = true, AFTER_DRAIN = false;
    unsigned char* O; int ldc; float ascale, oscale;
    __device__ __forceinline__ void operator()(const f32x4 (&acc)[2][2][4][2], const Unit& u, int wr, int wc, int fr, int fq) const {
        const int row0 = u.pm * BM + wr * 64 + fr, col0 = u.pn * HALF + wc * 32 + 8 * fq;
#pragma unroll
        for (int ai = 0; ai < 2; ++ai)
#pragma unroll
            for (int m = 0; m < 4; ++m) { unsigned char* rowp = O + (size_t)(row0 + ai * HALF + m * 16) * ldc + col0;
                f32x4 v0, v1;
#pragma unroll
                for (int j = 0; j < 4; ++j) { const float a0 = acc[ai][0][m][0][j], a1 = acc[ai][0][m][1][j], k1 = -1.44269504f * ascale, k2 = ascale * ascale * oscale;
                    v0[j] = (a0 * acc[ai][1][m][0][j]) * __builtin_amdgcn_rcpf(1.0f + __builtin_amdgcn_exp2f(a0 * k1)) * k2; v1[j] = (a1 * acc[ai][1][m][1][j]) * __builtin_amdgcn_rcpf(1.0f + __builtin_amdgcn_exp2f(a1 * k1)) * k2; }
                typedef unsigned u32x2 __attribute__((ext_vector_type(2))); u32x2 w; w.x = pk4_fp8(v0[0], v0[1], v0[2], v0[3]); w.y = pk4_fp8(v1[0], v1[1], v1[2], v1[3]);
                *(u32x2*)rowp = w; }
    }
};
struct EpiPlainS {
    static constexpr bool PERM = true, AFTER_DRAIN = false;
    bf16_t* O; int ldc; float scale;
    __device__ __forceinline__ void operator()(const f32x4 (&acc)[2][2][4][2], const Unit& u, int wr, int wc, int fr, int fq) const {
        const int row0 = u.pm * BM + wr * 64 + fr, col0 = u.pn * BM + wc * 32 + 8 * fq;
#pragma unroll
        for (int ai = 0; ai < 2; ++ai)
#pragma unroll
            for (int m = 0; m < 4; ++m) { bf16_t* rowp = O + (size_t)(row0 + ai * HALF + m * 16) * ldc + col0;
#pragma unroll
                for (int bj = 0; bj < 2; ++bj) *(u32x4*)(rowp + bj * HALF) = pack8(acc[ai][bj][m][0] * scale, acc[ai][bj][m][1] * scale); }
    }
};
struct EpiProj {
    static constexpr bool PERM = true, AFTER_DRAIN = false;
    bf16_t *PA, *PK, *UA2; const float* rs;
    __device__ __forceinline__ void operator()(const f32x4 (&acc)[2][2][4][2], const Unit& u, int wr, int wc, int fr, int fq) const {
        if (u.pn < 2) {
#pragma unroll
            for (int ai = 0; ai < 2; ++ai)
#pragma unroll
                for (int m = 0; m < 4; ++m) { const int row = u.pm * BM + wr * 64 + fr + ai * HALF + m * 16, bb = row >> 11, t = row & 2047; const float rsc = rs[row];
#pragma unroll
                    for (int bj = 0; bj < 2; ++bj) { const int col = 256 * u.pn + 128 * bj + wc * 32 + 8 * fq;
                        *(u32x4*)(UA2 + ((size_t)((bb * 32 + (col >> 4)) * 2048 + t)) * 16 + (col & 8)) = pack8(acc[ai][bj][m][0] * rsc, acc[ai][bj][m][1] * rsc); } }
            return; }
        bf16_t* base; int ldc, colt;
        if (u.pn < 6) { base = PA; ldc = 1024; colt = 256 * (u.pn - 2); } else { base = PK; ldc = 256; colt = 0; }
        const int row0 = u.pm * BM + wr * 64 + fr, col0 = colt + wc * 32 + 8 * fq;
#pragma unroll
        for (int ai = 0; ai < 2; ++ai)
#pragma unroll
            for (int m = 0; m < 4; ++m) { bf16_t* rowp = base + (size_t)(row0 + ai * HALF + m * 16) * ldc + col0; const float rsc = rs[row0 + ai * HALF + m * 16];
#pragma unroll
                for (int bj = 0; bj < 2; ++bj) *(u32x4*)(rowp + bj * HALF) = pack8(acc[ai][bj][m][0] * rsc, acc[ai][bj][m][1] * rsc); }
    }
};
struct EpiGates8 {
    static constexpr bool PERM = true, AFTER_DRAIN = false;
    bf16_t* PG; const float* rs;
    __device__ __forceinline__ void operator()(const f32x4 (&acc)[2][2][4][2], const Unit& u, int wr, int wc, int fr, int fq) const {
        const int row0 = u.pm * BM + wr * 64 + fr, col0 = u.pn * BM + wc * 32 + 8 * fq;
#pragma unroll
        for (int ai = 0; ai < 2; ++ai)
#pragma unroll
            for (int m = 0; m < 4; ++m) { bf16_t* rowp = PG + (size_t)(row0 + ai * HALF + m * 16) * 2048 + col0; const float rsc = rs[row0 + ai * HALF + m * 16] * (1.0f / 256.0f);
#pragma unroll
                for (int bj = 0; bj < 2; ++bj) *(u32x4*)(rowp + bj * HALF) = pack8(acc[ai][bj][m][0] * rsc, acc[ai][bj][m][1] * rsc); }
    }
};
struct ProjOrderA {
    StaticOrder base; int c;
    __device__ __forceinline__ bool next(int i, Unit& u) const { if (i < 3) return base.next(i, u); if (i == 3 && c < 128) { u.pm = c; u.pn = 6; return true; } return false; }
    __device__ __forceinline__ void a_ready(const Unit&) const {}
    __device__ __forceinline__ void done(const Unit&) const {}
};
struct ProjOrderB {
    int c;
    __device__ __forceinline__ bool next(int i, Unit& u) const {
        int Lx; if (c < 128) { if (i >= 3) return false; Lx = c + 128 * i; } else { if (i >= 5) return false; Lx = 384 + (c - 128) + 128 * i; }
        const int wgid = (Lx % NXCD) * 128 + Lx / NXCD, nig = WGM * 8;
        u.pm = (wgid / nig) * WGM + (wgid % nig) % WGM; u.pn = (wgid % nig) / WGM; return true; }
    __device__ __forceinline__ void a_ready(const Unit&) const {}
    __device__ __forceinline__ void done(const Unit&) const {}
};
struct EpiGlu {
    static constexpr bool PERM = true, AFTER_DRAIN = false;
    const bf16_t* Y; bf16_t* O;
    __device__ __forceinline__ void operator()(const f32x4 (&acc)[2][2][4][2], const Unit& u, int wr, int wc, int fr, int fq) const {
        const int row0 = u.pm * BM + wr * 64 + fr, col0 = u.pn * BM + wc * 32 + 8 * fq;
#pragma unroll
        for (int ai = 0; ai < 2; ++ai)
#pragma unroll
            for (int m = 0; m < 4; ++m) { const size_t off = (size_t)(row0 + ai * HALF + m * 16) * 512 + col0;
#pragma unroll
                for (int bj = 0; bj < 2; ++bj) { f32x4 y0, y1; unpack8(*(const u32x4*)(Y + off + bj * HALF), y0, y1); f32x4 v0, v1;
#pragma unroll
                    for (int j = 0; j < 4; ++j) { v0[j] = y0[j] * fsigmoid(acc[ai][bj][m][0][j]); v1[j] = y1[j] * fsigmoid(acc[ai][bj][m][1][j]); }
                    *(u32x4*)(O + off + bj * HALF) = pack8(v0, v1); } }
    }
};
template <bool SECOND> struct EpiMerge {
    static constexpr bool PERM = true, AFTER_DRAIN = false;
    const bf16_t* G; int goff; const bf16_t* T; bf16_t* O;
    __device__ __forceinline__ void operator()(const f32x4 (&acc)[2][2][4][2], const Unit& u, int wr, int wc, int fr, int fq) const {
        const int row0 = u.pm * BM + wr * 64 + fr, col0 = u.pn * BM + wc * 32 + 8 * fq;
#pragma unroll
        for (int ai = 0; ai < 2; ++ai)
#pragma unroll
            for (int m = 0; m < 4; ++m) { const size_t row = (size_t)(row0 + ai * HALF + m * 16);
#pragma unroll
                for (int bj = 0; bj < 2; ++bj) { const int col = col0 + bj * HALF; f32x4 g0, g1; unpack8(*(const u32x4*)(G + row * 2048 + goff + col), g0, g1);
                    f32x4 t0 = (f32x4){0.f, 0.f, 0.f, 0.f}, t1 = t0; if (SECOND) unpack8(*(const u32x4*)(T + row * 1024 + col), t0, t1);
                    f32x4 v0, v1;
#pragma unroll
                    for (int j = 0; j < 4; ++j) { v0[j] = t0[j] + fsigmoid(g0[j]) * acc[ai][bj][m][0][j]; v1[j] = t1[j] + fsigmoid(g1[j]) * acc[ai][bj][m][1][j]; }
                    *(u32x4*)(O + row * 1024 + col) = pack8(v0, v1); } }
    }
};

struct MergeOrder {
    StaticOrder base;
    __device__ __forceinline__ bool next(int i, Unit& u) const { if (i >= 4) return false; if (!base.next(i & 1, u)) return false; if (i >= 2) { u.pm += 128; u.pn += 4; } return true; }
    __device__ __forceinline__ void a_ready(const Unit&) const {}
    __device__ __forceinline__ void done(const Unit&) const {}
};
struct EpiMerge2 {
    static constexpr bool PERM = true, AFTER_DRAIN = false;
    const bf16_t* G; bf16_t* T; bf16_t* O;
    __device__ __forceinline__ void operator()(const f32x4 (&acc)[2][2][4][2], const Unit& u, int wr, int wc, int fr, int fq) const {
        const bool second = u.pm >= 128; const int pm = second ? u.pm - 128 : u.pm, pn = second ? u.pn - 4 : u.pn, goff = second ? 1024 : 0;
        const int row0 = pm * BM + wr * 64 + fr, col0 = pn * BM + wc * 32 + 8 * fq;
#pragma unroll
        for (int ai = 0; ai < 2; ++ai)
#pragma unroll
            for (int m = 0; m < 4; ++m) { const size_t row = (size_t)(row0 + ai * HALF + m * 16);
#pragma unroll
                for (int bj = 0; bj < 2; ++bj) { const int col = col0 + bj * HALF; f32x4 g0, g1; unpack8(*(const u32x4*)(G + row * 2048 + goff + col), g0, g1);
                    f32x4 t0 = (f32x4){0.f, 0.f, 0.f, 0.f}, t1 = t0; if (second) unpack8(*(const u32x4*)(T + row * 1024 + col), t0, t1);
                    f32x4 v0, v1;
#pragma unroll
                    for (int j = 0; j < 4; ++j) { v0[j] = t0[j] + fsigmoid(g0[j]) * acc[ai][bj][m][0][j]; v1[j] = t1[j] + fsigmoid(g1[j]) * acc[ai][bj][m][1][j]; }
                    *(u32x4*)((second ? O : T) + row * 1024 + col) = pack8(v0, v1); } }
    }
};
typedef int i32x8 __attribute__((ext_vector_type(8)));
typedef int i32x4v __attribute__((ext_vector_type(4)));
__device__ __forceinline__ i32x8 cat8(const bf16x8 lo, const bf16x8 hi) { const i32x4v a = __builtin_bit_cast(i32x4v, lo), b = __builtin_bit_cast(i32x4v, hi); return __builtin_shufflevector(a, b, 0, 1, 2, 3, 4, 5, 6, 7); }
template <class Epi, class Sched, bool ALIGN_EPI = false, bool SP2 = false, bool F8 = false>
__device__ __forceinline__ void gemm_phase(PG8_LAS unsigned char* lds, const Gemm g, const Sched& S, const Epi& E) {
    const int tid = threadIdx.x, wid = __builtin_amdgcn_readfirstlane(tid >> 6), lane = tid & 63, wr = wid >> 2, wc = wid & 3, fr = lane & 15, fq = lane >> 4;
    const int K = g.K, KB = F8 ? K : 2 * K  , nt = KB / 128;
    unsigned voffA[2], voffB[2];
#pragma unroll
    for (int i = 0; i < 2; ++i) { int R, C; stage_rc(tid * 16 + i * 8192, R, C); const int Rb = Epi::PERM ? ((R & ~31) + perm32(R & 31)) : R;
        voffA[i] = (unsigned)(R * KB + C * 2); voffB[i] = (unsigned)(Rb * KB + C * 2); }
    const size_t kstep = (size_t)(BK * 2);
    const size_t hstep = (size_t)HALF * KB;
    const size_t tstep = 2 * hstep;
    const unsigned ldsw = (unsigned)wid * 1024u;
    const int aoff = lds_byte(wr * 64 + fr, fq * 8), boff = lds_byte(wc * 32 + fr, fq * 8);
#define PG8_SA(b, h) (((b) * 2 + (h)) * HTB)
#define PG8_SB(b, h) ((4 + (b) * 2 + (h)) * HTB)
#define PG8_STAGE(bufoff, gbase, voff) do { _Pragma("unroll") for (int _i = 0; _i < 2; ++_i) \
        __builtin_amdgcn_global_load_lds((const unsigned*)((const char*)(gbase) + (voff)[_i]), (PG8_LAS unsigned*)(lds + (bufoff) + ldsw + _i * 8192), 16, 0, 0); } while (0)
#define PG8_LDA(dst, b, h) do { if constexpr (F8) { _Pragma("unroll") for (int m = 0; m < 4; ++m) dst##8[m] = cat8(*(const PG8_LAS bf16x8*)(lds + PG8_SA(b, h) + aoff + m * 2048), *(const PG8_LAS bf16x8*)(lds + PG8_SA(b, h) + aoff + m * 2048 + 1024)); } else { \
        _Pragma("unroll") for (int m = 0; m < 4; ++m) _Pragma("unroll") for (int k = 0; k < 2; ++k) dst[m][k] = *(const PG8_LAS bf16x8*)(lds + PG8_SA(b, h) + aoff + m * 2048 + k * 1024); } } while (0)
#define PG8_LDB(dst, b, h) do { if constexpr (F8) { _Pragma("unroll") for (int n = 0; n < 2; ++n) dst##8[n] = cat8(*(const PG8_LAS bf16x8*)(lds + PG8_SB(b, h) + boff + n * 2048), *(const PG8_LAS bf16x8*)(lds + PG8_SB(b, h) + boff + n * 2048 + 1024)); } else { \
        _Pragma("unroll") for (int n = 0; n < 2; ++n) _Pragma("unroll") for (int k = 0; k < 2; ++k) dst[n][k] = *(const PG8_LAS bf16x8*)(lds + PG8_SB(b, h) + boff + n * 2048 + k * 1024); } } while (0)
#define PG8_MMA(ai, bj, At, Bt) do { __builtin_amdgcn_s_setprio(1); if constexpr (F8) { _Pragma("unroll") for (int m = 0; m < 4; ++m) _Pragma("unroll") for (int n = 0; n < 2; ++n) \
        acc[ai][bj][m][n] = __builtin_amdgcn_mfma_scale_f32_16x16x128_f8f6f4(Bt##8[n], At##8[m], acc[ai][bj][m][n], 0, 0, 0, 0x7F7F7F7F, 0, 0x7F7F7F7F); \
        _Pragma("unroll") for (int m = 0; m < 4; ++m) _Pragma("unroll") for (int n = 0; n < 2; ++n) asm volatile("" : "+v"(acc[ai][bj][m][n])); } else { \
        _Pragma("unroll") for (int m = 0; m < 4; ++m) _Pragma("unroll") for (int n = 0; n < 2; ++n) _Pragma("unroll") for (int k = 0; k < 2; ++k) \
        acc[ai][bj][m][n] = __builtin_amdgcn_mfma_f32_16x16x32_bf16(Bt[n][k], At[m][k], acc[ai][bj][m][n], 0, 0, 0); } __builtin_amdgcn_s_setprio(0); } while (0)
#define PG8_WAIT_V(n) asm volatile("s_waitcnt vmcnt(" #n ")" ::: "memory")
#define PG8_WAIT_L(n) asm volatile("s_waitcnt lgkmcnt(" #n ")" ::: "memory")
#define PG8_BAR __builtin_amdgcn_s_barrier()
#define PG8_SCHED __builtin_amdgcn_sched_barrier(0)
    Unit cur, nxt; int ui = 0;
    if (!S.next(0, cur)) return;
    f32x4 acc[2][2][4][2];
#pragma unroll
    for (int a = 0; a < 2; ++a)
#pragma unroll
        for (int b = 0; b < 2; ++b)
#pragma unroll
            for (int m = 0; m < 4; ++m)
#pragma unroll
                for (int n = 0; n < 2; ++n) acc[a][b][m][n] = (f32x4){0.f, 0.f, 0.f, 0.f};
    bf16x8 At[4][2], B0[2][2], B1[2][2]; i32x8 At8[4], B08[2], B18[2];
    const char* cA = (const char*)g.A + (size_t)cur.pm * tstep; const char* cB = (const char*)g.Bt + (size_t)cur.pn * tstep;
    S.a_ready(cur);
    if constexpr (SP2) {
        PG8_STAGE(PG8_SB(0, 0), cB, voffB); PG8_STAGE(PG8_SB(0, 1), cB + hstep, voffB); PG8_STAGE(PG8_SA(0, 0), cA, voffA); PG8_STAGE(PG8_SA(0, 1), cA + hstep, voffA);
        if (wr == 1) PG8_BAR;
        PG8_WAIT_V(2); PG8_BAR;
        PG8_STAGE(PG8_SB(1, 0), cB + kstep, voffB); PG8_STAGE(PG8_SA(1, 0), cA + kstep, voffA); PG8_STAGE(PG8_SB(1, 1), cB + hstep + kstep, voffB);
        PG8_WAIT_V(6); PG8_BAR;
    } else {
        PG8_STAGE(PG8_SB(0, 0), cB, voffB); PG8_STAGE(PG8_SA(0, 0), cA, voffA); PG8_STAGE(PG8_SB(0, 1), cB + hstep, voffB); PG8_STAGE(PG8_SA(0, 1), cA + hstep, voffA);
        if (wr == 1) PG8_BAR;
        PG8_WAIT_V(4); PG8_BAR;
        PG8_STAGE(PG8_SB(1, 0), cB + kstep, voffB); PG8_STAGE(PG8_SA(1, 0), cA + kstep, voffA); PG8_STAGE(PG8_SB(1, 1), cB + hstep + kstep, voffB);
        PG8_WAIT_V(6); PG8_BAR;
    }
    for (;;) {
        const bool has_next = S.next(ui + 1, nxt);
        const char* nA = has_next ? (const char*)g.A + (size_t)nxt.pm * tstep : cA; const char* nB = has_next ? (const char*)g.Bt + (size_t)nxt.pn * tstep : cB;
        for (int t = 0; t < nt; t += 2) {
            const bool last = (t == nt - 2);
            const char* a1 = cA + (size_t)(t + 1) * kstep;
            const char* a2 = last ? nA : cA + (size_t)(t + 2) * kstep; const char* b2 = last ? nB : cB + (size_t)(t + 2) * kstep;
            const char* a3 = a2 + kstep; const char* b3 = b2 + kstep;
            if (last && has_next) S.a_ready(nxt);
            if constexpr (SP2) {
            PG8_LDB(B0, 0, 0); PG8_LDB(B1, 0, 1); PG8_SCHED; PG8_LDA(At, 0, 0); PG8_STAGE(PG8_SA(1, 1), a1 + hstep, voffA);
            PG8_WAIT_V(8); PG8_WAIT_L(0); PG8_BAR; PG8_MMA(0, 0, At, B0); PG8_MMA(0, 1, At, B1); PG8_BAR; PG8_SCHED;
            PG8_LDA(At, 0, 1); PG8_STAGE(PG8_SB(0, 0), b2, voffB); PG8_STAGE(PG8_SB(0, 1), b2 + hstep, voffB); PG8_STAGE(PG8_SA(0, 0), a2, voffA);
            PG8_WAIT_V(8); PG8_WAIT_L(0); PG8_BAR; PG8_MMA(1, 0, At, B0); PG8_MMA(1, 1, At, B1); PG8_BAR; PG8_SCHED;
            PG8_LDB(B0, 1, 0); PG8_LDB(B1, 1, 1); PG8_SCHED; PG8_LDA(At, 1, 0); PG8_STAGE(PG8_SA(0, 1), a2 + hstep, voffA);
            PG8_WAIT_V(8); PG8_WAIT_L(0); PG8_BAR; PG8_MMA(0, 0, At, B0); PG8_MMA(0, 1, At, B1); PG8_BAR; PG8_SCHED;
            PG8_LDA(At, 1, 1); PG8_STAGE(PG8_SB(1, 0), b3, voffB); PG8_STAGE(PG8_SB(1, 1), b3 + hstep, voffB); PG8_STAGE(PG8_SA(1, 0), a3, voffA);
            PG8_WAIT_V(8); PG8_WAIT_L(0); PG8_BAR; PG8_MMA(1, 0, At, B0); PG8_MMA(1, 1, At, B1); PG8_BAR; PG8_SCHED;
            } else {
            PG8_LDB(B0, 0, 0); PG8_SCHED; PG8_LDA(At, 0, 0); PG8_STAGE(PG8_SA(1, 1), a1 + hstep, voffA);
            PG8_WAIT_L(8); PG8_BAR; PG8_WAIT_L(0); PG8_MMA(0, 0, At, B0); PG8_BAR; PG8_SCHED;
            PG8_LDB(B1, 0, 1); PG8_STAGE(PG8_SB(0, 0), b2, voffB);
            PG8_BAR; PG8_WAIT_L(0); PG8_MMA(0, 1, At, B1); PG8_BAR;
            PG8_LDA(At, 0, 1); PG8_STAGE(PG8_SA(0, 0), a2, voffA);
            PG8_BAR; PG8_WAIT_L(0); PG8_MMA(1, 0, At, B0); PG8_BAR; PG8_SCHED;
            PG8_STAGE(PG8_SB(0, 1), b2 + hstep, voffB);
            PG8_WAIT_V(6); PG8_BAR; PG8_MMA(1, 1, At, B1); PG8_BAR;
            PG8_LDB(B0, 1, 0); PG8_SCHED; PG8_LDA(At, 1, 0); PG8_STAGE(PG8_SA(0, 1), a2 + hstep, voffA);
            PG8_WAIT_L(8); PG8_BAR; PG8_WAIT_L(0); PG8_MMA(0, 0, At, B0); PG8_BAR; PG8_SCHED;
            PG8_LDB(B1, 1, 1); PG8_STAGE(PG8_SB(1, 0), b3, voffB);
            PG8_BAR; PG8_WAIT_L(0); PG8_MMA(0, 1, At, B1); PG8_BAR;
            PG8_LDA(At, 1, 1); PG8_STAGE(PG8_SA(1, 0), a3, voffA);
            PG8_BAR; PG8_WAIT_L(0); PG8_MMA(1, 0, At, B0); PG8_BAR; PG8_SCHED;
            PG8_STAGE(PG8_SB(1, 1), b3 + hstep, voffB);
            PG8_WAIT_V(6); PG8_BAR; PG8_MMA(1, 1, At, B1); PG8_BAR;
            }
        }
        if constexpr (ALIGN_EPI) { if (wr == 0) PG8_BAR; }
        if constexpr (!Epi::AFTER_DRAIN) { E(acc, cur, wr, wc, fr, fq); S.done(cur); }
        if (!has_next) break;
#pragma unroll
        for (int a = 0; a < 2; ++a)
#pragma unroll
            for (int b = 0; b < 2; ++b)
#pragma unroll
                for (int m = 0; m < 4; ++m)
#pragma unroll
                    for (int n = 0; n < 2; ++n) acc[a][b][m][n] = (f32x4){0.f, 0.f, 0.f, 0.f};
        cur = nxt; cA = nA; cB = nB; ++ui;
        if constexpr (ALIGN_EPI) { if (wr == 1) PG8_BAR; }
    }
    PG8_WAIT_V(0);
    if constexpr (!ALIGN_EPI) { if (wr == 0) PG8_BAR; }
    PG8_BAR;
    if constexpr (Epi::AFTER_DRAIN) { E.fused(acc, cur, wr, wc, fr, fq, lds, wid, lane); S.done(cur); }
#undef PG8_SA
#undef PG8_SB
#undef PG8_STAGE
#undef PG8_LDA
#undef PG8_LDB
#undef PG8_MMA
#undef PG8_WAIT_V
#undef PG8_WAIT_L
#undef PG8_BAR
#undef PG8_SCHED
}
}
#ifndef PG8_SP2
#define PG8_SP2 true
#endif
#ifndef PG8_ALIGN
#define PG8_ALIGN true
#endif
#ifndef MK_PER_PHASE
#define MK_PER_PHASE 0
#endif
#ifndef REP_S5
#define REP_S5 1
#endif
#ifndef REP_DSA
#define REP_DSA 1
#endif
#ifndef REP_G1
#define REP_G1 1
#endif
#ifndef PROBE_SEC
#define PROBE_SEC 0
#endif
#define PROBE_BEGIN(k) do { if (PROBE_SEC == (k) && blockIdx.x == 0 && threadIdx.x == 0) { const unsigned long long t_ = wall_clock64(); PRB[2] = (unsigned)t_; PRB[3] = (unsigned)(t_ >> 32); } } while (0)
#define PROBE_END(k) do { if (PROBE_SEC == (k) && blockIdx.x == 0 && threadIdx.x == 0) { const unsigned long long t0_ = ((unsigned long long)PRB[3] << 32) | PRB[2]; const unsigned long long a_ = (((unsigned long long)PRB[1] << 32) | PRB[0]) + (wall_clock64() - t0_); PRB[0] = (unsigned)a_; PRB[1] = (unsigned)(a_ >> 32); } } while (0)
constexpr int NWAVES = 8;
constexpr int NPH = 14;

constexpr int NB = 16, SEQ = 2048, D = 1024, NMETA = 16, DFF = 2816;
constexpr int R = NB * SEQ;
constexpr int NG = 32, NP = 64, NM = 16;
constexpr float RMS_EPS = 1e-6f;

constexpr size_t MiB = 1u << 20;
constexpr size_t WS_CTL = 0, CTL_ZERO_BYTES = 1 * MiB;
constexpr size_t WS_WT3B = 23 * MiB  ;
constexpr size_t WS_WT1 = 2 * MiB, WS_WT2 = 13 * MiB, WS_WT3 = 19 * MiB, WS_WT4 = 27 * MiB, WS_WT5 = 38 * MiB;
constexpr size_t WS_WGLU = 44 * MiB, WS_WA = 45 * MiB, WS_WB = 46 * MiB, WS_WOUT = 47 * MiB;
constexpr size_t WS_KS = 50 * MiB, WS_KO = 58 * MiB, WS_KI = 66 * MiB;
constexpr size_t WS_META = 67 * MiB;
constexpr size_t MO_AM1 = 0, MO_ACTM = 32768, MO_FM = 131072, MO_AM2 = 262144, MO_PMU = 294912, MO_PMK = 311296;
constexpr size_t WS_HN = 68 * MiB;
constexpr size_t WS_F = 132 * MiB;
constexpr size_t WS_BIG = 196 * MiB;
constexpr size_t WS_PA = WS_BIG, WS_PG = WS_BIG + 96 * MiB, WS_PK = WS_BIG + 224 * MiB, WS_HB = WS_BIG + 240 * MiB  , WS_END = WS_BIG + 304 * MiB;
constexpr size_t WS_HB8 = WS_BIG + 64 * MiB;
constexpr size_t WS_UA2 = WS_F + 32 * MiB;
constexpr int CW_BAR = 4096;

constexpr int LDS_BYTES = 155648;
constexpr int MISC_OFF = 154624;

#define GAS __attribute__((address_space(1)))
#define LAS __attribute__((address_space(3)))
typedef unsigned short bf16;
typedef unsigned v4u __attribute__((ext_vector_type(4)));
typedef unsigned v2u __attribute__((ext_vector_type(2)));
typedef float f32x4 __attribute__((ext_vector_type(4)));
typedef short bf16x8 __attribute__((ext_vector_type(8)));
#define LDS_WAIT() asm volatile("s_waitcnt lgkmcnt(0)" ::: "memory")
#define VM_WAIT() asm volatile("s_waitcnt vmcnt(0)" ::: "memory")
__device__ __forceinline__ unsigned f2bf(float f) { unsigned u = __builtin_bit_cast(unsigned, f); return (u + 0x7fffu + ((u >> 16) & 1u)) >> 16; }
__device__ __forceinline__ unsigned pk2(float lo, float hi) { return f2bf(lo) | (f2bf(hi) << 16); }
__device__ __forceinline__ float bflo(unsigned w) { return __uint_as_float(w << 16); }
__device__ __forceinline__ float bfhi(unsigned w) { return __uint_as_float(w & 0xffff0000u); }
__device__ __forceinline__ float bf2f(bf16 v) { return __uint_as_float(((unsigned)v) << 16); }
__device__ __forceinline__ float fsig(float x) { return __builtin_amdgcn_rcpf(1.0f + __expf(-x)); }

#define XB_TMO      128
#define XB_XCNT(j)  (256  + 64 * (j))
#define XB_XSUB(j)  (1280 + 64 * (j))
#define XB_XGEN(j)  (2304 + 64 * (j))
#define XB_TOP      3328
#define XB_TOPGEN   3392
#define XCD_BAR_WORDS 3456
#define XB_SPIN_CAP (1u << 18)
__device__ __forceinline__ unsigned xb_ld(unsigned* p)              { return __hip_atomic_load(p, __ATOMIC_RELAXED, __HIP_MEMORY_SCOPE_AGENT); }
__device__ __forceinline__ unsigned xb_add(unsigned* p, unsigned v) { return __hip_atomic_fetch_add(p, v, __ATOMIC_RELAXED, __HIP_MEMORY_SCOPE_AGENT); }
__device__ __forceinline__ unsigned xb_xcc_id() { return (unsigned)__builtin_amdgcn_s_getreg((3 << 11) | 20) & 0xFu; }
#define XB_SPIN(cond, bar) do { unsigned _sp = 0; while (cond) { __builtin_amdgcn_s_sleep(1); \
    if ((++_sp & 255u) == 0u) { if (xb_ld(&(bar)[XB_TMO])) break; if (_sp > XB_SPIN_CAP) { atomicAdd(&(bar)[XB_TMO], 1u); break; } } } } while (0)
struct XcdBarrier { unsigned* bar; unsigned x; volatile LAS unsigned* st; };
__device__ __forceinline__ XcdBarrier xcd_barrier_post(unsigned* bar, volatile LAS unsigned* st) {
    XcdBarrier b; b.bar = bar; b.x = xb_xcc_id(); b.st = st;
    if (threadIdx.x == 0) (void)xb_add(&bar[XB_XCNT(b.x)], 1u);
    return b;
}
__device__ __forceinline__ void xcd_barrier_complete(unsigned* bar, unsigned x, unsigned& nloc, unsigned& nx) {
    const unsigned G = gridDim.x * gridDim.y * gridDim.z;
    unsigned sum, cnt, mine, sp = 0u;
    for (;;) {
        sum = 0u; cnt = 0u; mine = 0u;
#pragma unroll
        for (unsigned j = 0; j < 16; ++j) { const unsigned c = xb_ld(&bar[XB_XCNT(j)]); sum += c; cnt += (c > 0u) ? 1u : 0u; mine = (j == x) ? c : mine; }
        if (sum == G) break;
        __builtin_amdgcn_s_sleep(1);
        if ((++sp & 255u) == 0u) { if (xb_ld(&bar[XB_TMO])) break; if (sp > XB_SPIN_CAP) { atomicAdd(&bar[XB_TMO], 1u); break; } }
    }
    nloc = mine > 0u ? mine : 1u; nx = cnt > 0u ? cnt : 1u;
}
__device__ __forceinline__ void xcd_barrier(const XcdBarrier& b) {
    asm volatile("s_waitcnt vmcnt(0)" ::: "memory");
    __syncthreads();
    if (threadIdx.x == 0) {
        unsigned* bar = b.bar;
        __builtin_amdgcn_s_waitcnt(0);
        unsigned nloc = b.st[0], nx = b.st[1];
        if (nloc == 0u) { xcd_barrier_complete(bar, b.x, nloc, nx); b.st[0] = nloc; b.st[1] = nx; }
        const unsigned old = xb_add(&bar[XB_XSUB(b.x)], 1u);
        const unsigned gen = old / nloc;
        if (old + 1u == (gen + 1u) * nloc) {
            __builtin_amdgcn_fence(__ATOMIC_RELEASE, "agent");
            asm volatile("s_waitcnt vmcnt(0)" ::: "memory");
            const unsigned og = xb_add(&bar[XB_TOP], 1u);
            const unsigned tg = og / nx;
            if (og + 1u == (tg + 1u) * nx) xb_add(&bar[XB_TOPGEN], 1u);
            else XB_SPIN(xb_ld(&bar[XB_TOPGEN]) == tg, bar);
            __builtin_amdgcn_fence(__ATOMIC_ACQUIRE, "agent");
            xb_add(&bar[XB_XGEN(b.x)], 1u);
            asm volatile("s_waitcnt vmcnt(0)" ::: "memory");
        } else {
            XB_SPIN(xb_ld(&bar[XB_XGEN(b.x)]) == gen, bar);
            __builtin_amdgcn_fence(__ATOMIC_ACQUIRE, "agent");
            asm volatile("s_waitcnt vmcnt(0)" ::: "memory");
        }
    }
    __syncthreads();
}

__device__ __forceinline__ float wave_sum(float v) {
#pragma unroll
    for (int o = 1; o < 64; o <<= 1) v += __shfl_xor(v, o);
    return v;
}
__device__ __forceinline__ f32x4 mfma16(bf16x8 a, bf16x8 b, f32x4 c) { return __builtin_amdgcn_mfma_f32_16x16x32_bf16(a, b, c, 0, 0, 0); }

__device__ __forceinline__ void transpose_item(const float* W, int Nsrc, int K, bf16* WT, int k0, int drow0, int srccol, LAS float* scr, int lane, const float* gk = nullptr) {
    f32x4 wl[8];
#pragma unroll
    for (int i = 0; i < 8; ++i) { const int kk = 8 * i + (lane >> 3); wl[i] = (srccol >= 0) ? *(const f32x4*)(W + (size_t)(k0 + kk) * Nsrc + srccol) : (f32x4){0.f, 0.f, 0.f, 0.f}; }
#pragma unroll
    for (int i = 0; i < 8; ++i) { const int kk = 8 * i + (lane >> 3); f32x4 v = wl[i]; if (gk) v = v * gk[k0 + kk]; LAS float* d = scr + kk * 33 + 4 * (lane & 7); d[0] = v.x; d[1] = v.y; d[2] = v.z; d[3] = v.w; }
    LDS_WAIT(); asm volatile("" ::: "memory");
    const int c = lane & 7;
#pragma unroll
    for (int j = 0; j < 4; ++j) { const int n = (lane >> 3) + 8 * j; const LAS float* s = scr + (8 * c) * 33 + n;
        v4u o; o.x = pk2(s[0 * 33], s[1 * 33]); o.y = pk2(s[2 * 33], s[3 * 33]); o.z = pk2(s[4 * 33], s[5 * 33]); o.w = pk2(s[6 * 33], s[7 * 33]);
        *(v4u*)(WT + (size_t)(drow0 + n) * K + k0 + 8 * c) = o; }
    LDS_WAIT(); asm volatile("" ::: "memory");
}

__device__ __forceinline__ unsigned pk4q(float a, float b, float c, float d) { int w = 0; w = __builtin_amdgcn_cvt_pk_fp8_f32(__builtin_amdgcn_fmed3f(a, -448.f, 448.f), __builtin_amdgcn_fmed3f(b, -448.f, 448.f), w, false);
    w = __builtin_amdgcn_cvt_pk_fp8_f32(__builtin_amdgcn_fmed3f(c, -448.f, 448.f), __builtin_amdgcn_fmed3f(d, -448.f, 448.f), w, true); return (unsigned)w; }
__device__ __forceinline__ void transpose_item8(const float* W, int Nsrc, int K, unsigned char* WT8, int k0, int drow0, int srccol, LAS float* scr, int lane, const float* gk = nullptr) {
    f32x4 wl[8];
#pragma unroll
    for (int i = 0; i < 8; ++i) { const int kk = 8 * i + (lane >> 3); wl[i] = *(const f32x4*)(W + (size_t)(k0 + kk) * Nsrc + srccol); }
#pragma unroll
    for (int i = 0; i < 8; ++i) { const int kk = 8 * i + (lane >> 3); f32x4 v = wl[i] * 64.0f; if (gk) v = v * gk[k0 + kk]; LAS float* d = scr + kk * 33 + 4 * (lane & 7); d[0] = v.x; d[1] = v.y; d[2] = v.z; d[3] = v.w; }
    LDS_WAIT(); asm volatile("" ::: "memory");
    const int c = lane & 7;
#pragma unroll
    for (int j = 0; j < 4; ++j) { const int n = (lane >> 3) + 8 * j; const LAS float* sp = scr + (8 * c) * 33 + n;
        v2u o; o.x = pk4q(sp[0 * 33], sp[1 * 33], sp[2 * 33], sp[3 * 33]); o.y = pk4q(sp[4 * 33], sp[5 * 33], sp[6 * 33], sp[7 * 33]);
        *(v2u*)(WT8 + (size_t)(drow0 + n) * K + k0 + 8 * c) = o; }
    LDS_WAIT(); asm volatile("" ::: "memory");
}
__device__ __forceinline__ int win_srccol(int d) {
    if (d < 1024) return d;
    if (d < 1536) return 1096 + (d - 1024);
    if (d < 1600) return 1024 + (d - 1536);
    if (d < 1664) return 1608 + (d - 1600);
    if (d < 1728) return 1672 + (d - 1664);
    if (d < 1736) return 1088 + (d - 1728);
    return -1;
}
__device__ __forceinline__ void norm_row_to_bf16(const float* xrow, const float* g, bf16* orow, int lane) {
    f32x4 v[4]; float ss = 0.f;
#pragma unroll
    for (int j = 0; j < 4; ++j) { v[j] = ((const f32x4*)xrow)[lane + 64 * j]; ss += (v[j].x * v[j].x + v[j].y * v[j].y) + (v[j].z * v[j].z + v[j].w * v[j].w); }
    const float rs = rsqrtf(wave_sum(ss) * (1.f / D) + RMS_EPS);
#pragma unroll
    for (int j = 0; j < 4; ++j) { const f32x4 gv = ((const f32x4*)g)[lane + 64 * j]; v2u o; o.x = pk2(v[j].x * rs * gv.x, v[j].y * rs * gv.y); o.y = pk2(v[j].z * rs * gv.z, v[j].w * rs * gv.w);
        ((v2u*)orow)[lane + 64 * j] = o; }
}

struct Args { const float* in[28]; float* out; unsigned char* ws; int ph_lo, ph_hi; };
struct TrDesc { const float* src; const float* gk; unsigned char* dst; int nsrc, K, k0, drow0; int f8; int valid; };
__device__ __forceinline__ void tr_decode(const Args& a, unsigned char* ws, int it, int lane, TrDesc& d) {
    const int n4 = 4 * (lane & 7); int r = it; d.gk = nullptr; d.f8 = 0; d.valid = 1; int srccol;
    if (r < 6 * 1408) { const int mat = r / 1408; r -= mat * 1408;
        if (mat == 2 || mat == 5) { const int kb = r / 32, nb = r % 32; d.nsrc = D; d.K = DFF; d.k0 = 64 * kb; d.drow0 = 32 * nb; srccol = 32 * nb + n4;
            d.src = a.in[mat == 2 ? 10 : 13]; d.dst = ws + (mat == 2 ? WS_WT2 : WS_WT5); d.f8 = (mat == 5); }
        else { const int kb = r / 88, nb = r % 88, d0 = 32 * nb, up = (mat == 1 || mat == 4) ? 128 : 0; d.nsrc = DFF; d.K = D; d.k0 = 64 * kb; d.drow0 = 256 * (d0 >> 7) + (d0 & 127) + up; srccol = d0 + n4;
            d.src = a.in[mat == 0 ? 8 : mat == 1 ? 9 : mat == 3 ? 11 : 12]; d.dst = ws + (mat < 3 ? WS_WT1 : WS_WT4); d.f8 = (mat >= 3); if (mat < 3) d.gk = a.in[2]; }
    } else { r -= 6 * 1408;
        if (r < 896) { const int kb = r / 56, nb = r % 56; d.nsrc = 3784; d.K = D; d.k0 = 64 * kb; d.drow0 = 32 * nb; srccol = win_srccol(32 * nb + n4); d.src = a.in[14]; d.dst = ws + WS_WT3; d.gk = a.in[4]; if (srccol < 0) { d.valid = 0; srccol = 0; } }
        else { r -= 896;
            if (r < 1024) { const int kb = r / 64, nb = r % 64; d.nsrc = 3784; d.K = D; d.k0 = 64 * kb; d.drow0 = 32 * nb; srccol = 1736 + 32 * nb + n4; d.src = a.in[14]; d.dst = ws + WS_WT3B; d.gk = a.in[4]; d.f8 = 1; }
            else { r -= 1024;
                if (r < 128) { const int kb = r / 16, nb = r % 16; d.nsrc = 512; d.K = 512; d.k0 = 64 * kb; d.drow0 = 32 * nb; srccol = 32 * nb + n4; d.src = a.in[23]; d.dst = ws + WS_WGLU; }
                else { r -= 128; const int which = r / 256; r -= which * 256;
                    if (which < 2) { const int kb = r / 32, nb = r % 32; d.nsrc = D; d.K = 512; d.k0 = 64 * kb; d.drow0 = 32 * nb; srccol = 32 * nb + n4; d.src = a.in[which == 0 ? 24 : 26]; d.dst = ws + (which == 0 ? WS_WA : WS_WB); }
                    else { const int r2 = r + (which - 2) * 256; const int kb = r2 / 32, nb = r2 % 32; d.nsrc = D; d.K = D; d.k0 = 64 * kb; d.drow0 = 32 * nb; srccol = 32 * nb + n4; d.src = a.in[27]; d.dst = ws + WS_WOUT; } } } } }
    d.src += (size_t)(d.k0 + (lane >> 3)) * d.nsrc + srccol;
}
__device__ __forceinline__ void tr_load(const TrDesc& d, f32x4 (&wl)[8]) {
#pragma unroll
    for (int i = 0; i < 8; ++i) wl[i] = d.valid ? *(const f32x4*)(d.src + (size_t)(8 * i) * d.nsrc) : (f32x4){0.f, 0.f, 0.f, 0.f};
}
__device__ __forceinline__ void tr_finish(const TrDesc& d, const f32x4 (&wl)[8], LAS float* scr, int lane) {
    const float sc8 = d.f8 ? 64.0f : 1.0f;
#pragma unroll
    for (int i = 0; i < 8; ++i) { const int kk = 8 * i + (lane >> 3); f32x4 v = wl[i] * sc8; if (d.gk) v = v * d.gk[d.k0 + kk]; LAS float* p = scr + kk * 33 + 4 * (lane & 7); p[0] = v.x; p[1] = v.y; p[2] = v.z; p[3] = v.w; }
    LDS_WAIT(); asm volatile("" ::: "memory");
    const int c = lane & 7;
#pragma unroll
    for (int j = 0; j < 4; ++j) { const int n = (lane >> 3) + 8 * j; const LAS float* sp = scr + (8 * c) * 33 + n;
        if (d.f8) { v2u o; o.x = pk4q(sp[0 * 33], sp[1 * 33], sp[2 * 33], sp[3 * 33]); o.y = pk4q(sp[4 * 33], sp[5 * 33], sp[6 * 33], sp[7 * 33]); *(v2u*)(d.dst + (size_t)(d.drow0 + n) * d.K + d.k0 + 8 * c) = o; }
        else { v4u o; o.x = pk2(sp[0 * 33], sp[1 * 33]); o.y = pk2(sp[2 * 33], sp[3 * 33]); o.z = pk2(sp[4 * 33], sp[5 * 33]); o.w = pk2(sp[6 * 33], sp[7 * 33]); *(v4u*)((bf16*)d.dst + (size_t)(d.drow0 + n) * d.K + d.k0 + 8 * c) = o; } }
    LDS_WAIT(); asm volatile("" ::: "memory");
}
template <bool PRESCALE>
__device__ __forceinline__ void x_row_to_bf16(const float* xrow, bf16* orow, float* rs_out, int lane) {
    f32x4 v[4]; float ss = 0.f;
#pragma unroll
    for (int j = 0; j < 4; ++j) { v[j] = ((const f32x4*)xrow)[lane + 64 * j]; ss += (v[j].x * v[j].x + v[j].y * v[j].y) + (v[j].z * v[j].z + v[j].w * v[j].w); }
    const float rs = rsqrtf(wave_sum(ss) * (1.f / D) + RMS_EPS), pre = PRESCALE ? rs : 1.0f;
#pragma unroll
    for (int j = 0; j < 4; ++j) { v2u o; o.x = pk2(v[j].x * pre, v[j].y * pre); o.y = pk2(v[j].z * pre, v[j].w * pre); ((v2u*)orow)[lane + 64 * j] = o; }
    if (rs_out && lane == 0) *rs_out = rs;
}
template <bool BASE_BF16, bool OUT_BF16, bool HN_F8 = false>
__device__ __forceinline__ void row_update(const bf16* frow, const void* base, void* outrow, bf16* hnrow, const float* gpost, const float* gnext, float scale, int lane, float* rs_out = nullptr, unsigned* h8row = nullptr) {
    f32x4 f[4], h[4]; float ss = 0.f;
#pragma unroll
    for (int j = 0; j < 4; ++j) { const v2u w = ((const v2u*)frow)[lane + 64 * j]; f[j] = (f32x4){bflo(w.x), bfhi(w.x), bflo(w.y), bfhi(w.y)};
        ss += (f[j].x * f[j].x + f[j].y * f[j].y) + (f[j].z * f[j].z + f[j].w * f[j].w); }
    const float rs = rsqrtf(wave_sum(ss) * (1.f / D) + RMS_EPS) * scale; float s2 = 0.f;
#pragma unroll
    for (int j = 0; j < 4; ++j) { const f32x4 gv = ((const f32x4*)gpost)[lane + 64 * j]; f32x4 bv;
        if (BASE_BF16) { const v2u w = ((const v2u*)base)[lane + 64 * j]; bv = (f32x4){bflo(w.x), bfhi(w.x), bflo(w.y), bfhi(w.y)}; } else bv = ((const f32x4*)base)[lane + 64 * j];
        h[j] = bv + f[j] * rs * gv; s2 += (h[j].x * h[j].x + h[j].y * h[j].y) + (h[j].z * h[j].z + h[j].w * h[j].w); }
    if (h8row) {
#pragma unroll
        for (int j = 0; j < 4; ++j) h8row[lane + 64 * j] = pk4q(4.0f * h[j].x, 4.0f * h[j].y, 4.0f * h[j].z, 4.0f * h[j].w); }
    if (outrow) {
#pragma unroll
        for (int j = 0; j < 4; ++j) { if (OUT_BF16) { v2u o; o.x = pk2(h[j].x, h[j].y); o.y = pk2(h[j].z, h[j].w); ((v2u*)outrow)[lane + 64 * j] = o; } else ((f32x4*)outrow)[lane + 64 * j] = h[j]; } }
    if (hnrow || rs_out) { const float r2 = rsqrtf(wave_sum(s2) * (1.f / D) + RMS_EPS); if (rs_out && lane == 0) *rs_out = r2;
        if (hnrow)
#pragma unroll
        for (int j = 0; j < 4; ++j) { const f32x4 gv = gnext ? ((const f32x4*)gnext)[lane + 64 * j] : (f32x4){1.f, 1.f, 1.f, 1.f};
            if (HN_F8) { const float q = 4.0f * r2; ((unsigned*)hnrow)[lane + 64 * j] = pk4q(h[j].x * q * gv.x, h[j].y * q * gv.y, h[j].z * q * gv.z, h[j].w * q * gv.w); }
            else { v2u o; o.x = pk2(h[j].x * r2 * gv.x, h[j].y * r2 * gv.y); o.y = pk2(h[j].z * r2 * gv.z, h[j].w * r2 * gv.w); ((v2u*)hnrow)[lane + 64 * j] = o; } } }
}

template <bool OUT_BF16, bool HAS_HN8, bool HAS_RS, bool HAS_H8, int NR = 2>
__device__ __forceinline__ void rows_phase(const bf16* F, const bf16* BASE, void* OUT, unsigned char* HN8, const float* gpost, const float* gnext, float scale, float* RS, unsigned char* H8, int gw, int NGW, int lane) {
    f32x4 gp[4], gn[4];
#pragma unroll
    for (int j = 0; j < 4; ++j) { gp[j] = ((const f32x4*)gpost)[lane + 64 * j]; gn[j] = HAS_HN8 ? ((const f32x4*)gnext)[lane + 64 * j] : (f32x4){1.f, 1.f, 1.f, 1.f}; }
    for (int m0 = gw; m0 < R; m0 += NR * NGW) {
        v2u fw[NR][4], bw[NR][4];
#pragma unroll
        for (int t = 0; t < NR; ++t) { const size_t m = (size_t)(m0 + t * NGW);
#pragma unroll
            for (int j = 0; j < 4; ++j) { fw[t][j] = ((const v2u*)(F + m * D))[lane + 64 * j]; bw[t][j] = ((const v2u*)(BASE + m * D))[lane + 64 * j]; } }
#pragma unroll
        for (int t = 0; t < NR; ++t) { const size_t m = (size_t)(m0 + t * NGW);
            f32x4 f[4], h[4]; float ss = 0.f;
#pragma unroll
            for (int j = 0; j < 4; ++j) { f[j] = (f32x4){bflo(fw[t][j].x), bfhi(fw[t][j].x), bflo(fw[t][j].y), bfhi(fw[t][j].y)}; ss += (f[j].x * f[j].x + f[j].y * f[j].y) + (f[j].z * f[j].z + f[j].w * f[j].w); }
            const float rs = rsqrtf(wave_sum(ss) * (1.f / D) + RMS_EPS) * scale; float s2 = 0.f;
#pragma unroll
            for (int j = 0; j < 4; ++j) { const f32x4 bv = (f32x4){bflo(bw[t][j].x), bfhi(bw[t][j].x), bflo(bw[t][j].y), bfhi(bw[t][j].y)};
                h[j] = bv + f[j] * rs * gp[j]; s2 += (h[j].x * h[j].x + h[j].y * h[j].y) + (h[j].z * h[j].z + h[j].w * h[j].w); }
            if (HAS_H8) {
#pragma unroll
                for (int j = 0; j < 4; ++j) ((unsigned*)(H8 + m * D))[lane + 64 * j] = pk4q(4.0f * h[j].x, 4.0f * h[j].y, 4.0f * h[j].z, 4.0f * h[j].w); }
#pragma unroll
            for (int j = 0; j < 4; ++j) { if (OUT_BF16) { v2u o; o.x = pk2(h[j].x, h[j].y); o.y = pk2(h[j].z, h[j].w); ((v2u*)((bf16*)OUT + m * D))[lane + 64 * j] = o; } else ((f32x4*)((float*)OUT + m * D))[lane + 64 * j] = h[j]; }
            if (HAS_HN8 || HAS_RS) { const float r2 = rsqrtf(wave_sum(s2) * (1.f / D) + RMS_EPS); if (HAS_RS && lane == 0) RS[m] = r2;
                if (HAS_HN8) { const float q = 4.0f * r2;
#pragma unroll
                    for (int j = 0; j < 4; ++j) ((unsigned*)(HN8 + m * D))[lane + 64 * j] = pk4q(h[j].x * q * gn[j].x, h[j].y * q * gn[j].y, h[j].z * q * gn[j].z, h[j].w * q * gn[j].w); } } }
    }
}
__device__ __forceinline__ f32x4 meta_tile(const bf16* A, const bf16* B, int K, int lane) {
    const int fr = lane & 15, kq = lane >> 4; const bf16* ap = A + (size_t)fr * K + 8 * kq; const bf16* bp = B + (size_t)fr * K + 8 * kq;
    f32x4 acc = (f32x4){0.f, 0.f, 0.f, 0.f};
#pragma unroll 4
    for (int k = 0; k < K; k += 32) { const bf16x8 a = *(const bf16x8*)(ap + k); const bf16x8 b = *(const bf16x8*)(bp + k); acc = mfma16(a, b, acc); }
    return acc;
}


template <int STEPS>
__device__ __forceinline__ void meta_tile_blk(const bf16* A, const bf16* B0, const bf16* B1, int K, LAS float* red, int wave, int lane, f32x4& c0, f32x4& c1) {
    const int fr = lane & 15, kq = lane >> 4, k0 = wave * (32 * STEPS);
    const bf16* ap = A + (size_t)fr * K + k0 + 8 * kq; const bf16* bp0 = B0 + (size_t)fr * K + k0 + 8 * kq; const bf16* bp1 = (B1 ? B1 : B0) + (size_t)fr * K + k0 + 8 * kq;
    bf16x8 av[STEPS], bv0[STEPS], bv1[STEPS];
#pragma unroll
    for (int i = 0; i < STEPS; ++i) { av[i] = *(const bf16x8*)(ap + 32 * i); bv0[i] = *(const bf16x8*)(bp0 + 32 * i); bv1[i] = *(const bf16x8*)(bp1 + 32 * i); }
    f32x4 a0 = (f32x4){0.f, 0.f, 0.f, 0.f}, a1 = a0;
#pragma unroll
    for (int i = 0; i < STEPS; ++i) { a0 = mfma16(av[i], bv0[i], a0); a1 = mfma16(av[i], bv1[i], a1); }
    *(LAS f32x4*)(red + (wave * 64 + lane) * 8) = a0; *(LAS f32x4*)(red + (wave * 64 + lane) * 8 + 4) = a1;
    __syncthreads();
    c0 = (f32x4){0.f, 0.f, 0.f, 0.f}; c1 = c0;
#pragma unroll
    for (int w2 = 0; w2 < 8; ++w2) { c0 += *(const LAS f32x4*)(red + (w2 * 64 + lane) * 8); c1 += *(const LAS f32x4*)(red + (w2 * 64 + lane) * 8 + 4); }
    __syncthreads();
}


__device__ __forceinline__ void s5_tables_block(const Args& a, int g, int oct, LAS float* sc, int tid) {
    const float* lam_re = a.in[15]; const float* lam_im = a.in[16]; const float* log_dt = a.in[17];
    const float* b_re = a.in[18]; const float* b_im = a.in[19]; const float* c_re = a.in[20]; const float* c_im = a.in[21]; const float* dsk = a.in[22];
    LAS float* CR = sc; LAS float* CI = sc + 1024; LAS float* BR = sc + 2048; LAS float* BI = sc + 3072;
    LAS float* ANG = sc + 4096; LAS float* LRDT = sc + 4160; LAS float* CFR = sc + 4224; LAS float* CFI = sc + 4288;
    LAS float* WR = sc + 4352; LAS float* WI = sc + 4864;
    __syncthreads();
#pragma unroll
    for (int k = 0; k < 2; ++k) { const int e = tid + 512 * k; CR[e] = c_re[g * 1024 + e]; CI[e] = c_im[g * 1024 + e]; BR[e] = b_re[g * 1024 + e]; BI[e] = b_im[g * 1024 + e]; }
    if (tid < 64) { const int p = tid; const float lr = lam_re[g * 64 + p], li = lam_im[g * 64 + p], dt = expf(log_dt[g]);
        const float ang = li * dt, mag = expf(lr * dt); float s1, c1; sincosf(ang, &s1, &c1);
        const float a_re = mag * c1, a_im = mag * s1, den = lr * lr + li * li, nr = a_re - 1.0f, ni = a_im;
        ANG[p] = ang; LRDT[p] = lr * dt; CFR[p] = (nr * lr + ni * li) / den; CFI[p] = (ni * lr - nr * li) / den; }
    __syncthreads();
    const int ti = tid >> 6, p64 = tid & 63, idx0 = 8 * oct;
    { const float n = (float)(idx0 + ti); float sn, cn; sincosf(n * ANG[p64], &sn, &cn); const float mn = expf(n * LRDT[p64]); const float pr = mn * cn, pi = mn * sn;
      WR[tid] = pr * CFR[p64] - pi * CFI[p64]; WI[tid] = pr * CFI[p64] + pi * CFR[p64]; }
    __syncthreads();
#pragma unroll
    for (int k = 0; k < 4; ++k) { const int e = tid + 512 * k, t8 = e >> 8, m = (e >> 4) & 15, mp = e & 15; float s = 0.f;
        for (int p = 0; p < 64; ++p) { const float wr_ = WR[t8 * 64 + p], wi_ = WI[t8 * 64 + p], br = BR[p * 16 + mp], bi = BI[p * 16 + mp];
            const float zr = wr_ * br - wi_ * bi, zi = wr_ * bi + wi_ * br; s += CR[m * 64 + p] * zr - CI[m * 64 + p] * zi; }
        if (idx0 + t8 == 0 && m == mp) s += dsk[g * 16 + m];
        ((bf16*)(a.ws + WS_KI))[((g * 64 + idx0 + t8) * 16 + m) * 16 + mp] = (bf16)f2bf(s); }
    __syncthreads();
    { const float n = (float)(63 - (idx0 + ti)); float sn, cn; sincosf(n * ANG[p64], &sn, &cn); const float mn = expf(n * LRDT[p64]); const float pr = mn * cn, pi = mn * sn;
      WR[tid] = pr * CFR[p64] - pi * CFI[p64]; WI[tid] = pr * CFI[p64] + pi * CFR[p64]; }
    __syncthreads();
    for (int k = 0; k < 32; ++k) { const int e = tid + 512 * k, t8 = e >> 11, n_ = (e >> 4) & 127, mp = e & 15, p = n_ & 63;
        const float wr_ = WR[t8 * 64 + p], wi_ = WI[t8 * 64 + p], br = BR[p * 16 + mp], bi = BI[p * 16 + mp];
        const float zr = wr_ * br - wi_ * bi, zi = wr_ * bi + wi_ * br;
        ((bf16*)(a.ws + WS_KS))[((size_t)(g * 64 + idx0 + t8) * 128 + n_) * 16 + mp] = (bf16)f2bf(n_ < 64 ? zr : zi); }
    __syncthreads();
    { const float n = (float)(idx0 + ti + 1); float sn, cn; sincosf(n * ANG[p64], &sn, &cn); const float mn = expf(n * LRDT[p64]); WR[tid] = mn * cn; WI[tid] = mn * sn; }
    __syncthreads();
    for (int k = 0; k < 32; ++k) { const int e = tid + 512 * k, t8 = e >> 11, m = (e >> 7) & 15, kk = e & 127, p = kk & 63;
        const float cr = CR[m * 64 + p], ci = CI[m * 64 + p], ar_ = WR[t8 * 64 + p], ai_ = WI[t8 * 64 + p];
        const float wr_ = cr * ar_ - ci * ai_, wi_ = cr * ai_ + ci * ar_;
        ((bf16*)(a.ws + WS_KO))[((size_t)(g * 64 + idx0 + t8) * 16 + m) * 128 + kk] = (bf16)f2bf(kk < 64 ? wr_ : -wi_); }
}

constexpr int S5_U = 0, S5_USTR = 2064, S5_KI = 66048, S5_SLOC = 98816, S5_XINB = 115200, S5_XSTR = 272, S5_MISC = 123904;
__device__ __forceinline__ float gelu_tanh(float x) { const float z = 0.7978845608028654f * (x + 0.044715f * x * x * x); return x * fsig(2.0f * z); }
__device__ __forceinline__ void s5_meta(const Args& a, LAS unsigned char* L, int g, int tid) {
    const int lane = tid & 63; const bf16* PMU = (const bf16*)(a.ws + WS_META + MO_PMU); LAS float* MS = (LAS float*)(L + S5_MISC);
    if (tid < 64) { const int p = lane; const float lr = a.in[15][g * 64 + p], li = a.in[16][g * 64 + p], dt = expf(a.in[17][g]);
        const float ang = li * dt, mag = expf(lr * dt); float s1, c1; sincosf(ang, &s1, &c1);
        const float a_re = mag * c1, a_im = mag * s1, den = lr * lr + li * li, nr = a_re - 1.0f, ni = a_im;
        const float cf_re = (nr * lr + ni * li) / den, cf_im = (ni * lr - nr * li) / den;
        float bb_re[16], bb_im[16];
#pragma unroll
        for (int m = 0; m < 16; ++m) { const float br = a.in[18][(g * 64 + p) * 16 + m], bi = a.in[19][(g * 64 + p) * 16 + m]; bb_re[m] = cf_re * br - cf_im * bi; bb_im[m] = cf_re * bi + cf_im * br; }
        LAS bf16* UM = (LAS bf16*)(L + S5_MISC + 1024);
        if (lane < 32) *(LAS v4u*)(UM + lane * 8) = *(const v4u*)(PMU + (lane >> 1) * 512 + 16 * g + 8 * (lane & 1));
        LDS_WAIT();
        float xr = 0.f, xi = 0.f;
#pragma unroll
        for (int i = 0; i < 16; ++i) { float ur = 0.f, ui = 0.f; const v4u w0 = *(const LAS v4u*)(UM + i * 16), w1 = *(const LAS v4u*)(UM + i * 16 + 8);
            const float uu[16] = {bflo(w0.x), bfhi(w0.x), bflo(w0.y), bfhi(w0.y), bflo(w0.z), bfhi(w0.z), bflo(w0.w), bfhi(w0.w), bflo(w1.x), bfhi(w1.x), bflo(w1.y), bfhi(w1.y), bflo(w1.z), bfhi(w1.z), bflo(w1.w), bfhi(w1.w)};
#pragma unroll
            for (int m = 0; m < 16; ++m) { ur += bb_re[m] * uu[m]; ui += bb_im[m] * uu[m]; }
            const float nr2 = a_re * xr - a_im * xi + ur, ni2 = a_re * xi + a_im * xr + ui; xr = nr2; xi = ni2; }
        float s64, c64; sincosf(64.0f * ang, &s64, &c64); const float m64 = expf(64.0f * lr * dt);
        MS[p] = xr; MS[64 + p] = xi; MS[128 + p] = m64 * c64; MS[192 + p] = m64 * s64; }
}
__device__ __forceinline__ void s5_unit(const Args& a, LAS unsigned char* L, int b, int g, int tid) {
    const int lane = tid & 63, w = __builtin_amdgcn_readfirstlane(tid >> 6), fr = lane & 15, kq = lane >> 4;
    const bf16* UA2 = (const bf16*)(a.ws + WS_UA2) + (size_t)(b * 32 + g) * 2048 * 16;
    const bf16* KS = (const bf16*)(a.ws + WS_KS); const bf16* KO = (const bf16*)(a.ws + WS_KO); const bf16* KI = (const bf16*)(a.ws + WS_KI);
    bf16* YA = (bf16*)(a.ws + WS_F);
    LAS float* SLOC = (LAS float*)(L + S5_SLOC); LAS float* MS = (LAS float*)(L + S5_MISC);
    __syncthreads();
#pragma unroll
    for (int k = 0; k < 8; ++k) { const int idx = tid + 512 * k, t = idx >> 1, hf = idx & 1;
        const v4u v = *(const v4u*)(UA2 + (size_t)idx * 8);
        *(LAS v4u*)(L + S5_U + (t >> 6) * S5_USTR + (t & 63) * 32 + 16 * hf) = v; }
#pragma unroll
    for (int k = 0; k < 4; ++k) { const int idx = tid + 512 * k; *(LAS v4u*)(L + S5_KI + idx * 16) = *(const v4u*)(KI + (size_t)g * 16384 + idx * 8); }
    bf16x8 bfr[16];
#pragma unroll
    for (int k = 0; k < 16; ++k) { const int i = 2 * k + (kq >> 1); bfr[k] = *(const bf16x8*)(KS + ((size_t)(g * 64 + i) * 128 + 16 * w + fr) * 16 + 8 * (kq & 1)); }
    __syncthreads();
    { f32x4 acc0 = (f32x4){0.f, 0.f, 0.f, 0.f}, acc1 = acc0;
#pragma unroll
      for (int hb = 0; hb < 2; ++hb) {
          if (hb == 1) {
#pragma unroll
              for (int k = 0; k < 16; ++k) { const int i = 2 * (16 + k) + (kq >> 1); bfr[k] = *(const bf16x8*)(KS + ((size_t)(g * 64 + i) * 128 + 16 * w + fr) * 16 + 8 * (kq & 1)); } }
#pragma unroll
          for (int k = 0; k < 16; ++k) { const int ks = 16 * hb + k;
              const bf16x8 a0 = *(const LAS bf16x8*)(L + S5_U + fr * S5_USTR + (32 * ks + 8 * kq) * 2);
              const bf16x8 a1 = *(const LAS bf16x8*)(L + S5_U + (16 + fr) * S5_USTR + (32 * ks + 8 * kq) * 2);
              acc0 = mfma16(a0, bfr[k], acc0); acc1 = mfma16(a1, bfr[k], acc1); } }
#pragma unroll
      for (int r = 0; r < 4; ++r) { SLOC[(4 * kq + r) * 128 + 16 * w + fr] = acc0[r]; SLOC[(16 + 4 * kq + r) * 128 + 16 * w + fr] = acc1[r]; } }
    bf16x8 kob[4][4];
#pragma unroll
    for (int jj = 0; jj < 4; ++jj)
#pragma unroll
        for (int ks = 0; ks < 4; ++ks) kob[jj][ks] = *(const bf16x8*)(KO + ((size_t)(g * 64 + 4 * w + jj) * 16 + fr) * 128 + 32 * ks + 8 * kq);
    __syncthreads();
    if (w == 0) { const int p = lane; float xr = MS[p], xi = MS[64 + p]; const float ar = MS[128 + p], ai = MS[192 + p];
#pragma unroll
        for (int hf = 0; hf < 2; ++hf) { float sr[16], si[16];
#pragma unroll
            for (int c = 0; c < 16; ++c) { sr[c] = SLOC[(16 * hf + c) * 128 + p]; si[c] = SLOC[(16 * hf + c) * 128 + 64 + p]; }
#pragma unroll
            for (int c = 0; c < 16; ++c) { const int cc = 16 * hf + c; *(LAS bf16*)(L + S5_XINB + cc * S5_XSTR + p * 2) = (bf16)f2bf(xr); *(LAS bf16*)(L + S5_XINB + cc * S5_XSTR + (64 + p) * 2) = (bf16)f2bf(xi);
                const float nr2 = ar * xr - ai * xi + sr[c], ni2 = ar * xi + ai * xr + si[c]; xr = nr2; xi = ni2; } } }
    __syncthreads();
    for (int bi = 0; bi < 2; ++bi) { const int t = bi == 0 ? w : 15 - w, j0 = 4 * t;
        f32x4 acc[4][2];
#pragma unroll
        for (int jj = 0; jj < 4; ++jj) { acc[jj][0] = (f32x4){0.f, 0.f, 0.f, 0.f}; acc[jj][1] = acc[jj][0]; }
#pragma unroll
        for (int ks = 0; ks < 4; ++ks) {
            const bf16x8 x0 = *(const LAS bf16x8*)(L + S5_XINB + fr * S5_XSTR + (32 * ks + 8 * kq) * 2);
            const bf16x8 x1 = *(const LAS bf16x8*)(L + S5_XINB + (16 + fr) * S5_XSTR + (32 * ks + 8 * kq) * 2);
#pragma unroll
            for (int jj = 0; jj < 4; ++jj) { acc[jj][0] = mfma16(x0, kob[jj][ks], acc[jj][0]); acc[jj][1] = mfma16(x1, kob[jj][ks], acc[jj][1]); } }
        const int h2 = kq >> 1; const bf16x8 zf = (bf16x8){0, 0, 0, 0, 0, 0, 0, 0};
#define S5_KIF(d) (((d) - h2) >= 0 ? *(const LAS bf16x8*)(L + S5_KI + ((((d) - h2) * 16 + fr) * 16 + 8 * (kq & 1)) * 2) : zf)
#define S5_UA(row, ks) (*(const LAS bf16x8*)(L + S5_U + (row) * S5_USTR + (32 * (ks) + 8 * kq) * 2))
        bf16x8 F0 = S5_KIF(j0), F1 = S5_KIF(j0 + 1), F2 = S5_KIF(j0 + 2), F3 = S5_KIF(j0 + 3);
        bf16x8 a0 = S5_UA(fr, 0), a1 = S5_UA(16 + fr, 0);
        const int ksmax = (j0 + 3) >> 1;
        for (int ks = 0; ks <= ksmax; ++ks) {
            const int ksn = ks < ksmax ? ks + 1 : ks, dn = j0 - 2 * (ks + 1);
            const bf16x8 a0n = S5_UA(fr, ksn), a1n = S5_UA(16 + fr, ksn), F0n = S5_KIF(dn), F1n = S5_KIF(dn + 1);
            acc[0][0] = mfma16(a0, F0, acc[0][0]); acc[0][1] = mfma16(a1, F0, acc[0][1]); acc[1][0] = mfma16(a0, F1, acc[1][0]); acc[1][1] = mfma16(a1, F1, acc[1][1]);
            acc[2][0] = mfma16(a0, F2, acc[2][0]); acc[2][1] = mfma16(a1, F2, acc[2][1]); acc[3][0] = mfma16(a0, F3, acc[3][0]); acc[3][1] = mfma16(a1, F3, acc[3][1]);
            F3 = F1; F2 = F0; F0 = F0n; F1 = F1n; a0 = a0n; a1 = a1n; }
#undef S5_KIF
#undef S5_UA
        if (bi == 0) {
#pragma unroll
            for (int jj = 0; jj < 4; ++jj)
#pragma unroll
                for (int ks = 0; ks < 4; ++ks) kob[jj][ks] = *(const bf16x8*)(KO + ((size_t)(g * 64 + 4 * (15 - w) + jj) * 16 + fr) * 128 + 32 * ks + 8 * kq); }
#pragma unroll
        for (int jj = 0; jj < 4; ++jj) { const int j = j0 + jj;
#pragma unroll
            for (int r = 0; r < 4; ++r) { const int c0 = 4 * kq + r, c1 = 16 + 4 * kq + r;
                YA[(size_t)(b * 2048 + 64 * c0 + j) * 512 + 16 * g + fr] = (bf16)f2bf(gelu_tanh(acc[jj][0][r]));
                YA[(size_t)(b * 2048 + 64 * c1 + j) * 512 + 16 * g + fr] = (bf16)f2bf(gelu_tanh(acc[jj][1][r])); } } }
}

constexpr int DS_SSTR = 2120, DS_TSTR = 144, DS_BUF = 18432  , DS_BT = 36864  , DS_HIST = 135680, DS_MASK = 143872, DS_RB = 152576, DS_TB = 153600;
typedef short s16x4 __attribute__((ext_vector_type(4)));
__device__ __forceinline__ s16x4 tr_read(unsigned addr) { s16x4 r; asm volatile("ds_read_b64_tr_b16 %0, %1" : "=&v"(r) : "v"(addr) : "memory"); return r; }
__device__ __forceinline__ float relu_i(float x) { const int i = __builtin_bit_cast(int, x); return __builtin_bit_cast(float, i > 0 ? i : 0); }
__device__ __forceinline__ unsigned f16key(float f) { const _Float16 hf = (_Float16)f; const unsigned h = (unsigned)__builtin_bit_cast(unsigned short, hf); return (h & 0x8000u) ? (~h & 0xffffu) : (h | 0x8000u); }
__device__ __forceinline__ unsigned cvtpk(float lo, float hi) { unsigned r; asm volatile("v_cvt_pk_bf16_f32 %0, %1, %2" : "=v"(r) : "v"(lo), "v"(hi)); return r; }
__device__ __forceinline__ void dsa_tables(const Args& a, LAS unsigned char* L, int tid) {
    if (tid < 256) { ((LAS float*)(L + DS_RB))[tid] = a.in[25][tid] * 1.44269504f;
        const int n = tid; const int lo = n < 8 ? n : (n < 12 ? 8 : n < 16 ? 9 : n < 23 ? 10 : n < 32 ? 11 : n < 46 ? 12 : n < 64 ? 13 : n < 91 ? 14 : 15);
        ((LAS int*)(L + DS_TB))[tid] = lo; }
}

__device__ __forceinline__ int wave_incl_scan(int x) {
    int v = x;
    v += __builtin_amdgcn_update_dpp(0, v, 0x111, 0xf, 0xf, false);
    v += __builtin_amdgcn_update_dpp(0, v, 0x112, 0xf, 0xf, false);
    v += __builtin_amdgcn_update_dpp(0, v, 0x114, 0xf, 0xf, false);
    v += __builtin_amdgcn_update_dpp(0, v, 0x118, 0xf, 0xf, false);
    v += __builtin_amdgcn_update_dpp(0, v, 0x142, 0xa, 0xf, false);
    v += __builtin_amdgcn_update_dpp(0, v, 0x143, 0xc, 0xf, false);
    return v;
}
template <int NE>
__device__ __forceinline__ void dsa_select(LAS unsigned char* L, int c, int nt64, int w, int lane) {
    LAS unsigned short* S16 = (LAS unsigned short*)L; LAS unsigned long long* MASK = (LAS unsigned long long*)(L + DS_MASK);
    LAS unsigned* H = (LAS unsigned*)(L + DS_HIST) + w * 256;
    const int rl = 63 - lane;
    for (int qq = 0; qq < 4; ++qq) { const int q = 4 * w + qq; const LAS unsigned short* Sq = S16 + q * DS_SSTR; unsigned tkey = 0u;
        unsigned kr[NE];
#pragma unroll
        for (int e = 0; e < NE; ++e) kr[e] = (unsigned)Sq[64 * e + lane];
        if (c >= 4) { unsigned prefix = 0u; int kth = 256;
#pragma unroll
            for (int pass = 0; pass < 2; ++pass) {
                H[lane] = 0u; H[lane + 64] = 0u; H[lane + 128] = 0u; H[lane + 192] = 0u; LDS_WAIT();
#pragma unroll
                for (int e = 0; e < NE; ++e) { const unsigned key = kr[e]; const bool in = (pass == 0) ? (key != 0u) : ((key >> 8) == prefix);
                    if (in) (void)__hip_atomic_fetch_add(&H[pass == 0 ? (key >> 8) : (key & 255u)], 1u, __ATOMIC_RELAXED, __HIP_MEMORY_SCOPE_WORKGROUP); }
                LDS_WAIT();
                const unsigned h0 = H[4 * rl], h1 = H[4 * rl + 1], h2 = H[4 * rl + 2], h3 = H[4 * rl + 3]; const int t = (int)(h0 + h1 + h2 + h3);
                const int sfx = wave_incl_scan(t), above = sfx - t; const bool has = (above < kth) && (above + t >= kth);
                const unsigned long long bm = __ballot(has); const int src = bm ? (__ffsll((long long)bm) - 1) : 0;
                int cum = above, B; if (cum + (int)h3 >= kth) B = 3; else { cum += (int)h3; if (cum + (int)h2 >= kth) B = 2; else { cum += (int)h2; if (cum + (int)h1 >= kth) B = 1; else { cum += (int)h1; B = 0; } } }
                const int bin = __builtin_amdgcn_readlane(4 * rl + B, src); kth = __builtin_amdgcn_readlane(kth - cum, src);
                prefix = (prefix << 8) | (unsigned)bin; LDS_WAIT(); }
            tkey = prefix; }
        unsigned mlo = 0u, mhi = 0u;
#pragma unroll
        for (int e = 0; e < NE; ++e) { const int s = 64 * e + lane; const bool sel = ((s < 16) || (s >= 64)) && (kr[e] >= tkey);
            const unsigned long long m = __ballot(sel); mlo = (lane == e) ? (unsigned)m : mlo; mhi = (lane == e) ? (unsigned)(m >> 32) : mhi; }
        if (lane < nt64) MASK[q * 34 + lane] = ((unsigned long long)mhi << 32) | mlo; }
}
__device__ __forceinline__ void dsa_unit(const Args& a, LAS unsigned char* L, int b, int uq, int tid) {
    volatile LAS unsigned* PRB = (volatile LAS unsigned*)(L + MISC_OFF) + 16;
    PROBE_BEGIN(4);
    const int lane = tid & 63, w = __builtin_amdgcn_readfirstlane(tid >> 6), fr = lane & 15, kq = lane >> 4;
    const bf16* PA = (const bf16*)(a.ws + WS_PA); const bf16* PK = (const bf16*)(a.ws + WS_PK); const bf16* PMK = (const bf16*)(a.ws + WS_META + MO_PMK);
    bf16* YB = (bf16*)(a.ws + WS_HN) + (size_t)R * 512;
    const int c = 1 + (uq >> 1), nt64 = c + 1, qrow0 = b * 2048 + 32 * uq;
    LAS unsigned short* S16 = (LAS unsigned short*)L; LAS unsigned long long* MASK = (LAS unsigned long long*)(L + DS_MASK);
    const LAS float* RB = (const LAS float*)(L + DS_RB); const LAS int* TB = (const LAS int*)(L + DS_TB);
    __syncthreads();
    PROBE_BEGIN(1);
    { const int qh = w >> 2; bf16x8 qa[4][2][2]; float wv[4][2][4];
#pragma unroll
      for (int p = 0; p < 4; ++p) {
#pragma unroll
          for (int hf = 0; hf < 2; ++hf)
#pragma unroll
              for (int ks = 0; ks < 2; ++ks) qa[p][hf][ks] = *(const bf16x8*)(PA + (size_t)(qrow0 + 16 * qh + 4 * p + (fr >> 2)) * 1024 + (4 * hf + (fr & 3)) * 64 + 32 * ks + 8 * kq);
          const v4u wraw = *(const v4u*)(PK + (size_t)(qrow0 + 16 * qh + 4 * p + kq) * 256 + 192);
          wv[p][0][0] = bflo(wraw.x) * 0.04419417382f; wv[p][0][1] = bfhi(wraw.x) * 0.04419417382f; wv[p][0][2] = bflo(wraw.y) * 0.04419417382f; wv[p][0][3] = bfhi(wraw.y) * 0.04419417382f;
          wv[p][1][0] = bflo(wraw.z) * 0.04419417382f; wv[p][1][1] = bfhi(wraw.z) * 0.04419417382f; wv[p][1][2] = bflo(wraw.w) * 0.04419417382f; wv[p][1][3] = bfhi(wraw.w) * 0.04419417382f; }
      const int nkt = 4 * nt64;
      { const int ner = nt64 <= 9 ? 9 : nt64 <= 17 ? 17 : nt64 <= 25 ? 25 : 33;
        for (int kz = 4 * nt64 + (w & 3); kz < 4 * ner; kz += 4) {
#pragma unroll
            for (int p = 0; p < 4; ++p) S16[(16 * qh + 4 * p + kq) * DS_SSTR + 16 * kz + fr] = (unsigned short)0; } }
      if ((w & 3) != 0) {
#pragma unroll
          for (int p = 0; p < 4; ++p) S16[(16 * qh + 4 * p + kq) * DS_SSTR + 16 * (w & 3) + fr] = (unsigned short)0; }
      int kt = (w & 3) == 0 ? 0 : (w & 3) + 4;
      bf16x8 kb0, kb1, kc0, kc1;
      { const bf16* krow = (kt == 0) ? PMK + fr * 256 : PK + (size_t)(b * 2048 + 16 * kt - 64 + fr) * 256; kb0 = *(const bf16x8*)(krow + 8 * kq); kb1 = *(const bf16x8*)(krow + 32 + 8 * kq); }
      { const int k1 = (kt == 0) ? 4 : kt + 4; kc0 = kb0; kc1 = kb1;
        if (k1 < nkt) { const bf16* krow = PK + (size_t)(b * 2048 + 16 * k1 - 64 + fr) * 256; kc0 = *(const bf16x8*)(krow + 8 * kq); kc1 = *(const bf16x8*)(krow + 32 + 8 * kq); } }
      while (kt < nkt) {
          const int ktn = (kt == 0) ? 4 : kt + 4, ktnn = ktn + 4; bf16x8 nb0 = kc0, nb1 = kc1;
          if (ktnn < nkt) { const bf16* krow = PK + (size_t)(b * 2048 + 16 * ktnn - 64 + fr) * 256; nb0 = *(const bf16x8*)(krow + 8 * kq); nb1 = *(const bf16x8*)(krow + 32 + 8 * kq); }
#pragma unroll
          for (int p = 0; p < 4; ++p) { f32x4 aA = (f32x4){0.f, 0.f, 0.f, 0.f}, aB = aA;
              aA = mfma16(qa[p][0][0], kb0, aA); aB = mfma16(qa[p][1][0], kb0, aB); aA = mfma16(qa[p][0][1], kb1, aA); aB = mfma16(qa[p][1][1], kb1, aB);
              const float v = (relu_i(aA[0]) * wv[p][0][0] + relu_i(aA[1]) * wv[p][0][1]) + (relu_i(aA[2]) * wv[p][0][2] + relu_i(aA[3]) * wv[p][0][3])
                            + (relu_i(aB[0]) * wv[p][1][0] + relu_i(aB[1]) * wv[p][1][1]) + (relu_i(aB[2]) * wv[p][1][2] + relu_i(aB[3]) * wv[p][1][3]);
              S16[(16 * qh + 4 * p + kq) * DS_SSTR + 16 * kt + fr] = (unsigned short)f16key(v); }
          kb0 = kc0; kb1 = kc1; kc0 = nb0; kc1 = nb1; kt = ktn; } }
    __syncthreads();
    PROBE_END(1);
    bf16x8 qb[2][2]; unsigned mkoff[2];
#pragma unroll
    for (int cg = 0; cg < 2; ++cg) { const int q = 4 * w + 2 * cg + (fr >> 3), h = fr & 7; mkoff[cg] = q * 34;
#pragma unroll
        for (int ks = 0; ks < 2; ++ks) qb[cg][ks] = *(const bf16x8*)(PA + (size_t)(qrow0 + q) * 1024 + 512 + h * 64 + 32 * ks + 8 * kq); }
    const int skey = tid >> 3, spiece = tid & 7;
    v4u kv0 = (v4u){0u, 0u, 0u, 0u}, vv0 = kv0, kv, vv;
    if (skey < 16) { const bf16* krow = PMK + skey * 256; kv0 = *(const v4u*)(krow + 64 + 8 * spiece); vv0 = *(const v4u*)(krow + 128 + 8 * spiece); }
    { const bf16* krow = PK + (size_t)(b * 2048 + skey) * 256; kv = *(const v4u*)(krow + 64 + 8 * spiece); vv = *(const v4u*)(krow + 128 + 8 * spiece); }
    PROBE_BEGIN(2);
    if (nt64 <= 9) dsa_select<9>(L, c, nt64, w, lane);
    else if (nt64 <= 17) dsa_select<17>(L, c, nt64, w, lane);
    else if (nt64 <= 25) dsa_select<25>(L, c, nt64, w, lane);
    else dsa_select<33>(L, c, nt64, w, lane);
    __syncthreads();
    PROBE_END(2);
    PROBE_BEGIN(3);
    {
      const int hh = fr & 7; const float bfar = RB[15 * 8 + hh];
      float mrun[2] = {0.f, 0.f}, lrun[2] = {0.f, 0.f}; f32x4 O[2][4];
#pragma unroll
      for (int cg = 0; cg < 2; ++cg)
#pragma unroll
          for (int dt = 0; dt < 4; ++dt) O[cg][dt] = (f32x4){0.f, 0.f, 0.f, 0.f};
      const LAS float* BT = (const LAS float*)(L + DS_BT);
#pragma unroll
      for (int k = 0; k < 4; ++k) { const int e = tid + 512 * k, relc = (e >> 3) - 128, n = relc < 0 ? -relc : relc; ((LAS float*)(L + DS_BT))[e] = RB[(TB[n] + (relc > 0 ? 16 : 0)) * 8 + (e & 7)]; }
      const unsigned ldsV = (unsigned)(size_t)(L) + 9216u + (unsigned)((4 * kq + ((lane & 15) >> 2)) * DS_TSTR + 8 * (lane & 3));
      *(LAS v4u*)(L + skey * DS_TSTR + 16 * spiece) = kv0; *(LAS v4u*)(L + 9216 + skey * DS_TSTR + 16 * spiece) = vv0;
      __syncthreads();
      for (int T = 0; T < nt64; ++T) { const int buf = T & 1;
          v4u kn = kv, vn = vv;
          if (T + 2 < nt64) { const bf16* krow = PK + (size_t)(b * 2048 + 64 * (T + 1) + skey) * 256; kn = *(const v4u*)(krow + 64 + 8 * spiece); vn = *(const v4u*)(krow + 128 + 8 * spiece); }
          const bool nearT = (64 * T > 32 * uq - 90);
          f32x4 lg[2][4];
          { bf16x8 ka[4][2];
#pragma unroll
            for (int sub = 0; sub < 4; ++sub)
#pragma unroll
                for (int ks = 0; ks < 2; ++ks) ka[sub][ks] = *(const LAS bf16x8*)(L + buf * DS_BUF + fr * DS_TSTR + 16 * kq + sub * 16 * DS_TSTR + ks * 64);
#pragma unroll
            for (int cg = 0; cg < 2; ++cg)
#pragma unroll
                for (int sub = 0; sub < 4; ++sub) { f32x4 acc = (f32x4){0.f, 0.f, 0.f, 0.f}; acc = mfma16(ka[sub][0], qb[cg][0], acc); acc = mfma16(ka[sub][1], qb[cg][1], acc); lg[cg][sub] = acc; } }
          s16x4 vt[2][4][2];
#pragma unroll
          for (int cg = 0; cg < 2; ++cg) {
              const float mc = mrun[cg]; float mxl = -1.0e30f;
              if (nearT) { const int relb = ((T == 0) ? 0 : 64 * T - 48) + 4 * kq - (16 + 32 * uq + 4 * w + 2 * cg + (fr >> 3));
#pragma unroll
                  for (int sub = 0; sub < 4; ++sub)
#pragma unroll
                      for (int r = 0; r < 4; ++r) { int idx = relb + 16 * sub + r; idx = idx < -128 ? -128 : idx; idx = idx > 127 ? 127 : idx;
                          const float v = lg[cg][sub][r] * 0.18033688f + (BT[(idx + 128) * 8 + hh] - mc); lg[cg][sub][r] = v; mxl = fmaxf(mxl, v); }
              } else { const float bm = bfar - mc;
#pragma unroll
                  for (int sub = 0; sub < 4; ++sub)
#pragma unroll
                      for (int r = 0; r < 4; ++r) { const float v = lg[cg][sub][r] * 0.18033688f + bm; lg[cg][sub][r] = v; mxl = fmaxf(mxl, v); } }
              if (T == 0 || __ballot(mxl > 8.0f) != 0ull) {
                  float mx = mxl; mx = fmaxf(mx, __shfl_xor(mx, 16)); mx = fmaxf(mx, __shfl_xor(mx, 32));
                  const float delta = (T == 0) ? mx : fmaxf(mx, 0.f), sc = __builtin_amdgcn_exp2f(-delta); mrun[cg] = mc + delta; lrun[cg] *= sc;
#pragma unroll
                  for (int dt = 0; dt < 4; ++dt) O[cg][dt] = O[cg][dt] * sc;
#pragma unroll
                  for (int sub = 0; sub < 4; ++sub)
#pragma unroll
                      for (int r = 0; r < 4; ++r) lg[cg][sub][r] -= delta; }
              const unsigned long long mword = MASK[mkoff[cg] + T] >> (4 * kq); const unsigned mlo = (unsigned)mword, mhi = (unsigned)(mword >> 32); float ls = 0.f;
#pragma unroll
              for (int sub = 0; sub < 4; ++sub)
#pragma unroll
                  for (int r = 0; r < 4; ++r) { const int keep = __builtin_amdgcn_sbfe((int)(sub < 2 ? mlo : mhi), 16 * (sub & 1) + r, 1);
                      const float p = __uint_as_float(__float_as_uint(__builtin_amdgcn_exp2f(lg[cg][sub][r])) & (unsigned)keep); ls += p; lg[cg][sub][r] = p; }
              lrun[cg] += ls; }
          { const unsigned vaddr = ldsV + (unsigned)(buf * DS_BUF);
            asm volatile("ds_read_b64_tr_b16 %0, %16 offset:0\n\t"
                "ds_read_b64_tr_b16 %1, %16 offset:2304\n\t"
                "ds_read_b64_tr_b16 %2, %16 offset:32\n\t"
                "ds_read_b64_tr_b16 %3, %16 offset:2336\n\t"
                "ds_read_b64_tr_b16 %4, %16 offset:64\n\t"
                "ds_read_b64_tr_b16 %5, %16 offset:2368\n\t"
                "ds_read_b64_tr_b16 %6, %16 offset:96\n\t"
                "ds_read_b64_tr_b16 %7, %16 offset:2400\n\t"
                "ds_read_b64_tr_b16 %8, %16 offset:4608\n\t"
                "ds_read_b64_tr_b16 %9, %16 offset:6912\n\t"
                "ds_read_b64_tr_b16 %10, %16 offset:4640\n\t"
                "ds_read_b64_tr_b16 %11, %16 offset:6944\n\t"
                "ds_read_b64_tr_b16 %12, %16 offset:4672\n\t"
                "ds_read_b64_tr_b16 %13, %16 offset:6976\n\t"
                "ds_read_b64_tr_b16 %14, %16 offset:4704\n\t"
                "ds_read_b64_tr_b16 %15, %16 offset:7008\n\t"
                "s_waitcnt lgkmcnt(0)"
                : "=&v"(vt[0][0][0]), "=&v"(vt[0][0][1]), "=&v"(vt[0][1][0]), "=&v"(vt[0][1][1]), "=&v"(vt[0][2][0]), "=&v"(vt[0][2][1]), "=&v"(vt[0][3][0]), "=&v"(vt[0][3][1]), "=&v"(vt[1][0][0]), "=&v"(vt[1][0][1]), "=&v"(vt[1][1][0]), "=&v"(vt[1][1][1]), "=&v"(vt[1][2][0]), "=&v"(vt[1][2][1]), "=&v"(vt[1][3][0]), "=&v"(vt[1][3][1])
                : "v"(vaddr) : "memory"); }
#pragma unroll
          for (int ks2 = 0; ks2 < 2; ++ks2) { bf16x8 pb[2];
#pragma unroll
              for (int cg = 0; cg < 2; ++cg) { v4u pw; pw.x = cvtpk(lg[cg][2 * ks2][0], lg[cg][2 * ks2][1]); pw.y = cvtpk(lg[cg][2 * ks2][2], lg[cg][2 * ks2][3]);
                  pw.z = cvtpk(lg[cg][2 * ks2 + 1][0], lg[cg][2 * ks2 + 1][1]); pw.w = cvtpk(lg[cg][2 * ks2 + 1][2], lg[cg][2 * ks2 + 1][3]); pb[cg] = __builtin_bit_cast(bf16x8, pw); }
#pragma unroll
              for (int dt = 0; dt < 4; ++dt) { const bf16x8 va = __builtin_shufflevector(vt[ks2][dt][0], vt[ks2][dt][1], 0, 1, 2, 3, 4, 5, 6, 7);
#pragma unroll
                  for (int cg = 0; cg < 2; ++cg) O[cg][dt] = mfma16(va, pb[cg], O[cg][dt]); } }
          if (T + 1 < nt64) { *(LAS v4u*)(L + (buf ^ 1) * DS_BUF + skey * DS_TSTR + 16 * spiece) = kv; *(LAS v4u*)(L + (buf ^ 1) * DS_BUF + 9216 + skey * DS_TSTR + 16 * spiece) = vv; }
          kv = kn; vv = vn;
          __syncthreads();
      }
#pragma unroll
      for (int cg = 0; cg < 2; ++cg) { float v = lrun[cg]; v += __shfl_xor(v, 16); v += __shfl_xor(v, 32); const float inv = 1.0f / v;
          const int q = 4 * w + 2 * cg + (fr >> 3);
#pragma unroll
          for (int dt = 0; dt < 4; ++dt) { v2u o; o.x = cvtpk(O[cg][dt][0] * inv, O[cg][dt][1] * inv); o.y = cvtpk(O[cg][dt][2] * inv, O[cg][dt][3] * inv);
              *(v2u*)(YB + (size_t)(qrow0 + q) * 512 + hh * 64 + 16 * dt + 4 * kq) = o; } } }
    PROBE_END(3);
    PROBE_END(4);
}

__global__ void __launch_bounds__(NWAVES * 64, 2) mk_fwd(Args args) {
    extern __shared__ __attribute__((aligned(16))) unsigned char lds[];
    LAS unsigned char* L = (LAS unsigned char*)lds;
    volatile LAS unsigned* MISC = (volatile LAS unsigned*)(L + MISC_OFF);
    const int tid = threadIdx.x, lane = tid & 63, wave = __builtin_amdgcn_readfirstlane(tid >> 6);
    const int G = gridDim.x, bx = blockIdx.x;
    const int gw = bx * NWAVES + wave, NGW = G * NWAVES;
    unsigned char* ws = args.ws;
    if (tid < 32) MISC[tid] = 0u;
    __syncthreads();
    XcdBarrier bar; bar.bar = (unsigned*)(ws + WS_CTL) + CW_BAR; bar.x = 0; bar.st = nullptr;
    if (!MK_PER_PHASE) bar = xcd_barrier_post((unsigned*)(ws + WS_CTL) + CW_BAR, MISC + 8);
    const int lo = args.ph_lo, hi = args.ph_hi;
    volatile LAS unsigned* PRB = MISC + 16;
#define IN(k) (lo <= (k) && (k) < hi)
#define SEAM(k) do { if (IN(k) && IN((k) + 1)) xcd_barrier(bar); } while (0)
    bf16* WT1 = (bf16*)(ws + WS_WT1); bf16* WT2 = (bf16*)(ws + WS_WT2); bf16* WT3 = (bf16*)(ws + WS_WT3); bf16* WT4 = (bf16*)(ws + WS_WT4); bf16* WT5 = (bf16*)(ws + WS_WT5);
    bf16* WGLU = (bf16*)(ws + WS_WGLU); bf16* WA = (bf16*)(ws + WS_WA); bf16* WB = (bf16*)(ws + WS_WB); bf16* WOUT = (bf16*)(ws + WS_WOUT);
    bf16* HN = (bf16*)(ws + WS_HN); bf16* FB = (bf16*)(ws + WS_F); bf16* ACT = (bf16*)(ws + WS_BIG);
    bf16* PA = (bf16*)(ws + WS_PA); bf16* PG = (bf16*)(ws + WS_PG); bf16* PK = (bf16*)(ws + WS_PK);
    bf16* AM1 = (bf16*)(ws + WS_META + MO_AM1); bf16* ACTM = (bf16*)(ws + WS_META + MO_ACTM); bf16* FM = (bf16*)(ws + WS_META + MO_FM); bf16* AM2 = (bf16*)(ws + WS_META + MO_AM2);
    bf16* PMU = (bf16*)(ws + WS_META + MO_PMU); bf16* PMK = (bf16*)(ws + WS_META + MO_PMK);
    bf16* HB = (bf16*)(ws + WS_HB); float* RS1 = (float*)(ws + WS_META + 524288); float* RS2 = (float*)(ws + WS_META + 655360);
    bf16* YA = FB; bf16* YG = HN; bf16* YB = HN + (size_t)R * 512; bf16* MERGED = PA;
    const float* x = args.in[0]; float* out = args.out;

    PROBE_BEGIN(20);
    if (IN(0)) {
        PROBE_BEGIN(40);
        for (int item = bx; item < 256; item += G) s5_tables_block(args, item >> 3, item & 7, (LAS float*)L, tid);
        __syncthreads();
        PROBE_END(40); PROBE_BEGIN(41);
        LAS float* scr = (LAS float*)(L + wave * 16384);
        { TrDesc da, db; f32x4 wa[8], wb[8];
          int it = gw; bool ha = it < 11520, hb;
          if (ha) { tr_decode(args, ws, it, lane, da); tr_load(da, wa); }
          while (ha) {
              hb = it + NGW < 11520; if (hb) { tr_decode(args, ws, it + NGW, lane, db); tr_load(db, wb); }
              tr_finish(da, wa, scr, lane);
              it += NGW; if (!hb) break;
              ha = it + NGW < 11520; if (ha) { tr_decode(args, ws, it + NGW, lane, da); tr_load(da, wa); }
              tr_finish(db, wb, scr, lane);
              it += NGW; } }
        PROBE_END(41); PROBE_BEGIN(42);
        for (int m0 = gw; m0 < R; m0 += 2 * NGW) {
            f32x4 xv[2][4];
#pragma unroll
            for (int t = 0; t < 2; ++t)
#pragma unroll
                for (int j = 0; j < 4; ++j) xv[t][j] = ((const f32x4*)(x + (size_t)(m0 + t * NGW) * D))[lane + 64 * j];
#pragma unroll
            for (int t = 0; t < 2; ++t) { const size_t m = (size_t)(m0 + t * NGW); float ss = 0.f;
#pragma unroll
                for (int j = 0; j < 4; ++j) { const f32x4 v = xv[t][j]; ss += (v.x * v.x + v.y * v.y) + (v.z * v.z + v.w * v.w); v2u o; o.x = pk2(v.x, v.y); o.y = pk2(v.z, v.w); ((v2u*)(HN + m * D))[lane + 64 * j] = o; }
                const float rs = rsqrtf(wave_sum(ss) * (1.f / D) + RMS_EPS); if (lane == 0) RS1[m] = rs; } }
        PROBE_END(42); PROBE_BEGIN(43);
        if (gw < NMETA) x_row_to_bf16<true>(args.in[1] + (size_t)gw * D, AM1 + (size_t)gw * D, nullptr, lane);
    }
    SEAM(0);
    PROBE_END(43);
    PROBE_END(20);
    PROBE_BEGIN(21);
    if (IN(1)) {
        if (bx < 176) { const int j0 = 16 * bx, grow = 256 * (j0 >> 7) + (j0 & 127); f32x4 g4, u4;
            meta_tile_blk<4>(AM1, WT1 + (size_t)grow * D, WT1 + (size_t)(grow + 128) * D, D, (LAS float*)L, wave, lane, g4, u4);
            if (wave == 0) {
#pragma unroll
                for (int r = 0; r < 4; ++r) ACTM[(4 * (lane >> 4) + r) * DFF + j0 + (lane & 15)] = (bf16)f2bf(g4[r] * fsig(g4[r]) * u4[r]); } }
        pg8::Gemm g{HN, WT1, R, 2 * DFF, D}; pg8::StaticOrder S; S.init(R, 2 * DFF, G, bx); pg8::EpiSwiglu E{ACT, DFF, RS1};
        pg8::gemm_phase<pg8::EpiSwiglu, pg8::StaticOrder, PG8_ALIGN, PG8_SP2>(L, g, S, E);
        if (REP_G1 > 1) pg8::gemm_phase<pg8::EpiSwiglu, pg8::StaticOrder, PG8_ALIGN, PG8_SP2>(L, g, S, E);
    }
    SEAM(1);
    PROBE_END(21);
    PROBE_BEGIN(22);
    if (IN(2)) {
        if (bx < 64) { const int n0 = 16 * bx; f32x4 f4, dummy;
            meta_tile_blk<11>(ACTM, WT2 + (size_t)n0 * DFF, nullptr, DFF, (LAS float*)L, wave, lane, f4, dummy);
            if (wave == 0) {
#pragma unroll
                for (int r = 0; r < 4; ++r) FM[(4 * (lane >> 4) + r) * D + n0 + (lane & 15)] = (bf16)f2bf(f4[r]); } }
        pg8::Gemm g{ACT, WT2, R, D, DFF}; pg8::StaticOrder S; S.init(R, D, G, bx); pg8::EpiPlain E{FB, D};
        pg8::gemm_phase<pg8::EpiPlain, pg8::StaticOrder, PG8_ALIGN, PG8_SP2>(L, g, S, E);
    }
    SEAM(2);
    PROBE_END(22);
    PROBE_BEGIN(23);
    if (IN(3)) {
        if (gw < NMETA) row_update<false, false>(FM + (size_t)gw * D, args.in[1] + (size_t)gw * D, nullptr, AM2 + (size_t)gw * D, args.in[3], nullptr, 0.5f, lane);
        rows_phase<true, false, true, true>(FB, HN, HB, nullptr, args.in[3], nullptr, 0.5f, RS2, (unsigned char*)(ws + WS_HB8), gw, NGW, lane);
    }
    SEAM(3);
    PROBE_END(23);
    PROBE_BEGIN(24);
    if (IN(4)) {
        if (bx < 44) { const int n0 = bx < 32 ? 16 * bx : 1536 + 16 * (bx - 32); f32x4 p4, dummy;
            meta_tile_blk<4>(AM2, WT3 + (size_t)n0 * D, nullptr, D, (LAS float*)L, wave, lane, p4, dummy);
            if (wave == 0) {
#pragma unroll
                for (int r = 0; r < 4; ++r) { const int row = 4 * (lane >> 4) + r; if (bx < 32) PMU[row * 512 + n0 + (lane & 15)] = (bf16)f2bf(p4[r]); else PMK[row * 256 + (n0 - 1536) + (lane & 15)] = (bf16)f2bf(p4[r]); } } }
        { pg8::Gemm g{HB, WT3, R, 1792, D}; pg8::ProjOrderA S; S.base.init(R, 1536, G, bx); S.c = bx; pg8::EpiProj E{PA, PK, (bf16*)(ws + WS_UA2), RS2};
          pg8::gemm_phase<pg8::EpiProj, pg8::ProjOrderA, PG8_ALIGN, PG8_SP2>(L, g, S, E); }
        { pg8::Gemm g{(const bf16*)(ws + WS_HB8), (const bf16*)(ws + WS_WT3B), R, 2048, D}; pg8::ProjOrderB S{bx}; pg8::EpiGates8 E{PG, RS2};
          pg8::gemm_phase<pg8::EpiGates8, pg8::ProjOrderB, PG8_ALIGN, PG8_SP2, true>(L, g, S, E); }
    }
    SEAM(4);
    PROBE_END(24);
    PROBE_BEGIN(25);
    if (IN(5)) {
        { const int v0 = 2 * (bx >> 3), gS = 4 * (bx & 7) + (v0 >> 4);
          PROBE_BEGIN(6); s5_meta(args, L, gS, tid); PROBE_END(6); PROBE_BEGIN(5);
          for (int rep = 0; rep < REP_S5; ++rep) for (int i = 0; i < 2; ++i) s5_unit(args, L, (v0 + i) & 15, gS, tid); PROBE_END(5); }
        __syncthreads();
        dsa_tables(args, L, tid);
        for (int i = 0; i < 4 * REP_DSA; ++i) { const int up = 4 * (bx >> 3) + (i & 3), u2 = up >> 1, b = 2 * (bx & 7) + (u2 >> 5), xq = u2 & 31; dsa_unit(args, L, b, (up & 1) ? 63 - xq : xq, tid); }
        __syncthreads();
    }
    SEAM(5);
    PROBE_END(25);
    PROBE_BEGIN(26);
    if (IN(6)) { pg8::Gemm g{YA, WGLU, R, 512, 512}; pg8::StaticOrder S; S.init(R, 512, G, bx); pg8::EpiGlu E{YA, YG};
        pg8::gemm_phase<pg8::EpiGlu, pg8::StaticOrder, PG8_ALIGN, PG8_SP2>(L, g, S, E); }
    SEAM(6);
    PROBE_END(26);
    PROBE_BEGIN(27);
    if (IN(7)) { pg8::Gemm g{YG, WA, 2 * R, 2048, 512}; pg8::MergeOrder S; S.base.init(R, D, G, bx); pg8::EpiMerge2 E{PG, FB, MERGED};
        pg8::gemm_phase<pg8::EpiMerge2, pg8::MergeOrder, PG8_ALIGN, PG8_SP2>(L, g, S, E); }
    if (IN(7) && IN(9)) xcd_barrier(bar);
    PROBE_END(27);
    PROBE_BEGIN(29);
    if (IN(9)) { pg8::Gemm g{MERGED, WOUT, R, D, D}; pg8::StaticOrder S; S.init(R, D, G, bx); pg8::EpiPlain E{FB, D};
        pg8::gemm_phase<pg8::EpiPlain, pg8::StaticOrder, PG8_ALIGN, PG8_SP2>(L, g, S, E); }
    SEAM(9);
    PROBE_END(29);
    PROBE_BEGIN(30);
    if (IN(10)) { rows_phase<true, true, false, false>(FB, HB, HB, (unsigned char*)HN, args.in[5], args.in[6], 1.0f, nullptr, nullptr, gw, NGW, lane); }
    SEAM(10);
    PROBE_END(30);
    PROBE_BEGIN(31);
    if (IN(11)) { pg8::Gemm g{HN, WT4, R, 2 * DFF, D}; pg8::StaticOrder S; S.init(R, 2 * DFF, G, bx); pg8::EpiSwiglu8 E{(unsigned char*)ACT, DFF, 1.0f / 256.0f, 8.0f};
        pg8::gemm_phase<pg8::EpiSwiglu8, pg8::StaticOrder, PG8_ALIGN, PG8_SP2, true>(L, g, S, E); }
    SEAM(11);
    PROBE_END(31);
    PROBE_BEGIN(32);
    if (IN(12)) { pg8::Gemm g{ACT, WT5, R, D, DFF}; pg8::StaticOrder S; S.init(R, D, G, bx); pg8::EpiPlainS E{FB, D, 1.0f / 512.0f};
        pg8::gemm_phase<pg8::EpiPlainS, pg8::StaticOrder, PG8_ALIGN, PG8_SP2, true>(L, g, S, E); }
    SEAM(12);
    PROBE_END(32);
    PROBE_BEGIN(33);
    if (IN(13)) { rows_phase<false, false, false, false>(FB, HB, out, nullptr, args.in[7], nullptr, 0.5f, nullptr, nullptr, gw, NGW, lane); }
    PROBE_END(33);
    if (PROBE_SEC != 0 && bx == 0 && tid == 0) { const unsigned long long acc_ = ((unsigned long long)PRB[1] << 32) | PRB[0]; const unsigned long long t_ = wall_clock64(); while (wall_clock64() - t_ < acc_ * 8ull) __builtin_amdgcn_s_sleep(8); }
#undef IN
#undef SEAM
}

extern "C" void kernel_launch(void* const* d_in, const int* in_sizes, int n_in, void* d_out, int out_size, void* d_ws, size_t ws_size, hipStream_t stream) {
    static int grid = 0;
    if (grid == 0) {
        if (n_in != 28 || out_size != R * D || ws_size < WS_END) { fprintf(stderr, "kernel_launch: unexpected shapes (n_in %d, out %d, ws %zu); nothing launched\n", n_in, out_size, ws_size); grid = -1; return; }
        int dev = 0, cus = 0, per_cu = 0;
        if (hipGetDevice(&dev) != hipSuccess || hipDeviceGetAttribute(&cus, hipDeviceAttributeMultiprocessorCount, dev) != hipSuccess) { grid = -1; return; }
        if (hipFuncSetAttribute((const void*)mk_fwd, hipFuncAttributeMaxDynamicSharedMemorySize, LDS_BYTES) != hipSuccess) { fprintf(stderr, "kernel_launch: hipFuncSetAttribute failed\n"); grid = -1; return; }
        if (hipOccupancyMaxActiveBlocksPerMultiprocessor(&per_cu, (const void*)mk_fwd, NWAVES * 64, LDS_BYTES) != hipSuccess || per_cu < 1) fprintf(stderr, "kernel_launch: note: occupancy query reports %d\n", per_cu);
        (void)hipGetLastError();
        grid = cus;
    }
    if (grid < 0) return;
    if (hipMemsetAsync((char*)d_ws + WS_CTL, 0, CTL_ZERO_BYTES, stream) != hipSuccess) return;
    Args a{};
    for (int i = 0; i < 28; ++i) a.in[i] = (const float*)d_in[i];
    a.out = (float*)d_out; a.ws = (unsigned char*)d_ws;
#if MK_PER_PHASE
    for (int ph = 0; ph < NPH; ++ph) { a.ph_lo = ph; a.ph_hi = ph + 1; hipLaunchKernelGGL(mk_fwd, dim3(grid), dim3(NWAVES * 64), LDS_BYTES, stream, a); }
#else
    a.ph_lo = 0; a.ph_hi = NPH;
    hipLaunchKernelGGL(mk_fwd, dim3(grid), dim3(NWAVES * 64), LDS_BYTES, stream, a);
#endif
}
```

```cpp
#include <hip/hip_runtime.h>
#include <cstdio>
#include <cstdint>
namespace pg8 {
#define PG8_LAS __attribute__((address_space(3)))
typedef unsigned short bf16_t;
typedef short bf16x8 __attribute__((ext_vector_type(8)));
typedef float f32x4 __attribute__((ext_vector_type(4)));
typedef unsigned u32x4 __attribute__((ext_vector_type(4)));
constexpr int BM = 256, BK = 64, HALF = 128, HTB = HALF * BK * 2  , STAGE_BYTES = 8 * HTB, NXCD = 8, WGM = 8;

__host__ __device__ __forceinline__ int lds_byte(int r, int c) { const int st = (r >> 4) * 2 + (c >> 5), rr = r & 15, cc = c & 31, ob = rr * 64 + cc * 2; return st * 1024 + (ob ^ (((ob >> 9) & 1) << 5)); }
__host__ __device__ __forceinline__ void stage_rc(int b, int& R, int& C) { const int st = b / 1024, sb = b % 1024, swz = sb ^ (((sb >> 9) & 1) << 5); R = (st >> 1) * 16 + swz / 64; C = (st & 1) * 32 + (swz % 64) / 2; }
__host__ __device__ __forceinline__ int perm32(int rho) { const int n = rho >> 4, i = rho & 15; return 8 * (i >> 2) + 4 * n + (i & 3); }

struct Unit { int pm, pn; };
struct Gemm { const bf16_t* A; const bf16_t* Bt; int M, N, K; };

struct StaticOrder {
    int nM, nN, nwg, G, c;
    __host__ __device__ void init(int M, int N, int G_, int c_) { nM = M / BM; nN = N / BM; nwg = nM * nN; G = G_; c = c_; }
    __host__ __device__ bool next(int i, Unit& u) const {
        const long L = (long)i * G + c; if (L >= nwg) return false;
        int wgid = (int)L; { const int q = nwg / NXCD, r = nwg % NXCD, xcd = wgid % NXCD, off = wgid / NXCD; wgid = (xcd < r ? xcd * (q + 1) : r * (q + 1) + (xcd - r) * q) + off; }
        const int nig = WGM * nN, gid = wgid / nig, fm = gid * WGM, gsz = (nM - fm) < WGM ? (nM - fm) : WGM;
        u.pm = fm + ((wgid % nig) % gsz); u.pn = (wgid % nig) / gsz; return true;
    }
    __device__ __forceinline__ void a_ready(const Unit&) const {}
    __device__ __forceinline__ void done(const Unit&) const {}
};
__device__ __forceinline__ unsigned cvt_pk_bf16(float lo, float hi) { unsigned r; asm volatile("v_cvt_pk_bf16_f32 %0, %1, %2" : "=v"(r) : "v"(lo), "v"(hi)); return r; }
__device__ __forceinline__ float fsigmoid(float x) { return __builtin_amdgcn_rcpf(1.0f + __expf(-x)); }
__device__ __forceinline__ float bf_lo(unsigned w) { return __uint_as_float(w << 16); }
__device__ __forceinline__ float bf_hi(unsigned w) { return __uint_as_float(w & 0xffff0000u); }
__device__ __forceinline__ u32x4 pack8(const f32x4 v0, const f32x4 v1) { u32x4 w; w.x = cvt_pk_bf16(v0[0], v0[1]); w.y = cvt_pk_bf16(v0[2], v0[3]); w.z = cvt_pk_bf16(v1[0], v1[1]); w.w = cvt_pk_bf16(v1[2], v1[3]); return w; }
__device__ __forceinline__ void unpack8(const u32x4 w, f32x4& v0, f32x4& v1) { v0 = (f32x4){bf_lo(w.x), bf_hi(w.x), bf_lo(w.y), bf_hi(w.y)}; v1 = (f32x4){bf_lo(w.z), bf_hi(w.z), bf_lo(w.w), bf_hi(w.w)}; }

typedef float f32x2 __attribute__((ext_vector_type(2)));
__device__ __forceinline__ f32x2 lo2(const f32x4 v) { return (f32x2){v[0], v[1]}; }
__device__ __forceinline__ f32x2 hi2(const f32x4 v) { return (f32x2){v[2], v[3]}; }
__device__ __forceinline__ f32x2 exp2_2(const f32x2 t) { return (f32x2){__builtin_amdgcn_exp2f(t.x), __builtin_amdgcn_exp2f(t.y)}; }
__device__ __forceinline__ f32x2 rcp_2(const f32x2 t) { return (f32x2){__builtin_amdgcn_rcpf(t.x), __builtin_amdgcn_rcpf(t.y)}; }
__device__ __forceinline__ f32x2 swiglu2(const f32x2 g, const f32x2 u, const f32x2 K1, const f32x2 IK2) { const f32x2 e = exp2_2(g * K1); return (g * u) * rcp_2(e * IK2 + IK2); }
__device__ __forceinline__ void load_rs8(const float* rs, int row0, float (&v)[2][4]) {
#pragma unroll
    for (int ai = 0; ai < 2; ++ai)
#pragma unroll
        for (int m = 0; m < 4; ++m) v[ai][m] = rs[row0 + ai * HALF + m * 16];
    asm volatile("" : "+v"(v[0][0]), "+v"(v[0][1]), "+v"(v[0][2]), "+v"(v[0][3]), "+v"(v[1][0]), "+v"(v[1][1]), "+v"(v[1][2]), "+v"(v[1][3]));
}
struct EpiSwiglu {
    static constexpr bool PERM = true, AFTER_DRAIN = false;
    bf16_t* O; int ldc; const float* rs;
    __device__ __forceinline__ void operator()(const f32x4 (&acc)[2][2][4][2], const Unit& u, int wr, int wc, int fr, int fq) const {
        const int row0 = u.pm * BM + wr * 64 + fr, col0 = u.pn * HALF + wc * 32 + 8 * fq;
        float rsv[2][4]; load_rs8(rs, row0, rsv);
#pragma unroll
        for (int ai = 0; ai < 2; ++ai)
#pragma unroll
            for (int m = 0; m < 4; ++m) { bf16_t* rowp = O + (size_t)(row0 + ai * HALF + m * 16) * ldc + col0; const float rsc = rsv[ai][m];
                const float k1 = -1.44269504f * rsc, ik2 = __builtin_amdgcn_rcpf(rsc * rsc); const f32x2 K1 = (f32x2){k1, k1}, IK2 = (f32x2){ik2, ik2};
                const f32x2 p0 = swiglu2(lo2(acc[ai][0][m][0]), lo2(acc[ai][1][m][0]), K1, IK2), p1 = swiglu2(hi2(acc[ai][0][m][0]), hi2(acc[ai][1][m][0]), K1, IK2);
                const f32x2 p2 = swiglu2(lo2(acc[ai][0][m][1]), lo2(acc[ai][1][m][1]), K1, IK2), p3 = swiglu2(hi2(acc[ai][0][m][1]), hi2(acc[ai][1][m][1]), K1, IK2);
                u32x4 w; w.x = cvt_pk_bf16(p0.x, p0.y); w.y = cvt_pk_bf16(p1.x, p1.y); w.z = cvt_pk_bf16(p2.x, p2.y); w.w = cvt_pk_bf16(p3.x, p3.y);
                *(u32x4*)rowp = w; }
    }
};
struct EpiPlain {
    static constexpr bool PERM = true, AFTER_DRAIN = false;
    bf16_t* O; int ldc;
    __device__ __forceinline__ void operator()(const f32x4 (&acc)[2][2][4][2], const Unit& u, int wr, int wc, int fr, int fq) const {
        const int row0 = u.pm * BM + wr * 64 + fr, col0 = u.pn * BM + wc * 32 + 8 * fq;
#pragma unroll
        for (int ai = 0; ai < 2; ++ai)
#pragma unroll
            for (int m = 0; m < 4; ++m) { bf16_t* rowp = O + (size_t)(row0 + ai * HALF + m * 16) * ldc + col0;
#pragma unroll
                for (int bj = 0; bj < 2; ++bj) *(u32x4*)(rowp + bj * HALF) = pack8(acc[ai][bj][m][0], acc[ai][bj][m][1]); }
    }
};

__device__ __forceinline__ unsigned pk4_fp8(float a, float b, float c, float d) { int w = 0; w = __builtin_amdgcn_cvt_pk_fp8_f32(__builtin_amdgcn_fmed3f(a, -448.f, 448.f), __builtin_amdgcn_fmed3f(b, -448.f, 448.f), w, false);
    w = __builtin_amdgcn_cvt_pk_fp8_f32(__builtin_amdgcn_fmed3f(c, -448.f, 448.f), __builtin_amdgcn_fmed3f(d, -448.f, 448.f), w, true); return (unsigned)w; }
struct EpiSwiglu8 {
    static constexpr bool PERM = true, AFTER_DRAIN = false;
    unsigned char* O; int ldc; float ascale, oscale;
    __device__ __forceinline__ void operator()(const f32x4 (&acc)[2][2][4][2], const Unit& u, int wr, int wc, int fr, int fq) const {
        const int row0 = u.pm * BM + wr * 64 + fr, col0 = u.pn * HALF + wc * 32 + 8 * fq;
#pragma unroll
        for (int ai = 0; ai < 2; ++ai)
#pragma unroll
            for (int m = 0; m < 4; ++m) { unsigned char* rowp = O + (size_t)(row0 + ai * HALF + m * 16) * ldc + col0;
                const float k1 = -1.44269504f * ascale, ik2 = 1.0f / (ascale * ascale * oscale); const f32x2 K1 = (f32x2){k1, k1}, IK2 = (f32x2){ik2, ik2};
                const f32x2 p0 = swiglu2(lo2(acc[ai][0][m][0]), lo2(acc[ai][1][m][0]), K1, IK2), p1 = swiglu2(hi2(acc[ai][0][m][0]), hi2(acc[ai][1][m][0]), K1, IK2);
                const f32x2 p2 = swiglu2(lo2(acc[ai][0][m][1]), lo2(acc[ai][1][m][1]), K1, IK2), p3 = swiglu2(hi2(acc[ai][0][m][1]), hi2(acc[ai][1][m][1]), K1, IK2);
                typedef unsigned u32x2 __attribute__((ext_vector_type(2))); u32x2 w; w.x = pk4_fp8(p0.x, p0.y, p1.x, p1.y); w.y = pk4_fp8(p2.x, p2.y, p3.x, p3.y);
                *(u32x2*)rowp = w; }
    }
};
struct EpiSwigluR8 {
    static constexpr bool PERM = true, AFTER_DRAIN = false;
    unsigned char* O; int ldc; const float* rs; float oscale;
    __device__ __forceinline__ void operator()(const f32x4 (&acc)[2][2][4][2], const Unit& u, int wr, int wc, int fr, int fq) const {
        const int row0 = u.pm * BM + wr * 64 + fr, col0 = u.pn * HALF + wc * 32 + 8 * fq;
        float rsv[2][4]; load_rs8(rs, row0, rsv);
#pragma unroll
        for (int ai = 0; ai < 2; ++ai)
#pragma unroll
            for (int m = 0; m < 4; ++m) { unsigned char* rowp = O + (size_t)(row0 + ai * HALF + m * 16) * ldc + col0; const float rsc = rsv[ai][m];
                const float k1 = -1.44269504f * rsc, ik2 = __builtin_amdgcn_rcpf(rsc * rsc * oscale); const f32x2 K1 = (f32x2){k1, k1}, IK2 = (f32x2){ik2, ik2};
                const f32x2 p0 = swiglu2(lo2(acc[ai][0][m][0]), lo2(acc[ai][1][m][0]), K1, IK2), p1 = swiglu2(hi2(acc[ai][0][m][0]), hi2(acc[ai][1][m][0]), K1, IK2);
                const f32x2 p2 = swiglu2(lo2(acc[ai][0][m][1]), lo2(acc[ai][1][m][1]), K1, IK2), p3 = swiglu2(hi2(acc[ai][0][m][1]), hi2(acc[ai][1][m][1]), K1, IK2);
                typedef unsigned u32x2 __attribute__((ext_vector_type(2))); u32x2 w; w.x = pk4_fp8(p0.x, p0.y, p1.x, p1.y); w.y = pk4_fp8(p2.x, p2.y, p3.x, p3.y);
                *(u32x2*)rowp = w; }
    }
};
struct EpiPlainS {
    static constexpr bool PERM = true, AFTER_DRAIN = false;
    bf16_t* O; int ldc; float scale;
    __device__ __forceinline__ void operator()(const f32x4 (&acc)[2][2][4][2], const Unit& u, int wr, int wc, int fr, int fq) const {
        const int row0 = u.pm * BM + wr * 64 + fr, col0 = u.pn * BM + wc * 32 + 8 * fq;
#pragma unroll
        for (int ai = 0; ai < 2; ++ai)
#pragma unroll
            for (int m = 0; m < 4; ++m) { bf16_t* rowp = O + (size_t)(row0 + ai * HALF + m * 16) * ldc + col0;
#pragma unroll
                for (int bj = 0; bj < 2; ++bj) *(u32x4*)(rowp + bj * HALF) = pack8(acc[ai][bj][m][0] * scale, acc[ai][bj][m][1] * scale); }
    }
};
struct EpiProj {
    static constexpr bool PERM = true, AFTER_DRAIN = false;
    bf16_t *PA, *PK, *UA2; const float* rs;
    __device__ __forceinline__ void operator()(const f32x4 (&acc)[2][2][4][2], const Unit& u, int wr, int wc, int fr, int fq) const {
        float rsv[2][4]; load_rs8(rs, u.pm * BM + wr * 64 + fr, rsv);
        if (u.pn < 2) {
#pragma unroll
            for (int ai = 0; ai < 2; ++ai)
#pragma unroll
                for (int m = 0; m < 4; ++m) { const int row = u.pm * BM + wr * 64 + fr + ai * HALF + m * 16, bb = row >> 11, t = row & 2047; const float rsc = rsv[ai][m];
#pragma unroll
                    for (int bj = 0; bj < 2; ++bj) { const int col = 256 * u.pn + 128 * bj + wc * 32 + 8 * fq;
                        *(u32x4*)(UA2 + ((size_t)((bb * 32 + (col >> 4)) * 2048 + t)) * 16 + (col & 8)) = pack8(acc[ai][bj][m][0] * rsc, acc[ai][bj][m][1] * rsc); } }
            return; }
        bf16_t* base; int ldc, colt;
        if (u.pn < 6) { base = PA; ldc = 1024; colt = 256 * (u.pn - 2); } else { base = PK; ldc = 256; colt = 0; }
        const int row0 = u.pm * BM + wr * 64 + fr, col0 = colt + wc * 32 + 8 * fq;
#pragma unroll
        for (int ai = 0; ai < 2; ++ai)
#pragma unroll
            for (int m = 0; m < 4; ++m) { bf16_t* rowp = base + (size_t)(row0 + ai * HALF + m * 16) * ldc + col0; const float rsc = rsv[ai][m];
#pragma unroll
                for (int bj = 0; bj < 2; ++bj) *(u32x4*)(rowp + bj * HALF) = pack8(acc[ai][bj][m][0] * rsc, acc[ai][bj][m][1] * rsc); }
    }
};
struct EpiGates8 {
    static constexpr bool PERM = true, AFTER_DRAIN = false;
    bf16_t* PG; const float* rs;
    __device__ __forceinline__ void operator()(const f32x4 (&acc)[2][2][4][2], const Unit& u, int wr, int wc, int fr, int fq) const {
        const int row0 = u.pm * BM + wr * 64 + fr, col0 = u.pn * BM + wc * 32 + 8 * fq;
        float rsv[2][4]; load_rs8(rs, row0, rsv);
#pragma unroll
        for (int ai = 0; ai < 2; ++ai)
#pragma unroll
            for (int m = 0; m < 4; ++m) { bf16_t* rowp = PG + (size_t)(row0 + ai * HALF + m * 16) * 2048 + col0; const float rsc = rsv[ai][m] * (1.0f / 256.0f);
#pragma unroll
                for (int bj = 0; bj < 2; ++bj) *(u32x4*)(rowp + bj * HALF) = pack8(acc[ai][bj][m][0] * rsc, acc[ai][bj][m][1] * rsc); }
    }
};
struct ProjOrderA {
    StaticOrder base; int c;
    __device__ __forceinline__ bool next(int i, Unit& u) const { if (i < 3) return base.next(i, u); if (i == 3 && c < 128) { u.pm = c; u.pn = 6; return true; } return false; }
    __device__ __forceinline__ void a_ready(const Unit&) const {}
    __device__ __forceinline__ void done(const Unit&) const {}
};
struct ProjOrderB {
    int c;
    __device__ __forceinline__ bool next(int i, Unit& u) const {
        int Lx; if (c < 128) { if (i >= 3) return false; Lx = c + 128 * i; } else { if (i >= 5) return false; Lx = 384 + (c - 128) + 128 * i; }
        const int wgid = (Lx % NXCD) * 128 + Lx / NXCD, nig = WGM * 8;
        u.pm = (wgid / nig) * WGM + (wgid % nig) % WGM; u.pn = (wgid % nig) / WGM; return true; }
    __device__ __forceinline__ void a_ready(const Unit&) const {}
    __device__ __forceinline__ void done(const Unit&) const {}
};
struct EpiGlu {
    static constexpr bool PERM = true, AFTER_DRAIN = false;
    const bf16_t* Y; bf16_t* O;
    __device__ __forceinline__ void operator()(const f32x4 (&acc)[2][2][4][2], const Unit& u, int wr, int wc, int fr, int fq) const {
        const int row0 = u.pm * BM + wr * 64 + fr, col0 = u.pn * BM + wc * 32 + 8 * fq;
        u32x4 yv[2][4][2];
#pragma unroll
        for (int ai = 0; ai < 2; ++ai)
#pragma unroll
            for (int m = 0; m < 4; ++m)
#pragma unroll
                for (int bj = 0; bj < 2; ++bj) yv[ai][m][bj] = *(const u32x4*)(Y + (size_t)(row0 + ai * HALF + m * 16) * 512 + col0 + bj * HALF);
#pragma unroll
        for (int ai = 0; ai < 2; ++ai)
            asm volatile("" : "+v"(yv[ai][0][0]), "+v"(yv[ai][0][1]), "+v"(yv[ai][1][0]), "+v"(yv[ai][1][1]), "+v"(yv[ai][2][0]), "+v"(yv[ai][2][1]), "+v"(yv[ai][3][0]), "+v"(yv[ai][3][1]));
#pragma unroll
        for (int ai = 0; ai < 2; ++ai)
#pragma unroll
            for (int m = 0; m < 4; ++m) { const size_t off = (size_t)(row0 + ai * HALF + m * 16) * 512 + col0;
#pragma unroll
                for (int bj = 0; bj < 2; ++bj) { f32x4 y0, y1; unpack8(yv[ai][m][bj], y0, y1); f32x4 v0, v1;
#pragma unroll
                    for (int j = 0; j < 4; ++j) { v0[j] = y0[j] * fsigmoid(acc[ai][bj][m][0][j]); v1[j] = y1[j] * fsigmoid(acc[ai][bj][m][1][j]); }
                    *(u32x4*)(O + off + bj * HALF) = pack8(v0, v1); } }
    }
};
template <bool SECOND> struct EpiMerge {
    static constexpr bool PERM = true, AFTER_DRAIN = false;
    const bf16_t* G; int goff; const bf16_t* T; bf16_t* O;
    __device__ __forceinline__ void operator()(const f32x4 (&acc)[2][2][4][2], const Unit& u, int wr, int wc, int fr, int fq) const {
        const int row0 = u.pm * BM + wr * 64 + fr, col0 = u.pn * BM + wc * 32 + 8 * fq;
#pragma unroll
        for (int ai = 0; ai < 2; ++ai)
#pragma unroll
            for (int m = 0; m < 4; ++m) { const size_t row = (size_t)(row0 + ai * HALF + m * 16);
#pragma unroll
                for (int bj = 0; bj < 2; ++bj) { const int col = col0 + bj * HALF; f32x4 g0, g1; unpack8(*(const u32x4*)(G + row * 2048 + goff + col), g0, g1);
                    f32x4 t0 = (f32x4){0.f, 0.f, 0.f, 0.f}, t1 = t0; if (SECOND) unpack8(*(const u32x4*)(T + row * 1024 + col), t0, t1);
                    f32x4 v0, v1;
#pragma unroll
                    for (int j = 0; j < 4; ++j) { v0[j] = t0[j] + fsigmoid(g0[j]) * acc[ai][bj][m][0][j]; v1[j] = t1[j] + fsigmoid(g1[j]) * acc[ai][bj][m][1][j]; }
                    *(u32x4*)(O + row * 1024 + col) = pack8(v0, v1); } }
    }
};

struct MergeOrder {
    StaticOrder base;
    __device__ __forceinline__ bool next(int i, Unit& u) const { if (i >= 4) return false; if (!base.next(i & 1, u)) return false; if (i >= 2) { u.pm += 128; u.pn += 4; } return true; }
    __device__ __forceinline__ void a_ready(const Unit&) const {}
    __device__ __forceinline__ void done(const Unit&) const {}
};
struct EpiMerge2 {
    static constexpr bool PERM = true, AFTER_DRAIN = false;
    const bf16_t* G; bf16_t* T; bf16_t* O;
    __device__ __forceinline__ void operator()(const f32x4 (&acc)[2][2][4][2], const Unit& u, int wr, int wc, int fr, int fq) const {
        const bool second = u.pm >= 128; const int pm = second ? u.pm - 128 : u.pm, pn = second ? u.pn - 4 : u.pn, goff = second ? 1024 : 0;
        const int row0 = pm * BM + wr * 64 + fr, col0 = pn * BM + wc * 32 + 8 * fq;
#pragma unroll
        for (int ai = 0; ai < 2; ++ai) {
            u32x4 gv[4][2], tv[4][2];
#pragma unroll
            for (int m = 0; m < 4; ++m)
#pragma unroll
                for (int bj = 0; bj < 2; ++bj) { const size_t row = (size_t)(row0 + ai * HALF + m * 16); const int col = col0 + bj * HALF;
                    gv[m][bj] = *(const u32x4*)(G + row * 2048 + goff + col); tv[m][bj] = (u32x4){0u, 0u, 0u, 0u}; }
            if (second) {
#pragma unroll
                for (int m = 0; m < 4; ++m)
#pragma unroll
                    for (int bj = 0; bj < 2; ++bj) { const size_t row = (size_t)(row0 + ai * HALF + m * 16); const int col = col0 + bj * HALF; tv[m][bj] = *(const u32x4*)(T + row * 1024 + col); }
                asm volatile("" : "+v"(tv[0][0]), "+v"(tv[0][1]), "+v"(tv[1][0]), "+v"(tv[1][1]), "+v"(tv[2][0]), "+v"(tv[2][1]), "+v"(tv[3][0]), "+v"(tv[3][1])); }
            asm volatile("" : "+v"(gv[0][0]), "+v"(gv[0][1]), "+v"(gv[1][0]), "+v"(gv[1][1]), "+v"(gv[2][0]), "+v"(gv[2][1]), "+v"(gv[3][0]), "+v"(gv[3][1]));
#pragma unroll
            for (int m = 0; m < 4; ++m) { const size_t row = (size_t)(row0 + ai * HALF + m * 16);
#pragma unroll
                for (int bj = 0; bj < 2; ++bj) { const int col = col0 + bj * HALF; f32x4 g0, g1; unpack8(gv[m][bj], g0, g1);
                    f32x4 t0, t1; unpack8(tv[m][bj], t0, t1);
                    f32x4 v0, v1;
#pragma unroll
                    for (int j = 0; j < 4; ++j) { v0[j] = t0[j] + fsigmoid(g0[j]) * acc[ai][bj][m][0][j]; v1[j] = t1[j] + fsigmoid(g1[j]) * acc[ai][bj][m][1][j]; }
                    *(u32x4*)((second ? O : T) + row * 1024 + col) = pack8(v0, v1); } } }
    }
};
typedef int i32x8 __attribute__((ext_vector_type(8)));
typedef int i32x4v __attribute__((ext_vector_type(4)));
__device__ __forceinline__ i32x8 cat8(const bf16x8 lo, const bf16x8 hi) { const i32x4v a = __builtin_bit_cast(i32x4v, lo), b = __builtin_bit_cast(i32x4v, hi); return __builtin_shufflevector(a, b, 0, 1, 2, 3, 4, 5, 6, 7); }
template <class Epi, class Sched, bool ALIGN_EPI = false, bool SP2 = false, bool F8 = false>
__device__ __forceinline__ void gemm_phase(PG8_LAS unsigned char* lds, const Gemm g, const Sched& S, const Epi& E) {
    const int tid = threadIdx.x, wid = __builtin_amdgcn_readfirstlane(tid >> 6), lane = tid & 63, wr = wid >> 2, wc = wid & 3, fr = lane & 15, fq = lane >> 4;
    const int K = g.K, KB = F8 ? K : 2 * K  , nt = KB / 128;
    unsigned voffA[2], voffB[2];
#pragma unroll
    for (int i = 0; i < 2; ++i) { int R, C; stage_rc(tid * 16 + i * 8192, R, C); const int Rb = Epi::PERM ? ((R & ~31) + perm32(R & 31)) : R;
        voffA[i] = (unsigned)(R * KB + C * 2); voffB[i] = (unsigned)(Rb * KB + C * 2); }
    const size_t kstep = (size_t)(BK * 2);
    const size_t hstep = (size_t)HALF * KB;
    const size_t tstep = 2 * hstep;
    const unsigned ldsw = (unsigned)wid * 1024u;
    const int aoff = lds_byte(wr * 64 + fr, fq * 8), boff = lds_byte(wc * 32 + fr, fq * 8);
#define PG8_SA(b, h) (((b) * 2 + (h)) * HTB)
#define PG8_SB(b, h) ((4 + (b) * 2 + (h)) * HTB)
#define PG8_STAGE(bufoff, gbase, voff) do { _Pragma("unroll") for (int _i = 0; _i < 2; ++_i) \
        __builtin_amdgcn_global_load_lds((const unsigned*)((const char*)(gbase) + (voff)[_i]), (PG8_LAS unsigned*)(lds + (bufoff) + ldsw + _i * 8192), 16, 0, 0); } while (0)
#define PG8_LDA(dst, b, h) do { if constexpr (F8) { _Pragma("unroll") for (int m = 0; m < 4; ++m) dst##8[m] = cat8(*(const PG8_LAS bf16x8*)(lds + PG8_SA(b, h) + aoff + m * 2048), *(const PG8_LAS bf16x8*)(lds + PG8_SA(b, h) + aoff + m * 2048 + 1024)); } else { \
        _Pragma("unroll") for (int m = 0; m < 4; ++m) _Pragma("unroll") for (int k = 0; k < 2; ++k) dst[m][k] = *(const PG8_LAS bf16x8*)(lds + PG8_SA(b, h) + aoff + m * 2048 + k * 1024); } } while (0)
#define PG8_LDB(dst, b, h) do { if constexpr (F8) { _Pragma("unroll") for (int n = 0; n < 2; ++n) dst##8[n] = cat8(*(const PG8_LAS bf16x8*)(lds + PG8_SB(b, h) + boff + n * 2048), *(const PG8_LAS bf16x8*)(lds + PG8_SB(b, h) + boff + n * 2048 + 1024)); } else { \
        _Pragma("unroll") for (int n = 0; n < 2; ++n) _Pragma("unroll") for (int k = 0; k < 2; ++k) dst[n][k] = *(const PG8_LAS bf16x8*)(lds + PG8_SB(b, h) + boff + n * 2048 + k * 1024); } } while (0)
#define PG8_MMA(ai, bj, At, Bt) do { __builtin_amdgcn_s_setprio(1); if constexpr (F8) { _Pragma("unroll") for (int m = 0; m < 4; ++m) _Pragma("unroll") for (int n = 0; n < 2; ++n) \
        acc[ai][bj][m][n] = __builtin_amdgcn_mfma_scale_f32_16x16x128_f8f6f4(Bt##8[n], At##8[m], acc[ai][bj][m][n], 0, 0, 0, 0x7F7F7F7F, 0, 0x7F7F7F7F); \
        _Pragma("unroll") for (int m = 0; m < 4; ++m) _Pragma("unroll") for (int n = 0; n < 2; ++n) asm volatile("" : "+v"(acc[ai][bj][m][n])); } else { \
        _Pragma("unroll") for (int m = 0; m < 4; ++m) _Pragma("unroll") for (int n = 0; n < 2; ++n) _Pragma("unroll") for (int k = 0; k < 2; ++k) \
        acc[ai][bj][m][n] = __builtin_amdgcn_mfma_f32_16x16x32_bf16(Bt[n][k], At[m][k], acc[ai][bj][m][n], 0, 0, 0); } __builtin_amdgcn_s_setprio(0); } while (0)
#define PG8_WAIT_V(n) asm volatile("s_waitcnt vmcnt(" #n ")" ::: "memory")
#define PG8_WAIT_L(n) asm volatile("s_waitcnt lgkmcnt(" #n ")" ::: "memory")
#define PG8_BAR __builtin_amdgcn_s_barrier()
#define PG8_SCHED __builtin_amdgcn_sched_barrier(0)
    Unit cur, nxt; int ui = 0;
    if (!S.next(0, cur)) return;
    f32x4 acc[2][2][4][2];
#pragma unroll
    for (int a = 0; a < 2; ++a)
#pragma unroll
        for (int b = 0; b < 2; ++b)
#pragma unroll
            for (int m = 0; m < 4; ++m)
#pragma unroll
                for (int n = 0; n < 2; ++n) acc[a][b][m][n] = (f32x4){0.f, 0.f, 0.f, 0.f};
    bf16x8 At[4][2], B0[2][2], B1[2][2]; i32x8 At8[4], B08[2], B18[2];
    const char* cA = (const char*)g.A + (size_t)cur.pm * tstep; const char* cB = (const char*)g.Bt + (size_t)cur.pn * tstep;
    S.a_ready(cur);
    if constexpr (SP2) {
        PG8_STAGE(PG8_SB(0, 0), cB, voffB); PG8_STAGE(PG8_SB(0, 1), cB + hstep, voffB); PG8_STAGE(PG8_SA(0, 0), cA, voffA); PG8_STAGE(PG8_SA(0, 1), cA + hstep, voffA);
        if (wr == 1) PG8_BAR;
        PG8_WAIT_V(2); PG8_BAR;
        PG8_STAGE(PG8_SB(1, 0), cB + kstep, voffB); PG8_STAGE(PG8_SA(1, 0), cA + kstep, voffA); PG8_STAGE(PG8_SB(1, 1), cB + hstep + kstep, voffB);
        PG8_WAIT_V(6); PG8_BAR;
    } else {
        PG8_STAGE(PG8_SB(0, 0), cB, voffB); PG8_STAGE(PG8_SA(0, 0), cA, voffA); PG8_STAGE(PG8_SB(0, 1), cB + hstep, voffB); PG8_STAGE(PG8_SA(0, 1), cA + hstep, voffA);
        if (wr == 1) PG8_BAR;
        PG8_WAIT_V(4); PG8_BAR;
        PG8_STAGE(PG8_SB(1, 0), cB + kstep, voffB); PG8_STAGE(PG8_SA(1, 0), cA + kstep, voffA); PG8_STAGE(PG8_SB(1, 1), cB + hstep + kstep, voffB);
        PG8_WAIT_V(6); PG8_BAR;
    }
    for (;;) {
        const bool has_next = S.next(ui + 1, nxt);
        const char* nA = has_next ? (const char*)g.A + (size_t)nxt.pm * tstep : cA; const char* nB = has_next ? (const char*)g.Bt + (size_t)nxt.pn * tstep : cB;
        for (int t = 0; t < nt; t += 2) {
            const bool last = (t == nt - 2);
            const char* a1 = cA + (size_t)(t + 1) * kstep;
            const char* a2 = last ? nA : cA + (size_t)(t + 2) * kstep; const char* b2 = last ? nB : cB + (size_t)(t + 2) * kstep;
            const char* a3 = a2 + kstep; const char* b3 = b2 + kstep;
            if (last && has_next) S.a_ready(nxt);
            if constexpr (SP2) {
            PG8_LDB(B0, 0, 0); PG8_LDB(B1, 0, 1); PG8_SCHED; PG8_LDA(At, 0, 0); PG8_STAGE(PG8_SA(1, 1), a1 + hstep, voffA);
            PG8_WAIT_V(8); PG8_WAIT_L(0); PG8_BAR; PG8_MMA(0, 0, At, B0); PG8_MMA(0, 1, At, B1); PG8_BAR; PG8_SCHED;
            PG8_LDA(At, 0, 1); PG8_STAGE(PG8_SB(0, 0), b2, voffB); PG8_STAGE(PG8_SB(0, 1), b2 + hstep, voffB); PG8_STAGE(PG8_SA(0, 0), a2, voffA);
            PG8_WAIT_V(8); PG8_WAIT_L(0); PG8_BAR; PG8_MMA(1, 0, At, B0); PG8_MMA(1, 1, At, B1); PG8_BAR; PG8_SCHED;
            PG8_LDB(B0, 1, 0); PG8_LDB(B1, 1, 1); PG8_SCHED; PG8_LDA(At, 1, 0); PG8_STAGE(PG8_SA(0, 1), a2 + hstep, voffA);
            PG8_WAIT_V(8); PG8_WAIT_L(0); PG8_BAR; PG8_MMA(0, 0, At, B0); PG8_MMA(0, 1, At, B1); PG8_BAR; PG8_SCHED;
            PG8_LDA(At, 1, 1); PG8_STAGE(PG8_SB(1, 0), b3, voffB); PG8_STAGE(PG8_SB(1, 1), b3 + hstep, voffB); PG8_STAGE(PG8_SA(1, 0), a3, voffA);
            PG8_WAIT_V(8); PG8_WAIT_L(0); PG8_BAR; PG8_MMA(1, 0, At, B0); PG8_MMA(1, 1, At, B1); PG8_BAR; PG8_SCHED;
            } else {
            PG8_LDB(B0, 0, 0); PG8_SCHED; PG8_LDA(At, 0, 0); PG8_STAGE(PG8_SA(1, 1), a1 + hstep, voffA);
            PG8_WAIT_L(8); PG8_BAR; PG8_WAIT_L(0); PG8_MMA(0, 0, At, B0); PG8_BAR; PG8_SCHED;
            PG8_LDB(B1, 0, 1); PG8_STAGE(PG8_SB(0, 0), b2, voffB);
            PG8_BAR; PG8_WAIT_L(0); PG8_MMA(0, 1, At, B1); PG8_BAR;
            PG8_LDA(At, 0, 1); PG8_STAGE(PG8_SA(0, 0), a2, voffA);
            PG8_BAR; PG8_WAIT_L(0); PG8_MMA(1, 0, At, B0); PG8_BAR; PG8_SCHED;
            PG8_STAGE(PG8_SB(0, 1), b2 + hstep, voffB);
            PG8_WAIT_V(6); PG8_BAR; PG8_MMA(1, 1, At, B1); PG8_BAR;
            PG8_LDB(B0, 1, 0); PG8_SCHED; PG8_LDA(At, 1, 0); PG8_STAGE(PG8_SA(0, 1), a2 + hstep, voffA);
            PG8_WAIT_L(8); PG8_BAR; PG8_WAIT_L(0); PG8_MMA(0, 0, At, B0); PG8_BAR; PG8_SCHED;
            PG8_LDB(B1, 1, 1); PG8_STAGE(PG8_SB(1, 0), b3, voffB);
            PG8_BAR; PG8_WAIT_L(0); PG8_MMA(0, 1, At, B1); PG8_BAR;
            PG8_LDA(At, 1, 1); PG8_STAGE(PG8_SA(1, 0), a3, voffA);
            PG8_BAR; PG8_WAIT_L(0); PG8_MMA(1, 0, At, B0); PG8_BAR; PG8_SCHED;
            PG8_STAGE(PG8_SB(1, 1), b3 + hstep, voffB);
            PG8_WAIT_V(6); PG8_BAR; PG8_MMA(1, 1, At, B1); PG8_BAR;
            }
        }
        if constexpr (ALIGN_EPI) { if (wr == 0) PG8_BAR; }
        if constexpr (!Epi::AFTER_DRAIN) { E(acc, cur, wr, wc, fr, fq); S.done(cur); }
        if (!has_next) break;
#pragma unroll
        for (int a = 0; a < 2; ++a)
#pragma unroll
            for (int b = 0; b < 2; ++b)
#pragma unroll
                for (int m = 0; m < 4; ++m)
#pragma unroll
                    for (int n = 0; n < 2; ++n) acc[a][b][m][n] = (f32x4){0.f, 0.f, 0.f, 0.f};
        cur = nxt; cA = nA; cB = nB; ++ui;
        if constexpr (ALIGN_EPI) { if (wr == 1) PG8_BAR; }
    }
    PG8_WAIT_V(0);
    if constexpr (!ALIGN_EPI) { if (wr == 0) PG8_BAR; }
    PG8_BAR;
    if constexpr (Epi::AFTER_DRAIN) { E.fused(acc, cur, wr, wc, fr, fq, lds, wid, lane); S.done(cur); }
#undef PG8_SA
#undef PG8_SB
#undef PG8_STAGE
#undef PG8_LDA
#undef PG8_LDB
#undef PG8_MMA
#undef PG8_WAIT_V
#undef PG8_WAIT_L
#undef PG8_BAR
#undef PG8_SCHED
}
}
#ifndef PG8_SP2
#define PG8_SP2 true
#endif
#ifndef PG8_ALIGN
#define PG8_ALIGN true
#endif
#ifndef MK_PER_PHASE
#define MK_PER_PHASE 0
#endif
#ifndef REP_S5
#define REP_S5 1
#endif
#ifndef REP_DSA
#define REP_DSA 1
#endif
#ifndef REP_G1
#define REP_G1 1
#endif
#ifndef PROBE_SEC
#define PROBE_SEC 0
#endif
#define PROBE_BEGIN(k) do { if (PROBE_SEC == (k) && blockIdx.x == 0 && threadIdx.x == 0) { const unsigned long long t_ = wall_clock64(); PRB[2] = (unsigned)t_; PRB[3] = (unsigned)(t_ >> 32); } } while (0)
#define PROBE_END(k) do { if (PROBE_SEC == (k) && blockIdx.x == 0 && threadIdx.x == 0) { const unsigned long long t0_ = ((unsigned long long)PRB[3] << 32) | PRB[2]; const unsigned long long a_ = (((unsigned long long)PRB[1] << 32) | PRB[0]) + (wall_clock64() - t0_); PRB[0] = (unsigned)a_; PRB[1] = (unsigned)(a_ >> 32); } } while (0)
constexpr int NWAVES = 8;
constexpr int NPH = 14;

constexpr int NB = 16, SEQ = 2048, D = 1024, NMETA = 16, DFF = 2816;
constexpr int R = NB * SEQ;
constexpr int NG = 32, NP = 64, NM = 16;
constexpr float RMS_EPS = 1e-6f;

constexpr size_t MiB = 1u << 20;
constexpr size_t WS_CTL = 0, CTL_ZERO_BYTES = 32768;
constexpr size_t WS_WT3B = 23 * MiB  ;
constexpr size_t WS_WT1 = 2 * MiB, WS_WT2 = 13 * MiB, WS_WT3 = 19 * MiB, WS_WT4 = 27 * MiB, WS_WT5 = 38 * MiB;
constexpr size_t WS_WGLU = 44 * MiB, WS_WA = 45 * MiB, WS_WB = 46 * MiB, WS_WOUT = 47 * MiB;
constexpr size_t WS_KS = 50 * MiB, WS_KO = 58 * MiB, WS_KI = 66 * MiB;
constexpr size_t WS_META = 67 * MiB;
constexpr size_t MO_AM1 = 0, MO_ACTM = 32768, MO_FM = 131072, MO_AM2 = 262144, MO_PMU = 294912, MO_PMK = 311296;
constexpr size_t WS_HN = 68 * MiB;
constexpr size_t WS_F = 132 * MiB;
constexpr size_t WS_BIG = 196 * MiB;
constexpr size_t WS_PA = WS_BIG, WS_PG = WS_BIG + 96 * MiB, WS_PK = WS_BIG + 224 * MiB, WS_HB = WS_BIG + 240 * MiB  , WS_END = 503 * MiB;
constexpr size_t WS_WT2Q = 500 * MiB;
constexpr size_t WS_HB8 = WS_BIG + 64 * MiB;
constexpr size_t WS_UA2 = WS_F + 32 * MiB;
constexpr int CW_BAR = 4096;

constexpr int LDS_BYTES = 155648;
constexpr int MISC_OFF = 154624;

#define GAS __attribute__((address_space(1)))
#define LAS __attribute__((address_space(3)))
typedef unsigned short bf16;
typedef unsigned v4u __attribute__((ext_vector_type(4)));
typedef unsigned v2u __attribute__((ext_vector_type(2)));
typedef float f32x4 __attribute__((ext_vector_type(4)));
typedef short bf16x8 __attribute__((ext_vector_type(8)));
#define LDS_WAIT() asm volatile("s_waitcnt lgkmcnt(0)" ::: "memory")
#define VM_WAIT() asm volatile("s_waitcnt vmcnt(0)" ::: "memory")
__device__ __forceinline__ unsigned f2bf(float f) { unsigned u = __builtin_bit_cast(unsigned, f); return (u + 0x7fffu + ((u >> 16) & 1u)) >> 16; }
__device__ __forceinline__ unsigned pk2(float lo, float hi) { return f2bf(lo) | (f2bf(hi) << 16); }
__device__ __forceinline__ float bflo(unsigned w) { return __uint_as_float(w << 16); }
__device__ __forceinline__ float bfhi(unsigned w) { return __uint_as_float(w & 0xffff0000u); }
__device__ __forceinline__ float bf2f(bf16 v) { return __uint_as_float(((unsigned)v) << 16); }
__device__ __forceinline__ float fsig(float x) { return __builtin_amdgcn_rcpf(1.0f + __expf(-x)); }

#define XB_TMO      128
#define XB_XCNT(j)  (256  + 64 * (j))
#define XB_XSUB(j)  (1280 + 64 * (j))
#define XB_XGEN(j)  (2304 + 64 * (j))
#define XB_TOP      3328
#define XB_TOPGEN   3392
#define XCD_BAR_WORDS 3456
#define XB_SPIN_CAP (1u << 18)
__device__ __forceinline__ unsigned xb_ld(unsigned* p)              { return __hip_atomic_load(p, __ATOMIC_RELAXED, __HIP_MEMORY_SCOPE_AGENT); }
__device__ __forceinline__ unsigned xb_add(unsigned* p, unsigned v) { return __hip_atomic_fetch_add(p, v, __ATOMIC_RELAXED, __HIP_MEMORY_SCOPE_AGENT); }
__device__ __forceinline__ unsigned xb_xcc_id() { return (unsigned)__builtin_amdgcn_s_getreg((3 << 11) | 20) & 0xFu; }
#define XB_SPIN(cond, bar) do { unsigned _sp = 0; while (cond) { __builtin_amdgcn_s_sleep(1); \
    if ((++_sp & 255u) == 0u) { if (xb_ld(&(bar)[XB_TMO])) break; if (_sp > XB_SPIN_CAP) { atomicAdd(&(bar)[XB_TMO], 1u); break; } } } } while (0)
struct XcdBarrier { unsigned* bar; unsigned x; volatile LAS unsigned* st; };
__device__ __forceinline__ XcdBarrier xcd_barrier_post(unsigned* bar, volatile LAS unsigned* st) {
    XcdBarrier b; b.bar = bar; b.x = xb_xcc_id(); b.st = st;
    if (threadIdx.x == 0) (void)xb_add(&bar[XB_XCNT(b.x)], 1u);
    return b;
}
__device__ __forceinline__ void xcd_barrier_complete(unsigned* bar, unsigned x, unsigned& nloc, unsigned& nx) {
    const unsigned G = gridDim.x * gridDim.y * gridDim.z;
    unsigned sum, cnt, mine, sp = 0u;
    for (;;) {
        sum = 0u; cnt = 0u; mine = 0u;
#pragma unroll
        for (unsigned j = 0; j < 16; ++j) { const unsigned c = xb_ld(&bar[XB_XCNT(j)]); sum += c; cnt += (c > 0u) ? 1u : 0u; mine = (j == x) ? c : mine; }
        if (sum == G) break;
        __builtin_amdgcn_s_sleep(1);
        if ((++sp & 255u) == 0u) { if (xb_ld(&bar[XB_TMO])) break; if (sp > XB_SPIN_CAP) { atomicAdd(&bar[XB_TMO], 1u); break; } }
    }
    nloc = mine > 0u ? mine : 1u; nx = cnt > 0u ? cnt : 1u;
}
__device__ __forceinline__ void xcd_barrier(const XcdBarrier& b) {
    asm volatile("s_waitcnt vmcnt(0)" ::: "memory");
    __syncthreads();
    if (threadIdx.x == 0) {
        unsigned* bar = b.bar;
        __builtin_amdgcn_s_waitcnt(0);
        unsigned nloc = b.st[0], nx = b.st[1];
        if (nloc == 0u) { xcd_barrier_complete(bar, b.x, nloc, nx); b.st[0] = nloc; b.st[1] = nx; }
        const unsigned old = xb_add(&bar[XB_XSUB(b.x)], 1u);
        const unsigned gen = old / nloc;
        if (old + 1u == (gen + 1u) * nloc) {
            __builtin_amdgcn_fence(__ATOMIC_RELEASE, "agent");
            asm volatile("s_waitcnt vmcnt(0)" ::: "memory");
            const unsigned og = xb_add(&bar[XB_TOP], 1u);
            const unsigned tg = og / nx;
            if (og + 1u == (tg + 1u) * nx) xb_add(&bar[XB_TOPGEN], 1u);
            else XB_SPIN(xb_ld(&bar[XB_TOPGEN]) == tg, bar);
            __builtin_amdgcn_fence(__ATOMIC_ACQUIRE, "agent");
            xb_add(&bar[XB_XGEN(b.x)], 1u);
            asm volatile("s_waitcnt vmcnt(0)" ::: "memory");
        } else {
            XB_SPIN(xb_ld(&bar[XB_XGEN(b.x)]) == gen, bar);
            __builtin_amdgcn_fence(__ATOMIC_ACQUIRE, "agent");
            asm volatile("s_waitcnt vmcnt(0)" ::: "memory");
        }
    }
    __syncthreads();
}

__device__ __forceinline__ float wave_sum(float v) {
#pragma unroll
    for (int o = 1; o < 64; o <<= 1) v += __shfl_xor(v, o);
    return v;
}
__device__ __forceinline__ f32x4 mfma16(bf16x8 a, bf16x8 b, f32x4 c) { return __builtin_amdgcn_mfma_f32_16x16x32_bf16(a, b, c, 0, 0, 0); }

__device__ __forceinline__ void transpose_item(const float* W, int Nsrc, int K, bf16* WT, int k0, int drow0, int srccol, LAS float* scr, int lane, const float* gk = nullptr) {
    f32x4 wl[8];
#pragma unroll
    for (int i = 0; i < 8; ++i) { const int kk = 8 * i + (lane >> 3); wl[i] = (srccol >= 0) ? *(const f32x4*)(W + (size_t)(k0 + kk) * Nsrc + srccol) : (f32x4){0.f, 0.f, 0.f, 0.f}; }
#pragma unroll
    for (int i = 0; i < 8; ++i) { const int kk = 8 * i + (lane >> 3); f32x4 v = wl[i]; if (gk) v = v * gk[k0 + kk]; LAS float* d = scr + kk * 33 + 4 * (lane & 7); d[0] = v.x; d[1] = v.y; d[2] = v.z; d[3] = v.w; }
    LDS_WAIT(); asm volatile("" ::: "memory");
    const int c = lane & 7;
#pragma unroll
    for (int j = 0; j < 4; ++j) { const int n = (lane >> 3) + 8 * j; const LAS float* s = scr + (8 * c) * 33 + n;
        v4u o; o.x = pk2(s[0 * 33], s[1 * 33]); o.y = pk2(s[2 * 33], s[3 * 33]); o.z = pk2(s[4 * 33], s[5 * 33]); o.w = pk2(s[6 * 33], s[7 * 33]);
        *(v4u*)(WT + (size_t)(drow0 + n) * K + k0 + 8 * c) = o; }
    LDS_WAIT(); asm volatile("" ::: "memory");
}

__device__ __forceinline__ unsigned pk4q(float a, float b, float c, float d) { int w = 0; w = __builtin_amdgcn_cvt_pk_fp8_f32(__builtin_amdgcn_fmed3f(a, -448.f, 448.f), __builtin_amdgcn_fmed3f(b, -448.f, 448.f), w, false);
    w = __builtin_amdgcn_cvt_pk_fp8_f32(__builtin_amdgcn_fmed3f(c, -448.f, 448.f), __builtin_amdgcn_fmed3f(d, -448.f, 448.f), w, true); return (unsigned)w; }
__device__ __forceinline__ void transpose_item8(const float* W, int Nsrc, int K, unsigned char* WT8, int k0, int drow0, int srccol, LAS float* scr, int lane, const float* gk = nullptr) {
    f32x4 wl[8];
#pragma unroll
    for (int i = 0; i < 8; ++i) { const int kk = 8 * i + (lane >> 3); wl[i] = *(const f32x4*)(W + (size_t)(k0 + kk) * Nsrc + srccol); }
#pragma unroll
    for (int i = 0; i < 8; ++i) { const int kk = 8 * i + (lane >> 3); f32x4 v = wl[i] * 64.0f; if (gk) v = v * gk[k0 + kk]; LAS float* d = scr + kk * 33 + 4 * (lane & 7); d[0] = v.x; d[1] = v.y; d[2] = v.z; d[3] = v.w; }
    LDS_WAIT(); asm volatile("" ::: "memory");
    const int c = lane & 7;
#pragma unroll
    for (int j = 0; j < 4; ++j) { const int n = (lane >> 3) + 8 * j; const LAS float* sp = scr + (8 * c) * 33 + n;
        v2u o; o.x = pk4q(sp[0 * 33], sp[1 * 33], sp[2 * 33], sp[3 * 33]); o.y = pk4q(sp[4 * 33], sp[5 * 33], sp[6 * 33], sp[7 * 33]);
        *(v2u*)(WT8 + (size_t)(drow0 + n) * K + k0 + 8 * c) = o; }
    LDS_WAIT(); asm volatile("" ::: "memory");
}
__device__ __forceinline__ int win_srccol(int d) {
    if (d < 1024) return d;
    if (d < 1536) return 1096 + (d - 1024);
    if (d < 1600) return 1024 + (d - 1536);
    if (d < 1664) return 1608 + (d - 1600);
    if (d < 1728) return 1672 + (d - 1664);
    if (d < 1736) return 1088 + (d - 1728);
    return -1;
}
__device__ __forceinline__ void norm_row_to_bf16(const float* xrow, const float* g, bf16* orow, int lane) {
    f32x4 v[4]; float ss = 0.f;
#pragma unroll
    for (int j = 0; j < 4; ++j) { v[j] = ((const f32x4*)xrow)[lane + 64 * j]; ss += (v[j].x * v[j].x + v[j].y * v[j].y) + (v[j].z * v[j].z + v[j].w * v[j].w); }
    const float rs = rsqrtf(wave_sum(ss) * (1.f / D) + RMS_EPS);
#pragma unroll
    for (int j = 0; j < 4; ++j) { const f32x4 gv = ((const f32x4*)g)[lane + 64 * j]; v2u o; o.x = pk2(v[j].x * rs * gv.x, v[j].y * rs * gv.y); o.y = pk2(v[j].z * rs * gv.z, v[j].w * rs * gv.w);
        ((v2u*)orow)[lane + 64 * j] = o; }
}

struct Args { const float* in[28]; float* out; unsigned char* ws; int ph_lo, ph_hi; };
struct TrDesc { const float* src; const float* gk; unsigned char* dst; int nsrc, K, k0, drow0; int f8; int valid; };
__device__ __forceinline__ void tr_decode(const Args& a, unsigned char* ws, int it, int lane, TrDesc& d) {
    const int n4 = 4 * (lane & 7); int r = it; d.gk = nullptr; d.f8 = 0; d.valid = 1; int srccol;
    if (r >= 11520) { r -= 11520; const int kb = r / 32, nb = r % 32; d.nsrc = D; d.K = DFF; d.k0 = 64 * kb; d.drow0 = 32 * nb; srccol = 32 * nb + n4; d.src = a.in[10]; d.dst = ws + WS_WT2Q; d.f8 = 1;
        d.src += (size_t)(d.k0 + (lane >> 3)) * d.nsrc + srccol; return; }
    if (r < 6 * 1408) { const int mat = r / 1408; r -= mat * 1408;
        if (mat == 2 || mat == 5) { const int kb = r / 32, nb = r % 32; d.nsrc = D; d.K = DFF; d.k0 = 64 * kb; d.drow0 = 32 * nb; srccol = 32 * nb + n4;
            d.src = a.in[mat == 2 ? 10 : 13]; d.dst = ws + (mat == 2 ? WS_WT2 : WS_WT5); d.f8 = (mat == 5); }
        else { const int kb = r / 88, nb = r % 88, d0 = 32 * nb, up = (mat == 1 || mat == 4) ? 128 : 0; d.nsrc = DFF; d.K = D; d.k0 = 64 * kb; d.drow0 = 256 * (d0 >> 7) + (d0 & 127) + up; srccol = d0 + n4;
            d.src = a.in[mat == 0 ? 8 : mat == 1 ? 9 : mat == 3 ? 11 : 12]; d.dst = ws + (mat < 3 ? WS_WT1 : WS_WT4); d.f8 = (mat >= 3); if (mat < 3) d.gk = a.in[2]; }
    } else { r -= 6 * 1408;
        if (r < 896) { const int kb = r / 56, nb = r % 56; d.nsrc = 3784; d.K = D; d.k0 = 64 * kb; d.drow0 = 32 * nb; srccol = win_srccol(32 * nb + n4); d.src = a.in[14]; d.dst = ws + WS_WT3; d.gk = a.in[4]; if (srccol < 0) { d.valid = 0; srccol = 0; } }
        else { r -= 896;
            if (r < 1024) { const int kb = r / 64, nb = r % 64; d.nsrc = 3784; d.K = D; d.k0 = 64 * kb; d.drow0 = 32 * nb; srccol = 1736 + 32 * nb + n4; d.src = a.in[14]; d.dst = ws + WS_WT3B; d.gk = a.in[4]; d.f8 = 1; }
            else { r -= 1024;
                if (r < 128) { const int kb = r / 16, nb = r % 16; d.nsrc = 512; d.K = 512; d.k0 = 64 * kb; d.drow0 = 32 * nb; srccol = 32 * nb + n4; d.src = a.in[23]; d.dst = ws + WS_WGLU; }
                else { r -= 128; const int which = r / 256; r -= which * 256;
                    if (which < 2) { const int kb = r / 32, nb = r % 32; d.nsrc = D; d.K = 512; d.k0 = 64 * kb; d.drow0 = 32 * nb; srccol = 32 * nb + n4; d.src = a.in[which == 0 ? 24 : 26]; d.dst = ws + (which == 0 ? WS_WA : WS_WB); }
                    else { const int r2 = r + (which - 2) * 256; const int kb = r2 / 32, nb = r2 % 32; d.nsrc = D; d.K = D; d.k0 = 64 * kb; d.drow0 = 32 * nb; srccol = 32 * nb + n4; d.src = a.in[27]; d.dst = ws + WS_WOUT; } } } } }
    d.src += (size_t)(d.k0 + (lane >> 3)) * d.nsrc + srccol;
}
__device__ __forceinline__ void tr_load(const TrDesc& d, f32x4 (&wl)[8]) {
#pragma unroll
    for (int i = 0; i < 8; ++i) wl[i] = d.valid ? *(const f32x4*)(d.src + (size_t)(8 * i) * d.nsrc) : (f32x4){0.f, 0.f, 0.f, 0.f};
}
__device__ __forceinline__ void tr_finish(const TrDesc& d, const f32x4 (&wl)[8], LAS float* scr, int lane) {
    const float sc8 = d.f8 ? 64.0f : 1.0f;
#pragma unroll
    for (int i = 0; i < 8; ++i) { const int kk = 8 * i + (lane >> 3); f32x4 v = wl[i] * sc8; if (d.gk) v = v * d.gk[d.k0 + kk]; LAS float* p = scr + kk * 33 + 4 * (lane & 7); p[0] = v.x; p[1] = v.y; p[2] = v.z; p[3] = v.w; }
    LDS_WAIT(); asm volatile("" ::: "memory");
    const int c = lane & 7;
#pragma unroll
    for (int j = 0; j < 4; ++j) { const int n = (lane >> 3) + 8 * j; const LAS float* sp = scr + (8 * c) * 33 + n;
        if (d.f8) { v2u o; o.x = pk4q(sp[0 * 33], sp[1 * 33], sp[2 * 33], sp[3 * 33]); o.y = pk4q(sp[4 * 33], sp[5 * 33], sp[6 * 33], sp[7 * 33]); *(v2u*)(d.dst + (size_t)(d.drow0 + n) * d.K + d.k0 + 8 * c) = o; }
        else { v4u o; o.x = pk2(sp[0 * 33], sp[1 * 33]); o.y = pk2(sp[2 * 33], sp[3 * 33]); o.z = pk2(sp[4 * 33], sp[5 * 33]); o.w = pk2(sp[6 * 33], sp[7 * 33]); *(v4u*)((bf16*)d.dst + (size_t)(d.drow0 + n) * d.K + d.k0 + 8 * c) = o; } }
    LDS_WAIT(); asm volatile("" ::: "memory");
}
template <bool PRESCALE>
__device__ __forceinline__ void x_row_to_bf16(const float* xrow, bf16* orow, float* rs_out, int lane) {
    f32x4 v[4]; float ss = 0.f;
#pragma unroll
    for (int j = 0; j < 4; ++j) { v[j] = ((const f32x4*)xrow)[lane + 64 * j]; ss += (v[j].x * v[j].x + v[j].y * v[j].y) + (v[j].z * v[j].z + v[j].w * v[j].w); }
    const float rs = rsqrtf(wave_sum(ss) * (1.f / D) + RMS_EPS), pre = PRESCALE ? rs : 1.0f;
#pragma unroll
    for (int j = 0; j < 4; ++j) { v2u o; o.x = pk2(v[j].x * pre, v[j].y * pre); o.y = pk2(v[j].z * pre, v[j].w * pre); ((v2u*)orow)[lane + 64 * j] = o; }
    if (rs_out && lane == 0) *rs_out = rs;
}
template <bool BASE_BF16, bool OUT_BF16, bool HN_F8 = false>
__device__ __forceinline__ void row_update(const bf16* frow, const void* base, void* outrow, bf16* hnrow, const float* gpost, const float* gnext, float scale, int lane, float* rs_out = nullptr, unsigned* h8row = nullptr) {
    f32x4 f[4], h[4]; float ss = 0.f;
#pragma unroll
    for (int j = 0; j < 4; ++j) { const v2u w = ((const v2u*)frow)[lane + 64 * j]; f[j] = (f32x4){bflo(w.x), bfhi(w.x), bflo(w.y), bfhi(w.y)};
        ss += (f[j].x * f[j].x + f[j].y * f[j].y) + (f[j].z * f[j].z + f[j].w * f[j].w); }
    const float rs = rsqrtf(wave_sum(ss) * (1.f / D) + RMS_EPS) * scale; float s2 = 0.f;
#pragma unroll
    for (int j = 0; j < 4; ++j) { const f32x4 gv = ((const f32x4*)gpost)[lane + 64 * j]; f32x4 bv;
        if (BASE_BF16) { const v2u w = ((const v2u*)base)[lane + 64 * j]; bv = (f32x4){bflo(w.x), bfhi(w.x), bflo(w.y), bfhi(w.y)}; } else bv = ((const f32x4*)base)[lane + 64 * j];
        h[j] = bv + f[j] * rs * gv; s2 += (h[j].x * h[j].x + h[j].y * h[j].y) + (h[j].z * h[j].z + h[j].w * h[j].w); }
    if (h8row) {
#pragma unroll
        for (int j = 0; j < 4; ++j) h8row[lane + 64 * j] = pk4q(4.0f * h[j].x, 4.0f * h[j].y, 4.0f * h[j].z, 4.0f * h[j].w); }
    if (outrow) {
#pragma unroll
        for (int j = 0; j < 4; ++j) { if (OUT_BF16) { v2u o; o.x = pk2(h[j].x, h[j].y); o.y = pk2(h[j].z, h[j].w); ((v2u*)outrow)[lane + 64 * j] = o; } else ((f32x4*)outrow)[lane + 64 * j] = h[j]; } }
    if (hnrow || rs_out) { const float r2 = rsqrtf(wave_sum(s2) * (1.f / D) + RMS_EPS); if (rs_out && lane == 0) *rs_out = r2;
        if (hnrow)
#pragma unroll
        for (int j = 0; j < 4; ++j) { const f32x4 gv = gnext ? ((const f32x4*)gnext)[lane + 64 * j] : (f32x4){1.f, 1.f, 1.f, 1.f};
            if (HN_F8) { const float q = 4.0f * r2; ((unsigned*)hnrow)[lane + 64 * j] = pk4q(h[j].x * q * gv.x, h[j].y * q * gv.y, h[j].z * q * gv.z, h[j].w * q * gv.w); }
            else { v2u o; o.x = pk2(h[j].x * r2 * gv.x, h[j].y * r2 * gv.y); o.y = pk2(h[j].z * r2 * gv.z, h[j].w * r2 * gv.w); ((v2u*)hnrow)[lane + 64 * j] = o; } } }
}

template <bool OUT_BF16, bool HAS_HN8, bool HAS_RS, bool HAS_H8, int NR = 2>
__device__ __forceinline__ void rows_phase(const bf16* F, const bf16* BASE, void* OUT, unsigned char* HN8, const float* gpost, const float* gnext, float scale, float* RS, unsigned char* H8, int gw, int NGW, int lane) {
    f32x4 gp[4], gn[4];
#pragma unroll
    for (int j = 0; j < 4; ++j) { gp[j] = ((const f32x4*)gpost)[lane + 64 * j]; gn[j] = HAS_HN8 ? ((const f32x4*)gnext)[lane + 64 * j] : (f32x4){1.f, 1.f, 1.f, 1.f}; }
    for (int m0 = gw; m0 < R; m0 += NR * NGW) {
        v2u fw[NR][4], bw[NR][4];
#pragma unroll
        for (int t = 0; t < NR; ++t) { const size_t m = (size_t)(m0 + t * NGW);
#pragma unroll
            for (int j = 0; j < 4; ++j) { fw[t][j] = ((const v2u*)(F + m * D))[lane + 64 * j]; bw[t][j] = ((const v2u*)(BASE + m * D))[lane + 64 * j]; } }
#pragma unroll
        for (int t = 0; t < NR; ++t) { const size_t m = (size_t)(m0 + t * NGW);
            f32x4 f[4], h[4]; float ss = 0.f;
#pragma unroll
            for (int j = 0; j < 4; ++j) { f[j] = (f32x4){bflo(fw[t][j].x), bfhi(fw[t][j].x), bflo(fw[t][j].y), bfhi(fw[t][j].y)}; ss += (f[j].x * f[j].x + f[j].y * f[j].y) + (f[j].z * f[j].z + f[j].w * f[j].w); }
            const float rs = rsqrtf(wave_sum(ss) * (1.f / D) + RMS_EPS) * scale; float s2 = 0.f;
#pragma unroll
            for (int j = 0; j < 4; ++j) { const f32x4 bv = (f32x4){bflo(bw[t][j].x), bfhi(bw[t][j].x), bflo(bw[t][j].y), bfhi(bw[t][j].y)};
                h[j] = bv + f[j] * rs * gp[j]; s2 += (h[j].x * h[j].x + h[j].y * h[j].y) + (h[j].z * h[j].z + h[j].w * h[j].w); }
            if (HAS_H8) {
#pragma unroll
                for (int j = 0; j < 4; ++j) ((unsigned*)(H8 + m * D))[lane + 64 * j] = pk4q(4.0f * h[j].x, 4.0f * h[j].y, 4.0f * h[j].z, 4.0f * h[j].w); }
#pragma unroll
            for (int j = 0; j < 4; ++j) { if (OUT_BF16) { v2u o; o.x = pk2(h[j].x, h[j].y); o.y = pk2(h[j].z, h[j].w); ((v2u*)((bf16*)OUT + m * D))[lane + 64 * j] = o; } else ((f32x4*)((float*)OUT + m * D))[lane + 64 * j] = h[j]; }
            if (HAS_HN8 || HAS_RS) { const float r2 = rsqrtf(wave_sum(s2) * (1.f / D) + RMS_EPS); if (HAS_RS && lane == 0) RS[m] = r2;
                if (HAS_HN8) { const float q = 4.0f * r2;
#pragma unroll
                    for (int j = 0; j < 4; ++j) ((unsigned*)(HN8 + m * D))[lane + 64 * j] = pk4q(h[j].x * q * gn[j].x, h[j].y * q * gn[j].y, h[j].z * q * gn[j].z, h[j].w * q * gn[j].w); } } }
    }
}
__device__ __forceinline__ f32x4 meta_tile(const bf16* A, const bf16* B, int K, int lane) {
    const int fr = lane & 15, kq = lane >> 4; const bf16* ap = A + (size_t)fr * K + 8 * kq; const bf16* bp = B + (size_t)fr * K + 8 * kq;
    f32x4 acc = (f32x4){0.f, 0.f, 0.f, 0.f};
#pragma unroll 4
    for (int k = 0; k < K; k += 32) { const bf16x8 a = *(const bf16x8*)(ap + k); const bf16x8 b = *(const bf16x8*)(bp + k); acc = mfma16(a, b, acc); }
    return acc;
}


template <int STEPS>
__device__ __forceinline__ void meta_tile_blk(const bf16* A, const bf16* B0, const bf16* B1, int K, LAS float* red, int wave, int lane, f32x4& c0, f32x4& c1) {
    const int fr = lane & 15, kq = lane >> 4, k0 = wave * (32 * STEPS);
    const bf16* ap = A + (size_t)fr * K + k0 + 8 * kq; const bf16* bp0 = B0 + (size_t)fr * K + k0 + 8 * kq; const bf16* bp1 = (B1 ? B1 : B0) + (size_t)fr * K + k0 + 8 * kq;
    bf16x8 av[STEPS], bv0[STEPS], bv1[STEPS];
#pragma unroll
    for (int i = 0; i < STEPS; ++i) { av[i] = *(const bf16x8*)(ap + 32 * i); bv0[i] = *(const bf16x8*)(bp0 + 32 * i); bv1[i] = *(const bf16x8*)(bp1 + 32 * i); }
    f32x4 a0 = (f32x4){0.f, 0.f, 0.f, 0.f}, a1 = a0;
#pragma unroll
    for (int i = 0; i < STEPS; ++i) { a0 = mfma16(av[i], bv0[i], a0); a1 = mfma16(av[i], bv1[i], a1); }
    *(LAS f32x4*)(red + (wave * 64 + lane) * 8) = a0; *(LAS f32x4*)(red + (wave * 64 + lane) * 8 + 4) = a1;
    __syncthreads();
    c0 = (f32x4){0.f, 0.f, 0.f, 0.f}; c1 = c0;
#pragma unroll
    for (int w2 = 0; w2 < 8; ++w2) { c0 += *(const LAS f32x4*)(red + (w2 * 64 + lane) * 8); c1 += *(const LAS f32x4*)(red + (w2 * 64 + lane) * 8 + 4); }
    __syncthreads();
}


__device__ __forceinline__ void s5_tables_load(const Args& a, int g, LAS float* sc, int tid) {
    const float* b_re = a.in[18]; const float* b_im = a.in[19]; const float* c_re = a.in[20]; const float* c_im = a.in[21];
#pragma unroll
    for (int k = 0; k < 2; ++k) { const int e = tid + 512 * k; sc[e] = c_re[g * 1024 + e]; sc[1024 + e] = c_im[g * 1024 + e]; sc[2048 + e] = b_re[g * 1024 + e]; sc[3072 + e] = b_im[g * 1024 + e]; }
    __syncthreads();
}
__device__ __forceinline__ void s5_tables_wave(const Args& a, int g, int idx, const LAS float* sc, LAS float* wsc, int lane) {
    const LAS float* CR = sc; const LAS float* CI = sc + 1024; const LAS float* BR = sc + 2048; const LAS float* BI = sc + 3072;
    LAS float* WR = wsc; LAS float* WI = wsc + 64;
    const int p = lane; const float lr = a.in[15][g * 64 + p], li = a.in[16][g * 64 + p], dt = expf(a.in[17][g]);
    const float ang = li * dt, lrdt = lr * dt, mag = expf(lrdt); float s1, c1; sincosf(ang, &s1, &c1);
    const float a_re = mag * c1, a_im = mag * s1, den = lr * lr + li * li, nr = a_re - 1.0f, ni = a_im;
    const float cfr = (nr * lr + ni * li) / den, cfi = (ni * lr - nr * li) / den;
    { const float n = (float)idx; float sn, cn; sincosf(n * ang, &sn, &cn); const float mn = expf(n * lrdt); const float pr = mn * cn, pi = mn * sn;
      WR[p] = pr * cfr - pi * cfi; WI[p] = pr * cfi + pi * cfr; }
    LDS_WAIT();
#pragma unroll
    for (int k = 0; k < 4; ++k) { const int e = lane + 64 * k, m = e >> 4, mp = e & 15; float s = 0.f;
        for (int q = 0; q < 64; ++q) { const float wr_ = WR[q], wi_ = WI[q], br = BR[q * 16 + mp], bi = BI[q * 16 + mp];
            const float zr = wr_ * br - wi_ * bi, zi = wr_ * bi + wi_ * br; s += CR[m * 64 + q] * zr - CI[m * 64 + q] * zi; }
        if (idx == 0 && m == mp) s += a.in[22][g * 16 + m];
        ((bf16*)(a.ws + WS_KI))[((g * 64 + idx) * 16 + m) * 16 + mp] = (bf16)f2bf(s); }
    LDS_WAIT();
    { const float n = (float)(63 - idx); float sn, cn; sincosf(n * ang, &sn, &cn); const float mn = expf(n * lrdt); const float pr = mn * cn, pi = mn * sn;
      WR[p] = pr * cfr - pi * cfi; WI[p] = pr * cfi + pi * cfr; }
    LDS_WAIT();
    for (int k = 0; k < 32; ++k) { const int e = lane + 64 * k, n_ = e >> 4, mp = e & 15, q = n_ & 63;
        const float wr_ = WR[q], wi_ = WI[q], br = BR[q * 16 + mp], bi = BI[q * 16 + mp];
        const float zr = wr_ * br - wi_ * bi, zi = wr_ * bi + wi_ * br;
        ((bf16*)(a.ws + WS_KS))[((size_t)(g * 64 + idx) * 128 + n_) * 16 + mp] = (bf16)f2bf(n_ < 64 ? zr : zi); }
    LDS_WAIT();
    { const float n = (float)(idx + 1); float sn, cn; sincosf(n * ang, &sn, &cn); const float mn = expf(n * lrdt); WR[p] = mn * cn; WI[p] = mn * sn; }
    LDS_WAIT();
    for (int k = 0; k < 32; ++k) { const int e = lane + 64 * k, m = e >> 7, kk = e & 127, q = kk & 63;
        const float cr = CR[m * 64 + q], ci = CI[m * 64 + q], ar_ = WR[q], ai_ = WI[q];
        const float wr_ = cr * ar_ - ci * ai_, wi_ = cr * ai_ + ci * ar_;
        ((bf16*)(a.ws + WS_KO))[((size_t)(g * 64 + idx) * 16 + m) * 128 + kk] = (bf16)f2bf(kk < 64 ? wr_ : -wi_); }
    LDS_WAIT();
}

constexpr int S5_U = 0, S5_USTR = 2064, S5_KI = 66048, S5_SLOC = 98816, S5_XINB = 115200, S5_XSTR = 272, S5_MISC = 123904;
__device__ __forceinline__ float gelu_tanh(float x) { const float z = 0.7978845608028654f * (x + 0.044715f * x * x * x); return x * fsig(2.0f * z); }
__device__ __forceinline__ void s5_meta(const Args& a, LAS unsigned char* L, int g, int tid) {
    const int lane = tid & 63; const bf16* PMU = (const bf16*)(a.ws + WS_META + MO_PMU); LAS float* MS = (LAS float*)(L + S5_MISC);
    if (tid < 64) { const int p = lane; const float lr = a.in[15][g * 64 + p], li = a.in[16][g * 64 + p], dt = expf(a.in[17][g]);
        const float ang = li * dt, mag = expf(lr * dt); float s1, c1; sincosf(ang, &s1, &c1);
        const float a_re = mag * c1, a_im = mag * s1, den = lr * lr + li * li, nr = a_re - 1.0f, ni = a_im;
        const float cf_re = (nr * lr + ni * li) / den, cf_im = (ni * lr - nr * li) / den;
        float bb_re[16], bb_im[16];
#pragma unroll
        for (int m = 0; m < 16; ++m) { const float br = a.in[18][(g * 64 + p) * 16 + m], bi = a.in[19][(g * 64 + p) * 16 + m]; bb_re[m] = cf_re * br - cf_im * bi; bb_im[m] = cf_re * bi + cf_im * br; }
        LAS bf16* UM = (LAS bf16*)(L + S5_MISC + 1024);
        if (lane < 32) *(LAS v4u*)(UM + lane * 8) = *(const v4u*)(PMU + (lane >> 1) * 512 + 16 * g + 8 * (lane & 1));
        LDS_WAIT();
        float xr = 0.f, xi = 0.f;
#pragma unroll
        for (int i = 0; i < 16; ++i) { float ur = 0.f, ui = 0.f; const v4u w0 = *(const LAS v4u*)(UM + i * 16), w1 = *(const LAS v4u*)(UM + i * 16 + 8);
            const float uu[16] = {bflo(w0.x), bfhi(w0.x), bflo(w0.y), bfhi(w0.y), bflo(w0.z), bfhi(w0.z), bflo(w0.w), bfhi(w0.w), bflo(w1.x), bfhi(w1.x), bflo(w1.y), bfhi(w1.y), bflo(w1.z), bfhi(w1.z), bflo(w1.w), bfhi(w1.w)};
#pragma unroll
            for (int m = 0; m < 16; ++m) { ur += bb_re[m] * uu[m]; ui += bb_im[m] * uu[m]; }
            const float nr2 = a_re * xr - a_im * xi + ur, ni2 = a_re * xi + a_im * xr + ui; xr = nr2; xi = ni2; }
        float s64, c64; sincosf(64.0f * ang, &s64, &c64); const float m64 = expf(64.0f * lr * dt);
        MS[p] = xr; MS[64 + p] = xi; MS[128 + p] = m64 * c64; MS[192 + p] = m64 * s64; }
}
__device__ __forceinline__ void s5_unit(const Args& a, LAS unsigned char* L, int b, int g, int tid) {
    const int lane = tid & 63, w = __builtin_amdgcn_readfirstlane(tid >> 6), fr = lane & 15, kq = lane >> 4;
    const bf16* UA2 = (const bf16*)(a.ws + WS_UA2) + (size_t)(b * 32 + g) * 2048 * 16;
    const bf16* KS = (const bf16*)(a.ws + WS_KS); const bf16* KO = (const bf16*)(a.ws + WS_KO); const bf16* KI = (const bf16*)(a.ws + WS_KI);
    bf16* YA = (bf16*)(a.ws + WS_F);
    LAS float* SLOC = (LAS float*)(L + S5_SLOC); LAS float* MS = (LAS float*)(L + S5_MISC);
    __syncthreads();
#pragma unroll
    for (int k = 0; k < 8; ++k) { const int idx = tid + 512 * k, t = idx >> 1, hf = idx & 1;
        const v4u v = *(const v4u*)(UA2 + (size_t)idx * 8);
        *(LAS v4u*)(L + S5_U + (t >> 6) * S5_USTR + (t & 63) * 32 + 16 * hf) = v; }
#pragma unroll
    for (int k = 0; k < 4; ++k) { const int idx = tid + 512 * k; *(LAS v4u*)(L + S5_KI + idx * 16) = *(const v4u*)(KI + (size_t)g * 16384 + idx * 8); }
    bf16x8 bfr[16];
#pragma unroll
    for (int k = 0; k < 16; ++k) { const int i = 2 * k + (kq >> 1); bfr[k] = *(const bf16x8*)(KS + ((size_t)(g * 64 + i) * 128 + 16 * w + fr) * 16 + 8 * (kq & 1)); }
    __syncthreads();
    { f32x4 acc0 = (f32x4){0.f, 0.f, 0.f, 0.f}, acc1 = acc0;
#pragma unroll
      for (int hb = 0; hb < 2; ++hb) {
          if (hb == 1) {
#pragma unroll
              for (int k = 0; k < 16; ++k) { const int i = 2 * (16 + k) + (kq >> 1); bfr[k] = *(const bf16x8*)(KS + ((size_t)(g * 64 + i) * 128 + 16 * w + fr) * 16 + 8 * (kq & 1)); } }
#pragma unroll
          for (int k = 0; k < 16; ++k) { const int ks = 16 * hb + k;
              const bf16x8 a0 = *(const LAS bf16x8*)(L + S5_U + fr * S5_USTR + (32 * ks + 8 * kq) * 2);
              const bf16x8 a1 = *(const LAS bf16x8*)(L + S5_U + (16 + fr) * S5_USTR + (32 * ks + 8 * kq) * 2);
              acc0 = mfma16(a0, bfr[k], acc0); acc1 = mfma16(a1, bfr[k], acc1); } }
#pragma unroll
      for (int r = 0; r < 4; ++r) { SLOC[(4 * kq + r) * 128 + 16 * w + fr] = acc0[r]; SLOC[(16 + 4 * kq + r) * 128 + 16 * w + fr] = acc1[r]; } }
    bf16x8 kob[4][4];
#pragma unroll
    for (int jj = 0; jj < 4; ++jj)
#pragma unroll
        for (int ks = 0; ks < 4; ++ks) kob[jj][ks] = *(const bf16x8*)(KO + ((size_t)(g * 64 + 4 * w + jj) * 16 + fr) * 128 + 32 * ks + 8 * kq);
    __syncthreads();
    if (w == 0) { const int p = lane; float xr = MS[p], xi = MS[64 + p]; const float ar = MS[128 + p], ai = MS[192 + p];
#pragma unroll
        for (int hf = 0; hf < 2; ++hf) { float sr[16], si[16];
#pragma unroll
            for (int c = 0; c < 16; ++c) { sr[c] = SLOC[(16 * hf + c) * 128 + p]; si[c] = SLOC[(16 * hf + c) * 128 + 64 + p]; }
#pragma unroll
            for (int c = 0; c < 16; ++c) { const int cc = 16 * hf + c; *(LAS bf16*)(L + S5_XINB + cc * S5_XSTR + p * 2) = (bf16)f2bf(xr); *(LAS bf16*)(L + S5_XINB + cc * S5_XSTR + (64 + p) * 2) = (bf16)f2bf(xi);
                const float nr2 = ar * xr - ai * xi + sr[c], ni2 = ar * xi + ai * xr + si[c]; xr = nr2; xi = ni2; } } }
    __syncthreads();
    for (int bi = 0; bi < 2; ++bi) { const int t = bi == 0 ? w : 15 - w, j0 = 4 * t;
        f32x4 acc[4][2];
#pragma unroll
        for (int jj = 0; jj < 4; ++jj) { acc[jj][0] = (f32x4){0.f, 0.f, 0.f, 0.f}; acc[jj][1] = acc[jj][0]; }
#pragma unroll
        for (int ks = 0; ks < 4; ++ks) {
            const bf16x8 x0 = *(const LAS bf16x8*)(L + S5_XINB + fr * S5_XSTR + (32 * ks + 8 * kq) * 2);
            const bf16x8 x1 = *(const LAS bf16x8*)(L + S5_XINB + (16 + fr) * S5_XSTR + (32 * ks + 8 * kq) * 2);
#pragma unroll
            for (int jj = 0; jj < 4; ++jj) { acc[jj][0] = mfma16(x0, kob[jj][ks], acc[jj][0]); acc[jj][1] = mfma16(x1, kob[jj][ks], acc[jj][1]); } }
        const int h2 = kq >> 1; const bf16x8 zf = (bf16x8){0, 0, 0, 0, 0, 0, 0, 0};
#define S5_KIF(d) (((d) - h2) >= 0 ? *(const LAS bf16x8*)(L + S5_KI + ((((d) - h2) * 16 + fr) * 16 + 8 * (kq & 1)) * 2) : zf)
#define S5_UA(row, ks) (*(const LAS bf16x8*)(L + S5_U + (row) * S5_USTR + (32 * (ks) + 8 * kq) * 2))
        bf16x8 F0 = S5_KIF(j0), F1 = S5_KIF(j0 + 1), F2 = S5_KIF(j0 + 2), F3 = S5_KIF(j0 + 3);
        bf16x8 a0 = S5_UA(fr, 0), a1 = S5_UA(16 + fr, 0);
        const int ksmax = (j0 + 3) >> 1;
        for (int ks = 0; ks <= ksmax; ++ks) {
            const int ksn = ks < ksmax ? ks + 1 : ks, dn = j0 - 2 * (ks + 1);
            const bf16x8 a0n = S5_UA(fr, ksn), a1n = S5_UA(16 + fr, ksn), F0n = S5_KIF(dn), F1n = S5_KIF(dn + 1);
            acc[0][0] = mfma16(a0, F0, acc[0][0]); acc[0][1] = mfma16(a1, F0, acc[0][1]); acc[1][0] = mfma16(a0, F1, acc[1][0]); acc[1][1] = mfma16(a1, F1, acc[1][1]);
            acc[2][0] = mfma16(a0, F2, acc[2][0]); acc[2][1] = mfma16(a1, F2, acc[2][1]); acc[3][0] = mfma16(a0, F3, acc[3][0]); acc[3][1] = mfma16(a1, F3, acc[3][1]);
            F3 = F1; F2 = F0; F0 = F0n; F1 = F1n; a0 = a0n; a1 = a1n; }
#undef S5_KIF
#undef S5_UA
        if (bi == 0) {
#pragma unroll
            for (int jj = 0; jj < 4; ++jj)
#pragma unroll
                for (int ks = 0; ks < 4; ++ks) kob[jj][ks] = *(const bf16x8*)(KO + ((size_t)(g * 64 + 4 * (15 - w) + jj) * 16 + fr) * 128 + 32 * ks + 8 * kq); }
#pragma unroll
        for (int jj = 0; jj < 4; ++jj) { const int j = j0 + jj;
#pragma unroll
            for (int r = 0; r < 4; ++r) { const int c0 = 4 * kq + r, c1 = 16 + 4 * kq + r;
                YA[(size_t)(b * 2048 + 64 * c0 + j) * 512 + 16 * g + fr] = (bf16)f2bf(gelu_tanh(acc[jj][0][r]));
                YA[(size_t)(b * 2048 + 64 * c1 + j) * 512 + 16 * g + fr] = (bf16)f2bf(gelu_tanh(acc[jj][1][r])); } } }
}

constexpr int DS_SSTR = 2208  , DS_WREG = 17664, DS_TSTR = 144, DS_BMS = 2112  ,
    DS_GAP = 8448  ,
    DS_BUF = 2 * DS_WREG  , DS_VOFF = DS_WREG, DS_BT = 4 * DS_WREG + DS_GAP  , DS_HIST = 141312, DS_RB = 152576, DS_TB = 153600;
typedef short s16x4 __attribute__((ext_vector_type(4)));
__device__ __forceinline__ s16x4 tr_read(unsigned addr) { s16x4 r; asm volatile("ds_read_b64_tr_b16 %0, %1" : "=&v"(r) : "v"(addr) : "memory"); return r; }
__device__ __forceinline__ float relu_i(float x) { const int i = __builtin_bit_cast(int, x); return __builtin_bit_cast(float, i > 0 ? i : 0); }
typedef _Float16 h16x2 __attribute__((ext_vector_type(2)));
__device__ __forceinline__ h16x2 cvt_h2(float a, float b) { return __builtin_bit_cast(h16x2, __builtin_amdgcn_cvt_pkrtz(a, b)); }
__device__ __forceinline__ unsigned f16key_h(_Float16 hf) { const int h = (int)__builtin_bit_cast(unsigned short, hf); return (unsigned)(h ^ (__builtin_amdgcn_sbfe(h, 15, 1) | 0x8000)) & 0xffffu; }
__device__ __forceinline__ unsigned f16key(float f) { const _Float16 hf = (_Float16)f; const unsigned h = (unsigned)__builtin_bit_cast(unsigned short, hf); return (h & 0x8000u) ? (~h & 0xffffu) : (h | 0x8000u); }
__device__ __forceinline__ unsigned cvtpk(float lo, float hi) { unsigned r; asm volatile("v_cvt_pk_bf16_f32 %0, %1, %2" : "=v"(r) : "v"(lo), "v"(hi)); return r; }
__device__ __forceinline__ void dsa_tables(const Args& a, LAS unsigned char* L, int tid) {
    if (tid < 256) { ((LAS float*)(L + DS_RB))[tid] = a.in[25][tid] * 1.44269504f;
        const int n = tid; const int lo = n < 8 ? n : (n < 12 ? 8 : n < 16 ? 9 : n < 23 ? 10 : n < 32 ? 11 : n < 46 ? 12 : n < 64 ? 13 : n < 91 ? 14 : 15);
        ((LAS int*)(L + DS_TB))[tid] = lo; }
}

__device__ __forceinline__ int wave_incl_scan(int x) {
    int v = x;
    v += __builtin_amdgcn_update_dpp(0, v, 0x111, 0xf, 0xf, false);
    v += __builtin_amdgcn_update_dpp(0, v, 0x112, 0xf, 0xf, false);
    v += __builtin_amdgcn_update_dpp(0, v, 0x114, 0xf, 0xf, false);
    v += __builtin_amdgcn_update_dpp(0, v, 0x118, 0xf, 0xf, false);
    v += __builtin_amdgcn_update_dpp(0, v, 0x142, 0xa, 0xf, false);
    v += __builtin_amdgcn_update_dpp(0, v, 0x143, 0xc, 0xf, false);
    return v;
}
template <int NE>
__device__ __forceinline__ void dsa_select(LAS unsigned char* L, int c, int nt64, int w, int lane) {
    LAS unsigned short* S16 = (LAS unsigned short*)L;
    LAS unsigned* H = (LAS unsigned*)(L + DS_HIST) + w * 256;
    const int rl = 63 - lane;
    for (int qq = 0; qq < 4; ++qq) { const int q = 4 * w + qq; const LAS unsigned short* Sq = S16 + q * DS_SSTR; unsigned tkey = 0u;
        unsigned kr[NE];
#pragma unroll
        for (int e = 0; e < NE; ++e) kr[e] = (unsigned)Sq[64 * e + lane];
        if (c >= 4) { unsigned prefix = 0u; int kth = 256;
#pragma unroll
            for (int pass = 0; pass < 2; ++pass) {
                H[lane] = 0u; H[lane + 64] = 0u; H[lane + 128] = 0u; H[lane + 192] = 0u; LDS_WAIT();
#pragma unroll
                for (int e = 0; e < NE; ++e) { const unsigned key = kr[e]; const bool in = (pass == 0) ? (key != 0u) : ((key >> 8) == prefix);
                    if (in) (void)__hip_atomic_fetch_add(&H[pass == 0 ? (key >> 8) : (key & 255u)], 1u, __ATOMIC_RELAXED, __HIP_MEMORY_SCOPE_WORKGROUP); }
                LDS_WAIT();
                const unsigned h0 = H[4 * rl], h1 = H[4 * rl + 1], h2 = H[4 * rl + 2], h3 = H[4 * rl + 3]; const int t = (int)(h0 + h1 + h2 + h3);
                const int sfx = wave_incl_scan(t), above = sfx - t; const bool has = (above < kth) && (above + t >= kth);
                const unsigned long long bm = __ballot(has); const int src = bm ? (__ffsll((long long)bm) - 1) : 0;
                int cum = above, B; if (cum + (int)h3 >= kth) B = 3; else { cum += (int)h3; if (cum + (int)h2 >= kth) B = 2; else { cum += (int)h2; if (cum + (int)h1 >= kth) B = 1; else { cum += (int)h1; B = 0; } } }
                const int bin = __builtin_amdgcn_readlane(4 * rl + B, src); kth = __builtin_amdgcn_readlane(kth - cum, src);
                prefix = (prefix << 8) | (unsigned)bin; LDS_WAIT(); }
            tkey = prefix; }
        LAS unsigned char* bm = L + w * DS_WREG + qq * DS_BMS + lane;
#pragma unroll
        for (int e = 0; e < NE; ++e) { const int s = 64 * e + lane; const bool sel = ((s < 16) || (s >= 64)) && (kr[e] >= tkey); bm[64 * e] = sel ? (unsigned char)0xFF : (unsigned char)0; } }
}
__device__ __forceinline__ void dsa_unit(const Args& a, LAS unsigned char* L, int b, int uq, int tid) {
    volatile LAS unsigned* PRB = (volatile LAS unsigned*)(L + MISC_OFF) + 16;
    PROBE_BEGIN(4);
    const int lane = tid & 63, w = __builtin_amdgcn_readfirstlane(tid >> 6), fr = lane & 15, kq = lane >> 4;
    const bf16* PA = (const bf16*)(a.ws + WS_PA); const bf16* PK = (const bf16*)(a.ws + WS_PK); const bf16* PMK = (const bf16*)(a.ws + WS_META + MO_PMK);
    bf16* YB = (bf16*)(a.ws + WS_HN) + (size_t)R * 512;
    const int c = 1 + (uq >> 1), nt64 = c + 1, qrow0 = b * 2048 + 32 * uq;
    LAS unsigned short* S16 = (LAS unsigned short*)L;
    const LAS float* RB = (const LAS float*)(L + DS_RB); const LAS int* TB = (const LAS int*)(L + DS_TB);
    __syncthreads();
    PROBE_BEGIN(1);
    { const int qh = w >> 2; bf16x8 qa[4][2][2]; h16x2 wh[4][4];
#pragma unroll
      for (int p = 0; p < 4; ++p) {
#pragma unroll
          for (int hf = 0; hf < 2; ++hf)
#pragma unroll
              for (int ks = 0; ks < 2; ++ks) qa[p][hf][ks] = *(const bf16x8*)(PA + (size_t)(qrow0 + 16 * qh + 4 * p + (fr >> 2)) * 1024 + (4 * hf + (fr & 3)) * 64 + 32 * ks + 8 * kq);
          const v4u wraw = *(const v4u*)(PK + (size_t)(qrow0 + 16 * qh + 4 * p + kq) * 256 + 192);
          wh[p][0] = cvt_h2(bflo(wraw.x) * 0.04419417382f, bfhi(wraw.x) * 0.04419417382f); wh[p][1] = cvt_h2(bflo(wraw.y) * 0.04419417382f, bfhi(wraw.y) * 0.04419417382f);
          wh[p][2] = cvt_h2(bflo(wraw.z) * 0.04419417382f, bfhi(wraw.z) * 0.04419417382f); wh[p][3] = cvt_h2(bflo(wraw.w) * 0.04419417382f, bfhi(wraw.w) * 0.04419417382f); }
      const int nkt = 4 * nt64;
      { const int ner = nt64 <= 9 ? 9 : nt64 <= 17 ? 17 : nt64 <= 25 ? 25 : 33;
        for (int kz = 4 * nt64 + (w & 3); kz < 4 * ner; kz += 4) {
#pragma unroll
            for (int p = 0; p < 4; ++p) S16[(16 * qh + 4 * p + kq) * DS_SSTR + 16 * kz + fr] = (unsigned short)0; } }
      if ((w & 3) != 0) {
#pragma unroll
          for (int p = 0; p < 4; ++p) S16[(16 * qh + 4 * p + kq) * DS_SSTR + 16 * (w & 3) + fr] = (unsigned short)0; }
      int kt = (w & 3) == 0 ? 0 : (w & 3) + 4;
      bf16x8 kb0, kb1, kc0, kc1;
      { const bf16* krow = (kt == 0) ? PMK + fr * 256 : PK + (size_t)(b * 2048 + 16 * kt - 64 + fr) * 256; kb0 = *(const bf16x8*)(krow + 8 * kq); kb1 = *(const bf16x8*)(krow + 32 + 8 * kq); }
      { const int k1 = (kt == 0) ? 4 : kt + 4; kc0 = kb0; kc1 = kb1;
        if (k1 < nkt) { const bf16* krow = PK + (size_t)(b * 2048 + 16 * k1 - 64 + fr) * 256; kc0 = *(const bf16x8*)(krow + 8 * kq); kc1 = *(const bf16x8*)(krow + 32 + 8 * kq); } }
      while (kt < nkt) {
          const int ktn = (kt == 0) ? 4 : kt + 4, ktnn = ktn + 4; bf16x8 nb0 = kc0, nb1 = kc1;
          if (ktnn < nkt) { const bf16* krow = PK + (size_t)(b * 2048 + 16 * ktnn - 64 + fr) * 256; nb0 = *(const bf16x8*)(krow + 8 * kq); nb1 = *(const bf16x8*)(krow + 32 + 8 * kq); }
          h16x2 sacc[4];
#pragma unroll
          for (int p = 0; p < 4; ++p) { f32x4 aA = (f32x4){0.f, 0.f, 0.f, 0.f}, aB = aA;
              aA = mfma16(qa[p][0][0], kb0, aA); aB = mfma16(qa[p][1][0], kb0, aB); aA = mfma16(qa[p][0][1], kb1, aA); aB = mfma16(qa[p][1][1], kb1, aB);
              const h16x2 z2 = (h16x2){(_Float16)0.f, (_Float16)0.f};
              h16x2 sa = __builtin_elementwise_max(cvt_h2(aA[0], aA[1]), z2) * wh[p][0];
              sa = __builtin_elementwise_max(cvt_h2(aA[2], aA[3]), z2) * wh[p][1] + sa;
              sa = __builtin_elementwise_max(cvt_h2(aB[0], aB[1]), z2) * wh[p][2] + sa;
              sa = __builtin_elementwise_max(cvt_h2(aB[2], aB[3]), z2) * wh[p][3] + sa;
              sacc[p] = sa; }
#pragma unroll
          for (int pp = 0; pp < 4; pp += 2) { const unsigned a = __builtin_bit_cast(unsigned, sacc[pp]), bb = __builtin_bit_cast(unsigned, sacc[pp + 1]);
              const unsigned lo = __builtin_amdgcn_perm(bb, a, 0x05040100u), hi = __builtin_amdgcn_perm(bb, a, 0x07060302u);
              const h16x2 t = __builtin_bit_cast(h16x2, lo) + __builtin_bit_cast(h16x2, hi);
              typedef short s16x2v __attribute__((ext_vector_type(2)));
              const unsigned tb = __builtin_bit_cast(unsigned, t), m = __builtin_bit_cast(unsigned, __builtin_bit_cast(s16x2v, t) >> (s16x2v){15, 15});
              const unsigned k = tb ^ (m | 0x80008000u);
              S16[(16 * qh + 4 * pp + kq) * DS_SSTR + 16 * kt + fr] = (unsigned short)(k & 0xffffu);
              S16[(16 * qh + 4 * (pp + 1) + kq) * DS_SSTR + 16 * kt + fr] = (unsigned short)(k >> 16); }
          kb0 = kc0; kb1 = kc1; kc0 = nb0; kc1 = nb1; kt = ktn; } }
    __syncthreads();
    PROBE_END(1);
    bf16x8 qb[2][2]; unsigned mkoff[2];
#pragma unroll
    for (int cg = 0; cg < 2; ++cg) { const int q = 4 * w + 2 * cg + (fr >> 3), h = fr & 7; mkoff[cg] = (unsigned)(w * DS_WREG + (2 * cg + (fr >> 3)) * DS_BMS + 4 * kq);
#pragma unroll
        for (int ks = 0; ks < 2; ++ks) qb[cg][ks] = *(const bf16x8*)(PA + (size_t)(qrow0 + q) * 1024 + 512 + h * 64 + 32 * ks + 8 * kq); }
    const int skey = tid >> 3, spiece = tid & 7;
    v4u kv0 = (v4u){0u, 0u, 0u, 0u}, vv0 = kv0, kv, vv;
    if (skey < 16) { const bf16* krow = PMK + skey * 256; kv0 = *(const v4u*)(krow + 64 + 8 * spiece); vv0 = *(const v4u*)(krow + 128 + 8 * spiece); }
    { const bf16* krow = PK + (size_t)(b * 2048 + skey) * 256; kv = *(const v4u*)(krow + 64 + 8 * spiece); vv = *(const v4u*)(krow + 128 + 8 * spiece); }
    PROBE_BEGIN(2);
    if (nt64 <= 9) dsa_select<9>(L, c, nt64, w, lane);
    else if (nt64 <= 17) dsa_select<17>(L, c, nt64, w, lane);
    else if (nt64 <= 25) dsa_select<25>(L, c, nt64, w, lane);
    else dsa_select<33>(L, c, nt64, w, lane);
    __syncthreads();
    PROBE_END(2);
    PROBE_BEGIN(3);
    {
      const int hh = fr & 7; const float bfar = RB[15 * 8 + hh];
      float mrun[2] = {0.f, 0.f}, lrun[2] = {0.f, 0.f}; f32x4 O[2][4];
#pragma unroll
      for (int cg = 0; cg < 2; ++cg)
#pragma unroll
          for (int dt = 0; dt < 4; ++dt) O[cg][dt] = (f32x4){0.f, 0.f, 0.f, 0.f};
      const LAS float* BT = (const LAS float*)(L + DS_BT);
#pragma unroll
      for (int k = 0; k < 4; ++k) { const int e = tid + 512 * k, relc = (e >> 3) - 128, n = relc < 0 ? -relc : relc; ((LAS float*)(L + DS_BT))[e] = RB[(TB[n] + (relc > 0 ? 16 : 0)) * 8 + (e & 7)]; }
      const unsigned ldsV = (unsigned)(size_t)(L) + (unsigned)(DS_GAP + DS_VOFF) + (unsigned)((4 * kq + ((lane & 15) >> 2)) * DS_TSTR + 8 * (lane & 3));
      *(LAS v4u*)(L + DS_GAP + skey * DS_TSTR + 16 * spiece) = kv0; *(LAS v4u*)(L + DS_GAP + DS_VOFF + skey * DS_TSTR + 16 * spiece) = vv0;
      __syncthreads();
      for (int T = 0; T < nt64; ++T) { const int buf = T & 1;
          v4u kn = kv, vn = vv;
          if (T + 2 < nt64) { const bf16* krow = PK + (size_t)(b * 2048 + 64 * (T + 1) + skey) * 256; kn = *(const v4u*)(krow + 64 + 8 * spiece); vn = *(const v4u*)(krow + 128 + 8 * spiece); }
          const bool nearT = (64 * T > 32 * uq - 90);
          f32x4 lg[2][4];
          { bf16x8 ka[4][2];
#pragma unroll
            for (int sub = 0; sub < 4; ++sub)
#pragma unroll
                for (int ks = 0; ks < 2; ++ks) ka[sub][ks] = *(const LAS bf16x8*)(L + DS_GAP + buf * DS_BUF + fr * DS_TSTR + 16 * kq + sub * 16 * DS_TSTR + ks * 64);
#pragma unroll
            for (int cg = 0; cg < 2; ++cg)
#pragma unroll
                for (int sub = 0; sub < 4; ++sub) { f32x4 acc = (f32x4){0.f, 0.f, 0.f, 0.f}; acc = mfma16(ka[sub][0], qb[cg][0], acc); acc = mfma16(ka[sub][1], qb[cg][1], acc); lg[cg][sub] = acc; } }
          s16x4 vt[2][4][2];
#pragma unroll
          for (int cg = 0; cg < 2; ++cg) {
              const float mc = mrun[cg]; float mxl = -1.0e30f;
              if (nearT) { const int relb = ((T == 0) ? 0 : 64 * T - 48) + 4 * kq - (16 + 32 * uq + 4 * w + 2 * cg + (fr >> 3));
#pragma unroll
                  for (int sub = 0; sub < 4; ++sub)
#pragma unroll
                      for (int r = 0; r < 4; ++r) { int idx = relb + 16 * sub + r; idx = idx < -128 ? -128 : idx; idx = idx > 127 ? 127 : idx;
                          const float v = lg[cg][sub][r] * 0.18033688f + (BT[(idx + 128) * 8 + hh] - mc); lg[cg][sub][r] = v; mxl = fmaxf(mxl, v); }
              } else { const float bm = bfar - mc;
#pragma unroll
                  for (int sub = 0; sub < 4; ++sub)
#pragma unroll
                      for (int r = 0; r < 4; ++r) { const float v = lg[cg][sub][r] * 0.18033688f + bm; lg[cg][sub][r] = v; mxl = fmaxf(mxl, v); } }
              if (T == 0 || __ballot(mxl > 8.0f) != 0ull) {
                  float mx = mxl; mx = fmaxf(mx, __shfl_xor(mx, 16)); mx = fmaxf(mx, __shfl_xor(mx, 32));
                  const float delta = (T == 0) ? mx : fmaxf(mx, 0.f), sc = __builtin_amdgcn_exp2f(-delta); mrun[cg] = mc + delta; lrun[cg] *= sc;
#pragma unroll
                  for (int dt = 0; dt < 4; ++dt) O[cg][dt] = O[cg][dt] * sc;
#pragma unroll
                  for (int sub = 0; sub < 4; ++sub)
#pragma unroll
                      for (int r = 0; r < 4; ++r) lg[cg][sub][r] -= delta; }
              const LAS unsigned char* bmp = L + mkoff[cg] + 64 * T; float ls = 0.f;
#pragma unroll
              for (int sub = 0; sub < 4; ++sub) { const unsigned mw = *(const LAS unsigned*)(bmp + 16 * sub);
#pragma unroll
                  for (int r = 0; r < 4; ++r) { const float e = __builtin_amdgcn_exp2f(lg[cg][sub][r]); float p;
                      if (r == 0) asm("v_and_b32_sdwa %0, %1, sext(%2) dst_sel:DWORD dst_unused:UNUSED_PAD src0_sel:DWORD src1_sel:BYTE_0" : "=v"(p) : "v"(e), "v"(mw));
                      if (r == 1) asm("v_and_b32_sdwa %0, %1, sext(%2) dst_sel:DWORD dst_unused:UNUSED_PAD src0_sel:DWORD src1_sel:BYTE_1" : "=v"(p) : "v"(e), "v"(mw));
                      if (r == 2) asm("v_and_b32_sdwa %0, %1, sext(%2) dst_sel:DWORD dst_unused:UNUSED_PAD src0_sel:DWORD src1_sel:BYTE_2" : "=v"(p) : "v"(e), "v"(mw));
                      if (r == 3) asm("v_and_b32_sdwa %0, %1, sext(%2) dst_sel:DWORD dst_unused:UNUSED_PAD src0_sel:DWORD src1_sel:BYTE_3" : "=v"(p) : "v"(e), "v"(mw));
                      ls += p; lg[cg][sub][r] = p; } }
              lrun[cg] += ls; }
          { const unsigned vaddr = ldsV + (unsigned)(buf * DS_BUF);
            asm volatile("ds_read_b64_tr_b16 %0, %16 offset:0\n\t"
                "ds_read_b64_tr_b16 %1, %16 offset:2304\n\t"
                "ds_read_b64_tr_b16 %2, %16 offset:32\n\t"
                "ds_read_b64_tr_b16 %3, %16 offset:2336\n\t"
                "ds_read_b64_tr_b16 %4, %16 offset:64\n\t"
                "ds_read_b64_tr_b16 %5, %16 offset:2368\n\t"
                "ds_read_b64_tr_b16 %6, %16 offset:96\n\t"
                "ds_read_b64_tr_b16 %7, %16 offset:2400\n\t"
                "ds_read_b64_tr_b16 %8, %16 offset:4608\n\t"
                "ds_read_b64_tr_b16 %9, %16 offset:6912\n\t"
                "ds_read_b64_tr_b16 %10, %16 offset:4640\n\t"
                "ds_read_b64_tr_b16 %11, %16 offset:6944\n\t"
                "ds_read_b64_tr_b16 %12, %16 offset:4672\n\t"
                "ds_read_b64_tr_b16 %13, %16 offset:6976\n\t"
                "ds_read_b64_tr_b16 %14, %16 offset:4704\n\t"
                "ds_read_b64_tr_b16 %15, %16 offset:7008\n\t"
                "s_waitcnt lgkmcnt(0)"
                : "=&v"(vt[0][0][0]), "=&v"(vt[0][0][1]), "=&v"(vt[0][1][0]), "=&v"(vt[0][1][1]), "=&v"(vt[0][2][0]), "=&v"(vt[0][2][1]), "=&v"(vt[0][3][0]), "=&v"(vt[0][3][1]), "=&v"(vt[1][0][0]), "=&v"(vt[1][0][1]), "=&v"(vt[1][1][0]), "=&v"(vt[1][1][1]), "=&v"(vt[1][2][0]), "=&v"(vt[1][2][1]), "=&v"(vt[1][3][0]), "=&v"(vt[1][3][1])
                : "v"(vaddr) : "memory"); }
#pragma unroll
          for (int ks2 = 0; ks2 < 2; ++ks2) { bf16x8 pb[2];
#pragma unroll
              for (int cg = 0; cg < 2; ++cg) { v4u pw; pw.x = cvtpk(lg[cg][2 * ks2][0], lg[cg][2 * ks2][1]); pw.y = cvtpk(lg[cg][2 * ks2][2], lg[cg][2 * ks2][3]);
                  pw.z = cvtpk(lg[cg][2 * ks2 + 1][0], lg[cg][2 * ks2 + 1][1]); pw.w = cvtpk(lg[cg][2 * ks2 + 1][2], lg[cg][2 * ks2 + 1][3]); pb[cg] = __builtin_bit_cast(bf16x8, pw); }
#pragma unroll
              for (int dt = 0; dt < 4; ++dt) { const bf16x8 va = __builtin_shufflevector(vt[ks2][dt][0], vt[ks2][dt][1], 0, 1, 2, 3, 4, 5, 6, 7);
#pragma unroll
                  for (int cg = 0; cg < 2; ++cg) O[cg][dt] = mfma16(va, pb[cg], O[cg][dt]); } }
          if (T + 1 < nt64) { *(LAS v4u*)(L + DS_GAP + (buf ^ 1) * DS_BUF + skey * DS_TSTR + 16 * spiece) = kv; *(LAS v4u*)(L + DS_GAP + (buf ^ 1) * DS_BUF + DS_VOFF + skey * DS_TSTR + 16 * spiece) = vv; }
          kv = kn; vv = vn;
          __syncthreads();
      }
#pragma unroll
      for (int cg = 0; cg < 2; ++cg) { float v = lrun[cg]; v += __shfl_xor(v, 16); v += __shfl_xor(v, 32); const float inv = 1.0f / v;
          const int q = 4 * w + 2 * cg + (fr >> 3);
#pragma unroll
          for (int dt = 0; dt < 4; ++dt) { v2u o; o.x = cvtpk(O[cg][dt][0] * inv, O[cg][dt][1] * inv); o.y = cvtpk(O[cg][dt][2] * inv, O[cg][dt][3] * inv);
              *(v2u*)(YB + (size_t)(qrow0 + q) * 512 + hh * 64 + 16 * dt + 4 * kq) = o; } } }
    PROBE_END(3);
    PROBE_END(4);
}

__global__ void __launch_bounds__(NWAVES * 64, 2) mk_fwd(Args args) {
    extern __shared__ __attribute__((aligned(16))) unsigned char lds[];
    LAS unsigned char* L = (LAS unsigned char*)lds;
    volatile LAS unsigned* MISC = (volatile LAS unsigned*)(L + MISC_OFF);
    const int tid = threadIdx.x, lane = tid & 63, wave = __builtin_amdgcn_readfirstlane(tid >> 6);
    const int G = gridDim.x, bx = blockIdx.x;
    const int gw = bx * NWAVES + wave, NGW = G * NWAVES;
    unsigned char* ws = args.ws;
    if (tid < 32) MISC[tid] = 0u;
    __syncthreads();
    XcdBarrier bar; bar.bar = (unsigned*)(ws + WS_CTL) + CW_BAR; bar.x = 0; bar.st = nullptr;
    if (!MK_PER_PHASE) bar = xcd_barrier_post((unsigned*)(ws + WS_CTL) + CW_BAR, MISC + 8);
    const int lo = args.ph_lo, hi = args.ph_hi;
    volatile LAS unsigned* PRB = MISC + 16;
#define IN(k) (lo <= (k) && (k) < hi)
#define SEAM(k) do { if (IN(k) && IN((k) + 1)) xcd_barrier(bar); } while (0)
    bf16* WT1 = (bf16*)(ws + WS_WT1); bf16* WT2 = (bf16*)(ws + WS_WT2); bf16* WT3 = (bf16*)(ws + WS_WT3); bf16* WT4 = (bf16*)(ws + WS_WT4); bf16* WT5 = (bf16*)(ws + WS_WT5);
    bf16* WGLU = (bf16*)(ws + WS_WGLU); bf16* WA = (bf16*)(ws + WS_WA); bf16* WB = (bf16*)(ws + WS_WB); bf16* WOUT = (bf16*)(ws + WS_WOUT);
    bf16* HN = (bf16*)(ws + WS_HN); bf16* FB = (bf16*)(ws + WS_F); bf16* ACT = (bf16*)(ws + WS_BIG);
    bf16* PA = (bf16*)(ws + WS_PA); bf16* PG = (bf16*)(ws + WS_PG); bf16* PK = (bf16*)(ws + WS_PK);
    bf16* AM1 = (bf16*)(ws + WS_META + MO_AM1); bf16* ACTM = (bf16*)(ws + WS_META + MO_ACTM); bf16* FM = (bf16*)(ws + WS_META + MO_FM); bf16* AM2 = (bf16*)(ws + WS_META + MO_AM2);
    bf16* PMU = (bf16*)(ws + WS_META + MO_PMU); bf16* PMK = (bf16*)(ws + WS_META + MO_PMK);
    bf16* HB = (bf16*)(ws + WS_HB); float* RS1 = (float*)(ws + WS_META + 524288); float* RS2 = (float*)(ws + WS_META + 655360);
    bf16* YA = FB; bf16* YG = HN; bf16* YB = HN + (size_t)R * 512; bf16* MERGED = PA;
    const float* x = args.in[0]; float* out = args.out;

    PROBE_BEGIN(20);
    if (IN(0)) {
        PROBE_BEGIN(40);
        s5_tables_load(args, bx >> 3, (LAS float*)(L + 131072), tid);
        if (wave & 1) s5_tables_wave(args, bx >> 3, 8 * (bx & 7) + wave, (const LAS float*)(L + 131072), (LAS float*)(L + 147456 + wave * 512), lane);
        PROBE_END(40); PROBE_BEGIN(41);
        LAS float* scr = (LAS float*)(L + wave * 16384);
        { TrDesc da, db; f32x4 wa[8], wb[8];
          int it = gw; bool ha = it < 12928, hb;
          if (ha) { tr_decode(args, ws, it, lane, da); tr_load(da, wa); }
          while (ha) {
              hb = it + NGW < 12928; if (hb) { tr_decode(args, ws, it + NGW, lane, db); tr_load(db, wb); }
              tr_finish(da, wa, scr, lane);
              it += NGW; if (!hb) break;
              ha = it + NGW < 12928; if (ha) { tr_decode(args, ws, it + NGW, lane, da); tr_load(da, wa); }
              tr_finish(db, wb, scr, lane);
              it += NGW; } }
        PROBE_END(41); PROBE_BEGIN(42);
        for (int m0 = gw; m0 < R; m0 += 2 * NGW) {
            f32x4 xv[2][4];
#pragma unroll
            for (int t = 0; t < 2; ++t)
#pragma unroll
                for (int j = 0; j < 4; ++j) xv[t][j] = ((const f32x4*)(x + (size_t)(m0 + t * NGW) * D))[lane + 64 * j];
#pragma unroll
            for (int t = 0; t < 2; ++t) { const size_t m = (size_t)(m0 + t * NGW); float ss = 0.f;
#pragma unroll
                for (int j = 0; j < 4; ++j) { const f32x4 v = xv[t][j]; ss += (v.x * v.x + v.y * v.y) + (v.z * v.z + v.w * v.w); v2u o; o.x = pk2(v.x, v.y); o.y = pk2(v.z, v.w); ((v2u*)(HN + m * D))[lane + 64 * j] = o; }
                const float rs = rsqrtf(wave_sum(ss) * (1.f / D) + RMS_EPS); if (lane == 0) RS1[m] = rs; } }
        PROBE_END(42); PROBE_BEGIN(43);
        if (!(wave & 1)) s5_tables_wave(args, bx >> 3, 8 * (bx & 7) + wave, (const LAS float*)(L + 131072), (LAS float*)(L + 147456 + wave * 512), lane);
        if (gw < NMETA) x_row_to_bf16<true>(args.in[1] + (size_t)gw * D, AM1 + (size_t)gw * D, nullptr, lane);
    }
    SEAM(0);
    PROBE_END(43);
    PROBE_END(20);
    PROBE_BEGIN(21);
    if (IN(1)) {
        if (bx < 176) { const int j0 = 16 * bx, grow = 256 * (j0 >> 7) + (j0 & 127); f32x4 g4, u4;
            meta_tile_blk<4>(AM1, WT1 + (size_t)grow * D, WT1 + (size_t)(grow + 128) * D, D, (LAS float*)L, wave, lane, g4, u4);
            if (wave == 0) {
#pragma unroll
                for (int r = 0; r < 4; ++r) ACTM[(4 * (lane >> 4) + r) * DFF + j0 + (lane & 15)] = (bf16)f2bf(g4[r] * fsig(g4[r]) * u4[r]); } }
        pg8::Gemm g{HN, WT1, R, 2 * DFF, D}; pg8::StaticOrder S; S.init(R, 2 * DFF, G, bx); pg8::EpiSwigluR8 E{(unsigned char*)ACT, DFF, RS1, 8.0f};
        pg8::gemm_phase<pg8::EpiSwigluR8, pg8::StaticOrder, PG8_ALIGN, PG8_SP2>(L, g, S, E);
    }
    SEAM(1);
    PROBE_END(21);
    PROBE_BEGIN(22);
    if (IN(2)) {
        if (bx < 64) { const int n0 = 16 * bx; f32x4 f4, dummy;
            meta_tile_blk<11>(ACTM, WT2 + (size_t)n0 * DFF, nullptr, DFF, (LAS float*)L, wave, lane, f4, dummy);
            if (wave == 0) {
#pragma unroll
                for (int r = 0; r < 4; ++r) FM[(4 * (lane >> 4) + r) * D + n0 + (lane & 15)] = (bf16)f2bf(f4[r]); } }
        pg8::Gemm g{ACT, (const bf16*)(ws + WS_WT2Q), R, D, DFF}; pg8::StaticOrder S; S.init(R, D, G, bx); pg8::EpiPlainS E{FB, D, 1.0f / 512.0f};
        pg8::gemm_phase<pg8::EpiPlainS, pg8::StaticOrder, PG8_ALIGN, PG8_SP2, true>(L, g, S, E);
    }
    SEAM(2);
    PROBE_END(22);
    PROBE_BEGIN(23);
    if (IN(3)) {
        if (gw < NMETA) row_update<false, false>(FM + (size_t)gw * D, args.in[1] + (size_t)gw * D, nullptr, AM2 + (size_t)gw * D, args.in[3], nullptr, 0.5f, lane);
        rows_phase<true, false, true, true>(FB, HN, HB, nullptr, args.in[3], nullptr, 0.5f, RS2, (unsigned char*)(ws + WS_HB8), gw, NGW, lane);
    }
    SEAM(3);
    PROBE_END(23);
    PROBE_BEGIN(24);
    if (IN(4)) {
        if (bx < 44) { const int n0 = bx < 32 ? 16 * bx : 1536 + 16 * (bx - 32); f32x4 p4, dummy;
            meta_tile_blk<4>(AM2, WT3 + (size_t)n0 * D, nullptr, D, (LAS float*)L, wave, lane, p4, dummy);
            if (wave == 0) {
#pragma unroll
                for (int r = 0; r < 4; ++r) { const int row = 4 * (lane >> 4) + r; if (bx < 32) PMU[row * 512 + n0 + (lane & 15)] = (bf16)f2bf(p4[r]); else PMK[row * 256 + (n0 - 1536) + (lane & 15)] = (bf16)f2bf(p4[r]); } } }
        { pg8::Gemm g{HB, WT3, R, 1792, D}; pg8::ProjOrderA S; S.base.init(R, 1536, G, bx); S.c = bx; pg8::EpiProj E{PA, PK, (bf16*)(ws + WS_UA2), RS2};
          pg8::gemm_phase<pg8::EpiProj, pg8::ProjOrderA, PG8_ALIGN, PG8_SP2>(L, g, S, E); }
        { pg8::Gemm g{(const bf16*)(ws + WS_HB8), (const bf16*)(ws + WS_WT3B), R, 2048, D}; pg8::ProjOrderB S{bx}; pg8::EpiGates8 E{PG, RS2};
          pg8::gemm_phase<pg8::EpiGates8, pg8::ProjOrderB, PG8_ALIGN, PG8_SP2, true>(L, g, S, E); }
    }
    SEAM(4);
    PROBE_END(24);
    PROBE_BEGIN(25);
    if (IN(5)) {
        { const int v0 = 2 * (bx >> 3), gS = 4 * (bx & 7) + (v0 >> 4);
          if (wave != 0) { const unsigned char* ks = ws + WS_KS + (size_t)gS * 262144; const unsigned char* ko = ws + WS_KO + (size_t)gS * 262144; const unsigned char* ki = ws + WS_KI + (size_t)gS * 32768;
              const unsigned char* u1 = ws + WS_UA2 + (size_t)((v0 & 15) * 32 + gS) * 65536; unsigned tacc = 0u;
#pragma unroll
              for (int i = 0; i < 11; ++i) { const int ln = (tid - 64) + 448 * i;
                  if (ln < 4864) { const unsigned char* q = ln < 2048 ? ks + (size_t)ln * 128 : ln < 4096 ? ko + (size_t)(ln - 2048) * 128 : ln < 4352 ? ki + (size_t)(ln - 4096) * 128 : u1 + (size_t)(ln - 4352) * 128;
                      tacc ^= *(const volatile unsigned*)q; } }
              asm volatile("" :: "v"(tacc)); }
          PROBE_BEGIN(6); s5_meta(args, L, gS, tid); PROBE_END(6); PROBE_BEGIN(5);
          for (int rep = 0; rep < REP_S5; ++rep) for (int i = 0; i < 2; ++i) s5_unit(args, L, (v0 + i) & 15, gS, tid); PROBE_END(5); }
        __syncthreads();
        dsa_tables(args, L, tid);
        for (int i = 0; i < 4 * REP_DSA; ++i) { const int up = 4 * (bx >> 3) + (i & 3), u2 = up >> 1, b = 2 * (bx & 7) + (u2 >> 5), xq = u2 & 31; dsa_unit(args, L, b, (up & 1) ? 63 - xq : xq, tid); }
        __syncthreads();
    }
    SEAM(5);
    PROBE_END(25);
    PROBE_BEGIN(26);
    if (IN(6)) { pg8::Gemm g{YA, WGLU, R, 512, 512}; pg8::StaticOrder S; S.init(R, 512, G, bx); pg8::EpiGlu E{YA, YG};
        pg8::gemm_phase<pg8::EpiGlu, pg8::StaticOrder, PG8_ALIGN, PG8_SP2>(L, g, S, E); }
    SEAM(6);
    PROBE_END(26);
    PROBE_BEGIN(27);
    if (IN(7)) { pg8::Gemm g{YG, WA, 2 * R, 2048, 512}; pg8::MergeOrder S; S.base.init(R, D, G, bx); pg8::EpiMerge2 E{PG, FB, MERGED};
        pg8::gemm_phase<pg8::EpiMerge2, pg8::MergeOrder, PG8_ALIGN, PG8_SP2>(L, g, S, E); }
    if (IN(7) && IN(9)) xcd_barrier(bar);
    PROBE_END(27);
    PROBE_BEGIN(29);
    if (IN(9)) { pg8::Gemm g{MERGED, WOUT, R, D, D}; pg8::StaticOrder S; S.init(R, D, G, bx); pg8::EpiPlain E{FB, D};
        pg8::gemm_phase<pg8::EpiPlain, pg8::StaticOrder, PG8_ALIGN, PG8_SP2>(L, g, S, E); }
    SEAM(9);
    PROBE_END(29);
    PROBE_BEGIN(30);
    if (IN(10)) { rows_phase<true, true, false, false>(FB, HB, HB, (unsigned char*)HN, args.in[5], args.in[6], 1.0f, nullptr, nullptr, gw, NGW, lane); }
    SEAM(10);
    PROBE_END(30);
    PROBE_BEGIN(31);
    if (IN(11)) { pg8::Gemm g{HN, WT4, R, 2 * DFF, D}; pg8::StaticOrder S; S.init(R, 2 * DFF, G, bx); pg8::EpiSwiglu8 E{(unsigned char*)ACT, DFF, 1.0f / 256.0f, 8.0f};
        pg8::gemm_phase<pg8::EpiSwiglu8, pg8::StaticOrder, PG8_ALIGN, PG8_SP2, true>(L, g, S, E); }
    SEAM(11);
    PROBE_END(31);
    PROBE_BEGIN(32);
    if (IN(12)) { pg8::Gemm g{ACT, WT5, R, D, DFF}; pg8::StaticOrder S; S.init(R, D, G, bx); pg8::EpiPlainS E{FB, D, 1.0f / 512.0f};
        pg8::gemm_phase<pg8::EpiPlainS, pg8::StaticOrder, PG8_ALIGN, PG8_SP2, true>(L, g, S, E); }
    SEAM(12);
    PROBE_END(32);
    PROBE_BEGIN(33);
    if (IN(13)) { rows_phase<false, false, false, false>(FB, HB, out, nullptr, args.in[7], nullptr, 0.5f, nullptr, nullptr, gw, NGW, lane); }
    PROBE_END(33);
    if (PROBE_SEC != 0 && bx == 0 && tid == 0) { const unsigned long long acc_ = ((unsigned long long)PRB[1] << 32) | PRB[0]; const unsigned long long t_ = wall_clock64(); while (wall_clock64() - t_ < acc_ * 8ull) __builtin_amdgcn_s_sleep(8); }
#undef IN
#undef SEAM
}

extern "C" void kernel_launch(void* const* d_in, const int* in_sizes, int n_in, void* d_out, int out_size, void* d_ws, size_t ws_size, hipStream_t stream) {
    static int grid = 0;
    if (grid == 0) {
        if (n_in != 28 || out_size != R * D || ws_size < WS_END) { fprintf(stderr, "kernel_launch: unexpected shapes (n_in %d, out %d, ws %zu); nothing launched\n", n_in, out_size, ws_size); grid = -1; return; }
        int dev = 0, cus = 0, per_cu = 0;
        if (hipGetDevice(&dev) != hipSuccess || hipDeviceGetAttribute(&cus, hipDeviceAttributeMultiprocessorCount, dev) != hipSuccess) { grid = -1; return; }
        if (hipFuncSetAttribute((const void*)mk_fwd, hipFuncAttributeMaxDynamicSharedMemorySize, LDS_BYTES) != hipSuccess) { fprintf(stderr, "kernel_launch: hipFuncSetAttribute failed\n"); grid = -1; return; }
        if (hipOccupancyMaxActiveBlocksPerMultiprocessor(&per_cu, (const void*)mk_fwd, NWAVES * 64, LDS_BYTES) != hipSuccess || per_cu < 1) fprintf(stderr, "kernel_launch: note: occupancy query reports %d\n", per_cu);
        (void)hipGetLastError();
        grid = cus;
    }
    if (grid < 0) return;
    if (hipMemsetAsync((char*)d_ws + WS_CTL, 0, CTL_ZERO_BYTES, stream) != hipSuccess) return;
    Args a{};
    for (int i = 0; i < 28; ++i) a.in[i] = (const float*)d_in[i];
    a.out = (float*)d_out; a.ws = (unsigned char*)d_ws;
#if MK_PER_PHASE
    for (int ph = 0; ph < NPH; ++ph) { a.ph_lo = ph; a.ph_hi = ph + 1; hipLaunchKernelGGL(mk_fwd, dim3(grid), dim3(NWAVES * 64), LDS_BYTES, stream, a); }
#else
    a.ph_lo = 0; a.ph_hi = NPH;
    hipLaunchKernelGGL(mk_fwd, dim3(grid), dim3(NWAVES * 64), LDS_BYTES, stream, a);
#endif
}
```
